# Optimizing an MI355X kernel written in HIP

```python
import math
import jax
import jax.numpy as jnp
from jax import lax
import numpy as np

D_MODEL = 2048
BATCH = 2
SEQ = 4096
DEPTH = 1

D_MIX = D_MODEL
D_SSM = D_MIX // 2
D_ATTN = D_MIX - D_SSM
SSM_HEAD_DIM = 64
SSM_HEADS = D_SSM // SSM_HEAD_DIM
SSM_GROUPS = 2
SSM_STATE = 128
CONV_WIDTH = 4
CONV_CH = D_SSM + 2 * SSM_GROUPS * SSM_STATE
SSD_CHUNK = 128
ATTN_HEAD_DIM = 128
ATTN_HEADS = D_ATTN // ATTN_HEAD_DIM
IDX_HEADS = 16
IDX_DIM = 64
INDEX_TOPK = 256
Q_BLOCK = 128
ROPE_THETA = 10000.0
N_EXPERTS = 64
N_EXPERT_GROUPS = 8
EXPERTS_PER_GROUP = N_EXPERTS // N_EXPERT_GROUPS
TOPK_GROUPS = 4
TOP_K = 8
D_EXPERT = 512
D_SHARED = 512
ROUTED_SCALE = 2.5
ALPHA = (2.0 * DEPTH) ** 0.25
BETA = (8.0 * DEPTH) ** -0.25
SEG_SIZES = (D_SSM, CONV_CH, SSM_HEADS, D_ATTN, D_ATTN, D_ATTN, IDX_HEADS * IDX_DIM, IDX_DIM, IDX_HEADS)
SPLIT_POINTS = tuple(int(v) for v in np.cumsum(SEG_SIZES)[:-1])
D_IN_PROJ = int(sum(SEG_SIZES))

kernel_name = 'hybrid_ssd_dsa_moe_block'


def layer_norm(x, g, b, eps=1e-5):
    xf = x.astype(jnp.float32)
    mu = jnp.mean(xf, axis=-1, keepdims=True)
    var = jnp.mean(jnp.square(xf - mu), axis=-1, keepdims=True)
    return ((xf - mu) * lax.rsqrt(var + eps) * g.astype(jnp.float32) + b.astype(jnp.float32)).astype(x.dtype)


def gated_rms_norm(y, z, w, eps=1e-5):
    yf = (y * jax.nn.silu(z)).astype(jnp.float32)
    return (yf * lax.rsqrt(jnp.mean(jnp.square(yf), axis=-1, keepdims=True) + eps) * w.astype(jnp.float32)).astype(y.dtype)


def rope_tables(positions, dim):
    inv_freq = 1.0 / (ROPE_THETA ** (jnp.arange(0, dim, 2, dtype=jnp.float32) / dim))
    ang = positions.astype(jnp.float32)[..., None] * inv_freq
    return jnp.cos(ang), jnp.sin(ang)


def apply_rope(x, cos, sin):
    half = x.shape[-1] // 2
    x1, x2 = x[..., :half], x[..., half:]
    cos = cos[:, :, None, :].astype(x.dtype)
    sin = sin[:, :, None, :].astype(x.dtype)
    return jnp.concatenate([x1 * cos - x2 * sin, x2 * cos + x1 * sin], axis=-1)


def causal_depthwise_conv(x, w, b):
    k_w = w.shape[0]
    out = lax.conv_general_dilated(
        x, w[:, None, :].astype(x.dtype), window_strides=(1,), padding=[(k_w - 1, 0)],
        dimension_numbers=('NWC', 'WIO', 'NWC'), feature_group_count=x.shape[-1])
    return out + b.astype(x.dtype)


def ssd_chunked(xs, dt, a, b_mat, c_mat):
    bsz, s_len, n_h, p_dim = xs.shape
    n_g, n_st = b_mat.shape[2], b_mat.shape[3]
    q_len = SSD_CHUNK
    n_c = s_len // q_len
    hpg = n_h // n_g
    dtype = xs.dtype
    x_c = xs.reshape(bsz, n_c, q_len, n_g, hpg, p_dim)
    dt_c = dt.reshape(bsz, n_c, q_len, n_g, hpg)
    xdt = x_c * dt_c[..., None].astype(dtype)
    b_c = b_mat.reshape(bsz, n_c, q_len, n_g, n_st)
    c_c = c_mat.reshape(bsz, n_c, q_len, n_g, n_st)
    log_a = dt_c.astype(jnp.float32) * a.astype(jnp.float32).reshape(n_g, hpg)
    cs = jnp.cumsum(log_a, axis=2)
    causal = jnp.tril(jnp.ones((q_len, q_len), dtype=bool))[:, :, None, None]
    seg = cs[:, :, :, None] - cs[:, :, None, :]
    decay = jnp.exp(jnp.where(causal, seg, -jnp.inf)).astype(dtype)
    cb = jnp.einsum('bclgn,bcsgn->bclsg', c_c, b_c)
    y_diag = jnp.einsum('bclsg,bclsgh,bcsghp->bclghp', cb, decay, xdt)
    decay_to_end = jnp.exp(cs[:, :, -1:] - cs).astype(dtype)
    states = jnp.einsum('bcsgn,bcsgh,bcsghp->bcghpn', b_c, decay_to_end, xdt)
    chunk_decay = jnp.exp(cs[:, :, -1]).astype(dtype)

    def carry_state(h, inp):
        st, dec = inp
        return dec[..., None, None] * h + st, h

    h0 = jnp.zeros((bsz, n_g, hpg, p_dim, n_st), dtype)
    _, h_in = lax.scan(carry_state, h0, (jnp.moveaxis(states, 1, 0), jnp.moveaxis(chunk_decay, 1, 0)))
    h_in = jnp.moveaxis(h_in, 0, 1)
    y_off = jnp.einsum('bclgn,bcghpn,bclgh->bclghp', c_c, h_in, jnp.exp(cs).astype(dtype))
    return (y_diag + y_off).reshape(bsz, s_len, n_h, p_dim)


def dsa_attention(q, k, v, q_idx, k_idx, w_idx):
    bsz, s_len, n_h, d_h = q.shape
    topk = min(INDEX_TOPK, s_len // 4)
    n_blk = s_len // Q_BLOCK
    key_pos = jnp.arange(s_len, dtype=jnp.int32)
    gather_rows = jax.vmap(lambda table, idx: table[idx])

    def block(i):
        start = i * Q_BLOCK
        qb = lax.dynamic_slice_in_dim(q, start, Q_BLOCK, axis=1)
        qib = lax.dynamic_slice_in_dim(q_idx, start, Q_BLOCK, axis=1)
        wib = lax.dynamic_slice_in_dim(w_idx, start, Q_BLOCK, axis=1)
        t_pos = start + jnp.arange(Q_BLOCK, dtype=jnp.int32)
        causal = key_pos[None, :] <= t_pos[:, None]
        rel = jax.nn.relu(jnp.einsum('bqhd,bsd->bqhs', qib, k_idx))
        iscore = jnp.einsum('bqhs,bqh->bqs', rel, wib).astype(jnp.float32)
        iscore = jnp.where(causal[None], iscore, -jnp.inf)
        _, sel = lax.top_k(iscore, topk)
        valid = sel <= t_pos[None, :, None]
        k_sel = gather_rows(k, sel)
        v_sel = gather_rows(v, sel)
        logits = jnp.einsum('bqhd,bqkhd->bqhk', qb, k_sel).astype(jnp.float32) * (d_h ** -0.5)
        logits = jnp.where(valid[:, :, None, :], logits, -jnp.inf)
        probs = jax.nn.softmax(logits, axis=-1).astype(v.dtype)
        return jnp.einsum('bqhk,bqkhd->bqhd', probs, v_sel)

    out = lax.map(block, jnp.arange(n_blk, dtype=jnp.int32))
    return jnp.moveaxis(out, 0, 1).reshape(bsz, s_len, n_h * d_h)


def hybrid_mixer(u, cos_a, sin_a, cos_i, sin_i, w_in, conv_w, conv_b, dt_bias, a_log, d_skip,
                 ssd_norm_w, idx_k_ln_g, idx_k_ln_b, w_out):
    bsz, s_len, _ = u.shape
    proj = jnp.einsum('bsd,de->bse', u, w_in)
    z, xbc, dt_raw, q, k, v, q_idx, k_idx, w_idx = jnp.split(proj, SPLIT_POINTS, axis=-1)
    xbc = jax.nn.silu(causal_depthwise_conv(xbc, conv_w, conv_b))
    xs, b_mat, c_mat = jnp.split(xbc, [D_SSM, D_SSM + SSM_GROUPS * SSM_STATE], axis=-1)
    xs = xs.reshape(bsz, s_len, SSM_HEADS, SSM_HEAD_DIM)
    dt = jax.nn.softplus(dt_raw + dt_bias)
    a = -jnp.exp(a_log)
    y = ssd_chunked(xs, dt, a,
                    b_mat.reshape(bsz, s_len, SSM_GROUPS, SSM_STATE),
                    c_mat.reshape(bsz, s_len, SSM_GROUPS, SSM_STATE))
    y = y + d_skip[:, None] * xs
    y_ssm = gated_rms_norm(y.reshape(bsz, s_len, D_SSM), z, ssd_norm_w)
    q = apply_rope(q.reshape(bsz, s_len, ATTN_HEADS, ATTN_HEAD_DIM), cos_a, sin_a)
    k = apply_rope(k.reshape(bsz, s_len, ATTN_HEADS, ATTN_HEAD_DIM), cos_a, sin_a)
    v = v.reshape(bsz, s_len, ATTN_HEADS, ATTN_HEAD_DIM)
    q_idx = apply_rope(q_idx.reshape(bsz, s_len, IDX_HEADS, IDX_DIM), cos_i, sin_i)
    k_idx = apply_rope(layer_norm(k_idx, idx_k_ln_g, idx_k_ln_b)[:, :, None, :], cos_i, sin_i)[:, :, 0]
    w_idx = w_idx * (IDX_HEADS ** -0.5 * IDX_DIM ** -0.5)
    y_att = dsa_attention(q, k, v, q_idx, k_idx, w_idx)
    return jnp.einsum('bse,ed->bsd', jnp.concatenate([y_ssm, y_att], axis=-1), w_out)


def moe_ffn(h, w_router, router_bias, w_gate_e, w_up_e, w_down_e, w_gate_s, w_up_s, w_down_s):
    bsz, s_len, d = h.shape
    t = h.reshape(-1, d)
    n_tok = t.shape[0]
    scores = jax.nn.sigmoid(jnp.einsum('td,de->te', t, w_router).astype(jnp.float32))
    biased = scores + router_bias.astype(jnp.float32)
    grouped = biased.reshape(n_tok, N_EXPERT_GROUPS, EXPERTS_PER_GROUP)
    group_score = jnp.sum(lax.top_k(grouped, 2)[0], axis=-1)
    _, top_groups = lax.top_k(group_score, TOPK_GROUPS)
    group_keep = jnp.sum(jax.nn.one_hot(top_groups, N_EXPERT_GROUPS, dtype=jnp.float32), axis=1)
    expert_keep = jnp.repeat(group_keep, EXPERTS_PER_GROUP, axis=-1) > 0
    _, top_e = lax.top_k(jnp.where(expert_keep, biased, -jnp.inf), TOP_K)
    w = jnp.take_along_axis(scores, top_e, axis=-1)
    w = w / jnp.sum(w, axis=-1, keepdims=True) * ROUTED_SCALE
    gates = jnp.sum(jax.nn.one_hot(top_e, N_EXPERTS, dtype=jnp.float32) * w[..., None], axis=1).astype(h.dtype)
    routed = jnp.zeros_like(t)
    for g in range(N_EXPERT_GROUPS):
        sl = slice(g * EXPERTS_PER_GROUP, (g + 1) * EXPERTS_PER_GROUP)
        hid = jax.nn.silu(jnp.einsum('td,edf->tef', t, w_gate_e[sl])) * jnp.einsum('td,edf->tef', t, w_up_e[sl])
        routed = routed + jnp.einsum('tef,efd->td', hid * gates[:, sl, None], w_down_e[sl])
    shared = jnp.einsum('tf,fd->td', jax.nn.silu(t @ w_gate_s) * (t @ w_up_s), w_down_s)
    return (routed + shared).reshape(bsz, s_len, d)


def setup_inputs(seed: int = 0) -> dict:
    key = jax.random.key(seed)
    ks = jax.random.split(key, 32)
    f32 = jnp.float32

    def nrm(k, shape, scale):
        return jax.random.normal(k, shape, f32) * scale

    n_l = DEPTH
    x = nrm(ks[0], (BATCH, SEQ, D_MODEL), 1.0)
    c = nrm(ks[1], (BATCH, D_MODEL), 1.0)
    offset = jax.random.randint(ks[2], (BATCH, 1), 0, 1024, dtype=jnp.int32)
    positions = jnp.arange(SEQ, dtype=jnp.int32)[None, :] + offset
    w_ada = nrm(ks[3], (n_l, D_MODEL, 6 * D_MODEL), D_MODEL ** -0.5)
    b_ada = nrm(ks[4], (n_l, 6 * D_MODEL), 0.02)
    w_in = nrm(ks[5], (n_l, D_MODEL, D_IN_PROJ), D_MODEL ** -0.5)
    conv_w = nrm(ks[6], (n_l, CONV_WIDTH, CONV_CH), CONV_WIDTH ** -0.5)
    conv_b = nrm(ks[7], (n_l, CONV_CH), 0.02)
    dt0 = jnp.exp(jax.random.uniform(ks[8], (n_l, SSM_HEADS), f32, math.log(1e-3), math.log(1e-1)))
    dt_bias = dt0 + jnp.log(-jnp.expm1(-dt0))
    a_log = jnp.log(jax.random.uniform(ks[9], (n_l, SSM_HEADS), f32, 1.0, 16.0))
    d_skip = 1.0 + nrm(ks[10], (n_l, SSM_HEADS), 0.1)
    ssd_norm_w = 1.0 + nrm(ks[11], (n_l, D_SSM), 0.1)
    idx_k_ln_g = 1.0 + nrm(ks[12], (n_l, IDX_DIM), 0.1)
    idx_k_ln_b = nrm(ks[13], (n_l, IDX_DIM), 0.02)
    w_out = nrm(ks[14], (n_l, D_MIX, D_MODEL), BETA * D_MIX ** -0.5)
    ln1_g = 1.0 + nrm(ks[15], (n_l, D_MODEL), 0.1)
    ln1_b = nrm(ks[16], (n_l, D_MODEL), 0.02)
    w_router = nrm(ks[17], (n_l, D_MODEL, N_EXPERTS), D_MODEL ** -0.5)
    router_bias = nrm(ks[18], (n_l, N_EXPERTS), 0.01)
    w_gate_e = nrm(ks[19], (n_l, N_EXPERTS, D_MODEL, D_EXPERT), D_MODEL ** -0.5)
    w_up_e = nrm(ks[20], (n_l, N_EXPERTS, D_MODEL, D_EXPERT), D_MODEL ** -0.5)
    w_down_e = nrm(ks[21], (n_l, N_EXPERTS, D_EXPERT, D_MODEL), BETA * D_EXPERT ** -0.5)
    w_gate_s = nrm(ks[22], (n_l, D_MODEL, D_SHARED), D_MODEL ** -0.5)
    w_up_s = nrm(ks[23], (n_l, D_MODEL, D_SHARED), D_MODEL ** -0.5)
    w_down_s = nrm(ks[24], (n_l, D_SHARED, D_MODEL), BETA * D_SHARED ** -0.5)
    ln2_g = 1.0 + nrm(ks[25], (n_l, D_MODEL), 0.1)
    ln2_b = nrm(ks[26], (n_l, D_MODEL), 0.02)
    return {'x': x, 'c': c, 'positions': positions, 'w_ada': w_ada, 'b_ada': b_ada, 'w_in': w_in,
            'conv_w': conv_w, 'conv_b': conv_b, 'dt_bias': dt_bias, 'a_log': a_log, 'd_skip': d_skip,
            'ssd_norm_w': ssd_norm_w, 'idx_k_ln_g': idx_k_ln_g, 'idx_k_ln_b': idx_k_ln_b, 'w_out': w_out,
            'ln1_g': ln1_g, 'ln1_b': ln1_b, 'w_router': w_router, 'router_bias': router_bias,
            'w_gate_e': w_gate_e, 'w_up_e': w_up_e, 'w_down_e': w_down_e, 'w_gate_s': w_gate_s,
            'w_up_s': w_up_s, 'w_down_s': w_down_s, 'ln2_g': ln2_g, 'ln2_b': ln2_b}


def reference(x, c, positions, w_ada, b_ada, w_in, conv_w, conv_b, dt_bias, a_log, d_skip,
              ssd_norm_w, idx_k_ln_g, idx_k_ln_b, w_out, ln1_g, ln1_b, w_router, router_bias,
              w_gate_e, w_up_e, w_down_e, w_gate_s, w_up_s, w_down_s, ln2_g, ln2_b):
    cos_a, sin_a = rope_tables(positions, ATTN_HEAD_DIM)
    cos_i, sin_i = rope_tables(positions, IDX_DIM)
    c_act = jax.nn.silu(c)
    for l in range(DEPTH):
        mod = jnp.einsum('bd,de->be', c_act, w_ada[l]) + b_ada[l]
        shift1, scale1, gate1, shift2, scale2, gate2 = [m[:, None, :] for m in jnp.split(mod, 6, axis=-1)]
        u = x * (1 + scale1) + shift1
        mix = hybrid_mixer(u, cos_a, sin_a, cos_i, sin_i, w_in[l], conv_w[l], conv_b[l], dt_bias[l],
                           a_log[l], d_skip[l], ssd_norm_w[l], idx_k_ln_g[l], idx_k_ln_b[l], w_out[l])
        x = layer_norm(ALPHA * x + gate1 * mix, ln1_g[l], ln1_b[l])
        u = x * (1 + scale2) + shift2
        ffn = moe_ffn(u, w_router[l], router_bias[l], w_gate_e[l], w_up_e[l], w_down_e[l],
                      w_gate_s[l], w_up_s[l], w_down_s[l])
        x = layer_norm(ALPHA * x + gate2 * ffn, ln2_g[l], ln2_b[l])
    return x
```

```cpp
#include <hip/hip_runtime.h>
#include <cstdio>
#include <cstdint>

#define GAS __attribute__((address_space(1)))
#define LAS __attribute__((address_space(3)))
typedef unsigned short bf16;
typedef short bf16x8 __attribute__((ext_vector_type(8)));
typedef short s16x4 __attribute__((ext_vector_type(4)));
typedef float f32x2 __attribute__((ext_vector_type(2)));
typedef float f32x4 __attribute__((ext_vector_type(4)));
typedef float f32x16 __attribute__((ext_vector_type(16)));
typedef unsigned u32x2 __attribute__((ext_vector_type(2)));
typedef unsigned u32x4 __attribute__((ext_vector_type(4)));
typedef GAS unsigned gu32;
#define RLX_AGENT __ATOMIC_RELAXED, __HIP_MEMORY_SCOPE_AGENT
#define LDS_WAIT() asm volatile("s_waitcnt lgkmcnt(0)" ::: "memory")
#define VM_WAIT() asm volatile("s_waitcnt vmcnt(0)" ::: "memory")

constexpr int DM = 2048, NBATCH = 2, SEQ = 4096, NTOK = NBATCH * SEQ;
constexpr int D_SSM = 1024, SSM_H = 16, SSM_P = 64, SSM_N = 128, CONV_CH = 1536, CHUNK = 128, NCHUNK = SEQ / CHUNK;
constexpr int ATT_H = 8, ATT_D = 128, IDX_H = 16, IDX_D = 64, TOPK_SEL = 256;
constexpr int NE = 64, DE = 512, NEX = NE + 1;
constexpr int NPROJ = 6752, NPROJ_PAD = 6912, NPROJ_TILES = 27;
constexpr float ALPHA_DN = 1.189207115002721f;
constexpr float LN_EPS = 1e-5f;
constexpr int SEG_Z = 0, SEG_XBC = 1024, SEG_DT = 2560, SEG_Q = 2576, SEG_K = 3600, SEG_V = 4624, SEG_QI = 5648, SEG_KI = 6672, SEG_WI = 6736;

constexpr size_t MiB = 1u << 20;
constexpr size_t WS_CTL = 0, CTL_ZERO_BYTES = 1 * MiB;
constexpr size_t WS_MODP = 1 * MiB;
constexpr size_t WS_MODF = 3 * MiB;
constexpr size_t WS_COSA = 4 * MiB, WS_SINA = 6 * MiB;
constexpr size_t WS_COSI = 8 * MiB, WS_SINI = 9 * MiB;
constexpr size_t WS_WR = 10 * MiB;
constexpr size_t WS_KIDX = 11 * MiB;
constexpr size_t WS_WIDX = 12 * MiB;
constexpr size_t WS_DT = 12 * MiB + 512 * 1024;
constexpr size_t WS_CS = 13 * MiB;
constexpr size_t WS_INV = 14 * MiB;
constexpr size_t WS_LTOK = 15 * MiB;
constexpr size_t WS_LW = 17 * MiB;
constexpr size_t WS_MASK = 19 * MiB;
constexpr size_t WS_U2 = 25 * MiB;
constexpr size_t WS_WGU = 57 * MiB;
constexpr size_t WS_WDN = 317 * MiB;
constexpr size_t WS_T = 447 * MiB;
constexpr size_t WS_HID = WS_T;
constexpr size_t WS_OUTS = WS_T + 88 * MiB;
constexpr size_t WS_WIN = WS_T;
constexpr size_t WS_WOUT = WS_T + 27 * MiB;
constexpr size_t WS_U1 = WS_T + 35 * MiB;
constexpr size_t WS_Z = WS_T + 67 * MiB;
constexpr size_t WS_XBC = WS_T + 83 * MiB;
constexpr size_t WS_Q = WS_T + 107 * MiB, WS_K = WS_T + 123 * MiB, WS_V = WS_T + 139 * MiB;
constexpr size_t WS_QIDX = WS_T + 155 * MiB;
constexpr size_t WS_SCORES = WS_T + 171 * MiB;
constexpr size_t WS_STATES = WS_T + 299 * MiB;
constexpr size_t WS_HIN = WS_T + 331 * MiB;
constexpr size_t WS_YDIAG = WS_T + 347 * MiB;
constexpr size_t WS_YCAT = WS_T + 379 * MiB;
constexpr size_t WS_XBCACT = WS_T + 411 * MiB;
constexpr size_t WS_END = WS_T + 440 * MiB;
static_assert(WS_XBCACT + 24 * MiB <= WS_END && WS_OUTS + 352 * MiB <= WS_END, "ws map");
constexpr int MAXPOS = 90112;
constexpr int CW_TMO = 0, CW_BAR = 4096, CW_ECNT = 8192;

constexpr int LDS_MISC = 155648;
constexpr int LDS_BYTES = 157696;

typedef __bf16 bf16x2_t __attribute__((ext_vector_type(2)));
__device__ __forceinline__ unsigned cvt_pk_bf16(float lo, float hi) { const bf16x2_t v = {(__bf16)lo, (__bf16)hi}; return __builtin_bit_cast(unsigned, v); }
__device__ __forceinline__ float bflo(unsigned w) { return __uint_as_float(w << 16); }
__device__ __forceinline__ float bfhi(unsigned w) { return __uint_as_float(w & 0xffff0000u); }
__device__ __forceinline__ float bf2f(bf16 b) { return __uint_as_float((unsigned)b << 16); }
__device__ __forceinline__ bf16 f2bf(float f) { return __builtin_bit_cast(unsigned short, (__bf16)f); }
__device__ __forceinline__ float silu_f(float x) { return x / (1.f + __expf(-x)); }
__device__ __forceinline__ float sigmoid_f(float x) { return 1.f / (1.f + __expf(-x)); }
__device__ __forceinline__ float wave_sum(float v) {
#pragma unroll
    for (int o = 1; o < 64; o <<= 1) v += __shfl_xor(v, o);
    return v;
}
__device__ __forceinline__ bf16x8 pack8(f32x4 a, f32x4 b) {
    u32x4 w = {cvt_pk_bf16(a[0], a[1]), cvt_pk_bf16(a[2], a[3]), cvt_pk_bf16(b[0], b[1]), cvt_pk_bf16(b[2], b[3])};
    return __builtin_bit_cast(bf16x8, w);
}
__device__ __forceinline__ void unpack8(bf16x8 v, float (&o)[8]) {
    u32x4 w = __builtin_bit_cast(u32x4, v);
#pragma unroll
    for (int i = 0; i < 4; ++i) { o[2 * i] = bflo(w[i]); o[2 * i + 1] = bfhi(w[i]); }
}
__device__ __forceinline__ int crow(int r, int hi) { return (r & 3) + 8 * (r >> 2) + 4 * hi; }
#define MK_N_LAUNCHES 1
#define PH_MASK 0x7ff
#define XB_TMO      128
#define XB_XCNT(j)  (256  + 64 * (j))
#define XB_XSUB(j)  (1280 + 64 * (j))
#define XB_XGEN(j)  (2304 + 64 * (j))
#define XB_TOP      3328
#define XB_TOPGEN   3392
#define XCD_BAR_WORDS 3456
#define XB_SPIN_CAP (1u << 18)

__device__ __forceinline__ unsigned xb_ld(unsigned* p)              { return __hip_atomic_load(p, __ATOMIC_RELAXED, __HIP_MEMORY_SCOPE_AGENT); }
__device__ __forceinline__ unsigned xb_add(unsigned* p, unsigned v) { return __hip_atomic_fetch_add(p, v, __ATOMIC_RELAXED, __HIP_MEMORY_SCOPE_AGENT); }
__device__ __forceinline__ unsigned xb_xcc_id() { return (unsigned)__builtin_amdgcn_s_getreg((3 << 11) | 20) & 0xFu; }
#define XB_SPIN(cond, bar) do { unsigned _sp = 0; while (cond) { __builtin_amdgcn_s_sleep(1); \
    if ((++_sp & 255u) == 0u) { if (xb_ld(&(bar)[XB_TMO])) break; if (_sp > XB_SPIN_CAP) { atomicAdd(&(bar)[XB_TMO], 1u); break; } } } } while (0)

struct XcdBarrier {
    unsigned* bar; unsigned x;
    volatile LAS unsigned* st;
};

__device__ __forceinline__ XcdBarrier xcd_barrier_post(unsigned* bar, volatile LAS unsigned* st) {
    XcdBarrier b; b.bar = bar; b.x = xb_xcc_id(); b.st = st;
    if (threadIdx.x == 0) (void)xb_add(&bar[XB_XCNT(b.x)], 1u);
    return b;
}
__device__ __forceinline__ void xcd_barrier_complete(unsigned* bar, unsigned x, unsigned& nloc, unsigned& nx) {
    const unsigned G = gridDim.x * gridDim.y * gridDim.z;
    unsigned sum, cnt, mine, sp = 0u;
    for (;;) {
        sum = 0u; cnt = 0u; mine = 0u;
#pragma unroll
        for (unsigned j = 0; j < 16; ++j) { const unsigned c = xb_ld(&bar[XB_XCNT(j)]); sum += c; cnt += (c > 0u) ? 1u : 0u; mine = (j == x) ? c : mine; }
        if (sum == G) break;
        __builtin_amdgcn_s_sleep(1);
        if ((++sp & 255u) == 0u) { if (xb_ld(&bar[XB_TMO])) break; if (sp > XB_SPIN_CAP) { atomicAdd(&bar[XB_TMO], 1u); break; } }
    }
    nloc = mine > 0u ? mine : 1u; nx = cnt > 0u ? cnt : 1u;
}

__device__ __forceinline__ void xcd_barrier(const XcdBarrier& b) {
    asm volatile("s_waitcnt vmcnt(0)" ::: "memory");
    __syncthreads();
    if (threadIdx.x == 0) {
        unsigned* bar = b.bar;
        __builtin_amdgcn_s_waitcnt(0);
        unsigned nloc = b.st[0], nx = b.st[1];
        if (nloc == 0u) { xcd_barrier_complete(bar, b.x, nloc, nx); b.st[0] = nloc; b.st[1] = nx; }
        const unsigned old = xb_add(&bar[XB_XSUB(b.x)], 1u);
        const unsigned gen = old / nloc;
        if (old + 1u == (gen + 1u) * nloc) {
            __builtin_amdgcn_fence(__ATOMIC_RELEASE, "agent");
            asm volatile("s_waitcnt vmcnt(0)" ::: "memory");
            const unsigned og = xb_add(&bar[XB_TOP], 1u);
            const unsigned tg = og / nx;
            if (og + 1u == (tg + 1u) * nx) xb_add(&bar[XB_TOPGEN], 1u);
            else XB_SPIN(xb_ld(&bar[XB_TOPGEN]) == tg, bar);
            __builtin_amdgcn_fence(__ATOMIC_ACQUIRE, "agent");
            xb_add(&bar[XB_XGEN(b.x)], 1u);
            asm volatile("s_waitcnt vmcnt(0)" ::: "memory");
        } else {
            XB_SPIN(xb_ld(&bar[XB_XGEN(b.x)]) == gen, bar);
            __builtin_amdgcn_fence(__ATOMIC_ACQUIRE, "agent");
            asm volatile("s_waitcnt vmcnt(0)" ::: "memory");
        }
    }
    __syncthreads();
}

namespace pg8 {
constexpr int BM = 256, BK = 64, HALF = 128, HTB = HALF * BK * 2  , STAGE_BYTES = 8 * HTB, NXCD = 8, WGM = 8;
__host__ __device__ __forceinline__ int lds_byte(int r, int c) { const int st = (r >> 4) * 2 + (c >> 5), rr = r & 15, cc = c & 31, ob = rr * 64 + cc * 2; return st * 1024 + (ob ^ (((ob >> 9) & 1) << 5)); }
__host__ __device__ __forceinline__ void stage_rc(int b, int& R, int& C) { const int st = b / 1024, sb = b % 1024, swz = sb ^ (((sb >> 9) & 1) << 5); R = (st >> 1) * 16 + swz / 64; C = (st & 1) * 32 + (swz % 64) / 2; }
__host__ __device__ __forceinline__ int perm32(int rho) { const int n = rho >> 4, i = rho & 15; return 8 * (i >> 2) + 4 * n + (i & 3); }

struct Unit { int pm, pn, ax; };
struct Gemm { const bf16* A; const bf16* Bt; int K; };

struct StaticOrder {
    int nM, nN, nwg, G, c;
    __device__ void init(int M, int N, int G_, int c_) { nM = M / BM; nN = N / BM; nwg = nM * nN; G = G_; c = c_; }
    __device__ __forceinline__ bool next(int i, Unit& u) const {
        const long L = (long)i * G + c; if (L >= nwg) return false;
        int wgid = (int)L; { const int q = nwg / NXCD, r = nwg % NXCD, xcd = wgid % NXCD, off = wgid / NXCD; wgid = (xcd < r ? xcd * (q + 1) : r * (q + 1) + (xcd - r) * q) + off; }
        const int nig = WGM * nN, gid = wgid / nig, fm = gid * WGM, gsz = (nM - fm) < WGM ? (nM - fm) : WGM;
        u.pm = fm + ((wgid % nig) % gsz); u.pn = (wgid % nig) / gsz; u.ax = 0; return true;
    }
    __device__ __forceinline__ int row_tok(const Unit&, int) const { return 0; }
};

template <class Epi, class Sched, bool GATHER>
__device__ __forceinline__ void gemm_phase(LAS unsigned char* lds, const Gemm g, const Sched& S, const Epi& E) {
    const int tid = threadIdx.x, wid = __builtin_amdgcn_readfirstlane(tid >> 6), lane = tid & 63, wr = wid >> 2, wc = wid & 3, fr = lane & 15, fq = lane >> 4;
    const int K = g.K, nt = K / BK;
    unsigned voffB[2]; int RA[2]; unsigned CA2[2];
#pragma unroll
    for (int i = 0; i < 2; ++i) { int R, C; stage_rc(tid * 16 + i * 8192, R, C); const int Rb = Epi::PERM ? ((R & ~31) + perm32(R & 31)) : R;
        voffB[i] = (unsigned)(Rb * K + C) * 2u; RA[i] = R; CA2[i] = (unsigned)C * 2u; }
    const size_t kstep = (size_t)(BK * 2);
    const size_t hstep = (size_t)HALF * K * 2;
    const size_t tstep = 2 * hstep;
    const unsigned ldsw = (unsigned)wid * 1024u;
    const int aoff = lds_byte(wr * 64 + fr, fq * 8), boff = lds_byte(wc * 32 + fr, fq * 8);
#define PG8_SA(b, h) (((b) * 2 + (h)) * HTB)
#define PG8_SB(b, h) ((4 + (b) * 2 + (h)) * HTB)
#define PG8_STAGE(bufoff, gbase, voff) do { _Pragma("unroll") for (int _i = 0; _i < 2; ++_i) \
        __builtin_amdgcn_global_load_lds((const unsigned*)((const char*)(gbase) + (voff)[_i]), (LAS unsigned*)(lds + (bufoff) + ldsw + _i * 8192), 16, 0, 0); } while (0)
#define PG8_LDA(dst, b, h) do { _Pragma("unroll") for (int m = 0; m < 4; ++m) _Pragma("unroll") for (int k = 0; k < 2; ++k) dst[m][k] = *(const LAS bf16x8*)(lds + PG8_SA(b, h) + aoff + m * 2048 + k * 1024); } while (0)
#define PG8_LDB(dst, b, h) do { _Pragma("unroll") for (int n = 0; n < 2; ++n) _Pragma("unroll") for (int k = 0; k < 2; ++k) dst[n][k] = *(const LAS bf16x8*)(lds + PG8_SB(b, h) + boff + n * 2048 + k * 1024); } while (0)
#define PG8_MMA(ai, bj, At, Bt) do { __builtin_amdgcn_s_setprio(1); _Pragma("unroll") for (int m = 0; m < 4; ++m) _Pragma("unroll") for (int n = 0; n < 2; ++n) _Pragma("unroll") for (int k = 0; k < 2; ++k) \
        acc[ai][bj][m][n] = __builtin_amdgcn_mfma_f32_16x16x32_bf16(Bt[n][k], At[m][k], acc[ai][bj][m][n], 0, 0, 0); __builtin_amdgcn_s_setprio(0); } while (0)
#define PG8_WAIT_V(n) asm volatile("s_waitcnt vmcnt(" #n ")" ::: "memory")
#define PG8_WAIT_L(n) asm volatile("s_waitcnt lgkmcnt(" #n ")" ::: "memory")
#define PG8_BAR __builtin_amdgcn_s_barrier()
#define PG8_SCHED __builtin_amdgcn_sched_barrier(0)
#define PG8_SET_OA(o, u) do { _Pragma("unroll") for (int _h = 0; _h < 2; ++_h) _Pragma("unroll") for (int _i = 0; _i < 2; ++_i) { \
        if constexpr (GATHER) o[_h][_i] = (unsigned)S.row_tok(u, _h * HALF + RA[_i]) * (unsigned)(K * 2) + CA2[_i]; \
        else o[_h][_i] = (unsigned)(_h * (int)hstep) + (unsigned)(RA[_i] * K * 2) + CA2[_i]; } } while (0)
    Unit cur, nxt; int ui = 0;
    if (!S.next(0, cur)) return;
    f32x4 acc[2][2][4][2];
#pragma unroll
    for (int a = 0; a < 2; ++a)
#pragma unroll
        for (int b = 0; b < 2; ++b)
#pragma unroll
            for (int m = 0; m < 4; ++m)
#pragma unroll
                for (int n = 0; n < 2; ++n) acc[a][b][m][n] = (f32x4){0.f, 0.f, 0.f, 0.f};
    bf16x8 At[4][2], B0[2][2], B1[2][2];
    unsigned oAc[2][2], oAn[2][2];
    PG8_SET_OA(oAc, cur);
    const char* cA = GATHER ? (const char*)g.A : (const char*)g.A + (size_t)cur.pm * tstep; const char* cB = (const char*)g.Bt + (size_t)cur.pn * tstep;
    PG8_STAGE(PG8_SB(0, 0), cB, voffB); PG8_STAGE(PG8_SB(0, 1), cB + hstep, voffB); PG8_STAGE(PG8_SA(0, 0), cA, oAc[0]); PG8_STAGE(PG8_SA(0, 1), cA, oAc[1]);
    if (wr == 1) PG8_BAR;
    PG8_WAIT_V(2); PG8_BAR;
    PG8_STAGE(PG8_SB(1, 0), cB + kstep, voffB); PG8_STAGE(PG8_SA(1, 0), cA + kstep, oAc[0]); PG8_STAGE(PG8_SB(1, 1), cB + hstep + kstep, voffB);
    PG8_WAIT_V(6); PG8_BAR;
    for (;;) {
        const bool has_next = S.next(ui + 1, nxt);
        const char* nA = has_next ? (GATHER ? (const char*)g.A : (const char*)g.A + (size_t)nxt.pm * tstep) : cA; const char* nB = has_next ? (const char*)g.Bt + (size_t)nxt.pn * tstep : cB;
        if (has_next) { PG8_SET_OA(oAn, nxt); }
        else {
#pragma unroll
            for (int _h = 0; _h < 2; ++_h)
#pragma unroll
                for (int _i = 0; _i < 2; ++_i) oAn[_h][_i] = oAc[_h][_i]; }
        for (int t = 0; t < nt; t += 2) {
            const bool last = (t == nt - 2);
            const char* a1 = cA + (size_t)(t + 1) * kstep;
            const char* a2 = last ? nA : cA + (size_t)(t + 2) * kstep; const char* b2 = last ? nB : cB + (size_t)(t + 2) * kstep;
            const char* a3 = a2 + kstep; const char* b3 = b2 + kstep;
            unsigned o2[2][2];
#pragma unroll
            for (int _h = 0; _h < 2; ++_h)
#pragma unroll
                for (int _i = 0; _i < 2; ++_i) o2[_h][_i] = GATHER ? (last ? oAn[_h][_i] : oAc[_h][_i]) : oAc[_h][_i];
            PG8_LDB(B0, 0, 0); PG8_LDB(B1, 0, 1); PG8_SCHED; PG8_LDA(At, 0, 0); PG8_STAGE(PG8_SA(1, 1), a1, oAc[1]);
            PG8_WAIT_V(8); PG8_WAIT_L(0); PG8_BAR; PG8_MMA(0, 0, At, B0); PG8_MMA(0, 1, At, B1); PG8_BAR; PG8_SCHED;
            PG8_LDA(At, 0, 1); PG8_STAGE(PG8_SB(0, 0), b2, voffB); PG8_STAGE(PG8_SB(0, 1), b2 + hstep, voffB); PG8_STAGE(PG8_SA(0, 0), a2, o2[0]);
            PG8_WAIT_V(8); PG8_WAIT_L(0); PG8_BAR; PG8_MMA(1, 0, At, B0); PG8_MMA(1, 1, At, B1); PG8_BAR; PG8_SCHED;
            PG8_LDB(B0, 1, 0); PG8_LDB(B1, 1, 1); PG8_SCHED; PG8_LDA(At, 1, 0); PG8_STAGE(PG8_SA(0, 1), a2, o2[1]);
            PG8_WAIT_V(8); PG8_WAIT_L(0); PG8_BAR; PG8_MMA(0, 0, At, B0); PG8_MMA(0, 1, At, B1); PG8_BAR; PG8_SCHED;
            PG8_LDA(At, 1, 1); PG8_STAGE(PG8_SB(1, 0), b3, voffB); PG8_STAGE(PG8_SB(1, 1), b3 + hstep, voffB); PG8_STAGE(PG8_SA(1, 0), a3, o2[0]);
            PG8_WAIT_V(8); PG8_WAIT_L(0); PG8_BAR; PG8_MMA(1, 0, At, B0); PG8_MMA(1, 1, At, B1); PG8_BAR; PG8_SCHED;
        }
        if (wr == 0) PG8_BAR;
        { int fr_ = fr, fq_ = fq, wr_ = wr, wc_ = wc; asm volatile("" : "+v"(fr_), "+v"(fq_), "+s"(wr_), "+s"(wc_));
          E(acc, cur, wr_, wc_, fr_, fq_); }
        if (!has_next) break;
#pragma unroll
        for (int a = 0; a < 2; ++a)
#pragma unroll
            for (int b = 0; b < 2; ++b)
#pragma unroll
                for (int m = 0; m < 4; ++m)
#pragma unroll
                    for (int n = 0; n < 2; ++n) acc[a][b][m][n] = (f32x4){0.f, 0.f, 0.f, 0.f};
        cur = nxt; cA = nA; cB = nB; ++ui;
#pragma unroll
        for (int _h = 0; _h < 2; ++_h)
#pragma unroll
            for (int _i = 0; _i < 2; ++_i) oAc[_h][_i] = oAn[_h][_i];
        if (wr == 1) PG8_BAR;
    }
    PG8_WAIT_V(0);
    PG8_BAR;
#undef PG8_SA
#undef PG8_SB
#undef PG8_STAGE
#undef PG8_LDA
#undef PG8_LDB
#undef PG8_MMA
#undef PG8_WAIT_V
#undef PG8_WAIT_L
#undef PG8_BAR
#undef PG8_SCHED
#undef PG8_SET_OA
}
}
struct Args { const void* in[27]; float* out; unsigned char* ws; int ph_lo, ph_hi; };
struct Frame {
    const Args* ap;
    __device__ __forceinline__ LAS unsigned char* lds() const { extern __shared__ __attribute__((aligned(16))) unsigned char lds_raw[]; return (LAS unsigned char*)lds_raw; }
    __device__ __forceinline__ unsigned char* ws() const { return ap->ws; }
    __device__ __forceinline__ gu32* ctl() const { return (gu32*)(ap->ws + WS_CTL); }
    __device__ __forceinline__ float* out() const { return ap->out; }
    __device__ __forceinline__ int tid() const { return (int)threadIdx.x; }
    __device__ __forceinline__ int lane() const { return (int)threadIdx.x & 63; }
    __device__ __forceinline__ int wave() const { return __builtin_amdgcn_readfirstlane((int)threadIdx.x >> 6); }
    __device__ __forceinline__ int G() const { return (int)gridDim.x; }
    __device__ __forceinline__ int bid() const { return (int)blockIdx.x; }
    __device__ __forceinline__ const float* f(int i) const { return (const float*)ap->in[i]; }
    __device__ __forceinline__ const int* i32(int i) const { return (const int*)ap->in[i]; }
};
#define WSP(T, off) ((T*)(F.ws() + (off)))

__device__ __forceinline__ int inproj_src_col(int P) {
    const int tile = P >> 8, within = P & 255, bj = within >> 7, w = within & 127;
    if (tile < 4) return SEG_Z + tile * 256 + within;
    if (tile < 10) return SEG_XBC + (tile - 4) * 256 + within;
    if (tile < 14) return SEG_Q + (2 * (tile - 10) + (w >> 6)) * 128 + (w & 63) + 64 * bj;
    if (tile < 18) return SEG_K + (2 * (tile - 14) + (w >> 6)) * 128 + (w & 63) + 64 * bj;
    if (tile < 22) return SEG_V + (tile - 18) * 256 + within;
    if (tile < 26) return SEG_QI + (4 * (tile - 22) + (w >> 5)) * 64 + (w & 31) + 32 * bj;
    if (bj == 0) { if (w < 32) return SEG_KI + w; if (w < 48) return SEG_WI + (w - 32); if (w < 64) return SEG_DT + (w - 48); return -1; }
    if (w < 32) return SEG_KI + 32 + w;
    return -1;
}
__device__ __forceinline__ void tr64(const float* qsrc, bool valid, int ld, bf16* dst0  , int K, LAS float* scr, int lane) {
    f32x4 v[16];
#pragma unroll
    for (int i = 0; i < 16; ++i) v[i] = valid ? *(const f32x4*)(qsrc + (size_t)(4 * i) * ld) : (f32x4){0.f, 0.f, 0.f, 0.f};
#pragma unroll
    for (int i = 0; i < 16; ++i) { LAS float* s = scr + ((lane >> 4) + 4 * i) * 65 + 4 * (lane & 15); s[0] = v[i][0]; s[1] = v[i][1]; s[2] = v[i][2]; s[3] = v[i][3]; }
    LDS_WAIT(); asm volatile("" ::: "memory");
    const int c = lane & 7;
#pragma unroll
    for (int jj = 0; jj < 8; ++jj) { const int n = (lane >> 3) + 8 * jj; const LAS float* s = scr + (8 * c) * 65 + n;
        u32x4 o; o.x = cvt_pk_bf16(s[0], s[65]); o.y = cvt_pk_bf16(s[2 * 65], s[3 * 65]); o.z = cvt_pk_bf16(s[4 * 65], s[5 * 65]); o.w = cvt_pk_bf16(s[6 * 65], s[7 * 65]);
        *(u32x4*)(dst0 + (size_t)n * K + 8 * c) = o; }
    LDS_WAIT(); asm volatile("" ::: "memory");
}
constexpr int I_IN = 32 * 108, I_OUT = 32 * 32, I_GU = NEX * 32 * 16, I_DN = NEX * 8 * 32, I_TR = I_IN + I_OUT + I_GU + I_DN;
__device__ __forceinline__ void tr_item(Frame& F, int it, LAS float* scr) {
    const int lane = F.lane(), kr = lane >> 4, nq = 4 * (lane & 15);
    if (it < I_IN) { const int kb = it / 108, nb = it % 108, k0 = 64 * kb, n0 = 64 * nb; const int sc = inproj_src_col(n0 + nq);
        tr64(F.f(5) + (size_t)(k0 + kr) * NPROJ + (sc < 0 ? 0 : sc), sc >= 0, NPROJ, WSP(bf16, WS_WIN) + (size_t)n0 * DM + k0, DM, scr, lane); return; }
    it -= I_IN;
    if (it < I_OUT) { const int kb = it >> 5, nb = it & 31, k0 = 64 * kb, n0 = 64 * nb;
        tr64(F.f(14) + (size_t)(k0 + kr) * DM + n0 + nq, true, DM, WSP(bf16, WS_WOUT) + (size_t)n0 * DM + k0, DM, scr, lane); return; }
    it -= I_OUT;
    if (it < I_GU) { const int e = it >> 9, r = it & 511, kb = r >> 4, nb = r & 15, k0 = 64 * kb;
        const int p = nb >> 2, bj = (nb >> 1) & 1, w0 = (nb & 1) * 64;
        const float* src = (e < NE) ? ((bj ? F.f(20) : F.f(19)) + (size_t)e * DM * DE) : (bj ? F.f(23) : F.f(22));
        tr64(src + (size_t)(k0 + kr) * DE + 128 * p + w0 + nq, true, DE, WSP(bf16, WS_WGU) + ((size_t)e * 1024 + 64 * nb) * DM + k0, DM, scr, lane); return; }
    it -= I_GU;
    { const int e = it >> 8, r = it & 255, kb = r >> 5, nb = r & 31, k0 = 64 * kb, n0 = 64 * nb;
        const float* src = (e < NE) ? (F.f(21) + (size_t)e * DE * DM) : F.f(24);
        tr64(src + (size_t)(k0 + kr) * DM + n0 + nq, true, DM, WSP(bf16, WS_WDN) + ((size_t)e * DM + n0) * DE + k0, DE, scr, lane); }
}
__device__ __forceinline__ void p0_prologue(Frame& F) {
    const int gw = F.bid() * 8 + F.wave(), NGW = F.G() * 8, gt = F.bid() * 512 + F.tid(), NGT = F.G() * 512;
    {
        LAS float* red = (LAS float*)F.lds();
        float* modp = WSP(float, WS_MODP);
        for (int item = F.bid(); item < 48 * 16; item += F.G()) {
            const int cc = item % 48, ks = item / 48;
            f32x4 a0 = {0.f, 0.f, 0.f, 0.f}, a1 = {0.f, 0.f, 0.f, 0.f};
            const int kbase = ks * 128 + F.wave() * 16;
#pragma unroll 4
            for (int i = 0; i < 16; ++i) { const int k = kbase + i;
                const float c0 = silu_f(F.f(1)[k]), c1 = silu_f(F.f(1)[DM + k]);
                const f32x4 wv = *(const f32x4*)(F.f(3) + (size_t)k * (6 * DM) + cc * 256 + F.lane() * 4);
                a0 += wv * c0; a1 += wv * c1; }
            *(LAS f32x4*)(red + (F.wave() * 2 + 0) * 256 + F.lane() * 4) = a0;
            *(LAS f32x4*)(red + (F.wave() * 2 + 1) * 256 + F.lane() * 4) = a1;
            __syncthreads();
            { const int b = F.tid() >> 8, col = F.tid() & 255; float s = 0.f;
#pragma unroll
              for (int w = 0; w < 8; ++w) s += red[(w * 2 + b) * 256 + col];
              modp[((size_t)ks * 2 + b) * (6 * DM) + cc * 256 + col] = s; }
            __syncthreads();
        }
    }
    {
        float* cosA = WSP(float, WS_COSA); float* sinA = WSP(float, WS_SINA); float* cosI = WSP(float, WS_COSI); float* sinI = WSP(float, WS_SINI);
        for (int i = gt; i < NTOK * 64; i += NGT) { const int tok = i >> 6, j = i & 63;
            const float inv = 1.0f / powf(10000.0f, (float)(2 * j) / 128.0f); const float ang = (float)F.i32(2)[tok] * inv;
            float s, c; sincosf(ang, &s, &c); cosA[i] = c; sinA[i] = s; }
        for (int i = gt; i < NTOK * 32; i += NGT) { const int tok = i >> 5, j = i & 31;
            const float inv = 1.0f / powf(10000.0f, (float)(2 * j) / 64.0f); const float ang = (float)F.i32(2)[tok] * inv;
            float s, c; sincosf(ang, &s, &c); cosI[i] = c; sinI[i] = s; }
    }
    {
        bf16* wr_hi = WSP(bf16, WS_WR); bf16* wr_lo = wr_hi + NE * DM;
        for (int i = gt; i < NE * (DM / 8); i += NGT) { const int e = i & 63, kc = i >> 6;
            float v[8], l[8];
#pragma unroll
            for (int j = 0; j < 8; ++j) { v[j] = F.f(17)[(size_t)(8 * kc + j) * NE + e]; l[j] = v[j] - bf2f(f2bf(v[j])); }
            u32x4 h = {cvt_pk_bf16(v[0], v[1]), cvt_pk_bf16(v[2], v[3]), cvt_pk_bf16(v[4], v[5]), cvt_pk_bf16(v[6], v[7])};
            u32x4 lo = {cvt_pk_bf16(l[0], l[1]), cvt_pk_bf16(l[2], l[3]), cvt_pk_bf16(l[4], l[5]), cvt_pk_bf16(l[6], l[7])};
            *(u32x4*)(wr_hi + (size_t)e * DM + 8 * kc) = h; *(u32x4*)(wr_lo + (size_t)e * DM + 8 * kc) = lo; }
    }
    {
        LAS float* scr = (LAS float*)(F.lds() + F.wave() * 16640);
        for (int it = gw; it < I_TR; it += NGW) tr_item(F, it, scr);
    }
}

__device__ __forceinline__ void p1_modulate(Frame& F) {
    const float* modp = WSP(const float, WS_MODP); float* modf = WSP(float, WS_MODF); bf16* u1 = WSP(bf16, WS_U1);
    LAS float* sh = (LAS float*)F.lds(); LAS float* sc = sh + DM;
    for (int rg = F.bid(); rg < 256; rg += F.G()) {
        const int b = rg >> 7;
        if (F.tid() < 96) { const int v = rg * 96 + F.tid(); const int bb = v / (6 * DM), col = v % (6 * DM); float s = F.f(4)[col];
#pragma unroll
            for (int ks = 0; ks < 16; ++ks) s += modp[((size_t)ks * 2 + bb) * (6 * DM) + col];
            modf[v] = s; }
        { const int col = F.tid() * 4; f32x4 s0 = *(const f32x4*)(F.f(4) + col), s1 = *(const f32x4*)(F.f(4) + DM + col);
#pragma unroll
          for (int ks = 0; ks < 16; ++ks) { const float* p = modp + ((size_t)ks * 2 + b) * (6 * DM); s0 += *(const f32x4*)(p + col); s1 += *(const f32x4*)(p + DM + col); }
          *(LAS f32x4*)(sh + col) = s0; *(LAS f32x4*)(sc + col) = s1; }
        __syncthreads();
#pragma unroll
        for (int rr = 0; rr < 4; ++rr) { const int row = rg * 32 + F.wave() * 4 + rr;
#pragma unroll
            for (int j = 0; j < 8; ++j) { const int col = j * 256 + F.lane() * 4;
                const f32x4 xv = *(const f32x4*)(F.f(0) + (size_t)row * DM + col); const f32x4 s0 = *(const LAS f32x4*)(sh + col), s1 = *(const LAS f32x4*)(sc + col);
                const f32x4 u = xv * (s1 + 1.0f) + s0;
                u32x2 o = {cvt_pk_bf16(u[0], u[1]), cvt_pk_bf16(u[2], u[3])};
                *(u32x2*)(u1 + (size_t)row * DM + col) = o; } }
        __syncthreads();
    }
}
struct EpiInProj {
    static constexpr bool PERM = true;
    unsigned char* ws; const float *dt_bias, *lng, *lnb;
    __device__ __forceinline__ void operator()(const f32x4 (&acc)[2][2][4][2], const pg8::Unit& u, int wr, int wc, int fr, int fq) const {
        const int pn = u.pn; const int row0 = u.pm * 256 + wr * 64 + fr;
        if (pn < 10 || (pn >= 18 && pn < 22)) {
            size_t boff; int ld, col0;
            if (pn < 4) { boff = WS_Z; ld = 1024; col0 = pn * 256; } else if (pn < 10) { boff = WS_XBC; ld = CONV_CH; col0 = (pn - 4) * 256; } else { boff = WS_V; ld = 1024; col0 = (pn - 18) * 256; }
            bf16* base = (bf16*)(ws + boff);
            col0 += wc * 32 + 8 * fq;
#pragma unroll
            for (int ai = 0; ai < 2; ++ai)
#pragma unroll
                for (int m = 0; m < 4; ++m) { bf16* rowp = base + (size_t)(row0 + ai * 128 + m * 16) * ld + col0;
#pragma unroll
                    for (int bj = 0; bj < 2; ++bj) { const f32x4 v0 = acc[ai][bj][m][0], v1 = acc[ai][bj][m][1];
                        u32x4 w = {cvt_pk_bf16(v0[0], v0[1]), cvt_pk_bf16(v0[2], v0[3]), cvt_pk_bf16(v1[0], v1[1]), cvt_pk_bf16(v1[2], v1[3])};
                        *(u32x4*)(rowp + bj * 128) = w; } }
        } else if (pn < 26) {
            const bool att = pn < 18; const bool isq = pn < 14;
            bf16* base = (bf16*)(ws + (att ? (isq ? WS_Q : WS_K) : WS_QIDX)); const float* ct = (const float*)(ws + (att ? WS_COSA : WS_COSI)); const float* sn = (const float*)(ws + (att ? WS_SINA : WS_SINI));
            const int tw = att ? 64 : 32;
            const int head = att ? 2 * (pn - (isq ? 10 : 14)) + (wc >> 1) : 4 * (pn - 22) + wc, jj0 = att ? 32 * (wc & 1) + 8 * fq : 8 * fq;
#pragma unroll
            for (int ai = 0; ai < 2; ++ai)
#pragma unroll
                for (int m = 0; m < 4; ++m) { const int row = row0 + ai * 128 + m * 16;
                    bf16* rowp = base + (size_t)row * 1024 + head * (2 * tw) + jj0;
#pragma unroll
                    for (int n = 0; n < 2; ++n) { const f32x4 c = *(const f32x4*)(ct + (size_t)row * tw + jj0 + 4 * n), sv = *(const f32x4*)(sn + (size_t)row * tw + jj0 + 4 * n);
                        const f32x4 a = acc[ai][0][m][n], bb = acc[ai][1][m][n];
                        const f32x4 o1 = a * c - bb * sv, o2 = bb * c + a * sv;
                        *(u32x2*)(rowp + 4 * n) = (u32x2){cvt_pk_bf16(o1[0], o1[1]), cvt_pk_bf16(o1[2], o1[3])};
                        *(u32x2*)(rowp + tw + 4 * n) = (u32x2){cvt_pk_bf16(o2[0], o2[1]), cvt_pk_bf16(o2[2], o2[3])}; } }
        } else {
            const float* cosI = (const float*)(ws + WS_COSI); const float* sinI = (const float*)(ws + WS_SINI); bf16* kidx = (bf16*)(ws + WS_KIDX); float* widx = (float*)(ws + WS_WIDX); float* dt = (float*)(ws + WS_DT);
            if (wc == 0) {
                const int jj0 = 8 * fq;
#pragma unroll
                for (int am = 0; am < 8; ++am) { const int ai = am >> 2, m = am & 3; const int row = row0 + ai * 128 + m * 16;
                        f32x4 a0 = acc[ai][0][m][0], a1 = acc[ai][0][m][1], b0 = acc[ai][1][m][0], b1 = acc[ai][1][m][1];
                        float s = (a0[0] + a0[1] + a0[2] + a0[3]) + (a1[0] + a1[1] + a1[2] + a1[3]) + (b0[0] + b0[1] + b0[2] + b0[3]) + (b1[0] + b1[1] + b1[2] + b1[3]);
                        s += __shfl_xor(s, 16); s += __shfl_xor(s, 32);
                        const float mu = s * (1.0f / 64.0f);
                        a0 = a0 - mu; a1 = a1 - mu; b0 = b0 - mu; b1 = b1 - mu;
                        float qv = (a0[0] * a0[0] + a0[1] * a0[1] + a0[2] * a0[2] + a0[3] * a0[3]) + (a1[0] * a1[0] + a1[1] * a1[1] + a1[2] * a1[2] + a1[3] * a1[3])
                                 + (b0[0] * b0[0] + b0[1] * b0[1] + b0[2] * b0[2] + b0[3] * b0[3]) + (b1[0] * b1[0] + b1[1] * b1[1] + b1[2] * b1[2] + b1[3] * b1[3]);
                        qv += __shfl_xor(qv, 16); qv += __shfl_xor(qv, 32);
                        const float rstd = 1.0f / sqrtf(qv * (1.0f / 64.0f) + LN_EPS);
                        a0 = a0 * rstd * *(const f32x4*)(lng + jj0) + *(const f32x4*)(lnb + jj0); a1 = a1 * rstd * *(const f32x4*)(lng + jj0 + 4) + *(const f32x4*)(lnb + jj0 + 4);
                        b0 = b0 * rstd * *(const f32x4*)(lng + 32 + jj0) + *(const f32x4*)(lnb + 32 + jj0); b1 = b1 * rstd * *(const f32x4*)(lng + 36 + jj0) + *(const f32x4*)(lnb + 36 + jj0);
                        const f32x4 c0 = *(const f32x4*)(cosI + (size_t)row * 32 + jj0), c1 = *(const f32x4*)(cosI + (size_t)row * 32 + jj0 + 4);
                        const f32x4 s0 = *(const f32x4*)(sinI + (size_t)row * 32 + jj0), s1 = *(const f32x4*)(sinI + (size_t)row * 32 + jj0 + 4);
                        const f32x4 o10 = a0 * c0 - b0 * s0, o11 = a1 * c1 - b1 * s1, o20 = b0 * c0 + a0 * s0, o21 = b1 * c1 + a1 * s1;
                        bf16* rowp = kidx + (size_t)row * 64 + jj0;
                        u32x4 w1 = {cvt_pk_bf16(o10[0], o10[1]), cvt_pk_bf16(o10[2], o10[3]), cvt_pk_bf16(o11[0], o11[1]), cvt_pk_bf16(o11[2], o11[3])};
                        u32x4 w2 = {cvt_pk_bf16(o20[0], o20[1]), cvt_pk_bf16(o20[2], o20[3]), cvt_pk_bf16(o21[0], o21[1]), cvt_pk_bf16(o21[2], o21[3])};
                        *(u32x4*)rowp = w1; *(u32x4*)(rowp + 32) = w2; }
            } else if (wc == 1) {
                const int h0 = 8 * (fq & 1);
                const f32x4 db0 = *(const f32x4*)(dt_bias + h0), db1 = *(const f32x4*)(dt_bias + h0 + 4);
#pragma unroll
                for (int ai = 0; ai < 2; ++ai)
#pragma unroll
                    for (int m = 0; m < 4; ++m) { const int row = row0 + ai * 128 + m * 16;
                        const f32x4 a0 = acc[ai][0][m][0], a1 = acc[ai][0][m][1];
                        if (fq < 2) { *(f32x4*)(widx + (size_t)row * 16 + h0) = a0 * 0.03125f; *(f32x4*)(widx + (size_t)row * 16 + h0 + 4) = a1 * 0.03125f; }
                        else { f32x4 d0 = a0 + db0, d1 = a1 + db1;
#pragma unroll
                            for (int i = 0; i < 4; ++i) { d0[i] = d0[i] > 20.f ? d0[i] : log1pf(__expf(d0[i])); d1[i] = d1[i] > 20.f ? d1[i] : log1pf(__expf(d1[i])); }
                            *(f32x4*)(dt + (size_t)row * 16 + h0) = d0; *(f32x4*)(dt + (size_t)row * 16 + h0 + 4) = d1; } }
            }
        }
    }
};
__device__ __forceinline__ void idx_unit(Frame& F, int b, int qi, int ki) {
    const bf16* kidx = WSP(const bf16, WS_KIDX); const bf16* qidx = WSP(const bf16, WS_QIDX); const float* widx = WSP(const float, WS_WIDX); float* scores = WSP(float, WS_SCORES);
    const int lane = F.lane(), r32 = lane & 31, hi = lane >> 5, wq = F.wave() & 3, wk = F.wave() >> 2;
    const int kt0 = b * SEQ + ki * 128 + wk * 64, qtok = b * SEQ + qi * 128 + wq * 32 + r32;
    bf16x8 A[2][4];
#pragma unroll
    for (int kt = 0; kt < 2; ++kt)
#pragma unroll
        for (int ks = 0; ks < 4; ++ks) A[kt][ks] = *(const bf16x8*)(kidx + (size_t)(kt0 + kt * 32 + r32) * 64 + ks * 16 + hi * 8);
    f32x16 o0 = {}, o1 = {};
    const bf16* qrow = qidx + (size_t)qtok * 1024 + hi * 8;
#pragma unroll 1
    for (int h = 0; h < 16; ++h) { const float w = widx[(size_t)qtok * 16 + h];
        bf16x8 Bq[4];
#pragma unroll
        for (int ks = 0; ks < 4; ++ks) Bq[ks] = *(const bf16x8*)(qrow + h * 64 + ks * 16);
        f32x16 a0 = {}, a1 = {};
#pragma unroll
        for (int ks = 0; ks < 4; ++ks) { a0 = __builtin_amdgcn_mfma_f32_32x32x16_bf16(A[0][ks], Bq[ks], a0, 0, 0, 0); a1 = __builtin_amdgcn_mfma_f32_32x32x16_bf16(A[1][ks], Bq[ks], a1, 0, 0, 0); }
#pragma unroll
        for (int r = 0; r < 16; ++r) { o0[r] += w * fmaxf(a0[r], 0.f); o1[r] += w * fmaxf(a1[r], 0.f); } }
    LAS float* st = (LAS float*)(F.lds() + F.wave() * 8320);
    const int qpos = qi * 128 + wq * 32 + r32, kpos0 = ki * 128 + wk * 64;
    const float NEG = -__builtin_inff();
#pragma unroll
    for (int r = 0; r < 16; ++r) { const int kk = crow(r, hi);
        st[r32 * 65 + kk] = (kpos0 + kk > qpos) ? NEG : o0[r];
        st[r32 * 65 + 32 + kk] = (kpos0 + 32 + kk > qpos) ? NEG : o1[r]; }
    LDS_WAIT(); asm volatile("" ::: "memory");
    float* dst = scores + (size_t)(b * SEQ + qi * 128 + wq * 32) * SEQ + kpos0 + lane;
#pragma unroll 4
    for (int q = 0; q < 32; ++q) { *dst = st[q * 65 + lane]; dst += SEQ; }
    LDS_WAIT(); asm volatile("" ::: "memory");
}

constexpr int SA_P = 136;
constexpr int SA_BN = 0, SA_CN = 34816, SA_BT = 69632, SA_CB = 104448, SA_SM = 139264;
__device__ __forceinline__ void conv8(const bf16* xraw_row  , int tpos, const float* cw, const float* cb, float (&o)[8]) {
    const f32x4 b0 = *(const f32x4*)cb, b1 = *(const f32x4*)(cb + 4);
#pragma unroll
    for (int j = 0; j < 4; ++j) { o[j] = b0[j]; o[4 + j] = b1[j]; }
#pragma unroll
    for (int k = 0; k < 4; ++k) { const int dt_ = k - 3;
        if (tpos + dt_ >= 0) { const bf16x8 xv = *(const bf16x8*)(xraw_row + (long)dt_ * CONV_CH); float xf[8]; unpack8(xv, xf);
            const f32x4 w0 = *(const f32x4*)(cw + k * CONV_CH), w1 = *(const f32x4*)(cw + k * CONV_CH + 4);
#pragma unroll
            for (int j = 0; j < 4; ++j) { o[j] += w0[j] * xf[j]; o[4 + j] += w1[j] * xf[4 + j]; } } }
#pragma unroll
    for (int j = 0; j < 8; ++j) o[j] = silu_f(o[j]);
}
__device__ __forceinline__ void ssd_a_unit(Frame& F, int b, int c, int g, int hf) {
    const bf16* xbc = WSP(const bf16, WS_XBC); bf16* xact = WSP(bf16, WS_XBCACT); const float* dtg = WSP(const float, WS_DT); float* csg = WSP(float, WS_CS);
    float* ydiag = WSP(float, WS_YDIAG); float* states = WSP(float, WS_STATES);
    LAS bf16* Bn = (LAS bf16*)(F.lds() + SA_BN); LAS bf16* Cn = (LAS bf16*)(F.lds() + SA_CN); LAS bf16* BT = (LAS bf16*)(F.lds() + SA_BT); LAS bf16* CB = (LAS bf16*)(F.lds() + SA_CB);
    const int lane = F.lane(), r32 = lane & 31, hi = lane >> 5, w = F.wave();
    const int tok0 = b * SEQ + c * CHUNK;
#pragma unroll 2
    for (int i = 0; i < 8; ++i) { const int id = F.tid() + 512 * i, mi = id >> 11, rem = id & 2047, s = rem >> 4, ch = rem & 15;
        const int chan = 1024 + mi * 256 + g * 128 + ch * 8; float o[8];
        conv8(xbc + (size_t)(tok0 + s) * CONV_CH + chan, c * CHUNK + s, F.f(6) + chan, F.f(7) + chan, o);
        u32x4 pk = {cvt_pk_bf16(o[0], o[1]), cvt_pk_bf16(o[2], o[3]), cvt_pk_bf16(o[4], o[5]), cvt_pk_bf16(o[6], o[7])};
        if (mi == 0) { *(LAS u32x4*)(Bn + s * SA_P + ch * 8) = pk;
#pragma unroll
            for (int j = 0; j < 8; ++j) BT[(ch * 8 + j) * SA_P + s] = (bf16)((pk[j >> 1] >> (16 * (j & 1))) & 0xffffu); }
        else { *(LAS u32x4*)(Cn + s * SA_P + ch * 8) = pk; if (hf == 0) *(u32x4*)(xact + (size_t)(tok0 + s) * CONV_CH + chan) = pk; } }
    __syncthreads();
    { const int lt = w >> 1;
#pragma unroll
      for (int sq = 0; sq < 2; ++sq) { const int st = 2 * (w & 1) + sq; f32x16 a = {};
#pragma unroll
          for (int ks = 0; ks < 8; ++ks) { const bf16x8 av = *(const LAS bf16x8*)(Cn + (32 * lt + r32) * SA_P + 16 * ks + 8 * hi), bv = *(const LAS bf16x8*)(Bn + (32 * st + r32) * SA_P + 16 * ks + 8 * hi);
              a = __builtin_amdgcn_mfma_f32_32x32x16_bf16(av, bv, a, 0, 0, 0); }
#pragma unroll
          for (int r = 0; r < 16; ++r) CB[(32 * lt + crow(r, hi)) * SA_P + 32 * st + r32] = f2bf(a[r]); } }
    __syncthreads();
    const int j = w >> 1, sub = w & 1, h = 8 * g + 4 * hf + j;
    LAS bf16* XT = (LAS bf16*)(F.lds() + j * 17408);
    LAS float* cs_l = (LAS float*)(F.lds() + SA_SM) + j * 384; LAS float* wdec = cs_l + 128;
    {
        const float ah = -__expf(F.f(9)[h]);
        const float d0 = dtg[(size_t)(tok0 + lane) * 16 + h], d1 = dtg[(size_t)(tok0 + 64 + lane) * 16 + h];
        float c0 = d0 * ah, c1 = d1 * ah;
#pragma unroll
        for (int o = 1; o < 64; o <<= 1) { const float t0 = __shfl_up(c0, o), t1 = __shfl_up(c1, o); if (lane >= o) { c0 += t0; c1 += t1; } }
        const float tot0 = __shfl(c0, 63); c1 += tot0; const float cend = __shfl(c1, 63);
        if (sub == 0) { cs_l[lane] = c0; cs_l[64 + lane] = c1; wdec[lane] = __expf(cend - c0); wdec[64 + lane] = __expf(cend - c1);
            csg[(size_t)(tok0 + lane) * 16 + h] = c0; csg[(size_t)(tok0 + 64 + lane) * 16 + h] = c1; }
#pragma unroll 2
        for (int i = 0; i < 8; ++i) { const int id = lane + 64 * i, s = 64 * sub + (id >> 3), ch = id & 7, chan = h * 64 + ch * 8; float o[8];
            conv8(xbc + (size_t)(tok0 + s) * CONV_CH + chan, c * CHUNK + s, F.f(6) + chan, F.f(7) + chan, o);
            u32x4 pk = {cvt_pk_bf16(o[0], o[1]), cvt_pk_bf16(o[2], o[3]), cvt_pk_bf16(o[4], o[5]), cvt_pk_bf16(o[6], o[7])};
            *(u32x4*)(xact + (size_t)(tok0 + s) * CONV_CH + chan) = pk;
            const float dts = dtg[(size_t)(tok0 + s) * 16 + h];
#pragma unroll
            for (int jj = 0; jj < 8; ++jj) XT[(ch * 8 + jj) * SA_P + s] = f2bf(o[jj] * dts); }
    }
    __syncthreads();
#pragma unroll
    for (int lq = 0; lq < 2; ++lq) { const int lt = 2 * sub + lq; const int l = 32 * lt + r32; const float csl = cs_l[l];
        f32x16 a0 = {}, a1 = {};
        for (int ks = 0; ks <= 2 * lt + 1; ++ks) { const int s0 = 16 * ks + 8 * hi;
            float cbf[8]; unpack8(*(const LAS bf16x8*)(CB + l * SA_P + s0), cbf);
            const f32x4 q0 = *(const LAS f32x4*)(cs_l + s0), q1 = *(const LAS f32x4*)(cs_l + s0 + 4);
            float mv[8];
#pragma unroll
            for (int jj = 0; jj < 8; ++jj) { const float cq = jj < 4 ? q0[jj & 3] : q1[jj & 3]; mv[jj] = (s0 + jj <= l) ? cbf[jj] * __expf(csl - cq) : 0.f; }
            const bf16x8 av = pack8((f32x4){mv[0], mv[1], mv[2], mv[3]}, (f32x4){mv[4], mv[5], mv[6], mv[7]});
            const bf16x8 b0 = *(const LAS bf16x8*)(XT + r32 * SA_P + s0), b1 = *(const LAS bf16x8*)(XT + (32 + r32) * SA_P + s0);
            a0 = __builtin_amdgcn_mfma_f32_32x32x16_bf16(av, b0, a0, 0, 0, 0); a1 = __builtin_amdgcn_mfma_f32_32x32x16_bf16(av, b1, a1, 0, 0, 0); }
#pragma unroll
        for (int r = 0; r < 16; ++r) { float* yp = ydiag + (size_t)(tok0 + 32 * lt + crow(r, hi)) * D_SSM + h * 64 + r32; yp[0] = a0[r]; yp[32] = a1[r]; } }
    { f32x16 a[2][2] = {};
      for (int ks = 0; ks < 8; ++ks) { const int s0 = 16 * ks + 8 * hi;
          const f32x4 q0 = *(const LAS f32x4*)(wdec + s0), q1 = *(const LAS f32x4*)(wdec + s0 + 4);
          bf16x8 av[2];
#pragma unroll
          for (int pt = 0; pt < 2; ++pt) { float xf[8]; unpack8(*(const LAS bf16x8*)(XT + (32 * pt + r32) * SA_P + s0), xf);
              av[pt] = pack8((f32x4){xf[0] * q0[0], xf[1] * q0[1], xf[2] * q0[2], xf[3] * q0[3]}, (f32x4){xf[4] * q1[0], xf[5] * q1[1], xf[6] * q1[2], xf[7] * q1[3]}); }
#pragma unroll
          for (int nq = 0; nq < 2; ++nq) { const bf16x8 bv = *(const LAS bf16x8*)(BT + (32 * (2 * sub + nq) + r32) * SA_P + s0);
#pragma unroll
              for (int pt = 0; pt < 2; ++pt) a[pt][nq] = __builtin_amdgcn_mfma_f32_32x32x16_bf16(av[pt], bv, a[pt][nq], 0, 0, 0); } }
      float* sp = states + ((size_t)((b * NCHUNK + c) * SSM_H + h) * SSM_P) * SSM_N;
#pragma unroll
      for (int pt = 0; pt < 2; ++pt)
#pragma unroll
          for (int nq = 0; nq < 2; ++nq)
#pragma unroll
              for (int r = 0; r < 16; ++r) sp[(size_t)(32 * pt + crow(r, hi)) * SSM_N + 32 * (2 * sub + nq) + r32] = a[pt][nq][r]; }
    __syncthreads();
}
__device__ __forceinline__ void p3_phase(Frame& F) {
    constexpr int N_SSD = NBATCH * NCHUNK * 2 * 2, N_IDX = NBATCH * 528;
    int L = F.bid();
#pragma unroll 1
    for (; L < N_SSD; L += F.G()) { const int hf = L & 1, g = (L >> 1) & 1, c = (L >> 2) & 31, b = L >> 7; ssd_a_unit(F, b, c, g, hf); }
#pragma unroll 1
    for (; L < N_SSD + N_IDX; L += F.G()) { const int p0 = L - N_SSD, b = p0 / 528, p = p0 % 528;
        int qi = (int)((sqrtf(8.f * (float)p + 1.f) - 1.f) * 0.5f);
        while (qi * (qi + 1) / 2 > p) --qi;
        while ((qi + 1) * (qi + 2) / 2 <= p) ++qi;
        idx_unit(F, b, qi, p - qi * (qi + 1) / 2); }
}
__device__ __forceinline__ unsigned fkey(float f) { const unsigned u = __float_as_uint(f); return (u & 0x80000000u) ? ~u : (u | 0x80000000u); }
__device__ __forceinline__ void select_row(Frame& F, int row, LAS unsigned* hist, LAS unsigned* keys) {
    const float* sc = WSP(const float, WS_SCORES) + (size_t)row * SEQ; unsigned long long* mrow = WSP(unsigned long long, WS_MASK) + (size_t)row * 64;
    const int lane = F.lane(), t = row & (SEQ - 1);
    if (t < TOPK_SEL) {
        const int lo = 64 * lane; unsigned long long m;
        if (lo + 63 <= t) m = ~0ull; else if (lo > t) m = 0ull; else m = (1ull << (t - lo + 1)) - 1ull;
        mrow[lane] = m; return;
    }
    const int nI = (t >> 6) + 1;
#pragma unroll 8
    for (int i = 0; i < nI; ++i) { const int e = 64 * i + lane; float v = 0.f; if (e <= t) v = sc[e]; keys[e] = (e <= t) ? fkey(v) : 0u; }
    unsigned prefix = 0u, need = TOPK_SEL, pmask = 0u, cnt_eq = 0u;
#pragma unroll 1
    for (int pass = 0; pass < 4; ++pass) { const int shift = 24 - 8 * pass;
        hist[4 * lane] = 0u; hist[4 * lane + 1] = 0u; hist[4 * lane + 2] = 0u; hist[4 * lane + 3] = 0u;
        LDS_WAIT(); asm volatile("" ::: "memory");
#pragma unroll 4
        for (int i = 0; i < nI; ++i) { const unsigned k = keys[64 * i + lane]; if ((k & pmask) == prefix && k != 0u) __hip_atomic_fetch_add(hist + ((k >> shift) & 255u), 1u, __ATOMIC_RELAXED, __HIP_MEMORY_SCOPE_WORKGROUP); }
        LDS_WAIT(); asm volatile("" ::: "memory");
        const unsigned c0 = hist[4 * lane], c1 = hist[4 * lane + 1], c2 = hist[4 * lane + 2], c3 = hist[4 * lane + 3];
        const unsigned tot = c0 + c1 + c2 + c3;
        unsigned suf = tot;
#pragma unroll
        for (int o = 1; o < 64; o <<= 1) { const unsigned tt = __shfl_down(suf, o); if (lane + o < 64) suf += tt; }
        unsigned above = suf - tot;
        int found = -1; unsigned nneed = 0u, fcnt = 0u;
        if (above < need && need <= above + c3) { found = 3; nneed = need - above; fcnt = c3; }
        above += c3;
        if (found < 0 && above < need && need <= above + c2) { found = 2; nneed = need - above; fcnt = c2; }
        above += c2;
        if (found < 0 && above < need && need <= above + c1) { found = 1; nneed = need - above; fcnt = c1; }
        above += c1;
        if (found < 0 && above < need && need <= above + c0) { found = 0; nneed = need - above; fcnt = c0; }
        const unsigned long long bal = __ballot(found >= 0);
        const int src = (int)__builtin_ctzll(bal | (1ull << 63));
        const unsigned digit = (unsigned)__shfl(4 * lane + found, src);
        need = (unsigned)__shfl((int)nneed, src); cnt_eq = (unsigned)__shfl((int)fcnt, src);
        prefix |= digit << shift; pmask |= 255u << shift;
        LDS_WAIT(); asm volatile("" ::: "memory");
    }
    const bool all_eq = (cnt_eq == need);
    unsigned run = 0u; unsigned long long myword = 0ull;
    const unsigned long long lt_mask = (lane == 0) ? 0ull : (~0ull >> (64 - lane));
#pragma unroll 4
    for (int i = 0; i < nI; ++i) {
        const unsigned k = keys[64 * i + lane]; bool sel = k > prefix;
        if (all_eq) { sel = sel || (k == prefix); }
        else { const unsigned long long em = __ballot(k == prefix); if (k == prefix) sel = (run + (unsigned)__popcll(em & lt_mask)) < need; run += (unsigned)__popcll(em); }
        const unsigned long long wb = __ballot(sel);
        if (lane == i) myword = wb;
    }
    mrow[lane] = myword;
    LDS_WAIT(); asm volatile("" ::: "memory");
}
__device__ __forceinline__ void p4_select(Frame& F) {
    LAS unsigned* keys = (LAS unsigned*)(F.lds() + F.wave() * 16384); LAS unsigned* hist = (LAS unsigned*)(F.lds() + 131072 + F.wave() * 1024);
    const int gw = F.bid() * 8 + F.wave(), NGW = F.G() * 8;
    for (int pr = gw; pr < SEQ / 2; pr += NGW) {
#pragma unroll 1
        for (int b = 0; b < NBATCH; ++b) { select_row(F, b * SEQ + pr, hist, keys); select_row(F, b * SEQ + (SEQ - 1 - pr), hist, keys); }
    }
}
__device__ __forceinline__ void p4_scan(Frame& F) {
    const float* states = WSP(const float, WS_STATES); bf16* hin = WSP(bf16, WS_HIN); const float* csg = WSP(const float, WS_CS);
    const int gt = F.bid() * 512 + F.tid(), NGT = F.G() * 512;
    for (int q = gt; q < NBATCH * SSM_H * SSM_P * (SSM_N / 2); q += NGT) {
        const int n = 2 * (q & 63), p = (q >> 6) & 63, h = (q >> 12) & 15, b = q >> 16;
        float h0 = 0.f, h1 = 0.f;
#pragma unroll 8
        for (int c = 0; c < NCHUNK; ++c) {
            const size_t off = ((size_t)((b * NCHUNK + c) * SSM_H + h) * SSM_P + p) * SSM_N + n;
            *(unsigned*)(hin + off) = cvt_pk_bf16(h0, h1);
            const float dec = __expf(csg[(size_t)(b * SEQ + c * CHUNK + CHUNK - 1) * 16 + h]);
            const f32x2 st = *(const f32x2*)(states + off);
            h0 = dec * h0 + st[0]; h1 = dec * h1 + st[1];
        }
    }
}
namespace att {
constexpr int KVBLK = 64, SHM_K = KVBLK * 128 * 2, SHM_V = SHM_K;
constexpr float SCALE = 0.08838834764831845f, THR = 8.f, C2 = 1.4426950408889634f * SCALE;
#define KSWZ(row, colB) ((row) * 256 + ((colB) ^ (((row) & 7) << 4)))
__device__ __forceinline__ int v_st(int k, int c) { const int kk = (k & ~0xC) | ((k & 4) << 1) | ((k & 8) >> 1); return ((kk >> 3) * 4 + (c >> 5)) * 512 + ((kk & 7) * 32 + (c & 31)) * 2; }
__device__ __forceinline__ int v_rd_base(int lane) { return ((lane & 3) << 3) | (((lane >> 2) & 3) << 6) | (((lane >> 4) & 1) << 5) | (((lane >> 5) & 1) << 8); }
constexpr int v_rd_off(int d0, int ks, int half) { return d0 * 512 + ks * 4096 + half * 2048; }
template <int KB>
__device__ __forceinline__ void qkt(f32x16& p0, f32x16& p1, LAS const char* K_lds, int r32, int hi, const bf16x8* qr) {
    p0 = f32x16{}; p1 = f32x16{};
    LAS const char* kb[4];
#pragma unroll
    for (int dd = 0; dd < 4; ++dd) kb[dd] = K_lds + KB * SHM_K + KSWZ(r32, (dd * 16 + hi * 8) * 2);
#pragma unroll
    for (int d0 = 0; d0 < 8; ++d0) { LAS const char* a = kb[d0 & 3] + (d0 >> 2) * 128;
        const bf16x8 b0 = *(LAS const bf16x8*)a;
        const bf16x8 b1 = *(LAS const bf16x8*)(a + 32 * 256);
        p0 = __builtin_amdgcn_mfma_f32_32x32x16_bf16(b0, qr[d0], p0, 0, 0, 0);
        p1 = __builtin_amdgcn_mfma_f32_32x32x16_bf16(b1, qr[d0], p1, 0, 0, 0); }
}
template <int VB>
__device__ __forceinline__ void pv_tile(f32x16* o, int vb0, bf16x8 pa0, bf16x8 pa1, bf16x8 pa2, bf16x8 pa3) {
#define TRRD(dst, off) asm volatile("ds_read_b64_tr_b16 %0, %1 offset:%2" : "=&v"(dst) : "v"(vb0), "i"(off) : "memory")
#define PV_D0(d0) do { s16x4 l0, l1, l2, l3, h0, h1, h2, h3; constexpr int b_ = VB * SHM_V + v_rd_off(d0, 0, 0); \
        TRRD(l0, b_); TRRD(h0, b_ + 2048); TRRD(l1, b_ + 4096); TRRD(h1, b_ + 6144); TRRD(l2, b_ + 8192); TRRD(h2, b_ + 10240); TRRD(l3, b_ + 12288); TRRD(h3, b_ + 14336); \
        asm volatile("s_waitcnt lgkmcnt(0)" ::: "memory"); __builtin_amdgcn_sched_barrier(0); \
        o[d0] = __builtin_amdgcn_mfma_f32_32x32x16_bf16(pa0, (bf16x8){l0[0], l0[1], l0[2], l0[3], h0[0], h0[1], h0[2], h0[3]}, o[d0], 0, 0, 0);   \
        o[d0] = __builtin_amdgcn_mfma_f32_32x32x16_bf16(pa1, (bf16x8){l1[0], l1[1], l1[2], l1[3], h1[0], h1[1], h1[2], h1[3]}, o[d0], 0, 0, 0);   \
        o[d0] = __builtin_amdgcn_mfma_f32_32x32x16_bf16(pa2, (bf16x8){l2[0], l2[1], l2[2], l2[3], h2[0], h2[1], h2[2], h2[3]}, o[d0], 0, 0, 0);   \
        o[d0] = __builtin_amdgcn_mfma_f32_32x32x16_bf16(pa3, (bf16x8){l3[0], l3[1], l3[2], l3[3], h3[0], h3[1], h3[2], h3[3]}, o[d0], 0, 0, 0); } while (0)
    PV_D0(0); PV_D0(1); PV_D0(2); PV_D0(3);
#undef PV_D0
#undef TRRD
}
__device__ __forceinline__ void softmax_tile(f32x16& p0, f32x16& p1, unsigned long long mw, int hi, float& m_reg, float& l_reg, float& alpha, bf16x8& pa0, bf16x8& pa1, bf16x8& pa2, bf16x8& pa3) {
    float pmax = p0[0];
#pragma unroll
    for (int r = 1; r < 16; ++r) pmax = fmaxf(pmax, p0[r]);
#pragma unroll
    for (int r = 0; r < 16; ++r) pmax = fmaxf(pmax, p1[r]);
    { auto rr = __builtin_amdgcn_permlane32_swap(__float_as_uint(pmax), __float_as_uint(pmax), false, false); pmax = fmaxf(__uint_as_float(rr[0]), __uint_as_float(rr[1])); }
    float mn;
    if (__all((pmax - m_reg) * SCALE <= THR)) { mn = m_reg; alpha = 1.f; }
    else { mn = fmaxf(m_reg, pmax); alpha = __builtin_amdgcn_exp2f((m_reg - mn) * C2); m_reg = mn; }
    const float mnL = -mn * C2;
    const int lo = (int)((unsigned)mw >> (4 * hi)), hh = (int)((unsigned)(mw >> 32) >> (4 * hi));
#pragma unroll
    for (int r = 0; r < 16; ++r) { const int c = (r & 3) + 8 * (r >> 2);
        const float e0 = __builtin_amdgcn_exp2f(fmaf(p0[r], C2, mnL)), e1 = __builtin_amdgcn_exp2f(fmaf(p1[r], C2, mnL));
        p0[r] = __uint_as_float(__float_as_uint(e0) & (unsigned)__builtin_amdgcn_sbfe(lo, c, 1));
        p1[r] = __uint_as_float(__float_as_uint(e1) & (unsigned)__builtin_amdgcn_sbfe(hh, c, 1)); }
    float ps = 0.f;
#pragma unroll
    for (int r = 0; r < 16; ++r) ps += p0[r];
#pragma unroll
    for (int r = 0; r < 16; ++r) ps += p1[r];
    { auto rr = __builtin_amdgcn_permlane32_swap(__float_as_uint(ps), __float_as_uint(ps), false, false); ps = __uint_as_float(rr[0]) + __uint_as_float(rr[1]); }
    l_reg = l_reg * alpha + ps;
#define PK4(P, B_, OUT) do { unsigned a0 = cvt_pk_bf16(P[B_+0], P[B_+1]), a1 = cvt_pk_bf16(P[B_+2], P[B_+3]); \
        unsigned b0 = cvt_pk_bf16(P[B_+4], P[B_+5]), b1 = cvt_pk_bf16(P[B_+6], P[B_+7]); \
        auto r0 = __builtin_amdgcn_permlane32_swap(a0, b0, false, false); auto r1 = __builtin_amdgcn_permlane32_swap(a1, b1, false, false); \
        u32x4 w = {r0[0], r1[0], r0[1], r1[1]}; OUT = __builtin_bit_cast(bf16x8, w); } while (0)
    PK4(p0, 0, pa0); PK4(p0, 8, pa1); PK4(p1, 0, pa2); PK4(p1, 8, pa3);
#undef PK4
}
}

__device__ __forceinline__ void attn_item(Frame& F, int b, int h, int X) {
    using namespace att;
    const bf16* qg = WSP(const bf16, WS_Q); const bf16* kg = WSP(const bf16, WS_K) + (size_t)(b * SEQ) * 1024 + h * 128; const bf16* vg = WSP(const bf16, WS_V) + (size_t)(b * SEQ) * 1024 + h * 128;
    const unsigned long long* maskg = WSP(const unsigned long long, WS_MASK); bf16* ycat = WSP(bf16, WS_YCAT);
    const int tid = F.tid(), wid = F.wave(), lane = F.lane(), r32 = lane & 31, hi = lane >> 5;
    LAS char* V_lds = (LAS char*)F.lds(); LAS char* K_lds = V_lds + 2 * SHM_V;
    LAS float* wsl = (LAS float*)(F.lds() + 2 * SHM_V + 2 * SHM_K) + wid * 64; LAS float* li_l = wsl; LAS float* al_l = wsl + 32;
    const int tokq = b * SEQ + X * 256 + wid * 32 + r32, NT = 4 * X + 4;
    bf16x8 qr[8];
#pragma unroll
    for (int d0 = 0; d0 < 8; ++d0) qr[d0] = *(const bf16x8*)(qg + (size_t)tokq * 1024 + h * 128 + d0 * 16 + hi * 8);
    const unsigned long long* mrow = maskg + (size_t)tokq * 64;
    const int sr = tid >> 4, sc = (tid & 15) * 8, vst0 = v_st(sr, sc), vst1 = v_st(32 + sr, sc), kws = KSWZ(sr, sc * 2);
    const int vb0 = (int)(unsigned)(uintptr_t)V_lds + v_rd_base(lane);
    float m_reg = -1e30f, l_reg = 0.f; f32x16 o[4] = {};
    bf16x8 st_k0, st_k1, st_v0, st_v1;
#define ALOAD(t) do { const size_t r0_ = (size_t)((t) * KVBLK + sr) * 1024 + sc; st_k0 = *(const bf16x8*)(kg + r0_); st_k1 = *(const bf16x8*)(kg + r0_ + 32 * 1024); \
                      st_v0 = *(const bf16x8*)(vg + r0_); st_v1 = *(const bf16x8*)(vg + r0_ + 32 * 1024); } while (0)
#define AWRITE(bf) do { *(LAS bf16x8*)(K_lds + (bf) * SHM_K + kws) = st_k0; *(LAS bf16x8*)(K_lds + (bf) * SHM_K + kws + 32 * 256) = st_k1; \
                        *(LAS bf16x8*)(V_lds + (bf) * SHM_V + vst0) = st_v0; *(LAS bf16x8*)(V_lds + (bf) * SHM_V + vst1) = st_v1; } while (0)
#define ASTEP(t, KB) do { AWRITE(KB); __syncthreads(); \
        const unsigned long long mw_ = mrow[(t)]; if ((t) + 1 < NT) ALOAD((t) + 1); \
        f32x16 p0, p1; float alpha; bf16x8 pa0, pa1, pa2, pa3; \
        qkt<KB>(p0, p1, K_lds, r32, hi, qr); \
        softmax_tile(p0, p1, mw_, hi, m_reg, l_reg, alpha, pa0, pa1, pa2, pa3); \
        if (__any(alpha < 1.f)) { if (hi == 0) al_l[r32] = alpha; LDS_WAIT(); \
            _Pragma("unroll") for (int d_ = 0; d_ < 4; ++d_) _Pragma("unroll") for (int r = 0; r < 16; ++r) o[d_][r] *= al_l[crow(r, hi)]; } \
        pv_tile<KB>(o, vb0, pa0, pa1, pa2, pa3); } while (0)
    ALOAD(0);
    for (int t = 0; t < NT; t += 2) { ASTEP(t, 0); ASTEP(t + 1, 1); }
#undef ASTEP
#undef AWRITE
#undef ALOAD
    if (hi == 0) li_l[r32] = l_reg; LDS_WAIT();
    float rli[16];
#pragma unroll
    for (int r = 0; r < 16; ++r) rli[r] = __builtin_amdgcn_rcpf(li_l[crow(r, hi)]);
    bf16* Ow = ycat + (size_t)(b * SEQ + X * 256 + wid * 32) * DM + D_SSM + h * 128;
#pragma unroll
    for (int r = 0; r < 16; ++r) { const int orow = crow(r, hi);
#pragma unroll
        for (int d0 = 0; d0 < 4; ++d0) { const float v = o[d0][r] * rli[r]; const float vn = __shfl_xor(v, 1);
            if ((r32 & 1) == 0) *(unsigned*)(Ow + (size_t)orow * DM + d0 * 32 + r32) = cvt_pk_bf16(v, vn); } }
    __syncthreads();
}

__device__ __forceinline__ void ssd_c_unit(Frame& F, int b, int c, int lq) {
    const bf16* xact = WSP(const bf16, WS_XBCACT); const bf16* hin = WSP(const bf16, WS_HIN); const float* csg = WSP(const float, WS_CS); const float* ydiag = WSP(const float, WS_YDIAG);
    const bf16* zg = WSP(const bf16, WS_Z); bf16* ycat = WSP(bf16, WS_YCAT);
    LAS float* gb = (LAS float*)F.lds();
    const int lane = F.lane(), r32 = lane & 31, hi = lane >> 5, w = F.wave(), g = w >> 2;
    const int tok0 = b * SEQ + c * CHUNK + lq * 32;
    bf16x8 Af[8];
#pragma unroll
    for (int ks = 0; ks < 8; ++ks) Af[ks] = *(const bf16x8*)(xact + (size_t)(tok0 + r32) * CONV_CH + 1280 + g * 128 + 16 * ks + 8 * hi);
#pragma unroll
    for (int hh = 0; hh < 2; ++hh) { const int h = 2 * w + hh;
        const bf16* hp = hin + ((size_t)((b * NCHUNK + c) * SSM_H + h) * SSM_P) * SSM_N;
        f32x16 a0 = {}, a1 = {};
#pragma unroll
        for (int ks = 0; ks < 8; ++ks) { const bf16x8 b0 = *(const bf16x8*)(hp + (size_t)r32 * SSM_N + 16 * ks + 8 * hi), b1 = *(const bf16x8*)(hp + (size_t)(32 + r32) * SSM_N + 16 * ks + 8 * hi);
            a0 = __builtin_amdgcn_mfma_f32_32x32x16_bf16(Af[ks], b0, a0, 0, 0, 0); a1 = __builtin_amdgcn_mfma_f32_32x32x16_bf16(Af[ks], b1, a1, 0, 0, 0); }
        const float dsk = F.f(10)[h];
#pragma unroll
        for (int r = 0; r < 16; ++r) { const int l = crow(r, hi); const size_t tok = (size_t)(tok0 + l);
            const float e = __expf(csg[tok * 16 + h]);
#pragma unroll
            for (int pt = 0; pt < 2; ++pt) { const int col = h * 64 + 32 * pt + r32;
                const float y = ydiag[tok * D_SSM + col] + e * (pt ? a1[r] : a0[r]) + dsk * bf2f(xact[tok * CONV_CH + col]);
                gb[l * 1024 + col] = y * silu_f(bf2f(zg[tok * 1024 + col])); } } }
    __syncthreads();
#pragma unroll
    for (int rr = 0; rr < 4; ++rr) { const int l = 4 * w + rr; float ss = 0.f; f32x4 v[4];
#pragma unroll
        for (int j = 0; j < 4; ++j) { v[j] = *(const LAS f32x4*)(gb + l * 1024 + j * 256 + lane * 4); ss += v[j][0] * v[j][0] + v[j][1] * v[j][1] + v[j][2] * v[j][2] + v[j][3] * v[j][3]; }
        const float rs = 1.0f / sqrtf(wave_sum(ss) * (1.0f / 1024.0f) + LN_EPS);
#pragma unroll
        for (int j = 0; j < 4; ++j) { const f32x4 nw = *(const f32x4*)(F.f(11) + j * 256 + lane * 4); const f32x4 y = v[j] * rs * nw;
            u32x2 o = {cvt_pk_bf16(y[0], y[1]), cvt_pk_bf16(y[2], y[3])};
            *(u32x2*)(ycat + (size_t)(tok0 + l) * DM + j * 256 + lane * 4) = o; } }
    __syncthreads();
}
__device__ __forceinline__ void p5_phase(Frame& F) {
    for (int L = F.bid(); L < 256; L += F.G()) { const int lq = L & 3, c = (L >> 2) & 31, b = L >> 7; ssd_c_unit(F, b, c, lq); }
    for (int L = F.bid(); L < 256; L += F.G()) { const int X = 15 - (L >> 4), h = L & 7, b = (L >> 3) & 1; attn_item(F, b, h, X); }
}
struct EpiOutProj {
    static constexpr bool PERM = false;
    const float* x; const float* modf; float* out;
    __device__ __forceinline__ void operator()(const f32x4 (&acc)[2][2][4][2], const pg8::Unit& u, int wr, int wc, int fr, int fq) const {
        const int row0 = u.pm * 256 + wr * 64 + fr, col0 = u.pn * 256 + wc * 32 + 4 * fq; const int b = (u.pm * 256) / SEQ;
        f32x4 gv[2][2];
#pragma unroll
        for (int bj = 0; bj < 2; ++bj)
#pragma unroll
            for (int n = 0; n < 2; ++n) gv[bj][n] = *(const f32x4*)(modf + (size_t)b * (6 * DM) + 2 * DM + col0 + bj * 128 + n * 16);
#pragma unroll
        for (int ai = 0; ai < 2; ++ai)
#pragma unroll
            for (int m = 0; m < 4; ++m) { const size_t off = (size_t)(row0 + ai * 128 + m * 16) * DM + col0;
#pragma unroll
                for (int bj = 0; bj < 2; ++bj)
#pragma unroll
                    for (int n = 0; n < 2; ++n) { const f32x4 xv = *(const f32x4*)(x + off + bj * 128 + n * 16);
                        *(f32x4*)(out + off + bj * 128 + n * 16) = xv * ALPHA_DN + gv[bj][n] * acc[ai][bj][m][n]; } }
    }
};

constexpr int RT_P = 2056;
__device__ __forceinline__ void p7_unit(Frame& F, int un) {
    const float* modf = WSP(const float, WS_MODF); bf16* u2 = WSP(bf16, WS_U2); const bf16* wr_hi = WSP(const bf16, WS_WR); const bf16* wr_lo = wr_hi + NE * DM;
    int* inv = WSP(int, WS_INV); int* ltok = WSP(int, WS_LTOK); float* lw = WSP(float, WS_LW);
    LAS bf16* Ah = (LAS bf16*)F.lds(); LAS bf16* Al = Ah + 16 * RT_P; LAS float* red = (LAS float*)F.lds();
    LAS float* logit = (LAS float*)(F.lds() + 135168);
    const int lane = F.lane(), w = F.wave(), row0 = un * 16, b = row0 / SEQ;
    const float* sh2 = modf + (size_t)b * (6 * DM) + 3 * DM; const float* sc2 = modf + (size_t)b * (6 * DM) + 4 * DM;
#pragma unroll
    for (int rr = 0; rr < 2; ++rr) { const int rl = 2 * w + rr; const size_t row = (size_t)(row0 + rl);
        f32x4 v[8]; float s = 0.f;
#pragma unroll
        for (int j = 0; j < 8; ++j) { v[j] = *(const f32x4*)(F.out() + row * DM + j * 256 + lane * 4); s += (v[j][0] + v[j][1]) + (v[j][2] + v[j][3]); }
        const float mu = wave_sum(s) * (1.0f / DM); float q = 0.f;
#pragma unroll
        for (int j = 0; j < 8; ++j) { v[j] = v[j] - mu; q += (v[j][0] * v[j][0] + v[j][1] * v[j][1]) + (v[j][2] * v[j][2] + v[j][3] * v[j][3]); }
        const float rstd = 1.0f / sqrtf(wave_sum(q) * (1.0f / DM) + LN_EPS);
#pragma unroll
        for (int j = 0; j < 8; ++j) { const int col = j * 256 + lane * 4;
            const f32x4 x1 = v[j] * rstd * *(const f32x4*)(F.f(15) + col) + *(const f32x4*)(F.f(16) + col);
            *(f32x4*)(F.out() + row * DM + col) = x1;
            const f32x4 uu = x1 * (*(const f32x4*)(sc2 + col) + 1.0f) + *(const f32x4*)(sh2 + col);
            const unsigned h0 = cvt_pk_bf16(uu[0], uu[1]), h1 = cvt_pk_bf16(uu[2], uu[3]);
            *(u32x2*)(u2 + row * DM + col) = (u32x2){h0, h1};
            const unsigned l0 = cvt_pk_bf16(uu[0] - bflo(h0), uu[1] - bfhi(h0)), l1 = cvt_pk_bf16(uu[2] - bflo(h1), uu[3] - bfhi(h1));
            *(LAS u32x2*)(Ah + rl * RT_P + col) = (u32x2){h0, h1}; *(LAS u32x2*)(Al + rl * RT_P + col) = (u32x2){l0, l1}; } }
    __syncthreads();
    f32x4 acc[4] = {};
    { const int fr = lane & 15, fq = lane >> 4;
#pragma unroll 2
      for (int ks = 0; ks < 8; ++ks) { const int k0 = w * 256 + ks * 32 + fq * 8;
          const bf16x8 ah = *(const LAS bf16x8*)(Ah + fr * RT_P + k0), al = *(const LAS bf16x8*)(Al + fr * RT_P + k0);
#pragma unroll
          for (int nt = 0; nt < 4; ++nt) { const bf16x8 bh = *(const bf16x8*)(wr_hi + (size_t)(16 * nt + fr) * DM + k0), bl = *(const bf16x8*)(wr_lo + (size_t)(16 * nt + fr) * DM + k0);
              acc[nt] = __builtin_amdgcn_mfma_f32_16x16x32_bf16(ah, bh, acc[nt], 0, 0, 0);
              acc[nt] = __builtin_amdgcn_mfma_f32_16x16x32_bf16(al, bh, acc[nt], 0, 0, 0);
              acc[nt] = __builtin_amdgcn_mfma_f32_16x16x32_bf16(ah, bl, acc[nt], 0, 0, 0); } }
      __syncthreads();
#pragma unroll
      for (int nt = 0; nt < 4; ++nt)
#pragma unroll
          for (int r = 0; r < 4; ++r) red[(w * 16 + fq * 4 + r) * 64 + 16 * nt + fr] = acc[nt][r]; }
    __syncthreads();
#pragma unroll
    for (int i = 0; i < 2; ++i) { const int o = F.tid() + 512 * i; float s = 0.f;
#pragma unroll
        for (int ww = 0; ww < 8; ++ww) s += red[ww * 1024 + o];
        logit[o] = s; }
    __syncthreads();
#pragma unroll 1
    for (int rr = 0; rr < 2; ++rr) { const int rl = 2 * w + rr, tok = row0 + rl;
        const float score = sigmoid_f(logit[rl * 64 + lane]); const float biased = score + F.f(18)[lane];
        float m1 = biased;
#pragma unroll
        for (int o = 1; o < 8; o <<= 1) m1 = fmaxf(m1, __shfl_xor(m1, o));
        int i1 = (biased == m1) ? lane : 64;
#pragma unroll
        for (int o = 1; o < 8; o <<= 1) i1 = min(i1, __shfl_xor(i1, o));
        float m2 = (lane == i1) ? -__builtin_inff() : biased;
#pragma unroll
        for (int o = 1; o < 8; o <<= 1) m2 = fmaxf(m2, __shfl_xor(m2, o));
        const float gs = m1 + m2; const int grp = lane >> 3;
        int grank = 0;
#pragma unroll
        for (int g2 = 0; g2 < 8; ++g2) { const float og = __shfl(gs, 8 * g2); grank += (og > gs || (og == gs && g2 < grp)) ? 1 : 0; }
        const float mk = (grank < 4) ? biased : -__builtin_inff();
        int erank = 0;
#pragma unroll 4
        for (int e2 = 0; e2 < 64; ++e2) { const float oe = __shfl(mk, e2); erank += (oe > mk || (oe == mk && e2 < lane)) ? 1 : 0; }
        const bool sel = erank < 8;
        const float wsum = wave_sum(sel ? score : 0.f);
        if (sel) { const float gw = score / wsum * 2.5f;
            const int rk = (int)__hip_atomic_fetch_add(F.ctl() + CW_ECNT + 64 * lane, 1u, RLX_AGENT);
            ltok[lane * NTOK + rk] = tok; lw[lane * NTOK + rk] = gw; inv[tok * 8 + erank] = lane * NTOK + rk; } }
    __syncthreads();
}
__device__ __forceinline__ void p7_phase(Frame& F) { for (int un = F.bid(); un < NTOK / 16; un += F.G()) p7_unit(F, un); }
struct MoeOrder {
    const LAS int* tab; const int* ltok; int G, c, npn;
    __device__ __forceinline__ bool next(int i, pg8::Unit& u) const {
        const int L = i * G + c; const int total = tab[80 + NEX] * npn; if (L >= total) return false;
        int e = 0;
        for (int k = 1; k < NEX; ++k) e += (tab[80 + k] * npn <= L) ? 1 : 0;
        const int nte = tab[80 + e + 1] - tab[80 + e], rem = L - tab[80 + e] * npn;
        const int mt = rem % nte, pn = rem / nte;
        u.pm = tab[80 + e] + mt; u.pn = e * npn + pn; u.ax = (e << 8) | mt; return true;
    }
    __device__ __forceinline__ int row_tok(const pg8::Unit& u, int r) const {
        const int e = u.ax >> 8, idx = (u.ax & 255) * 256 + r;
        if (e == NE) return idx;
        return idx < tab[e] ? ltok[e * NTOK + idx] : 0;
    }
};
__device__ __forceinline__ void moe_tables(Frame& F) {
    LAS int* tab = (LAS int*)(F.lds() + LDS_MISC + 64);
    if (F.tid() == 0) { int cum = 0;
        for (int e = 0; e < NE; ++e) { const int cn = (int)__hip_atomic_load(F.ctl() + CW_ECNT + 64 * e, RLX_AGENT); tab[e] = cn; tab[80 + e] = cum; cum += (cn + 255) >> 8; }
        tab[NE] = NTOK; tab[80 + NE] = cum; cum += NTOK / 256; tab[80 + NEX] = cum; }
    __syncthreads();
}
struct EpiGateUp {
    static constexpr bool PERM = true;
    bf16* hid; const float* lw; const LAS int* tab;
    __device__ __forceinline__ void operator()(const f32x4 (&acc)[2][2][4][2], const pg8::Unit& u, int wr, int wc, int fr, int fq) const {
        const int e = u.ax >> 8, mt = u.ax & 255, pn = u.pn & 3; const int cnt = tab[e];
#pragma unroll
        for (int ai = 0; ai < 2; ++ai)
#pragma unroll
            for (int m = 0; m < 4; ++m) { const int rl = ai * 128 + wr * 64 + m * 16 + fr, idx = mt * 256 + rl;
                const float gw = (e == NE) ? 1.0f : (idx < cnt ? lw[e * NTOK + idx] : 0.0f);
                f32x4 h0, h1;
#pragma unroll
                for (int i = 0; i < 4; ++i) { h0[i] = silu_f(acc[ai][0][m][0][i]) * acc[ai][1][m][0][i] * gw; h1[i] = silu_f(acc[ai][0][m][1][i]) * acc[ai][1][m][1][i] * gw; }
                u32x4 w = {cvt_pk_bf16(h0[0], h0[1]), cvt_pk_bf16(h0[2], h0[3]), cvt_pk_bf16(h1[0], h1[1]), cvt_pk_bf16(h1[2], h1[3])};
                *(u32x4*)(hid + (size_t)(u.pm * 256 + rl) * DE + pn * 128 + wc * 32 + 8 * fq) = w; }
    }
};
struct EpiDown {
    static constexpr bool PERM = true;
    bf16* outs;
    __device__ __forceinline__ void operator()(const f32x4 (&acc)[2][2][4][2], const pg8::Unit& u, int wr, int wc, int fr, int fq) const {
        const int pn = u.pn & 7;
#pragma unroll
        for (int ai = 0; ai < 2; ++ai)
#pragma unroll
            for (int m = 0; m < 4; ++m) { bf16* rowp = outs + (size_t)(u.pm * 256 + ai * 128 + wr * 64 + m * 16 + fr) * DM + pn * 256 + wc * 32 + 8 * fq;
#pragma unroll
                for (int bj = 0; bj < 2; ++bj) { const f32x4 v0 = acc[ai][bj][m][0], v1 = acc[ai][bj][m][1];
                    u32x4 w = {cvt_pk_bf16(v0[0], v0[1]), cvt_pk_bf16(v0[2], v0[3]), cvt_pk_bf16(v1[0], v1[1]), cvt_pk_bf16(v1[2], v1[3])};
                    *(u32x4*)(rowp + bj * 128) = w; } }
    }
};
__device__ __forceinline__ void p10_final(Frame& F) {
    const float* modf = WSP(const float, WS_MODF); const bf16* outs = WSP(const bf16, WS_OUTS); const int* inv = WSP(const int, WS_INV);
    const LAS int* tab = (const LAS int*)(F.lds() + LDS_MISC + 64);
    const int gw = F.bid() * 8 + F.wave(), NGW = F.G() * 8;
    for (int tok = gw; tok < NTOK; tok += NGW) { int lane = F.lane(); asm volatile("" : "+v"(lane)); const int b = tok / SEQ; const float* g2 = modf + (size_t)b * (6 * DM) + 5 * DM;
        size_t rows[9];
#pragma unroll
        for (int k = 0; k < 8; ++k) { const int iv = inv[tok * 8 + k]; const int e = iv / NTOK, rk = iv % NTOK; rows[k] = (size_t)(tab[80 + e] * 256 + rk); }
        rows[8] = (size_t)(tab[80 + NE] * 256 + tok);
        f32x4 v[8]; float s = 0.f;
#pragma unroll
        for (int j = 0; j < 8; ++j) { const int col = j * 256 + lane * 4; f32x4 f = {0.f, 0.f, 0.f, 0.f};
#pragma unroll
            for (int k = 0; k < 9; ++k) { const u32x2 w = *(const u32x2*)(outs + rows[k] * DM + col); f[0] += bflo(w[0]); f[1] += bfhi(w[0]); f[2] += bflo(w[1]); f[3] += bfhi(w[1]); }
            const f32x4 x1 = *(const f32x4*)(F.out() + (size_t)tok * DM + col);
            v[j] = x1 * ALPHA_DN + *(const f32x4*)(g2 + col) * f; s += (v[j][0] + v[j][1]) + (v[j][2] + v[j][3]); }
        const float mu = wave_sum(s) * (1.0f / DM); float q = 0.f;
#pragma unroll
        for (int j = 0; j < 8; ++j) { v[j] = v[j] - mu; q += (v[j][0] * v[j][0] + v[j][1] * v[j][1]) + (v[j][2] * v[j][2] + v[j][3] * v[j][3]); }
        const float rstd = 1.0f / sqrtf(wave_sum(q) * (1.0f / DM) + LN_EPS);
#pragma unroll
        for (int j = 0; j < 8; ++j) { const int col = j * 256 + lane * 4;
            *(f32x4*)(F.out() + (size_t)tok * DM + col) = v[j] * rstd * *(const f32x4*)(F.f(25) + col) + *(const f32x4*)(F.f(26) + col); } }
}
#ifndef MK_N_LAUNCHES
#define MK_N_LAUNCHES 1
#endif
constexpr int N_PHASES = 11;
__global__ void __launch_bounds__(512, 2) fwd_kernel(Args args) {
    Frame F; F.ap = &args;
    if (F.tid() < 16) ((LAS unsigned*)(F.lds() + LDS_MISC))[F.tid()] = 0u;
    __syncthreads();
    if (args.ph_hi - args.ph_lo > 1) (void)xcd_barrier_post((unsigned*)(F.ctl() + CW_BAR), (volatile LAS unsigned*)(F.lds() + LDS_MISC));
#ifndef PH_MASK
#define PH_MASK 0x7ff
#endif
#define IN(k) (((PH_MASK >> (k)) & 1) && args.ph_lo <= (k) && (k) < args.ph_hi)
#define SEAM(k) do { if (IN(k) && IN((k) + 1)) { XcdBarrier bar_; bar_.bar = (unsigned*)(F.ctl() + CW_BAR); bar_.x = xb_xcc_id(); bar_.st = (volatile LAS unsigned*)(F.lds() + LDS_MISC); xcd_barrier(bar_); } } while (0)
    if (IN(0)) { p0_prologue(F); } SEAM(0);
    if (IN(1)) { p1_modulate(F); } SEAM(1);
    if (IN(2)) {
        pg8::Gemm g{WSP(const bf16, WS_U1), WSP(const bf16, WS_WIN), DM}; pg8::StaticOrder S; S.init(NTOK, NPROJ_PAD, F.G(), F.bid());
        EpiInProj E{F.ws(), F.f(8), F.f(12), F.f(13)};
        pg8::gemm_phase<EpiInProj, pg8::StaticOrder, false>(F.lds(), g, S, E);
    } SEAM(2);
    if (IN(3)) { p3_phase(F); } SEAM(3);
    if (IN(4)) { p4_select(F); p4_scan(F); } SEAM(4);
    if (IN(5)) { p5_phase(F); } SEAM(5);
    if (IN(6)) {
        pg8::Gemm g{WSP(const bf16, WS_YCAT), WSP(const bf16, WS_WOUT), DM}; pg8::StaticOrder S; S.init(NTOK, DM, F.G(), F.bid());
        EpiOutProj E{F.f(0), WSP(const float, WS_MODF), F.out()};
        pg8::gemm_phase<EpiOutProj, pg8::StaticOrder, false>(F.lds(), g, S, E);
    } SEAM(6);
    if (IN(7)) { p7_phase(F); } SEAM(7);
    if (IN(8)) {
        moe_tables(F);
        const LAS int* tab = (const LAS int*)(F.lds() + LDS_MISC + 64);
        pg8::Gemm g{WSP(const bf16, WS_U2), WSP(const bf16, WS_WGU), DM}; MoeOrder S{tab, WSP(const int, WS_LTOK), F.G(), F.bid(), 4};
        EpiGateUp E{WSP(bf16, WS_HID), WSP(const float, WS_LW), tab};
        pg8::gemm_phase<EpiGateUp, MoeOrder, true>(F.lds(), g, S, E);
    } SEAM(8);
    if (IN(9)) {
        moe_tables(F);
        const LAS int* tab = (const LAS int*)(F.lds() + LDS_MISC + 64);
        pg8::Gemm g{WSP(const bf16, WS_HID), WSP(const bf16, WS_WDN), DE}; MoeOrder S{tab, WSP(const int, WS_LTOK), F.G(), F.bid(), 8};
        EpiDown E{WSP(bf16, WS_OUTS)};
        pg8::gemm_phase<EpiDown, MoeOrder, false>(F.lds(), g, S, E);
    } SEAM(9);
    if (IN(10)) { moe_tables(F); p10_final(F); }
#ifdef DBG_OFF
    if (args.ph_hi == N_PHASES) {
        const size_t n = (size_t)NTOK * DM; float* o = F.out();
        for (size_t i = (size_t)F.bid() * 512 + F.tid(); i < n; i += (size_t)F.G() * 512) {
            float v;
            if (DBG_KIND == 0) v = bf2f(((const bf16*)(F.ws() + (size_t)(DBG_OFF)))[i % (size_t)(DBG_N)]);
            else v = ((const float*)(F.ws() + (size_t)(DBG_OFF)))[i % (size_t)(DBG_N)];
            if (!(fabsf(v) < 1e30f)) v = 1e30f;
            o[i] = v; }
    }
#endif
#undef IN
#undef SEAM
}

extern "C" void kernel_launch(void* const* d_in, const int* in_sizes, int n_in, void* d_out, int out_size, void* d_ws, size_t ws_size, hipStream_t stream) {
    static int grid = 0;
    if (grid == 0) {
        if (n_in != 27 || out_size != NTOK * DM || ws_size < WS_END) { fprintf(stderr, "kernel_launch: unexpected shapes (n_in %d, out %d, ws %zu; need ws >= %zu)\n", n_in, out_size, ws_size, (size_t)WS_END); }
        int dev = 0, cus = 0, per_cu = 0;
        if (hipGetDevice(&dev) != hipSuccess || hipDeviceGetAttribute(&cus, hipDeviceAttributeMultiprocessorCount, dev) != hipSuccess) { grid = -1; return; }
        if (hipFuncSetAttribute((const void*)fwd_kernel, hipFuncAttributeMaxDynamicSharedMemorySize, LDS_BYTES) != hipSuccess) { fprintf(stderr, "kernel_launch: hipFuncSetAttribute failed\n"); grid = -1; return; }
        if (hipOccupancyMaxActiveBlocksPerMultiprocessor(&per_cu, (const void*)fwd_kernel, 512, LDS_BYTES) != hipSuccess || per_cu < 1) fprintf(stderr, "kernel_launch: occupancy query reports %d\n", per_cu);
        (void)hipGetLastError();
        grid = cus;
    }
    if (grid < 0) return;
    (void)hipMemsetAsync((char*)d_ws + WS_CTL, 0, CTL_ZERO_BYTES, stream);
    Args a{};
    for (int i = 0; i < 27; ++i) a.in[i] = d_in[i];
    a.out = (float*)d_out; a.ws = (unsigned char*)d_ws;
#if MK_N_LAUNCHES == 1
    a.ph_lo = 0; a.ph_hi = N_PHASES;
    hipLaunchKernelGGL(fwd_kernel, dim3(grid), dim3(512), LDS_BYTES, stream, a);
#else
    for (int p = 0; p < N_PHASES; ++p) { a.ph_lo = p; a.ph_hi = p + 1; hipLaunchKernelGGL(fwd_kernel, dim3(grid), dim3(512), LDS_BYTES, stream, a); }
#endif
}
```

```cpp
#include <hip/hip_runtime.h>
#include <cstdio>
#include <cstdint>

#define GAS __attribute__((address_space(1)))
#define LAS __attribute__((address_space(3)))
typedef unsigned short bf16;
typedef short bf16x8 __attribute__((ext_vector_type(8)));
typedef short s16x4 __attribute__((ext_vector_type(4)));
typedef float f32x2 __attribute__((ext_vector_type(2)));
typedef float f32x4 __attribute__((ext_vector_type(4)));
typedef float f32x16 __attribute__((ext_vector_type(16)));
typedef unsigned u32x2 __attribute__((ext_vector_type(2)));
typedef unsigned u32x4 __attribute__((ext_vector_type(4)));
typedef GAS unsigned gu32;
#define RLX_AGENT __ATOMIC_RELAXED, __HIP_MEMORY_SCOPE_AGENT
#define LDS_WAIT() asm volatile("s_waitcnt lgkmcnt(0)" ::: "memory")
#define VM_WAIT() asm volatile("s_waitcnt vmcnt(0)" ::: "memory")

constexpr int DM = 2048, NBATCH = 2, SEQ = 4096, NTOK = NBATCH * SEQ;
constexpr int D_SSM = 1024, SSM_H = 16, SSM_P = 64, SSM_N = 128, CONV_CH = 1536, CHUNK = 128, NCHUNK = SEQ / CHUNK;
constexpr int ATT_H = 8, ATT_D = 128, IDX_H = 16, IDX_D = 64, TOPK_SEL = 256;
constexpr int NE = 64, DE = 512, NEX = NE + 1;
constexpr int NPROJ = 6752, NPROJ_PAD = 6912, NPROJ_TILES = 27;
constexpr float ALPHA_DN = 1.189207115002721f;
constexpr float LN_EPS = 1e-5f;
constexpr int SEG_Z = 0, SEG_XBC = 1024, SEG_DT = 2560, SEG_Q = 2576, SEG_K = 3600, SEG_V = 4624, SEG_QI = 5648, SEG_KI = 6672, SEG_WI = 6736;

constexpr size_t MiB = 1u << 20;
constexpr size_t WS_CTL = 0, CTL_ZERO_BYTES = 1 * MiB;
constexpr size_t WS_MODP = 1 * MiB;
constexpr size_t WS_MODF = 3 * MiB;
constexpr size_t WS_COSA = 4 * MiB, WS_SINA = 6 * MiB;
constexpr size_t WS_COSI = 8 * MiB, WS_SINI = 9 * MiB;
constexpr size_t WS_WR = 10 * MiB;
constexpr size_t WS_KIDX = 11 * MiB;
constexpr size_t WS_WIDX = 12 * MiB;
constexpr size_t WS_DT = 12 * MiB + 512 * 1024;
constexpr size_t WS_CS = 13 * MiB;
constexpr size_t WS_INV = 14 * MiB;
constexpr size_t WS_LTOK = 15 * MiB;
constexpr size_t WS_LW = 17 * MiB;
constexpr size_t WS_MASK = 19 * MiB;
constexpr size_t WS_U2 = 25 * MiB;
constexpr size_t WS_WGU = 57 * MiB;
constexpr size_t WS_WDN = 317 * MiB;
constexpr size_t WS_T = 447 * MiB;
constexpr size_t WS_HID = WS_T;
constexpr size_t WS_OUTS = WS_T + 88 * MiB;
constexpr size_t WS_WIN = WS_T;
constexpr size_t WS_WOUT = WS_T + 27 * MiB;
constexpr size_t WS_U1 = WS_T + 35 * MiB;
constexpr size_t WS_Z = WS_T + 67 * MiB;
constexpr size_t WS_XBC = WS_T + 83 * MiB;
constexpr size_t WS_Q = WS_T + 107 * MiB, WS_K = WS_T + 123 * MiB, WS_V = WS_T + 139 * MiB;
constexpr size_t WS_QIDX = WS_T + 155 * MiB;
constexpr size_t WS_SCORES = WS_T + 171 * MiB;
constexpr size_t WS_STATES = WS_T + 299 * MiB;
constexpr size_t WS_HIN = WS_T + 331 * MiB;
constexpr size_t WS_YDIAG = WS_T + 347 * MiB;
constexpr size_t WS_YCAT = WS_T + 379 * MiB;
constexpr size_t WS_XBCACT = WS_T + 411 * MiB;
constexpr size_t WS_END = WS_T + 440 * MiB;
static_assert(WS_XBCACT + 24 * MiB <= WS_END && WS_OUTS + 352 * MiB <= WS_END, "ws map");
constexpr int MAXPOS = 90112;
constexpr int CW_TMO = 0, CW_BAR = 4096, CW_ECNT = 8192;
constexpr int CW_QHEAD = 16384, CW_DONE = 16448;

constexpr int LDS_MISC = 155648;
constexpr int LDS_BYTES = 157696;

typedef __bf16 bf16x2_t __attribute__((ext_vector_type(2)));
__device__ __forceinline__ unsigned cvt_pk_bf16(float lo, float hi) { const bf16x2_t v = {(__bf16)lo, (__bf16)hi}; return __builtin_bit_cast(unsigned, v); }
__device__ __forceinline__ float bflo(unsigned w) { return __uint_as_float(w << 16); }
__device__ __forceinline__ float bfhi(unsigned w) { return __uint_as_float(w & 0xffff0000u); }
__device__ __forceinline__ float bf2f(bf16 b) { return __uint_as_float((unsigned)b << 16); }
__device__ __forceinline__ bf16 f2bf(float f) { return __builtin_bit_cast(unsigned short, (__bf16)f); }
__device__ __forceinline__ float silu_f(float x) { return x / (1.f + __expf(-x)); }
__device__ __forceinline__ float sigmoid_f(float x) { return 1.f / (1.f + __expf(-x)); }
__device__ __forceinline__ float wave_sum(float v) {
#pragma unroll
    for (int o = 1; o < 64; o <<= 1) v += __shfl_xor(v, o);
    return v;
}
__device__ __forceinline__ bf16x8 pack8(f32x4 a, f32x4 b) {
    u32x4 w = {cvt_pk_bf16(a[0], a[1]), cvt_pk_bf16(a[2], a[3]), cvt_pk_bf16(b[0], b[1]), cvt_pk_bf16(b[2], b[3])};
    return __builtin_bit_cast(bf16x8, w);
}
__device__ __forceinline__ void unpack8(bf16x8 v, float (&o)[8]) {
    u32x4 w = __builtin_bit_cast(u32x4, v);
#pragma unroll
    for (int i = 0; i < 4; ++i) { o[2 * i] = bflo(w[i]); o[2 * i + 1] = bfhi(w[i]); }
}
__device__ __forceinline__ int crow(int r, int hi) { return (r & 3) + 8 * (r >> 2) + 4 * hi; }
#define MK_N_LAUNCHES 1
#define PH_MASK 0x7ff
#define XB_TMO      128
#define XB_XCNT(j)  (256  + 64 * (j))
#define XB_XSUB(j)  (1280 + 64 * (j))
#define XB_XGEN(j)  (2304 + 64 * (j))
#define XB_TOP      3328
#define XB_TOPGEN   3392
#define XCD_BAR_WORDS 3456
#define XB_SPIN_CAP (1u << 18)

__device__ __forceinline__ unsigned xb_ld(unsigned* p)              { return __hip_atomic_load(p, __ATOMIC_RELAXED, __HIP_MEMORY_SCOPE_AGENT); }
__device__ __forceinline__ unsigned xb_add(unsigned* p, unsigned v) { return __hip_atomic_fetch_add(p, v, __ATOMIC_RELAXED, __HIP_MEMORY_SCOPE_AGENT); }
__device__ __forceinline__ unsigned xb_xcc_id() { return (unsigned)__builtin_amdgcn_s_getreg((3 << 11) | 20) & 0xFu; }
#define XB_SPIN(cond, bar) do { unsigned _sp = 0; while (cond) { __builtin_amdgcn_s_sleep(1); \
    if ((++_sp & 255u) == 0u) { if (xb_ld(&(bar)[XB_TMO])) break; if (_sp > XB_SPIN_CAP) { atomicAdd(&(bar)[XB_TMO], 1u); break; } } } } while (0)

struct XcdBarrier {
    unsigned* bar; unsigned x;
    volatile LAS unsigned* st;
};

__device__ __forceinline__ XcdBarrier xcd_barrier_post(unsigned* bar, volatile LAS unsigned* st) {
    XcdBarrier b; b.bar = bar; b.x = xb_xcc_id(); b.st = st;
    if (threadIdx.x == 0) (void)xb_add(&bar[XB_XCNT(b.x)], 1u);
    return b;
}
__device__ __forceinline__ void xcd_barrier_complete(unsigned* bar, unsigned x, unsigned& nloc, unsigned& nx) {
    const unsigned G = gridDim.x * gridDim.y * gridDim.z;
    unsigned sum, cnt, mine, sp = 0u;
    for (;;) {
        sum = 0u; cnt = 0u; mine = 0u;
#pragma unroll
        for (unsigned j = 0; j < 16; ++j) { const unsigned c = xb_ld(&bar[XB_XCNT(j)]); sum += c; cnt += (c > 0u) ? 1u : 0u; mine = (j == x) ? c : mine; }
        if (sum == G) break;
        __builtin_amdgcn_s_sleep(1);
        if ((++sp & 255u) == 0u) { if (xb_ld(&bar[XB_TMO])) break; if (sp > XB_SPIN_CAP) { atomicAdd(&bar[XB_TMO], 1u); break; } }
    }
    nloc = mine > 0u ? mine : 1u; nx = cnt > 0u ? cnt : 1u;
}

__device__ __forceinline__ void xcd_barrier(const XcdBarrier& b) {
    asm volatile("s_waitcnt vmcnt(0)" ::: "memory");
    __syncthreads();
    if (threadIdx.x == 0) {
        unsigned* bar = b.bar;
        __builtin_amdgcn_s_waitcnt(0);
        unsigned nloc = b.st[0], nx = b.st[1];
        if (nloc == 0u) { xcd_barrier_complete(bar, b.x, nloc, nx); b.st[0] = nloc; b.st[1] = nx; }
        const unsigned old = xb_add(&bar[XB_XSUB(b.x)], 1u);
        const unsigned gen = old / nloc;
        if (old + 1u == (gen + 1u) * nloc) {
            __builtin_amdgcn_fence(__ATOMIC_RELEASE, "agent");
            asm volatile("s_waitcnt vmcnt(0)" ::: "memory");
            const unsigned og = xb_add(&bar[XB_TOP], 1u);
            const unsigned tg = og / nx;
            if (og + 1u == (tg + 1u) * nx) xb_add(&bar[XB_TOPGEN], 1u);
            else XB_SPIN(xb_ld(&bar[XB_TOPGEN]) == tg, bar);
            __builtin_amdgcn_fence(__ATOMIC_ACQUIRE, "agent");
            xb_add(&bar[XB_XGEN(b.x)], 1u);
            asm volatile("s_waitcnt vmcnt(0)" ::: "memory");
        } else {
            XB_SPIN(xb_ld(&bar[XB_XGEN(b.x)]) == gen, bar);
            __builtin_amdgcn_fence(__ATOMIC_ACQUIRE, "agent");
            asm volatile("s_waitcnt vmcnt(0)" ::: "memory");
        }
    }
    __syncthreads();
}

namespace pg8 {
constexpr int BM = 256, BK = 64, HALF = 128, HTB = HALF * BK * 2  , STAGE_BYTES = 8 * HTB, NXCD = 8, WGM = 8;
__host__ __device__ __forceinline__ int lds_byte(int r, int c) { const int st = (r >> 4) * 2 + (c >> 5), rr = r & 15, cc = c & 31, ob = rr * 64 + cc * 2; return st * 1024 + (ob ^ (((ob >> 9) & 1) << 5)); }
__host__ __device__ __forceinline__ void stage_rc(int b, int& R, int& C) { const int st = b / 1024, sb = b % 1024, swz = sb ^ (((sb >> 9) & 1) << 5); R = (st >> 1) * 16 + swz / 64; C = (st & 1) * 32 + (swz % 64) / 2; }
__host__ __device__ __forceinline__ int perm32(int rho) { const int n = rho >> 4, i = rho & 15; return 8 * (i >> 2) + 4 * n + (i & 3); }

struct Unit { int pm, pn, ax; };
struct Gemm { const bf16* A; const bf16* Bt; int K; };

struct StaticOrder {
    int nM, nN, nwg, G, c;
    __device__ void init(int M, int N, int G_, int c_) { nM = M / BM; nN = N / BM; nwg = nM * nN; G = G_; c = c_; }
    __device__ __forceinline__ bool next(int i, Unit& u) const {
        const long L = (long)i * G + c; if (L >= nwg) return false;
        int wgid = (int)L; { const int q = nwg / NXCD, r = nwg % NXCD, xcd = wgid % NXCD, off = wgid / NXCD; wgid = (xcd < r ? xcd * (q + 1) : r * (q + 1) + (xcd - r) * q) + off; }
        const int nig = WGM * nN, gid = wgid / nig, fm = gid * WGM, gsz = (nM - fm) < WGM ? (nM - fm) : WGM;
        u.pm = fm + ((wgid % nig) % gsz); u.pn = (wgid % nig) / gsz; u.ax = 0; return true;
    }
    __device__ __forceinline__ int row_tok(const Unit&, int) const { return 0; }
};

template <class Epi, class Sched, bool GATHER>
__device__ __forceinline__ void gemm_phase(LAS unsigned char* lds, const Gemm g, const Sched& S, const Epi& E) {
    const int tid = threadIdx.x, wid = __builtin_amdgcn_readfirstlane(tid >> 6), lane = tid & 63, wr = wid >> 2, wc = wid & 3, fr = lane & 15, fq = lane >> 4;
    const int K = g.K, nt = K / BK;
    unsigned voffB[2]; int RA[2]; unsigned CA2[2];
#pragma unroll
    for (int i = 0; i < 2; ++i) { int R, C; stage_rc(tid * 16 + i * 8192, R, C); const int Rb = Epi::PERM ? ((R & ~31) + perm32(R & 31)) : R;
        voffB[i] = (unsigned)(Rb * K + C) * 2u; RA[i] = R; CA2[i] = (unsigned)C * 2u; }
    const size_t kstep = (size_t)(BK * 2);
    const size_t hstep = (size_t)HALF * K * 2;
    const size_t tstep = 2 * hstep;
    const unsigned ldsw = (unsigned)wid * 1024u;
    const int aoff = lds_byte(wr * 64 + fr, fq * 8), boff = lds_byte(wc * 32 + fr, fq * 8);
#define PG8_SA(b, h) (((b) * 2 + (h)) * HTB)
#define PG8_SB(b, h) ((4 + (b) * 2 + (h)) * HTB)
#define PG8_STAGE(bufoff, gbase, voff) do { _Pragma("unroll") for (int _i = 0; _i < 2; ++_i) \
        __builtin_amdgcn_global_load_lds((const unsigned*)((const char*)(gbase) + (voff)[_i]), (LAS unsigned*)(lds + (bufoff) + ldsw + _i * 8192), 16, 0, 0); } while (0)
#define PG8_LDA(dst, b, h) do { _Pragma("unroll") for (int m = 0; m < 4; ++m) _Pragma("unroll") for (int k = 0; k < 2; ++k) dst[m][k] = *(const LAS bf16x8*)(lds + PG8_SA(b, h) + aoff + m * 2048 + k * 1024); } while (0)
#define PG8_LDB(dst, b, h) do { _Pragma("unroll") for (int n = 0; n < 2; ++n) _Pragma("unroll") for (int k = 0; k < 2; ++k) dst[n][k] = *(const LAS bf16x8*)(lds + PG8_SB(b, h) + boff + n * 2048 + k * 1024); } while (0)
#define PG8_MMA(ai, bj, At, Bt) do { __builtin_amdgcn_s_setprio(1); _Pragma("unroll") for (int m = 0; m < 4; ++m) _Pragma("unroll") for (int n = 0; n < 2; ++n) _Pragma("unroll") for (int k = 0; k < 2; ++k) \
        acc[ai][bj][m][n] = __builtin_amdgcn_mfma_f32_16x16x32_bf16(Bt[n][k], At[m][k], acc[ai][bj][m][n], 0, 0, 0); __builtin_amdgcn_s_setprio(0); } while (0)
#define PG8_WAIT_V(n) asm volatile("s_waitcnt vmcnt(" #n ")" ::: "memory")
#define PG8_WAIT_L(n) asm volatile("s_waitcnt lgkmcnt(" #n ")" ::: "memory")
#define PG8_BAR __builtin_amdgcn_s_barrier()
#define PG8_SCHED __builtin_amdgcn_sched_barrier(0)
#define PG8_SET_OA(o, u) do { _Pragma("unroll") for (int _h = 0; _h < 2; ++_h) _Pragma("unroll") for (int _i = 0; _i < 2; ++_i) { \
        if constexpr (GATHER) o[_h][_i] = (unsigned)S.row_tok(u, _h * HALF + RA[_i]) * (unsigned)(K * 2) + CA2[_i]; \
        else o[_h][_i] = (unsigned)(_h * (int)hstep) + (unsigned)(RA[_i] * K * 2) + CA2[_i]; } } while (0)
    Unit cur, nxt; int ui = 0;
    if (!S.next(0, cur)) return;
    f32x4 acc[2][2][4][2];
#pragma unroll
    for (int a = 0; a < 2; ++a)
#pragma unroll
        for (int b = 0; b < 2; ++b)
#pragma unroll
            for (int m = 0; m < 4; ++m)
#pragma unroll
                for (int n = 0; n < 2; ++n) acc[a][b][m][n] = (f32x4){0.f, 0.f, 0.f, 0.f};
    bf16x8 At[4][2], B0[2][2], B1[2][2];
    unsigned oAc[2][2], oAn[2][2];
    PG8_SET_OA(oAc, cur);
    const char* cA = GATHER ? (const char*)g.A : (const char*)g.A + (size_t)cur.pm * tstep; const char* cB = (const char*)g.Bt + (size_t)cur.pn * tstep;
    PG8_STAGE(PG8_SB(0, 0), cB, voffB); PG8_STAGE(PG8_SB(0, 1), cB + hstep, voffB); PG8_STAGE(PG8_SA(0, 0), cA, oAc[0]); PG8_STAGE(PG8_SA(0, 1), cA, oAc[1]);
    if (wr == 1) PG8_BAR;
    PG8_WAIT_V(2); PG8_BAR;
    PG8_STAGE(PG8_SB(1, 0), cB + kstep, voffB); PG8_STAGE(PG8_SA(1, 0), cA + kstep, oAc[0]); PG8_STAGE(PG8_SB(1, 1), cB + hstep + kstep, voffB);
    PG8_WAIT_V(6); PG8_BAR;
    for (;;) {
        const bool has_next = S.next(ui + 1, nxt);
        const char* nA = has_next ? (GATHER ? (const char*)g.A : (const char*)g.A + (size_t)nxt.pm * tstep) : cA; const char* nB = has_next ? (const char*)g.Bt + (size_t)nxt.pn * tstep : cB;
        if (has_next) { PG8_SET_OA(oAn, nxt); }
        else {
#pragma unroll
            for (int _h = 0; _h < 2; ++_h)
#pragma unroll
                for (int _i = 0; _i < 2; ++_i) oAn[_h][_i] = oAc[_h][_i]; }
        for (int t = 0; t < nt; t += 2) {
            const bool last = (t == nt - 2);
            const char* a1 = cA + (size_t)(t + 1) * kstep;
            const char* a2 = last ? nA : cA + (size_t)(t + 2) * kstep; const char* b2 = last ? nB : cB + (size_t)(t + 2) * kstep;
            const char* a3 = a2 + kstep; const char* b3 = b2 + kstep;
            unsigned o2[2][2];
#pragma unroll
            for (int _h = 0; _h < 2; ++_h)
#pragma unroll
                for (int _i = 0; _i < 2; ++_i) o2[_h][_i] = GATHER ? (last ? oAn[_h][_i] : oAc[_h][_i]) : oAc[_h][_i];
            PG8_LDB(B0, 0, 0); PG8_LDB(B1, 0, 1); PG8_SCHED; PG8_LDA(At, 0, 0); PG8_STAGE(PG8_SA(1, 1), a1, oAc[1]);
            PG8_WAIT_V(8); PG8_WAIT_L(0); PG8_BAR; PG8_MMA(0, 0, At, B0); PG8_MMA(0, 1, At, B1); PG8_BAR; PG8_SCHED;
            PG8_LDA(At, 0, 1); PG8_STAGE(PG8_SB(0, 0), b2, voffB); PG8_STAGE(PG8_SB(0, 1), b2 + hstep, voffB); PG8_STAGE(PG8_SA(0, 0), a2, o2[0]);
            PG8_WAIT_V(8); PG8_WAIT_L(0); PG8_BAR; PG8_MMA(1, 0, At, B0); PG8_MMA(1, 1, At, B1); PG8_BAR; PG8_SCHED;
            PG8_LDB(B0, 1, 0); PG8_LDB(B1, 1, 1); PG8_SCHED; PG8_LDA(At, 1, 0); PG8_STAGE(PG8_SA(0, 1), a2, o2[1]);
            PG8_WAIT_V(8); PG8_WAIT_L(0); PG8_BAR; PG8_MMA(0, 0, At, B0); PG8_MMA(0, 1, At, B1); PG8_BAR; PG8_SCHED;
            PG8_LDA(At, 1, 1); PG8_STAGE(PG8_SB(1, 0), b3, voffB); PG8_STAGE(PG8_SB(1, 1), b3 + hstep, voffB); PG8_STAGE(PG8_SA(1, 0), a3, o2[0]);
            PG8_WAIT_V(8); PG8_WAIT_L(0); PG8_BAR; PG8_MMA(1, 0, At, B0); PG8_MMA(1, 1, At, B1); PG8_BAR; PG8_SCHED;
        }
        if (wr == 0) PG8_BAR;
        { int fr_ = fr, fq_ = fq, wr_ = wr, wc_ = wc; asm volatile("" : "+v"(fr_), "+v"(fq_), "+s"(wr_), "+s"(wc_));
          E(acc, cur, wr_, wc_, fr_, fq_); }
        if (!has_next) break;
#pragma unroll
        for (int a = 0; a < 2; ++a)
#pragma unroll
            for (int b = 0; b < 2; ++b)
#pragma unroll
                for (int m = 0; m < 4; ++m)
#pragma unroll
                    for (int n = 0; n < 2; ++n) acc[a][b][m][n] = (f32x4){0.f, 0.f, 0.f, 0.f};
        cur = nxt; cA = nA; cB = nB; ++ui;
#pragma unroll
        for (int _h = 0; _h < 2; ++_h)
#pragma unroll
            for (int _i = 0; _i < 2; ++_i) oAc[_h][_i] = oAn[_h][_i];
        if (wr == 1) PG8_BAR;
    }
    PG8_WAIT_V(0);
    PG8_BAR;
#undef PG8_SA
#undef PG8_SB
#undef PG8_STAGE
#undef PG8_LDA
#undef PG8_LDB
#undef PG8_MMA
#undef PG8_WAIT_V
#undef PG8_WAIT_L
#undef PG8_BAR
#undef PG8_SCHED
#undef PG8_SET_OA
}
}
struct Args { const void* in[27]; float* out; unsigned char* ws; int ph_lo, ph_hi; };
struct Frame {
    const Args* ap;
    __device__ __forceinline__ LAS unsigned char* lds() const { extern __shared__ __attribute__((aligned(16))) unsigned char lds_raw[]; return (LAS unsigned char*)lds_raw; }
    __device__ __forceinline__ unsigned char* ws() const { return ap->ws; }
    __device__ __forceinline__ gu32* ctl() const { return (gu32*)(ap->ws + WS_CTL); }
    __device__ __forceinline__ float* out() const { return ap->out; }
    __device__ __forceinline__ int tid() const { return (int)threadIdx.x; }
    __device__ __forceinline__ int lane() const { return (int)threadIdx.x & 63; }
    __device__ __forceinline__ int wave() const { return __builtin_amdgcn_readfirstlane((int)threadIdx.x >> 6); }
    __device__ __forceinline__ int G() const { return (int)gridDim.x; }
    __device__ __forceinline__ int bid() const { return (int)blockIdx.x; }
    __device__ __forceinline__ const float* f(int i) const { return (const float*)ap->in[i]; }
    __device__ __forceinline__ const int* i32(int i) const { return (const int*)ap->in[i]; }
};
#define WSP(T, off) ((T*)(F.ws() + (off)))

__device__ __forceinline__ int inproj_src_col(int P) {
    const int tile = P >> 8, within = P & 255, bj = within >> 7, w = within & 127;
    if (tile < 4) return SEG_Z + tile * 256 + within;
    if (tile < 10) return SEG_XBC + (tile - 4) * 256 + within;
    if (tile < 14) return SEG_Q + (2 * (tile - 10) + (w >> 6)) * 128 + (w & 63) + 64 * bj;
    if (tile < 18) return SEG_K + (2 * (tile - 14) + (w >> 6)) * 128 + (w & 63) + 64 * bj;
    if (tile < 22) return SEG_V + (tile - 18) * 256 + within;
    if (tile < 26) return SEG_QI + (4 * (tile - 22) + (w >> 5)) * 64 + (w & 31) + 32 * bj;
    if (bj == 0) { if (w < 32) return SEG_KI + w; if (w < 48) return SEG_WI + (w - 32); if (w < 64) return SEG_DT + (w - 48); return -1; }
    if (w < 32) return SEG_KI + 32 + w;
    return -1;
}
__device__ __forceinline__ void tr64(const float* qsrc, bool valid, int ld, bf16* dst0  , int K, LAS float* scr, int lane) {
    f32x4 v[16];
#pragma unroll
    for (int i = 0; i < 16; ++i) v[i] = valid ? *(const f32x4*)(qsrc + (size_t)(4 * i) * ld) : (f32x4){0.f, 0.f, 0.f, 0.f};
#pragma unroll
    for (int i = 0; i < 16; ++i) { LAS float* s = scr + ((lane >> 4) + 4 * i) * 65 + 4 * (lane & 15); s[0] = v[i][0]; s[1] = v[i][1]; s[2] = v[i][2]; s[3] = v[i][3]; }
    LDS_WAIT(); asm volatile("" ::: "memory");
    const int c = lane & 7;
#pragma unroll
    for (int jj = 0; jj < 8; ++jj) { const int n = (lane >> 3) + 8 * jj; const LAS float* s = scr + (8 * c) * 65 + n;
        u32x4 o; o.x = cvt_pk_bf16(s[0], s[65]); o.y = cvt_pk_bf16(s[2 * 65], s[3 * 65]); o.z = cvt_pk_bf16(s[4 * 65], s[5 * 65]); o.w = cvt_pk_bf16(s[6 * 65], s[7 * 65]);
        *(u32x4*)(dst0 + (size_t)n * K + 8 * c) = o; }
    LDS_WAIT(); asm volatile("" ::: "memory");
}
constexpr int I_IN = 32 * 108, I_OUT = 32 * 32, I_GU = NEX * 32 * 16, I_DN = NEX * 8 * 32, I_TR = I_IN + I_OUT + I_GU + I_DN;
__device__ __forceinline__ void tr_item(Frame& F, int it, LAS float* scr) {
    const int lane = F.lane(), kr = lane >> 4, nq = 4 * (lane & 15);
    if (it < I_IN) { const int kb = it / 108, nb = it % 108, k0 = 64 * kb, n0 = 64 * nb; const int sc = inproj_src_col(n0 + nq);
        tr64(F.f(5) + (size_t)(k0 + kr) * NPROJ + (sc < 0 ? 0 : sc), sc >= 0, NPROJ, WSP(bf16, WS_WIN) + (size_t)n0 * DM + k0, DM, scr, lane); return; }
    it -= I_IN;
    if (it < I_OUT) { const int kb = it >> 5, nb = it & 31, k0 = 64 * kb, n0 = 64 * nb;
        tr64(F.f(14) + (size_t)(k0 + kr) * DM + n0 + nq, true, DM, WSP(bf16, WS_WOUT) + (size_t)n0 * DM + k0, DM, scr, lane); return; }
    it -= I_OUT;
    if (it < I_GU) { const int e = it >> 9, r = it & 511, kb = r >> 4, nb = r & 15, k0 = 64 * kb;
        const int p = nb >> 2, bj = (nb >> 1) & 1, w0 = (nb & 1) * 64;
        const float* src = (e < NE) ? ((bj ? F.f(20) : F.f(19)) + (size_t)e * DM * DE) : (bj ? F.f(23) : F.f(22));
        tr64(src + (size_t)(k0 + kr) * DE + 128 * p + w0 + nq, true, DE, WSP(bf16, WS_WGU) + ((size_t)e * 1024 + 64 * nb) * DM + k0, DM, scr, lane); return; }
    it -= I_GU;
    { const int e = it >> 8, r = it & 255, kb = r >> 5, nb = r & 31, k0 = 64 * kb, n0 = 64 * nb;
        const float* src = (e < NE) ? (F.f(21) + (size_t)e * DE * DM) : F.f(24);
        tr64(src + (size_t)(k0 + kr) * DM + n0 + nq, true, DM, WSP(bf16, WS_WDN) + ((size_t)e * DM + n0) * DE + k0, DE, scr, lane); }
}
__device__ __forceinline__ void p0_prologue(Frame& F) {
    const int gw = F.bid() * 8 + F.wave(), NGW = F.G() * 8, gt = F.bid() * 512 + F.tid(), NGT = F.G() * 512;
    {
        LAS float* red = (LAS float*)F.lds();
        float* modp = WSP(float, WS_MODP);
        for (int item = F.bid(); item < 48 * 16; item += F.G()) {
            const int cc = item % 48, ks = item / 48;
            f32x4 a0 = {0.f, 0.f, 0.f, 0.f}, a1 = {0.f, 0.f, 0.f, 0.f};
            const int kbase = ks * 128 + F.wave() * 16;
#pragma unroll 4
            for (int i = 0; i < 16; ++i) { const int k = kbase + i;
                const float c0 = silu_f(F.f(1)[k]), c1 = silu_f(F.f(1)[DM + k]);
                const f32x4 wv = *(const f32x4*)(F.f(3) + (size_t)k * (6 * DM) + cc * 256 + F.lane() * 4);
                a0 += wv * c0; a1 += wv * c1; }
            *(LAS f32x4*)(red + (F.wave() * 2 + 0) * 256 + F.lane() * 4) = a0;
            *(LAS f32x4*)(red + (F.wave() * 2 + 1) * 256 + F.lane() * 4) = a1;
            __syncthreads();
            { const int b = F.tid() >> 8, col = F.tid() & 255; float s = 0.f;
#pragma unroll
              for (int w = 0; w < 8; ++w) s += red[(w * 2 + b) * 256 + col];
              modp[((size_t)ks * 2 + b) * (6 * DM) + cc * 256 + col] = s; }
            __syncthreads();
        }
    }
    {
        float* cosA = WSP(float, WS_COSA); float* sinA = WSP(float, WS_SINA); float* cosI = WSP(float, WS_COSI); float* sinI = WSP(float, WS_SINI);
        for (int i = gt; i < NTOK * 64; i += NGT) { const int tok = i >> 6, j = i & 63;
            const float inv = 1.0f / powf(10000.0f, (float)(2 * j) / 128.0f); const float ang = (float)F.i32(2)[tok] * inv;
            float s, c; sincosf(ang, &s, &c); cosA[i] = c; sinA[i] = s; }
        for (int i = gt; i < NTOK * 32; i += NGT) { const int tok = i >> 5, j = i & 31;
            const float inv = 1.0f / powf(10000.0f, (float)(2 * j) / 64.0f); const float ang = (float)F.i32(2)[tok] * inv;
            float s, c; sincosf(ang, &s, &c); cosI[i] = c; sinI[i] = s; }
    }
    {
        bf16* wr_hi = WSP(bf16, WS_WR); bf16* wr_lo = wr_hi + NE * DM;
        for (int i = gt; i < NE * (DM / 8); i += NGT) { const int e = i & 63, kc = i >> 6;
            float v[8], l[8];
#pragma unroll
            for (int j = 0; j < 8; ++j) { v[j] = F.f(17)[(size_t)(8 * kc + j) * NE + e]; l[j] = v[j] - bf2f(f2bf(v[j])); }
            u32x4 h = {cvt_pk_bf16(v[0], v[1]), cvt_pk_bf16(v[2], v[3]), cvt_pk_bf16(v[4], v[5]), cvt_pk_bf16(v[6], v[7])};
            u32x4 lo = {cvt_pk_bf16(l[0], l[1]), cvt_pk_bf16(l[2], l[3]), cvt_pk_bf16(l[4], l[5]), cvt_pk_bf16(l[6], l[7])};
            *(u32x4*)(wr_hi + (size_t)e * DM + 8 * kc) = h; *(u32x4*)(wr_lo + (size_t)e * DM + 8 * kc) = lo; }
    }
    {
        LAS float* scr = (LAS float*)(F.lds() + F.wave() * 16640);
        for (int it = gw; it < I_IN + I_OUT; it += NGW) tr_item(F, it, scr);
    }
}

constexpr int Q_GU = I_GU, Q_ALL = I_GU + I_DN, Q_GRAB = 16;
__device__ __forceinline__ void slack_fill(Frame& F, int ph, bool drain, int upto) {
    LAS float* scr = (LAS float*)(F.lds() + F.wave() * 16640);
    volatile LAS int* qw = (volatile LAS int*)(F.lds() + LDS_MISC + 16);
    __syncthreads();
    if (F.tid() == 0) (void)__hip_atomic_fetch_add(F.ctl() + CW_DONE + 64 * ph, 1u, RLX_AGENT);
    for (;;) {
        if (F.tid() == 0) { int stop = 0, idx = Q_ALL;
            if (!drain && __hip_atomic_load(F.ctl() + CW_DONE + 64 * ph, RLX_AGENT) >= (unsigned)F.G()) stop = 1;
            else { idx = (int)__hip_atomic_fetch_add(F.ctl() + CW_QHEAD, (unsigned)Q_GRAB, RLX_AGENT); if (idx >= Q_ALL) stop = 1; else if (idx >= upto) stop = 2; }
            qw[0] = stop; qw[1] = idx; }
        __syncthreads();
        const int stop = qw[0], idx = qw[1];
        __syncthreads();
        if (stop == 1) break;
#pragma unroll 1
        for (int i = 0; i < Q_GRAB / 8; ++i) { const int it = idx + i * 8 + F.wave(); if (it < Q_ALL) tr_item(F, I_IN + I_OUT + it, scr); }
        if (stop == 2) break;
    }
}

__device__ __forceinline__ void p1_modulate(Frame& F) {
    const float* modp = WSP(const float, WS_MODP); float* modf = WSP(float, WS_MODF); bf16* u1 = WSP(bf16, WS_U1);
    LAS float* sh = (LAS float*)F.lds(); LAS float* sc = sh + DM;
    for (int rg = F.bid(); rg < 256; rg += F.G()) {
        const int b = rg >> 7;
        if (F.tid() < 96) { const int v = rg * 96 + F.tid(); const int bb = v / (6 * DM), col = v % (6 * DM); float s = F.f(4)[col];
#pragma unroll
            for (int ks = 0; ks < 16; ++ks) s += modp[((size_t)ks * 2 + bb) * (6 * DM) + col];
            modf[v] = s; }
        { const int col = F.tid() * 4; f32x4 s0 = *(const f32x4*)(F.f(4) + col), s1 = *(const f32x4*)(F.f(4) + DM + col);
#pragma unroll
          for (int ks = 0; ks < 16; ++ks) { const float* p = modp + ((size_t)ks * 2 + b) * (6 * DM); s0 += *(const f32x4*)(p + col); s1 += *(const f32x4*)(p + DM + col); }
          *(LAS f32x4*)(sh + col) = s0; *(LAS f32x4*)(sc + col) = s1; }
        __syncthreads();
#pragma unroll
        for (int rr = 0; rr < 4; ++rr) { const int row = rg * 32 + F.wave() * 4 + rr;
#pragma unroll
            for (int j = 0; j < 8; ++j) { const int col = j * 256 + F.lane() * 4;
                const f32x4 xv = *(const f32x4*)(F.f(0) + (size_t)row * DM + col); const f32x4 s0 = *(const LAS f32x4*)(sh + col), s1 = *(const LAS f32x4*)(sc + col);
                const f32x4 u = xv * (s1 + 1.0f) + s0;
                u32x2 o = {cvt_pk_bf16(u[0], u[1]), cvt_pk_bf16(u[2], u[3])};
                *(u32x2*)(u1 + (size_t)row * DM + col) = o; } }
        __syncthreads();
    }
}
struct EpiInProj {
    static constexpr bool PERM = true;
    unsigned char* ws; const float *dt_bias, *lng, *lnb;
    __device__ __forceinline__ void operator()(const f32x4 (&acc)[2][2][4][2], const pg8::Unit& u, int wr, int wc, int fr, int fq) const {
        const int pn = u.pn; const int row0 = u.pm * 256 + wr * 64 + fr;
        if (pn < 10 || (pn >= 18 && pn < 22)) {
            size_t boff; int ld, col0;
            if (pn < 4) { boff = WS_Z; ld = 1024; col0 = pn * 256; } else if (pn < 10) { boff = WS_XBC; ld = CONV_CH; col0 = (pn - 4) * 256; } else { boff = WS_V; ld = 1024; col0 = (pn - 18) * 256; }
            bf16* base = (bf16*)(ws + boff);
            col0 += wc * 32 + 8 * fq;
#pragma unroll
            for (int ai = 0; ai < 2; ++ai)
#pragma unroll
                for (int m = 0; m < 4; ++m) { bf16* rowp = base + (size_t)(row0 + ai * 128 + m * 16) * ld + col0;
#pragma unroll
                    for (int bj = 0; bj < 2; ++bj) { const f32x4 v0 = acc[ai][bj][m][0], v1 = acc[ai][bj][m][1];
                        u32x4 w = {cvt_pk_bf16(v0[0], v0[1]), cvt_pk_bf16(v0[2], v0[3]), cvt_pk_bf16(v1[0], v1[1]), cvt_pk_bf16(v1[2], v1[3])};
                        *(u32x4*)(rowp + bj * 128) = w; } }
        } else if (pn < 26) {
            const bool att = pn < 18; const bool isq = pn < 14;
            bf16* base = (bf16*)(ws + (att ? (isq ? WS_Q : WS_K) : WS_QIDX)); const float* ct = (const float*)(ws + (att ? WS_COSA : WS_COSI)); const float* sn = (const float*)(ws + (att ? WS_SINA : WS_SINI));
            const int tw = att ? 64 : 32;
            const int head = att ? 2 * (pn - (isq ? 10 : 14)) + (wc >> 1) : 4 * (pn - 22) + wc, jj0 = att ? 32 * (wc & 1) + 8 * fq : 8 * fq;
#pragma unroll
            for (int ai = 0; ai < 2; ++ai)
#pragma unroll
                for (int m = 0; m < 4; ++m) { const int row = row0 + ai * 128 + m * 16;
                    bf16* rowp = base + (size_t)row * 1024 + head * (2 * tw) + jj0;
#pragma unroll
                    for (int n = 0; n < 2; ++n) { const f32x4 c = *(const f32x4*)(ct + (size_t)row * tw + jj0 + 4 * n), sv = *(const f32x4*)(sn + (size_t)row * tw + jj0 + 4 * n);
                        const f32x4 a = acc[ai][0][m][n], bb = acc[ai][1][m][n];
                        const f32x4 o1 = a * c - bb * sv, o2 = bb * c + a * sv;
                        *(u32x2*)(rowp + 4 * n) = (u32x2){cvt_pk_bf16(o1[0], o1[1]), cvt_pk_bf16(o1[2], o1[3])};
                        *(u32x2*)(rowp + tw + 4 * n) = (u32x2){cvt_pk_bf16(o2[0], o2[1]), cvt_pk_bf16(o2[2], o2[3])}; } }
        } else {
            const float* cosI = (const float*)(ws + WS_COSI); const float* sinI = (const float*)(ws + WS_SINI); bf16* kidx = (bf16*)(ws + WS_KIDX); float* widx = (float*)(ws + WS_WIDX); float* dt = (float*)(ws + WS_DT);
            if (wc == 0) {
                const int jj0 = 8 * fq;
#pragma unroll
                for (int am = 0; am < 8; ++am) { const int ai = am >> 2, m = am & 3; const int row = row0 + ai * 128 + m * 16;
                        f32x4 a0 = acc[ai][0][m][0], a1 = acc[ai][0][m][1], b0 = acc[ai][1][m][0], b1 = acc[ai][1][m][1];
                        float s = (a0[0] + a0[1] + a0[2] + a0[3]) + (a1[0] + a1[1] + a1[2] + a1[3]) + (b0[0] + b0[1] + b0[2] + b0[3]) + (b1[0] + b1[1] + b1[2] + b1[3]);
                        s += __shfl_xor(s, 16); s += __shfl_xor(s, 32);
                        const float mu = s * (1.0f / 64.0f);
                        a0 = a0 - mu; a1 = a1 - mu; b0 = b0 - mu; b1 = b1 - mu;
                        float qv = (a0[0] * a0[0] + a0[1] * a0[1] + a0[2] * a0[2] + a0[3] * a0[3]) + (a1[0] * a1[0] + a1[1] * a1[1] + a1[2] * a1[2] + a1[3] * a1[3])
                                 + (b0[0] * b0[0] + b0[1] * b0[1] + b0[2] * b0[2] + b0[3] * b0[3]) + (b1[0] * b1[0] + b1[1] * b1[1] + b1[2] * b1[2] + b1[3] * b1[3]);
                        qv += __shfl_xor(qv, 16); qv += __shfl_xor(qv, 32);
                        const float rstd = 1.0f / sqrtf(qv * (1.0f / 64.0f) + LN_EPS);
                        a0 = a0 * rstd * *(const f32x4*)(lng + jj0) + *(const f32x4*)(lnb + jj0); a1 = a1 * rstd * *(const f32x4*)(lng + jj0 + 4) + *(const f32x4*)(lnb + jj0 + 4);
                        b0 = b0 * rstd * *(const f32x4*)(lng + 32 + jj0) + *(const f32x4*)(lnb + 32 + jj0); b1 = b1 * rstd * *(const f32x4*)(lng + 36 + jj0) + *(const f32x4*)(lnb + 36 + jj0);
                        const f32x4 c0 = *(const f32x4*)(cosI + (size_t)row * 32 + jj0), c1 = *(const f32x4*)(cosI + (size_t)row * 32 + jj0 + 4);
                        const f32x4 s0 = *(const f32x4*)(sinI + (size_t)row * 32 + jj0), s1 = *(const f32x4*)(sinI + (size_t)row * 32 + jj0 + 4);
                        const f32x4 o10 = a0 * c0 - b0 * s0, o11 = a1 * c1 - b1 * s1, o20 = b0 * c0 + a0 * s0, o21 = b1 * c1 + a1 * s1;
                        bf16* rowp = kidx + (size_t)row * 64 + jj0;
                        u32x4 w1 = {cvt_pk_bf16(o10[0], o10[1]), cvt_pk_bf16(o10[2], o10[3]), cvt_pk_bf16(o11[0], o11[1]), cvt_pk_bf16(o11[2], o11[3])};
                        u32x4 w2 = {cvt_pk_bf16(o20[0], o20[1]), cvt_pk_bf16(o20[2], o20[3]), cvt_pk_bf16(o21[0], o21[1]), cvt_pk_bf16(o21[2], o21[3])};
                        *(u32x4*)rowp = w1; *(u32x4*)(rowp + 32) = w2; }
            } else if (wc == 1) {
                const int h0 = 8 * (fq & 1);
                const f32x4 db0 = *(const f32x4*)(dt_bias + h0), db1 = *(const f32x4*)(dt_bias + h0 + 4);
#pragma unroll
                for (int ai = 0; ai < 2; ++ai)
#pragma unroll
                    for (int m = 0; m < 4; ++m) { const int row = row0 + ai * 128 + m * 16;
                        const f32x4 a0 = acc[ai][0][m][0], a1 = acc[ai][0][m][1];
                        if (fq < 2) { *(f32x4*)(widx + (size_t)row * 16 + h0) = a0 * 0.03125f; *(f32x4*)(widx + (size_t)row * 16 + h0 + 4) = a1 * 0.03125f; }
                        else { f32x4 d0 = a0 + db0, d1 = a1 + db1;
#pragma unroll
                            for (int i = 0; i < 4; ++i) { d0[i] = d0[i] > 20.f ? d0[i] : log1pf(__expf(d0[i])); d1[i] = d1[i] > 20.f ? d1[i] : log1pf(__expf(d1[i])); }
                            *(f32x4*)(dt + (size_t)row * 16 + h0) = d0; *(f32x4*)(dt + (size_t)row * 16 + h0 + 4) = d1; } }
            }
        }
    }
};
__device__ __forceinline__ void idx_unit(Frame& F, int b, int qi, int ki) {
    const bf16* kidx = WSP(const bf16, WS_KIDX); const bf16* qidx = WSP(const bf16, WS_QIDX); const float* widx = WSP(const float, WS_WIDX); float* scores = WSP(float, WS_SCORES);
    const int lane = F.lane(), r32 = lane & 31, hi = lane >> 5, wq = F.wave() & 3, wk = F.wave() >> 2;
    const int kt0 = b * SEQ + ki * 128 + wk * 64, qtok = b * SEQ + qi * 128 + wq * 32 + r32;
    bf16x8 A[2][4];
#pragma unroll
    for (int kt = 0; kt < 2; ++kt)
#pragma unroll
        for (int ks = 0; ks < 4; ++ks) A[kt][ks] = *(const bf16x8*)(kidx + (size_t)(kt0 + kt * 32 + r32) * 64 + ks * 16 + hi * 8);
    f32x16 o0 = {}, o1 = {};
    const bf16* qrow = qidx + (size_t)qtok * 1024 + hi * 8;
#pragma unroll 1
    for (int h = 0; h < 16; ++h) { const float w = widx[(size_t)qtok * 16 + h];
        bf16x8 Bq[4];
#pragma unroll
        for (int ks = 0; ks < 4; ++ks) Bq[ks] = *(const bf16x8*)(qrow + h * 64 + ks * 16);
        f32x16 a0 = {}, a1 = {};
#pragma unroll
        for (int ks = 0; ks < 4; ++ks) { a0 = __builtin_amdgcn_mfma_f32_32x32x16_bf16(A[0][ks], Bq[ks], a0, 0, 0, 0); a1 = __builtin_amdgcn_mfma_f32_32x32x16_bf16(A[1][ks], Bq[ks], a1, 0, 0, 0); }
#pragma unroll
        for (int r = 0; r < 16; ++r) { o0[r] += w * fmaxf(a0[r], 0.f); o1[r] += w * fmaxf(a1[r], 0.f); } }
    LAS float* st = (LAS float*)(F.lds() + F.wave() * 8320);
    const int qpos = qi * 128 + wq * 32 + r32, kpos0 = ki * 128 + wk * 64;
    const float NEG = -__builtin_inff();
#pragma unroll
    for (int r = 0; r < 16; ++r) { const int kk = crow(r, hi);
        st[r32 * 65 + kk] = (kpos0 + kk > qpos) ? NEG : o0[r];
        st[r32 * 65 + 32 + kk] = (kpos0 + 32 + kk > qpos) ? NEG : o1[r]; }
    LDS_WAIT(); asm volatile("" ::: "memory");
    float* dst = scores + (size_t)(b * SEQ + qi * 128 + wq * 32) * SEQ + kpos0 + lane;
#pragma unroll 4
    for (int q = 0; q < 32; ++q) { *dst = st[q * 65 + lane]; dst += SEQ; }
    LDS_WAIT(); asm volatile("" ::: "memory");
}

constexpr int SA_P = 136;
constexpr int SA_BN = 0, SA_CN = 34816, SA_BT = 69632, SA_CB = 104448, SA_SM = 139264;
__device__ __forceinline__ void conv8(const bf16* xraw_row  , int tpos, const float* cw, const float* cb, float (&o)[8]) {
    const f32x4 b0 = *(const f32x4*)cb, b1 = *(const f32x4*)(cb + 4);
#pragma unroll
    for (int j = 0; j < 4; ++j) { o[j] = b0[j]; o[4 + j] = b1[j]; }
#pragma unroll
    for (int k = 0; k < 4; ++k) { const int dt_ = k - 3;
        if (tpos + dt_ >= 0) { const bf16x8 xv = *(const bf16x8*)(xraw_row + (long)dt_ * CONV_CH); float xf[8]; unpack8(xv, xf);
            const f32x4 w0 = *(const f32x4*)(cw + k * CONV_CH), w1 = *(const f32x4*)(cw + k * CONV_CH + 4);
#pragma unroll
            for (int j = 0; j < 4; ++j) { o[j] += w0[j] * xf[j]; o[4 + j] += w1[j] * xf[4 + j]; } } }
#pragma unroll
    for (int j = 0; j < 8; ++j) o[j] = silu_f(o[j]);
}
__device__ __forceinline__ void ssd_a_unit(Frame& F, int b, int c, int g, int hf) {
    const bf16* xbc = WSP(const bf16, WS_XBC); bf16* xact = WSP(bf16, WS_XBCACT); const float* dtg = WSP(const float, WS_DT); float* csg = WSP(float, WS_CS);
    float* ydiag = WSP(float, WS_YDIAG); float* states = WSP(float, WS_STATES);
    LAS bf16* Bn = (LAS bf16*)(F.lds() + SA_BN); LAS bf16* Cn = (LAS bf16*)(F.lds() + SA_CN); LAS bf16* BT = (LAS bf16*)(F.lds() + SA_BT); LAS bf16* CB = (LAS bf16*)(F.lds() + SA_CB);
    const int lane = F.lane(), r32 = lane & 31, hi = lane >> 5, w = F.wave();
    const int tok0 = b * SEQ + c * CHUNK;
#pragma unroll 2
    for (int i = 0; i < 8; ++i) { const int id = F.tid() + 512 * i, mi = id >> 11, rem = id & 2047, s = rem >> 4, ch = rem & 15;
        const int chan = 1024 + mi * 256 + g * 128 + ch * 8; float o[8];
        conv8(xbc + (size_t)(tok0 + s) * CONV_CH + chan, c * CHUNK + s, F.f(6) + chan, F.f(7) + chan, o);
        u32x4 pk = {cvt_pk_bf16(o[0], o[1]), cvt_pk_bf16(o[2], o[3]), cvt_pk_bf16(o[4], o[5]), cvt_pk_bf16(o[6], o[7])};
        if (mi == 0) { *(LAS u32x4*)(Bn + s * SA_P + ch * 8) = pk;
#pragma unroll
            for (int j = 0; j < 8; ++j) BT[(ch * 8 + j) * SA_P + s] = (bf16)((pk[j >> 1] >> (16 * (j & 1))) & 0xffffu); }
        else { *(LAS u32x4*)(Cn + s * SA_P + ch * 8) = pk; if (hf == 0) *(u32x4*)(xact + (size_t)(tok0 + s) * CONV_CH + chan) = pk; } }
    __syncthreads();
    { const int lt = w >> 1;
#pragma unroll
      for (int sq = 0; sq < 2; ++sq) { const int st = 2 * (w & 1) + sq; f32x16 a = {};
#pragma unroll
          for (int ks = 0; ks < 8; ++ks) { const bf16x8 av = *(const LAS bf16x8*)(Cn + (32 * lt + r32) * SA_P + 16 * ks + 8 * hi), bv = *(const LAS bf16x8*)(Bn + (32 * st + r32) * SA_P + 16 * ks + 8 * hi);
              a = __builtin_amdgcn_mfma_f32_32x32x16_bf16(av, bv, a, 0, 0, 0); }
#pragma unroll
          for (int r = 0; r < 16; ++r) CB[(32 * lt + crow(r, hi)) * SA_P + 32 * st + r32] = f2bf(a[r]); } }
    __syncthreads();
    const int j = w >> 1, sub = w & 1, h = 8 * g + 4 * hf + j;
    LAS bf16* XT = (LAS bf16*)(F.lds() + j * 17408);
    LAS float* cs_l = (LAS float*)(F.lds() + SA_SM) + j * 384; LAS float* wdec = cs_l + 128;
    {
        const float ah = -__expf(F.f(9)[h]);
        const float d0 = dtg[(size_t)(tok0 + lane) * 16 + h], d1 = dtg[(size_t)(tok0 + 64 + lane) * 16 + h];
        float c0 = d0 * ah, c1 = d1 * ah;
#pragma unroll
        for (int o = 1; o < 64; o <<= 1) { const float t0 = __shfl_up(c0, o), t1 = __shfl_up(c1, o); if (lane >= o) { c0 += t0; c1 += t1; } }
        const float tot0 = __shfl(c0, 63); c1 += tot0; const float cend = __shfl(c1, 63);
        if (sub == 0) { cs_l[lane] = c0; cs_l[64 + lane] = c1; wdec[lane] = __expf(cend - c0); wdec[64 + lane] = __expf(cend - c1);
            csg[(size_t)(tok0 + lane) * 16 + h] = c0; csg[(size_t)(tok0 + 64 + lane) * 16 + h] = c1; }
#pragma unroll 2
        for (int i = 0; i < 8; ++i) { const int id = lane + 64 * i, s = 64 * sub + (id >> 3), ch = id & 7, chan = h * 64 + ch * 8; float o[8];
            conv8(xbc + (size_t)(tok0 + s) * CONV_CH + chan, c * CHUNK + s, F.f(6) + chan, F.f(7) + chan, o);
            u32x4 pk = {cvt_pk_bf16(o[0], o[1]), cvt_pk_bf16(o[2], o[3]), cvt_pk_bf16(o[4], o[5]), cvt_pk_bf16(o[6], o[7])};
            *(u32x4*)(xact + (size_t)(tok0 + s) * CONV_CH + chan) = pk;
            const float dts = dtg[(size_t)(tok0 + s) * 16 + h];
#pragma unroll
            for (int jj = 0; jj < 8; ++jj) XT[(ch * 8 + jj) * SA_P + s] = f2bf(o[jj] * dts); }
    }
    __syncthreads();
#pragma unroll
    for (int lq = 0; lq < 2; ++lq) { const int lt = 2 * sub + lq; const int l = 32 * lt + r32; const float csl = cs_l[l];
        f32x16 a0 = {}, a1 = {};
        for (int ks = 0; ks <= 2 * lt + 1; ++ks) { const int s0 = 16 * ks + 8 * hi;
            float cbf[8]; unpack8(*(const LAS bf16x8*)(CB + l * SA_P + s0), cbf);
            const f32x4 q0 = *(const LAS f32x4*)(cs_l + s0), q1 = *(const LAS f32x4*)(cs_l + s0 + 4);
            float mv[8];
#pragma unroll
            for (int jj = 0; jj < 8; ++jj) { const float cq = jj < 4 ? q0[jj & 3] : q1[jj & 3]; mv[jj] = (s0 + jj <= l) ? cbf[jj] * __expf(csl - cq) : 0.f; }
            const bf16x8 av = pack8((f32x4){mv[0], mv[1], mv[2], mv[3]}, (f32x4){mv[4], mv[5], mv[6], mv[7]});
            const bf16x8 b0 = *(const LAS bf16x8*)(XT + r32 * SA_P + s0), b1 = *(const LAS bf16x8*)(XT + (32 + r32) * SA_P + s0);
            a0 = __builtin_amdgcn_mfma_f32_32x32x16_bf16(av, b0, a0, 0, 0, 0); a1 = __builtin_amdgcn_mfma_f32_32x32x16_bf16(av, b1, a1, 0, 0, 0); }
#pragma unroll
        for (int r = 0; r < 16; ++r) { float* yp = ydiag + (size_t)(tok0 + 32 * lt + crow(r, hi)) * D_SSM + h * 64 + r32; yp[0] = a0[r]; yp[32] = a1[r]; } }
    { f32x16 a[2][2] = {};
      for (int ks = 0; ks < 8; ++ks) { const int s0 = 16 * ks + 8 * hi;
          const f32x4 q0 = *(const LAS f32x4*)(wdec + s0), q1 = *(const LAS f32x4*)(wdec + s0 + 4);
          bf16x8 av[2];
#pragma unroll
          for (int pt = 0; pt < 2; ++pt) { float xf[8]; unpack8(*(const LAS bf16x8*)(XT + (32 * pt + r32) * SA_P + s0), xf);
              av[pt] = pack8((f32x4){xf[0] * q0[0], xf[1] * q0[1], xf[2] * q0[2], xf[3] * q0[3]}, (f32x4){xf[4] * q1[0], xf[5] * q1[1], xf[6] * q1[2], xf[7] * q1[3]}); }
#pragma unroll
          for (int nq = 0; nq < 2; ++nq) { const bf16x8 bv = *(const LAS bf16x8*)(BT + (32 * (2 * sub + nq) + r32) * SA_P + s0);
#pragma unroll
              for (int pt = 0; pt < 2; ++pt) a[pt][nq] = __builtin_amdgcn_mfma_f32_32x32x16_bf16(av[pt], bv, a[pt][nq], 0, 0, 0); } }
      float* sp = states + ((size_t)((b * NCHUNK + c) * SSM_H + h) * SSM_P) * SSM_N;
#pragma unroll
      for (int pt = 0; pt < 2; ++pt)
#pragma unroll
          for (int nq = 0; nq < 2; ++nq)
#pragma unroll
              for (int r = 0; r < 16; ++r) sp[(size_t)(32 * pt + crow(r, hi)) * SSM_N + 32 * (2 * sub + nq) + r32] = a[pt][nq][r]; }
    __syncthreads();
}
__device__ __forceinline__ void p3_phase(Frame& F) {
    constexpr int N_SSD = NBATCH * NCHUNK * 2 * 2, N_IDX = NBATCH * 528;
    int L = F.bid();
#pragma unroll 1
    for (; L < N_SSD; L += F.G()) { const int hf = L & 1, g = (L >> 1) & 1, c = (L >> 2) & 31, b = L >> 7; ssd_a_unit(F, b, c, g, hf); }
#pragma unroll 1
    for (; L < N_SSD + N_IDX; L += F.G()) { const int p0 = L - N_SSD, b = p0 / 528, p = p0 % 528;
        int qi = (int)((sqrtf(8.f * (float)p + 1.f) - 1.f) * 0.5f);
        while (qi * (qi + 1) / 2 > p) --qi;
        while ((qi + 1) * (qi + 2) / 2 <= p) ++qi;
        idx_unit(F, b, qi, p - qi * (qi + 1) / 2); }
}
__device__ __forceinline__ unsigned fkey(float f) { const unsigned u = __float_as_uint(f); return (u & 0x80000000u) ? ~u : (u | 0x80000000u); }
__device__ __forceinline__ void select_row(Frame& F, int row, LAS unsigned* hist, LAS unsigned* keys) {
    const float* sc = WSP(const float, WS_SCORES) + (size_t)row * SEQ; unsigned long long* mrow = WSP(unsigned long long, WS_MASK) + (size_t)row * 64;
    const int lane = F.lane(), t = row & (SEQ - 1);
    if (t < TOPK_SEL) {
        const int lo = 64 * lane; unsigned long long m;
        if (lo + 63 <= t) m = ~0ull; else if (lo > t) m = 0ull; else m = (1ull << (t - lo + 1)) - 1ull;
        mrow[lane] = m; return;
    }
    const int nI = (t >> 6) + 1;
#pragma unroll 8
    for (int i = 0; i < nI; ++i) { const int e = 64 * i + lane; float v = 0.f; if (e <= t) v = sc[e]; keys[e] = (e <= t) ? fkey(v) : 0u; }
    unsigned prefix = 0u, need = TOPK_SEL, pmask = 0u, cnt_eq = 0u;
#pragma unroll 1
    for (int pass = 0; pass < 4; ++pass) { const int shift = 24 - 8 * pass;
        hist[4 * lane] = 0u; hist[4 * lane + 1] = 0u; hist[4 * lane + 2] = 0u; hist[4 * lane + 3] = 0u;
        LDS_WAIT(); asm volatile("" ::: "memory");
#pragma unroll 4
        for (int i = 0; i < nI; ++i) { const unsigned k = keys[64 * i + lane]; if ((k & pmask) == prefix && k != 0u) __hip_atomic_fetch_add(hist + ((k >> shift) & 255u), 1u, __ATOMIC_RELAXED, __HIP_MEMORY_SCOPE_WORKGROUP); }
        LDS_WAIT(); asm volatile("" ::: "memory");
        const unsigned c0 = hist[4 * lane], c1 = hist[4 * lane + 1], c2 = hist[4 * lane + 2], c3 = hist[4 * lane + 3];
        const unsigned tot = c0 + c1 + c2 + c3;
        unsigned suf = tot;
#pragma unroll
        for (int o = 1; o < 64; o <<= 1) { const unsigned tt = __shfl_down(suf, o); if (lane + o < 64) suf += tt; }
        unsigned above = suf - tot;
        int found = -1; unsigned nneed = 0u, fcnt = 0u;
        if (above < need && need <= above + c3) { found = 3; nneed = need - above; fcnt = c3; }
        above += c3;
        if (found < 0 && above < need && need <= above + c2) { found = 2; nneed = need - above; fcnt = c2; }
        above += c2;
        if (found < 0 && above < need && need <= above + c1) { found = 1; nneed = need - above; fcnt = c1; }
        above += c1;
        if (found < 0 && above < need && need <= above + c0) { found = 0; nneed = need - above; fcnt = c0; }
        const unsigned long long bal = __ballot(found >= 0);
        const int src = (int)__builtin_ctzll(bal | (1ull << 63));
        const unsigned digit = (unsigned)__shfl(4 * lane + found, src);
        need = (unsigned)__shfl((int)nneed, src); cnt_eq = (unsigned)__shfl((int)fcnt, src);
        prefix |= digit << shift; pmask |= 255u << shift;
        LDS_WAIT(); asm volatile("" ::: "memory");
    }
    const bool all_eq = (cnt_eq == need);
    unsigned run = 0u; unsigned long long myword = 0ull;
    const unsigned long long lt_mask = (lane == 0) ? 0ull : (~0ull >> (64 - lane));
#pragma unroll 4
    for (int i = 0; i < nI; ++i) {
        const unsigned k = keys[64 * i + lane]; bool sel = k > prefix;
        if (all_eq) { sel = sel || (k == prefix); }
        else { const unsigned long long em = __ballot(k == prefix); if (k == prefix) sel = (run + (unsigned)__popcll(em & lt_mask)) < need; run += (unsigned)__popcll(em); }
        const unsigned long long wb = __ballot(sel);
        if (lane == i) myword = wb;
    }
    mrow[lane] = myword;
    LDS_WAIT(); asm volatile("" ::: "memory");
}
__device__ __forceinline__ void p4_select(Frame& F) {
    LAS unsigned* keys = (LAS unsigned*)(F.lds() + F.wave() * 16384); LAS unsigned* hist = (LAS unsigned*)(F.lds() + 131072 + F.wave() * 1024);
    const int gw = F.bid() * 8 + F.wave(), NGW = F.G() * 8;
    for (int pr = gw; pr < SEQ / 2; pr += NGW) {
#pragma unroll 1
        for (int b = 0; b < NBATCH; ++b) { select_row(F, b * SEQ + pr, hist, keys); select_row(F, b * SEQ + (SEQ - 1 - pr), hist, keys); }
    }
}
__device__ __forceinline__ void p4_scan(Frame& F) {
    const float* states = WSP(const float, WS_STATES); bf16* hin = WSP(bf16, WS_HIN); const float* csg = WSP(const float, WS_CS);
    const int gt = F.bid() * 512 + F.tid(), NGT = F.G() * 512;
    for (int q = gt; q < NBATCH * SSM_H * SSM_P * (SSM_N / 2); q += NGT) {
        const int n = 2 * (q & 63), p = (q >> 6) & 63, h = (q >> 12) & 15, b = q >> 16;
        float h0 = 0.f, h1 = 0.f;
#pragma unroll 8
        for (int c = 0; c < NCHUNK; ++c) {
            const size_t off = ((size_t)((b * NCHUNK + c) * SSM_H + h) * SSM_P + p) * SSM_N + n;
            *(unsigned*)(hin + off) = cvt_pk_bf16(h0, h1);
            const float dec = __expf(csg[(size_t)(b * SEQ + c * CHUNK + CHUNK - 1) * 16 + h]);
            const f32x2 st = *(const f32x2*)(states + off);
            h0 = dec * h0 + st[0]; h1 = dec * h1 + st[1];
        }
    }
}
namespace att {
constexpr int KVBLK = 64, SHM_K = KVBLK * 128 * 2, SHM_V = SHM_K;
constexpr float SCALE = 0.08838834764831845f, THR = 8.f, C2 = 1.4426950408889634f * SCALE;
#define KSWZ(row, colB) ((row) * 256 + ((colB) ^ (((row) & 7) << 4)))
__device__ __forceinline__ int v_st(int k, int c) { const int kk = (k & ~0xC) | ((k & 4) << 1) | ((k & 8) >> 1); return ((kk >> 3) * 4 + (c >> 5)) * 512 + ((kk & 7) * 32 + (c & 31)) * 2; }
__device__ __forceinline__ int v_rd_base(int lane) { return ((lane & 3) << 3) | (((lane >> 2) & 3) << 6) | (((lane >> 4) & 1) << 5) | (((lane >> 5) & 1) << 8); }
constexpr int v_rd_off(int d0, int ks, int half) { return d0 * 512 + ks * 4096 + half * 2048; }
template <int KB>
__device__ __forceinline__ void qkt(f32x16& p0, f32x16& p1, LAS const char* K_lds, int r32, int hi, const bf16x8* qr) {
    p0 = f32x16{}; p1 = f32x16{};
    LAS const char* kb[4];
#pragma unroll
    for (int dd = 0; dd < 4; ++dd) kb[dd] = K_lds + KB * SHM_K + KSWZ(r32, (dd * 16 + hi * 8) * 2);
#pragma unroll
    for (int d0 = 0; d0 < 8; ++d0) { LAS const char* a = kb[d0 & 3] + (d0 >> 2) * 128;
        const bf16x8 b0 = *(LAS const bf16x8*)a;
        const bf16x8 b1 = *(LAS const bf16x8*)(a + 32 * 256);
        p0 = __builtin_amdgcn_mfma_f32_32x32x16_bf16(b0, qr[d0], p0, 0, 0, 0);
        p1 = __builtin_amdgcn_mfma_f32_32x32x16_bf16(b1, qr[d0], p1, 0, 0, 0); }
}
template <int VB>
__device__ __forceinline__ void pv_tile(f32x16* o, int vb0, bf16x8 pa0, bf16x8 pa1, bf16x8 pa2, bf16x8 pa3) {
#define TRRD(dst, off) asm volatile("ds_read_b64_tr_b16 %0, %1 offset:%2" : "=&v"(dst) : "v"(vb0), "i"(off) : "memory")
#define PV_D0(d0) do { s16x4 l0, l1, l2, l3, h0, h1, h2, h3; constexpr int b_ = VB * SHM_V + v_rd_off(d0, 0, 0); \
        TRRD(l0, b_); TRRD(h0, b_ + 2048); TRRD(l1, b_ + 4096); TRRD(h1, b_ + 6144); TRRD(l2, b_ + 8192); TRRD(h2, b_ + 10240); TRRD(l3, b_ + 12288); TRRD(h3, b_ + 14336); \
        asm volatile("s_waitcnt lgkmcnt(0)" ::: "memory"); __builtin_amdgcn_sched_barrier(0); \
        o[d0] = __builtin_amdgcn_mfma_f32_32x32x16_bf16(pa0, (bf16x8){l0[0], l0[1], l0[2], l0[3], h0[0], h0[1], h0[2], h0[3]}, o[d0], 0, 0, 0);   \
        o[d0] = __builtin_amdgcn_mfma_f32_32x32x16_bf16(pa1, (bf16x8){l1[0], l1[1], l1[2], l1[3], h1[0], h1[1], h1[2], h1[3]}, o[d0], 0, 0, 0);   \
        o[d0] = __builtin_amdgcn_mfma_f32_32x32x16_bf16(pa2, (bf16x8){l2[0], l2[1], l2[2], l2[3], h2[0], h2[1], h2[2], h2[3]}, o[d0], 0, 0, 0);   \
        o[d0] = __builtin_amdgcn_mfma_f32_32x32x16_bf16(pa3, (bf16x8){l3[0], l3[1], l3[2], l3[3], h3[0], h3[1], h3[2], h3[3]}, o[d0], 0, 0, 0); } while (0)
    PV_D0(0); PV_D0(1); PV_D0(2); PV_D0(3);
#undef PV_D0
#undef TRRD
}
__device__ __forceinline__ void softmax_tile(f32x16& p0, f32x16& p1, unsigned long long mw, int hi, float& m_reg, float& l_reg, float& alpha, bf16x8& pa0, bf16x8& pa1, bf16x8& pa2, bf16x8& pa3) {
    float pmax = p0[0];
#pragma unroll
    for (int r = 1; r < 16; ++r) pmax = fmaxf(pmax, p0[r]);
#pragma unroll
    for (int r = 0; r < 16; ++r) pmax = fmaxf(pmax, p1[r]);
    { auto rr = __builtin_amdgcn_permlane32_swap(__float_as_uint(pmax), __float_as_uint(pmax), false, false); pmax = fmaxf(__uint_as_float(rr[0]), __uint_as_float(rr[1])); }
    float mn;
    if (__all((pmax - m_reg) * SCALE <= THR)) { mn = m_reg; alpha = 1.f; }
    else { mn = fmaxf(m_reg, pmax); alpha = __builtin_amdgcn_exp2f((m_reg - mn) * C2); m_reg = mn; }
    const float mnL = -mn * C2;
    const int lo = (int)((unsigned)mw >> (4 * hi)), hh = (int)((unsigned)(mw >> 32) >> (4 * hi));
#pragma unroll
    for (int r = 0; r < 16; ++r) { const int c = (r & 3) + 8 * (r >> 2);
        const float e0 = __builtin_amdgcn_exp2f(fmaf(p0[r], C2, mnL)), e1 = __builtin_amdgcn_exp2f(fmaf(p1[r], C2, mnL));
        p0[r] = __uint_as_float(__float_as_uint(e0) & (unsigned)__builtin_amdgcn_sbfe(lo, c, 1));
        p1[r] = __uint_as_float(__float_as_uint(e1) & (unsigned)__builtin_amdgcn_sbfe(hh, c, 1)); }
    float ps = 0.f;
#pragma unroll
    for (int r = 0; r < 16; ++r) ps += p0[r];
#pragma unroll
    for (int r = 0; r < 16; ++r) ps += p1[r];
    { auto rr = __builtin_amdgcn_permlane32_swap(__float_as_uint(ps), __float_as_uint(ps), false, false); ps = __uint_as_float(rr[0]) + __uint_as_float(rr[1]); }
    l_reg = l_reg * alpha + ps;
#define PK4(P, B_, OUT) do { unsigned a0 = cvt_pk_bf16(P[B_+0], P[B_+1]), a1 = cvt_pk_bf16(P[B_+2], P[B_+3]); \
        unsigned b0 = cvt_pk_bf16(P[B_+4], P[B_+5]), b1 = cvt_pk_bf16(P[B_+6], P[B_+7]); \
        auto r0 = __builtin_amdgcn_permlane32_swap(a0, b0, false, false); auto r1 = __builtin_amdgcn_permlane32_swap(a1, b1, false, false); \
        u32x4 w = {r0[0], r1[0], r0[1], r1[1]}; OUT = __builtin_bit_cast(bf16x8, w); } while (0)
    PK4(p0, 0, pa0); PK4(p0, 8, pa1); PK4(p1, 0, pa2); PK4(p1, 8, pa3);
#undef PK4
}
}

__device__ __forceinline__ void attn_item(Frame& F, int b, int h, int X) {
    using namespace att;
    const bf16* qg = WSP(const bf16, WS_Q); const bf16* kg = WSP(const bf16, WS_K) + (size_t)(b * SEQ) * 1024 + h * 128; const bf16* vg = WSP(const bf16, WS_V) + (size_t)(b * SEQ) * 1024 + h * 128;
    const unsigned long long* maskg = WSP(const unsigned long long, WS_MASK); bf16* ycat = WSP(bf16, WS_YCAT);
    const int tid = F.tid(), wid = F.wave(), lane = F.lane(), r32 = lane & 31, hi = lane >> 5;
    LAS char* V_lds = (LAS char*)F.lds(); LAS char* K_lds = V_lds + 2 * SHM_V;
    LAS float* wsl = (LAS float*)(F.lds() + 2 * SHM_V + 2 * SHM_K) + wid * 64; LAS float* li_l = wsl; LAS float* al_l = wsl + 32;
    const int tokq = b * SEQ + X * 256 + wid * 32 + r32, NT = 4 * X + 4;
    bf16x8 qr[8];
#pragma unroll
    for (int d0 = 0; d0 < 8; ++d0) qr[d0] = *(const bf16x8*)(qg + (size_t)tokq * 1024 + h * 128 + d0 * 16 + hi * 8);
    const unsigned long long* mrow = maskg + (size_t)tokq * 64;
    const int sr = tid >> 4, sc = (tid & 15) * 8, vst0 = v_st(sr, sc), vst1 = v_st(32 + sr, sc), kws = KSWZ(sr, sc * 2);
    const int vb0 = (int)(unsigned)(uintptr_t)V_lds + v_rd_base(lane);
    float m_reg = -1e30f, l_reg = 0.f; f32x16 o[4] = {};
    bf16x8 st_k0, st_k1, st_v0, st_v1;
#define ALOAD(t) do { const size_t r0_ = (size_t)((t) * KVBLK + sr) * 1024 + sc; st_k0 = *(const bf16x8*)(kg + r0_); st_k1 = *(const bf16x8*)(kg + r0_ + 32 * 1024); \
                      st_v0 = *(const bf16x8*)(vg + r0_); st_v1 = *(const bf16x8*)(vg + r0_ + 32 * 1024); } while (0)
#define AWRITE(bf) do { *(LAS bf16x8*)(K_lds + (bf) * SHM_K + kws) = st_k0; *(LAS bf16x8*)(K_lds + (bf) * SHM_K + kws + 32 * 256) = st_k1; \
                        *(LAS bf16x8*)(V_lds + (bf) * SHM_V + vst0) = st_v0; *(LAS bf16x8*)(V_lds + (bf) * SHM_V + vst1) = st_v1; } while (0)
#define ASTEP(t, KB) do { AWRITE(KB); __syncthreads(); \
        const unsigned long long mw_ = mrow[(t)]; if ((t) + 1 < NT) ALOAD((t) + 1); \
        f32x16 p0, p1; float alpha; bf16x8 pa0, pa1, pa2, pa3; \
        qkt<KB>(p0, p1, K_lds, r32, hi, qr); \
        softmax_tile(p0, p1, mw_, hi, m_reg, l_reg, alpha, pa0, pa1, pa2, pa3); \
        if (__any(alpha < 1.f)) { if (hi == 0) al_l[r32] = alpha; LDS_WAIT(); \
            _Pragma("unroll") for (int d_ = 0; d_ < 4; ++d_) _Pragma("unroll") for (int r = 0; r < 16; ++r) o[d_][r] *= al_l[crow(r, hi)]; } \
        pv_tile<KB>(o, vb0, pa0, pa1, pa2, pa3); } while (0)
    ALOAD(0);
    for (int t = 0; t < NT; t += 2) { ASTEP(t, 0); ASTEP(t + 1, 1); }
#undef ASTEP
#undef AWRITE
#undef ALOAD
    if (hi == 0) li_l[r32] = l_reg; LDS_WAIT();
    float rli[16];
#pragma unroll
    for (int r = 0; r < 16; ++r) rli[r] = __builtin_amdgcn_rcpf(li_l[crow(r, hi)]);
    bf16* Ow = ycat + (size_t)(b * SEQ + X * 256 + wid * 32) * DM + D_SSM + h * 128;
#pragma unroll
    for (int r = 0; r < 16; ++r) { const int orow = crow(r, hi);
#pragma unroll
        for (int d0 = 0; d0 < 4; ++d0) { const float v = o[d0][r] * rli[r]; const float vn = __shfl_xor(v, 1);
            if ((r32 & 1) == 0) *(unsigned*)(Ow + (size_t)orow * DM + d0 * 32 + r32) = cvt_pk_bf16(v, vn); } }
    __syncthreads();
}

__device__ __forceinline__ void ssd_c_unit(Frame& F, int b, int c, int lq) {
    const bf16* xact = WSP(const bf16, WS_XBCACT); const bf16* hin = WSP(const bf16, WS_HIN); const float* csg = WSP(const float, WS_CS); const float* ydiag = WSP(const float, WS_YDIAG);
    const bf16* zg = WSP(const bf16, WS_Z); bf16* ycat = WSP(bf16, WS_YCAT);
    LAS float* gb = (LAS float*)F.lds();
    const int lane = F.lane(), r32 = lane & 31, hi = lane >> 5, w = F.wave(), g = w >> 2;
    const int tok0 = b * SEQ + c * CHUNK + lq * 32;
    bf16x8 Af[8];
#pragma unroll
    for (int ks = 0; ks < 8; ++ks) Af[ks] = *(const bf16x8*)(xact + (size_t)(tok0 + r32) * CONV_CH + 1280 + g * 128 + 16 * ks + 8 * hi);
#pragma unroll
    for (int hh = 0; hh < 2; ++hh) { const int h = 2 * w + hh;
        const bf16* hp = hin + ((size_t)((b * NCHUNK + c) * SSM_H + h) * SSM_P) * SSM_N;
        f32x16 a0 = {}, a1 = {};
#pragma unroll
        for (int ks = 0; ks < 8; ++ks) { const bf16x8 b0 = *(const bf16x8*)(hp + (size_t)r32 * SSM_N + 16 * ks + 8 * hi), b1 = *(const bf16x8*)(hp + (size_t)(32 + r32) * SSM_N + 16 * ks + 8 * hi);
            a0 = __builtin_amdgcn_mfma_f32_32x32x16_bf16(Af[ks], b0, a0, 0, 0, 0); a1 = __builtin_amdgcn_mfma_f32_32x32x16_bf16(Af[ks], b1, a1, 0, 0, 0); }
        const float dsk = F.f(10)[h];
#pragma unroll
        for (int r = 0; r < 16; ++r) { const int l = crow(r, hi); const size_t tok = (size_t)(tok0 + l);
            const float e = __expf(csg[tok * 16 + h]);
#pragma unroll
            for (int pt = 0; pt < 2; ++pt) { const int col = h * 64 + 32 * pt + r32;
                const float y = ydiag[tok * D_SSM + col] + e * (pt ? a1[r] : a0[r]) + dsk * bf2f(xact[tok * CONV_CH + col]);
                gb[l * 1024 + col] = y * silu_f(bf2f(zg[tok * 1024 + col])); } } }
    __syncthreads();
#pragma unroll
    for (int rr = 0; rr < 4; ++rr) { const int l = 4 * w + rr; float ss = 0.f; f32x4 v[4];
#pragma unroll
        for (int j = 0; j < 4; ++j) { v[j] = *(const LAS f32x4*)(gb + l * 1024 + j * 256 + lane * 4); ss += v[j][0] * v[j][0] + v[j][1] * v[j][1] + v[j][2] * v[j][2] + v[j][3] * v[j][3]; }
        const float rs = 1.0f / sqrtf(wave_sum(ss) * (1.0f / 1024.0f) + LN_EPS);
#pragma unroll
        for (int j = 0; j < 4; ++j) { const f32x4 nw = *(const f32x4*)(F.f(11) + j * 256 + lane * 4); const f32x4 y = v[j] * rs * nw;
            u32x2 o = {cvt_pk_bf16(y[0], y[1]), cvt_pk_bf16(y[2], y[3])};
            *(u32x2*)(ycat + (size_t)(tok0 + l) * DM + j * 256 + lane * 4) = o; } }
    __syncthreads();
}
__device__ __forceinline__ void p5_phase(Frame& F) {
    for (int L = F.bid(); L < 256; L += F.G()) { const int lq = L & 3, c = (L >> 2) & 31, b = L >> 7; ssd_c_unit(F, b, c, lq); }
    for (int L = F.bid(); L < 256; L += F.G()) { const int X = 15 - (L >> 4), h = L & 7, b = (L >> 3) & 1; attn_item(F, b, h, X); }
}
struct EpiOutProj {
    static constexpr bool PERM = false;
    const float* x; const float* modf; float* out;
    __device__ __forceinline__ void operator()(const f32x4 (&acc)[2][2][4][2], const pg8::Unit& u, int wr, int wc, int fr, int fq) const {
        const int row0 = u.pm * 256 + wr * 64 + fr, col0 = u.pn * 256 + wc * 32 + 4 * fq; const int b = (u.pm * 256) / SEQ;
        f32x4 gv[2][2];
#pragma unroll
        for (int bj = 0; bj < 2; ++bj)
#pragma unroll
            for (int n = 0; n < 2; ++n) gv[bj][n] = *(const f32x4*)(modf + (size_t)b * (6 * DM) + 2 * DM + col0 + bj * 128 + n * 16);
#pragma unroll
        for (int ai = 0; ai < 2; ++ai)
#pragma unroll
            for (int m = 0; m < 4; ++m) { const size_t off = (size_t)(row0 + ai * 128 + m * 16) * DM + col0;
#pragma unroll
                for (int bj = 0; bj < 2; ++bj)
#pragma unroll
                    for (int n = 0; n < 2; ++n) { const f32x4 xv = *(const f32x4*)(x + off + bj * 128 + n * 16);
                        *(f32x4*)(out + off + bj * 128 + n * 16) = xv * ALPHA_DN + gv[bj][n] * acc[ai][bj][m][n]; } }
    }
};

constexpr int RT_P = 2056;
__device__ __forceinline__ void p7_unit(Frame& F, int un) {
    const float* modf = WSP(const float, WS_MODF); bf16* u2 = WSP(bf16, WS_U2); const bf16* wr_hi = WSP(const bf16, WS_WR); const bf16* wr_lo = wr_hi + NE * DM;
    int* inv = WSP(int, WS_INV); int* ltok = WSP(int, WS_LTOK); float* lw = WSP(float, WS_LW);
    LAS bf16* Ah = (LAS bf16*)F.lds(); LAS bf16* Al = Ah + 16 * RT_P; LAS float* red = (LAS float*)F.lds();
    LAS float* logit = (LAS float*)(F.lds() + 135168);
    const int lane = F.lane(), w = F.wave(), row0 = un * 16, b = row0 / SEQ;
    const float* sh2 = modf + (size_t)b * (6 * DM) + 3 * DM; const float* sc2 = modf + (size_t)b * (6 * DM) + 4 * DM;
#pragma unroll
    for (int rr = 0; rr < 2; ++rr) { const int rl = 2 * w + rr; const size_t row = (size_t)(row0 + rl);
        f32x4 v[8]; float s = 0.f;
#pragma unroll
        for (int j = 0; j < 8; ++j) { v[j] = *(const f32x4*)(F.out() + row * DM + j * 256 + lane * 4); s += (v[j][0] + v[j][1]) + (v[j][2] + v[j][3]); }
        const float mu = wave_sum(s) * (1.0f / DM); float q = 0.f;
#pragma unroll
        for (int j = 0; j < 8; ++j) { v[j] = v[j] - mu; q += (v[j][0] * v[j][0] + v[j][1] * v[j][1]) + (v[j][2] * v[j][2] + v[j][3] * v[j][3]); }
        const float rstd = 1.0f / sqrtf(wave_sum(q) * (1.0f / DM) + LN_EPS);
#pragma unroll
        for (int j = 0; j < 8; ++j) { const int col = j * 256 + lane * 4;
            const f32x4 x1 = v[j] * rstd * *(const f32x4*)(F.f(15) + col) + *(const f32x4*)(F.f(16) + col);
            *(f32x4*)(F.out() + row * DM + col) = x1;
            const f32x4 uu = x1 * (*(const f32x4*)(sc2 + col) + 1.0f) + *(const f32x4*)(sh2 + col);
            const unsigned h0 = cvt_pk_bf16(uu[0], uu[1]), h1 = cvt_pk_bf16(uu[2], uu[3]);
            *(u32x2*)(u2 + row * DM + col) = (u32x2){h0, h1};
            const unsigned l0 = cvt_pk_bf16(uu[0] - bflo(h0), uu[1] - bfhi(h0)), l1 = cvt_pk_bf16(uu[2] - bflo(h1), uu[3] - bfhi(h1));
            *(LAS u32x2*)(Ah + rl * RT_P + col) = (u32x2){h0, h1}; *(LAS u32x2*)(Al + rl * RT_P + col) = (u32x2){l0, l1}; } }
    __syncthreads();
    f32x4 acc[4] = {};
    { const int fr = lane & 15, fq = lane >> 4;
#pragma unroll 2
      for (int ks = 0; ks < 8; ++ks) { const int k0 = w * 256 + ks * 32 + fq * 8;
          const bf16x8 ah = *(const LAS bf16x8*)(Ah + fr * RT_P + k0), al = *(const LAS bf16x8*)(Al + fr * RT_P + k0);
#pragma unroll
          for (int nt = 0; nt < 4; ++nt) { const bf16x8 bh = *(const bf16x8*)(wr_hi + (size_t)(16 * nt + fr) * DM + k0), bl = *(const bf16x8*)(wr_lo + (size_t)(16 * nt + fr) * DM + k0);
              acc[nt] = __builtin_amdgcn_mfma_f32_16x16x32_bf16(ah, bh, acc[nt], 0, 0, 0);
              acc[nt] = __builtin_amdgcn_mfma_f32_16x16x32_bf16(al, bh, acc[nt], 0, 0, 0);
              acc[nt] = __builtin_amdgcn_mfma_f32_16x16x32_bf16(ah, bl, acc[nt], 0, 0, 0); } }
      __syncthreads();
#pragma unroll
      for (int nt = 0; nt < 4; ++nt)
#pragma unroll
          for (int r = 0; r < 4; ++r) red[(w * 16 + fq * 4 + r) * 64 + 16 * nt + fr] = acc[nt][r]; }
    __syncthreads();
#pragma unroll
    for (int i = 0; i < 2; ++i) { const int o = F.tid() + 512 * i; float s = 0.f;
#pragma unroll
        for (int ww = 0; ww < 8; ++ww) s += red[ww * 1024 + o];
        logit[o] = s; }
    __syncthreads();
#pragma unroll 1
    for (int rr = 0; rr < 2; ++rr) { const int rl = 2 * w + rr, tok = row0 + rl;
        const float score = sigmoid_f(logit[rl * 64 + lane]); const float biased = score + F.f(18)[lane];
        float m1 = biased;
#pragma unroll
        for (int o = 1; o < 8; o <<= 1) m1 = fmaxf(m1, __shfl_xor(m1, o));
        int i1 = (biased == m1) ? lane : 64;
#pragma unroll
        for (int o = 1; o < 8; o <<= 1) i1 = min(i1, __shfl_xor(i1, o));
        float m2 = (lane == i1) ? -__builtin_inff() : biased;
#pragma unroll
        for (int o = 1; o < 8; o <<= 1) m2 = fmaxf(m2, __shfl_xor(m2, o));
        const float gs = m1 + m2; const int grp = lane >> 3;
        int grank = 0;
#pragma unroll
        for (int g2 = 0; g2 < 8; ++g2) { const float og = __shfl(gs, 8 * g2); grank += (og > gs || (og == gs && g2 < grp)) ? 1 : 0; }
        const float mk = (grank < 4) ? biased : -__builtin_inff();
        int erank = 0;
#pragma unroll 4
        for (int e2 = 0; e2 < 64; ++e2) { const float oe = __shfl(mk, e2); erank += (oe > mk || (oe == mk && e2 < lane)) ? 1 : 0; }
        const bool sel = erank < 8;
        const float wsum = wave_sum(sel ? score : 0.f);
        if (sel) { const float gw = score / wsum * 2.5f;
            const int rk = (int)__hip_atomic_fetch_add(F.ctl() + CW_ECNT + 64 * lane, 1u, RLX_AGENT);
            ltok[lane * NTOK + rk] = tok; lw[lane * NTOK + rk] = gw; inv[tok * 8 + erank] = lane * NTOK + rk; } }
    __syncthreads();
}
__device__ __forceinline__ void p7_phase(Frame& F) { for (int un = F.bid(); un < NTOK / 16; un += F.G()) p7_unit(F, un); }
struct MoeOrder {
    const LAS int* tab; const int* ltok; int G, c, npn;
    __device__ __forceinline__ bool next(int i, pg8::Unit& u) const {
        const int L = i * G + c; const int total = tab[80 + NEX] * npn; if (L >= total) return false;
        int e = 0;
        for (int k = 1; k < NEX; ++k) e += (tab[80 + k] * npn <= L) ? 1 : 0;
        const int nte = tab[80 + e + 1] - tab[80 + e], rem = L - tab[80 + e] * npn;
        const int mt = rem % nte, pn = rem / nte;
        u.pm = tab[80 + e] + mt; u.pn = e * npn + pn; u.ax = (e << 8) | mt; return true;
    }
    __device__ __forceinline__ int row_tok(const pg8::Unit& u, int r) const {
        const int e = u.ax >> 8, idx = (u.ax & 255) * 256 + r;
        if (e == NE) return idx;
        return idx < tab[e] ? ltok[e * NTOK + idx] : 0;
    }
};
__device__ __forceinline__ void moe_tables(Frame& F) {
    LAS int* tab = (LAS int*)(F.lds() + LDS_MISC + 64);
    if (F.tid() == 0) { int cum = 0;
        for (int e = 0; e < NE; ++e) { const int cn = (int)__hip_atomic_load(F.ctl() + CW_ECNT + 64 * e, RLX_AGENT); tab[e] = cn; tab[80 + e] = cum; cum += (cn + 255) >> 8; }
        tab[NE] = NTOK; tab[80 + NE] = cum; cum += NTOK / 256; tab[80 + NEX] = cum; }
    __syncthreads();
}
struct EpiGateUp {
    static constexpr bool PERM = true;
    bf16* hid; const float* lw; const LAS int* tab;
    __device__ __forceinline__ void operator()(const f32x4 (&acc)[2][2][4][2], const pg8::Unit& u, int wr, int wc, int fr, int fq) const {
        const int e = u.ax >> 8, mt = u.ax & 255, pn = u.pn & 3; const int cnt = tab[e];
#pragma unroll
        for (int ai = 0; ai < 2; ++ai)
#pragma unroll
            for (int m = 0; m < 4; ++m) { const int rl = ai * 128 + wr * 64 + m * 16 + fr, idx = mt * 256 + rl;
                const float gw = (e == NE) ? 1.0f : (idx < cnt ? lw[e * NTOK + idx] : 0.0f);
                f32x4 h0, h1;
#pragma unroll
                for (int i = 0; i < 4; ++i) { h0[i] = silu_f(acc[ai][0][m][0][i]) * acc[ai][1][m][0][i] * gw; h1[i] = silu_f(acc[ai][0][m][1][i]) * acc[ai][1][m][1][i] * gw; }
                u32x4 w = {cvt_pk_bf16(h0[0], h0[1]), cvt_pk_bf16(h0[2], h0[3]), cvt_pk_bf16(h1[0], h1[1]), cvt_pk_bf16(h1[2], h1[3])};
                *(u32x4*)(hid + (size_t)(u.pm * 256 + rl) * DE + pn * 128 + wc * 32 + 8 * fq) = w; }
    }
};
struct EpiDown {
    static constexpr bool PERM = true;
    bf16* outs;
    __device__ __forceinline__ void operator()(const f32x4 (&acc)[2][2][4][2], const pg8::Unit& u, int wr, int wc, int fr, int fq) const {
        const int pn = u.pn & 7;
#pragma unroll
        for (int ai = 0; ai < 2; ++ai)
#pragma unroll
            for (int m = 0; m < 4; ++m) { bf16* rowp = outs + (size_t)(u.pm * 256 + ai * 128 + wr * 64 + m * 16 + fr) * DM + pn * 256 + wc * 32 + 8 * fq;
#pragma unroll
                for (int bj = 0; bj < 2; ++bj) { const f32x4 v0 = acc[ai][bj][m][0], v1 = acc[ai][bj][m][1];
                    u32x4 w = {cvt_pk_bf16(v0[0], v0[1]), cvt_pk_bf16(v0[2], v0[3]), cvt_pk_bf16(v1[0], v1[1]), cvt_pk_bf16(v1[2], v1[3])};
                    *(u32x4*)(rowp + bj * 128) = w; } }
    }
};
__device__ __forceinline__ void p10_final(Frame& F) {
    const float* modf = WSP(const float, WS_MODF); const bf16* outs = WSP(const bf16, WS_OUTS); const int* inv = WSP(const int, WS_INV);
    const LAS int* tab = (const LAS int*)(F.lds() + LDS_MISC + 64);
    const int gw = F.bid() * 8 + F.wave(), NGW = F.G() * 8;
    for (int tok = gw; tok < NTOK; tok += NGW) { int lane = F.lane(); asm volatile("" : "+v"(lane)); const int b = tok / SEQ; const float* g2 = modf + (size_t)b * (6 * DM) + 5 * DM;
        size_t rows[9];
#pragma unroll
        for (int k = 0; k < 8; ++k) { const int iv = inv[tok * 8 + k]; const int e = iv / NTOK, rk = iv % NTOK; rows[k] = (size_t)(tab[80 + e] * 256 + rk); }
        rows[8] = (size_t)(tab[80 + NE] * 256 + tok);
        f32x4 v[8]; float s = 0.f;
#pragma unroll
        for (int jj = 0; jj < 4; ++jj) { const int col = jj * 512 + lane * 8; f32x4 f0 = {0.f, 0.f, 0.f, 0.f}, f1 = {0.f, 0.f, 0.f, 0.f};
#pragma unroll
            for (int k = 0; k < 9; ++k) { const u32x4 w = *(const u32x4*)(outs + rows[k] * DM + col);
                f0[0] += bflo(w[0]); f0[1] += bfhi(w[0]); f0[2] += bflo(w[1]); f0[3] += bfhi(w[1]); f1[0] += bflo(w[2]); f1[1] += bfhi(w[2]); f1[2] += bflo(w[3]); f1[3] += bfhi(w[3]); }
            const f32x4 xa = *(const f32x4*)(F.out() + (size_t)tok * DM + col), xb = *(const f32x4*)(F.out() + (size_t)tok * DM + col + 4);
            v[2 * jj] = xa * ALPHA_DN + *(const f32x4*)(g2 + col) * f0; v[2 * jj + 1] = xb * ALPHA_DN + *(const f32x4*)(g2 + col + 4) * f1;
            s += (v[2 * jj][0] + v[2 * jj][1]) + (v[2 * jj][2] + v[2 * jj][3]) + (v[2 * jj + 1][0] + v[2 * jj + 1][1]) + (v[2 * jj + 1][2] + v[2 * jj + 1][3]); }
        const float mu = wave_sum(s) * (1.0f / DM); float q = 0.f;
#pragma unroll
        for (int j = 0; j < 8; ++j) { v[j] = v[j] - mu; q += (v[j][0] * v[j][0] + v[j][1] * v[j][1]) + (v[j][2] * v[j][2] + v[j][3] * v[j][3]); }
        const float rstd = 1.0f / sqrtf(wave_sum(q) * (1.0f / DM) + LN_EPS);
#pragma unroll
        for (int j = 0; j < 8; ++j) { const int col = (j >> 1) * 512 + lane * 8 + (j & 1) * 4;
            *(f32x4*)(F.out() + (size_t)tok * DM + col) = v[j] * rstd * *(const f32x4*)(F.f(25) + col) + *(const f32x4*)(F.f(26) + col); } }
}
#ifndef MK_N_LAUNCHES
#define MK_N_LAUNCHES 1
#endif
constexpr int N_PHASES = 11;
__global__ void __launch_bounds__(512, 2) fwd_kernel(Args args) {
    Frame F; F.ap = &args;
    if (F.tid() < 16) ((LAS unsigned*)(F.lds() + LDS_MISC))[F.tid()] = 0u;
    __syncthreads();
    if (args.ph_hi - args.ph_lo > 1) (void)xcd_barrier_post((unsigned*)(F.ctl() + CW_BAR), (volatile LAS unsigned*)(F.lds() + LDS_MISC));
#ifndef PH_MASK
#define PH_MASK 0x7ff
#endif
#define IN(k) (((PH_MASK >> (k)) & 1) && args.ph_lo <= (k) && (k) < args.ph_hi)
#define SEAM(k) do { if (IN(k) && IN((k) + 1)) { XcdBarrier bar_; bar_.bar = (unsigned*)(F.ctl() + CW_BAR); bar_.x = xb_xcc_id(); bar_.st = (volatile LAS unsigned*)(F.lds() + LDS_MISC); xcd_barrier(bar_); } } while (0)
    if (IN(0)) { p0_prologue(F); } SEAM(0);
    if (IN(1)) { p1_modulate(F); slack_fill(F, 1, false, Q_ALL); } SEAM(1);
    if (IN(2)) {
        pg8::Gemm g{WSP(const bf16, WS_U1), WSP(const bf16, WS_WIN), DM}; pg8::StaticOrder S; S.init(NTOK, NPROJ_PAD, F.G(), F.bid());
        EpiInProj E{F.ws(), F.f(8), F.f(12), F.f(13)};
        pg8::gemm_phase<EpiInProj, pg8::StaticOrder, false>(F.lds(), g, S, E);
        slack_fill(F, 2, false, Q_ALL);
    } SEAM(2);
    if (IN(3)) { p3_phase(F); slack_fill(F, 3, false, Q_ALL); } SEAM(3);
    if (IN(4)) { p4_select(F); p4_scan(F); slack_fill(F, 4, false, Q_ALL); } SEAM(4);
    if (IN(5)) { p5_phase(F); slack_fill(F, 5, false, Q_ALL); } SEAM(5);
    if (IN(6)) {
        pg8::Gemm g{WSP(const bf16, WS_YCAT), WSP(const bf16, WS_WOUT), DM}; pg8::StaticOrder S; S.init(NTOK, DM, F.G(), F.bid());
        EpiOutProj E{F.f(0), WSP(const float, WS_MODF), F.out()};
        pg8::gemm_phase<EpiOutProj, pg8::StaticOrder, false>(F.lds(), g, S, E);
        slack_fill(F, 6, false, Q_ALL);
    } SEAM(6);
    if (IN(7)) { p7_phase(F); slack_fill(F, 7, true, Q_GU); } SEAM(7);
    if (IN(8)) {
        moe_tables(F);
        const LAS int* tab = (const LAS int*)(F.lds() + LDS_MISC + 64);
        pg8::Gemm g{WSP(const bf16, WS_U2), WSP(const bf16, WS_WGU), DM}; MoeOrder S{tab, WSP(const int, WS_LTOK), F.G(), F.bid(), 4};
        EpiGateUp E{WSP(bf16, WS_HID), WSP(const float, WS_LW), tab};
        pg8::gemm_phase<EpiGateUp, MoeOrder, true>(F.lds(), g, S, E);
        slack_fill(F, 8, true, Q_ALL);
    } SEAM(8);
    if (IN(9)) {
        moe_tables(F);
        const LAS int* tab = (const LAS int*)(F.lds() + LDS_MISC + 64);
        pg8::Gemm g{WSP(const bf16, WS_HID), WSP(const bf16, WS_WDN), DE}; MoeOrder S{tab, WSP(const int, WS_LTOK), F.G(), F.bid(), 8};
        EpiDown E{WSP(bf16, WS_OUTS)};
        pg8::gemm_phase<EpiDown, MoeOrder, false>(F.lds(), g, S, E);
    } SEAM(9);
    if (IN(10)) { moe_tables(F); p10_final(F); }
#ifdef DBG_OFF
    if (args.ph_hi == N_PHASES) {
        const size_t n = (size_t)NTOK * DM; float* o = F.out();
        for (size_t i = (size_t)F.bid() * 512 + F.tid(); i < n; i += (size_t)F.G() * 512) {
            float v;
            if (DBG_KIND == 0) v = bf2f(((const bf16*)(F.ws() + (size_t)(DBG_OFF)))[i % (size_t)(DBG_N)]);
            else v = ((const float*)(F.ws() + (size_t)(DBG_OFF)))[i % (size_t)(DBG_N)];
            if (!(fabsf(v) < 1e30f)) v = 1e30f;
            o[i] = v; }
    }
#endif
#undef IN
#undef SEAM
}

extern "C" void kernel_launch(void* const* d_in, const int* in_sizes, int n_in, void* d_out, int out_size, void* d_ws, size_t ws_size, hipStream_t stream) {
    static int grid = 0;
    if (grid == 0) {
        if (n_in != 27 || out_size != NTOK * DM || ws_size < WS_END) { fprintf(stderr, "kernel_launch: unexpected shapes (n_in %d, out %d, ws %zu; need ws >= %zu)\n", n_in, out_size, ws_size, (size_t)WS_END); }
        int dev = 0, cus = 0, per_cu = 0;
        if (hipGetDevice(&dev) != hipSuccess || hipDeviceGetAttribute(&cus, hipDeviceAttributeMultiprocessorCount, dev) != hipSuccess) { grid = -1; return; }
        if (hipFuncSetAttribute((const void*)fwd_kernel, hipFuncAttributeMaxDynamicSharedMemorySize, LDS_BYTES) != hipSuccess) { fprintf(stderr, "kernel_launch: hipFuncSetAttribute failed\n"); grid = -1; return; }
        if (hipOccupancyMaxActiveBlocksPerMultiprocessor(&per_cu, (const void*)fwd_kernel, 512, LDS_BYTES) != hipSuccess || per_cu < 1) fprintf(stderr, "kernel_launch: occupancy query reports %d\n", per_cu);
        (void)hipGetLastError();
        grid = cus;
    }
    if (grid < 0) return;
    (void)hipMemsetAsync((char*)d_ws + WS_CTL, 0, CTL_ZERO_BYTES, stream);
    Args a{};
    for (int i = 0; i < 27; ++i) a.in[i] = d_in[i];
    a.out = (float*)d_out; a.ws = (unsigned char*)d_ws;
#if MK_N_LAUNCHES == 1
    a.ph_lo = 0; a.ph_hi = N_PHASES;
    hipLaunchKernelGGL(fwd_kernel, dim3(grid), dim3(512), LDS_BYTES, stream, a);
#else
    for (int p = 0; p < N_PHASES; ++p) { a.ph_lo = p; a.ph_hi = p + 1; hipLaunchKernelGGL(fwd_kernel, dim3(grid), dim3(512), LDS_BYTES, stream, a);
#ifdef DUP_PHASE
        if (p == DUP_PHASE) hipLaunchKernelGGL(fwd_kernel, dim3(grid), dim3(512), LDS_BYTES, stream, a);
#endif
    }
#endif
}
```

```cpp
#include <hip/hip_runtime.h>
#include <cstdio>
#include <cstdint>

#define GAS __attribute__((address_space(1)))
#define LAS __attribute__((address_space(3)))
typedef unsigned short bf16;
typedef short bf16x8 __attribute__((ext_vector_type(8)));
typedef short s16x4 __attribute__((ext_vector_type(4)));
typedef float f32x2 __attribute__((ext_vector_type(2)));
typedef float f32x4 __attribute__((ext_vector_type(4)));
typedef float f32x16 __attribute__((ext_vector_type(16)));
typedef unsigned u32x2 __attribute__((ext_vector_type(2)));
typedef unsigned u32x4 __attribute__((ext_vector_type(4)));
typedef GAS unsigned gu32;
#define RLX_AGENT __ATOMIC_RELAXED, __HIP_MEMORY_SCOPE_AGENT
#define LDS_WAIT() asm volatile("s_waitcnt lgkmcnt(0)" ::: "memory")
#define VM_WAIT() asm volatile("s_waitcnt vmcnt(0)" ::: "memory")

constexpr int DM = 2048, NBATCH = 2, SEQ = 4096, NTOK = NBATCH * SEQ;
constexpr int D_SSM = 1024, SSM_H = 16, SSM_P = 64, SSM_N = 128, CONV_CH = 1536, CHUNK = 128, NCHUNK = SEQ / CHUNK;
constexpr int ATT_H = 8, ATT_D = 128, IDX_H = 16, IDX_D = 64, TOPK_SEL = 256;
constexpr int NE = 64, DE = 512, NEX = NE + 1;
constexpr int NPROJ = 6752, NPROJ_PAD = 6912, NPROJ_TILES = 27;
constexpr float ALPHA_DN = 1.189207115002721f;
constexpr float LN_EPS = 1e-5f;
constexpr int SEG_Z = 0, SEG_XBC = 1024, SEG_DT = 2560, SEG_Q = 2576, SEG_K = 3600, SEG_V = 4624, SEG_QI = 5648, SEG_KI = 6672, SEG_WI = 6736;

constexpr size_t MiB = 1u << 20;
constexpr size_t WS_CTL = 0, CTL_ZERO_BYTES = 1 * MiB;
constexpr size_t WS_MODP = 1 * MiB;
constexpr size_t WS_MODF = 3 * MiB;
constexpr size_t WS_COSA = 4 * MiB, WS_SINA = 6 * MiB;
constexpr size_t WS_COSI = 8 * MiB, WS_SINI = 9 * MiB;
constexpr size_t WS_WR = 10 * MiB;
constexpr size_t WS_KIDX = 11 * MiB;
constexpr size_t WS_WIDX = 12 * MiB;
constexpr size_t WS_DT = 12 * MiB + 512 * 1024;
constexpr size_t WS_CS = 13 * MiB;
constexpr size_t WS_INV = 14 * MiB;
constexpr size_t WS_LTOK = 15 * MiB;
constexpr size_t WS_LW = 17 * MiB;
constexpr size_t WS_MASK = 19 * MiB;
constexpr size_t WS_U2 = 25 * MiB;
constexpr size_t WS_WGU = 57 * MiB;
constexpr size_t WS_WDN = 317 * MiB;
constexpr size_t WS_T = 447 * MiB;
constexpr size_t WS_HID = WS_T;
constexpr size_t WS_OUTS = WS_T + 88 * MiB;
constexpr size_t WS_WIN = WS_T;
constexpr size_t WS_WOUT = WS_T + 27 * MiB;
constexpr size_t WS_U1 = WS_T + 35 * MiB;
constexpr size_t WS_Z = WS_T + 67 * MiB;
constexpr size_t WS_XBC = WS_T + 83 * MiB;
constexpr size_t WS_Q = WS_T + 107 * MiB, WS_K = WS_T + 123 * MiB, WS_V = WS_T + 139 * MiB;
constexpr size_t WS_QIDX = WS_T + 155 * MiB;
constexpr size_t WS_SCORES = WS_T + 171 * MiB;
constexpr size_t WS_STATES = WS_T + 299 * MiB;
constexpr size_t WS_HIN = WS_T + 331 * MiB;
constexpr size_t WS_YDIAG = WS_T + 347 * MiB;
constexpr size_t WS_YCAT = WS_T + 379 * MiB;
constexpr size_t WS_XBCACT = WS_T + 411 * MiB;
constexpr size_t WS_END = WS_T + 440 * MiB;
static_assert(WS_XBCACT + 24 * MiB <= WS_END && WS_OUTS + 352 * MiB <= WS_END, "ws map");
constexpr int MAXPOS = 90112;
constexpr int CW_TMO = 0, CW_BAR = 4096, CW_ECNT = 8192;
constexpr int CW_QHEAD = 16384, CW_DONE = 16448;

constexpr int LDS_MISC = 155648;
constexpr int LDS_BYTES = 157696;

typedef __bf16 bf16x2_t __attribute__((ext_vector_type(2)));
__device__ __forceinline__ unsigned cvt_pk_bf16(float lo, float hi) { const bf16x2_t v = {(__bf16)lo, (__bf16)hi}; return __builtin_bit_cast(unsigned, v); }
__device__ __forceinline__ float bflo(unsigned w) { return __uint_as_float(w << 16); }
__device__ __forceinline__ float bfhi(unsigned w) { return __uint_as_float(w & 0xffff0000u); }
__device__ __forceinline__ float bf2f(bf16 b) { return __uint_as_float((unsigned)b << 16); }
__device__ __forceinline__ bf16 f2bf(float f) { return __builtin_bit_cast(unsigned short, (__bf16)f); }
__device__ __forceinline__ float silu_f(float x) { return x / (1.f + __expf(-x)); }
__device__ __forceinline__ float sigmoid_f(float x) { return 1.f / (1.f + __expf(-x)); }
__device__ __forceinline__ float wave_sum(float v) {
#pragma unroll
    for (int o = 1; o < 64; o <<= 1) v += __shfl_xor(v, o);
    return v;
}
__device__ __forceinline__ bf16x8 pack8(f32x4 a, f32x4 b) {
    u32x4 w = {cvt_pk_bf16(a[0], a[1]), cvt_pk_bf16(a[2], a[3]), cvt_pk_bf16(b[0], b[1]), cvt_pk_bf16(b[2], b[3])};
    return __builtin_bit_cast(bf16x8, w);
}
__device__ __forceinline__ void unpack8(bf16x8 v, float (&o)[8]) {
    u32x4 w = __builtin_bit_cast(u32x4, v);
#pragma unroll
    for (int i = 0; i < 4; ++i) { o[2 * i] = bflo(w[i]); o[2 * i + 1] = bfhi(w[i]); }
}
__device__ __forceinline__ int crow(int r, int hi) { return (r & 3) + 8 * (r >> 2) + 4 * hi; }
#define MK_N_LAUNCHES 1
#define PH_MASK 0x7ff
#define XB_TMO      128
#define XB_XCNT(j)  (256  + 64 * (j))
#define XB_XSUB(j)  (1280 + 64 * (j))
#define XB_XGEN(j)  (2304 + 64 * (j))
#define XB_TOP      3328
#define XB_TOPGEN   3392
#define XCD_BAR_WORDS 3456
#define XB_SPIN_CAP (1u << 18)

__device__ __forceinline__ unsigned xb_ld(unsigned* p)              { return __hip_atomic_load(p, __ATOMIC_RELAXED, __HIP_MEMORY_SCOPE_AGENT); }
__device__ __forceinline__ unsigned xb_add(unsigned* p, unsigned v) { return __hip_atomic_fetch_add(p, v, __ATOMIC_RELAXED, __HIP_MEMORY_SCOPE_AGENT); }
__device__ __forceinline__ unsigned xb_xcc_id() { return (unsigned)__builtin_amdgcn_s_getreg((3 << 11) | 20) & 0xFu; }
#define XB_SPIN(cond, bar) do { unsigned _sp = 0; while (cond) { __builtin_amdgcn_s_sleep(1); \
    if ((++_sp & 255u) == 0u) { if (xb_ld(&(bar)[XB_TMO])) break; if (_sp > XB_SPIN_CAP) { atomicAdd(&(bar)[XB_TMO], 1u); break; } } } } while (0)

struct XcdBarrier {
    unsigned* bar; unsigned x;
    volatile LAS unsigned* st;
};

__device__ __forceinline__ XcdBarrier xcd_barrier_post(unsigned* bar, volatile LAS unsigned* st) {
    XcdBarrier b; b.bar = bar; b.x = xb_xcc_id(); b.st = st;
    if (threadIdx.x == 0) (void)xb_add(&bar[XB_XCNT(b.x)], 1u);
    return b;
}
__device__ __forceinline__ void xcd_barrier_complete(unsigned* bar, unsigned x, unsigned& nloc, unsigned& nx) {
    const unsigned G = gridDim.x * gridDim.y * gridDim.z;
    unsigned sum, cnt, mine, sp = 0u;
    for (;;) {
        sum = 0u; cnt = 0u; mine = 0u;
#pragma unroll
        for (unsigned j = 0; j < 16; ++j) { const unsigned c = xb_ld(&bar[XB_XCNT(j)]); sum += c; cnt += (c > 0u) ? 1u : 0u; mine = (j == x) ? c : mine; }
        if (sum == G) break;
        __builtin_amdgcn_s_sleep(1);
        if ((++sp & 255u) == 0u) { if (xb_ld(&bar[XB_TMO])) break; if (sp > XB_SPIN_CAP) { atomicAdd(&bar[XB_TMO], 1u); break; } }
    }
    nloc = mine > 0u ? mine : 1u; nx = cnt > 0u ? cnt : 1u;
}

__device__ __forceinline__ void xcd_barrier(const XcdBarrier& b) {
    asm volatile("s_waitcnt vmcnt(0)" ::: "memory");
    __syncthreads();
    if (threadIdx.x == 0) {
        unsigned* bar = b.bar;
        __builtin_amdgcn_s_waitcnt(0);
        unsigned nloc = b.st[0], nx = b.st[1];
        if (nloc == 0u) { xcd_barrier_complete(bar, b.x, nloc, nx); b.st[0] = nloc; b.st[1] = nx; }
        const unsigned old = xb_add(&bar[XB_XSUB(b.x)], 1u);
        const unsigned gen = old / nloc;
        if (old + 1u == (gen + 1u) * nloc) {
            __builtin_amdgcn_fence(__ATOMIC_RELEASE, "agent");
            asm volatile("s_waitcnt vmcnt(0)" ::: "memory");
            const unsigned og = xb_add(&bar[XB_TOP], 1u);
            const unsigned tg = og / nx;
            if (og + 1u == (tg + 1u) * nx) xb_add(&bar[XB_TOPGEN], 1u);
            else XB_SPIN(xb_ld(&bar[XB_TOPGEN]) == tg, bar);
            __builtin_amdgcn_fence(__ATOMIC_ACQUIRE, "agent");
            xb_add(&bar[XB_XGEN(b.x)], 1u);
            asm volatile("s_waitcnt vmcnt(0)" ::: "memory");
        } else {
            XB_SPIN(xb_ld(&bar[XB_XGEN(b.x)]) == gen, bar);
            __builtin_amdgcn_fence(__ATOMIC_ACQUIRE, "agent");
            asm volatile("s_waitcnt vmcnt(0)" ::: "memory");
        }
    }
    __syncthreads();
}

namespace pg8 {
constexpr int BM = 256, BK = 64, HALF = 128, HTB = HALF * BK * 2  , STAGE_BYTES = 8 * HTB, NXCD = 8, WGM = 8;
__host__ __device__ __forceinline__ int lds_byte(int r, int c) { const int st = (r >> 4) * 2 + (c >> 5), rr = r & 15, cc = c & 31, ob = rr * 64 + cc * 2; return st * 1024 + (ob ^ (((ob >> 9) & 1) << 5)); }
__host__ __device__ __forceinline__ void stage_rc(int b, int& R, int& C) { const int st = b / 1024, sb = b % 1024, swz = sb ^ (((sb >> 9) & 1) << 5); R = (st >> 1) * 16 + swz / 64; C = (st & 1) * 32 + (swz % 64) / 2; }
__host__ __device__ __forceinline__ int perm32(int rho) { const int n = rho >> 4, i = rho & 15; return 8 * (i >> 2) + 4 * n + (i & 3); }

struct Unit { int pm, pn, ax; };
struct Gemm { const bf16* A; const bf16* Bt; int K; };

struct StaticOrder {
    int nM, nN, nwg, G, c;
    __device__ void init(int M, int N, int G_, int c_) { nM = M / BM; nN = N / BM; nwg = nM * nN; G = G_; c = c_; }
    __device__ __forceinline__ bool next(int i, Unit& u) const {
        const long L = (long)i * G + c; if (L >= nwg) return false;
        int wgid = (int)L; { const int q = nwg / NXCD, r = nwg % NXCD, xcd = wgid % NXCD, off = wgid / NXCD; wgid = (xcd < r ? xcd * (q + 1) : r * (q + 1) + (xcd - r) * q) + off; }
        const int nig = WGM * nN, gid = wgid / nig, fm = gid * WGM, gsz = (nM - fm) < WGM ? (nM - fm) : WGM;
        u.pm = fm + ((wgid % nig) % gsz); u.pn = (wgid % nig) / gsz; u.ax = 0; return true;
    }
    __device__ __forceinline__ int row_tok(const Unit&, int) const { return 0; }
};

template <class Epi, class Sched, bool GATHER>
__device__ __forceinline__ void gemm_phase(LAS unsigned char* lds, const Gemm g, const Sched& S, const Epi& E) {
    const int tid = threadIdx.x, wid = __builtin_amdgcn_readfirstlane(tid >> 6), lane = tid & 63, wr = wid >> 2, wc = wid & 3, fr = lane & 15, fq = lane >> 4;
    const int K = g.K, nt = K / BK;
    unsigned voffB[2]; int RA[2]; unsigned CA2[2];
#pragma unroll
    for (int i = 0; i < 2; ++i) { int R, C; stage_rc(tid * 16 + i * 8192, R, C); const int Rb = Epi::PERM ? ((R & ~31) + perm32(R & 31)) : R;
        voffB[i] = (unsigned)(Rb * K + C) * 2u; RA[i] = R; CA2[i] = (unsigned)C * 2u; }
    const size_t kstep = (size_t)(BK * 2);
    const size_t hstep = (size_t)HALF * K * 2;
    const size_t tstep = 2 * hstep;
    const unsigned ldsw = (unsigned)wid * 1024u;
    const int aoff = lds_byte(wr * 64 + fr, fq * 8), boff = lds_byte(wc * 32 + fr, fq * 8);
#define PG8_SA(b, h) (((b) * 2 + (h)) * HTB)
#define PG8_SB(b, h) ((4 + (b) * 2 + (h)) * HTB)
#define PG8_STAGE(bufoff, gbase, voff) do { _Pragma("unroll") for (int _i = 0; _i < 2; ++_i) \
        __builtin_amdgcn_global_load_lds((const unsigned*)((const char*)(gbase) + (voff)[_i]), (LAS unsigned*)(lds + (bufoff) + ldsw + _i * 8192), 16, 0, 0); } while (0)
#define PG8_LDA(dst, b, h) do { _Pragma("unroll") for (int m = 0; m < 4; ++m) _Pragma("unroll") for (int k = 0; k < 2; ++k) dst[m][k] = *(const LAS bf16x8*)(lds + PG8_SA(b, h) + aoff + m * 2048 + k * 1024); } while (0)
#define PG8_LDB(dst, b, h) do { _Pragma("unroll") for (int n = 0; n < 2; ++n) _Pragma("unroll") for (int k = 0; k < 2; ++k) dst[n][k] = *(const LAS bf16x8*)(lds + PG8_SB(b, h) + boff + n * 2048 + k * 1024); } while (0)
#define PG8_MMA(ai, bj, At, Bt) do { __builtin_amdgcn_s_setprio(1); _Pragma("unroll") for (int m = 0; m < 4; ++m) _Pragma("unroll") for (int n = 0; n < 2; ++n) _Pragma("unroll") for (int k = 0; k < 2; ++k) \
        acc[ai][bj][m][n] = __builtin_amdgcn_mfma_f32_16x16x32_bf16(Bt[n][k], At[m][k], acc[ai][bj][m][n], 0, 0, 0); __builtin_amdgcn_s_setprio(0); } while (0)
#define PG8_WAIT_V(n) asm volatile("s_waitcnt vmcnt(" #n ")" ::: "memory")
#define PG8_WAIT_L(n) asm volatile("s_waitcnt lgkmcnt(" #n ")" ::: "memory")
#define PG8_BAR __builtin_amdgcn_s_barrier()
#define PG8_SCHED __builtin_amdgcn_sched_barrier(0)
#define PG8_SET_OA(o, u) do { _Pragma("unroll") for (int _h = 0; _h < 2; ++_h) _Pragma("unroll") for (int _i = 0; _i < 2; ++_i) { \
        if constexpr (GATHER) o[_h][_i] = (unsigned)S.row_tok(u, _h * HALF + RA[_i]) * (unsigned)(K * 2) + CA2[_i]; \
        else o[_h][_i] = (unsigned)(_h * (int)hstep) + (unsigned)(RA[_i] * K * 2) + CA2[_i]; } } while (0)
    Unit cur, nxt; int ui = 0;
    if (!S.next(0, cur)) return;
    f32x4 acc[2][2][4][2];
#pragma unroll
    for (int a = 0; a < 2; ++a)
#pragma unroll
        for (int b = 0; b < 2; ++b)
#pragma unroll
            for (int m = 0; m < 4; ++m)
#pragma unroll
                for (int n = 0; n < 2; ++n) acc[a][b][m][n] = (f32x4){0.f, 0.f, 0.f, 0.f};
    bf16x8 At[4][2], B0[2][2], B1[2][2];
    unsigned oAc[2][2], oAn[2][2];
    PG8_SET_OA(oAc, cur);
    const char* cA = GATHER ? (const char*)g.A : (const char*)g.A + (size_t)cur.pm * tstep; const char* cB = (const char*)g.Bt + (size_t)cur.pn * tstep;
    PG8_STAGE(PG8_SB(0, 0), cB, voffB); PG8_STAGE(PG8_SB(0, 1), cB + hstep, voffB); PG8_STAGE(PG8_SA(0, 0), cA, oAc[0]); PG8_STAGE(PG8_SA(0, 1), cA, oAc[1]);
    if (wr == 1) PG8_BAR;
    PG8_WAIT_V(2); PG8_BAR;
    PG8_STAGE(PG8_SB(1, 0), cB + kstep, voffB); PG8_STAGE(PG8_SA(1, 0), cA + kstep, oAc[0]); PG8_STAGE(PG8_SB(1, 1), cB + hstep + kstep, voffB);
    PG8_WAIT_V(6); PG8_BAR;
    for (;;) {
        const bool has_next = S.next(ui + 1, nxt);
        const char* nA = has_next ? (GATHER ? (const char*)g.A : (const char*)g.A + (size_t)nxt.pm * tstep) : cA; const char* nB = has_next ? (const char*)g.Bt + (size_t)nxt.pn * tstep : cB;
        if (has_next) { PG8_SET_OA(oAn, nxt); }
        else {
#pragma unroll
            for (int _h = 0; _h < 2; ++_h)
#pragma unroll
                for (int _i = 0; _i < 2; ++_i) oAn[_h][_i] = oAc[_h][_i]; }
        for (int t = 0; t < nt; t += 2) {
            const bool last = (t == nt - 2);
            const char* a1 = cA + (size_t)(t + 1) * kstep;
            const char* a2 = last ? nA : cA + (size_t)(t + 2) * kstep; const char* b2 = last ? nB : cB + (size_t)(t + 2) * kstep;
            const char* a3 = a2 + kstep; const char* b3 = b2 + kstep;
            unsigned o2[2][2];
#pragma unroll
            for (int _h = 0; _h < 2; ++_h)
#pragma unroll
                for (int _i = 0; _i < 2; ++_i) o2[_h][_i] = GATHER ? (last ? oAn[_h][_i] : oAc[_h][_i]) : oAc[_h][_i];
            PG8_LDB(B0, 0, 0); PG8_LDB(B1, 0, 1); PG8_SCHED; PG8_LDA(At, 0, 0); PG8_STAGE(PG8_SA(1, 1), a1, oAc[1]);
            PG8_WAIT_V(8); PG8_WAIT_L(0); PG8_BAR; PG8_MMA(0, 0, At, B0); PG8_MMA(0, 1, At, B1); PG8_BAR; PG8_SCHED;
            PG8_LDA(At, 0, 1); PG8_STAGE(PG8_SB(0, 0), b2, voffB); PG8_STAGE(PG8_SB(0, 1), b2 + hstep, voffB); PG8_STAGE(PG8_SA(0, 0), a2, o2[0]);
            PG8_WAIT_V(8); PG8_WAIT_L(0); PG8_BAR; PG8_MMA(1, 0, At, B0); PG8_MMA(1, 1, At, B1); PG8_BAR; PG8_SCHED;
            PG8_LDB(B0, 1, 0); PG8_LDB(B1, 1, 1); PG8_SCHED; PG8_LDA(At, 1, 0); PG8_STAGE(PG8_SA(0, 1), a2, o2[1]);
            PG8_WAIT_V(8); PG8_WAIT_L(0); PG8_BAR; PG8_MMA(0, 0, At, B0); PG8_MMA(0, 1, At, B1); PG8_BAR; PG8_SCHED;
            PG8_LDA(At, 1, 1); PG8_STAGE(PG8_SB(1, 0), b3, voffB); PG8_STAGE(PG8_SB(1, 1), b3 + hstep, voffB); PG8_STAGE(PG8_SA(1, 0), a3, o2[0]);
            PG8_WAIT_V(8); PG8_WAIT_L(0); PG8_BAR; PG8_MMA(1, 0, At, B0); PG8_MMA(1, 1, At, B1); PG8_BAR; PG8_SCHED;
        }
        if (wr == 0) PG8_BAR;
        { int fr_ = fr, fq_ = fq, wr_ = wr, wc_ = wc; asm volatile("" : "+v"(fr_), "+v"(fq_), "+s"(wr_), "+s"(wc_));
          E(acc, cur, wr_, wc_, fr_, fq_); }
        if (!has_next) break;
#pragma unroll
        for (int a = 0; a < 2; ++a)
#pragma unroll
            for (int b = 0; b < 2; ++b)
#pragma unroll
                for (int m = 0; m < 4; ++m)
#pragma unroll
                    for (int n = 0; n < 2; ++n) acc[a][b][m][n] = (f32x4){0.f, 0.f, 0.f, 0.f};
        cur = nxt; cA = nA; cB = nB; ++ui;
#pragma unroll
        for (int _h = 0; _h < 2; ++_h)
#pragma unroll
            for (int _i = 0; _i < 2; ++_i) oAc[_h][_i] = oAn[_h][_i];
        if (wr == 1) PG8_BAR;
    }
    PG8_WAIT_V(0);
    PG8_BAR;
#undef PG8_SA
#undef PG8_SB
#undef PG8_STAGE
#undef PG8_LDA
#undef PG8_LDB
#undef PG8_MMA
#undef PG8_WAIT_V
#undef PG8_WAIT_L
#undef PG8_BAR
#undef PG8_SCHED
#undef PG8_SET_OA
}
}
struct Args { const void* in[27]; float* out; unsigned char* ws; int ph_lo, ph_hi; };
struct Frame {
    const Args* ap;
    __device__ __forceinline__ LAS unsigned char* lds() const { extern __shared__ __attribute__((aligned(16))) unsigned char lds_raw[]; return (LAS unsigned char*)lds_raw; }
    __device__ __forceinline__ unsigned char* ws() const { return ap->ws; }
    __device__ __forceinline__ gu32* ctl() const { return (gu32*)(ap->ws + WS_CTL); }
    __device__ __forceinline__ float* out() const { return ap->out; }
    __device__ __forceinline__ int tid() const { return (int)threadIdx.x; }
    __device__ __forceinline__ int lane() const { return (int)threadIdx.x & 63; }
    __device__ __forceinline__ int wave() const { return __builtin_amdgcn_readfirstlane((int)threadIdx.x >> 6); }
    __device__ __forceinline__ int G() const { return (int)gridDim.x; }
    __device__ __forceinline__ int bid() const { return (int)blockIdx.x; }
    __device__ __forceinline__ const float* f(int i) const { return (const float*)ap->in[i]; }
    __device__ __forceinline__ const int* i32(int i) const { return (const int*)ap->in[i]; }
};
#define WSP(T, off) ((T*)(F.ws() + (off)))

__device__ __forceinline__ int inproj_src_col(int P) {
    const int tile = P >> 8, within = P & 255, bj = within >> 7, w = within & 127;
    if (tile < 4) return SEG_Z + tile * 256 + within;
    if (tile < 10) return SEG_XBC + (tile - 4) * 256 + within;
    if (tile < 14) return SEG_Q + (2 * (tile - 10) + (w >> 6)) * 128 + (w & 63) + 64 * bj;
    if (tile < 18) return SEG_K + (2 * (tile - 14) + (w >> 6)) * 128 + (w & 63) + 64 * bj;
    if (tile < 22) return SEG_V + (tile - 18) * 256 + within;
    if (tile < 26) return SEG_QI + (4 * (tile - 22) + (w >> 5)) * 64 + (w & 31) + 32 * bj;
    if (bj == 0) { if (w < 32) return SEG_KI + w; if (w < 48) return SEG_WI + (w - 32); if (w < 64) return SEG_DT + (w - 48); return -1; }
    if (w < 32) return SEG_KI + 32 + w;
    return -1;
}
__device__ __forceinline__ void tr64(const float* qsrc, bool valid, int ld, bf16* dst0  , int K, LAS float* scr, int lane) {
    f32x4 v[16];
#pragma unroll
    for (int i = 0; i < 16; ++i) v[i] = valid ? *(const f32x4*)(qsrc + (size_t)(4 * i) * ld) : (f32x4){0.f, 0.f, 0.f, 0.f};
#pragma unroll
    for (int i = 0; i < 16; ++i) { LAS float* s = scr + ((lane >> 4) + 4 * i) * 65 + 4 * (lane & 15); s[0] = v[i][0]; s[1] = v[i][1]; s[2] = v[i][2]; s[3] = v[i][3]; }
    LDS_WAIT(); asm volatile("" ::: "memory");
    const int c = lane & 7;
#pragma unroll
    for (int jj = 0; jj < 8; ++jj) { const int n = (lane >> 3) + 8 * jj; const LAS float* s = scr + (8 * c) * 65 + n;
        u32x4 o; o.x = cvt_pk_bf16(s[0], s[65]); o.y = cvt_pk_bf16(s[2 * 65], s[3 * 65]); o.z = cvt_pk_bf16(s[4 * 65], s[5 * 65]); o.w = cvt_pk_bf16(s[6 * 65], s[7 * 65]);
        *(u32x4*)(dst0 + (size_t)n * K + 8 * c) = o; }
    LDS_WAIT(); asm volatile("" ::: "memory");
}
constexpr int I_IN = 32 * 108, I_OUT = 32 * 32, I_GU = NEX * 32 * 16, I_DN = NEX * 8 * 32, I_TR = I_IN + I_OUT + I_GU + I_DN;
__device__ __forceinline__ void tr_item(Frame& F, int it, LAS float* scr) {
    const int lane = F.lane(), kr = lane >> 4, nq = 4 * (lane & 15);
    if (it < I_IN) { const int kb = it / 108, nb = it % 108, k0 = 64 * kb, n0 = 64 * nb; const int sc = inproj_src_col(n0 + nq);
        tr64(F.f(5) + (size_t)(k0 + kr) * NPROJ + (sc < 0 ? 0 : sc), sc >= 0, NPROJ, WSP(bf16, WS_WIN) + (size_t)n0 * DM + k0, DM, scr, lane); return; }
    it -= I_IN;
    if (it < I_OUT) { const int kb = it >> 5, nb = it & 31, k0 = 64 * kb, n0 = 64 * nb;
        tr64(F.f(14) + (size_t)(k0 + kr) * DM + n0 + nq, true, DM, WSP(bf16, WS_WOUT) + (size_t)n0 * DM + k0, DM, scr, lane); return; }
    it -= I_OUT;
    if (it < I_GU) { const int e = it >> 9, r = it & 511, kb = r >> 4, nb = r & 15, k0 = 64 * kb;
        const int p = nb >> 2, bj = (nb >> 1) & 1, w0 = (nb & 1) * 64;
        const float* src = (e < NE) ? ((bj ? F.f(20) : F.f(19)) + (size_t)e * DM * DE) : (bj ? F.f(23) : F.f(22));
        tr64(src + (size_t)(k0 + kr) * DE + 128 * p + w0 + nq, true, DE, WSP(bf16, WS_WGU) + ((size_t)e * 1024 + 64 * nb) * DM + k0, DM, scr, lane); return; }
    it -= I_GU;
    { const int e = it >> 8, r = it & 255, kb = r >> 5, nb = r & 31, k0 = 64 * kb, n0 = 64 * nb;
        const float* src = (e < NE) ? (F.f(21) + (size_t)e * DE * DM) : F.f(24);
        tr64(src + (size_t)(k0 + kr) * DM + n0 + nq, true, DM, WSP(bf16, WS_WDN) + ((size_t)e * DM + n0) * DE + k0, DE, scr, lane); }
}
__device__ __forceinline__ void p0_prologue(Frame& F) {
    const int gw = F.bid() * 8 + F.wave(), NGW = F.G() * 8, gt = F.bid() * 512 + F.tid(), NGT = F.G() * 512;
    {
        LAS float* red = (LAS float*)F.lds();
        float* modp = WSP(float, WS_MODP);
        for (int item = F.bid(); item < 48 * 16; item += F.G()) {
            const int cc = item % 48, ks = item / 48;
            f32x4 a0 = {0.f, 0.f, 0.f, 0.f}, a1 = {0.f, 0.f, 0.f, 0.f};
            const int kbase = ks * 128 + F.wave() * 16;
#pragma unroll 4
            for (int i = 0; i < 16; ++i) { const int k = kbase + i;
                const float c0 = silu_f(F.f(1)[k]), c1 = silu_f(F.f(1)[DM + k]);
                const f32x4 wv = *(const f32x4*)(F.f(3) + (size_t)k * (6 * DM) + cc * 256 + F.lane() * 4);
                a0 += wv * c0; a1 += wv * c1; }
            *(LAS f32x4*)(red + (F.wave() * 2 + 0) * 256 + F.lane() * 4) = a0;
            *(LAS f32x4*)(red + (F.wave() * 2 + 1) * 256 + F.lane() * 4) = a1;
            __syncthreads();
            { const int b = F.tid() >> 8, col = F.tid() & 255; float s = 0.f;
#pragma unroll
              for (int w = 0; w < 8; ++w) s += red[(w * 2 + b) * 256 + col];
              modp[((size_t)ks * 2 + b) * (6 * DM) + cc * 256 + col] = s; }
            __syncthreads();
        }
    }
    {
        float* cosA = WSP(float, WS_COSA); float* sinA = WSP(float, WS_SINA); float* cosI = WSP(float, WS_COSI); float* sinI = WSP(float, WS_SINI);
        for (int i = gt; i < NTOK * 64; i += NGT) { const int tok = i >> 6, j = i & 63;
            const float inv = 1.0f / powf(10000.0f, (float)(2 * j) / 128.0f); const float ang = (float)F.i32(2)[tok] * inv;
            float s, c; sincosf(ang, &s, &c); cosA[i] = c; sinA[i] = s; }
        for (int i = gt; i < NTOK * 32; i += NGT) { const int tok = i >> 5, j = i & 31;
            const float inv = 1.0f / powf(10000.0f, (float)(2 * j) / 64.0f); const float ang = (float)F.i32(2)[tok] * inv;
            float s, c; sincosf(ang, &s, &c); cosI[i] = c; sinI[i] = s; }
    }
    {
        bf16* wr_hi = WSP(bf16, WS_WR); bf16* wr_lo = wr_hi + NE * DM;
        for (int i = gt; i < NE * (DM / 8); i += NGT) { const int e = i & 63, kc = i >> 6;
            float v[8], l[8];
#pragma unroll
            for (int j = 0; j < 8; ++j) { v[j] = F.f(17)[(size_t)(8 * kc + j) * NE + e]; l[j] = v[j] - bf2f(f2bf(v[j])); }
            u32x4 h = {cvt_pk_bf16(v[0], v[1]), cvt_pk_bf16(v[2], v[3]), cvt_pk_bf16(v[4], v[5]), cvt_pk_bf16(v[6], v[7])};
            u32x4 lo = {cvt_pk_bf16(l[0], l[1]), cvt_pk_bf16(l[2], l[3]), cvt_pk_bf16(l[4], l[5]), cvt_pk_bf16(l[6], l[7])};
            *(u32x4*)(wr_hi + (size_t)e * DM + 8 * kc) = h; *(u32x4*)(wr_lo + (size_t)e * DM + 8 * kc) = lo; }
    }
    {
        LAS float* scr = (LAS float*)(F.lds() + F.wave() * 16640);
        for (int it = gw; it < I_IN + I_OUT; it += NGW) tr_item(F, it, scr);
    }
}

constexpr int Q_GU = I_GU, Q_ALL = I_GU + I_DN, Q_GRAB = 16;
__device__ __forceinline__ void slack_fill(Frame& F, int budget, bool drain, int upto) {
    LAS float* scr = (LAS float*)(F.lds() + F.wave() * 16640);
    volatile LAS int* qw = (volatile LAS int*)(F.lds() + LDS_MISC + 16);
    __syncthreads();
    for (int gi = 0; drain || gi < budget; ++gi) {
        if (F.tid() == 0) { int stop = 0;
            const int idx = (int)__hip_atomic_fetch_add(F.ctl() + CW_QHEAD, (unsigned)Q_GRAB, RLX_AGENT); if (idx >= Q_ALL) stop = 1; else if (idx >= upto) stop = 2;
            qw[0] = stop; qw[1] = idx; }
        __syncthreads();
        const int stop = qw[0], idx = qw[1];
        __syncthreads();
        if (stop == 1) break;
#pragma unroll 1
        for (int i = 0; i < Q_GRAB / 8; ++i) { const int it = idx + i * 8 + F.wave(); if (it < Q_ALL) tr_item(F, I_IN + I_OUT + it, scr); }
        if (stop == 2) break;
    }
}

__device__ __forceinline__ void p1_modulate(Frame& F) {
    const float* modp = WSP(const float, WS_MODP); float* modf = WSP(float, WS_MODF); bf16* u1 = WSP(bf16, WS_U1);
    LAS float* sh = (LAS float*)F.lds(); LAS float* sc = sh + DM;
    for (int rg = F.bid(); rg < 256; rg += F.G()) {
        const int b = rg >> 7;
        if (F.tid() < 96) { const int v = rg * 96 + F.tid(); const int bb = v / (6 * DM), col = v % (6 * DM); float s = F.f(4)[col];
#pragma unroll
            for (int ks = 0; ks < 16; ++ks) s += modp[((size_t)ks * 2 + bb) * (6 * DM) + col];
            modf[v] = s; }
        { const int col = F.tid() * 4; f32x4 s0 = *(const f32x4*)(F.f(4) + col), s1 = *(const f32x4*)(F.f(4) + DM + col);
#pragma unroll
          for (int ks = 0; ks < 16; ++ks) { const float* p = modp + ((size_t)ks * 2 + b) * (6 * DM); s0 += *(const f32x4*)(p + col); s1 += *(const f32x4*)(p + DM + col); }
          *(LAS f32x4*)(sh + col) = s0; *(LAS f32x4*)(sc + col) = s1; }
        __syncthreads();
#pragma unroll
        for (int rr = 0; rr < 4; ++rr) { const int row = rg * 32 + F.wave() * 4 + rr;
#pragma unroll
            for (int j = 0; j < 8; ++j) { const int col = j * 256 + F.lane() * 4;
                const f32x4 xv = *(const f32x4*)(F.f(0) + (size_t)row * DM + col); const f32x4 s0 = *(const LAS f32x4*)(sh + col), s1 = *(const LAS f32x4*)(sc + col);
                const f32x4 u = xv * (s1 + 1.0f) + s0;
                u32x2 o = {cvt_pk_bf16(u[0], u[1]), cvt_pk_bf16(u[2], u[3])};
                *(u32x2*)(u1 + (size_t)row * DM + col) = o; } }
        __syncthreads();
    }
}
struct EpiInProj {
    static constexpr bool PERM = true;
    unsigned char* ws; const float *dt_bias, *lng, *lnb;
    __device__ __forceinline__ void operator()(const f32x4 (&acc)[2][2][4][2], const pg8::Unit& u, int wr, int wc, int fr, int fq) const {
        const int pn = u.pn; const int row0 = u.pm * 256 + wr * 64 + fr;
        if (pn < 10 || (pn >= 18 && pn < 22)) {
            size_t boff; int ld, col0;
            if (pn < 4) { boff = WS_Z; ld = 1024; col0 = pn * 256; } else if (pn < 10) { boff = WS_XBC; ld = CONV_CH; col0 = (pn - 4) * 256; } else { boff = WS_V; ld = 1024; col0 = (pn - 18) * 256; }
            bf16* base = (bf16*)(ws + boff);
            col0 += wc * 32 + 8 * fq;
#pragma unroll
            for (int ai = 0; ai < 2; ++ai)
#pragma unroll
                for (int m = 0; m < 4; ++m) { bf16* rowp = base + (size_t)(row0 + ai * 128 + m * 16) * ld + col0;
#pragma unroll
                    for (int bj = 0; bj < 2; ++bj) { const f32x4 v0 = acc[ai][bj][m][0], v1 = acc[ai][bj][m][1];
                        u32x4 w = {cvt_pk_bf16(v0[0], v0[1]), cvt_pk_bf16(v0[2], v0[3]), cvt_pk_bf16(v1[0], v1[1]), cvt_pk_bf16(v1[2], v1[3])};
                        *(u32x4*)(rowp + bj * 128) = w; } }
        } else if (pn < 26) {
            const bool att = pn < 18; const bool isq = pn < 14;
            bf16* base = (bf16*)(ws + (att ? (isq ? WS_Q : WS_K) : WS_QIDX)); const float* ct = (const float*)(ws + (att ? WS_COSA : WS_COSI)); const float* sn = (const float*)(ws + (att ? WS_SINA : WS_SINI));
            const int tw = att ? 64 : 32;
            const int head = att ? 2 * (pn - (isq ? 10 : 14)) + (wc >> 1) : 4 * (pn - 22) + wc, jj0 = att ? 32 * (wc & 1) + 8 * fq : 8 * fq;
#pragma unroll
            for (int ai = 0; ai < 2; ++ai)
#pragma unroll
                for (int m = 0; m < 4; ++m) { const int row = row0 + ai * 128 + m * 16;
                    bf16* rowp = base + (size_t)row * 1024 + head * (2 * tw) + jj0;
#pragma unroll
                    for (int n = 0; n < 2; ++n) { const f32x4 c = *(const f32x4*)(ct + (size_t)row * tw + jj0 + 4 * n), sv = *(const f32x4*)(sn + (size_t)row * tw + jj0 + 4 * n);
                        const f32x4 a = acc[ai][0][m][n], bb = acc[ai][1][m][n];
                        const f32x4 o1 = a * c - bb * sv, o2 = bb * c + a * sv;
                        *(u32x2*)(rowp + 4 * n) = (u32x2){cvt_pk_bf16(o1[0], o1[1]), cvt_pk_bf16(o1[2], o1[3])};
                        *(u32x2*)(rowp + tw + 4 * n) = (u32x2){cvt_pk_bf16(o2[0], o2[1]), cvt_pk_bf16(o2[2], o2[3])}; } }
        } else {
            const float* cosI = (const float*)(ws + WS_COSI); const float* sinI = (const float*)(ws + WS_SINI); bf16* kidx = (bf16*)(ws + WS_KIDX); float* widx = (float*)(ws + WS_WIDX); float* dt = (float*)(ws + WS_DT);
            if (wc == 0) {
                const int jj0 = 8 * fq;
#pragma unroll
                for (int am = 0; am < 8; ++am) { const int ai = am >> 2, m = am & 3; const int row = row0 + ai * 128 + m * 16;
                        f32x4 a0 = acc[ai][0][m][0], a1 = acc[ai][0][m][1], b0 = acc[ai][1][m][0], b1 = acc[ai][1][m][1];
                        float s = (a0[0] + a0[1] + a0[2] + a0[3]) + (a1[0] + a1[1] + a1[2] + a1[3]) + (b0[0] + b0[1] + b0[2] + b0[3]) + (b1[0] + b1[1] + b1[2] + b1[3]);
                        s += __shfl_xor(s, 16); s += __shfl_xor(s, 32);
                        const float mu = s * (1.0f / 64.0f);
                        a0 = a0 - mu; a1 = a1 - mu; b0 = b0 - mu; b1 = b1 - mu;
                        float qv = (a0[0] * a0[0] + a0[1] * a0[1] + a0[2] * a0[2] + a0[3] * a0[3]) + (a1[0] * a1[0] + a1[1] * a1[1] + a1[2] * a1[2] + a1[3] * a1[3])
                                 + (b0[0] * b0[0] + b0[1] * b0[1] + b0[2] * b0[2] + b0[3] * b0[3]) + (b1[0] * b1[0] + b1[1] * b1[1] + b1[2] * b1[2] + b1[3] * b1[3]);
                        qv += __shfl_xor(qv, 16); qv += __shfl_xor(qv, 32);
                        const float rstd = 1.0f / sqrtf(qv * (1.0f / 64.0f) + LN_EPS);
                        a0 = a0 * rstd * *(const f32x4*)(lng + jj0) + *(const f32x4*)(lnb + jj0); a1 = a1 * rstd * *(const f32x4*)(lng + jj0 + 4) + *(const f32x4*)(lnb + jj0 + 4);
                        b0 = b0 * rstd * *(const f32x4*)(lng + 32 + jj0) + *(const f32x4*)(lnb + 32 + jj0); b1 = b1 * rstd * *(const f32x4*)(lng + 36 + jj0) + *(const f32x4*)(lnb + 36 + jj0);
                        const f32x4 c0 = *(const f32x4*)(cosI + (size_t)row * 32 + jj0), c1 = *(const f32x4*)(cosI + (size_t)row * 32 + jj0 + 4);
                        const f32x4 s0 = *(const f32x4*)(sinI + (size_t)row * 32 + jj0), s1 = *(const f32x4*)(sinI + (size_t)row * 32 + jj0 + 4);
                        const f32x4 o10 = a0 * c0 - b0 * s0, o11 = a1 * c1 - b1 * s1, o20 = b0 * c0 + a0 * s0, o21 = b1 * c1 + a1 * s1;
                        bf16* rowp = kidx + (size_t)row * 64 + jj0;
                        u32x4 w1 = {cvt_pk_bf16(o10[0], o10[1]), cvt_pk_bf16(o10[2], o10[3]), cvt_pk_bf16(o11[0], o11[1]), cvt_pk_bf16(o11[2], o11[3])};
                        u32x4 w2 = {cvt_pk_bf16(o20[0], o20[1]), cvt_pk_bf16(o20[2], o20[3]), cvt_pk_bf16(o21[0], o21[1]), cvt_pk_bf16(o21[2], o21[3])};
                        *(u32x4*)rowp = w1; *(u32x4*)(rowp + 32) = w2; }
            } else if (wc == 1) {
                const int h0 = 8 * (fq & 1);
                const f32x4 db0 = *(const f32x4*)(dt_bias + h0), db1 = *(const f32x4*)(dt_bias + h0 + 4);
#pragma unroll
                for (int ai = 0; ai < 2; ++ai)
#pragma unroll
                    for (int m = 0; m < 4; ++m) { const int row = row0 + ai * 128 + m * 16;
                        const f32x4 a0 = acc[ai][0][m][0], a1 = acc[ai][0][m][1];
                        if (fq < 2) { *(f32x4*)(widx + (size_t)row * 16 + h0) = a0 * 0.03125f; *(f32x4*)(widx + (size_t)row * 16 + h0 + 4) = a1 * 0.03125f; }
                        else { f32x4 d0 = a0 + db0, d1 = a1 + db1;
#pragma unroll
                            for (int i = 0; i < 4; ++i) { d0[i] = d0[i] > 20.f ? d0[i] : log1pf(__expf(d0[i])); d1[i] = d1[i] > 20.f ? d1[i] : log1pf(__expf(d1[i])); }
                            *(f32x4*)(dt + (size_t)row * 16 + h0) = d0; *(f32x4*)(dt + (size_t)row * 16 + h0 + 4) = d1; } }
            }
        }
    }
};
__device__ __forceinline__ void idx_unit(Frame& F, int b, int qi, int ki) {
    const bf16* kidx = WSP(const bf16, WS_KIDX); const bf16* qidx = WSP(const bf16, WS_QIDX); const float* widx = WSP(const float, WS_WIDX); float* scores = WSP(float, WS_SCORES);
    const int lane = F.lane(), r32 = lane & 31, hi = lane >> 5, wq = F.wave() & 3, wk = F.wave() >> 2;
    const int kt0 = b * SEQ + ki * 128 + wk * 64, qtok = b * SEQ + qi * 128 + wq * 32 + r32;
    bf16x8 A[2][4];
#pragma unroll
    for (int kt = 0; kt < 2; ++kt)
#pragma unroll
        for (int ks = 0; ks < 4; ++ks) A[kt][ks] = *(const bf16x8*)(kidx + (size_t)(kt0 + kt * 32 + r32) * 64 + ks * 16 + hi * 8);
    f32x16 o0 = {}, o1 = {};
    const bf16* qrow = qidx + (size_t)qtok * 1024 + hi * 8;
#pragma unroll 1
    for (int h = 0; h < 16; ++h) { const float w = widx[(size_t)qtok * 16 + h];
        bf16x8 Bq[4];
#pragma unroll
        for (int ks = 0; ks < 4; ++ks) Bq[ks] = *(const bf16x8*)(qrow + h * 64 + ks * 16);
        f32x16 a0 = {}, a1 = {};
#pragma unroll
        for (int ks = 0; ks < 4; ++ks) { a0 = __builtin_amdgcn_mfma_f32_32x32x16_bf16(A[0][ks], Bq[ks], a0, 0, 0, 0); a1 = __builtin_amdgcn_mfma_f32_32x32x16_bf16(A[1][ks], Bq[ks], a1, 0, 0, 0); }
#pragma unroll
        for (int r = 0; r < 16; ++r) { o0[r] += w * fmaxf(a0[r], 0.f); o1[r] += w * fmaxf(a1[r], 0.f); } }
    LAS float* st = (LAS float*)(F.lds() + F.wave() * 8320);
    const int qpos = qi * 128 + wq * 32 + r32, kpos0 = ki * 128 + wk * 64;
    const float NEG = -__builtin_inff();
#pragma unroll
    for (int r = 0; r < 16; ++r) { const int kk = crow(r, hi);
        st[r32 * 65 + kk] = (kpos0 + kk > qpos) ? NEG : o0[r];
        st[r32 * 65 + 32 + kk] = (kpos0 + 32 + kk > qpos) ? NEG : o1[r]; }
    LDS_WAIT(); asm volatile("" ::: "memory");
    float* dst = scores + (size_t)(b * SEQ + qi * 128 + wq * 32) * SEQ + kpos0 + lane;
#pragma unroll 4
    for (int q = 0; q < 32; ++q) { *dst = st[q * 65 + lane]; dst += SEQ; }
    LDS_WAIT(); asm volatile("" ::: "memory");
}

constexpr int SA_P = 136;
constexpr int SA_BN = 0, SA_CN = 34816, SA_BT = 69632, SA_CB = 104448, SA_SM = 139264;
__device__ __forceinline__ void conv8(const bf16* xraw_row  , int tpos, const float* cw, const float* cb, float (&o)[8]) {
    const f32x4 b0 = *(const f32x4*)cb, b1 = *(const f32x4*)(cb + 4);
#pragma unroll
    for (int j = 0; j < 4; ++j) { o[j] = b0[j]; o[4 + j] = b1[j]; }
#pragma unroll
    for (int k = 0; k < 4; ++k) { const int dt_ = k - 3;
        if (tpos + dt_ >= 0) { const bf16x8 xv = *(const bf16x8*)(xraw_row + (long)dt_ * CONV_CH); float xf[8]; unpack8(xv, xf);
            const f32x4 w0 = *(const f32x4*)(cw + k * CONV_CH), w1 = *(const f32x4*)(cw + k * CONV_CH + 4);
#pragma unroll
            for (int j = 0; j < 4; ++j) { o[j] += w0[j] * xf[j]; o[4 + j] += w1[j] * xf[4 + j]; } } }
#pragma unroll
    for (int j = 0; j < 8; ++j) o[j] = silu_f(o[j]);
}
__device__ __forceinline__ void ssd_a_unit(Frame& F, int b, int c, int g, int hf) {
    const bf16* xbc = WSP(const bf16, WS_XBC); bf16* xact = WSP(bf16, WS_XBCACT); const float* dtg = WSP(const float, WS_DT); float* csg = WSP(float, WS_CS);
    float* ydiag = WSP(float, WS_YDIAG); float* states = WSP(float, WS_STATES);
    LAS bf16* Bn = (LAS bf16*)(F.lds() + SA_BN); LAS bf16* Cn = (LAS bf16*)(F.lds() + SA_CN); LAS bf16* BT = (LAS bf16*)(F.lds() + SA_BT); LAS bf16* CB = (LAS bf16*)(F.lds() + SA_CB);
    const int lane = F.lane(), r32 = lane & 31, hi = lane >> 5, w = F.wave();
    const int tok0 = b * SEQ + c * CHUNK;
#pragma unroll 2
    for (int i = 0; i < 8; ++i) { const int id = F.tid() + 512 * i, mi = id >> 11, rem = id & 2047, s = rem >> 4, ch = rem & 15;
        const int chan = 1024 + mi * 256 + g * 128 + ch * 8; float o[8];
        conv8(xbc + (size_t)(tok0 + s) * CONV_CH + chan, c * CHUNK + s, F.f(6) + chan, F.f(7) + chan, o);
        u32x4 pk = {cvt_pk_bf16(o[0], o[1]), cvt_pk_bf16(o[2], o[3]), cvt_pk_bf16(o[4], o[5]), cvt_pk_bf16(o[6], o[7])};
        if (mi == 0) { *(LAS u32x4*)(Bn + s * SA_P + ch * 8) = pk;
#pragma unroll
            for (int j = 0; j < 8; ++j) BT[(ch * 8 + j) * SA_P + s] = (bf16)((pk[j >> 1] >> (16 * (j & 1))) & 0xffffu); }
        else { *(LAS u32x4*)(Cn + s * SA_P + ch * 8) = pk; if (hf == 0) *(u32x4*)(xact + (size_t)(tok0 + s) * CONV_CH + chan) = pk; } }
    __syncthreads();
    { const int lt = w >> 1;
#pragma unroll
      for (int sq = 0; sq < 2; ++sq) { const int st = 2 * (w & 1) + sq; f32x16 a = {};
#pragma unroll
          for (int ks = 0; ks < 8; ++ks) { const bf16x8 av = *(const LAS bf16x8*)(Cn + (32 * lt + r32) * SA_P + 16 * ks + 8 * hi), bv = *(const LAS bf16x8*)(Bn + (32 * st + r32) * SA_P + 16 * ks + 8 * hi);
              a = __builtin_amdgcn_mfma_f32_32x32x16_bf16(av, bv, a, 0, 0, 0); }
#pragma unroll
          for (int r = 0; r < 16; ++r) CB[(32 * lt + crow(r, hi)) * SA_P + 32 * st + r32] = f2bf(a[r]); } }
    __syncthreads();
    const int j = w >> 1, sub = w & 1, h = 8 * g + 4 * hf + j;
    LAS bf16* XT = (LAS bf16*)(F.lds() + j * 17408);
    LAS float* cs_l = (LAS float*)(F.lds() + SA_SM) + j * 384; LAS float* wdec = cs_l + 128;
    {
        const float ah = -__expf(F.f(9)[h]);
        const float d0 = dtg[(size_t)(tok0 + lane) * 16 + h], d1 = dtg[(size_t)(tok0 + 64 + lane) * 16 + h];
        float c0 = d0 * ah, c1 = d1 * ah;
#pragma unroll
        for (int o = 1; o < 64; o <<= 1) { const float t0 = __shfl_up(c0, o), t1 = __shfl_up(c1, o); if (lane >= o) { c0 += t0; c1 += t1; } }
        const float tot0 = __shfl(c0, 63); c1 += tot0; const float cend = __shfl(c1, 63);
        if (sub == 0) { cs_l[lane] = c0; cs_l[64 + lane] = c1; wdec[lane] = __expf(cend - c0); wdec[64 + lane] = __expf(cend - c1);
            csg[(size_t)(tok0 + lane) * 16 + h] = c0; csg[(size_t)(tok0 + 64 + lane) * 16 + h] = c1; }
#pragma unroll 2
        for (int i = 0; i < 8; ++i) { const int id = lane + 64 * i, s = 64 * sub + (id >> 3), ch = id & 7, chan = h * 64 + ch * 8; float o[8];
            conv8(xbc + (size_t)(tok0 + s) * CONV_CH + chan, c * CHUNK + s, F.f(6) + chan, F.f(7) + chan, o);
            u32x4 pk = {cvt_pk_bf16(o[0], o[1]), cvt_pk_bf16(o[2], o[3]), cvt_pk_bf16(o[4], o[5]), cvt_pk_bf16(o[6], o[7])};
            *(u32x4*)(xact + (size_t)(tok0 + s) * CONV_CH + chan) = pk;
            const float dts = dtg[(size_t)(tok0 + s) * 16 + h];
#pragma unroll
            for (int jj = 0; jj < 8; ++jj) XT[(ch * 8 + jj) * SA_P + s] = f2bf(o[jj] * dts); }
    }
    __syncthreads();
#pragma unroll
    for (int lq = 0; lq < 2; ++lq) { const int lt = 2 * sub + lq; const int l = 32 * lt + r32; const float csl = cs_l[l];
        f32x16 a0 = {}, a1 = {};
        for (int ks = 0; ks <= 2 * lt + 1; ++ks) { const int s0 = 16 * ks + 8 * hi;
            float cbf[8]; unpack8(*(const LAS bf16x8*)(CB + l * SA_P + s0), cbf);
            const f32x4 q0 = *(const LAS f32x4*)(cs_l + s0), q1 = *(const LAS f32x4*)(cs_l + s0 + 4);
            float mv[8];
#pragma unroll
            for (int jj = 0; jj < 8; ++jj) { const float cq = jj < 4 ? q0[jj & 3] : q1[jj & 3]; mv[jj] = (s0 + jj <= l) ? cbf[jj] * __expf(csl - cq) : 0.f; }
            const bf16x8 av = pack8((f32x4){mv[0], mv[1], mv[2], mv[3]}, (f32x4){mv[4], mv[5], mv[6], mv[7]});
            const bf16x8 b0 = *(const LAS bf16x8*)(XT + r32 * SA_P + s0), b1 = *(const LAS bf16x8*)(XT + (32 + r32) * SA_P + s0);
            a0 = __builtin_amdgcn_mfma_f32_32x32x16_bf16(av, b0, a0, 0, 0, 0); a1 = __builtin_amdgcn_mfma_f32_32x32x16_bf16(av, b1, a1, 0, 0, 0); }
#pragma unroll
        for (int r = 0; r < 16; ++r) { float* yp = ydiag + (size_t)(tok0 + 32 * lt + crow(r, hi)) * D_SSM + h * 64 + r32; yp[0] = a0[r]; yp[32] = a1[r]; } }
    { f32x16 a[2][2] = {};
      for (int ks = 0; ks < 8; ++ks) { const int s0 = 16 * ks + 8 * hi;
          const f32x4 q0 = *(const LAS f32x4*)(wdec + s0), q1 = *(const LAS f32x4*)(wdec + s0 + 4);
          bf16x8 av[2];
#pragma unroll
          for (int pt = 0; pt < 2; ++pt) { float xf[8]; unpack8(*(const LAS bf16x8*)(XT + (32 * pt + r32) * SA_P + s0), xf);
              av[pt] = pack8((f32x4){xf[0] * q0[0], xf[1] * q0[1], xf[2] * q0[2], xf[3] * q0[3]}, (f32x4){xf[4] * q1[0], xf[5] * q1[1], xf[6] * q1[2], xf[7] * q1[3]}); }
#pragma unroll
          for (int nq = 0; nq < 2; ++nq) { const bf16x8 bv = *(const LAS bf16x8*)(BT + (32 * (2 * sub + nq) + r32) * SA_P + s0);
#pragma unroll
              for (int pt = 0; pt < 2; ++pt) a[pt][nq] = __builtin_amdgcn_mfma_f32_32x32x16_bf16(av[pt], bv, a[pt][nq], 0, 0, 0); } }
      float* sp = states + ((size_t)((b * NCHUNK + c) * SSM_H + h) * SSM_P) * SSM_N;
#pragma unroll
      for (int pt = 0; pt < 2; ++pt)
#pragma unroll
          for (int nq = 0; nq < 2; ++nq)
#pragma unroll
              for (int r = 0; r < 16; ++r) sp[(size_t)(32 * pt + crow(r, hi)) * SSM_N + 32 * (2 * sub + nq) + r32] = a[pt][nq][r]; }
    __syncthreads();
}
__device__ __forceinline__ void p3_phase(Frame& F) {
    constexpr int N_SSD = NBATCH * NCHUNK * 2 * 2, N_IDX = NBATCH * 528;
    int L = F.bid();
#pragma unroll 1
    for (; L < N_SSD; L += F.G()) { const int hf = L & 1, g = (L >> 1) & 1, c = (L >> 2) & 31, b = L >> 7; ssd_a_unit(F, b, c, g, hf); }
#pragma unroll 1
    for (; L < N_SSD + N_IDX; L += F.G()) { const int p0 = L - N_SSD, b = p0 / 528, p = p0 % 528;
        int qi = (int)((sqrtf(8.f * (float)p + 1.f) - 1.f) * 0.5f);
        while (qi * (qi + 1) / 2 > p) --qi;
        while ((qi + 1) * (qi + 2) / 2 <= p) ++qi;
        idx_unit(F, b, qi, p - qi * (qi + 1) / 2); }
}
__device__ __forceinline__ unsigned fkey(float f) { const unsigned u = __float_as_uint(f); return (u & 0x80000000u) ? ~u : (u | 0x80000000u); }
__device__ __forceinline__ void select_row(Frame& F, int row, LAS unsigned* hist, LAS unsigned* keys) {
    const float* sc = WSP(const float, WS_SCORES) + (size_t)row * SEQ; unsigned long long* mrow = WSP(unsigned long long, WS_MASK) + (size_t)row * 64;
    const int lane = F.lane(), t = row & (SEQ - 1);
    if (t < TOPK_SEL) {
        const int lo = 64 * lane; unsigned long long m;
        if (lo + 63 <= t) m = ~0ull; else if (lo > t) m = 0ull; else m = (1ull << (t - lo + 1)) - 1ull;
        mrow[lane] = m; return;
    }
    const int nI = (t >> 6) + 1;
#pragma unroll 8
    for (int i = 0; i < nI; ++i) { const int e = 64 * i + lane; float v = 0.f; if (e <= t) v = sc[e]; keys[e] = (e <= t) ? fkey(v) : 0u; }
    unsigned prefix = 0u, need = TOPK_SEL, pmask = 0u, cnt_eq = 0u;
#pragma unroll 1
    for (int pass = 0; pass < 4; ++pass) { const int shift = 24 - 8 * pass;
        hist[4 * lane] = 0u; hist[4 * lane + 1] = 0u; hist[4 * lane + 2] = 0u; hist[4 * lane + 3] = 0u;
        LDS_WAIT(); asm volatile("" ::: "memory");
#pragma unroll 4
        for (int i = 0; i < nI; ++i) { const unsigned k = keys[64 * i + lane]; if ((k & pmask) == prefix && k != 0u) __hip_atomic_fetch_add(hist + ((k >> shift) & 255u), 1u, __ATOMIC_RELAXED, __HIP_MEMORY_SCOPE_WORKGROUP); }
        LDS_WAIT(); asm volatile("" ::: "memory");
        const unsigned c0 = hist[4 * lane], c1 = hist[4 * lane + 1], c2 = hist[4 * lane + 2], c3 = hist[4 * lane + 3];
        const unsigned tot = c0 + c1 + c2 + c3;
        unsigned suf = tot;
#pragma unroll
        for (int o = 1; o < 64; o <<= 1) { const unsigned tt = __shfl_down(suf, o); if (lane + o < 64) suf += tt; }
        unsigned above = suf - tot;
        int found = -1; unsigned nneed = 0u, fcnt = 0u;
        if (above < need && need <= above + c3) { found = 3; nneed = need - above; fcnt = c3; }
        above += c3;
        if (found < 0 && above < need && need <= above + c2) { found = 2; nneed = need - above; fcnt = c2; }
        above += c2;
        if (found < 0 && above < need && need <= above + c1) { found = 1; nneed = need - above; fcnt = c1; }
        above += c1;
        if (found < 0 && above < need && need <= above + c0) { found = 0; nneed = need - above; fcnt = c0; }
        const unsigned long long bal = __ballot(found >= 0);
        const int src = (int)__builtin_ctzll(bal | (1ull << 63));
        const unsigned digit = (unsigned)__shfl(4 * lane + found, src);
        need = (unsigned)__shfl((int)nneed, src); cnt_eq = (unsigned)__shfl((int)fcnt, src);
        prefix |= digit << shift; pmask |= 255u << shift;
        LDS_WAIT(); asm volatile("" ::: "memory");
    }
    const bool all_eq = (cnt_eq == need);
    unsigned run = 0u; unsigned long long myword = 0ull;
    const unsigned long long lt_mask = (lane == 0) ? 0ull : (~0ull >> (64 - lane));
#pragma unroll 4
    for (int i = 0; i < nI; ++i) {
        const unsigned k = keys[64 * i + lane]; bool sel = k > prefix;
        if (all_eq) { sel = sel || (k == prefix); }
        else { const unsigned long long em = __ballot(k == prefix); if (k == prefix) sel = (run + (unsigned)__popcll(em & lt_mask)) < need; run += (unsigned)__popcll(em); }
        const unsigned long long wb = __ballot(sel);
        if (lane == i) myword = wb;
    }
    mrow[lane] = myword;
    LDS_WAIT(); asm volatile("" ::: "memory");
}
__device__ __forceinline__ void p4_select(Frame& F) {
    LAS unsigned* keys = (LAS unsigned*)(F.lds() + F.wave() * 16384); LAS unsigned* hist = (LAS unsigned*)(F.lds() + 131072 + F.wave() * 1024);
    const int gw = F.bid() * 8 + F.wave(), NGW = F.G() * 8;
    for (int pr = gw; pr < SEQ / 2; pr += NGW) {
#pragma unroll 1
        for (int b = 0; b < NBATCH; ++b) { select_row(F, b * SEQ + pr, hist, keys); select_row(F, b * SEQ + (SEQ - 1 - pr), hist, keys); }
    }
}
__device__ __forceinline__ void p4_scan(Frame& F) {
    const float* states = WSP(const float, WS_STATES); bf16* hin = WSP(bf16, WS_HIN); const float* csg = WSP(const float, WS_CS);
    const int gt = F.bid() * 512 + F.tid(), NGT = F.G() * 512;
    for (int q = gt; q < NBATCH * SSM_H * SSM_P * (SSM_N / 2); q += NGT) {
        const int n = 2 * (q & 63), p = (q >> 6) & 63, h = (q >> 12) & 15, b = q >> 16;
        float h0 = 0.f, h1 = 0.f;
#pragma unroll 8
        for (int c = 0; c < NCHUNK; ++c) {
            const size_t off = ((size_t)((b * NCHUNK + c) * SSM_H + h) * SSM_P + p) * SSM_N + n;
            *(unsigned*)(hin + off) = cvt_pk_bf16(h0, h1);
            const float dec = __expf(csg[(size_t)(b * SEQ + c * CHUNK + CHUNK - 1) * 16 + h]);
            const f32x2 st = *(const f32x2*)(states + off);
            h0 = dec * h0 + st[0]; h1 = dec * h1 + st[1];
        }
    }
}
namespace att {
constexpr int KVBLK = 64, SHM_K = KVBLK * 128 * 2, SHM_V = SHM_K;
constexpr float SCALE = 0.08838834764831845f, THR = 8.f, C2 = 1.4426950408889634f * SCALE;
#define KSWZ(row, colB) ((row) * 256 + ((colB) ^ (((row) & 7) << 4)))
__device__ __forceinline__ int v_st(int k, int c) { const int kk = (k & ~0xC) | ((k & 4) << 1) | ((k & 8) >> 1); return ((kk >> 3) * 4 + (c >> 5)) * 512 + ((kk & 7) * 32 + (c & 31)) * 2; }
__device__ __forceinline__ int v_rd_base(int lane) { return ((lane & 3) << 3) | (((lane >> 2) & 3) << 6) | (((lane >> 4) & 1) << 5) | (((lane >> 5) & 1) << 8); }
constexpr int v_rd_off(int d0, int ks, int half) { return d0 * 512 + ks * 4096 + half * 2048; }
template <int KB>
__device__ __forceinline__ void qkt(f32x16& p0, f32x16& p1, LAS const char* K_lds, int r32, int hi, const bf16x8* qr) {
    p0 = f32x16{}; p1 = f32x16{};
    LAS const char* kb[4];
#pragma unroll
    for (int dd = 0; dd < 4; ++dd) kb[dd] = K_lds + KB * SHM_K + KSWZ(r32, (dd * 16 + hi * 8) * 2);
#pragma unroll
    for (int d0 = 0; d0 < 8; ++d0) { LAS const char* a = kb[d0 & 3] + (d0 >> 2) * 128;
        const bf16x8 b0 = *(LAS const bf16x8*)a;
        const bf16x8 b1 = *(LAS const bf16x8*)(a + 32 * 256);
        p0 = __builtin_amdgcn_mfma_f32_32x32x16_bf16(b0, qr[d0], p0, 0, 0, 0);
        p1 = __builtin_amdgcn_mfma_f32_32x32x16_bf16(b1, qr[d0], p1, 0, 0, 0); }
}
template <int VB>
__device__ __forceinline__ void pv_tile(f32x16* o, int vb0, bf16x8 pa0, bf16x8 pa1, bf16x8 pa2, bf16x8 pa3) {
#define TRRD(dst, off) asm volatile("ds_read_b64_tr_b16 %0, %1 offset:%2" : "=&v"(dst) : "v"(vb0), "i"(off) : "memory")
#define PV_D0(d0) do { s16x4 l0, l1, l2, l3, h0, h1, h2, h3; constexpr int b_ = VB * SHM_V + v_rd_off(d0, 0, 0); \
        TRRD(l0, b_); TRRD(h0, b_ + 2048); TRRD(l1, b_ + 4096); TRRD(h1, b_ + 6144); TRRD(l2, b_ + 8192); TRRD(h2, b_ + 10240); TRRD(l3, b_ + 12288); TRRD(h3, b_ + 14336); \
        asm volatile("s_waitcnt lgkmcnt(0)" ::: "memory"); __builtin_amdgcn_sched_barrier(0); \
        o[d0] = __builtin_amdgcn_mfma_f32_32x32x16_bf16(pa0, (bf16x8){l0[0], l0[1], l0[2], l0[3], h0[0], h0[1], h0[2], h0[3]}, o[d0], 0, 0, 0);   \
        o[d0] = __builtin_amdgcn_mfma_f32_32x32x16_bf16(pa1, (bf16x8){l1[0], l1[1], l1[2], l1[3], h1[0], h1[1], h1[2], h1[3]}, o[d0], 0, 0, 0);   \
        o[d0] = __builtin_amdgcn_mfma_f32_32x32x16_bf16(pa2, (bf16x8){l2[0], l2[1], l2[2], l2[3], h2[0], h2[1], h2[2], h2[3]}, o[d0], 0, 0, 0);   \
        o[d0] = __builtin_amdgcn_mfma_f32_32x32x16_bf16(pa3, (bf16x8){l3[0], l3[1], l3[2], l3[3], h3[0], h3[1], h3[2], h3[3]}, o[d0], 0, 0, 0); } while (0)
    PV_D0(0); PV_D0(1); PV_D0(2); PV_D0(3);
#undef PV_D0
#undef TRRD
}
__device__ __forceinline__ void softmax_tile(f32x16& p0, f32x16& p1, unsigned long long mw, int hi, float& m_reg, float& l_reg, float& alpha, bf16x8& pa0, bf16x8& pa1, bf16x8& pa2, bf16x8& pa3) {
    float pmax = p0[0];
#pragma unroll
    for (int r = 1; r < 16; ++r) pmax = fmaxf(pmax, p0[r]);
#pragma unroll
    for (int r = 0; r < 16; ++r) pmax = fmaxf(pmax, p1[r]);
    { auto rr = __builtin_amdgcn_permlane32_swap(__float_as_uint(pmax), __float_as_uint(pmax), false, false); pmax = fmaxf(__uint_as_float(rr[0]), __uint_as_float(rr[1])); }
    float mn;
    if (__all((pmax - m_reg) * SCALE <= THR)) { mn = m_reg; alpha = 1.f; }
    else { mn = fmaxf(m_reg, pmax); alpha = __builtin_amdgcn_exp2f((m_reg - mn) * C2); m_reg = mn; }
    const float mnL = -mn * C2;
    const int lo = (int)((unsigned)mw >> (4 * hi)), hh = (int)((unsigned)(mw >> 32) >> (4 * hi));
#pragma unroll
    for (int r = 0; r < 16; ++r) { const int c = (r & 3) + 8 * (r >> 2);
        const float e0 = __builtin_amdgcn_exp2f(fmaf(p0[r], C2, mnL)), e1 = __builtin_amdgcn_exp2f(fmaf(p1[r], C2, mnL));
        p0[r] = __uint_as_float(__float_as_uint(e0) & (unsigned)__builtin_amdgcn_sbfe(lo, c, 1));
        p1[r] = __uint_as_float(__float_as_uint(e1) & (unsigned)__builtin_amdgcn_sbfe(hh, c, 1)); }
    float ps = 0.f;
#pragma unroll
    for (int r = 0; r < 16; ++r) ps += p0[r];
#pragma unroll
    for (int r = 0; r < 16; ++r) ps += p1[r];
    { auto rr = __builtin_amdgcn_permlane32_swap(__float_as_uint(ps), __float_as_uint(ps), false, false); ps = __uint_as_float(rr[0]) + __uint_as_float(rr[1]); }
    l_reg = l_reg * alpha + ps;
#define PK4(P, B_, OUT) do { unsigned a0 = cvt_pk_bf16(P[B_+0], P[B_+1]), a1 = cvt_pk_bf16(P[B_+2], P[B_+3]); \
        unsigned b0 = cvt_pk_bf16(P[B_+4], P[B_+5]), b1 = cvt_pk_bf16(P[B_+6], P[B_+7]); \
        auto r0 = __builtin_amdgcn_permlane32_swap(a0, b0, false, false); auto r1 = __builtin_amdgcn_permlane32_swap(a1, b1, false, false); \
        u32x4 w = {r0[0], r1[0], r0[1], r1[1]}; OUT = __builtin_bit_cast(bf16x8, w); } while (0)
    PK4(p0, 0, pa0); PK4(p0, 8, pa1); PK4(p1, 0, pa2); PK4(p1, 8, pa3);
#undef PK4
}
}

__device__ __forceinline__ void attn_item(Frame& F, int b, int h, int X) {
    using namespace att;
    const bf16* qg = WSP(const bf16, WS_Q); const bf16* kg = WSP(const bf16, WS_K) + (size_t)(b * SEQ) * 1024 + h * 128; const bf16* vg = WSP(const bf16, WS_V) + (size_t)(b * SEQ) * 1024 + h * 128;
    const unsigned long long* maskg = WSP(const unsigned long long, WS_MASK); bf16* ycat = WSP(bf16, WS_YCAT);
    const int tid = F.tid(), wid = F.wave(), lane = F.lane(), r32 = lane & 31, hi = lane >> 5;
    LAS char* V_lds = (LAS char*)F.lds(); LAS char* K_lds = V_lds + 2 * SHM_V;
    LAS float* wsl = (LAS float*)(F.lds() + 2 * SHM_V + 2 * SHM_K) + wid * 64; LAS float* li_l = wsl; LAS float* al_l = wsl + 32;
    const int tokq = b * SEQ + X * 256 + wid * 32 + r32, NT = 4 * X + 4;
    bf16x8 qr[8];
#pragma unroll
    for (int d0 = 0; d0 < 8; ++d0) qr[d0] = *(const bf16x8*)(qg + (size_t)tokq * 1024 + h * 128 + d0 * 16 + hi * 8);
    const unsigned long long* mrow = maskg + (size_t)tokq * 64;
    const int sr = tid >> 4, sc = (tid & 15) * 8, vst0 = v_st(sr, sc), vst1 = v_st(32 + sr, sc), kws = KSWZ(sr, sc * 2);
    const int vb0 = (int)(unsigned)(uintptr_t)V_lds + v_rd_base(lane);
    float m_reg = -1e30f, l_reg = 0.f; f32x16 o[4] = {};
    bf16x8 st_k0, st_k1, st_v0, st_v1;
#define ALOAD(t) do { const size_t r0_ = (size_t)((t) * KVBLK + sr) * 1024 + sc; st_k0 = *(const bf16x8*)(kg + r0_); st_k1 = *(const bf16x8*)(kg + r0_ + 32 * 1024); \
                      st_v0 = *(const bf16x8*)(vg + r0_); st_v1 = *(const bf16x8*)(vg + r0_ + 32 * 1024); } while (0)
#define AWRITE(bf) do { *(LAS bf16x8*)(K_lds + (bf) * SHM_K + kws) = st_k0; *(LAS bf16x8*)(K_lds + (bf) * SHM_K + kws + 32 * 256) = st_k1; \
                        *(LAS bf16x8*)(V_lds + (bf) * SHM_V + vst0) = st_v0; *(LAS bf16x8*)(V_lds + (bf) * SHM_V + vst1) = st_v1; } while (0)
#define ASTEP(t, KB) do { AWRITE(KB); __syncthreads(); \
        const unsigned long long mw_ = mrow[(t)]; if ((t) + 1 < NT) ALOAD((t) + 1); \
        f32x16 p0, p1; float alpha; bf16x8 pa0, pa1, pa2, pa3; \
        qkt<KB>(p0, p1, K_lds, r32, hi, qr); \
        softmax_tile(p0, p1, mw_, hi, m_reg, l_reg, alpha, pa0, pa1, pa2, pa3); \
        if (__any(alpha < 1.f)) { if (hi == 0) al_l[r32] = alpha; LDS_WAIT(); \
            _Pragma("unroll") for (int d_ = 0; d_ < 4; ++d_) _Pragma("unroll") for (int r = 0; r < 16; ++r) o[d_][r] *= al_l[crow(r, hi)]; } \
        pv_tile<KB>(o, vb0, pa0, pa1, pa2, pa3); } while (0)
    ALOAD(0);
    for (int t = 0; t < NT; t += 2) { ASTEP(t, 0); ASTEP(t + 1, 1); }
#undef ASTEP
#undef AWRITE
#undef ALOAD
    if (hi == 0) li_l[r32] = l_reg; LDS_WAIT();
    float rli[16];
#pragma unroll
    for (int r = 0; r < 16; ++r) rli[r] = __builtin_amdgcn_rcpf(li_l[crow(r, hi)]);
    bf16* Ow = ycat + (size_t)(b * SEQ + X * 256 + wid * 32) * DM + D_SSM + h * 128;
#pragma unroll
    for (int r = 0; r < 16; ++r) { const int orow = crow(r, hi);
#pragma unroll
        for (int d0 = 0; d0 < 4; ++d0) { const float v = o[d0][r] * rli[r]; const float vn = __shfl_xor(v, 1);
            if ((r32 & 1) == 0) *(unsigned*)(Ow + (size_t)orow * DM + d0 * 32 + r32) = cvt_pk_bf16(v, vn); } }
    __syncthreads();
}

__device__ __forceinline__ void ssd_c_unit(Frame& F, int b, int c, int lq) {
    const bf16* xact = WSP(const bf16, WS_XBCACT); const bf16* hin = WSP(const bf16, WS_HIN); const float* csg = WSP(const float, WS_CS); const float* ydiag = WSP(const float, WS_YDIAG);
    const bf16* zg = WSP(const bf16, WS_Z); bf16* ycat = WSP(bf16, WS_YCAT);
    LAS float* gb = (LAS float*)F.lds();
    const int lane = F.lane(), r32 = lane & 31, hi = lane >> 5, w = F.wave(), g = w >> 2;
    const int tok0 = b * SEQ + c * CHUNK + lq * 32;
    bf16x8 Af[8];
#pragma unroll
    for (int ks = 0; ks < 8; ++ks) Af[ks] = *(const bf16x8*)(xact + (size_t)(tok0 + r32) * CONV_CH + 1280 + g * 128 + 16 * ks + 8 * hi);
#pragma unroll
    for (int hh = 0; hh < 2; ++hh) { const int h = 2 * w + hh;
        const bf16* hp = hin + ((size_t)((b * NCHUNK + c) * SSM_H + h) * SSM_P) * SSM_N;
        f32x16 a0 = {}, a1 = {};
#pragma unroll
        for (int ks = 0; ks < 8; ++ks) { const bf16x8 b0 = *(const bf16x8*)(hp + (size_t)r32 * SSM_N + 16 * ks + 8 * hi), b1 = *(const bf16x8*)(hp + (size_t)(32 + r32) * SSM_N + 16 * ks + 8 * hi);
            a0 = __builtin_amdgcn_mfma_f32_32x32x16_bf16(Af[ks], b0, a0, 0, 0, 0); a1 = __builtin_amdgcn_mfma_f32_32x32x16_bf16(Af[ks], b1, a1, 0, 0, 0); }
        const float dsk = F.f(10)[h];
#pragma unroll
        for (int r = 0; r < 16; ++r) { const int l = crow(r, hi); const size_t tok = (size_t)(tok0 + l);
            const float e = __expf(csg[tok * 16 + h]);
#pragma unroll
            for (int pt = 0; pt < 2; ++pt) { const int col = h * 64 + 32 * pt + r32;
                const float y = ydiag[tok * D_SSM + col] + e * (pt ? a1[r] : a0[r]) + dsk * bf2f(xact[tok * CONV_CH + col]);
                gb[l * 1024 + col] = y * silu_f(bf2f(zg[tok * 1024 + col])); } } }
    __syncthreads();
#pragma unroll
    for (int rr = 0; rr < 4; ++rr) { const int l = 4 * w + rr; float ss = 0.f; f32x4 v[4];
#pragma unroll
        for (int j = 0; j < 4; ++j) { v[j] = *(const LAS f32x4*)(gb + l * 1024 + j * 256 + lane * 4); ss += v[j][0] * v[j][0] + v[j][1] * v[j][1] + v[j][2] * v[j][2] + v[j][3] * v[j][3]; }
        const float rs = 1.0f / sqrtf(wave_sum(ss) * (1.0f / 1024.0f) + LN_EPS);
#pragma unroll
        for (int j = 0; j < 4; ++j) { const f32x4 nw = *(const f32x4*)(F.f(11) + j * 256 + lane * 4); const f32x4 y = v[j] * rs * nw;
            u32x2 o = {cvt_pk_bf16(y[0], y[1]), cvt_pk_bf16(y[2], y[3])};
            *(u32x2*)(ycat + (size_t)(tok0 + l) * DM + j * 256 + lane * 4) = o; } }
    __syncthreads();
}
__device__ __forceinline__ void p5_phase(Frame& F) {
    for (int L = F.bid(); L < 256; L += F.G()) { const int lq = L & 3, c = (L >> 2) & 31, b = L >> 7; ssd_c_unit(F, b, c, lq); }
    for (int L = F.bid(); L < 256; L += F.G()) { const int X = 15 - (L >> 4), h = L & 7, b = (L >> 3) & 1; attn_item(F, b, h, X); }
}
struct EpiOutProj {
    static constexpr bool PERM = false;
    const float* x; const float* modf; float* out;
    __device__ __forceinline__ void operator()(const f32x4 (&acc)[2][2][4][2], const pg8::Unit& u, int wr, int wc, int fr, int fq) const {
        const int row0 = u.pm * 256 + wr * 64 + fr, col0 = u.pn * 256 + wc * 32 + 4 * fq; const int b = (u.pm * 256) / SEQ;
        f32x4 gv[2][2];
#pragma unroll
        for (int bj = 0; bj < 2; ++bj)
#pragma unroll
            for (int n = 0; n < 2; ++n) gv[bj][n] = *(const f32x4*)(modf + (size_t)b * (6 * DM) + 2 * DM + col0 + bj * 128 + n * 16);
#pragma unroll
        for (int ai = 0; ai < 2; ++ai)
#pragma unroll
            for (int m = 0; m < 4; ++m) { const size_t off = (size_t)(row0 + ai * 128 + m * 16) * DM + col0;
#pragma unroll
                for (int bj = 0; bj < 2; ++bj)
#pragma unroll
                    for (int n = 0; n < 2; ++n) { const f32x4 xv = *(const f32x4*)(x + off + bj * 128 + n * 16);
                        *(f32x4*)(out + off + bj * 128 + n * 16) = xv * ALPHA_DN + gv[bj][n] * acc[ai][bj][m][n]; } }
    }
};

constexpr int RT_P = 2056;
__device__ __forceinline__ void p7_unit(Frame& F, int un) {
    const float* modf = WSP(const float, WS_MODF); bf16* u2 = WSP(bf16, WS_U2); const bf16* wr_hi = WSP(const bf16, WS_WR); const bf16* wr_lo = wr_hi + NE * DM;
    int* inv = WSP(int, WS_INV); int* ltok = WSP(int, WS_LTOK); float* lw = WSP(float, WS_LW);
    LAS bf16* Ah = (LAS bf16*)F.lds(); LAS bf16* Al = Ah + 16 * RT_P; LAS float* red = (LAS float*)F.lds();
    LAS float* logit = (LAS float*)(F.lds() + 135168);
    const int lane = F.lane(), w = F.wave(), row0 = un * 16, b = row0 / SEQ;
    const float* sh2 = modf + (size_t)b * (6 * DM) + 3 * DM; const float* sc2 = modf + (size_t)b * (6 * DM) + 4 * DM;
#pragma unroll
    for (int rr = 0; rr < 2; ++rr) { const int rl = 2 * w + rr; const size_t row = (size_t)(row0 + rl);
        f32x4 v[8]; float s = 0.f;
#pragma unroll
        for (int j = 0; j < 8; ++j) { v[j] = *(const f32x4*)(F.out() + row * DM + j * 256 + lane * 4); s += (v[j][0] + v[j][1]) + (v[j][2] + v[j][3]); }
        const float mu = wave_sum(s) * (1.0f / DM); float q = 0.f;
#pragma unroll
        for (int j = 0; j < 8; ++j) { v[j] = v[j] - mu; q += (v[j][0] * v[j][0] + v[j][1] * v[j][1]) + (v[j][2] * v[j][2] + v[j][3] * v[j][3]); }
        const float rstd = 1.0f / sqrtf(wave_sum(q) * (1.0f / DM) + LN_EPS);
#pragma unroll
        for (int j = 0; j < 8; ++j) { const int col = j * 256 + lane * 4;
            const f32x4 x1 = v[j] * rstd * *(const f32x4*)(F.f(15) + col) + *(const f32x4*)(F.f(16) + col);
            *(f32x4*)(F.out() + row * DM + col) = x1;
            const f32x4 uu = x1 * (*(const f32x4*)(sc2 + col) + 1.0f) + *(const f32x4*)(sh2 + col);
            const unsigned h0 = cvt_pk_bf16(uu[0], uu[1]), h1 = cvt_pk_bf16(uu[2], uu[3]);
            *(u32x2*)(u2 + row * DM + col) = (u32x2){h0, h1};
            const unsigned l0 = cvt_pk_bf16(uu[0] - bflo(h0), uu[1] - bfhi(h0)), l1 = cvt_pk_bf16(uu[2] - bflo(h1), uu[3] - bfhi(h1));
            *(LAS u32x2*)(Ah + rl * RT_P + col) = (u32x2){h0, h1}; *(LAS u32x2*)(Al + rl * RT_P + col) = (u32x2){l0, l1}; } }
    __syncthreads();
    f32x4 acc[4] = {};
    { const int fr = lane & 15, fq = lane >> 4;
#pragma unroll 2
      for (int ks = 0; ks < 8; ++ks) { const int k0 = w * 256 + ks * 32 + fq * 8;
          const bf16x8 ah = *(const LAS bf16x8*)(Ah + fr * RT_P + k0), al = *(const LAS bf16x8*)(Al + fr * RT_P + k0);
#pragma unroll
          for (int nt = 0; nt < 4; ++nt) { const bf16x8 bh = *(const bf16x8*)(wr_hi + (size_t)(16 * nt + fr) * DM + k0), bl = *(const bf16x8*)(wr_lo + (size_t)(16 * nt + fr) * DM + k0);
              acc[nt] = __builtin_amdgcn_mfma_f32_16x16x32_bf16(ah, bh, acc[nt], 0, 0, 0);
              acc[nt] = __builtin_amdgcn_mfma_f32_16x16x32_bf16(al, bh, acc[nt], 0, 0, 0);
              acc[nt] = __builtin_amdgcn_mfma_f32_16x16x32_bf16(ah, bl, acc[nt], 0, 0, 0); } }
      __syncthreads();
#pragma unroll
      for (int nt = 0; nt < 4; ++nt)
#pragma unroll
          for (int r = 0; r < 4; ++r) red[(w * 16 + fq * 4 + r) * 64 + 16 * nt + fr] = acc[nt][r]; }
    __syncthreads();
#pragma unroll
    for (int i = 0; i < 2; ++i) { const int o = F.tid() + 512 * i; float s = 0.f;
#pragma unroll
        for (int ww = 0; ww < 8; ++ww) s += red[ww * 1024 + o];
        logit[o] = s; }
    __syncthreads();
#pragma unroll 1
    for (int rr = 0; rr < 2; ++rr) { const int rl = 2 * w + rr, tok = row0 + rl;
        const float score = sigmoid_f(logit[rl * 64 + lane]); const float biased = score + F.f(18)[lane];
        float m1 = biased;
#pragma unroll
        for (int o = 1; o < 8; o <<= 1) m1 = fmaxf(m1, __shfl_xor(m1, o));
        int i1 = (biased == m1) ? lane : 64;
#pragma unroll
        for (int o = 1; o < 8; o <<= 1) i1 = min(i1, __shfl_xor(i1, o));
        float m2 = (lane == i1) ? -__builtin_inff() : biased;
#pragma unroll
        for (int o = 1; o < 8; o <<= 1) m2 = fmaxf(m2, __shfl_xor(m2, o));
        const float gs = m1 + m2; const int grp = lane >> 3;
        int grank = 0;
#pragma unroll
        for (int g2 = 0; g2 < 8; ++g2) { const float og = __shfl(gs, 8 * g2); grank += (og > gs || (og == gs && g2 < grp)) ? 1 : 0; }
        const float mk = (grank < 4) ? biased : -__builtin_inff();
        int erank = 0;
#pragma unroll 4
        for (int e2 = 0; e2 < 64; ++e2) { const float oe = __shfl(mk, e2); erank += (oe > mk || (oe == mk && e2 < lane)) ? 1 : 0; }
        const bool sel = erank < 8;
        const float wsum = wave_sum(sel ? score : 0.f);
        if (sel) { const float gw = score / wsum * 2.5f;
            const int rk = (int)__hip_atomic_fetch_add(F.ctl() + CW_ECNT + 64 * lane, 1u, RLX_AGENT);
            ltok[lane * NTOK + rk] = tok; lw[lane * NTOK + rk] = gw; inv[tok * 8 + erank] = lane * NTOK + rk; } }
    __syncthreads();
}
__device__ __forceinline__ void p7_phase(Frame& F) { for (int un = F.bid(); un < NTOK / 16; un += F.G()) p7_unit(F, un); }
struct MoeOrder {
    const LAS int* tab; const int* ltok; int G, c, npn;
    __device__ __forceinline__ bool next(int i, pg8::Unit& u) const {
        const int L = i * G + c; const int total = tab[80 + NEX] * npn; if (L >= total) return false;
        int e = 0;
        for (int k = 1; k < NEX; ++k) e += (tab[80 + k] * npn <= L) ? 1 : 0;
        const int nte = tab[80 + e + 1] - tab[80 + e], rem = L - tab[80 + e] * npn;
        const int mt = rem % nte, pn = rem / nte;
        u.pm = tab[80 + e] + mt; u.pn = e * npn + pn; u.ax = (e << 8) | mt; return true;
    }
    __device__ __forceinline__ int row_tok(const pg8::Unit& u, int r) const {
        const int e = u.ax >> 8, idx = (u.ax & 255) * 256 + r;
        if (e == NE) return idx;
        return idx < tab[e] ? ltok[e * NTOK + idx] : 0;
    }
};
__device__ __forceinline__ void moe_tables(Frame& F) {
    LAS int* tab = (LAS int*)(F.lds() + LDS_MISC + 64);
    if (F.tid() == 0) { int cum = 0;
        for (int e = 0; e < NE; ++e) { const int cn = (int)__hip_atomic_load(F.ctl() + CW_ECNT + 64 * e, RLX_AGENT); tab[e] = cn; tab[80 + e] = cum; cum += (cn + 255) >> 8; }
        tab[NE] = NTOK; tab[80 + NE] = cum; cum += NTOK / 256; tab[80 + NEX] = cum; }
    __syncthreads();
}
struct EpiGateUp {
    static constexpr bool PERM = true;
    bf16* hid; const float* lw; const LAS int* tab;
    __device__ __forceinline__ void operator()(const f32x4 (&acc)[2][2][4][2], const pg8::Unit& u, int wr, int wc, int fr, int fq) const {
        const int e = u.ax >> 8, mt = u.ax & 255, pn = u.pn & 3; const int cnt = tab[e];
#pragma unroll
        for (int ai = 0; ai < 2; ++ai)
#pragma unroll
            for (int m = 0; m < 4; ++m) { const int rl = ai * 128 + wr * 64 + m * 16 + fr, idx = mt * 256 + rl;
                const float gw = (e == NE) ? 1.0f : (idx < cnt ? lw[e * NTOK + idx] : 0.0f);
                f32x4 h0, h1;
#pragma unroll
                for (int i = 0; i < 4; ++i) { h0[i] = silu_f(acc[ai][0][m][0][i]) * acc[ai][1][m][0][i] * gw; h1[i] = silu_f(acc[ai][0][m][1][i]) * acc[ai][1][m][1][i] * gw; }
                u32x4 w = {cvt_pk_bf16(h0[0], h0[1]), cvt_pk_bf16(h0[2], h0[3]), cvt_pk_bf16(h1[0], h1[1]), cvt_pk_bf16(h1[2], h1[3])};
                *(u32x4*)(hid + (size_t)(u.pm * 256 + rl) * DE + pn * 128 + wc * 32 + 8 * fq) = w; }
    }
};
struct EpiDown {
    static constexpr bool PERM = true;
    bf16* outs;
    __device__ __forceinline__ void operator()(const f32x4 (&acc)[2][2][4][2], const pg8::Unit& u, int wr, int wc, int fr, int fq) const {
        const int pn = u.pn & 7;
#pragma unroll
        for (int ai = 0; ai < 2; ++ai)
#pragma unroll
            for (int m = 0; m < 4; ++m) { bf16* rowp = outs + (size_t)(u.pm * 256 + ai * 128 + wr * 64 + m * 16 + fr) * DM + pn * 256 + wc * 32 + 8 * fq;
#pragma unroll
                for (int bj = 0; bj < 2; ++bj) { const f32x4 v0 = acc[ai][bj][m][0], v1 = acc[ai][bj][m][1];
                    u32x4 w = {cvt_pk_bf16(v0[0], v0[1]), cvt_pk_bf16(v0[2], v0[3]), cvt_pk_bf16(v1[0], v1[1]), cvt_pk_bf16(v1[2], v1[3])};
                    *(u32x4*)(rowp + bj * 128) = w; } }
    }
};
__device__ __forceinline__ void p10_final(Frame& F) {
    const float* modf = WSP(const float, WS_MODF); const bf16* outs = WSP(const bf16, WS_OUTS); const int* inv = WSP(const int, WS_INV);
    const LAS int* tab = (const LAS int*)(F.lds() + LDS_MISC + 64);
    const int gw = F.bid() * 8 + F.wave(), NGW = F.G() * 8;
    for (int tok = gw; tok < NTOK; tok += NGW) { int lane = F.lane(); asm volatile("" : "+v"(lane)); const int b = tok / SEQ; const float* g2 = modf + (size_t)b * (6 * DM) + 5 * DM;
        size_t rows[9];
#pragma unroll
        for (int k = 0; k < 8; ++k) { const int iv = inv[tok * 8 + k]; const int e = iv / NTOK, rk = iv % NTOK; rows[k] = (size_t)(tab[80 + e] * 256 + rk); }
        rows[8] = (size_t)(tab[80 + NE] * 256 + tok);
        f32x4 v[8]; float s = 0.f;
#pragma unroll
        for (int jj = 0; jj < 4; ++jj) { const int col = jj * 512 + lane * 8; f32x4 f0 = {0.f, 0.f, 0.f, 0.f}, f1 = {0.f, 0.f, 0.f, 0.f};
#pragma unroll
            for (int k = 0; k < 9; ++k) { const u32x4 w = *(const u32x4*)(outs + rows[k] * DM + col);
                f0[0] += bflo(w[0]); f0[1] += bfhi(w[0]); f0[2] += bflo(w[1]); f0[3] += bfhi(w[1]); f1[0] += bflo(w[2]); f1[1] += bfhi(w[2]); f1[2] += bflo(w[3]); f1[3] += bfhi(w[3]); }
            const f32x4 xa = *(const f32x4*)(F.out() + (size_t)tok * DM + col), xb = *(const f32x4*)(F.out() + (size_t)tok * DM + col + 4);
            v[2 * jj] = xa * ALPHA_DN + *(const f32x4*)(g2 + col) * f0; v[2 * jj + 1] = xb * ALPHA_DN + *(const f32x4*)(g2 + col + 4) * f1;
            s += (v[2 * jj][0] + v[2 * jj][1]) + (v[2 * jj][2] + v[2 * jj][3]) + (v[2 * jj + 1][0] + v[2 * jj + 1][1]) + (v[2 * jj + 1][2] + v[2 * jj + 1][3]); }
        const float mu = wave_sum(s) * (1.0f / DM); float q = 0.f;
#pragma unroll
        for (int j = 0; j < 8; ++j) { v[j] = v[j] - mu; q += (v[j][0] * v[j][0] + v[j][1] * v[j][1]) + (v[j][2] * v[j][2] + v[j][3] * v[j][3]); }
        const float rstd = 1.0f / sqrtf(wave_sum(q) * (1.0f / DM) + LN_EPS);
#pragma unroll
        for (int j = 0; j < 8; ++j) { const int col = (j >> 1) * 512 + lane * 8 + (j & 1) * 4;
            *(f32x4*)(F.out() + (size_t)tok * DM + col) = v[j] * rstd * *(const f32x4*)(F.f(25) + col) + *(const f32x4*)(F.f(26) + col); } }
}
#ifndef MK_N_LAUNCHES
#define MK_N_LAUNCHES 1
#endif
constexpr int N_PHASES = 11;
__global__ void __launch_bounds__(512, 2) fwd_kernel(Args args) {
    Frame F; F.ap = &args;
    if (F.tid() < 16) ((LAS unsigned*)(F.lds() + LDS_MISC))[F.tid()] = 0u;
    __syncthreads();
    if (args.ph_hi - args.ph_lo > 1) (void)xcd_barrier_post((unsigned*)(F.ctl() + CW_BAR), (volatile LAS unsigned*)(F.lds() + LDS_MISC));
#ifndef PH_MASK
#define PH_MASK 0x7ff
#endif
#define IN(k) (((PH_MASK >> (k)) & 1) && args.ph_lo <= (k) && (k) < args.ph_hi)
#ifdef PROBE_PHASE
    unsigned long long pt0_ = __builtin_amdgcn_s_memrealtime(), pt1_ = 0ull;
#define PMARK(k) do { if ((k) + 1 == PROBE_PHASE) pt0_ = __builtin_amdgcn_s_memrealtime(); if ((k) == PROBE_PHASE) pt1_ = __builtin_amdgcn_s_memrealtime(); } while (0)
#else
#define PMARK(k) do { } while (0)
#endif
#define SEAM(k) do { if (IN(k) && IN((k) + 1)) { XcdBarrier bar_; bar_.bar = (unsigned*)(F.ctl() + CW_BAR); bar_.x = xb_xcc_id(); bar_.st = (volatile LAS unsigned*)(F.lds() + LDS_MISC); xcd_barrier(bar_); } } while (0)
    if (IN(0)) { p0_prologue(F); } SEAM(0); PMARK(0);
    if (IN(1)) { p1_modulate(F); } SEAM(1); PMARK(1);
    if (IN(2)) {
        pg8::Gemm g{WSP(const bf16, WS_U1), WSP(const bf16, WS_WIN), DM}; pg8::StaticOrder S; S.init(NTOK, NPROJ_PAD, F.G(), F.bid());
        EpiInProj E{F.ws(), F.f(8), F.f(12), F.f(13)};
        pg8::gemm_phase<EpiInProj, pg8::StaticOrder, false>(F.lds(), g, S, E);
        slack_fill(F, (F.bid() + 3 * F.G() < 32 * NPROJ_TILES) ? 0 : 8, false, Q_ALL);
    } SEAM(2); PMARK(2);
    if (IN(3)) { p3_phase(F); } SEAM(3); PMARK(3);
    if (IN(4)) { p4_select(F); p4_scan(F); } SEAM(4); PMARK(4);
    if (IN(5)) { p5_phase(F); slack_fill(F, (F.G() == 256) ? ((F.bid() >> 4) * 3) / 2 : 0, false, Q_ALL); } SEAM(5);
    if (IN(6)) {
        pg8::Gemm g{WSP(const bf16, WS_YCAT), WSP(const bf16, WS_WOUT), DM}; pg8::StaticOrder S; S.init(NTOK, DM, F.G(), F.bid());
        EpiOutProj E{F.f(0), WSP(const float, WS_MODF), F.out()};
        pg8::gemm_phase<EpiOutProj, pg8::StaticOrder, false>(F.lds(), g, S, E);
    } SEAM(6); PMARK(6);
    if (IN(7)) { p7_phase(F); slack_fill(F, 0, true, Q_GU); } SEAM(7); PMARK(7);
    if (IN(8)) {
        moe_tables(F);
        const LAS int* tab = (const LAS int*)(F.lds() + LDS_MISC + 64);
        pg8::Gemm g{WSP(const bf16, WS_U2), WSP(const bf16, WS_WGU), DM}; MoeOrder S{tab, WSP(const int, WS_LTOK), F.G(), F.bid(), 4};
        EpiGateUp E{WSP(bf16, WS_HID), WSP(const float, WS_LW), tab};
        pg8::gemm_phase<EpiGateUp, MoeOrder, true>(F.lds(), g, S, E);
        slack_fill(F, 0, true, Q_ALL);
    } SEAM(8); PMARK(8);
    if (IN(9)) {
        moe_tables(F);
        const LAS int* tab = (const LAS int*)(F.lds() + LDS_MISC + 64);
        pg8::Gemm g{WSP(const bf16, WS_HID), WSP(const bf16, WS_WDN), DE}; MoeOrder S{tab, WSP(const int, WS_LTOK), F.G(), F.bid(), 8};
        EpiDown E{WSP(bf16, WS_OUTS)};
        pg8::gemm_phase<EpiDown, MoeOrder, false>(F.lds(), g, S, E);
    } SEAM(9); PMARK(9);
    if (IN(10)) { moe_tables(F); p10_final(F); }
#ifdef PROBE_PHASE
    if (pt1_ == 0ull) pt1_ = __builtin_amdgcn_s_memrealtime();
    if (F.bid() == 0) { const unsigned long long w = 8ull * (pt1_ - pt0_), te = __builtin_amdgcn_s_memrealtime(); while (__builtin_amdgcn_s_memrealtime() - te < w) __builtin_amdgcn_s_sleep(32); }
#endif
#ifdef DBG_OFF
    if (args.ph_hi == N_PHASES) {
        const size_t n = (size_t)NTOK * DM; float* o = F.out();
        for (size_t i = (size_t)F.bid() * 512 + F.tid(); i < n; i += (size_t)F.G() * 512) {
            float v;
            if (DBG_KIND == 0) v = bf2f(((const bf16*)(F.ws() + (size_t)(DBG_OFF)))[i % (size_t)(DBG_N)]);
            else v = ((const float*)(F.ws() + (size_t)(DBG_OFF)))[i % (size_t)(DBG_N)];
            if (!(fabsf(v) < 1e30f)) v = 1e30f;
            o[i] = v; }
    }
#endif
#undef IN
#undef SEAM
#undef PMARK
}

extern "C" void kernel_launch(void* const* d_in, const int* in_sizes, int n_in, void* d_out, int out_size, void* d_ws, size_t ws_size, hipStream_t stream) {
    static int grid = 0;
    if (grid == 0) {
        if (n_in != 27 || out_size != NTOK * DM || ws_size < WS_END) { fprintf(stderr, "kernel_launch: unexpected shapes (n_in %d, out %d, ws %zu; need ws >= %zu)\n", n_in, out_size, ws_size, (size_t)WS_END); }
        int dev = 0, cus = 0, per_cu = 0;
        if (hipGetDevice(&dev) != hipSuccess || hipDeviceGetAttribute(&cus, hipDeviceAttributeMultiprocessorCount, dev) != hipSuccess) { grid = -1; return; }
        if (hipFuncSetAttribute((const void*)fwd_kernel, hipFuncAttributeMaxDynamicSharedMemorySize, LDS_BYTES) != hipSuccess) { fprintf(stderr, "kernel_launch: hipFuncSetAttribute failed\n"); grid = -1; return; }
        if (hipOccupancyMaxActiveBlocksPerMultiprocessor(&per_cu, (const void*)fwd_kernel, 512, LDS_BYTES) != hipSuccess || per_cu < 1) fprintf(stderr, "kernel_launch: occupancy query reports %d\n", per_cu);
        (void)hipGetLastError();
        grid = cus;
    }
    if (grid < 0) return;
    (void)hipMemsetAsync((char*)d_ws + WS_CTL, 0, CTL_ZERO_BYTES, stream);
    Args a{};
    for (int i = 0; i < 27; ++i) a.in[i] = d_in[i];
    a.out = (float*)d_out; a.ws = (unsigned char*)d_ws;
#if MK_N_LAUNCHES == 1
    a.ph_lo = 0; a.ph_hi = N_PHASES;
    hipLaunchKernelGGL(fwd_kernel, dim3(grid), dim3(512), LDS_BYTES, stream, a);
#else
    for (int p = 0; p < N_PHASES; ++p) { a.ph_lo = p; a.ph_hi = p + 1; hipLaunchKernelGGL(fwd_kernel, dim3(grid), dim3(512), LDS_BYTES, stream, a);
#ifdef DUP_PHASE
        if (p == DUP_PHASE) hipLaunchKernelGGL(fwd_kernel, dim3(grid), dim3(512), LDS_BYTES, stream, a);
#endif
    }
#endif
}
```

```cpp
#include <hip/hip_runtime.h>
#include <cstdio>
#include <cstdint>

#define GAS __attribute__((address_space(1)))
#define LAS __attribute__((address_space(3)))
typedef unsigned short bf16;
typedef short bf16x8 __attribute__((ext_vector_type(8)));
typedef short s16x4 __attribute__((ext_vector_type(4)));
typedef float f32x2 __attribute__((ext_vector_type(2)));
typedef float f32x4 __attribute__((ext_vector_type(4)));
typedef float f32x16 __attribute__((ext_vector_type(16)));
typedef unsigned u32x2 __attribute__((ext_vector_type(2)));
typedef unsigned u32x4 __attribute__((ext_vector_type(4)));
typedef GAS unsigned gu32;
#define RLX_AGENT __ATOMIC_RELAXED, __HIP_MEMORY_SCOPE_AGENT
#define LDS_WAIT() asm volatile("s_waitcnt lgkmcnt(0)" ::: "memory")
#define VM_WAIT() asm volatile("s_waitcnt vmcnt(0)" ::: "memory")

constexpr int DM = 2048, NBATCH = 2, SEQ = 4096, NTOK = NBATCH * SEQ;
constexpr int D_SSM = 1024, SSM_H = 16, SSM_P = 64, SSM_N = 128, CONV_CH = 1536, CHUNK = 128, NCHUNK = SEQ / CHUNK;
constexpr int ATT_H = 8, ATT_D = 128, IDX_H = 16, IDX_D = 64, TOPK_SEL = 256;
constexpr int NE = 64, DE = 512, NEX = NE + 1;
constexpr int NPROJ = 6752, NPROJ_PAD = 6912, NPROJ_TILES = 27;
constexpr float ALPHA_DN = 1.189207115002721f;
constexpr float LN_EPS = 1e-5f;
constexpr int SEG_Z = 0, SEG_XBC = 1024, SEG_DT = 2560, SEG_Q = 2576, SEG_K = 3600, SEG_V = 4624, SEG_QI = 5648, SEG_KI = 6672, SEG_WI = 6736;

constexpr size_t MiB = 1u << 20;
constexpr size_t WS_CTL = 0, CTL_ZERO_BYTES = 1 * MiB;
constexpr size_t WS_MODP = 1 * MiB;
constexpr size_t WS_MODF = 3 * MiB;
constexpr size_t WS_COSA = 4 * MiB, WS_SINA = 6 * MiB;
constexpr size_t WS_COSI = 8 * MiB, WS_SINI = 9 * MiB;
constexpr size_t WS_WR = 10 * MiB;
constexpr size_t WS_KIDX = 11 * MiB;
constexpr size_t WS_WIDX = 12 * MiB;
constexpr size_t WS_DT = 12 * MiB + 512 * 1024;
constexpr size_t WS_CS = 13 * MiB;
constexpr size_t WS_INV = 14 * MiB;
constexpr size_t WS_LTOK = 15 * MiB;
constexpr size_t WS_LW = 17 * MiB;
constexpr size_t WS_MASK = 19 * MiB;
constexpr size_t WS_U2 = 25 * MiB;
constexpr size_t WS_WGU = 57 * MiB;
constexpr size_t WS_WDN = 317 * MiB;
constexpr size_t WS_T = 447 * MiB;
constexpr size_t WS_HID = WS_T;
constexpr size_t WS_OUTS = WS_T + 88 * MiB;
constexpr size_t WS_WIN = WS_T;
constexpr size_t WS_WOUT = WS_T + 27 * MiB;
constexpr size_t WS_U1 = WS_T + 35 * MiB;
constexpr size_t WS_Z = WS_T + 67 * MiB;
constexpr size_t WS_XBC = WS_T + 83 * MiB;
constexpr size_t WS_Q = WS_T + 107 * MiB, WS_K = WS_T + 123 * MiB, WS_V = WS_T + 139 * MiB;
constexpr size_t WS_QIDX = WS_T + 155 * MiB;
constexpr size_t WS_SCORES = WS_T + 171 * MiB;
constexpr size_t WS_STATES = WS_T + 299 * MiB;
constexpr size_t WS_HIN = WS_T + 331 * MiB;
constexpr size_t WS_YDIAG = WS_T + 347 * MiB;
constexpr size_t WS_YCAT = WS_T + 379 * MiB;
constexpr size_t WS_XBCACT = WS_T + 411 * MiB;
constexpr size_t WS_END = WS_T + 440 * MiB;
static_assert(WS_XBCACT + 24 * MiB <= WS_END && WS_OUTS + 352 * MiB <= WS_END, "ws map");
constexpr int MAXPOS = 90112;
constexpr int CW_TMO = 0, CW_BAR = 4096, CW_ECNT = 8192;
constexpr int CW_QHEAD = 16384, CW_DONE = 16448;

constexpr int LDS_MISC = 155648;
constexpr int LDS_BYTES = 157696;

typedef __bf16 bf16x2_t __attribute__((ext_vector_type(2)));
__device__ __forceinline__ unsigned cvt_pk_bf16(float lo, float hi) { const bf16x2_t v = {(__bf16)lo, (__bf16)hi}; return __builtin_bit_cast(unsigned, v); }
__device__ __forceinline__ float bflo(unsigned w) { return __uint_as_float(w << 16); }
__device__ __forceinline__ float bfhi(unsigned w) { return __uint_as_float(w & 0xffff0000u); }
__device__ __forceinline__ float bf2f(bf16 b) { return __uint_as_float((unsigned)b << 16); }
__device__ __forceinline__ bf16 f2bf(float f) { return __builtin_bit_cast(unsigned short, (__bf16)f); }
__device__ __forceinline__ float silu_f(float x) { return x / (1.f + __expf(-x)); }
__device__ __forceinline__ float sigmoid_f(float x) { return 1.f / (1.f + __expf(-x)); }
__device__ __forceinline__ float wave_sum(float v) {
#pragma unroll
    for (int o = 1; o < 64; o <<= 1) v += __shfl_xor(v, o);
    return v;
}
__device__ __forceinline__ bf16x8 pack8(f32x4 a, f32x4 b) {
    u32x4 w = {cvt_pk_bf16(a[0], a[1]), cvt_pk_bf16(a[2], a[3]), cvt_pk_bf16(b[0], b[1]), cvt_pk_bf16(b[2], b[3])};
    return __builtin_bit_cast(bf16x8, w);
}
__device__ __forceinline__ void unpack8(bf16x8 v, float (&o)[8]) {
    u32x4 w = __builtin_bit_cast(u32x4, v);
#pragma unroll
    for (int i = 0; i < 4; ++i) { o[2 * i] = bflo(w[i]); o[2 * i + 1] = bfhi(w[i]); }
}
__device__ __forceinline__ int crow(int r, int hi) { return (r & 3) + 8 * (r >> 2) + 4 * hi; }
#define MK_N_LAUNCHES 1
#define PH_MASK 0x7ff
#define XB_TMO      128
#define XB_XCNT(j)  (256  + 64 * (j))
#define XB_XSUB(j)  (1280 + 64 * (j))
#define XB_XGEN(j)  (2304 + 64 * (j))
#define XB_TOP      3328
#define XB_TOPGEN   3392
#define XCD_BAR_WORDS 3456
#define XB_SPIN_CAP (1u << 18)

__device__ __forceinline__ unsigned xb_ld(unsigned* p)              { return __hip_atomic_load(p, __ATOMIC_RELAXED, __HIP_MEMORY_SCOPE_AGENT); }
__device__ __forceinline__ unsigned xb_add(unsigned* p, unsigned v) { return __hip_atomic_fetch_add(p, v, __ATOMIC_RELAXED, __HIP_MEMORY_SCOPE_AGENT); }
__device__ __forceinline__ unsigned xb_xcc_id() { return (unsigned)__builtin_amdgcn_s_getreg((3 << 11) | 20) & 0xFu; }
#define XB_SPIN(cond, bar) do { unsigned _sp = 0; while (cond) { __builtin_amdgcn_s_sleep(1); \
    if ((++_sp & 255u) == 0u) { if (xb_ld(&(bar)[XB_TMO])) break; if (_sp > XB_SPIN_CAP) { atomicAdd(&(bar)[XB_TMO], 1u); break; } } } } while (0)

struct XcdBarrier {
    unsigned* bar; unsigned x;
    volatile LAS unsigned* st;
};

__device__ __forceinline__ XcdBarrier xcd_barrier_post(unsigned* bar, volatile LAS unsigned* st) {
    XcdBarrier b; b.bar = bar; b.x = xb_xcc_id(); b.st = st;
    if (threadIdx.x == 0) (void)xb_add(&bar[XB_XCNT(b.x)], 1u);
    return b;
}
__device__ __forceinline__ void xcd_barrier_complete(unsigned* bar, unsigned x, unsigned& nloc, unsigned& nx) {
    const unsigned G = gridDim.x * gridDim.y * gridDim.z;
    unsigned sum, cnt, mine, sp = 0u;
    for (;;) {
        sum = 0u; cnt = 0u; mine = 0u;
#pragma unroll
        for (unsigned j = 0; j < 16; ++j) { const unsigned c = xb_ld(&bar[XB_XCNT(j)]); sum += c; cnt += (c > 0u) ? 1u : 0u; mine = (j == x) ? c : mine; }
        if (sum == G) break;
        __builtin_amdgcn_s_sleep(1);
        if ((++sp & 255u) == 0u) { if (xb_ld(&bar[XB_TMO])) break; if (sp > XB_SPIN_CAP) { atomicAdd(&bar[XB_TMO], 1u); break; } }
    }
    nloc = mine > 0u ? mine : 1u; nx = cnt > 0u ? cnt : 1u;
}

__device__ __forceinline__ void xcd_barrier(const XcdBarrier& b) {
    asm volatile("s_waitcnt vmcnt(0)" ::: "memory");
    __syncthreads();
    if (threadIdx.x == 0) {
        unsigned* bar = b.bar;
        __builtin_amdgcn_s_waitcnt(0);
        unsigned nloc = b.st[0], nx = b.st[1];
        if (nloc == 0u) { xcd_barrier_complete(bar, b.x, nloc, nx); b.st[0] = nloc; b.st[1] = nx; }
        const unsigned old = xb_add(&bar[XB_XSUB(b.x)], 1u);
        const unsigned gen = old / nloc;
        if (old + 1u == (gen + 1u) * nloc) {
            __builtin_amdgcn_fence(__ATOMIC_RELEASE, "agent");
            asm volatile("s_waitcnt vmcnt(0)" ::: "memory");
            const unsigned og = xb_add(&bar[XB_TOP], 1u);
            const unsigned tg = og / nx;
            if (og + 1u == (tg + 1u) * nx) xb_add(&bar[XB_TOPGEN], 1u);
            else XB_SPIN(xb_ld(&bar[XB_TOPGEN]) == tg, bar);
            __builtin_amdgcn_fence(__ATOMIC_ACQUIRE, "agent");
            xb_add(&bar[XB_XGEN(b.x)], 1u);
            asm volatile("s_waitcnt vmcnt(0)" ::: "memory");
        } else {
            XB_SPIN(xb_ld(&bar[XB_XGEN(b.x)]) == gen, bar);
            __builtin_amdgcn_fence(__ATOMIC_ACQUIRE, "agent");
            asm volatile("s_waitcnt vmcnt(0)" ::: "memory");
        }
    }
    __syncthreads();
}

namespace pg8 {
constexpr int BM = 256, BK = 64, HALF = 128, HTB = HALF * BK * 2  , STAGE_BYTES = 8 * HTB, NXCD = 8, WGM = 8;
__host__ __device__ __forceinline__ int lds_byte(int r, int c) { const int st = (r >> 4) * 2 + (c >> 5), rr = r & 15, cc = c & 31, ob = rr * 64 + cc * 2; return st * 1024 + (ob ^ (((ob >> 9) & 1) << 5)); }
__host__ __device__ __forceinline__ void stage_rc(int b, int& R, int& C) { const int st = b / 1024, sb = b % 1024, swz = sb ^ (((sb >> 9) & 1) << 5); R = (st >> 1) * 16 + swz / 64; C = (st & 1) * 32 + (swz % 64) / 2; }
__host__ __device__ __forceinline__ int perm32(int rho) { const int n = rho >> 4, i = rho & 15; return 8 * (i >> 2) + 4 * n + (i & 3); }

struct Unit { int pm, pn, ax; };
struct Gemm { const bf16* A; const bf16* Bt; int K; };

struct StaticOrder {
    int nM, nN, nwg, G, c;
    __device__ void init(int M, int N, int G_, int c_) { nM = M / BM; nN = N / BM; nwg = nM * nN; G = G_; c = c_; }
    __device__ __forceinline__ bool next(int i, Unit& u) const {
        const long L = (long)i * G + c; if (L >= nwg) return false;
        int wgid = (int)L; { const int q = nwg / NXCD, r = nwg % NXCD, xcd = wgid % NXCD, off = wgid / NXCD; wgid = (xcd < r ? xcd * (q + 1) : r * (q + 1) + (xcd - r) * q) + off; }
        const int nig = WGM * nN, gid = wgid / nig, fm = gid * WGM, gsz = (nM - fm) < WGM ? (nM - fm) : WGM;
        u.pm = fm + ((wgid % nig) % gsz); u.pn = (wgid % nig) / gsz; u.ax = 0; return true;
    }
    __device__ __forceinline__ int row_tok(const Unit&, int) const { return 0; }
};

template <class Epi, class Sched, bool GATHER>
__device__ __forceinline__ void gemm_phase(LAS unsigned char* lds, const Gemm g, const Sched& S, const Epi& E) {
    const int tid = threadIdx.x, wid = __builtin_amdgcn_readfirstlane(tid >> 6), lane = tid & 63, wr = wid >> 2, wc = wid & 3, fr = lane & 15, fq = lane >> 4;
    const int K = g.K, nt = K / BK;
    unsigned voffB[2]; int RA[2]; unsigned CA2[2];
#pragma unroll
    for (int i = 0; i < 2; ++i) { int R, C; stage_rc(tid * 16 + i * 8192, R, C); const int Rb = Epi::PERM ? ((R & ~31) + perm32(R & 31)) : R;
        voffB[i] = (unsigned)(Rb * K + C) * 2u; RA[i] = R; CA2[i] = (unsigned)C * 2u; }
    const size_t kstep = (size_t)(BK * 2);
    const size_t hstep = (size_t)HALF * K * 2;
    const size_t tstep = 2 * hstep;
    const unsigned ldsw = (unsigned)wid * 1024u;
    const int aoff = lds_byte(wr * 64 + fr, fq * 8), boff = lds_byte(wc * 32 + fr, fq * 8);
#define PG8_SA(b, h) (((b) * 2 + (h)) * HTB)
#define PG8_SB(b, h) ((4 + (b) * 2 + (h)) * HTB)
#define PG8_STAGE(bufoff, gbase, voff) do { _Pragma("unroll") for (int _i = 0; _i < 2; ++_i) \
        __builtin_amdgcn_global_load_lds((const unsigned*)((const char*)(gbase) + (voff)[_i]), (LAS unsigned*)(lds + (bufoff) + ldsw + _i * 8192), 16, 0, 0); } while (0)
#define PG8_LDA(dst, b, h) do { _Pragma("unroll") for (int m = 0; m < 4; ++m) _Pragma("unroll") for (int k = 0; k < 2; ++k) dst[m][k] = *(const LAS bf16x8*)(lds + PG8_SA(b, h) + aoff + m * 2048 + k * 1024); } while (0)
#define PG8_LDB(dst, b, h) do { _Pragma("unroll") for (int n = 0; n < 2; ++n) _Pragma("unroll") for (int k = 0; k < 2; ++k) dst[n][k] = *(const LAS bf16x8*)(lds + PG8_SB(b, h) + boff + n * 2048 + k * 1024); } while (0)
#define PG8_MMA(ai, bj, At, Bt) do { __builtin_amdgcn_s_setprio(1); _Pragma("unroll") for (int m = 0; m < 4; ++m) _Pragma("unroll") for (int n = 0; n < 2; ++n) _Pragma("unroll") for (int k = 0; k < 2; ++k) \
        acc[ai][bj][m][n] = __builtin_amdgcn_mfma_f32_16x16x32_bf16(Bt[n][k], At[m][k], acc[ai][bj][m][n], 0, 0, 0); __builtin_amdgcn_s_setprio(0); } while (0)
#define PG8_WAIT_V(n) asm volatile("s_waitcnt vmcnt(" #n ")" ::: "memory")
#define PG8_WAIT_L(n) asm volatile("s_waitcnt lgkmcnt(" #n ")" ::: "memory")
#define PG8_BAR __builtin_amdgcn_s_barrier()
#define PG8_SCHED __builtin_amdgcn_sched_barrier(0)
#define PG8_SET_OA(o, u) do { _Pragma("unroll") for (int _h = 0; _h < 2; ++_h) _Pragma("unroll") for (int _i = 0; _i < 2; ++_i) { \
        if constexpr (GATHER) o[_h][_i] = (unsigned)S.row_tok(u, _h * HALF + RA[_i]) * (unsigned)(K * 2) + CA2[_i]; \
        else o[_h][_i] = (unsigned)(_h * (int)hstep) + (unsigned)(RA[_i] * K * 2) + CA2[_i]; } } while (0)
    Unit cur, nxt; int ui = 0;
    if (!S.next(0, cur)) return;
    f32x4 acc[2][2][4][2];
#pragma unroll
    for (int a = 0; a < 2; ++a)
#pragma unroll
        for (int b = 0; b < 2; ++b)
#pragma unroll
            for (int m = 0; m < 4; ++m)
#pragma unroll
                for (int n = 0; n < 2; ++n) acc[a][b][m][n] = (f32x4){0.f, 0.f, 0.f, 0.f};
    bf16x8 At[4][2], B0[2][2], B1[2][2];
    unsigned oAc[2][2], oAn[2][2];
    PG8_SET_OA(oAc, cur);
    const char* cA = GATHER ? (const char*)g.A : (const char*)g.A + (size_t)cur.pm * tstep; const char* cB = (const char*)g.Bt + (size_t)cur.pn * tstep;
    PG8_STAGE(PG8_SB(0, 0), cB, voffB); PG8_STAGE(PG8_SB(0, 1), cB + hstep, voffB); PG8_STAGE(PG8_SA(0, 0), cA, oAc[0]); PG8_STAGE(PG8_SA(0, 1), cA, oAc[1]);
    if (wr == 1) PG8_BAR;
    PG8_WAIT_V(2); PG8_BAR;
    PG8_STAGE(PG8_SB(1, 0), cB + kstep, voffB); PG8_STAGE(PG8_SA(1, 0), cA + kstep, oAc[0]); PG8_STAGE(PG8_SB(1, 1), cB + hstep + kstep, voffB);
    PG8_WAIT_V(6); PG8_BAR;
    for (;;) {
        const bool has_next = S.next(ui + 1, nxt);
        const char* nA = has_next ? (GATHER ? (const char*)g.A : (const char*)g.A + (size_t)nxt.pm * tstep) : cA; const char* nB = has_next ? (const char*)g.Bt + (size_t)nxt.pn * tstep : cB;
        if (has_next) { PG8_SET_OA(oAn, nxt); }
        else {
#pragma unroll
            for (int _h = 0; _h < 2; ++_h)
#pragma unroll
                for (int _i = 0; _i < 2; ++_i) oAn[_h][_i] = oAc[_h][_i]; }
        for (int t = 0; t < nt; t += 2) {
            const bool last = (t == nt - 2);
            const char* a1 = cA + (size_t)(t + 1) * kstep;
            const char* a2 = last ? nA : cA + (size_t)(t + 2) * kstep; const char* b2 = last ? nB : cB + (size_t)(t + 2) * kstep;
            const char* a3 = a2 + kstep; const char* b3 = b2 + kstep;
            unsigned o2[2][2];
#pragma unroll
            for (int _h = 0; _h < 2; ++_h)
#pragma unroll
                for (int _i = 0; _i < 2; ++_i) o2[_h][_i] = GATHER ? (last ? oAn[_h][_i] : oAc[_h][_i]) : oAc[_h][_i];
            PG8_LDB(B0, 0, 0); PG8_LDB(B1, 0, 1); PG8_SCHED; PG8_LDA(At, 0, 0); PG8_STAGE(PG8_SA(1, 1), a1, oAc[1]);
            PG8_WAIT_V(8); PG8_WAIT_L(0); PG8_BAR; PG8_MMA(0, 0, At, B0); PG8_MMA(0, 1, At, B1); PG8_BAR; PG8_SCHED;
            PG8_LDA(At, 0, 1); PG8_STAGE(PG8_SB(0, 0), b2, voffB); PG8_STAGE(PG8_SB(0, 1), b2 + hstep, voffB); PG8_STAGE(PG8_SA(0, 0), a2, o2[0]);
            PG8_WAIT_V(8); PG8_WAIT_L(0); PG8_BAR; PG8_MMA(1, 0, At, B0); PG8_MMA(1, 1, At, B1); PG8_BAR; PG8_SCHED;
            PG8_LDB(B0, 1, 0); PG8_LDB(B1, 1, 1); PG8_SCHED; PG8_LDA(At, 1, 0); PG8_STAGE(PG8_SA(0, 1), a2, o2[1]);
            PG8_WAIT_V(8); PG8_WAIT_L(0); PG8_BAR; PG8_MMA(0, 0, At, B0); PG8_MMA(0, 1, At, B1); PG8_BAR; PG8_SCHED;
            PG8_LDA(At, 1, 1); PG8_STAGE(PG8_SB(1, 0), b3, voffB); PG8_STAGE(PG8_SB(1, 1), b3 + hstep, voffB); PG8_STAGE(PG8_SA(1, 0), a3, o2[0]);
            PG8_WAIT_V(8); PG8_WAIT_L(0); PG8_BAR; PG8_MMA(1, 0, At, B0); PG8_MMA(1, 1, At, B1); PG8_BAR; PG8_SCHED;
        }
        if (wr == 0) PG8_BAR;
        { int fr_ = fr, fq_ = fq, wr_ = wr, wc_ = wc; asm volatile("" : "+v"(fr_), "+v"(fq_), "+s"(wr_), "+s"(wc_));
          E(acc, cur, wr_, wc_, fr_, fq_); }
        if (!has_next) break;
#pragma unroll
        for (int a = 0; a < 2; ++a)
#pragma unroll
            for (int b = 0; b < 2; ++b)
#pragma unroll
                for (int m = 0; m < 4; ++m)
#pragma unroll
                    for (int n = 0; n < 2; ++n) acc[a][b][m][n] = (f32x4){0.f, 0.f, 0.f, 0.f};
        cur = nxt; cA = nA; cB = nB; ++ui;
#pragma unroll
        for (int _h = 0; _h < 2; ++_h)
#pragma unroll
            for (int _i = 0; _i < 2; ++_i) oAc[_h][_i] = oAn[_h][_i];
        if (wr == 1) PG8_BAR;
    }
    PG8_WAIT_V(0);
    PG8_BAR;
#undef PG8_SA
#undef PG8_SB
#undef PG8_STAGE
#undef PG8_LDA
#undef PG8_LDB
#undef PG8_MMA
#undef PG8_WAIT_V
#undef PG8_WAIT_L
#undef PG8_BAR
#undef PG8_SCHED
#undef PG8_SET_OA
}
}
struct Args { const void* in[27]; float* out; unsigned char* ws; int ph_lo, ph_hi; };
struct Frame {
    const Args* ap;
    __device__ __forceinline__ LAS unsigned char* lds() const { extern __shared__ __attribute__((aligned(16))) unsigned char lds_raw[]; return (LAS unsigned char*)lds_raw; }
    __device__ __forceinline__ unsigned char* ws() const { return ap->ws; }
    __device__ __forceinline__ gu32* ctl() const { return (gu32*)(ap->ws + WS_CTL); }
    __device__ __forceinline__ float* out() const { return ap->out; }
    __device__ __forceinline__ int tid() const { return (int)threadIdx.x; }
    __device__ __forceinline__ int lane() const { return (int)threadIdx.x & 63; }
    __device__ __forceinline__ int wave() const { return __builtin_amdgcn_readfirstlane((int)threadIdx.x >> 6); }
    __device__ __forceinline__ int G() const { return (int)gridDim.x; }
    __device__ __forceinline__ int bid() const { return (int)blockIdx.x; }
    __device__ __forceinline__ const float* f(int i) const { return (const float*)ap->in[i]; }
    __device__ __forceinline__ const int* i32(int i) const { return (const int*)ap->in[i]; }
};
#ifdef PROBE_SUB
#define PSUB(n, w) do { if ((n) == PROBE_SUB && blockIdx.x == 0 && threadIdx.x == 0) *(volatile LAS unsigned long long*)(F.lds() + LDS_MISC + 32 + 8 * (w)) = __builtin_amdgcn_s_memrealtime(); } while (0)
#else
#define PSUB(n, w) do { } while (0)
#endif
#define WSP(T, off) ((T*)(F.ws() + (off)))

__device__ __forceinline__ int inproj_src_col(int P) {
    const int tile = P >> 8, within = P & 255, bj = within >> 7, w = within & 127;
    if (tile < 4) return SEG_Z + tile * 256 + within;
    if (tile < 10) return SEG_XBC + (tile - 4) * 256 + within;
    if (tile < 14) return SEG_Q + (2 * (tile - 10) + (w >> 6)) * 128 + (w & 63) + 64 * bj;
    if (tile < 18) return SEG_K + (2 * (tile - 14) + (w >> 6)) * 128 + (w & 63) + 64 * bj;
    if (tile < 22) return SEG_V + (tile - 18) * 256 + within;
    if (tile < 26) return SEG_QI + (4 * (tile - 22) + (w >> 5)) * 64 + (w & 31) + 32 * bj;
    if (bj == 0) { if (w < 32) return SEG_KI + w; if (w < 48) return SEG_WI + (w - 32); if (w < 64) return SEG_DT + (w - 48); return -1; }
    if (w < 32) return SEG_KI + 32 + w;
    return -1;
}
__device__ __forceinline__ void tr64(const float* qsrc, bool valid, int ld, bf16* dst0  , int K, LAS float* scr, int lane) {
    f32x4 v[16];
#pragma unroll
    for (int i = 0; i < 16; ++i) v[i] = valid ? *(const f32x4*)(qsrc + (size_t)(4 * i) * ld) : (f32x4){0.f, 0.f, 0.f, 0.f};
#pragma unroll
    for (int i = 0; i < 16; ++i) { LAS float* s = scr + ((lane >> 4) + 4 * i) * 65 + 4 * (lane & 15); s[0] = v[i][0]; s[1] = v[i][1]; s[2] = v[i][2]; s[3] = v[i][3]; }
    LDS_WAIT(); asm volatile("" ::: "memory");
    const int c = lane & 7;
#pragma unroll
    for (int jj = 0; jj < 8; ++jj) { const int n = (lane >> 3) + 8 * jj; const LAS float* s = scr + (8 * c) * 65 + n;
        u32x4 o; o.x = cvt_pk_bf16(s[0], s[65]); o.y = cvt_pk_bf16(s[2 * 65], s[3 * 65]); o.z = cvt_pk_bf16(s[4 * 65], s[5 * 65]); o.w = cvt_pk_bf16(s[6 * 65], s[7 * 65]);
        *(u32x4*)(dst0 + (size_t)n * K + 8 * c) = o; }
    LDS_WAIT(); asm volatile("" ::: "memory");
}
constexpr int I_IN = 32 * 108, I_OUT = 32 * 32, I_GU = NEX * 32 * 16, I_DN = NEX * 8 * 32, I_TR = I_IN + I_OUT + I_GU + I_DN;
__device__ __forceinline__ void tr_item(Frame& F, int it, LAS float* scr) {
    const int lane = F.lane(), kr = lane >> 4, nq = 4 * (lane & 15);
    if (it < I_IN) { const int kb = it / 108, nb = it % 108, k0 = 64 * kb, n0 = 64 * nb; const int sc = inproj_src_col(n0 + nq);
        tr64(F.f(5) + (size_t)(k0 + kr) * NPROJ + (sc < 0 ? 0 : sc), sc >= 0, NPROJ, WSP(bf16, WS_WIN) + (size_t)n0 * DM + k0, DM, scr, lane); return; }
    it -= I_IN;
    if (it < I_OUT) { const int kb = it >> 5, nb = it & 31, k0 = 64 * kb, n0 = 64 * nb;
        tr64(F.f(14) + (size_t)(k0 + kr) * DM + n0 + nq, true, DM, WSP(bf16, WS_WOUT) + (size_t)n0 * DM + k0, DM, scr, lane); return; }
    it -= I_OUT;
    if (it < I_GU) { const int e = it >> 9, r = it & 511, kb = r >> 4, nb = r & 15, k0 = 64 * kb;
        const int p = nb >> 2, bj = (nb >> 1) & 1, w0 = (nb & 1) * 64;
        const float* src = (e < NE) ? ((bj ? F.f(20) : F.f(19)) + (size_t)e * DM * DE) : (bj ? F.f(23) : F.f(22));
        tr64(src + (size_t)(k0 + kr) * DE + 128 * p + w0 + nq, true, DE, WSP(bf16, WS_WGU) + ((size_t)e * 1024 + 64 * nb) * DM + k0, DM, scr, lane); return; }
    it -= I_GU;
    { const int e = it >> 8, r = it & 255, kb = r >> 5, nb = r & 31, k0 = 64 * kb, n0 = 64 * nb;
        const float* src = (e < NE) ? (F.f(21) + (size_t)e * DE * DM) : F.f(24);
        tr64(src + (size_t)(k0 + kr) * DM + n0 + nq, true, DM, WSP(bf16, WS_WDN) + ((size_t)e * DM + n0) * DE + k0, DE, scr, lane); }
}
__device__ __forceinline__ void p0_prologue(Frame& F) {
    const int gw = F.bid() * 8 + F.wave(), NGW = F.G() * 8, gt = F.bid() * 512 + F.tid(), NGT = F.G() * 512;
    {
        LAS float* red = (LAS float*)F.lds();
        float* modp = WSP(float, WS_MODP);
        for (int item = F.bid(); item < 48 * 16; item += F.G()) {
            const int cc = item % 48, ks = item / 48;
            f32x4 a0 = {0.f, 0.f, 0.f, 0.f}, a1 = {0.f, 0.f, 0.f, 0.f};
            const int kbase = ks * 128 + F.wave() * 16;
#pragma unroll 4
            for (int i = 0; i < 16; ++i) { const int k = kbase + i;
                const float c0 = silu_f(F.f(1)[k]), c1 = silu_f(F.f(1)[DM + k]);
                const f32x4 wv = *(const f32x4*)(F.f(3) + (size_t)k * (6 * DM) + cc * 256 + F.lane() * 4);
                a0 += wv * c0; a1 += wv * c1; }
            *(LAS f32x4*)(red + (F.wave() * 2 + 0) * 256 + F.lane() * 4) = a0;
            *(LAS f32x4*)(red + (F.wave() * 2 + 1) * 256 + F.lane() * 4) = a1;
            __syncthreads();
            { const int b = F.tid() >> 8, col = F.tid() & 255; float s = 0.f;
#pragma unroll
              for (int w = 0; w < 8; ++w) s += red[(w * 2 + b) * 256 + col];
              modp[((size_t)ks * 2 + b) * (6 * DM) + cc * 256 + col] = s; }
            __syncthreads();
        }
    }
    {
        float* cosA = WSP(float, WS_COSA); float* sinA = WSP(float, WS_SINA); float* cosI = WSP(float, WS_COSI); float* sinI = WSP(float, WS_SINI);
        for (int i = gt; i < NTOK * 64; i += NGT) { const int tok = i >> 6, j = i & 63;
            const float inv = 1.0f / powf(10000.0f, (float)(2 * j) / 128.0f); const float ang = (float)F.i32(2)[tok] * inv;
            float s, c; sincosf(ang, &s, &c); cosA[i] = c; sinA[i] = s; }
        for (int i = gt; i < NTOK * 32; i += NGT) { const int tok = i >> 5, j = i & 31;
            const float inv = 1.0f / powf(10000.0f, (float)(2 * j) / 64.0f); const float ang = (float)F.i32(2)[tok] * inv;
            float s, c; sincosf(ang, &s, &c); cosI[i] = c; sinI[i] = s; }
    }
    {
        bf16* wr_hi = WSP(bf16, WS_WR); bf16* wr_lo = wr_hi + NE * DM;
        for (int i = gt; i < NE * (DM / 8); i += NGT) { const int e = i & 63, kc = i >> 6;
            float v[8], l[8];
#pragma unroll
            for (int j = 0; j < 8; ++j) { v[j] = F.f(17)[(size_t)(8 * kc + j) * NE + e]; l[j] = v[j] - bf2f(f2bf(v[j])); }
            u32x4 h = {cvt_pk_bf16(v[0], v[1]), cvt_pk_bf16(v[2], v[3]), cvt_pk_bf16(v[4], v[5]), cvt_pk_bf16(v[6], v[7])};
            u32x4 lo = {cvt_pk_bf16(l[0], l[1]), cvt_pk_bf16(l[2], l[3]), cvt_pk_bf16(l[4], l[5]), cvt_pk_bf16(l[6], l[7])};
            *(u32x4*)(wr_hi + (size_t)e * DM + 8 * kc) = h; *(u32x4*)(wr_lo + (size_t)e * DM + 8 * kc) = lo; }
    }
    {
        LAS float* scr = (LAS float*)(F.lds() + F.wave() * 16640);
        for (int it = gw; it < I_IN + I_OUT; it += NGW) tr_item(F, it, scr);
    }
}

constexpr int Q_GU = I_GU, Q_ALL = I_GU + I_DN, Q_GRAB = 16;
__device__ __forceinline__ void slack_fill(Frame& F, int budget, bool drain, int upto) {
    LAS float* scr = (LAS float*)(F.lds() + F.wave() * 16640);
    volatile LAS int* qw = (volatile LAS int*)(F.lds() + LDS_MISC + 16);
    __syncthreads();
    for (int gi = 0; drain || gi < budget; ++gi) {
        if (F.tid() == 0) { int stop = 0;
            const int idx = (int)__hip_atomic_fetch_add(F.ctl() + CW_QHEAD, (unsigned)Q_GRAB, RLX_AGENT); if (idx >= Q_ALL) stop = 1; else if (idx >= upto) stop = 2;
            qw[0] = stop; qw[1] = idx; }
        __syncthreads();
        const int stop = qw[0], idx = qw[1];
        __syncthreads();
        if (stop == 1) break;
#pragma unroll 1
        for (int i = 0; i < Q_GRAB / 8; ++i) { const int it = idx + i * 8 + F.wave(); if (it < Q_ALL) tr_item(F, I_IN + I_OUT + it, scr); }
        if (stop == 2) break;
    }
}

__device__ __forceinline__ void p1_modulate(Frame& F) {
    const float* modp = WSP(const float, WS_MODP); float* modf = WSP(float, WS_MODF); bf16* u1 = WSP(bf16, WS_U1);
    LAS float* sh = (LAS float*)F.lds(); LAS float* sc = sh + DM;
    for (int rg = F.bid(); rg < 256; rg += F.G()) {
        const int b = rg >> 7;
        if (F.tid() < 96) { const int v = rg * 96 + F.tid(); const int bb = v / (6 * DM), col = v % (6 * DM); float s = F.f(4)[col];
#pragma unroll
            for (int ks = 0; ks < 16; ++ks) s += modp[((size_t)ks * 2 + bb) * (6 * DM) + col];
            modf[v] = s; }
        { const int col = F.tid() * 4; f32x4 s0 = *(const f32x4*)(F.f(4) + col), s1 = *(const f32x4*)(F.f(4) + DM + col);
#pragma unroll
          for (int ks = 0; ks < 16; ++ks) { const float* p = modp + ((size_t)ks * 2 + b) * (6 * DM); s0 += *(const f32x4*)(p + col); s1 += *(const f32x4*)(p + DM + col); }
          *(LAS f32x4*)(sh + col) = s0; *(LAS f32x4*)(sc + col) = s1; }
        __syncthreads();
#pragma unroll
        for (int rr = 0; rr < 4; ++rr) { const int row = rg * 32 + F.wave() * 4 + rr;
#pragma unroll
            for (int j = 0; j < 8; ++j) { const int col = j * 256 + F.lane() * 4;
                const f32x4 xv = *(const f32x4*)(F.f(0) + (size_t)row * DM + col); const f32x4 s0 = *(const LAS f32x4*)(sh + col), s1 = *(const LAS f32x4*)(sc + col);
                const f32x4 u = xv * (s1 + 1.0f) + s0;
                u32x2 o = {cvt_pk_bf16(u[0], u[1]), cvt_pk_bf16(u[2], u[3])};
                *(u32x2*)(u1 + (size_t)row * DM + col) = o; } }
        __syncthreads();
    }
}
struct EpiInProj {
    static constexpr bool PERM = true;
    unsigned char* ws; const float *dt_bias, *lng, *lnb;
    __device__ __forceinline__ void operator()(const f32x4 (&acc)[2][2][4][2], const pg8::Unit& u, int wr, int wc, int fr, int fq) const {
        const int pn = u.pn; const int row0 = u.pm * 256 + wr * 64 + fr;
        if (pn < 10 || (pn >= 18 && pn < 22)) {
            size_t boff; int ld, col0;
            if (pn < 4) { boff = WS_Z; ld = 1024; col0 = pn * 256; } else if (pn < 10) { boff = WS_XBC; ld = CONV_CH; col0 = (pn - 4) * 256; } else { boff = WS_V; ld = 1024; col0 = (pn - 18) * 256; }
            bf16* base = (bf16*)(ws + boff);
            col0 += wc * 32 + 8 * fq;
#pragma unroll
            for (int ai = 0; ai < 2; ++ai)
#pragma unroll
                for (int m = 0; m < 4; ++m) { bf16* rowp = base + (size_t)(row0 + ai * 128 + m * 16) * ld + col0;
#pragma unroll
                    for (int bj = 0; bj < 2; ++bj) { const f32x4 v0 = acc[ai][bj][m][0], v1 = acc[ai][bj][m][1];
                        u32x4 w = {cvt_pk_bf16(v0[0], v0[1]), cvt_pk_bf16(v0[2], v0[3]), cvt_pk_bf16(v1[0], v1[1]), cvt_pk_bf16(v1[2], v1[3])};
                        *(u32x4*)(rowp + bj * 128) = w; } }
        } else if (pn < 26) {
            const bool att = pn < 18; const bool isq = pn < 14;
            bf16* base = (bf16*)(ws + (att ? (isq ? WS_Q : WS_K) : WS_QIDX)); const float* ct = (const float*)(ws + (att ? WS_COSA : WS_COSI)); const float* sn = (const float*)(ws + (att ? WS_SINA : WS_SINI));
            const int tw = att ? 64 : 32;
            const int head = att ? 2 * (pn - (isq ? 10 : 14)) + (wc >> 1) : 4 * (pn - 22) + wc, jj0 = att ? 32 * (wc & 1) + 8 * fq : 8 * fq;
#pragma unroll
            for (int ai = 0; ai < 2; ++ai)
#pragma unroll
                for (int m = 0; m < 4; ++m) { const int row = row0 + ai * 128 + m * 16;
                    bf16* rowp = base + (size_t)row * 1024 + head * (2 * tw) + jj0;
#pragma unroll
                    for (int n = 0; n < 2; ++n) { const f32x4 c = *(const f32x4*)(ct + (size_t)row * tw + jj0 + 4 * n), sv = *(const f32x4*)(sn + (size_t)row * tw + jj0 + 4 * n);
                        const f32x4 a = acc[ai][0][m][n], bb = acc[ai][1][m][n];
                        const f32x4 o1 = a * c - bb * sv, o2 = bb * c + a * sv;
                        *(u32x2*)(rowp + 4 * n) = (u32x2){cvt_pk_bf16(o1[0], o1[1]), cvt_pk_bf16(o1[2], o1[3])};
                        *(u32x2*)(rowp + tw + 4 * n) = (u32x2){cvt_pk_bf16(o2[0], o2[1]), cvt_pk_bf16(o2[2], o2[3])}; } }
        } else {
            const float* cosI = (const float*)(ws + WS_COSI); const float* sinI = (const float*)(ws + WS_SINI); bf16* kidx = (bf16*)(ws + WS_KIDX); float* widx = (float*)(ws + WS_WIDX); float* dt = (float*)(ws + WS_DT);
            if (wc == 0) {
                const int jj0 = 8 * fq;
#pragma unroll
                for (int am = 0; am < 8; ++am) { const int ai = am >> 2, m = am & 3; const int row = row0 + ai * 128 + m * 16;
                        f32x4 a0 = acc[ai][0][m][0], a1 = acc[ai][0][m][1], b0 = acc[ai][1][m][0], b1 = acc[ai][1][m][1];
                        float s = (a0[0] + a0[1] + a0[2] + a0[3]) + (a1[0] + a1[1] + a1[2] + a1[3]) + (b0[0] + b0[1] + b0[2] + b0[3]) + (b1[0] + b1[1] + b1[2] + b1[3]);
                        s += __shfl_xor(s, 16); s += __shfl_xor(s, 32);
                        const float mu = s * (1.0f / 64.0f);
                        a0 = a0 - mu; a1 = a1 - mu; b0 = b0 - mu; b1 = b1 - mu;
                        float qv = (a0[0] * a0[0] + a0[1] * a0[1] + a0[2] * a0[2] + a0[3] * a0[3]) + (a1[0] * a1[0] + a1[1] * a1[1] + a1[2] * a1[2] + a1[3] * a1[3])
                                 + (b0[0] * b0[0] + b0[1] * b0[1] + b0[2] * b0[2] + b0[3] * b0[3]) + (b1[0] * b1[0] + b1[1] * b1[1] + b1[2] * b1[2] + b1[3] * b1[3]);
                        qv += __shfl_xor(qv, 16); qv += __shfl_xor(qv, 32);
                        const float rstd = 1.0f / sqrtf(qv * (1.0f / 64.0f) + LN_EPS);
                        a0 = a0 * rstd * *(const f32x4*)(lng + jj0) + *(const f32x4*)(lnb + jj0); a1 = a1 * rstd * *(const f32x4*)(lng + jj0 + 4) + *(const f32x4*)(lnb + jj0 + 4);
                        b0 = b0 * rstd * *(const f32x4*)(lng + 32 + jj0) + *(const f32x4*)(lnb + 32 + jj0); b1 = b1 * rstd * *(const f32x4*)(lng + 36 + jj0) + *(const f32x4*)(lnb + 36 + jj0);
                        const f32x4 c0 = *(const f32x4*)(cosI + (size_t)row * 32 + jj0), c1 = *(const f32x4*)(cosI + (size_t)row * 32 + jj0 + 4);
                        const f32x4 s0 = *(const f32x4*)(sinI + (size_t)row * 32 + jj0), s1 = *(const f32x4*)(sinI + (size_t)row * 32 + jj0 + 4);
                        const f32x4 o10 = a0 * c0 - b0 * s0, o11 = a1 * c1 - b1 * s1, o20 = b0 * c0 + a0 * s0, o21 = b1 * c1 + a1 * s1;
                        bf16* rowp = kidx + (size_t)row * 64 + jj0;
                        u32x4 w1 = {cvt_pk_bf16(o10[0], o10[1]), cvt_pk_bf16(o10[2], o10[3]), cvt_pk_bf16(o11[0], o11[1]), cvt_pk_bf16(o11[2], o11[3])};
                        u32x4 w2 = {cvt_pk_bf16(o20[0], o20[1]), cvt_pk_bf16(o20[2], o20[3]), cvt_pk_bf16(o21[0], o21[1]), cvt_pk_bf16(o21[2], o21[3])};
                        *(u32x4*)rowp = w1; *(u32x4*)(rowp + 32) = w2; }
            } else if (wc == 1) {
                const int h0 = 8 * (fq & 1);
                const f32x4 db0 = *(const f32x4*)(dt_bias + h0), db1 = *(const f32x4*)(dt_bias + h0 + 4);
#pragma unroll
                for (int ai = 0; ai < 2; ++ai)
#pragma unroll
                    for (int m = 0; m < 4; ++m) { const int row = row0 + ai * 128 + m * 16;
                        const f32x4 a0 = acc[ai][0][m][0], a1 = acc[ai][0][m][1];
                        if (fq < 2) { *(f32x4*)(widx + (size_t)row * 16 + h0) = a0 * 0.03125f; *(f32x4*)(widx + (size_t)row * 16 + h0 + 4) = a1 * 0.03125f; }
                        else { f32x4 d0 = a0 + db0, d1 = a1 + db1;
#pragma unroll
                            for (int i = 0; i < 4; ++i) { d0[i] = d0[i] > 20.f ? d0[i] : log1pf(__expf(d0[i])); d1[i] = d1[i] > 20.f ? d1[i] : log1pf(__expf(d1[i])); }
                            *(f32x4*)(dt + (size_t)row * 16 + h0) = d0; *(f32x4*)(dt + (size_t)row * 16 + h0 + 4) = d1; } }
            }
        }
    }
};
__device__ __forceinline__ void idx_unit(Frame& F, int b, int qi, int ki) {
    const bf16* kidx = WSP(const bf16, WS_KIDX); const bf16* qidx = WSP(const bf16, WS_QIDX); const float* widx = WSP(const float, WS_WIDX); float* scores = WSP(float, WS_SCORES);
    const int lane = F.lane(), r32 = lane & 31, hi = lane >> 5, wq = F.wave() & 3, wk = F.wave() >> 2;
    const int kt0 = b * SEQ + ki * 128 + wk * 64, qtok = b * SEQ + qi * 128 + wq * 32 + r32;
    bf16x8 A[2][4];
#pragma unroll
    for (int kt = 0; kt < 2; ++kt)
#pragma unroll
        for (int ks = 0; ks < 4; ++ks) A[kt][ks] = *(const bf16x8*)(kidx + (size_t)(kt0 + kt * 32 + r32) * 64 + ks * 16 + hi * 8);
    f32x16 o0 = {}, o1 = {};
    const bf16* qrow = qidx + (size_t)qtok * 1024 + hi * 8;
#define IDX_LOADQ(dst, wdst, h_) do { _Pragma("unroll") for (int ks = 0; ks < 4; ++ks) dst[ks] = *(const bf16x8*)(qrow + (h_) * 64 + ks * 16); wdst = widx[(size_t)qtok * 16 + (h_)]; } while (0)
#define IDX_HEAD(src, w_) do { f32x16 a0 = {}, a1 = {}; \
        _Pragma("unroll") for (int ks = 0; ks < 4; ++ks) { a0 = __builtin_amdgcn_mfma_f32_32x32x16_bf16(A[0][ks], src[ks], a0, 0, 0, 0); a1 = __builtin_amdgcn_mfma_f32_32x32x16_bf16(A[1][ks], src[ks], a1, 0, 0, 0); } \
        _Pragma("unroll") for (int r = 0; r < 16; ++r) { o0[r] += (w_) * fmaxf(a0[r], 0.f); o1[r] += (w_) * fmaxf(a1[r], 0.f); } } while (0)
    bf16x8 Bq0[4], Bq1[4]; float w0, w1;
    IDX_LOADQ(Bq0, w0, 0);
#pragma unroll 1
    for (int h = 0; h < 16; h += 2) {
        IDX_LOADQ(Bq1, w1, h + 1);
        IDX_HEAD(Bq0, w0);
        if (h + 2 < 16) IDX_LOADQ(Bq0, w0, h + 2);
        IDX_HEAD(Bq1, w1);
    }
#undef IDX_LOADQ
#undef IDX_HEAD
    LAS float* st = (LAS float*)(F.lds() + F.wave() * 8320);
    const int qpos = qi * 128 + wq * 32 + r32, kpos0 = ki * 128 + wk * 64;
    const float NEG = -__builtin_inff();
#pragma unroll
    for (int r = 0; r < 16; ++r) { const int kk = crow(r, hi);
        st[r32 * 65 + kk] = (kpos0 + kk > qpos) ? NEG : o0[r];
        st[r32 * 65 + 32 + kk] = (kpos0 + 32 + kk > qpos) ? NEG : o1[r]; }
    LDS_WAIT(); asm volatile("" ::: "memory");
    float* dst = scores + (size_t)(b * SEQ + qi * 128 + wq * 32) * SEQ + kpos0 + lane;
#pragma unroll 4
    for (int q = 0; q < 32; ++q) { *dst = st[q * 65 + lane]; dst += SEQ; }
    LDS_WAIT(); asm volatile("" ::: "memory");
}

constexpr int SA_P = 136;
constexpr int SA_BN = 0, SA_CN = 34816, SA_BT = 69632, SA_CB = 104448, SA_SM = 139264;
__device__ __forceinline__ void conv8(const bf16* xraw_row  , int tpos, const float* cw, const float* cb, float (&o)[8]) {
    bf16x8 xv[4];
#pragma unroll
    for (int k = 0; k < 4; ++k) { const int dt_ = k - 3; xv[k] = *(const bf16x8*)(xraw_row + ((tpos + dt_ >= 0) ? (long)dt_ * CONV_CH : 0l)); }
    const f32x4 b0 = *(const f32x4*)cb, b1 = *(const f32x4*)(cb + 4);
#pragma unroll
    for (int j = 0; j < 4; ++j) { o[j] = b0[j]; o[4 + j] = b1[j]; }
#pragma unroll
    for (int k = 0; k < 4; ++k) { const float vm = (tpos + k - 3 >= 0) ? 1.f : 0.f; float xf[8]; unpack8(xv[k], xf);
        const f32x4 w0 = *(const f32x4*)(cw + k * CONV_CH) * vm, w1 = *(const f32x4*)(cw + k * CONV_CH + 4) * vm;
#pragma unroll
        for (int j = 0; j < 4; ++j) { o[j] += w0[j] * xf[j]; o[4 + j] += w1[j] * xf[4 + j]; } }
#pragma unroll
    for (int j = 0; j < 8; ++j) o[j] = silu_f(o[j]);
}
__device__ __forceinline__ void ssd_a_unit(Frame& F, int b, int c, int g, int hf) {
    const bf16* xbc = WSP(const bf16, WS_XBC); bf16* xact = WSP(bf16, WS_XBCACT); const float* dtg = WSP(const float, WS_DT); float* csg = WSP(float, WS_CS);
    float* ydiag = WSP(float, WS_YDIAG); float* states = WSP(float, WS_STATES);
    LAS bf16* Bn = (LAS bf16*)(F.lds() + SA_BN); LAS bf16* Cn = (LAS bf16*)(F.lds() + SA_CN); LAS bf16* BT = (LAS bf16*)(F.lds() + SA_BT); LAS bf16* CB = (LAS bf16*)(F.lds() + SA_CB);
    const int lane = F.lane(), r32 = lane & 31, hi = lane >> 5, w = F.wave();
    const int tok0 = b * SEQ + c * CHUNK;
#pragma unroll 4
    for (int i = 0; i < 8; ++i) { const int id = F.tid() + 512 * i, mi = id >> 11, rem = id & 2047, s = rem >> 4, ch = rem & 15;
        const int chan = 1024 + mi * 256 + g * 128 + ch * 8; float o[8];
        conv8(xbc + (size_t)(tok0 + s) * CONV_CH + chan, c * CHUNK + s, F.f(6) + chan, F.f(7) + chan, o);
        u32x4 pk = {cvt_pk_bf16(o[0], o[1]), cvt_pk_bf16(o[2], o[3]), cvt_pk_bf16(o[4], o[5]), cvt_pk_bf16(o[6], o[7])};
        if (mi == 0) { *(LAS u32x4*)(Bn + s * SA_P + ch * 8) = pk;
#pragma unroll
            for (int j = 0; j < 8; ++j) BT[(ch * 8 + j) * SA_P + s] = (bf16)((pk[j >> 1] >> (16 * (j & 1))) & 0xffffu); }
        else { *(LAS u32x4*)(Cn + s * SA_P + ch * 8) = pk; if (hf == 0) *(u32x4*)(xact + (size_t)(tok0 + s) * CONV_CH + chan) = pk; } }
    __syncthreads();
    { const int lt = w >> 1;
#pragma unroll
      for (int sq = 0; sq < 2; ++sq) { const int st = 2 * (w & 1) + sq; f32x16 a = {};
#pragma unroll
          for (int ks = 0; ks < 8; ++ks) { const bf16x8 av = *(const LAS bf16x8*)(Cn + (32 * lt + r32) * SA_P + 16 * ks + 8 * hi), bv = *(const LAS bf16x8*)(Bn + (32 * st + r32) * SA_P + 16 * ks + 8 * hi);
              a = __builtin_amdgcn_mfma_f32_32x32x16_bf16(av, bv, a, 0, 0, 0); }
#pragma unroll
          for (int r = 0; r < 16; ++r) CB[(32 * lt + crow(r, hi)) * SA_P + 32 * st + r32] = f2bf(a[r]); } }
    __syncthreads();
    const int j = w >> 1, sub = w & 1, h = 8 * g + 4 * hf + j;
    LAS bf16* XT = (LAS bf16*)(F.lds() + j * 17408);
    LAS float* cs_l = (LAS float*)(F.lds() + SA_SM) + j * 384; LAS float* wdec = cs_l + 128;
    {
        const float ah = -__expf(F.f(9)[h]);
        const float d0 = dtg[(size_t)(tok0 + lane) * 16 + h], d1 = dtg[(size_t)(tok0 + 64 + lane) * 16 + h];
        float c0 = d0 * ah, c1 = d1 * ah;
#pragma unroll
        for (int o = 1; o < 64; o <<= 1) { const float t0 = __shfl_up(c0, o), t1 = __shfl_up(c1, o); if (lane >= o) { c0 += t0; c1 += t1; } }
        const float tot0 = __shfl(c0, 63); c1 += tot0; const float cend = __shfl(c1, 63);
        if (sub == 0) { cs_l[lane] = c0; cs_l[64 + lane] = c1; wdec[lane] = __expf(cend - c0); wdec[64 + lane] = __expf(cend - c1);
            csg[(size_t)(tok0 + lane) * 16 + h] = c0; csg[(size_t)(tok0 + 64 + lane) * 16 + h] = c1; }
#pragma unroll 4
        for (int i = 0; i < 8; ++i) { const int id = lane + 64 * i, s = 64 * sub + (id >> 3), ch = id & 7, chan = h * 64 + ch * 8; float o[8];
            conv8(xbc + (size_t)(tok0 + s) * CONV_CH + chan, c * CHUNK + s, F.f(6) + chan, F.f(7) + chan, o);
            u32x4 pk = {cvt_pk_bf16(o[0], o[1]), cvt_pk_bf16(o[2], o[3]), cvt_pk_bf16(o[4], o[5]), cvt_pk_bf16(o[6], o[7])};
            *(u32x4*)(xact + (size_t)(tok0 + s) * CONV_CH + chan) = pk;
            const float dts = dtg[(size_t)(tok0 + s) * 16 + h];
#pragma unroll
            for (int jj = 0; jj < 8; ++jj) XT[(ch * 8 + jj) * SA_P + s] = f2bf(o[jj] * dts); }
    }
    __syncthreads();
#pragma unroll
    for (int lq = 0; lq < 2; ++lq) { const int lt = 2 * sub + lq; const int l = 32 * lt + r32; const float csl = cs_l[l];
        f32x16 a0 = {}, a1 = {};
        for (int ks = 0; ks <= 2 * lt + 1; ++ks) { const int s0 = 16 * ks + 8 * hi;
            float cbf[8]; unpack8(*(const LAS bf16x8*)(CB + l * SA_P + s0), cbf);
            const f32x4 q0 = *(const LAS f32x4*)(cs_l + s0), q1 = *(const LAS f32x4*)(cs_l + s0 + 4);
            float mv[8];
#pragma unroll
            for (int jj = 0; jj < 8; ++jj) { const float cq = jj < 4 ? q0[jj & 3] : q1[jj & 3]; mv[jj] = (s0 + jj <= l) ? cbf[jj] * __expf(csl - cq) : 0.f; }
            const bf16x8 av = pack8((f32x4){mv[0], mv[1], mv[2], mv[3]}, (f32x4){mv[4], mv[5], mv[6], mv[7]});
            const bf16x8 b0 = *(const LAS bf16x8*)(XT + r32 * SA_P + s0), b1 = *(const LAS bf16x8*)(XT + (32 + r32) * SA_P + s0);
            a0 = __builtin_amdgcn_mfma_f32_32x32x16_bf16(av, b0, a0, 0, 0, 0); a1 = __builtin_amdgcn_mfma_f32_32x32x16_bf16(av, b1, a1, 0, 0, 0); }
#pragma unroll
        for (int r = 0; r < 16; ++r) { float* yp = ydiag + (size_t)(tok0 + 32 * lt + crow(r, hi)) * D_SSM + h * 64 + r32; yp[0] = a0[r]; yp[32] = a1[r]; } }
    { f32x16 a[2][2] = {};
      for (int ks = 0; ks < 8; ++ks) { const int s0 = 16 * ks + 8 * hi;
          const f32x4 q0 = *(const LAS f32x4*)(wdec + s0), q1 = *(const LAS f32x4*)(wdec + s0 + 4);
          bf16x8 av[2];
#pragma unroll
          for (int pt = 0; pt < 2; ++pt) { float xf[8]; unpack8(*(const LAS bf16x8*)(XT + (32 * pt + r32) * SA_P + s0), xf);
              av[pt] = pack8((f32x4){xf[0] * q0[0], xf[1] * q0[1], xf[2] * q0[2], xf[3] * q0[3]}, (f32x4){xf[4] * q1[0], xf[5] * q1[1], xf[6] * q1[2], xf[7] * q1[3]}); }
#pragma unroll
          for (int nq = 0; nq < 2; ++nq) { const bf16x8 bv = *(const LAS bf16x8*)(BT + (32 * (2 * sub + nq) + r32) * SA_P + s0);
#pragma unroll
              for (int pt = 0; pt < 2; ++pt) a[pt][nq] = __builtin_amdgcn_mfma_f32_32x32x16_bf16(av[pt], bv, a[pt][nq], 0, 0, 0); } }
      float* sp = states + ((size_t)((b * NCHUNK + c) * SSM_H + h) * SSM_P) * SSM_N;
#pragma unroll
      for (int pt = 0; pt < 2; ++pt)
#pragma unroll
          for (int nq = 0; nq < 2; ++nq)
#pragma unroll
              for (int r = 0; r < 16; ++r) sp[(size_t)(32 * pt + crow(r, hi)) * SSM_N + 32 * (2 * sub + nq) + r32] = a[pt][nq][r]; }
    __syncthreads();
}
constexpr int N_SSD_A = NBATCH * NCHUNK * 2 * 2, N_IDX_U = NBATCH * 528;
__device__ __forceinline__ void p3_ssd(Frame& F) {
#pragma unroll 1
    for (int L = F.bid(); L < N_SSD_A; L += F.G()) { const int hf = L & 1, g = (L >> 1) & 1, c = (L >> 2) & 31, b = L >> 7; ssd_a_unit(F, b, c, g, hf); }
}
__device__ __forceinline__ void p3_idx(Frame& F) {
    int L = F.bid(); while (L < N_SSD_A) L += F.G();
#pragma unroll 1
    for (; L < N_SSD_A + N_IDX_U; L += F.G()) { const int p0 = L - N_SSD_A, b = p0 / 528, p = p0 % 528;
        int qi = (int)((sqrtf(8.f * (float)p + 1.f) - 1.f) * 0.5f);
        while (qi * (qi + 1) / 2 > p) --qi;
        while ((qi + 1) * (qi + 2) / 2 <= p) ++qi;
        idx_unit(F, b, qi, p - qi * (qi + 1) / 2); }
}
__device__ __forceinline__ unsigned fkey(float f) { const unsigned u = __float_as_uint(f); return (u & 0x80000000u) ? ~u : (u | 0x80000000u); }
__device__ __forceinline__ void select_row(Frame& F, int row, LAS unsigned* hist, LAS unsigned* keys) {
    const float* sc = WSP(const float, WS_SCORES) + (size_t)row * SEQ; unsigned long long* mrow = WSP(unsigned long long, WS_MASK) + (size_t)row * 64;
    const int lane = F.lane(), t = row & (SEQ - 1);
    if (t < TOPK_SEL) {
        const int lo = 64 * lane; unsigned long long m;
        if (lo + 63 <= t) m = ~0ull; else if (lo > t) m = 0ull; else m = (1ull << (t - lo + 1)) - 1ull;
        mrow[lane] = m; return;
    }
    const int nI = (t >> 6) + 1;
#pragma unroll 8
    for (int i = 0; i < nI; ++i) { const int e = 64 * i + lane; float v = 0.f; if (e <= t) v = sc[e]; keys[e] = (e <= t) ? fkey(v) : 0u; }
    unsigned prefix = 0u, need = TOPK_SEL, pmask = 0u, cnt_eq = 0u;
#pragma unroll 1
    for (int pass = 0; pass < 4; ++pass) { const int shift = 24 - 8 * pass;
        hist[4 * lane] = 0u; hist[4 * lane + 1] = 0u; hist[4 * lane + 2] = 0u; hist[4 * lane + 3] = 0u;
        LDS_WAIT(); asm volatile("" ::: "memory");
#pragma unroll 4
        for (int i = 0; i < nI; ++i) { const unsigned k = keys[64 * i + lane]; if ((k & pmask) == prefix && k != 0u) __hip_atomic_fetch_add(hist + ((k >> shift) & 255u), 1u, __ATOMIC_RELAXED, __HIP_MEMORY_SCOPE_WORKGROUP); }
        LDS_WAIT(); asm volatile("" ::: "memory");
        const unsigned c0 = hist[4 * lane], c1 = hist[4 * lane + 1], c2 = hist[4 * lane + 2], c3 = hist[4 * lane + 3];
        const unsigned tot = c0 + c1 + c2 + c3;
        unsigned suf = tot;
#pragma unroll
        for (int o = 1; o < 64; o <<= 1) { const unsigned tt = __shfl_down(suf, o); if (lane + o < 64) suf += tt; }
        unsigned above = suf - tot;
        int found = -1; unsigned nneed = 0u, fcnt = 0u;
        if (above < need && need <= above + c3) { found = 3; nneed = need - above; fcnt = c3; }
        above += c3;
        if (found < 0 && above < need && need <= above + c2) { found = 2; nneed = need - above; fcnt = c2; }
        above += c2;
        if (found < 0 && above < need && need <= above + c1) { found = 1; nneed = need - above; fcnt = c1; }
        above += c1;
        if (found < 0 && above < need && need <= above + c0) { found = 0; nneed = need - above; fcnt = c0; }
        const unsigned long long bal = __ballot(found >= 0);
        const int src = (int)__builtin_ctzll(bal | (1ull << 63));
        const unsigned digit = (unsigned)__shfl(4 * lane + found, src);
        need = (unsigned)__shfl((int)nneed, src); cnt_eq = (unsigned)__shfl((int)fcnt, src);
        prefix |= digit << shift; pmask |= 255u << shift;
        LDS_WAIT(); asm volatile("" ::: "memory");
    }
    const bool all_eq = (cnt_eq == need);
    unsigned run = 0u; unsigned long long myword = 0ull;
    const unsigned long long lt_mask = (lane == 0) ? 0ull : (~0ull >> (64 - lane));
#pragma unroll 4
    for (int i = 0; i < nI; ++i) {
        const unsigned k = keys[64 * i + lane]; bool sel = k > prefix;
        if (all_eq) { sel = sel || (k == prefix); }
        else { const unsigned long long em = __ballot(k == prefix); if (k == prefix) sel = (run + (unsigned)__popcll(em & lt_mask)) < need; run += (unsigned)__popcll(em); }
        const unsigned long long wb = __ballot(sel);
        if (lane == i) myword = wb;
    }
    mrow[lane] = myword;
    LDS_WAIT(); asm volatile("" ::: "memory");
}
__device__ __forceinline__ void p4_select(Frame& F) {
    LAS unsigned* keys = (LAS unsigned*)(F.lds() + F.wave() * 16384); LAS unsigned* hist = (LAS unsigned*)(F.lds() + 131072 + F.wave() * 1024);
    const int gw = F.bid() * 8 + F.wave(), NGW = F.G() * 8;
    for (int pr = gw; pr < SEQ / 2; pr += NGW) {
#pragma unroll 1
        for (int b = 0; b < NBATCH; ++b) { select_row(F, b * SEQ + pr, hist, keys); select_row(F, b * SEQ + (SEQ - 1 - pr), hist, keys); }
    }
}
__device__ __forceinline__ void p4_scan(Frame& F) {
    const float* states = WSP(const float, WS_STATES); bf16* hin = WSP(bf16, WS_HIN); const float* csg = WSP(const float, WS_CS);
    const int gt = F.bid() * 512 + F.tid(), NGT = F.G() * 512;
    for (int q = gt; q < NBATCH * SSM_H * SSM_P * (SSM_N / 2); q += NGT) {
        const int n = 2 * (q & 63), p = (q >> 6) & 63, h = (q >> 12) & 15, b = q >> 16;
        float h0 = 0.f, h1 = 0.f;
#pragma unroll 8
        for (int c = 0; c < NCHUNK; ++c) {
            const size_t off = ((size_t)((b * NCHUNK + c) * SSM_H + h) * SSM_P + p) * SSM_N + n;
            *(unsigned*)(hin + off) = cvt_pk_bf16(h0, h1);
            const float dec = __expf(csg[(size_t)(b * SEQ + c * CHUNK + CHUNK - 1) * 16 + h]);
            const f32x2 st = *(const f32x2*)(states + off);
            h0 = dec * h0 + st[0]; h1 = dec * h1 + st[1];
        }
    }
}
namespace att {
constexpr int KVBLK = 64, SHM_K = KVBLK * 128 * 2, SHM_V = SHM_K;
constexpr float SCALE = 0.08838834764831845f, THR = 8.f, C2 = 1.4426950408889634f * SCALE;
#define KSWZ(row, colB) ((row) * 256 + ((colB) ^ (((row) & 7) << 4)))
__device__ __forceinline__ int v_st(int k, int c) { const int kk = (k & ~0xC) | ((k & 4) << 1) | ((k & 8) >> 1); return ((kk >> 3) * 4 + (c >> 5)) * 512 + ((kk & 7) * 32 + (c & 31)) * 2; }
__device__ __forceinline__ int v_rd_base(int lane) { return ((lane & 3) << 3) | (((lane >> 2) & 3) << 6) | (((lane >> 4) & 1) << 5) | (((lane >> 5) & 1) << 8); }
constexpr int v_rd_off(int d0, int ks, int half) { return d0 * 512 + ks * 4096 + half * 2048; }
template <int KB>
__device__ __forceinline__ void qkt(f32x16& p0, f32x16& p1, LAS const char* K_lds, int r32, int hi, const bf16x8* qr) {
    p0 = f32x16{}; p1 = f32x16{};
    LAS const char* kb[4];
#pragma unroll
    for (int dd = 0; dd < 4; ++dd) kb[dd] = K_lds + KB * SHM_K + KSWZ(r32, (dd * 16 + hi * 8) * 2);
#pragma unroll
    for (int d0 = 0; d0 < 8; ++d0) { LAS const char* a = kb[d0 & 3] + (d0 >> 2) * 128;
        const bf16x8 b0 = *(LAS const bf16x8*)a;
        const bf16x8 b1 = *(LAS const bf16x8*)(a + 32 * 256);
        p0 = __builtin_amdgcn_mfma_f32_32x32x16_bf16(b0, qr[d0], p0, 0, 0, 0);
        p1 = __builtin_amdgcn_mfma_f32_32x32x16_bf16(b1, qr[d0], p1, 0, 0, 0); }
}
template <int VB>
__device__ __forceinline__ void pv_tile(f32x16* o, int vb0, bf16x8 pa0, bf16x8 pa1, bf16x8 pa2, bf16x8 pa3) {
#define TRRD(dst, off) asm volatile("ds_read_b64_tr_b16 %0, %1 offset:%2" : "=&v"(dst) : "v"(vb0), "i"(off) : "memory")
#define PV_D0(d0) do { s16x4 l0, l1, l2, l3, h0, h1, h2, h3; constexpr int b_ = VB * SHM_V + v_rd_off(d0, 0, 0); \
        TRRD(l0, b_); TRRD(h0, b_ + 2048); TRRD(l1, b_ + 4096); TRRD(h1, b_ + 6144); TRRD(l2, b_ + 8192); TRRD(h2, b_ + 10240); TRRD(l3, b_ + 12288); TRRD(h3, b_ + 14336); \
        asm volatile("s_waitcnt lgkmcnt(0)" ::: "memory"); __builtin_amdgcn_sched_barrier(0); \
        o[d0] = __builtin_amdgcn_mfma_f32_32x32x16_bf16(pa0, (bf16x8){l0[0], l0[1], l0[2], l0[3], h0[0], h0[1], h0[2], h0[3]}, o[d0], 0, 0, 0);   \
        o[d0] = __builtin_amdgcn_mfma_f32_32x32x16_bf16(pa1, (bf16x8){l1[0], l1[1], l1[2], l1[3], h1[0], h1[1], h1[2], h1[3]}, o[d0], 0, 0, 0);   \
        o[d0] = __builtin_amdgcn_mfma_f32_32x32x16_bf16(pa2, (bf16x8){l2[0], l2[1], l2[2], l2[3], h2[0], h2[1], h2[2], h2[3]}, o[d0], 0, 0, 0);   \
        o[d0] = __builtin_amdgcn_mfma_f32_32x32x16_bf16(pa3, (bf16x8){l3[0], l3[1], l3[2], l3[3], h3[0], h3[1], h3[2], h3[3]}, o[d0], 0, 0, 0); } while (0)
    PV_D0(0); PV_D0(1); PV_D0(2); PV_D0(3);
#undef PV_D0
#undef TRRD
}
__device__ __forceinline__ void softmax_tile(f32x16& p0, f32x16& p1, unsigned long long mw, int hi, float& m_reg, float& l_reg, float& alpha, bf16x8& pa0, bf16x8& pa1, bf16x8& pa2, bf16x8& pa3) {
    float pmax = p0[0];
#pragma unroll
    for (int r = 1; r < 16; ++r) pmax = fmaxf(pmax, p0[r]);
#pragma unroll
    for (int r = 0; r < 16; ++r) pmax = fmaxf(pmax, p1[r]);
    { auto rr = __builtin_amdgcn_permlane32_swap(__float_as_uint(pmax), __float_as_uint(pmax), false, false); pmax = fmaxf(__uint_as_float(rr[0]), __uint_as_float(rr[1])); }
    float mn;
    if (__all((pmax - m_reg) * SCALE <= THR)) { mn = m_reg; alpha = 1.f; }
    else { mn = fmaxf(m_reg, pmax); alpha = __builtin_amdgcn_exp2f((m_reg - mn) * C2); m_reg = mn; }
    const float mnL = -mn * C2;
    const int lo = (int)((unsigned)mw >> (4 * hi)), hh = (int)((unsigned)(mw >> 32) >> (4 * hi));
#pragma unroll
    for (int r = 0; r < 16; ++r) { const int c = (r & 3) + 8 * (r >> 2);
        const float e0 = __builtin_amdgcn_exp2f(fmaf(p0[r], C2, mnL)), e1 = __builtin_amdgcn_exp2f(fmaf(p1[r], C2, mnL));
        p0[r] = __uint_as_float(__float_as_uint(e0) & (unsigned)__builtin_amdgcn_sbfe(lo, c, 1));
        p1[r] = __uint_as_float(__float_as_uint(e1) & (unsigned)__builtin_amdgcn_sbfe(hh, c, 1)); }
    float ps = 0.f;
#pragma unroll
    for (int r = 0; r < 16; ++r) ps += p0[r];
#pragma unroll
    for (int r = 0; r < 16; ++r) ps += p1[r];
    { auto rr = __builtin_amdgcn_permlane32_swap(__float_as_uint(ps), __float_as_uint(ps), false, false); ps = __uint_as_float(rr[0]) + __uint_as_float(rr[1]); }
    l_reg = l_reg * alpha + ps;
#define PK4(P, B_, OUT) do { unsigned a0 = cvt_pk_bf16(P[B_+0], P[B_+1]), a1 = cvt_pk_bf16(P[B_+2], P[B_+3]); \
        unsigned b0 = cvt_pk_bf16(P[B_+4], P[B_+5]), b1 = cvt_pk_bf16(P[B_+6], P[B_+7]); \
        auto r0 = __builtin_amdgcn_permlane32_swap(a0, b0, false, false); auto r1 = __builtin_amdgcn_permlane32_swap(a1, b1, false, false); \
        u32x4 w = {r0[0], r1[0], r0[1], r1[1]}; OUT = __builtin_bit_cast(bf16x8, w); } while (0)
    PK4(p0, 0, pa0); PK4(p0, 8, pa1); PK4(p1, 0, pa2); PK4(p1, 8, pa3);
#undef PK4
}
}

__device__ __forceinline__ void attn_item(Frame& F, int b, int h, int X) {
    using namespace att;
    const bf16* qg = WSP(const bf16, WS_Q); const bf16* kg = WSP(const bf16, WS_K) + (size_t)(b * SEQ) * 1024 + h * 128; const bf16* vg = WSP(const bf16, WS_V) + (size_t)(b * SEQ) * 1024 + h * 128;
    const unsigned long long* maskg = WSP(const unsigned long long, WS_MASK); bf16* ycat = WSP(bf16, WS_YCAT);
    const int tid = F.tid(), wid = F.wave(), lane = F.lane(), r32 = lane & 31, hi = lane >> 5;
    LAS char* V_lds = (LAS char*)F.lds(); LAS char* K_lds = V_lds + 2 * SHM_V;
    LAS float* wsl = (LAS float*)(F.lds() + 2 * SHM_V + 2 * SHM_K) + wid * 64; LAS float* li_l = wsl; LAS float* al_l = wsl + 32;
    const int tokq = b * SEQ + X * 256 + wid * 32 + r32, NT = 4 * X + 4;
    bf16x8 qr[8];
#pragma unroll
    for (int d0 = 0; d0 < 8; ++d0) qr[d0] = *(const bf16x8*)(qg + (size_t)tokq * 1024 + h * 128 + d0 * 16 + hi * 8);
    const unsigned long long* mrow = maskg + (size_t)tokq * 64;
    const int sr = tid >> 4, sc = (tid & 15) * 8, vst0 = v_st(sr, sc), vst1 = v_st(32 + sr, sc), kws = KSWZ(sr, sc * 2);
    const int vb0 = (int)(unsigned)(uintptr_t)V_lds + v_rd_base(lane);
    float m_reg = -1e30f, l_reg = 0.f; f32x16 o[4] = {};
    bf16x8 st_k0, st_k1, st_v0, st_v1;
#define ALOAD(t) do { const size_t r0_ = (size_t)((t) * KVBLK + sr) * 1024 + sc; st_k0 = *(const bf16x8*)(kg + r0_); st_k1 = *(const bf16x8*)(kg + r0_ + 32 * 1024); \
                      st_v0 = *(const bf16x8*)(vg + r0_); st_v1 = *(const bf16x8*)(vg + r0_ + 32 * 1024); } while (0)
#define AWRITE(bf) do { *(LAS bf16x8*)(K_lds + (bf) * SHM_K + kws) = st_k0; *(LAS bf16x8*)(K_lds + (bf) * SHM_K + kws + 32 * 256) = st_k1; \
                        *(LAS bf16x8*)(V_lds + (bf) * SHM_V + vst0) = st_v0; *(LAS bf16x8*)(V_lds + (bf) * SHM_V + vst1) = st_v1; } while (0)
#define ASTEP(t, KB) do { AWRITE(KB); __syncthreads(); \
        const unsigned long long mw_ = mrow[(t)]; if ((t) + 1 < NT) ALOAD((t) + 1); \
        f32x16 p0, p1; float alpha; bf16x8 pa0, pa1, pa2, pa3; \
        qkt<KB>(p0, p1, K_lds, r32, hi, qr); \
        softmax_tile(p0, p1, mw_, hi, m_reg, l_reg, alpha, pa0, pa1, pa2, pa3); \
        if (__any(alpha < 1.f)) { if (hi == 0) al_l[r32] = alpha; LDS_WAIT(); \
            _Pragma("unroll") for (int d_ = 0; d_ < 4; ++d_) _Pragma("unroll") for (int r = 0; r < 16; ++r) o[d_][r] *= al_l[crow(r, hi)]; } \
        pv_tile<KB>(o, vb0, pa0, pa1, pa2, pa3); } while (0)
    ALOAD(0);
    for (int t = 0; t < NT; t += 2) { ASTEP(t, 0); ASTEP(t + 1, 1); }
#undef ASTEP
#undef AWRITE
#undef ALOAD
    if (hi == 0) li_l[r32] = l_reg; LDS_WAIT();
    float rli[16];
#pragma unroll
    for (int r = 0; r < 16; ++r) rli[r] = __builtin_amdgcn_rcpf(li_l[crow(r, hi)]);
    bf16* Ow = ycat + (size_t)(b * SEQ + X * 256 + wid * 32) * DM + D_SSM + h * 128;
#pragma unroll
    for (int r = 0; r < 16; ++r) { const int orow = crow(r, hi);
#pragma unroll
        for (int d0 = 0; d0 < 4; ++d0) { const float v = o[d0][r] * rli[r]; const float vn = __shfl_xor(v, 1);
            if ((r32 & 1) == 0) *(unsigned*)(Ow + (size_t)orow * DM + d0 * 32 + r32) = cvt_pk_bf16(v, vn); } }
    __syncthreads();
}

__device__ __forceinline__ void ssd_c_unit(Frame& F, int b, int c, int lq) {
    const bf16* xact = WSP(const bf16, WS_XBCACT); const bf16* hin = WSP(const bf16, WS_HIN); const float* csg = WSP(const float, WS_CS); const float* ydiag = WSP(const float, WS_YDIAG);
    const bf16* zg = WSP(const bf16, WS_Z); bf16* ycat = WSP(bf16, WS_YCAT);
    LAS float* gb = (LAS float*)F.lds();
    const int lane = F.lane(), r32 = lane & 31, hi = lane >> 5, w = F.wave(), g = w >> 2;
    const int tok0 = b * SEQ + c * CHUNK + lq * 32;
    bf16x8 Af[8];
#pragma unroll
    for (int ks = 0; ks < 8; ++ks) Af[ks] = *(const bf16x8*)(xact + (size_t)(tok0 + r32) * CONV_CH + 1280 + g * 128 + 16 * ks + 8 * hi);
#pragma unroll
    for (int hh = 0; hh < 2; ++hh) { const int h = 2 * w + hh;
        const bf16* hp = hin + ((size_t)((b * NCHUNK + c) * SSM_H + h) * SSM_P) * SSM_N;
        f32x16 a0 = {}, a1 = {};
#pragma unroll
        for (int ks = 0; ks < 8; ++ks) { const bf16x8 b0 = *(const bf16x8*)(hp + (size_t)r32 * SSM_N + 16 * ks + 8 * hi), b1 = *(const bf16x8*)(hp + (size_t)(32 + r32) * SSM_N + 16 * ks + 8 * hi);
            a0 = __builtin_amdgcn_mfma_f32_32x32x16_bf16(Af[ks], b0, a0, 0, 0, 0); a1 = __builtin_amdgcn_mfma_f32_32x32x16_bf16(Af[ks], b1, a1, 0, 0, 0); }
        const float dsk = F.f(10)[h];
#pragma unroll
        for (int r = 0; r < 16; ++r) { const int l = crow(r, hi); const size_t tok = (size_t)(tok0 + l);
            const float e = __expf(csg[tok * 16 + h]);
#pragma unroll
            for (int pt = 0; pt < 2; ++pt) { const int col = h * 64 + 32 * pt + r32;
                const float y = ydiag[tok * D_SSM + col] + e * (pt ? a1[r] : a0[r]) + dsk * bf2f(xact[tok * CONV_CH + col]);
                gb[l * 1024 + col] = y * silu_f(bf2f(zg[tok * 1024 + col])); } } }
    __syncthreads();
#pragma unroll
    for (int rr = 0; rr < 4; ++rr) { const int l = 4 * w + rr; float ss = 0.f; f32x4 v[4];
#pragma unroll
        for (int j = 0; j < 4; ++j) { v[j] = *(const LAS f32x4*)(gb + l * 1024 + j * 256 + lane * 4); ss += v[j][0] * v[j][0] + v[j][1] * v[j][1] + v[j][2] * v[j][2] + v[j][3] * v[j][3]; }
        const float rs = 1.0f / sqrtf(wave_sum(ss) * (1.0f / 1024.0f) + LN_EPS);
#pragma unroll
        for (int j = 0; j < 4; ++j) { const f32x4 nw = *(const f32x4*)(F.f(11) + j * 256 + lane * 4); const f32x4 y = v[j] * rs * nw;
            u32x2 o = {cvt_pk_bf16(y[0], y[1]), cvt_pk_bf16(y[2], y[3])};
            *(u32x2*)(ycat + (size_t)(tok0 + l) * DM + j * 256 + lane * 4) = o; } }
    __syncthreads();
}
__device__ __forceinline__ void p5_phase(Frame& F) {
    for (int L = F.bid(); L < 256; L += F.G()) { const int lq = L & 3, c = (L >> 2) & 31, b = L >> 7; ssd_c_unit(F, b, c, lq); }
    for (int L = F.bid(); L < 256; L += F.G()) { const int X = 15 - (L >> 4), h = L & 7, b = (L >> 3) & 1; attn_item(F, b, h, X); }
}
struct EpiOutProj {
    static constexpr bool PERM = false;
    const float* x; const float* modf; float* out;
    __device__ __forceinline__ void operator()(const f32x4 (&acc)[2][2][4][2], const pg8::Unit& u, int wr, int wc, int fr, int fq) const {
        const int row0 = u.pm * 256 + wr * 64 + fr, col0 = u.pn * 256 + wc * 32 + 4 * fq; const int b = (u.pm * 256) / SEQ;
        f32x4 gv[2][2];
#pragma unroll
        for (int bj = 0; bj < 2; ++bj)
#pragma unroll
            for (int n = 0; n < 2; ++n) gv[bj][n] = *(const f32x4*)(modf + (size_t)b * (6 * DM) + 2 * DM + col0 + bj * 128 + n * 16);
#pragma unroll
        for (int ai = 0; ai < 2; ++ai)
#pragma unroll
            for (int m = 0; m < 4; ++m) { const size_t off = (size_t)(row0 + ai * 128 + m * 16) * DM + col0;
#pragma unroll
                for (int bj = 0; bj < 2; ++bj)
#pragma unroll
                    for (int n = 0; n < 2; ++n) { const f32x4 xv = *(const f32x4*)(x + off + bj * 128 + n * 16);
                        *(f32x4*)(out + off + bj * 128 + n * 16) = xv * ALPHA_DN + gv[bj][n] * acc[ai][bj][m][n]; } }
    }
};

constexpr int RT_P = 2056;
__device__ __forceinline__ void p7_unit(Frame& F, int un) {
    const float* modf = WSP(const float, WS_MODF); bf16* u2 = WSP(bf16, WS_U2); const bf16* wr_hi = WSP(const bf16, WS_WR); const bf16* wr_lo = wr_hi + NE * DM;
    int* inv = WSP(int, WS_INV); int* ltok = WSP(int, WS_LTOK); float* lw = WSP(float, WS_LW);
    LAS bf16* Ah = (LAS bf16*)F.lds(); LAS bf16* Al = Ah + 16 * RT_P; LAS float* red = (LAS float*)F.lds();
    LAS float* logit = (LAS float*)(F.lds() + 135168);
    const int lane = F.lane(), w = F.wave(), row0 = un * 16, b = row0 / SEQ;
    const float* sh2 = modf + (size_t)b * (6 * DM) + 3 * DM; const float* sc2 = modf + (size_t)b * (6 * DM) + 4 * DM;
    PSUB(70, 0); PSUB(71, 0);
#pragma unroll
    for (int rr = 0; rr < 2; ++rr) { const int rl = 2 * w + rr; const size_t row = (size_t)(row0 + rl);
        f32x4 v[8]; float s = 0.f;
#pragma unroll
        for (int j = 0; j < 8; ++j) { v[j] = *(const f32x4*)(F.out() + row * DM + j * 256 + lane * 4); s += (v[j][0] + v[j][1]) + (v[j][2] + v[j][3]); }
        const float mu = wave_sum(s) * (1.0f / DM); float q = 0.f;
#pragma unroll
        for (int j = 0; j < 8; ++j) { v[j] = v[j] - mu; q += (v[j][0] * v[j][0] + v[j][1] * v[j][1]) + (v[j][2] * v[j][2] + v[j][3] * v[j][3]); }
        const float rstd = 1.0f / sqrtf(wave_sum(q) * (1.0f / DM) + LN_EPS);
#pragma unroll
        for (int j = 0; j < 8; ++j) { const int col = j * 256 + lane * 4;
            const f32x4 x1 = v[j] * rstd * *(const f32x4*)(F.f(15) + col) + *(const f32x4*)(F.f(16) + col);
            *(f32x4*)(F.out() + row * DM + col) = x1;
            const f32x4 uu = x1 * (*(const f32x4*)(sc2 + col) + 1.0f) + *(const f32x4*)(sh2 + col);
            const unsigned h0 = cvt_pk_bf16(uu[0], uu[1]), h1 = cvt_pk_bf16(uu[2], uu[3]);
            *(u32x2*)(u2 + row * DM + col) = (u32x2){h0, h1};
            const unsigned l0 = cvt_pk_bf16(uu[0] - bflo(h0), uu[1] - bfhi(h0)), l1 = cvt_pk_bf16(uu[2] - bflo(h1), uu[3] - bfhi(h1));
            *(LAS u32x2*)(Ah + rl * RT_P + col) = (u32x2){h0, h1}; *(LAS u32x2*)(Al + rl * RT_P + col) = (u32x2){l0, l1}; } }
    __syncthreads();
    PSUB(70, 1); PSUB(72, 0);
    f32x4 acc[4] = {};
    { const int fr = lane & 15, fq = lane >> 4;
#pragma unroll 2
      for (int ks = 0; ks < 8; ++ks) { const int k0 = w * 256 + ks * 32 + fq * 8;
          const bf16x8 ah = *(const LAS bf16x8*)(Ah + fr * RT_P + k0), al = *(const LAS bf16x8*)(Al + fr * RT_P + k0);
#pragma unroll
          for (int nt = 0; nt < 4; ++nt) { const bf16x8 bh = *(const bf16x8*)(wr_hi + (size_t)(16 * nt + fr) * DM + k0), bl = *(const bf16x8*)(wr_lo + (size_t)(16 * nt + fr) * DM + k0);
              acc[nt] = __builtin_amdgcn_mfma_f32_16x16x32_bf16(ah, bh, acc[nt], 0, 0, 0);
              acc[nt] = __builtin_amdgcn_mfma_f32_16x16x32_bf16(al, bh, acc[nt], 0, 0, 0);
              acc[nt] = __builtin_amdgcn_mfma_f32_16x16x32_bf16(ah, bl, acc[nt], 0, 0, 0); } }
      __syncthreads();
#pragma unroll
      for (int nt = 0; nt < 4; ++nt)
#pragma unroll
          for (int r = 0; r < 4; ++r) red[(w * 16 + fq * 4 + r) * 64 + 16 * nt + fr] = acc[nt][r]; }
    __syncthreads();
#pragma unroll
    for (int i = 0; i < 2; ++i) { const int o = F.tid() + 512 * i; float s = 0.f;
#pragma unroll
        for (int ww = 0; ww < 8; ++ww) s += red[ww * 1024 + o];
        logit[o] = s; }
    __syncthreads();
    PSUB(72, 1); PSUB(73, 0);
#pragma unroll 1
    for (int rr = 0; rr < 2; ++rr) { const int rl = 2 * w + rr, tok = row0 + rl;
        const float score = sigmoid_f(logit[rl * 64 + lane]); const float biased = score + F.f(18)[lane];
        float m1 = biased;
#pragma unroll
        for (int o = 1; o < 8; o <<= 1) m1 = fmaxf(m1, __shfl_xor(m1, o));
        int i1 = (biased == m1) ? lane : 64;
#pragma unroll
        for (int o = 1; o < 8; o <<= 1) i1 = min(i1, __shfl_xor(i1, o));
        float m2 = (lane == i1) ? -__builtin_inff() : biased;
#pragma unroll
        for (int o = 1; o < 8; o <<= 1) m2 = fmaxf(m2, __shfl_xor(m2, o));
        const float gs = m1 + m2; const int grp = lane >> 3;
        int grank = 0;
#pragma unroll
        for (int g2 = 0; g2 < 8; ++g2) { const float og = __shfl(gs, 8 * g2); grank += (og > gs || (og == gs && g2 < grp)) ? 1 : 0; }
        const float mk = (grank < 4) ? biased : -__builtin_inff();
        int erank = 0;
#pragma unroll 4
        for (int e2 = 0; e2 < 64; ++e2) { const float oe = __shfl(mk, e2); erank += (oe > mk || (oe == mk && e2 < lane)) ? 1 : 0; }
        const bool sel = erank < 8;
        const float wsum = wave_sum(sel ? score : 0.f);
        if (sel) { const float gw = score / wsum * 2.5f;
            const int rk = (int)__hip_atomic_fetch_add(F.ctl() + CW_ECNT + 64 * lane, 1u, RLX_AGENT);
            ltok[lane * NTOK + rk] = tok; lw[lane * NTOK + rk] = gw; inv[tok * 8 + erank] = lane * NTOK + rk; } }
    __syncthreads();
    PSUB(73, 1); PSUB(71, 1);
}
__device__ __forceinline__ void p7_phase(Frame& F) { for (int un = F.bid(); un < NTOK / 16; un += F.G()) p7_unit(F, un); }
struct MoeOrder {
    const LAS int* tab; const int* ltok; int G, c, npn;
    __device__ __forceinline__ bool next(int i, pg8::Unit& u) const {
        const int L = i * G + c; const int total = tab[80 + NEX] * npn; if (L >= total) return false;
        int e = 0;
        for (int k = 1; k < NEX; ++k) e += (tab[80 + k] * npn <= L) ? 1 : 0;
        const int nte = tab[80 + e + 1] - tab[80 + e], rem = L - tab[80 + e] * npn;
        const int mt = rem % nte, pn = rem / nte;
        u.pm = tab[80 + e] + mt; u.pn = e * npn + pn; u.ax = (e << 8) | mt; return true;
    }
    __device__ __forceinline__ int row_tok(const pg8::Unit& u, int r) const {
        const int e = u.ax >> 8, idx = (u.ax & 255) * 256 + r;
        if (e == NE) return idx;
        return idx < tab[e] ? ltok[e * NTOK + idx] : 0;
    }
};
__device__ __forceinline__ void moe_tables(Frame& F) {
    LAS int* tab = (LAS int*)(F.lds() + LDS_MISC + 64);
    if (F.tid() == 0) { int cum = 0;
        for (int e = 0; e < NE; ++e) { const int cn = (int)__hip_atomic_load(F.ctl() + CW_ECNT + 64 * e, RLX_AGENT); tab[e] = cn; tab[80 + e] = cum; cum += (cn + 255) >> 8; }
        tab[NE] = NTOK; tab[80 + NE] = cum; cum += NTOK / 256; tab[80 + NEX] = cum; }
    __syncthreads();
}
struct EpiGateUp {
    static constexpr bool PERM = true;
    bf16* hid; const float* lw; const LAS int* tab;
    __device__ __forceinline__ void operator()(const f32x4 (&acc)[2][2][4][2], const pg8::Unit& u, int wr, int wc, int fr, int fq) const {
        const int e = u.ax >> 8, mt = u.ax & 255, pn = u.pn & 3; const int cnt = tab[e];
#pragma unroll
        for (int ai = 0; ai < 2; ++ai)
#pragma unroll
            for (int m = 0; m < 4; ++m) { const int rl = ai * 128 + wr * 64 + m * 16 + fr, idx = mt * 256 + rl;
                const float gw = (e == NE) ? 1.0f : (idx < cnt ? lw[e * NTOK + idx] : 0.0f);
                f32x4 h0, h1;
#pragma unroll
                for (int i = 0; i < 4; ++i) { h0[i] = silu_f(acc[ai][0][m][0][i]) * acc[ai][1][m][0][i] * gw; h1[i] = silu_f(acc[ai][0][m][1][i]) * acc[ai][1][m][1][i] * gw; }
                u32x4 w = {cvt_pk_bf16(h0[0], h0[1]), cvt_pk_bf16(h0[2], h0[3]), cvt_pk_bf16(h1[0], h1[1]), cvt_pk_bf16(h1[2], h1[3])};
                *(u32x4*)(hid + (size_t)(u.pm * 256 + rl) * DE + pn * 128 + wc * 32 + 8 * fq) = w; }
    }
};
struct EpiDown {
    static constexpr bool PERM = true;
    bf16* outs;
    __device__ __forceinline__ void operator()(const f32x4 (&acc)[2][2][4][2], const pg8::Unit& u, int wr, int wc, int fr, int fq) const {
        const int pn = u.pn & 7;
#pragma unroll
        for (int ai = 0; ai < 2; ++ai)
#pragma unroll
            for (int m = 0; m < 4; ++m) { bf16* rowp = outs + (size_t)(u.pm * 256 + ai * 128 + wr * 64 + m * 16 + fr) * DM + pn * 256 + wc * 32 + 8 * fq;
#pragma unroll
                for (int bj = 0; bj < 2; ++bj) { const f32x4 v0 = acc[ai][bj][m][0], v1 = acc[ai][bj][m][1];
                    u32x4 w = {cvt_pk_bf16(v0[0], v0[1]), cvt_pk_bf16(v0[2], v0[3]), cvt_pk_bf16(v1[0], v1[1]), cvt_pk_bf16(v1[2], v1[3])};
                    *(u32x4*)(rowp + bj * 128) = w; } }
    }
};
__device__ __forceinline__ void p10_final(Frame& F) {
    const float* modf = WSP(const float, WS_MODF); const bf16* outs = WSP(const bf16, WS_OUTS); const int* inv = WSP(const int, WS_INV);
    const LAS int* tab = (const LAS int*)(F.lds() + LDS_MISC + 64);
    const int gw = F.bid() * 8 + F.wave(), NGW = F.G() * 8;
    for (int tok = gw; tok < NTOK; tok += NGW) { int lane = F.lane(); asm volatile("" : "+v"(lane)); const int b = tok / SEQ; const float* g2 = modf + (size_t)b * (6 * DM) + 5 * DM;
        size_t rows[9];
#pragma unroll
        for (int k = 0; k < 8; ++k) { const int iv = inv[tok * 8 + k]; const int e = iv / NTOK, rk = iv % NTOK; rows[k] = (size_t)(tab[80 + e] * 256 + rk); }
        rows[8] = (size_t)(tab[80 + NE] * 256 + tok);
        f32x4 v[8]; float s = 0.f;
#pragma unroll
        for (int jj = 0; jj < 4; ++jj) { const int col = jj * 512 + lane * 8; f32x4 f0 = {0.f, 0.f, 0.f, 0.f}, f1 = {0.f, 0.f, 0.f, 0.f};
#pragma unroll
            for (int k = 0; k < 9; ++k) { const u32x4 w = *(const u32x4*)(outs + rows[k] * DM + col);
                f0[0] += bflo(w[0]); f0[1] += bfhi(w[0]); f0[2] += bflo(w[1]); f0[3] += bfhi(w[1]); f1[0] += bflo(w[2]); f1[1] += bfhi(w[2]); f1[2] += bflo(w[3]); f1[3] += bfhi(w[3]); }
            const f32x4 xa = *(const f32x4*)(F.out() + (size_t)tok * DM + col), xb = *(const f32x4*)(F.out() + (size_t)tok * DM + col + 4);
            v[2 * jj] = xa * ALPHA_DN + *(const f32x4*)(g2 + col) * f0; v[2 * jj + 1] = xb * ALPHA_DN + *(const f32x4*)(g2 + col + 4) * f1;
            s += (v[2 * jj][0] + v[2 * jj][1]) + (v[2 * jj][2] + v[2 * jj][3]) + (v[2 * jj + 1][0] + v[2 * jj + 1][1]) + (v[2 * jj + 1][2] + v[2 * jj + 1][3]); }
        const float mu = wave_sum(s) * (1.0f / DM); float q = 0.f;
#pragma unroll
        for (int j = 0; j < 8; ++j) { v[j] = v[j] - mu; q += (v[j][0] * v[j][0] + v[j][1] * v[j][1]) + (v[j][2] * v[j][2] + v[j][3] * v[j][3]); }
        const float rstd = 1.0f / sqrtf(wave_sum(q) * (1.0f / DM) + LN_EPS);
#pragma unroll
        for (int j = 0; j < 8; ++j) { const int col = (j >> 1) * 512 + lane * 8 + (j & 1) * 4;
            *(f32x4*)(F.out() + (size_t)tok * DM + col) = v[j] * rstd * *(const f32x4*)(F.f(25) + col) + *(const f32x4*)(F.f(26) + col); } }
}
#ifndef MK_N_LAUNCHES
#define MK_N_LAUNCHES 1
#endif
constexpr int N_PHASES = 11;
__global__ void __launch_bounds__(512, 2) fwd_kernel(Args args) {
    Frame F; F.ap = &args;
    if (F.tid() < 16) ((LAS unsigned*)(F.lds() + LDS_MISC))[F.tid()] = 0u;
    __syncthreads();
    if (args.ph_hi - args.ph_lo > 1) (void)xcd_barrier_post((unsigned*)(F.ctl() + CW_BAR), (volatile LAS unsigned*)(F.lds() + LDS_MISC));
#ifndef PH_MASK
#define PH_MASK 0x7ff
#endif
#define IN(k) (((PH_MASK >> (k)) & 1) && args.ph_lo <= (k) && (k) < args.ph_hi)
#ifdef PROBE_PHASE
    unsigned long long pt0_ = __builtin_amdgcn_s_memrealtime(), pt1_ = 0ull;
#ifdef PROBE_SUB
#define PMARK(k) do { } while (0)
#else
#define PMARK(k) do { if ((k) + 1 == PROBE_PHASE) pt0_ = __builtin_amdgcn_s_memrealtime(); if ((k) == PROBE_PHASE) pt1_ = __builtin_amdgcn_s_memrealtime(); } while (0)
#endif
#else
#define PMARK(k) do { } while (0)
#endif
#define SEAM(k) do { if (IN(k) && IN((k) + 1)) { XcdBarrier bar_; bar_.bar = (unsigned*)(F.ctl() + CW_BAR); bar_.x = xb_xcc_id(); bar_.st = (volatile LAS unsigned*)(F.lds() + LDS_MISC); xcd_barrier(bar_); } } while (0)
    if (IN(0)) { p0_prologue(F); } SEAM(0); PMARK(0);
    if (IN(1)) { p1_modulate(F); } SEAM(1); PMARK(1);
    if (IN(2)) {
        pg8::Gemm g{WSP(const bf16, WS_U1), WSP(const bf16, WS_WIN), DM}; pg8::StaticOrder S; S.init(NTOK, NPROJ_PAD, F.G(), F.bid());
        EpiInProj E{F.ws(), F.f(8), F.f(12), F.f(13)};
        pg8::gemm_phase<EpiInProj, pg8::StaticOrder, false>(F.lds(), g, S, E);
        slack_fill(F, (F.bid() + 3 * F.G() < 32 * NPROJ_TILES) ? 0 : 8, false, Q_ALL);
    } SEAM(2); PMARK(2);
    if (IN(3)) {
        PSUB(3, 0); p3_ssd(F); PSUB(3, 1); p3_idx(F);
    } SEAM(3); PMARK(3);
    if (IN(4)) { p4_select(F); p4_scan(F); } SEAM(4); PMARK(4);
    if (IN(5)) { p5_phase(F); slack_fill(F, (F.G() == 256) ? ((F.bid() >> 4) * 3) / 2 : 0, false, Q_ALL); } SEAM(5); PMARK(5);
    if (IN(6)) {
        pg8::Gemm g{WSP(const bf16, WS_YCAT), WSP(const bf16, WS_WOUT), DM}; pg8::StaticOrder S; S.init(NTOK, DM, F.G(), F.bid());
        EpiOutProj E{F.f(0), WSP(const float, WS_MODF), F.out()};
        pg8::gemm_phase<EpiOutProj, pg8::StaticOrder, false>(F.lds(), g, S, E);
    } SEAM(6); PMARK(6);
    if (IN(7)) { p7_phase(F); slack_fill(F, 0, true, Q_GU); } SEAM(7); PMARK(7);
    if (IN(8)) {
        const int vcu = (F.G() % 8 == 0) ? (F.bid() % 8) * (F.G() / 8) + F.bid() / 8 : F.bid();
        moe_tables(F);
        const LAS int* tab = (const LAS int*)(F.lds() + LDS_MISC + 64);
        pg8::Gemm g{WSP(const bf16, WS_U2), WSP(const bf16, WS_WGU), DM}; MoeOrder S{tab, WSP(const int, WS_LTOK), F.G(), vcu, 4};
        EpiGateUp E{WSP(bf16, WS_HID), WSP(const float, WS_LW), tab};
        pg8::gemm_phase<EpiGateUp, MoeOrder, true>(F.lds(), g, S, E);
        slack_fill(F, 0, true, Q_ALL);
    } SEAM(8); PMARK(8);
    if (IN(9)) {
        const int vcu = (F.G() % 8 == 0) ? (F.bid() % 8) * (F.G() / 8) + F.bid() / 8 : F.bid();
        moe_tables(F);
        const LAS int* tab = (const LAS int*)(F.lds() + LDS_MISC + 64);
        pg8::Gemm g{WSP(const bf16, WS_HID), WSP(const bf16, WS_WDN), DE}; MoeOrder S{tab, WSP(const int, WS_LTOK), F.G(), vcu, 8};
        EpiDown E{WSP(bf16, WS_OUTS)};
        pg8::gemm_phase<EpiDown, MoeOrder, false>(F.lds(), g, S, E);
    } SEAM(9); PMARK(9);
    if (IN(10)) { moe_tables(F); p10_final(F); }
#ifdef PROBE_PHASE
    if (pt1_ == 0ull) pt1_ = __builtin_amdgcn_s_memrealtime();
#ifdef PROBE_SUB
    __syncthreads(); pt0_ = *(volatile LAS unsigned long long*)(F.lds() + LDS_MISC + 32); pt1_ = *(volatile LAS unsigned long long*)(F.lds() + LDS_MISC + 40);
#endif
    if (F.bid() == 0) { const unsigned long long w = 8ull * (pt1_ - pt0_), te = __builtin_amdgcn_s_memrealtime(); while (__builtin_amdgcn_s_memrealtime() - te < w) __builtin_amdgcn_s_sleep(32); }
#endif
#ifdef DBG_OFF
    if (args.ph_hi == N_PHASES) {
        const size_t n = (size_t)NTOK * DM; float* o = F.out();
        for (size_t i = (size_t)F.bid() * 512 + F.tid(); i < n; i += (size_t)F.G() * 512) {
            float v;
            if (DBG_KIND == 0) v = bf2f(((const bf16*)(F.ws() + (size_t)(DBG_OFF)))[i % (size_t)(DBG_N)]);
            else v = ((const float*)(F.ws() + (size_t)(DBG_OFF)))[i % (size_t)(DBG_N)];
            if (!(fabsf(v) < 1e30f)) v = 1e30f;
            o[i] = v; }
    }
#endif
#undef IN
#undef SEAM
#undef PMARK
}

extern "C" void kernel_launch(void* const* d_in, const int* in_sizes, int n_in, void* d_out, int out_size, void* d_ws, size_t ws_size, hipStream_t stream) {
    static int grid = 0;
    if (grid == 0) {
        if (n_in != 27 || out_size != NTOK * DM || ws_size < WS_END) { fprintf(stderr, "kernel_launch: unexpected shapes (n_in %d, out %d, ws %zu; need ws >= %zu)\n", n_in, out_size, ws_size, (size_t)WS_END); }
        int dev = 0, cus = 0, per_cu = 0;
        if (hipGetDevice(&dev) != hipSuccess || hipDeviceGetAttribute(&cus, hipDeviceAttributeMultiprocessorCount, dev) != hipSuccess) { grid = -1; return; }
        if (hipFuncSetAttribute((const void*)fwd_kernel, hipFuncAttributeMaxDynamicSharedMemorySize, LDS_BYTES) != hipSuccess) { fprintf(stderr, "kernel_launch: hipFuncSetAttribute failed\n"); grid = -1; return; }
        if (hipOccupancyMaxActiveBlocksPerMultiprocessor(&per_cu, (const void*)fwd_kernel, 512, LDS_BYTES) != hipSuccess || per_cu < 1) fprintf(stderr, "kernel_launch: occupancy query reports %d\n", per_cu);
        (void)hipGetLastError();
        grid = cus;
    }
    if (grid < 0) return;
    (void)hipMemsetAsync((char*)d_ws + WS_CTL, 0, CTL_ZERO_BYTES, stream);
    Args a{};
    for (int i = 0; i < 27; ++i) a.in[i] = d_in[i];
    a.out = (float*)d_out; a.ws = (unsigned char*)d_ws;
#if MK_N_LAUNCHES == 1
    a.ph_lo = 0; a.ph_hi = N_PHASES;
    hipLaunchKernelGGL(fwd_kernel, dim3(grid), dim3(512), LDS_BYTES, stream, a);
#else
    for (int p = 0; p < N_PHASES; ++p) { a.ph_lo = p; a.ph_hi = p + 1; hipLaunchKernelGGL(fwd_kernel, dim3(grid), dim3(512), LDS_BYTES, stream, a);
#ifdef DUP_PHASE
        if (p == DUP_PHASE) hipLaunchKernelGGL(fwd_kernel, dim3(grid), dim3(512), LDS_BYTES, stream, a);
#endif
    }
#endif
}
```

```cpp
#include <hip/hip_runtime.h>
#include <cstdio>
#include <cstdint>

#define GAS __attribute__((address_space(1)))
#define LAS __attribute__((address_space(3)))
#define CAS __attribute__((address_space(4)))
typedef unsigned short bf16;
typedef short bf16x8 __attribute__((ext_vector_type(8)));
typedef short s16x4 __attribute__((ext_vector_type(4)));
typedef float f32x2 __attribute__((ext_vector_type(2)));
typedef float f32x4 __attribute__((ext_vector_type(4)));
typedef float f32x16 __attribute__((ext_vector_type(16)));
typedef unsigned u32x2 __attribute__((ext_vector_type(2)));
typedef unsigned u32x4 __attribute__((ext_vector_type(4)));
typedef GAS unsigned gu32;
#define RLX_AGENT __ATOMIC_RELAXED, __HIP_MEMORY_SCOPE_AGENT
#define LDS_WAIT() asm volatile("s_waitcnt lgkmcnt(0)" ::: "memory")
#define VM_WAIT() asm volatile("s_waitcnt vmcnt(0)" ::: "memory")

constexpr int DM = 2048, NBATCH = 2, SEQ = 4096, NTOK = NBATCH * SEQ;
constexpr int D_SSM = 1024, SSM_H = 16, SSM_P = 64, SSM_N = 128, CONV_CH = 1536, CHUNK = 128, NCHUNK = SEQ / CHUNK;
constexpr int ATT_H = 8, ATT_D = 128, IDX_H = 16, IDX_D = 64, TOPK_SEL = 256;
constexpr int NE = 64, DE = 512, NEX = NE + 1;
constexpr int NPROJ = 6752, NPROJ_PAD = 6912, NPROJ_TILES = 27;
constexpr float ALPHA_DN = 1.189207115002721f;
constexpr float LN_EPS = 1e-5f;
constexpr int SEG_Z = 0, SEG_XBC = 1024, SEG_DT = 2560, SEG_Q = 2576, SEG_K = 3600, SEG_V = 4624, SEG_QI = 5648, SEG_KI = 6672, SEG_WI = 6736;

constexpr size_t MiB = 1u << 20;
constexpr size_t WS_CTL = 0, CTL_ZERO_BYTES = 1 * MiB;
constexpr size_t WS_MODP = 1 * MiB;
constexpr size_t WS_MODF = 3 * MiB;
constexpr size_t WS_COSA = 4 * MiB, WS_SINA = 6 * MiB;
constexpr size_t WS_COSI = 8 * MiB, WS_SINI = 9 * MiB;
constexpr size_t WS_WR = 10 * MiB;
constexpr size_t WS_KIDX = 11 * MiB;
constexpr size_t WS_WIDX = 12 * MiB;
constexpr size_t WS_DT = 12 * MiB + 512 * 1024;
constexpr size_t WS_CS = 13 * MiB;
constexpr size_t WS_INV = 14 * MiB;
constexpr size_t WS_LTOK = 15 * MiB;
constexpr size_t WS_LW = 17 * MiB;
constexpr size_t WS_MASK = 19 * MiB;
constexpr size_t WS_U2 = 25 * MiB;
constexpr size_t WS_WGU = 57 * MiB;
constexpr size_t WS_WDN = 317 * MiB;
constexpr size_t WS_T = 447 * MiB;
constexpr size_t WS_HID = WS_T;
constexpr size_t WS_OUTS = WS_T + 88 * MiB;
constexpr size_t WS_WIN = WS_T;
constexpr size_t WS_WOUT = WS_T + 27 * MiB;
constexpr size_t WS_U1 = WS_T + 35 * MiB;
constexpr size_t WS_Z = WS_T + 67 * MiB;
constexpr size_t WS_XBC = WS_T + 83 * MiB;
constexpr size_t WS_Q = WS_T + 107 * MiB, WS_K = WS_T + 123 * MiB, WS_V = WS_T + 139 * MiB;
constexpr size_t WS_QIDX = WS_T + 155 * MiB;
constexpr size_t WS_SCORES = WS_T + 171 * MiB;
constexpr size_t WS_STATES = WS_T + 299 * MiB;
constexpr size_t WS_HIN = WS_T + 331 * MiB;
constexpr size_t WS_YDIAG = WS_T + 347 * MiB;
constexpr size_t WS_YCAT = WS_T + 379 * MiB;
constexpr size_t WS_XBCACT = WS_T + 411 * MiB;
constexpr size_t WS_END = WS_T + 440 * MiB;
static_assert(WS_XBCACT + 24 * MiB <= WS_END && WS_OUTS + 352 * MiB <= WS_END, "ws map");
constexpr int MAXPOS = 90112;
constexpr int CW_TMO = 0, CW_BAR = 4096, CW_ECNT = 8192;
constexpr int CW_QHEAD = 16384, CW_DONE = 16448;

constexpr int LDS_MISC = 155648;
constexpr int LDS_BYTES = 157696;

typedef __bf16 bf16x2_t __attribute__((ext_vector_type(2)));
__device__ __forceinline__ unsigned cvt_pk_bf16(float lo, float hi) { const bf16x2_t v = {(__bf16)lo, (__bf16)hi}; return __builtin_bit_cast(unsigned, v); }
__device__ __forceinline__ float bflo(unsigned w) { return __uint_as_float(w << 16); }
__device__ __forceinline__ float bfhi(unsigned w) { return __uint_as_float(w & 0xffff0000u); }
__device__ __forceinline__ float bf2f(bf16 b) { return __uint_as_float((unsigned)b << 16); }
__device__ __forceinline__ bf16 f2bf(float f) { return __builtin_bit_cast(unsigned short, (__bf16)f); }
__device__ __forceinline__ float silu_f(float x) { return x / (1.f + __expf(-x)); }
__device__ __forceinline__ float sigmoid_f(float x) { return 1.f / (1.f + __expf(-x)); }
__device__ __forceinline__ float wave_sum(float v) {
#pragma unroll
    for (int o = 1; o < 64; o <<= 1) v += __shfl_xor(v, o);
    return v;
}
__device__ __forceinline__ bf16x8 pack8(f32x4 a, f32x4 b) {
    u32x4 w = {cvt_pk_bf16(a[0], a[1]), cvt_pk_bf16(a[2], a[3]), cvt_pk_bf16(b[0], b[1]), cvt_pk_bf16(b[2], b[3])};
    return __builtin_bit_cast(bf16x8, w);
}
__device__ __forceinline__ void unpack8(bf16x8 v, float (&o)[8]) {
    u32x4 w = __builtin_bit_cast(u32x4, v);
#pragma unroll
    for (int i = 0; i < 4; ++i) { o[2 * i] = bflo(w[i]); o[2 * i + 1] = bfhi(w[i]); }
}
__device__ __forceinline__ int crow(int r, int hi) { return (r & 3) + 8 * (r >> 2) + 4 * hi; }
#define MK_N_LAUNCHES 1
#define PH_MASK 0x7ff
#define XB_TMO      128
#define XB_XCNT(j)  (256  + 64 * (j))
#define XB_XSUB(j)  (1280 + 64 * (j))
#define XB_XGEN(j)  (2304 + 64 * (j))
#define XB_TOP      3328
#define XB_TOPGEN   3392
#define XCD_BAR_WORDS 3456
#define XB_SPIN_CAP (1u << 18)

__device__ __forceinline__ unsigned xb_ld(unsigned* p)              { return __hip_atomic_load(p, __ATOMIC_RELAXED, __HIP_MEMORY_SCOPE_AGENT); }
__device__ __forceinline__ unsigned xb_add(unsigned* p, unsigned v) { return __hip_atomic_fetch_add(p, v, __ATOMIC_RELAXED, __HIP_MEMORY_SCOPE_AGENT); }
__device__ __forceinline__ unsigned xb_xcc_id() { return (unsigned)__builtin_amdgcn_s_getreg((3 << 11) | 20) & 0xFu; }
#define XB_SPIN(cond, bar) do { unsigned _sp = 0; while (cond) { __builtin_amdgcn_s_sleep(1); \
    if ((++_sp & 255u) == 0u) { if (xb_ld(&(bar)[XB_TMO])) break; if (_sp > XB_SPIN_CAP) { atomicAdd(&(bar)[XB_TMO], 1u); break; } } } } while (0)

struct XcdBarrier {
    unsigned* bar; unsigned x;
    volatile LAS unsigned* st;
};

__device__ __forceinline__ XcdBarrier xcd_barrier_post(unsigned* bar, volatile LAS unsigned* st) {
    XcdBarrier b; b.bar = bar; b.x = xb_xcc_id(); b.st = st;
    if (threadIdx.x == 0) (void)xb_add(&bar[XB_XCNT(b.x)], 1u);
    return b;
}
__device__ __forceinline__ void xcd_barrier_complete(unsigned* bar, unsigned x, unsigned& nloc, unsigned& nx) {
    const unsigned G = gridDim.x * gridDim.y * gridDim.z;
    unsigned sum, cnt, mine, sp = 0u;
    for (;;) {
        sum = 0u; cnt = 0u; mine = 0u;
#pragma unroll
        for (unsigned j = 0; j < 16; ++j) { const unsigned c = xb_ld(&bar[XB_XCNT(j)]); sum += c; cnt += (c > 0u) ? 1u : 0u; mine = (j == x) ? c : mine; }
        if (sum == G) break;
        __builtin_amdgcn_s_sleep(1);
        if ((++sp & 255u) == 0u) { if (xb_ld(&bar[XB_TMO])) break; if (sp > XB_SPIN_CAP) { atomicAdd(&bar[XB_TMO], 1u); break; } }
    }
    nloc = mine > 0u ? mine : 1u; nx = cnt > 0u ? cnt : 1u;
}

__device__ __forceinline__ void xcd_barrier(const XcdBarrier& b) {
    asm volatile("s_waitcnt vmcnt(0)" ::: "memory");
    __syncthreads();
    if (threadIdx.x == 0) {
        unsigned* bar = b.bar;
        __builtin_amdgcn_s_waitcnt(0);
        unsigned nloc = b.st[0], nx = b.st[1];
        if (nloc == 0u) { xcd_barrier_complete(bar, b.x, nloc, nx); b.st[0] = nloc; b.st[1] = nx; }
        const unsigned old = xb_add(&bar[XB_XSUB(b.x)], 1u);
        const unsigned gen = old / nloc;
        if (old + 1u == (gen + 1u) * nloc) {
            __builtin_amdgcn_fence(__ATOMIC_RELEASE, "agent");
            asm volatile("s_waitcnt vmcnt(0)" ::: "memory");
            const unsigned og = xb_add(&bar[XB_TOP], 1u);
            const unsigned tg = og / nx;
            if (og + 1u == (tg + 1u) * nx) xb_add(&bar[XB_TOPGEN], 1u);
            else XB_SPIN(xb_ld(&bar[XB_TOPGEN]) == tg, bar);
            __builtin_amdgcn_fence(__ATOMIC_ACQUIRE, "agent");
            xb_add(&bar[XB_XGEN(b.x)], 1u);
            asm volatile("s_waitcnt vmcnt(0)" ::: "memory");
        } else {
            XB_SPIN(xb_ld(&bar[XB_XGEN(b.x)]) == gen, bar);
            __builtin_amdgcn_fence(__ATOMIC_ACQUIRE, "agent");
            asm volatile("s_waitcnt vmcnt(0)" ::: "memory");
        }
    }
    __syncthreads();
}

namespace pg8 {
constexpr int BM = 256, BK = 64, HALF = 128, HTB = HALF * BK * 2  , STAGE_BYTES = 8 * HTB, NXCD = 8, WGM = 8;
__host__ __device__ __forceinline__ int lds_byte(int r, int c) { const int st = (r >> 4) * 2 + (c >> 5), rr = r & 15, cc = c & 31, ob = rr * 64 + cc * 2; return st * 1024 + (ob ^ (((ob >> 9) & 1) << 5)); }
__host__ __device__ __forceinline__ void stage_rc(int b, int& R, int& C) { const int st = b / 1024, sb = b % 1024, swz = sb ^ (((sb >> 9) & 1) << 5); R = (st >> 1) * 16 + swz / 64; C = (st & 1) * 32 + (swz % 64) / 2; }
__host__ __device__ __forceinline__ int perm32(int rho) { const int n = rho >> 4, i = rho & 15; return 8 * (i >> 2) + 4 * n + (i & 3); }

struct Unit { int pm, pn, ax; };
struct Gemm { const bf16* A; const bf16* Bt; int K; };

struct StaticOrder {
    int nM, nN, nwg, G, c;
    __device__ void init(int M, int N, int G_, int c_) { nM = M / BM; nN = N / BM; nwg = nM * nN; G = G_; c = c_; }
    __device__ __forceinline__ bool next(int i, Unit& u) const {
        const long L = (long)i * G + c; if (L >= nwg) return false;
        int wgid = (int)L; { const int q = nwg / NXCD, r = nwg % NXCD, xcd = wgid % NXCD, off = wgid / NXCD; wgid = (xcd < r ? xcd * (q + 1) : r * (q + 1) + (xcd - r) * q) + off; }
        const int nig = WGM * nN, gid = wgid / nig, fm = gid * WGM, gsz = (nM - fm) < WGM ? (nM - fm) : WGM;
        u.pm = fm + ((wgid % nig) % gsz); u.pn = (wgid % nig) / gsz; u.ax = 0; return true;
    }
    __device__ __forceinline__ int row_tok(const Unit&, int) const { return 0; }
};

template <class Epi, class Sched, bool GATHER>
__device__ __forceinline__ void gemm_phase(LAS unsigned char* lds, const Gemm g, const Sched& S, const Epi& E) {
    const int tid = threadIdx.x, wid = __builtin_amdgcn_readfirstlane(tid >> 6), lane = tid & 63, wr = wid >> 2, wc = wid & 3, fr = lane & 15, fq = lane >> 4;
    const int K = g.K, nt = K / BK;
    unsigned voffB[2]; int RA[2]; unsigned CA2[2];
#pragma unroll
    for (int i = 0; i < 2; ++i) { int R, C; stage_rc(tid * 16 + i * 8192, R, C); const int Rb = Epi::PERM ? ((R & ~31) + perm32(R & 31)) : R;
        voffB[i] = (unsigned)(Rb * K + C) * 2u; RA[i] = R; CA2[i] = (unsigned)C * 2u; }
    const size_t kstep = (size_t)(BK * 2);
    const size_t hstep = (size_t)HALF * K * 2;
    const size_t tstep = 2 * hstep;
    const unsigned ldsw = (unsigned)wid * 1024u;
    const int aoff = lds_byte(wr * 64 + fr, fq * 8), boff = lds_byte(wc * 32 + fr, fq * 8);
#define PG8_SA(b, h) (((b) * 2 + (h)) * HTB)
#define PG8_SB(b, h) ((4 + (b) * 2 + (h)) * HTB)
#define PG8_STAGE(bufoff, gbase, voff) do { _Pragma("unroll") for (int _i = 0; _i < 2; ++_i) \
        __builtin_amdgcn_global_load_lds((const unsigned*)((const char*)(gbase) + (voff)[_i]), (LAS unsigned*)(lds + (bufoff) + ldsw + _i * 8192), 16, 0, 0); } while (0)
#define PG8_LDA(dst, b, h) do { _Pragma("unroll") for (int m = 0; m < 4; ++m) _Pragma("unroll") for (int k = 0; k < 2; ++k) dst[m][k] = *(const LAS bf16x8*)(lds + PG8_SA(b, h) + aoff + m * 2048 + k * 1024); } while (0)
#define PG8_LDB(dst, b, h) do { _Pragma("unroll") for (int n = 0; n < 2; ++n) _Pragma("unroll") for (int k = 0; k < 2; ++k) dst[n][k] = *(const LAS bf16x8*)(lds + PG8_SB(b, h) + boff + n * 2048 + k * 1024); } while (0)
#define PG8_MMA(ai, bj, At, Bt) do { __builtin_amdgcn_s_setprio(1); _Pragma("unroll") for (int m = 0; m < 4; ++m) _Pragma("unroll") for (int n = 0; n < 2; ++n) _Pragma("unroll") for (int k = 0; k < 2; ++k) \
        acc[ai][bj][m][n] = __builtin_amdgcn_mfma_f32_16x16x32_bf16(Bt[n][k], At[m][k], acc[ai][bj][m][n], 0, 0, 0); __builtin_amdgcn_s_setprio(0); } while (0)
#define PG8_WAIT_V(n) asm volatile("s_waitcnt vmcnt(" #n ")" ::: "memory")
#define PG8_WAIT_L(n) asm volatile("s_waitcnt lgkmcnt(" #n ")" ::: "memory")
#define PG8_BAR __builtin_amdgcn_s_barrier()
#define PG8_SCHED __builtin_amdgcn_sched_barrier(0)
#define PG8_SET_OA(o, u) do { _Pragma("unroll") for (int _h = 0; _h < 2; ++_h) _Pragma("unroll") for (int _i = 0; _i < 2; ++_i) { \
        if constexpr (GATHER) o[_h][_i] = (unsigned)S.row_tok(u, _h * HALF + RA[_i]) * (unsigned)(K * 2) + CA2[_i]; \
        else o[_h][_i] = (unsigned)(_h * (int)hstep) + (unsigned)(RA[_i] * K * 2) + CA2[_i]; } } while (0)
    Unit cur, nxt; int ui = 0;
    if (!S.next(0, cur)) return;
    f32x4 acc[2][2][4][2];
#pragma unroll
    for (int a = 0; a < 2; ++a)
#pragma unroll
        for (int b = 0; b < 2; ++b)
#pragma unroll
            for (int m = 0; m < 4; ++m)
#pragma unroll
                for (int n = 0; n < 2; ++n) acc[a][b][m][n] = (f32x4){0.f, 0.f, 0.f, 0.f};
    bf16x8 At[4][2], B0[2][2], B1[2][2];
    unsigned oAc[2][2], oAn[2][2];
    PG8_SET_OA(oAc, cur);
    const char* cA = GATHER ? (const char*)g.A : (const char*)g.A + (size_t)cur.pm * tstep; const char* cB = (const char*)g.Bt + (size_t)cur.pn * tstep;
    PG8_STAGE(PG8_SB(0, 0), cB, voffB); PG8_STAGE(PG8_SB(0, 1), cB + hstep, voffB); PG8_STAGE(PG8_SA(0, 0), cA, oAc[0]); PG8_STAGE(PG8_SA(0, 1), cA, oAc[1]);
    if (wr == 1) PG8_BAR;
    PG8_WAIT_V(2); PG8_BAR;
    PG8_STAGE(PG8_SB(1, 0), cB + kstep, voffB); PG8_STAGE(PG8_SA(1, 0), cA + kstep, oAc[0]); PG8_STAGE(PG8_SB(1, 1), cB + hstep + kstep, voffB);
    PG8_WAIT_V(6); PG8_BAR;
    for (;;) {
        const bool has_next = S.next(ui + 1, nxt);
        const char* nA = has_next ? (GATHER ? (const char*)g.A : (const char*)g.A + (size_t)nxt.pm * tstep) : cA; const char* nB = has_next ? (const char*)g.Bt + (size_t)nxt.pn * tstep : cB;
        if (has_next) { PG8_SET_OA(oAn, nxt); }
        else {
#pragma unroll
            for (int _h = 0; _h < 2; ++_h)
#pragma unroll
                for (int _i = 0; _i < 2; ++_i) oAn[_h][_i] = oAc[_h][_i]; }
        for (int t = 0; t < nt; t += 2) {
            const bool last = (t == nt - 2);
            const char* a1 = cA + (size_t)(t + 1) * kstep;
            const char* a2 = last ? nA : cA + (size_t)(t + 2) * kstep; const char* b2 = last ? nB : cB + (size_t)(t + 2) * kstep;
            const char* a3 = a2 + kstep; const char* b3 = b2 + kstep;
            unsigned o2[2][2];
#pragma unroll
            for (int _h = 0; _h < 2; ++_h)
#pragma unroll
                for (int _i = 0; _i < 2; ++_i) o2[_h][_i] = GATHER ? (last ? oAn[_h][_i] : oAc[_h][_i]) : oAc[_h][_i];
            PG8_LDB(B0, 0, 0); PG8_LDB(B1, 0, 1); PG8_SCHED; PG8_LDA(At, 0, 0); PG8_STAGE(PG8_SA(1, 1), a1, oAc[1]);
            PG8_WAIT_V(8); PG8_WAIT_L(0); PG8_BAR; PG8_MMA(0, 0, At, B0); PG8_MMA(0, 1, At, B1); PG8_BAR; PG8_SCHED;
            PG8_LDA(At, 0, 1); PG8_STAGE(PG8_SB(0, 0), b2, voffB); PG8_STAGE(PG8_SB(0, 1), b2 + hstep, voffB); PG8_STAGE(PG8_SA(0, 0), a2, o2[0]);
            PG8_WAIT_V(8); PG8_WAIT_L(0); PG8_BAR; PG8_MMA(1, 0, At, B0); PG8_MMA(1, 1, At, B1); PG8_BAR; PG8_SCHED;
            PG8_LDB(B0, 1, 0); PG8_LDB(B1, 1, 1); PG8_SCHED; PG8_LDA(At, 1, 0); PG8_STAGE(PG8_SA(0, 1), a2, o2[1]);
            PG8_WAIT_V(8); PG8_WAIT_L(0); PG8_BAR; PG8_MMA(0, 0, At, B0); PG8_MMA(0, 1, At, B1); PG8_BAR; PG8_SCHED;
            PG8_LDA(At, 1, 1); PG8_STAGE(PG8_SB(1, 0), b3, voffB); PG8_STAGE(PG8_SB(1, 1), b3 + hstep, voffB); PG8_STAGE(PG8_SA(1, 0), a3, o2[0]);
            PG8_WAIT_V(8); PG8_WAIT_L(0); PG8_BAR; PG8_MMA(1, 0, At, B0); PG8_MMA(1, 1, At, B1); PG8_BAR; PG8_SCHED;
        }
        if (wr == 0) PG8_BAR;
        { int fr_ = fr, fq_ = fq, wr_ = wr, wc_ = wc; asm volatile("" : "+v"(fr_), "+v"(fq_), "+s"(wr_), "+s"(wc_));
          E(acc, cur, wr_, wc_, fr_, fq_); }
        if (!has_next) break;
#pragma unroll
        for (int a = 0; a < 2; ++a)
#pragma unroll
            for (int b = 0; b < 2; ++b)
#pragma unroll
                for (int m = 0; m < 4; ++m)
#pragma unroll
                    for (int n = 0; n < 2; ++n) acc[a][b][m][n] = (f32x4){0.f, 0.f, 0.f, 0.f};
        cur = nxt; cA = nA; cB = nB; ++ui;
#pragma unroll
        for (int _h = 0; _h < 2; ++_h)
#pragma unroll
            for (int _i = 0; _i < 2; ++_i) oAc[_h][_i] = oAn[_h][_i];
        if (wr == 1) PG8_BAR;
    }
    PG8_WAIT_V(0);
    PG8_BAR;
#undef PG8_SA
#undef PG8_SB
#undef PG8_STAGE
#undef PG8_LDA
#undef PG8_LDB
#undef PG8_MMA
#undef PG8_WAIT_V
#undef PG8_WAIT_L
#undef PG8_BAR
#undef PG8_SCHED
#undef PG8_SET_OA
}
}
struct Args { const void* in[27]; float* out; unsigned char* ws; int ph_lo, ph_hi; };
struct Frame {
    const Args* ap;
    __device__ __forceinline__ LAS unsigned char* lds() const { extern __shared__ __attribute__((aligned(16))) unsigned char lds_raw[]; return (LAS unsigned char*)lds_raw; }
    __device__ __forceinline__ unsigned char* ws() const { return ap->ws; }
    __device__ __forceinline__ gu32* ctl() const { return (gu32*)(ap->ws + WS_CTL); }
    __device__ __forceinline__ float* out() const { return ap->out; }
    __device__ __forceinline__ int tid() const { return (int)threadIdx.x; }
    __device__ __forceinline__ int lane() const { return (int)threadIdx.x & 63; }
    __device__ __forceinline__ int wave() const { return __builtin_amdgcn_readfirstlane((int)threadIdx.x >> 6); }
    __device__ __forceinline__ int G() const { return (int)gridDim.x; }
    __device__ __forceinline__ int bid() const { return (int)blockIdx.x; }
    __device__ __forceinline__ const CAS float* f(int i) const { return (const CAS float*)ap->in[i]; }
    __device__ __forceinline__ const CAS int* i32(int i) const { return (const CAS int*)ap->in[i]; }
};
#ifdef PROBE_SUB
#define PSUB(n, w) do { if ((n) == PROBE_SUB && blockIdx.x == 0 && threadIdx.x == 0) *(volatile LAS unsigned long long*)(F.lds() + LDS_MISC + 32 + 8 * (w)) = __builtin_amdgcn_s_memrealtime(); } while (0)
#else
#define PSUB(n, w) do { } while (0)
#endif
#define WSP(T, off) ((T*)(F.ws() + (off)))

__device__ __forceinline__ int inproj_src_col(int P) {
    const int tile = P >> 8, within = P & 255, bj = within >> 7, w = within & 127;
    if (tile < 4) return SEG_Z + tile * 256 + within;
    if (tile < 10) return SEG_XBC + (tile - 4) * 256 + within;
    if (tile < 14) return SEG_Q + (2 * (tile - 10) + (w >> 6)) * 128 + (w & 63) + 64 * bj;
    if (tile < 18) return SEG_K + (2 * (tile - 14) + (w >> 6)) * 128 + (w & 63) + 64 * bj;
    if (tile < 22) return SEG_V + (tile - 18) * 256 + within;
    if (tile < 26) return SEG_QI + (4 * (tile - 22) + (w >> 5)) * 64 + (w & 31) + 32 * bj;
    if (bj == 0) { if (w < 32) return SEG_KI + w; if (w < 48) return SEG_WI + (w - 32); if (w < 64) return SEG_DT + (w - 48); return -1; }
    if (w < 32) return SEG_KI + 32 + w;
    return -1;
}
__device__ __forceinline__ void tr64(const CAS float* qsrc, bool valid, int ld, bf16* dst0  , int K, LAS float* scr, int lane) {
    f32x4 v[16];
#pragma unroll
    for (int i = 0; i < 16; ++i) v[i] = valid ? *(const CAS f32x4*)(qsrc + (size_t)(4 * i) * ld) : (f32x4){0.f, 0.f, 0.f, 0.f};
#pragma unroll
    for (int i = 0; i < 16; ++i) { LAS float* s = scr + ((lane >> 4) + 4 * i) * 65 + 4 * (lane & 15); s[0] = v[i][0]; s[1] = v[i][1]; s[2] = v[i][2]; s[3] = v[i][3]; }
    LDS_WAIT(); asm volatile("" ::: "memory");
    const int c = lane & 7;
#pragma unroll
    for (int jj = 0; jj < 8; ++jj) { const int n = (lane >> 3) + 8 * jj; const LAS float* s = scr + (8 * c) * 65 + n;
        u32x4 o; o.x = cvt_pk_bf16(s[0], s[65]); o.y = cvt_pk_bf16(s[2 * 65], s[3 * 65]); o.z = cvt_pk_bf16(s[4 * 65], s[5 * 65]); o.w = cvt_pk_bf16(s[6 * 65], s[7 * 65]);
        *(u32x4*)(dst0 + (size_t)n * K + 8 * c) = o; }
    LDS_WAIT(); asm volatile("" ::: "memory");
}
constexpr int I_IN = 32 * 108, I_OUT = 32 * 32, I_GU = NEX * 32 * 16, I_DN = NEX * 8 * 32, I_TR = I_IN + I_OUT + I_GU + I_DN;
__device__ __forceinline__ void tr_item(Frame& F, int it, LAS float* scr) {
    const int lane = F.lane(), kr = lane >> 4, nq = 4 * (lane & 15);
    if (it < I_IN) { const int kb = it / 108, nb = it % 108, k0 = 64 * kb, n0 = 64 * nb; const int sc = inproj_src_col(n0 + nq);
        tr64(F.f(5) + (size_t)(k0 + kr) * NPROJ + (sc < 0 ? 0 : sc), sc >= 0, NPROJ, WSP(bf16, WS_WIN) + (size_t)n0 * DM + k0, DM, scr, lane); return; }
    it -= I_IN;
    if (it < I_OUT) { const int kb = it >> 5, nb = it & 31, k0 = 64 * kb, n0 = 64 * nb;
        tr64(F.f(14) + (size_t)(k0 + kr) * DM + n0 + nq, true, DM, WSP(bf16, WS_WOUT) + (size_t)n0 * DM + k0, DM, scr, lane); return; }
    it -= I_OUT;
    if (it < I_GU) { const int e = it >> 9, r = it & 511, kb = r >> 4, nb = r & 15, k0 = 64 * kb;
        const int p = nb >> 2, bj = (nb >> 1) & 1, w0 = (nb & 1) * 64;
        const CAS float* src = (e < NE) ? ((bj ? F.f(20) : F.f(19)) + (size_t)e * DM * DE) : (bj ? F.f(23) : F.f(22));
        tr64(src + (size_t)(k0 + kr) * DE + 128 * p + w0 + nq, true, DE, WSP(bf16, WS_WGU) + ((size_t)e * 1024 + 64 * nb) * DM + k0, DM, scr, lane); return; }
    it -= I_GU;
    { const int e = it >> 8, r = it & 255, kb = r >> 5, nb = r & 31, k0 = 64 * kb, n0 = 64 * nb;
        const CAS float* src = (e < NE) ? (F.f(21) + (size_t)e * DE * DM) : F.f(24);
        tr64(src + (size_t)(k0 + kr) * DM + n0 + nq, true, DM, WSP(bf16, WS_WDN) + ((size_t)e * DM + n0) * DE + k0, DE, scr, lane); }
}
__device__ __forceinline__ void p0_prologue(Frame& F) {
    const int gw = F.bid() * 8 + F.wave(), NGW = F.G() * 8, gt = F.bid() * 512 + F.tid(), NGT = F.G() * 512;
    {
        LAS float* red = (LAS float*)F.lds();
        float* modp = WSP(float, WS_MODP);
        for (int item = F.bid(); item < 48 * 16; item += F.G()) {
            const int cc = item % 48, ks = item / 48;
            f32x4 a0 = {0.f, 0.f, 0.f, 0.f}, a1 = {0.f, 0.f, 0.f, 0.f};
            const int kbase = ks * 128 + F.wave() * 16;
#pragma unroll 4
            for (int i = 0; i < 16; ++i) { const int k = kbase + i;
                const float c0 = silu_f(F.f(1)[k]), c1 = silu_f(F.f(1)[DM + k]);
                const f32x4 wv = *(const CAS f32x4*)(F.f(3) + (size_t)k * (6 * DM) + cc * 256 + F.lane() * 4);
                a0 += wv * c0; a1 += wv * c1; }
            *(LAS f32x4*)(red + (F.wave() * 2 + 0) * 256 + F.lane() * 4) = a0;
            *(LAS f32x4*)(red + (F.wave() * 2 + 1) * 256 + F.lane() * 4) = a1;
            __syncthreads();
            { const int b = F.tid() >> 8, col = F.tid() & 255; float s = 0.f;
#pragma unroll
              for (int w = 0; w < 8; ++w) s += red[(w * 2 + b) * 256 + col];
              modp[((size_t)ks * 2 + b) * (6 * DM) + cc * 256 + col] = s; }
            __syncthreads();
        }
    }
    {
        float* cosA = WSP(float, WS_COSA); float* sinA = WSP(float, WS_SINA); float* cosI = WSP(float, WS_COSI); float* sinI = WSP(float, WS_SINI);
        for (int i = gt; i < NTOK * 64; i += NGT) { const int tok = i >> 6, j = i & 63;
            const float inv = 1.0f / powf(10000.0f, (float)(2 * j) / 128.0f); const float ang = (float)F.i32(2)[tok] * inv;
            float s, c; sincosf(ang, &s, &c); cosA[i] = c; sinA[i] = s; }
        for (int i = gt; i < NTOK * 32; i += NGT) { const int tok = i >> 5, j = i & 31;
            const float inv = 1.0f / powf(10000.0f, (float)(2 * j) / 64.0f); const float ang = (float)F.i32(2)[tok] * inv;
            float s, c; sincosf(ang, &s, &c); cosI[i] = c; sinI[i] = s; }
    }
    {
        bf16* wr_hi = WSP(bf16, WS_WR); bf16* wr_lo = wr_hi + NE * DM;
        for (int i = gt; i < NE * (DM / 8); i += NGT) { const int e = i & 63, kc = i >> 6;
            float v[8], l[8];
#pragma unroll
            for (int j = 0; j < 8; ++j) { v[j] = F.f(17)[(size_t)(8 * kc + j) * NE + e]; l[j] = v[j] - bf2f(f2bf(v[j])); }
            u32x4 h = {cvt_pk_bf16(v[0], v[1]), cvt_pk_bf16(v[2], v[3]), cvt_pk_bf16(v[4], v[5]), cvt_pk_bf16(v[6], v[7])};
            u32x4 lo = {cvt_pk_bf16(l[0], l[1]), cvt_pk_bf16(l[2], l[3]), cvt_pk_bf16(l[4], l[5]), cvt_pk_bf16(l[6], l[7])};
            *(u32x4*)(wr_hi + (size_t)e * DM + 8 * kc) = h; *(u32x4*)(wr_lo + (size_t)e * DM + 8 * kc) = lo; }
    }
    {
        LAS float* scr = (LAS float*)(F.lds() + F.wave() * 16640);
        for (int it = gw; it < I_IN + I_OUT; it += NGW) tr_item(F, it, scr);
    }
}

constexpr int Q_GU = I_GU, Q_ALL = I_GU + I_DN, Q_GRAB = 16;
__device__ __forceinline__ void slack_fill(Frame& F, int budget, bool drain, int upto) {
    LAS float* scr = (LAS float*)(F.lds() + F.wave() * 16640);
    volatile LAS int* qw = (volatile LAS int*)(F.lds() + LDS_MISC + 16);
    __syncthreads();
    for (int gi = 0; drain || gi < budget; ++gi) {
        if (F.tid() == 0) { int stop = 0;
            const int idx = (int)__hip_atomic_fetch_add(F.ctl() + CW_QHEAD, (unsigned)Q_GRAB, RLX_AGENT); if (idx >= Q_ALL) stop = 1; else if (idx >= upto) stop = 2;
            qw[0] = stop; qw[1] = idx; }
        __syncthreads();
        const int stop = qw[0], idx = qw[1];
        __syncthreads();
        if (stop == 1) break;
#pragma unroll 1
        for (int i = 0; i < Q_GRAB / 8; ++i) { const int it = idx + i * 8 + F.wave(); if (it < Q_ALL) tr_item(F, I_IN + I_OUT + it, scr); }
        if (stop == 2) break;
    }
}

__device__ __forceinline__ void p1_modulate(Frame& F) {
    const float* modp = WSP(const float, WS_MODP); float* modf = WSP(float, WS_MODF); bf16* u1 = WSP(bf16, WS_U1);
    LAS float* sh = (LAS float*)F.lds(); LAS float* sc = sh + DM;
    for (int rg = F.bid(); rg < 256; rg += F.G()) {
        const int b = rg >> 7;
        if (F.tid() < 96) { const int v = rg * 96 + F.tid(); const int bb = v / (6 * DM), col = v % (6 * DM); float s = F.f(4)[col];
#pragma unroll
            for (int ks = 0; ks < 16; ++ks) s += modp[((size_t)ks * 2 + bb) * (6 * DM) + col];
            modf[v] = s; }
        { const int col = F.tid() * 4; f32x4 s0 = *(const CAS f32x4*)(F.f(4) + col), s1 = *(const CAS f32x4*)(F.f(4) + DM + col);
#pragma unroll
          for (int ks = 0; ks < 16; ++ks) { const float* p = modp + ((size_t)ks * 2 + b) * (6 * DM); s0 += *(const f32x4*)(p + col); s1 += *(const f32x4*)(p + DM + col); }
          *(LAS f32x4*)(sh + col) = s0; *(LAS f32x4*)(sc + col) = s1; }
        __syncthreads();
#pragma unroll
        for (int rr = 0; rr < 4; ++rr) { const int row = rg * 32 + F.wave() * 4 + rr;
#pragma unroll
            for (int j = 0; j < 8; ++j) { const int col = j * 256 + F.lane() * 4;
                const f32x4 xv = *(const CAS f32x4*)(F.f(0) + (size_t)row * DM + col); const f32x4 s0 = *(const LAS f32x4*)(sh + col), s1 = *(const LAS f32x4*)(sc + col);
                const f32x4 u = xv * (s1 + 1.0f) + s0;
                u32x2 o = {cvt_pk_bf16(u[0], u[1]), cvt_pk_bf16(u[2], u[3])};
                *(u32x2*)(u1 + (size_t)row * DM + col) = o; } }
        __syncthreads();
    }
}
struct EpiInProj {
    static constexpr bool PERM = true;
    unsigned char* ws; const CAS float *dt_bias, *lng, *lnb;
    __device__ __forceinline__ void operator()(const f32x4 (&acc)[2][2][4][2], const pg8::Unit& u, int wr, int wc, int fr, int fq) const {
        const int pn = u.pn; const int row0 = u.pm * 256 + wr * 64 + fr;
        if (pn < 10 || (pn >= 18 && pn < 22)) {
            size_t boff; int ld, col0;
            if (pn < 4) { boff = WS_Z; ld = 1024; col0 = pn * 256; } else if (pn < 10) { boff = WS_XBC; ld = CONV_CH; col0 = (pn - 4) * 256; } else { boff = WS_V; ld = 1024; col0 = (pn - 18) * 256; }
            bf16* base = (bf16*)(ws + boff);
            col0 += wc * 32 + 8 * fq;
#pragma unroll
            for (int ai = 0; ai < 2; ++ai)
#pragma unroll
                for (int m = 0; m < 4; ++m) { bf16* rowp = base + (size_t)(row0 + ai * 128 + m * 16) * ld + col0;
#pragma unroll
                    for (int bj = 0; bj < 2; ++bj) { const f32x4 v0 = acc[ai][bj][m][0], v1 = acc[ai][bj][m][1];
                        u32x4 w = {cvt_pk_bf16(v0[0], v0[1]), cvt_pk_bf16(v0[2], v0[3]), cvt_pk_bf16(v1[0], v1[1]), cvt_pk_bf16(v1[2], v1[3])};
                        *(u32x4*)(rowp + bj * 128) = w; } }
        } else if (pn < 26) {
            const bool att = pn < 18; const bool isq = pn < 14;
            bf16* base = (bf16*)(ws + (att ? (isq ? WS_Q : WS_K) : WS_QIDX)); const CAS float* ct = (const CAS float*)(ws + (att ? WS_COSA : WS_COSI)); const CAS float* sn = (const CAS float*)(ws + (att ? WS_SINA : WS_SINI));
            const int tw = att ? 64 : 32;
            const int head = att ? 2 * (pn - (isq ? 10 : 14)) + (wc >> 1) : 4 * (pn - 22) + wc, jj0 = att ? 32 * (wc & 1) + 8 * fq : 8 * fq;
#pragma unroll
            for (int ai = 0; ai < 2; ++ai)
#pragma unroll
                for (int m = 0; m < 4; ++m) { const int row = row0 + ai * 128 + m * 16;
                    bf16* rowp = base + (size_t)row * 1024 + head * (2 * tw) + jj0;
#pragma unroll
                    for (int n = 0; n < 2; ++n) { const f32x4 c = *(const CAS f32x4*)(ct + (size_t)row * tw + jj0 + 4 * n), sv = *(const CAS f32x4*)(sn + (size_t)row * tw + jj0 + 4 * n);
                        const f32x4 a = acc[ai][0][m][n], bb = acc[ai][1][m][n];
                        const f32x4 o1 = a * c - bb * sv, o2 = bb * c + a * sv;
                        *(u32x2*)(rowp + 4 * n) = (u32x2){cvt_pk_bf16(o1[0], o1[1]), cvt_pk_bf16(o1[2], o1[3])};
                        *(u32x2*)(rowp + tw + 4 * n) = (u32x2){cvt_pk_bf16(o2[0], o2[1]), cvt_pk_bf16(o2[2], o2[3])}; } }
        } else {
            const CAS float* cosI = (const CAS float*)(ws + WS_COSI); const CAS float* sinI = (const CAS float*)(ws + WS_SINI); bf16* kidx = (bf16*)(ws + WS_KIDX); float* widx = (float*)(ws + WS_WIDX); float* dt = (float*)(ws + WS_DT);
            if (wc == 0) {
                const int jj0 = 8 * fq;
#pragma unroll
                for (int am = 0; am < 8; ++am) { const int ai = am >> 2, m = am & 3; const int row = row0 + ai * 128 + m * 16;
                        f32x4 a0 = acc[ai][0][m][0], a1 = acc[ai][0][m][1], b0 = acc[ai][1][m][0], b1 = acc[ai][1][m][1];
                        float s = (a0[0] + a0[1] + a0[2] + a0[3]) + (a1[0] + a1[1] + a1[2] + a1[3]) + (b0[0] + b0[1] + b0[2] + b0[3]) + (b1[0] + b1[1] + b1[2] + b1[3]);
                        s += __shfl_xor(s, 16); s += __shfl_xor(s, 32);
                        const float mu = s * (1.0f / 64.0f);
                        a0 = a0 - mu; a1 = a1 - mu; b0 = b0 - mu; b1 = b1 - mu;
                        float qv = (a0[0] * a0[0] + a0[1] * a0[1] + a0[2] * a0[2] + a0[3] * a0[3]) + (a1[0] * a1[0] + a1[1] * a1[1] + a1[2] * a1[2] + a1[3] * a1[3])
                                 + (b0[0] * b0[0] + b0[1] * b0[1] + b0[2] * b0[2] + b0[3] * b0[3]) + (b1[0] * b1[0] + b1[1] * b1[1] + b1[2] * b1[2] + b1[3] * b1[3]);
                        qv += __shfl_xor(qv, 16); qv += __shfl_xor(qv, 32);
                        const float rstd = 1.0f / sqrtf(qv * (1.0f / 64.0f) + LN_EPS);
                        a0 = a0 * rstd * *(const CAS f32x4*)(lng + jj0) + *(const CAS f32x4*)(lnb + jj0); a1 = a1 * rstd * *(const CAS f32x4*)(lng + jj0 + 4) + *(const CAS f32x4*)(lnb + jj0 + 4);
                        b0 = b0 * rstd * *(const CAS f32x4*)(lng + 32 + jj0) + *(const CAS f32x4*)(lnb + 32 + jj0); b1 = b1 * rstd * *(const CAS f32x4*)(lng + 36 + jj0) + *(const CAS f32x4*)(lnb + 36 + jj0);
                        const f32x4 c0 = *(const CAS f32x4*)(cosI + (size_t)row * 32 + jj0), c1 = *(const CAS f32x4*)(cosI + (size_t)row * 32 + jj0 + 4);
                        const f32x4 s0 = *(const CAS f32x4*)(sinI + (size_t)row * 32 + jj0), s1 = *(const CAS f32x4*)(sinI + (size_t)row * 32 + jj0 + 4);
                        const f32x4 o10 = a0 * c0 - b0 * s0, o11 = a1 * c1 - b1 * s1, o20 = b0 * c0 + a0 * s0, o21 = b1 * c1 + a1 * s1;
                        bf16* rowp = kidx + (size_t)row * 64 + jj0;
                        u32x4 w1 = {cvt_pk_bf16(o10[0], o10[1]), cvt_pk_bf16(o10[2], o10[3]), cvt_pk_bf16(o11[0], o11[1]), cvt_pk_bf16(o11[2], o11[3])};
                        u32x4 w2 = {cvt_pk_bf16(o20[0], o20[1]), cvt_pk_bf16(o20[2], o20[3]), cvt_pk_bf16(o21[0], o21[1]), cvt_pk_bf16(o21[2], o21[3])};
                        *(u32x4*)rowp = w1; *(u32x4*)(rowp + 32) = w2; }
            } else if (wc == 1) {
                const int h0 = 8 * (fq & 1);
                const f32x4 db0 = *(const CAS f32x4*)(dt_bias + h0), db1 = *(const CAS f32x4*)(dt_bias + h0 + 4);
#pragma unroll
                for (int ai = 0; ai < 2; ++ai)
#pragma unroll
                    for (int m = 0; m < 4; ++m) { const int row = row0 + ai * 128 + m * 16;
                        const f32x4 a0 = acc[ai][0][m][0], a1 = acc[ai][0][m][1];
                        if (fq < 2) { *(f32x4*)(widx + (size_t)row * 16 + h0) = a0 * 0.03125f; *(f32x4*)(widx + (size_t)row * 16 + h0 + 4) = a1 * 0.03125f; }
                        else { f32x4 d0 = a0 + db0, d1 = a1 + db1;
#pragma unroll
                            for (int i = 0; i < 4; ++i) { d0[i] = d0[i] > 20.f ? d0[i] : log1pf(__expf(d0[i])); d1[i] = d1[i] > 20.f ? d1[i] : log1pf(__expf(d1[i])); }
                            *(f32x4*)(dt + (size_t)row * 16 + h0) = d0; *(f32x4*)(dt + (size_t)row * 16 + h0 + 4) = d1; } }
            }
        }
    }
};
constexpr int IX_QP = 2064;
constexpr int IX_ST = 32 * IX_QP;
constexpr int IX_WL = IX_ST + 8 * 8320;
__device__ __forceinline__ void idx_unit(Frame& F, int b, int s, int par) {
    const CAS bf16* kidx = (const CAS bf16*)(F.ws() + WS_KIDX); const CAS bf16* qidx = (const CAS bf16*)(F.ws() + WS_QIDX); const CAS float* widx = (const CAS float*)(F.ws() + WS_WIDX); float* scores = WSP(float, WS_SCORES);
    const int lane = F.lane(), r32 = lane & 31, hi = lane >> 5, w = F.wave(), tid = F.tid();
    LAS unsigned char* Ql = F.lds();
    { const CAS bf16* src = qidx + (size_t)(b * SEQ + s * 32) * 1024;
#pragma unroll
      for (int i = 0; i < 8; ++i) { const int c = tid + 512 * i, row = c >> 7, ch = c & 127;
          *(LAS bf16x8*)(Ql + row * IX_QP + ch * 16) = *(const CAS bf16x8*)(src + (size_t)row * 1024 + ch * 8); }
      if (tid < 128) { const f32x4 wv = *(const CAS f32x4*)(widx + (size_t)(b * SEQ + s * 32 + (tid >> 2)) * 16 + 4 * (tid & 3)); LAS float* wl = (LAS float*)(F.lds() + IX_WL) + (tid >> 2) * 17 + 4 * (tid & 3);
          wl[0] = wv[0]; wl[1] = wv[1]; wl[2] = wv[2]; wl[3] = wv[3]; } }
    __syncthreads();
    const int qpos = s * 32 + r32, nT = (s >> 2) + 1;
    const LAS float* wrow = (const LAS float*)(F.lds() + IX_WL) + r32 * 17;
    const LAS unsigned char* qrow = Ql + r32 * IX_QP + hi * 16;
    LAS float* st = (LAS float*)(F.lds() + IX_ST + w * 8320);
#pragma unroll 1
    for (int t = par + 2 * w; t < nT; t += 16) {
        const int kpos0 = t * 128;
        bf16x8 A[4][4];
#pragma unroll
        for (int kt = 0; kt < 4; ++kt)
#pragma unroll
            for (int ks = 0; ks < 4; ++ks) A[kt][ks] = *(const CAS bf16x8*)(kidx + (size_t)(b * SEQ + kpos0 + kt * 32 + r32) * 64 + ks * 16 + hi * 8);
        f32x16 o[4] = {};
#pragma unroll 1
        for (int h = 0; h < 16; ++h) { const float wh = wrow[h];
            bf16x8 Bq[4];
#pragma unroll
            for (int ks = 0; ks < 4; ++ks) Bq[ks] = *(const LAS bf16x8*)(qrow + h * 128 + ks * 32);
#pragma unroll
            for (int kt = 0; kt < 4; ++kt) { f32x16 a = {};
#pragma unroll
                for (int ks = 0; ks < 4; ++ks) a = __builtin_amdgcn_mfma_f32_32x32x16_bf16(A[kt][ks], Bq[ks], a, 0, 0, 0);
#pragma unroll
                for (int r = 0; r < 16; ++r) o[kt][r] += wh * fmaxf(a[r], 0.f); } }
        const float NEG = -__builtin_inff();
#pragma unroll
        for (int half = 0; half < 2; ++half) {
#pragma unroll
            for (int r = 0; r < 16; ++r) { const int kk = crow(r, hi);
                st[r32 * 65 + kk] = (kpos0 + half * 64 + kk > qpos) ? NEG : o[2 * half][r];
                st[r32 * 65 + 32 + kk] = (kpos0 + half * 64 + 32 + kk > qpos) ? NEG : o[2 * half + 1][r]; }
            LDS_WAIT(); asm volatile("" ::: "memory");
            float* dst = scores + (size_t)(b * SEQ + s * 32) * SEQ + kpos0 + half * 64 + lane;
#pragma unroll 4
            for (int q = 0; q < 32; ++q) { *dst = st[q * 65 + lane]; dst += SEQ; }
            LDS_WAIT(); asm volatile("" ::: "memory"); }
    }
    __syncthreads();
}

constexpr int SA_P = 136;
constexpr int SA_BN = 0, SA_CN = 34816, SA_BT = 69632, SA_CB = 104448, SA_SM = 139264;
__device__ __forceinline__ void conv8(const CAS bf16* xraw_row  , int tpos, const CAS float* cw, const CAS float* cb, float (&o)[8]) {
    bf16x8 xv[4];
#pragma unroll
    for (int k = 0; k < 4; ++k) { const int dt_ = k - 3; xv[k] = *(const CAS bf16x8*)(xraw_row + ((tpos + dt_ >= 0) ? (long)dt_ * CONV_CH : 0l)); }
    const f32x4 b0 = *(const CAS f32x4*)cb, b1 = *(const CAS f32x4*)(cb + 4);
#pragma unroll
    for (int j = 0; j < 4; ++j) { o[j] = b0[j]; o[4 + j] = b1[j]; }
#pragma unroll
    for (int k = 0; k < 4; ++k) { const float vm = (tpos + k - 3 >= 0) ? 1.f : 0.f; float xf[8]; unpack8(xv[k], xf);
        const f32x4 w0 = *(const CAS f32x4*)(cw + k * CONV_CH) * vm, w1 = *(const CAS f32x4*)(cw + k * CONV_CH + 4) * vm;
#pragma unroll
        for (int j = 0; j < 4; ++j) { o[j] += w0[j] * xf[j]; o[4 + j] += w1[j] * xf[4 + j]; } }
#pragma unroll
    for (int j = 0; j < 8; ++j) o[j] = silu_f(o[j]);
}
__device__ __forceinline__ void ssd_a_unit(Frame& F, int b, int c, int g, int hf) {
    const CAS bf16* xbc = (const CAS bf16*)(F.ws() + WS_XBC); bf16* xact = WSP(bf16, WS_XBCACT); const CAS float* dtg = (const CAS float*)(F.ws() + WS_DT); float* csg = WSP(float, WS_CS);
    float* ydiag = WSP(float, WS_YDIAG); float* states = WSP(float, WS_STATES);
    LAS bf16* Bn = (LAS bf16*)(F.lds() + SA_BN); LAS bf16* Cn = (LAS bf16*)(F.lds() + SA_CN); LAS bf16* BT = (LAS bf16*)(F.lds() + SA_BT); LAS bf16* CB = (LAS bf16*)(F.lds() + SA_CB);
    const int lane = F.lane(), r32 = lane & 31, hi = lane >> 5, w = F.wave();
    const int tok0 = b * SEQ + c * CHUNK;
#pragma unroll 4
    for (int i = 0; i < 8; ++i) { const int id = F.tid() + 512 * i, mi = id >> 11, rem = id & 2047, s = rem >> 4, ch = rem & 15;
        const int chan = 1024 + mi * 256 + g * 128 + ch * 8; float o[8];
        conv8(xbc + (size_t)(tok0 + s) * CONV_CH + chan, c * CHUNK + s, F.f(6) + chan, F.f(7) + chan, o);
        u32x4 pk = {cvt_pk_bf16(o[0], o[1]), cvt_pk_bf16(o[2], o[3]), cvt_pk_bf16(o[4], o[5]), cvt_pk_bf16(o[6], o[7])};
        if (mi == 0) { *(LAS u32x4*)(Bn + s * SA_P + ch * 8) = pk;
#pragma unroll
            for (int j = 0; j < 8; ++j) BT[(ch * 8 + j) * SA_P + s] = (bf16)((pk[j >> 1] >> (16 * (j & 1))) & 0xffffu); }
        else { *(LAS u32x4*)(Cn + s * SA_P + ch * 8) = pk; if (hf == 0) *(u32x4*)(xact + (size_t)(tok0 + s) * CONV_CH + chan) = pk; } }
    __syncthreads();
    { const int lt = w >> 1;
#pragma unroll
      for (int sq = 0; sq < 2; ++sq) { const int st = 2 * (w & 1) + sq; f32x16 a = {};
#pragma unroll
          for (int ks = 0; ks < 8; ++ks) { const bf16x8 av = *(const LAS bf16x8*)(Cn + (32 * lt + r32) * SA_P + 16 * ks + 8 * hi), bv = *(const LAS bf16x8*)(Bn + (32 * st + r32) * SA_P + 16 * ks + 8 * hi);
              a = __builtin_amdgcn_mfma_f32_32x32x16_bf16(av, bv, a, 0, 0, 0); }
#pragma unroll
          for (int r = 0; r < 16; ++r) CB[(32 * lt + crow(r, hi)) * SA_P + 32 * st + r32] = f2bf(a[r]); } }
    __syncthreads();
    const int j = w >> 1, sub = w & 1, h = 8 * g + 4 * hf + j;
    LAS bf16* XT = (LAS bf16*)(F.lds() + j * 17408);
    LAS float* cs_l = (LAS float*)(F.lds() + SA_SM) + j * 384; LAS float* wdec = cs_l + 128;
    {
        const float ah = -__expf(F.f(9)[h]);
        const float d0 = dtg[(size_t)(tok0 + lane) * 16 + h], d1 = dtg[(size_t)(tok0 + 64 + lane) * 16 + h];
        float c0 = d0 * ah, c1 = d1 * ah;
#pragma unroll
        for (int o = 1; o < 64; o <<= 1) { const float t0 = __shfl_up(c0, o), t1 = __shfl_up(c1, o); if (lane >= o) { c0 += t0; c1 += t1; } }
        const float tot0 = __shfl(c0, 63); c1 += tot0; const float cend = __shfl(c1, 63);
        if (sub == 0) { cs_l[lane] = c0; cs_l[64 + lane] = c1; wdec[lane] = __expf(cend - c0); wdec[64 + lane] = __expf(cend - c1);
            csg[(size_t)(tok0 + lane) * 16 + h] = c0; csg[(size_t)(tok0 + 64 + lane) * 16 + h] = c1; }
#pragma unroll 4
        for (int i = 0; i < 8; ++i) { const int id = lane + 64 * i, s = 64 * sub + (id >> 3), ch = id & 7, chan = h * 64 + ch * 8; float o[8];
            conv8(xbc + (size_t)(tok0 + s) * CONV_CH + chan, c * CHUNK + s, F.f(6) + chan, F.f(7) + chan, o);
            u32x4 pk = {cvt_pk_bf16(o[0], o[1]), cvt_pk_bf16(o[2], o[3]), cvt_pk_bf16(o[4], o[5]), cvt_pk_bf16(o[6], o[7])};
            *(u32x4*)(xact + (size_t)(tok0 + s) * CONV_CH + chan) = pk;
            const float dts = dtg[(size_t)(tok0 + s) * 16 + h];
#pragma unroll
            for (int jj = 0; jj < 8; ++jj) XT[(ch * 8 + jj) * SA_P + s] = f2bf(o[jj] * dts); }
    }
    __syncthreads();
#pragma unroll
    for (int lq = 0; lq < 2; ++lq) { const int lt = 2 * sub + lq; const int l = 32 * lt + r32; const float csl = cs_l[l];
        f32x16 a0 = {}, a1 = {};
        for (int ks = 0; ks <= 2 * lt + 1; ++ks) { const int s0 = 16 * ks + 8 * hi;
            float cbf[8]; unpack8(*(const LAS bf16x8*)(CB + l * SA_P + s0), cbf);
            const f32x4 q0 = *(const LAS f32x4*)(cs_l + s0), q1 = *(const LAS f32x4*)(cs_l + s0 + 4);
            float mv[8];
#pragma unroll
            for (int jj = 0; jj < 8; ++jj) { const float cq = jj < 4 ? q0[jj & 3] : q1[jj & 3]; mv[jj] = (s0 + jj <= l) ? cbf[jj] * __expf(csl - cq) : 0.f; }
            const bf16x8 av = pack8((f32x4){mv[0], mv[1], mv[2], mv[3]}, (f32x4){mv[4], mv[5], mv[6], mv[7]});
            const bf16x8 b0 = *(const LAS bf16x8*)(XT + r32 * SA_P + s0), b1 = *(const LAS bf16x8*)(XT + (32 + r32) * SA_P + s0);
            a0 = __builtin_amdgcn_mfma_f32_32x32x16_bf16(av, b0, a0, 0, 0, 0); a1 = __builtin_amdgcn_mfma_f32_32x32x16_bf16(av, b1, a1, 0, 0, 0); }
#pragma unroll
        for (int r = 0; r < 16; ++r) { float* yp = ydiag + (size_t)(tok0 + 32 * lt + crow(r, hi)) * D_SSM + h * 64 + r32; yp[0] = a0[r]; yp[32] = a1[r]; } }
    { f32x16 a[2][2] = {};
      for (int ks = 0; ks < 8; ++ks) { const int s0 = 16 * ks + 8 * hi;
          const f32x4 q0 = *(const LAS f32x4*)(wdec + s0), q1 = *(const LAS f32x4*)(wdec + s0 + 4);
          bf16x8 av[2];
#pragma unroll
          for (int pt = 0; pt < 2; ++pt) { float xf[8]; unpack8(*(const LAS bf16x8*)(XT + (32 * pt + r32) * SA_P + s0), xf);
              av[pt] = pack8((f32x4){xf[0] * q0[0], xf[1] * q0[1], xf[2] * q0[2], xf[3] * q0[3]}, (f32x4){xf[4] * q1[0], xf[5] * q1[1], xf[6] * q1[2], xf[7] * q1[3]}); }
#pragma unroll
          for (int nq = 0; nq < 2; ++nq) { const bf16x8 bv = *(const LAS bf16x8*)(BT + (32 * (2 * sub + nq) + r32) * SA_P + s0);
#pragma unroll
              for (int pt = 0; pt < 2; ++pt) a[pt][nq] = __builtin_amdgcn_mfma_f32_32x32x16_bf16(av[pt], bv, a[pt][nq], 0, 0, 0); } }
      float* sp = states + ((size_t)((b * NCHUNK + c) * SSM_H + h) * SSM_P) * SSM_N;
#pragma unroll
      for (int pt = 0; pt < 2; ++pt)
#pragma unroll
          for (int nq = 0; nq < 2; ++nq)
#pragma unroll
              for (int r = 0; r < 16; ++r) sp[(size_t)(32 * pt + crow(r, hi)) * SSM_N + 32 * (2 * sub + nq) + r32] = a[pt][nq][r]; }
    __syncthreads();
}
constexpr int N_SSD_A = NBATCH * NCHUNK * 2 * 2, N_IDX_U = 256;
__device__ __forceinline__ void p3_ssd(Frame& F) {
#pragma unroll 1
    for (int L = F.bid(); L < N_SSD_A; L += F.G()) { const int hf = L & 1, g = (L >> 1) & 1, c = (L >> 2) & 31, b = L >> 7; ssd_a_unit(F, b, c, g, hf); }
}
__device__ __forceinline__ void p3_idx(Frame& F) {
    int L = F.bid(); while (L < N_SSD_A) L += F.G();
#pragma unroll 1
    for (; L < N_SSD_A + N_IDX_U; L += F.G()) { const int p0 = L - N_SSD_A, b = p0 >> 7, par = p0 & 1, s = (p0 >> 1) & 63;
        idx_unit(F, b, 127 - s, par); idx_unit(F, b, s, par); }
}
__device__ __forceinline__ unsigned fkey(float f) { const unsigned u = __float_as_uint(f); return (u & 0x80000000u) ? ~u : (u | 0x80000000u); }
__device__ __forceinline__ void select_row(Frame& F, int row, LAS unsigned* hist, LAS unsigned* keys) {
    const float* sc = WSP(const float, WS_SCORES) + (size_t)row * SEQ; unsigned long long* mrow = WSP(unsigned long long, WS_MASK) + (size_t)row * 64;
    const int lane = F.lane(), t = row & (SEQ - 1);
    if (t < TOPK_SEL) {
        const int lo = 64 * lane; unsigned long long m;
        if (lo + 63 <= t) m = ~0ull; else if (lo > t) m = 0ull; else m = (1ull << (t - lo + 1)) - 1ull;
        mrow[lane] = m; return;
    }
    const int nI = (t >> 6) + 1;
#pragma unroll 8
    for (int i = 0; i < nI; ++i) { const int e = 64 * i + lane; float v = 0.f; if (e <= t) v = sc[e]; keys[e] = (e <= t) ? fkey(v) : 0u; }
    unsigned prefix = 0u, need = TOPK_SEL, pmask = 0u, cnt_eq = 0u;
#pragma unroll 1
    for (int pass = 0; pass < 4; ++pass) { const int shift = 24 - 8 * pass;
        hist[4 * lane] = 0u; hist[4 * lane + 1] = 0u; hist[4 * lane + 2] = 0u; hist[4 * lane + 3] = 0u;
        LDS_WAIT(); asm volatile("" ::: "memory");
#pragma unroll 4
        for (int i = 0; i < nI; ++i) { const unsigned k = keys[64 * i + lane]; if ((k & pmask) == prefix && k != 0u) __hip_atomic_fetch_add(hist + ((k >> shift) & 255u), 1u, __ATOMIC_RELAXED, __HIP_MEMORY_SCOPE_WORKGROUP); }
        LDS_WAIT(); asm volatile("" ::: "memory");
        const unsigned c0 = hist[4 * lane], c1 = hist[4 * lane + 1], c2 = hist[4 * lane + 2], c3 = hist[4 * lane + 3];
        const unsigned tot = c0 + c1 + c2 + c3;
        unsigned suf = tot;
#pragma unroll
        for (int o = 1; o < 64; o <<= 1) { const unsigned tt = __shfl_down(suf, o); if (lane + o < 64) suf += tt; }
        unsigned above = suf - tot;
        int found = -1; unsigned nneed = 0u, fcnt = 0u;
        if (above < need && need <= above + c3) { found = 3; nneed = need - above; fcnt = c3; }
        above += c3;
        if (found < 0 && above < need && need <= above + c2) { found = 2; nneed = need - above; fcnt = c2; }
        above += c2;
        if (found < 0 && above < need && need <= above + c1) { found = 1; nneed = need - above; fcnt = c1; }
        above += c1;
        if (found < 0 && above < need && need <= above + c0) { found = 0; nneed = need - above; fcnt = c0; }
        const unsigned long long bal = __ballot(found >= 0);
        const int src = (int)__builtin_ctzll(bal | (1ull << 63));
        const unsigned digit = (unsigned)__shfl(4 * lane + found, src);
        need = (unsigned)__shfl((int)nneed, src); cnt_eq = (unsigned)__shfl((int)fcnt, src);
        prefix |= digit << shift; pmask |= 255u << shift;
        LDS_WAIT(); asm volatile("" ::: "memory");
    }
    const bool all_eq = (cnt_eq == need);
    unsigned run = 0u; unsigned long long myword = 0ull;
    const unsigned long long lt_mask = (lane == 0) ? 0ull : (~0ull >> (64 - lane));
#pragma unroll 4
    for (int i = 0; i < nI; ++i) {
        const unsigned k = keys[64 * i + lane]; bool sel = k > prefix;
        if (all_eq) { sel = sel || (k == prefix); }
        else { const unsigned long long em = __ballot(k == prefix); if (k == prefix) sel = (run + (unsigned)__popcll(em & lt_mask)) < need; run += (unsigned)__popcll(em); }
        const unsigned long long wb = __ballot(sel);
        if (lane == i) myword = wb;
    }
    mrow[lane] = myword;
    LDS_WAIT(); asm volatile("" ::: "memory");
}
__device__ __forceinline__ void p4_select(Frame& F) {
    LAS unsigned* keys = (LAS unsigned*)(F.lds() + F.wave() * 16384); LAS unsigned* hist = (LAS unsigned*)(F.lds() + 131072 + F.wave() * 1024);
    const int gw = F.bid() * 8 + F.wave(), NGW = F.G() * 8;
    for (int pr = gw; pr < SEQ / 2; pr += NGW) {
#pragma unroll 1
        for (int b = 0; b < NBATCH; ++b) { select_row(F, b * SEQ + pr, hist, keys); select_row(F, b * SEQ + (SEQ - 1 - pr), hist, keys); }
    }
}
__device__ __forceinline__ void p4_scan(Frame& F) {
    const CAS float* states = (const CAS float*)(F.ws() + WS_STATES); bf16* hin = WSP(bf16, WS_HIN); const CAS float* csg = (const CAS float*)(F.ws() + WS_CS);
    const int gt = F.bid() * 512 + F.tid(), NGT = F.G() * 512;
    for (int q = gt; q < NBATCH * SSM_H * SSM_P * (SSM_N / 2); q += NGT) {
        const int n = 2 * (q & 63), p = (q >> 6) & 63, h = (q >> 12) & 15, b = q >> 16;
        float h0 = 0.f, h1 = 0.f;
#pragma unroll 8
        for (int c = 0; c < NCHUNK; ++c) {
            const size_t off = ((size_t)((b * NCHUNK + c) * SSM_H + h) * SSM_P + p) * SSM_N + n;
            *(unsigned*)(hin + off) = cvt_pk_bf16(h0, h1);
            const float dec = __expf(csg[(size_t)(b * SEQ + c * CHUNK + CHUNK - 1) * 16 + h]);
            const f32x2 st = *(const CAS f32x2*)(states + off);
            h0 = dec * h0 + st[0]; h1 = dec * h1 + st[1];
        }
    }
}
namespace att {
constexpr int KVBLK = 64, SHM_K = KVBLK * 128 * 2, SHM_V = SHM_K;
constexpr float SCALE = 0.08838834764831845f, THR = 8.f, C2 = 1.4426950408889634f * SCALE;
#define KSWZ(row, colB) ((row) * 256 + ((colB) ^ (((row) & 7) << 4)))
__device__ __forceinline__ int v_st(int k, int c) { const int kk = (k & ~0xC) | ((k & 4) << 1) | ((k & 8) >> 1); return ((kk >> 3) * 4 + (c >> 5)) * 512 + ((kk & 7) * 32 + (c & 31)) * 2; }
__device__ __forceinline__ int v_rd_base(int lane) { return ((lane & 3) << 3) | (((lane >> 2) & 3) << 6) | (((lane >> 4) & 1) << 5) | (((lane >> 5) & 1) << 8); }
constexpr int v_rd_off(int d0, int ks, int half) { return d0 * 512 + ks * 4096 + half * 2048; }
template <int KB>
__device__ __forceinline__ void qkt(f32x16& p0, f32x16& p1, LAS const char* K_lds, int r32, int hi, const bf16x8* qr) {
    p0 = f32x16{}; p1 = f32x16{};
    LAS const char* kb[4];
#pragma unroll
    for (int dd = 0; dd < 4; ++dd) kb[dd] = K_lds + KB * SHM_K + KSWZ(r32, (dd * 16 + hi * 8) * 2);
#pragma unroll
    for (int d0 = 0; d0 < 8; ++d0) { LAS const char* a = kb[d0 & 3] + (d0 >> 2) * 128;
        const bf16x8 b0 = *(LAS const bf16x8*)a;
        const bf16x8 b1 = *(LAS const bf16x8*)(a + 32 * 256);
        p0 = __builtin_amdgcn_mfma_f32_32x32x16_bf16(b0, qr[d0], p0, 0, 0, 0);
        p1 = __builtin_amdgcn_mfma_f32_32x32x16_bf16(b1, qr[d0], p1, 0, 0, 0); }
}
template <int VB>
__device__ __forceinline__ void pv_tile(f32x16* o, int vb0, bf16x8 pa0, bf16x8 pa1, bf16x8 pa2, bf16x8 pa3) {
#define TRRD(dst, off) asm volatile("ds_read_b64_tr_b16 %0, %1 offset:%2" : "=&v"(dst) : "v"(vb0), "i"(off) : "memory")
#define PV_D0(d0) do { s16x4 l0, l1, l2, l3, h0, h1, h2, h3; constexpr int b_ = VB * SHM_V + v_rd_off(d0, 0, 0); \
        TRRD(l0, b_); TRRD(h0, b_ + 2048); TRRD(l1, b_ + 4096); TRRD(h1, b_ + 6144); TRRD(l2, b_ + 8192); TRRD(h2, b_ + 10240); TRRD(l3, b_ + 12288); TRRD(h3, b_ + 14336); \
        asm volatile("s_waitcnt lgkmcnt(0)" ::: "memory"); __builtin_amdgcn_sched_barrier(0); \
        o[d0] = __builtin_amdgcn_mfma_f32_32x32x16_bf16(pa0, (bf16x8){l0[0], l0[1], l0[2], l0[3], h0[0], h0[1], h0[2], h0[3]}, o[d0], 0, 0, 0);   \
        o[d0] = __builtin_amdgcn_mfma_f32_32x32x16_bf16(pa1, (bf16x8){l1[0], l1[1], l1[2], l1[3], h1[0], h1[1], h1[2], h1[3]}, o[d0], 0, 0, 0);   \
        o[d0] = __builtin_amdgcn_mfma_f32_32x32x16_bf16(pa2, (bf16x8){l2[0], l2[1], l2[2], l2[3], h2[0], h2[1], h2[2], h2[3]}, o[d0], 0, 0, 0);   \
        o[d0] = __builtin_amdgcn_mfma_f32_32x32x16_bf16(pa3, (bf16x8){l3[0], l3[1], l3[2], l3[3], h3[0], h3[1], h3[2], h3[3]}, o[d0], 0, 0, 0); } while (0)
    PV_D0(0); PV_D0(1); PV_D0(2); PV_D0(3);
#undef PV_D0
#undef TRRD
}
__device__ __forceinline__ void softmax_tile(f32x16& p0, f32x16& p1, unsigned long long mw, int hi, float& m_reg, float& l_reg, float& alpha, bf16x8& pa0, bf16x8& pa1, bf16x8& pa2, bf16x8& pa3) {
    float pmax = p0[0];
#pragma unroll
    for (int r = 1; r < 16; ++r) pmax = fmaxf(pmax, p0[r]);
#pragma unroll
    for (int r = 0; r < 16; ++r) pmax = fmaxf(pmax, p1[r]);
    { auto rr = __builtin_amdgcn_permlane32_swap(__float_as_uint(pmax), __float_as_uint(pmax), false, false); pmax = fmaxf(__uint_as_float(rr[0]), __uint_as_float(rr[1])); }
    float mn;
    if (__all((pmax - m_reg) * SCALE <= THR)) { mn = m_reg; alpha = 1.f; }
    else { mn = fmaxf(m_reg, pmax); alpha = __builtin_amdgcn_exp2f((m_reg - mn) * C2); m_reg = mn; }
    const float mnL = -mn * C2;
    const int lo = (int)((unsigned)mw >> (4 * hi)), hh = (int)((unsigned)(mw >> 32) >> (4 * hi));
#pragma unroll
    for (int r = 0; r < 16; ++r) { const int c = (r & 3) + 8 * (r >> 2);
        const float e0 = __builtin_amdgcn_exp2f(fmaf(p0[r], C2, mnL)), e1 = __builtin_amdgcn_exp2f(fmaf(p1[r], C2, mnL));
        p0[r] = __uint_as_float(__float_as_uint(e0) & (unsigned)__builtin_amdgcn_sbfe(lo, c, 1));
        p1[r] = __uint_as_float(__float_as_uint(e1) & (unsigned)__builtin_amdgcn_sbfe(hh, c, 1)); }
    float ps = 0.f;
#pragma unroll
    for (int r = 0; r < 16; ++r) ps += p0[r];
#pragma unroll
    for (int r = 0; r < 16; ++r) ps += p1[r];
    { auto rr = __builtin_amdgcn_permlane32_swap(__float_as_uint(ps), __float_as_uint(ps), false, false); ps = __uint_as_float(rr[0]) + __uint_as_float(rr[1]); }
    l_reg = l_reg * alpha + ps;
#define PK4(P, B_, OUT) do { unsigned a0 = cvt_pk_bf16(P[B_+0], P[B_+1]), a1 = cvt_pk_bf16(P[B_+2], P[B_+3]); \
        unsigned b0 = cvt_pk_bf16(P[B_+4], P[B_+5]), b1 = cvt_pk_bf16(P[B_+6], P[B_+7]); \
        auto r0 = __builtin_amdgcn_permlane32_swap(a0, b0, false, false); auto r1 = __builtin_amdgcn_permlane32_swap(a1, b1, false, false); \
        u32x4 w = {r0[0], r1[0], r0[1], r1[1]}; OUT = __builtin_bit_cast(bf16x8, w); } while (0)
    PK4(p0, 0, pa0); PK4(p0, 8, pa1); PK4(p1, 0, pa2); PK4(p1, 8, pa3);
#undef PK4
}
}

__device__ __forceinline__ void attn_item(Frame& F, int b, int h, int X) {
    using namespace att;
    const bf16* qg = WSP(const bf16, WS_Q); const bf16* kg = WSP(const bf16, WS_K) + (size_t)(b * SEQ) * 1024 + h * 128; const bf16* vg = WSP(const bf16, WS_V) + (size_t)(b * SEQ) * 1024 + h * 128;
    const unsigned long long* maskg = WSP(const unsigned long long, WS_MASK); bf16* ycat = WSP(bf16, WS_YCAT);
    const int tid = F.tid(), wid = F.wave(), lane = F.lane(), r32 = lane & 31, hi = lane >> 5;
    LAS char* V_lds = (LAS char*)F.lds(); LAS char* K_lds = V_lds + 2 * SHM_V;
    LAS float* wsl = (LAS float*)(F.lds() + 2 * SHM_V + 2 * SHM_K) + wid * 64; LAS float* li_l = wsl; LAS float* al_l = wsl + 32;
    const int tokq = b * SEQ + X * 256 + wid * 32 + r32, NT = 4 * X + 4;
    bf16x8 qr[8];
#pragma unroll
    for (int d0 = 0; d0 < 8; ++d0) qr[d0] = *(const bf16x8*)(qg + (size_t)tokq * 1024 + h * 128 + d0 * 16 + hi * 8);
    const unsigned long long* mrow = maskg + (size_t)tokq * 64;
    const int sr = tid >> 4, sc = (tid & 15) * 8, vst0 = v_st(sr, sc), vst1 = v_st(32 + sr, sc), kws = KSWZ(sr, sc * 2);
    const int vb0 = (int)(unsigned)(uintptr_t)V_lds + v_rd_base(lane);
    float m_reg = -1e30f, l_reg = 0.f; f32x16 o[4] = {};
    bf16x8 st_k0, st_k1, st_v0, st_v1;
#define ALOAD(t) do { const size_t r0_ = (size_t)((t) * KVBLK + sr) * 1024 + sc; st_k0 = *(const bf16x8*)(kg + r0_); st_k1 = *(const bf16x8*)(kg + r0_ + 32 * 1024); \
                      st_v0 = *(const bf16x8*)(vg + r0_); st_v1 = *(const bf16x8*)(vg + r0_ + 32 * 1024); } while (0)
#define AWRITE(bf) do { *(LAS bf16x8*)(K_lds + (bf) * SHM_K + kws) = st_k0; *(LAS bf16x8*)(K_lds + (bf) * SHM_K + kws + 32 * 256) = st_k1; \
                        *(LAS bf16x8*)(V_lds + (bf) * SHM_V + vst0) = st_v0; *(LAS bf16x8*)(V_lds + (bf) * SHM_V + vst1) = st_v1; } while (0)
#define ASTEP(t, KB) do { AWRITE(KB); __syncthreads(); \
        const unsigned long long mw_ = mrow[(t)]; if ((t) + 1 < NT) ALOAD((t) + 1); \
        f32x16 p0, p1; float alpha; bf16x8 pa0, pa1, pa2, pa3; \
        qkt<KB>(p0, p1, K_lds, r32, hi, qr); \
        softmax_tile(p0, p1, mw_, hi, m_reg, l_reg, alpha, pa0, pa1, pa2, pa3); \
        if (__any(alpha < 1.f)) { if (hi == 0) al_l[r32] = alpha; LDS_WAIT(); \
            _Pragma("unroll") for (int d_ = 0; d_ < 4; ++d_) _Pragma("unroll") for (int r = 0; r < 16; ++r) o[d_][r] *= al_l[crow(r, hi)]; } \
        pv_tile<KB>(o, vb0, pa0, pa1, pa2, pa3); } while (0)
    ALOAD(0);
    for (int t = 0; t < NT; t += 2) { ASTEP(t, 0); ASTEP(t + 1, 1); }
#undef ASTEP
#undef AWRITE
#undef ALOAD
    if (hi == 0) li_l[r32] = l_reg; LDS_WAIT();
    float rli[16];
#pragma unroll
    for (int r = 0; r < 16; ++r) rli[r] = __builtin_amdgcn_rcpf(li_l[crow(r, hi)]);
    bf16* Ow = ycat + (size_t)(b * SEQ + X * 256 + wid * 32) * DM + D_SSM + h * 128;
#pragma unroll
    for (int r = 0; r < 16; ++r) { const int orow = crow(r, hi);
#pragma unroll
        for (int d0 = 0; d0 < 4; ++d0) { const float v = o[d0][r] * rli[r]; const float vn = __shfl_xor(v, 1);
            if ((r32 & 1) == 0) *(unsigned*)(Ow + (size_t)orow * DM + d0 * 32 + r32) = cvt_pk_bf16(v, vn); } }
    __syncthreads();
}

__device__ __forceinline__ void ssd_c_unit(Frame& F, int b, int c, int lq) {
    const bf16* xact = WSP(const bf16, WS_XBCACT); const bf16* hin = WSP(const bf16, WS_HIN); const float* csg = WSP(const float, WS_CS); const float* ydiag = WSP(const float, WS_YDIAG);
    const bf16* zg = WSP(const bf16, WS_Z); bf16* ycat = WSP(bf16, WS_YCAT);
    LAS float* gb = (LAS float*)F.lds();
    const int lane = F.lane(), r32 = lane & 31, hi = lane >> 5, w = F.wave(), g = w >> 2;
    const int tok0 = b * SEQ + c * CHUNK + lq * 32;
    bf16x8 Af[8];
#pragma unroll
    for (int ks = 0; ks < 8; ++ks) Af[ks] = *(const bf16x8*)(xact + (size_t)(tok0 + r32) * CONV_CH + 1280 + g * 128 + 16 * ks + 8 * hi);
#pragma unroll
    for (int hh = 0; hh < 2; ++hh) { const int h = 2 * w + hh;
        const bf16* hp = hin + ((size_t)((b * NCHUNK + c) * SSM_H + h) * SSM_P) * SSM_N;
        f32x16 a0 = {}, a1 = {};
#pragma unroll
        for (int ks = 0; ks < 8; ++ks) { const bf16x8 b0 = *(const bf16x8*)(hp + (size_t)r32 * SSM_N + 16 * ks + 8 * hi), b1 = *(const bf16x8*)(hp + (size_t)(32 + r32) * SSM_N + 16 * ks + 8 * hi);
            a0 = __builtin_amdgcn_mfma_f32_32x32x16_bf16(Af[ks], b0, a0, 0, 0, 0); a1 = __builtin_amdgcn_mfma_f32_32x32x16_bf16(Af[ks], b1, a1, 0, 0, 0); }
        const float dsk = F.f(10)[h];
#pragma unroll
        for (int r = 0; r < 16; ++r) { const int l = crow(r, hi); const size_t tok = (size_t)(tok0 + l);
            const float e = __expf(csg[tok * 16 + h]);
#pragma unroll
            for (int pt = 0; pt < 2; ++pt) { const int col = h * 64 + 32 * pt + r32;
                const float y = ydiag[tok * D_SSM + col] + e * (pt ? a1[r] : a0[r]) + dsk * bf2f(xact[tok * CONV_CH + col]);
                gb[l * 1024 + col] = y * silu_f(bf2f(zg[tok * 1024 + col])); } } }
    __syncthreads();
#pragma unroll
    for (int rr = 0; rr < 4; ++rr) { const int l = 4 * w + rr; float ss = 0.f; f32x4 v[4];
#pragma unroll
        for (int j = 0; j < 4; ++j) { v[j] = *(const LAS f32x4*)(gb + l * 1024 + j * 256 + lane * 4); ss += v[j][0] * v[j][0] + v[j][1] * v[j][1] + v[j][2] * v[j][2] + v[j][3] * v[j][3]; }
        const float rs = 1.0f / sqrtf(wave_sum(ss) * (1.0f / 1024.0f) + LN_EPS);
#pragma unroll
        for (int j = 0; j < 4; ++j) { const f32x4 nw = *(const CAS f32x4*)(F.f(11) + j * 256 + lane * 4); const f32x4 y = v[j] * rs * nw;
            u32x2 o = {cvt_pk_bf16(y[0], y[1]), cvt_pk_bf16(y[2], y[3])};
            *(u32x2*)(ycat + (size_t)(tok0 + l) * DM + j * 256 + lane * 4) = o; } }
    __syncthreads();
}
__device__ __forceinline__ void p5_phase(Frame& F) {
    for (int L = F.bid(); L < 256; L += F.G()) { const int lq = L & 3, c = (L >> 2) & 31, b = L >> 7; ssd_c_unit(F, b, c, lq); }
    for (int L = F.bid(); L < 256; L += F.G()) { const int X = 15 - (L >> 4), h = L & 7, b = (L >> 3) & 1; attn_item(F, b, h, X); }
}
struct EpiOutProj {
    static constexpr bool PERM = false;
    const CAS float* x; const CAS float* modf; float* out;
    __device__ __forceinline__ void operator()(const f32x4 (&acc)[2][2][4][2], const pg8::Unit& u, int wr, int wc, int fr, int fq) const {
        const int row0 = u.pm * 256 + wr * 64 + fr, col0 = u.pn * 256 + wc * 32 + 4 * fq; const int b = (u.pm * 256) / SEQ;
        f32x4 gv[2][2];
#pragma unroll
        for (int bj = 0; bj < 2; ++bj)
#pragma unroll
            for (int n = 0; n < 2; ++n) gv[bj][n] = *(const CAS f32x4*)(modf + (size_t)b * (6 * DM) + 2 * DM + col0 + bj * 128 + n * 16);
#pragma unroll
        for (int ai = 0; ai < 2; ++ai)
#pragma unroll
            for (int m = 0; m < 4; ++m) { const size_t off = (size_t)(row0 + ai * 128 + m * 16) * DM + col0;
#pragma unroll
                for (int bj = 0; bj < 2; ++bj)
#pragma unroll
                    for (int n = 0; n < 2; ++n) { const f32x4 xv = *(const CAS f32x4*)(x + off + bj * 128 + n * 16);
                        *(f32x4*)(out + off + bj * 128 + n * 16) = xv * ALPHA_DN + gv[bj][n] * acc[ai][bj][m][n]; } }
    }
};

constexpr int RT_P = 2056;
__device__ __forceinline__ void p7_unit(Frame& F, int un) {
    const CAS float* modf = (const CAS float*)(F.ws() + WS_MODF); bf16* u2 = WSP(bf16, WS_U2); const CAS bf16* wr_hi = (const CAS bf16*)(F.ws() + WS_WR); const CAS bf16* wr_lo = wr_hi + NE * DM;
    int* inv = WSP(int, WS_INV); int* ltok = WSP(int, WS_LTOK); float* lw = WSP(float, WS_LW);
    LAS bf16* Ah = (LAS bf16*)F.lds(); LAS bf16* Al = Ah + 16 * RT_P; LAS float* red = (LAS float*)F.lds();
    LAS float* logit = (LAS float*)(F.lds() + 135168);
    const int lane = F.lane(), w = F.wave(), row0 = un * 16, b = row0 / SEQ;
    const CAS float* sh2 = modf + (size_t)b * (6 * DM) + 3 * DM; const CAS float* sc2 = modf + (size_t)b * (6 * DM) + 4 * DM;
    PSUB(70, 0); PSUB(71, 0);
#pragma unroll 1
    for (int rr = 0; rr < 2; ++rr) { const int rl = 2 * w + rr; const size_t row = (size_t)(row0 + rl);
        f32x4 v[8]; float s = 0.f;
#pragma unroll
        for (int j = 0; j < 8; ++j) { v[j] = *(const f32x4*)(F.out() + row * DM + j * 256 + lane * 4); s += (v[j][0] + v[j][1]) + (v[j][2] + v[j][3]); }
        const float mu = wave_sum(s) * (1.0f / DM); float q = 0.f;
#pragma unroll
        for (int j = 0; j < 8; ++j) { v[j] = v[j] - mu; q += (v[j][0] * v[j][0] + v[j][1] * v[j][1]) + (v[j][2] * v[j][2] + v[j][3] * v[j][3]); }
        const float rstd = 1.0f / sqrtf(wave_sum(q) * (1.0f / DM) + LN_EPS);
#pragma unroll
        for (int j = 0; j < 8; ++j) { const int col = j * 256 + lane * 4;
            const f32x4 x1 = v[j] * rstd * *(const CAS f32x4*)(F.f(15) + col) + *(const CAS f32x4*)(F.f(16) + col);
            *(f32x4*)(F.out() + row * DM + col) = x1;
            const f32x4 uu = x1 * (*(const CAS f32x4*)(sc2 + col) + 1.0f) + *(const CAS f32x4*)(sh2 + col);
            const unsigned h0 = cvt_pk_bf16(uu[0], uu[1]), h1 = cvt_pk_bf16(uu[2], uu[3]);
            *(u32x2*)(u2 + row * DM + col) = (u32x2){h0, h1};
            const unsigned l0 = cvt_pk_bf16(uu[0] - bflo(h0), uu[1] - bfhi(h0)), l1 = cvt_pk_bf16(uu[2] - bflo(h1), uu[3] - bfhi(h1));
            *(LAS u32x2*)(Ah + rl * RT_P + col) = (u32x2){h0, h1}; *(LAS u32x2*)(Al + rl * RT_P + col) = (u32x2){l0, l1}; } }
    __syncthreads();
    PSUB(70, 1); PSUB(72, 0);
    f32x4 acc[4] = {};
    { const int fr = lane & 15, fq = lane >> 4;
      bf16x8 bhA[4], blA[4], bhB[4], blB[4];
#define RT_LOADB(dh, dl, ks_) do { const int k0_ = w * 256 + (ks_) * 32 + fq * 8; _Pragma("unroll") for (int nt = 0; nt < 4; ++nt) { \
          dh[nt] = *(const CAS bf16x8*)(wr_hi + (size_t)(16 * nt + fr) * DM + k0_); dl[nt] = *(const CAS bf16x8*)(wr_lo + (size_t)(16 * nt + fr) * DM + k0_); } } while (0)
#define RT_STEP(sh_, sl_, ks_) do { const int k0_ = w * 256 + (ks_) * 32 + fq * 8; \
          const bf16x8 ah = *(const LAS bf16x8*)(Ah + fr * RT_P + k0_), al = *(const LAS bf16x8*)(Al + fr * RT_P + k0_); \
          _Pragma("unroll") for (int nt = 0; nt < 4; ++nt) { acc[nt] = __builtin_amdgcn_mfma_f32_16x16x32_bf16(ah, sh_[nt], acc[nt], 0, 0, 0); \
              acc[nt] = __builtin_amdgcn_mfma_f32_16x16x32_bf16(al, sh_[nt], acc[nt], 0, 0, 0); acc[nt] = __builtin_amdgcn_mfma_f32_16x16x32_bf16(ah, sl_[nt], acc[nt], 0, 0, 0); } } while (0)
      RT_LOADB(bhA, blA, 0);
#pragma unroll
      for (int ks = 0; ks < 8; ks += 2) { RT_LOADB(bhB, blB, ks + 1); RT_STEP(bhA, blA, ks); if (ks + 2 < 8) RT_LOADB(bhA, blA, ks + 2); RT_STEP(bhB, blB, ks + 1); }
#undef RT_LOADB
#undef RT_STEP
      __syncthreads();
#pragma unroll
      for (int nt = 0; nt < 4; ++nt)
#pragma unroll
          for (int r = 0; r < 4; ++r) red[(w * 16 + fq * 4 + r) * 64 + 16 * nt + fr] = acc[nt][r]; }
    __syncthreads();
#pragma unroll
    for (int i = 0; i < 2; ++i) { const int o = F.tid() + 512 * i; float s = 0.f;
#pragma unroll
        for (int ww = 0; ww < 8; ++ww) s += red[ww * 1024 + o];
        logit[o] = s; }
    __syncthreads();
    PSUB(72, 1); PSUB(73, 0);
    float score_[2]; int erank_[2]; bool sel_[2];
#pragma unroll
    for (int rr = 0; rr < 2; ++rr) { const int rl = 2 * w + rr;
        const float score = sigmoid_f(logit[rl * 64 + lane]); const float biased = score + F.f(18)[lane];
        float m1 = biased;
#pragma unroll
        for (int o = 1; o < 8; o <<= 1) m1 = fmaxf(m1, __shfl_xor(m1, o));
        int i1 = (biased == m1) ? lane : 64;
#pragma unroll
        for (int o = 1; o < 8; o <<= 1) i1 = min(i1, __shfl_xor(i1, o));
        float m2 = (lane == i1) ? -__builtin_inff() : biased;
#pragma unroll
        for (int o = 1; o < 8; o <<= 1) m2 = fmaxf(m2, __shfl_xor(m2, o));
        const float gs = m1 + m2; const int grp = lane >> 3;
        int grank = 0;
#pragma unroll
        for (int g2 = 0; g2 < 8; ++g2) { const float og = __int_as_float(__builtin_amdgcn_readlane(__float_as_int(gs), 8 * g2)); grank += (og > gs || (og == gs && g2 < grp)) ? 1 : 0; }
        const float mk = (grank < 4) ? biased : -__builtin_inff();
        int erank = 0;
#pragma unroll 8
        for (int e2 = 0; e2 < 64; ++e2) { const float oe = __int_as_float(__builtin_amdgcn_readlane(__float_as_int(mk), e2)); erank += (oe > mk || (oe == mk && e2 < lane)) ? 1 : 0; }
        score_[rr] = score; erank_[rr] = erank; sel_[rr] = erank < 8; }
#pragma unroll
    for (int rr = 0; rr < 2; ++rr) { const int tok = row0 + 2 * w + rr;
        const float wsum = wave_sum(sel_[rr] ? score_[rr] : 0.f);
        if (sel_[rr]) { const float gw = score_[rr] / wsum * 2.5f;
            const int rk = (int)__hip_atomic_fetch_add(F.ctl() + CW_ECNT + 64 * lane, 1u, RLX_AGENT);
            ltok[lane * NTOK + rk] = tok; lw[lane * NTOK + rk] = gw; inv[tok * 8 + erank_[rr]] = lane * NTOK + rk; } }
    __syncthreads();
    PSUB(73, 1); PSUB(71, 1);
}
__device__ __forceinline__ void p7_phase(Frame& F) { for (int un = F.bid(); un < NTOK / 16; un += F.G()) p7_unit(F, un); }
struct MoeOrder {
    const LAS int* tab; const int* ltok; int G, c, npn;
    __device__ __forceinline__ bool next(int i, pg8::Unit& u) const {
        const int L = i * G + c; const int total = tab[80 + NEX] * npn; if (L >= total) return false;
        int e = 0;
        for (int k = 1; k < NEX; ++k) e += (tab[80 + k] * npn <= L) ? 1 : 0;
        const int nte = tab[80 + e + 1] - tab[80 + e], rem = L - tab[80 + e] * npn;
        const int mt = rem % nte, pn = rem / nte;
        u.pm = tab[80 + e] + mt; u.pn = e * npn + pn; u.ax = (e << 8) | mt; return true;
    }
    __device__ __forceinline__ int row_tok(const pg8::Unit& u, int r) const {
        const int e = u.ax >> 8, idx = (u.ax & 255) * 256 + r;
        if (e == NE) return idx;
        return idx < tab[e] ? ltok[e * NTOK + idx] : 0;
    }
};
__device__ __forceinline__ void moe_tables(Frame& F) {
    LAS int* tab = (LAS int*)(F.lds() + LDS_MISC + 64);
    if (F.tid() == 0) { int cum = 0;
        for (int e = 0; e < NE; ++e) { const int cn = (int)__hip_atomic_load(F.ctl() + CW_ECNT + 64 * e, RLX_AGENT); tab[e] = cn; tab[80 + e] = cum; cum += (cn + 255) >> 8; }
        tab[NE] = NTOK; tab[80 + NE] = cum; cum += NTOK / 256; tab[80 + NEX] = cum; }
    __syncthreads();
}
struct EpiGateUp {
    static constexpr bool PERM = true;
    bf16* hid; const CAS float* lw; const LAS int* tab;
    __device__ __forceinline__ void operator()(const f32x4 (&acc)[2][2][4][2], const pg8::Unit& u, int wr, int wc, int fr, int fq) const {
        const int e = u.ax >> 8, mt = u.ax & 255, pn = u.pn & 3; const int cnt = tab[e];
#pragma unroll
        for (int ai = 0; ai < 2; ++ai)
#pragma unroll
            for (int m = 0; m < 4; ++m) { const int rl = ai * 128 + wr * 64 + m * 16 + fr, idx = mt * 256 + rl;
                const float gw = (e == NE) ? 1.0f : (idx < cnt ? lw[e * NTOK + idx] : 0.0f);
                f32x4 h0, h1;
#pragma unroll
                for (int i = 0; i < 4; ++i) { h0[i] = silu_f(acc[ai][0][m][0][i]) * acc[ai][1][m][0][i] * gw; h1[i] = silu_f(acc[ai][0][m][1][i]) * acc[ai][1][m][1][i] * gw; }
                u32x4 w = {cvt_pk_bf16(h0[0], h0[1]), cvt_pk_bf16(h0[2], h0[3]), cvt_pk_bf16(h1[0], h1[1]), cvt_pk_bf16(h1[2], h1[3])};
                *(u32x4*)(hid + (size_t)(u.pm * 256 + rl) * DE + pn * 128 + wc * 32 + 8 * fq) = w; }
    }
};
struct EpiDown {
    static constexpr bool PERM = true;
    bf16* outs;
    __device__ __forceinline__ void operator()(const f32x4 (&acc)[2][2][4][2], const pg8::Unit& u, int wr, int wc, int fr, int fq) const {
        const int pn = u.pn & 7;
#pragma unroll
        for (int ai = 0; ai < 2; ++ai)
#pragma unroll
            for (int m = 0; m < 4; ++m) { bf16* rowp = outs + (size_t)(u.pm * 256 + ai * 128 + wr * 64 + m * 16 + fr) * DM + pn * 256 + wc * 32 + 8 * fq;
#pragma unroll
                for (int bj = 0; bj < 2; ++bj) { const f32x4 v0 = acc[ai][bj][m][0], v1 = acc[ai][bj][m][1];
                    u32x4 w = {cvt_pk_bf16(v0[0], v0[1]), cvt_pk_bf16(v0[2], v0[3]), cvt_pk_bf16(v1[0], v1[1]), cvt_pk_bf16(v1[2], v1[3])};
                    *(u32x4*)(rowp + bj * 128) = w; } }
    }
};
__device__ __forceinline__ void p10_final(Frame& F) {
    const CAS float* modf = (const CAS float*)(F.ws() + WS_MODF); const CAS bf16* outs = (const CAS bf16*)(F.ws() + WS_OUTS); const CAS int* inv = (const CAS int*)(F.ws() + WS_INV);
    const LAS int* tab = (const LAS int*)(F.lds() + LDS_MISC + 64);
    const int gw = F.bid() * 8 + F.wave(), NGW = F.G() * 8;
    for (int tok = gw; tok < NTOK; tok += NGW) { int lane = F.lane(); asm volatile("" : "+v"(lane)); const int b = tok / SEQ; const CAS float* g2 = modf + (size_t)b * (6 * DM) + 5 * DM;
        size_t rows[9];
#pragma unroll
        for (int k = 0; k < 8; ++k) { const int iv = inv[tok * 8 + k]; const int e = iv / NTOK, rk = iv % NTOK; rows[k] = (size_t)(tab[80 + e] * 256 + rk); }
        rows[8] = (size_t)(tab[80 + NE] * 256 + tok);
        f32x4 v[8]; float s = 0.f;
#pragma unroll
        for (int jj = 0; jj < 4; ++jj) { const int col = jj * 512 + lane * 8; f32x4 f0 = {0.f, 0.f, 0.f, 0.f}, f1 = {0.f, 0.f, 0.f, 0.f};
#pragma unroll
            for (int k = 0; k < 9; ++k) { const u32x4 w = *(const CAS u32x4*)(outs + rows[k] * DM + col);
                f0[0] += bflo(w[0]); f0[1] += bfhi(w[0]); f0[2] += bflo(w[1]); f0[3] += bfhi(w[1]); f1[0] += bflo(w[2]); f1[1] += bfhi(w[2]); f1[2] += bflo(w[3]); f1[3] += bfhi(w[3]); }
            const f32x4 xa = *(const f32x4*)(F.out() + (size_t)tok * DM + col), xb = *(const f32x4*)(F.out() + (size_t)tok * DM + col + 4);
            v[2 * jj] = xa * ALPHA_DN + *(const CAS f32x4*)(g2 + col) * f0; v[2 * jj + 1] = xb * ALPHA_DN + *(const CAS f32x4*)(g2 + col + 4) * f1;
            s += (v[2 * jj][0] + v[2 * jj][1]) + (v[2 * jj][2] + v[2 * jj][3]) + (v[2 * jj + 1][0] + v[2 * jj + 1][1]) + (v[2 * jj + 1][2] + v[2 * jj + 1][3]); }
        const float mu = wave_sum(s) * (1.0f / DM); float q = 0.f;
#pragma unroll
        for (int j = 0; j < 8; ++j) { v[j] = v[j] - mu; q += (v[j][0] * v[j][0] + v[j][1] * v[j][1]) + (v[j][2] * v[j][2] + v[j][3] * v[j][3]); }
        const float rstd = 1.0f / sqrtf(wave_sum(q) * (1.0f / DM) + LN_EPS);
#pragma unroll
        for (int j = 0; j < 8; ++j) { const int col = (j >> 1) * 512 + lane * 8 + (j & 1) * 4;
            *(f32x4*)(F.out() + (size_t)tok * DM + col) = v[j] * rstd * *(const CAS f32x4*)(F.f(25) + col) + *(const CAS f32x4*)(F.f(26) + col); } }
}
#ifndef MK_N_LAUNCHES
#define MK_N_LAUNCHES 1
#endif
constexpr int N_PHASES = 11;
__global__ void __launch_bounds__(512, 2) fwd_kernel(Args args) {
    Frame F; F.ap = &args;
    if (F.tid() < 16) ((LAS unsigned*)(F.lds() + LDS_MISC))[F.tid()] = 0u;
    __syncthreads();
    if (args.ph_hi - args.ph_lo > 1) (void)xcd_barrier_post((unsigned*)(F.ctl() + CW_BAR), (volatile LAS unsigned*)(F.lds() + LDS_MISC));
#ifndef PH_MASK
#define PH_MASK 0x7ff
#endif
#define IN(k) (((PH_MASK >> (k)) & 1) && args.ph_lo <= (k) && (k) < args.ph_hi)
#ifdef PROBE_PHASE
    unsigned long long pt0_ = __builtin_amdgcn_s_memrealtime(), pt1_ = 0ull;
#ifdef PROBE_SUB
#define PMARK(k) do { } while (0)
#else
#define PMARK(k) do { if ((k) + 1 == PROBE_PHASE) pt0_ = __builtin_amdgcn_s_memrealtime(); if ((k) == PROBE_PHASE) pt1_ = __builtin_amdgcn_s_memrealtime(); } while (0)
#endif
#else
#define PMARK(k) do { } while (0)
#endif
#define SEAM(k) do { if (IN(k) && IN((k) + 1)) { XcdBarrier bar_; bar_.bar = (unsigned*)(F.ctl() + CW_BAR); bar_.x = xb_xcc_id(); bar_.st = (volatile LAS unsigned*)(F.lds() + LDS_MISC); xcd_barrier(bar_); } } while (0)
    if (IN(0)) { p0_prologue(F); } SEAM(0); PMARK(0);
    if (IN(1)) { p1_modulate(F); } SEAM(1); PMARK(1);
    if (IN(2)) {
        pg8::Gemm g{WSP(const bf16, WS_U1), WSP(const bf16, WS_WIN), DM}; pg8::StaticOrder S; S.init(NTOK, NPROJ_PAD, F.G(), F.bid());
        EpiInProj E{F.ws(), F.f(8), F.f(12), F.f(13)};
        pg8::gemm_phase<EpiInProj, pg8::StaticOrder, false>(F.lds(), g, S, E);
        slack_fill(F, (F.bid() + 3 * F.G() < 32 * NPROJ_TILES) ? 0 : 8, false, Q_ALL);
    } SEAM(2); PMARK(2);
    if (IN(3)) {
        PSUB(3, 0); p3_ssd(F); PSUB(3, 1); p3_idx(F);
    } SEAM(3); PMARK(3);
    if (IN(4)) { p4_select(F); p4_scan(F); } SEAM(4); PMARK(4);
    if (IN(5)) { p5_phase(F); slack_fill(F, (F.G() == 256) ? ((F.bid() >> 4) * 3) / 2 : 0, false, Q_ALL); } SEAM(5); PMARK(5);
    if (IN(6)) {
        pg8::Gemm g{WSP(const bf16, WS_YCAT), WSP(const bf16, WS_WOUT), DM}; pg8::StaticOrder S; S.init(NTOK, DM, F.G(), F.bid());
        EpiOutProj E{F.f(0), (const CAS float*)(F.ws() + WS_MODF), F.out()};
        pg8::gemm_phase<EpiOutProj, pg8::StaticOrder, false>(F.lds(), g, S, E);
    } SEAM(6); PMARK(6);
    if (IN(7)) { p7_phase(F); slack_fill(F, 0, true, Q_GU); } SEAM(7); PMARK(7);
    if (IN(8)) {
        const int vcu = (F.G() % 8 == 0) ? (F.bid() % 8) * (F.G() / 8) + F.bid() / 8 : F.bid();
        moe_tables(F);
        const LAS int* tab = (const LAS int*)(F.lds() + LDS_MISC + 64);
        pg8::Gemm g{WSP(const bf16, WS_U2), WSP(const bf16, WS_WGU), DM}; MoeOrder S{tab, WSP(const int, WS_LTOK), F.G(), vcu, 4};
        EpiGateUp E{WSP(bf16, WS_HID), (const CAS float*)(F.ws() + WS_LW), tab};
        pg8::gemm_phase<EpiGateUp, MoeOrder, true>(F.lds(), g, S, E);
        slack_fill(F, 0, true, Q_ALL);
    } SEAM(8); PMARK(8);
    if (IN(9)) {
        const int vcu = (F.G() % 8 == 0) ? (F.bid() % 8) * (F.G() / 8) + F.bid() / 8 : F.bid();
        moe_tables(F);
        const LAS int* tab = (const LAS int*)(F.lds() + LDS_MISC + 64);
        pg8::Gemm g{WSP(const bf16, WS_HID), WSP(const bf16, WS_WDN), DE}; MoeOrder S{tab, WSP(const int, WS_LTOK), F.G(), vcu, 8};
        EpiDown E{WSP(bf16, WS_OUTS)};
        pg8::gemm_phase<EpiDown, MoeOrder, false>(F.lds(), g, S, E);
    } SEAM(9); PMARK(9);
    if (IN(10)) { moe_tables(F); p10_final(F); }
#ifdef PROBE_PHASE
    if (pt1_ == 0ull) pt1_ = __builtin_amdgcn_s_memrealtime();
#ifdef PROBE_SUB
    __syncthreads(); pt0_ = *(volatile LAS unsigned long long*)(F.lds() + LDS_MISC + 32); pt1_ = *(volatile LAS unsigned long long*)(F.lds() + LDS_MISC + 40);
#endif
    if (F.bid() == 0) { const unsigned long long w = 8ull * (pt1_ - pt0_), te = __builtin_amdgcn_s_memrealtime(); while (__builtin_amdgcn_s_memrealtime() - te < w) __builtin_amdgcn_s_sleep(32); }
#endif
#ifdef DBG_OFF
    if (args.ph_hi == N_PHASES) {
        const size_t n = (size_t)NTOK * DM; float* o = F.out();
        for (size_t i = (size_t)F.bid() * 512 + F.tid(); i < n; i += (size_t)F.G() * 512) {
            float v;
            if (DBG_KIND == 0) v = bf2f(((const bf16*)(F.ws() + (size_t)(DBG_OFF)))[i % (size_t)(DBG_N)]);
            else v = ((const float*)(F.ws() + (size_t)(DBG_OFF)))[i % (size_t)(DBG_N)];
            if (!(fabsf(v) < 1e30f)) v = 1e30f;
            o[i] = v; }
    }
#endif
#undef IN
#undef SEAM
#undef PMARK
}

extern "C" void kernel_launch(void* const* d_in, const int* in_sizes, int n_in, void* d_out, int out_size, void* d_ws, size_t ws_size, hipStream_t stream) {
    static int grid = 0;
    if (grid == 0) {
        if (n_in != 27 || out_size != NTOK * DM || ws_size < WS_END) { fprintf(stderr, "kernel_launch: unexpected shapes (n_in %d, out %d, ws %zu; need ws >= %zu)\n", n_in, out_size, ws_size, (size_t)WS_END); }
        int dev = 0, cus = 0, per_cu = 0;
        if (hipGetDevice(&dev) != hipSuccess || hipDeviceGetAttribute(&cus, hipDeviceAttributeMultiprocessorCount, dev) != hipSuccess) { grid = -1; return; }
        if (hipFuncSetAttribute((const void*)fwd_kernel, hipFuncAttributeMaxDynamicSharedMemorySize, LDS_BYTES) != hipSuccess) { fprintf(stderr, "kernel_launch: hipFuncSetAttribute failed\n"); grid = -1; return; }
        if (hipOccupancyMaxActiveBlocksPerMultiprocessor(&per_cu, (const void*)fwd_kernel, 512, LDS_BYTES) != hipSuccess || per_cu < 1) fprintf(stderr, "kernel_launch: occupancy query reports %d\n", per_cu);
        (void)hipGetLastError();
        grid = cus;
    }
    if (grid < 0) return;
    (void)hipMemsetAsync((char*)d_ws + WS_CTL, 0, CTL_ZERO_BYTES, stream);
    Args a{};
    for (int i = 0; i < 27; ++i) a.in[i] = d_in[i];
    a.out = (float*)d_out; a.ws = (unsigned char*)d_ws;
#if MK_N_LAUNCHES == 1
    a.ph_lo = 0; a.ph_hi = N_PHASES;
    hipLaunchKernelGGL(fwd_kernel, dim3(grid), dim3(512), LDS_BYTES, stream, a);
#else
    for (int p = 0; p < N_PHASES; ++p) { a.ph_lo = p; a.ph_hi = p + 1; hipLaunchKernelGGL(fwd_kernel, dim3(grid), dim3(512), LDS_BYTES, stream, a);
#ifdef DUP_PHASE
        if (p == DUP_PHASE) hipLaunchKernelGGL(fwd_kernel, dim3(grid), dim3(512), LDS_BYTES, stream, a);
#endif
    }
#endif
}
```

```cpp
#define MK_N_LAUNCHES 1
#define PH_MASK 0x7ff
#include <hip/hip_runtime.h>
#include <cstdio>
#include <cstdint>

#define GAS __attribute__((address_space(1)))
#define LAS __attribute__((address_space(3)))
#define CAS __attribute__((address_space(4)))
typedef unsigned short bf16;
typedef short bf16x8 __attribute__((ext_vector_type(8)));
typedef short s16x4 __attribute__((ext_vector_type(4)));
typedef float f32x2 __attribute__((ext_vector_type(2)));
typedef float f32x4 __attribute__((ext_vector_type(4)));
typedef float f32x16 __attribute__((ext_vector_type(16)));
typedef unsigned u32x2 __attribute__((ext_vector_type(2)));
typedef unsigned u32x4 __attribute__((ext_vector_type(4)));
typedef GAS unsigned gu32;
#define RLX_AGENT __ATOMIC_RELAXED, __HIP_MEMORY_SCOPE_AGENT
#define LDS_WAIT() asm volatile("s_waitcnt lgkmcnt(0)" ::: "memory")
#define VM_WAIT() asm volatile("s_waitcnt vmcnt(0)" ::: "memory")

constexpr int DM = 2048, NBATCH = 2, SEQ = 4096, NTOK = NBATCH * SEQ;
constexpr int D_SSM = 1024, SSM_H = 16, SSM_P = 64, SSM_N = 128, CONV_CH = 1536, CHUNK = 128, NCHUNK = SEQ / CHUNK;
constexpr int ATT_H = 8, ATT_D = 128, IDX_H = 16, IDX_D = 64, TOPK_SEL = 256;
constexpr int NE = 64, DE = 512, NEX = NE + 1;
constexpr int NPROJ = 6752, NPROJ_PAD = 6912, NPROJ_TILES = 27;
constexpr float ALPHA_DN = 1.189207115002721f;
constexpr float LN_EPS = 1e-5f;
constexpr int SEG_Z = 0, SEG_XBC = 1024, SEG_DT = 2560, SEG_Q = 2576, SEG_K = 3600, SEG_V = 4624, SEG_QI = 5648, SEG_KI = 6672, SEG_WI = 6736;

constexpr size_t MiB = 1u << 20;
constexpr size_t WS_CTL = 0, CTL_ZERO_BYTES = 1 * MiB;
constexpr size_t WS_MODP = 1 * MiB;
constexpr size_t WS_MODF = 3 * MiB;
constexpr size_t WS_COSA = 4 * MiB, WS_SINA = 6 * MiB;
constexpr size_t WS_COSI = 8 * MiB, WS_SINI = 9 * MiB;
constexpr size_t WS_WR = 10 * MiB;
constexpr size_t WS_KIDX = 11 * MiB;
constexpr size_t WS_WIDX = 12 * MiB;
constexpr size_t WS_DT = 12 * MiB + 512 * 1024;
constexpr size_t WS_CS = 13 * MiB;
constexpr size_t WS_INV = 14 * MiB;
constexpr size_t WS_LTOK = 15 * MiB;
constexpr size_t WS_LW = 17 * MiB;
constexpr size_t WS_MASK = 19 * MiB;
constexpr size_t WS_U2 = 25 * MiB;
constexpr size_t WS_WGU = 57 * MiB;
constexpr size_t WS_WDN = 317 * MiB;
constexpr size_t WS_T = 447 * MiB;
constexpr size_t WS_HID = WS_T;
constexpr size_t WS_OUTS = WS_T + 88 * MiB;
constexpr size_t WS_WIN = WS_T;
constexpr size_t WS_WOUT = WS_T + 27 * MiB;
constexpr size_t WS_U1 = WS_T + 35 * MiB;
constexpr size_t WS_Z = WS_T + 67 * MiB;
constexpr size_t WS_XBC = WS_T + 83 * MiB;
constexpr size_t WS_Q = WS_T + 107 * MiB, WS_K = WS_T + 123 * MiB, WS_V = WS_T + 139 * MiB;
constexpr size_t WS_QIDX = WS_T + 155 * MiB;
constexpr size_t WS_SCORES = WS_T + 171 * MiB;
constexpr size_t WS_STATES = WS_T + 299 * MiB;
constexpr size_t WS_HIN = WS_T + 331 * MiB;
constexpr size_t WS_YDIAG = WS_T + 347 * MiB;
constexpr size_t WS_YCAT = WS_T + 379 * MiB;
constexpr size_t WS_XBCACT = WS_T + 411 * MiB;
constexpr size_t WS_END = WS_T + 440 * MiB;
static_assert(WS_XBCACT + 24 * MiB <= WS_END && WS_OUTS + 352 * MiB <= WS_END, "ws map");
constexpr int MAXPOS = 90112;
constexpr int CW_TMO = 0, CW_BAR = 4096, CW_ECNT = 8192;
constexpr int CW_QHEAD = 16384, CW_DONE = 16448;

constexpr int LDS_MISC = 155648;
constexpr int LDS_BYTES = 157696;

typedef __bf16 bf16x2_t __attribute__((ext_vector_type(2)));
__device__ __forceinline__ unsigned cvt_pk_bf16(float lo, float hi) { const bf16x2_t v = {(__bf16)lo, (__bf16)hi}; return __builtin_bit_cast(unsigned, v); }
__device__ __forceinline__ float bflo(unsigned w) { return __uint_as_float(w << 16); }
__device__ __forceinline__ float bfhi(unsigned w) { return __uint_as_float(w & 0xffff0000u); }
__device__ __forceinline__ float bf2f(bf16 b) { return __uint_as_float((unsigned)b << 16); }
__device__ __forceinline__ bf16 f2bf(float f) { return __builtin_bit_cast(unsigned short, (__bf16)f); }
__device__ __forceinline__ float silu_f(float x) { return x / (1.f + __expf(-x)); }
__device__ __forceinline__ float sigmoid_f(float x) { return 1.f / (1.f + __expf(-x)); }
__device__ __forceinline__ float wave_sum(float v) {
#pragma unroll
    for (int o = 1; o < 64; o <<= 1) v += __shfl_xor(v, o);
    return v;
}
__device__ __forceinline__ bf16x8 pack8(f32x4 a, f32x4 b) {
    u32x4 w = {cvt_pk_bf16(a[0], a[1]), cvt_pk_bf16(a[2], a[3]), cvt_pk_bf16(b[0], b[1]), cvt_pk_bf16(b[2], b[3])};
    return __builtin_bit_cast(bf16x8, w);
}
__device__ __forceinline__ void unpack8(bf16x8 v, float (&o)[8]) {
    u32x4 w = __builtin_bit_cast(u32x4, v);
#pragma unroll
    for (int i = 0; i < 4; ++i) { o[2 * i] = bflo(w[i]); o[2 * i + 1] = bfhi(w[i]); }
}
__device__ __forceinline__ int crow(int r, int hi) { return (r & 3) + 8 * (r >> 2) + 4 * hi; }

__device__ __forceinline__ LAS unsigned char* lds_base() { extern __shared__ __attribute__((aligned(16))) unsigned char lds_raw[]; return (LAS unsigned char*)lds_raw; }
#ifdef PROBE_SUB
#define PSUB(n, w) do { if ((n) == PROBE_SUB && blockIdx.x == 0 && threadIdx.x == 0) *(volatile LAS unsigned long long*)(lds_base() + LDS_MISC + 32 + 8 * (w)) = __builtin_amdgcn_s_memrealtime(); } while (0)
#else
#define PSUB(n, w) do { } while (0)
#endif
#define XB_TMO      128
#define XB_XCNT(j)  (256  + 64 * (j))
#define XB_XSUB(j)  (1280 + 64 * (j))
#define XB_XGEN(j)  (2304 + 64 * (j))
#define XB_TOP      3328
#define XB_TOPGEN   3392
#define XCD_BAR_WORDS 3456
#define XB_SPIN_CAP (1u << 18)

__device__ __forceinline__ unsigned xb_ld(unsigned* p)              { return __hip_atomic_load(p, __ATOMIC_RELAXED, __HIP_MEMORY_SCOPE_AGENT); }
__device__ __forceinline__ unsigned xb_add(unsigned* p, unsigned v) { return __hip_atomic_fetch_add(p, v, __ATOMIC_RELAXED, __HIP_MEMORY_SCOPE_AGENT); }
__device__ __forceinline__ unsigned xb_xcc_id() { return (unsigned)__builtin_amdgcn_s_getreg((3 << 11) | 20) & 0xFu; }
#define XB_SPIN(cond, bar) do { unsigned _sp = 0; while (cond) { __builtin_amdgcn_s_sleep(1); \
    if ((++_sp & 255u) == 0u) { if (xb_ld(&(bar)[XB_TMO])) break; if (_sp > XB_SPIN_CAP) { atomicAdd(&(bar)[XB_TMO], 1u); break; } } } } while (0)

struct XcdBarrier {
    unsigned* bar; unsigned x;
    volatile LAS unsigned* st;
};

__device__ __forceinline__ XcdBarrier xcd_barrier_post(unsigned* bar, volatile LAS unsigned* st) {
    XcdBarrier b; b.bar = bar; b.x = xb_xcc_id(); b.st = st;
    if (threadIdx.x == 0) (void)xb_add(&bar[XB_XCNT(b.x)], 1u);
    return b;
}
__device__ __forceinline__ void xcd_barrier_complete(unsigned* bar, unsigned x, unsigned& nloc, unsigned& nx) {
    const unsigned G = gridDim.x * gridDim.y * gridDim.z;
    unsigned sum, cnt, mine, sp = 0u;
    for (;;) {
        sum = 0u; cnt = 0u; mine = 0u;
#pragma unroll
        for (unsigned j = 0; j < 16; ++j) { const unsigned c = xb_ld(&bar[XB_XCNT(j)]); sum += c; cnt += (c > 0u) ? 1u : 0u; mine = (j == x) ? c : mine; }
        if (sum == G) break;
        __builtin_amdgcn_s_sleep(1);
        if ((++sp & 255u) == 0u) { if (xb_ld(&bar[XB_TMO])) break; if (sp > XB_SPIN_CAP) { atomicAdd(&bar[XB_TMO], 1u); break; } }
    }
    nloc = mine > 0u ? mine : 1u; nx = cnt > 0u ? cnt : 1u;
}

__device__ __forceinline__ void xcd_barrier(const XcdBarrier& b) {
    asm volatile("s_waitcnt vmcnt(0)" ::: "memory");
    __syncthreads();
    if (threadIdx.x == 0) {
        unsigned* bar = b.bar;
        __builtin_amdgcn_s_waitcnt(0);
        unsigned nloc = b.st[0], nx = b.st[1];
        if (nloc == 0u) { xcd_barrier_complete(bar, b.x, nloc, nx); b.st[0] = nloc; b.st[1] = nx; }
        const unsigned old = xb_add(&bar[XB_XSUB(b.x)], 1u);
        const unsigned gen = old / nloc;
        if (old + 1u == (gen + 1u) * nloc) {
            __builtin_amdgcn_fence(__ATOMIC_RELEASE, "agent");
            asm volatile("s_waitcnt vmcnt(0)" ::: "memory");
            const unsigned og = xb_add(&bar[XB_TOP], 1u);
            const unsigned tg = og / nx;
            if (og + 1u == (tg + 1u) * nx) xb_add(&bar[XB_TOPGEN], 1u);
            else XB_SPIN(xb_ld(&bar[XB_TOPGEN]) == tg, bar);
            __builtin_amdgcn_fence(__ATOMIC_ACQUIRE, "agent");
            xb_add(&bar[XB_XGEN(b.x)], 1u);
            asm volatile("s_waitcnt vmcnt(0)" ::: "memory");
        } else {
            XB_SPIN(xb_ld(&bar[XB_XGEN(b.x)]) == gen, bar);
            __builtin_amdgcn_fence(__ATOMIC_ACQUIRE, "agent");
            asm volatile("s_waitcnt vmcnt(0)" ::: "memory");
        }
    }
    __syncthreads();
}

namespace pg8 {
constexpr int BM = 256, BK = 64, HALF = 128, HTB = HALF * BK * 2  , STAGE_BYTES = 8 * HTB, NXCD = 8, WGM = 8;
__host__ __device__ __forceinline__ int lds_byte(int r, int c) { const int st = (r >> 4) * 2 + (c >> 5), rr = r & 15, cc = c & 31, ob = rr * 64 + cc * 2; return st * 1024 + (ob ^ (((ob >> 9) & 1) << 5)); }
__host__ __device__ __forceinline__ void stage_rc(int b, int& R, int& C) { const int st = b / 1024, sb = b % 1024, swz = sb ^ (((sb >> 9) & 1) << 5); R = (st >> 1) * 16 + swz / 64; C = (st & 1) * 32 + (swz % 64) / 2; }
__host__ __device__ __forceinline__ int perm32(int rho) { const int n = rho >> 4, i = rho & 15; return 8 * (i >> 2) + 4 * n + (i & 3); }

struct Unit { int pm, pn, ax; };
struct Gemm { const bf16* A; const bf16* Bt; int K; int pid; };

struct StaticOrder {
    int nM, nN, nwg, G, c;
    __device__ void init(int M, int N, int G_, int c_) { nM = M / BM; nN = N / BM; nwg = nM * nN; G = G_; c = c_; }
    __device__ __forceinline__ bool next(int i, Unit& u) const {
        const long L = (long)i * G + c; if (L >= nwg) return false;
        int wgid = (int)L; { const int q = nwg / NXCD, r = nwg % NXCD, xcd = wgid % NXCD, off = wgid / NXCD; wgid = (xcd < r ? xcd * (q + 1) : r * (q + 1) + (xcd - r) * q) + off; }
        const int nig = WGM * nN, gid = wgid / nig, fm = gid * WGM, gsz = (nM - fm) < WGM ? (nM - fm) : WGM;
        u.pm = fm + ((wgid % nig) % gsz); u.pn = (wgid % nig) / gsz; u.ax = 0; return true;
    }
    __device__ __forceinline__ int row_tok(const Unit&, int) const { return 0; }
};

template <class Epi, class Sched, bool GATHER>
__device__ __forceinline__ void gemm_phase(LAS unsigned char* lds, const Gemm g, const Sched& S, const Epi& E) {
    const int tid = threadIdx.x, wid = __builtin_amdgcn_readfirstlane(tid >> 6), lane = tid & 63, wr = wid >> 2, wc = wid & 3, fr = lane & 15, fq = lane >> 4;
    const int K = g.K, nt = K / BK;
    unsigned voffB[2]; int RA[2]; unsigned CA2[2];
#pragma unroll
    for (int i = 0; i < 2; ++i) { int R, C; stage_rc(tid * 16 + i * 8192, R, C); const int Rb = Epi::PERM ? ((R & ~31) + perm32(R & 31)) : R;
        voffB[i] = (unsigned)(Rb * K + C) * 2u; RA[i] = R; CA2[i] = (unsigned)C * 2u; }
    const size_t kstep = (size_t)(BK * 2);
    const size_t hstep = (size_t)HALF * K * 2;
    const size_t tstep = 2 * hstep;
    const unsigned ldsw = (unsigned)wid * 1024u;
    const int aoff = lds_byte(wr * 64 + fr, fq * 8), boff = lds_byte(wc * 32 + fr, fq * 8);
#define PG8_SA(b, h) (((b) * 2 + (h)) * HTB)
#define PG8_SB(b, h) ((4 + (b) * 2 + (h)) * HTB)
#define PG8_STAGE(bufoff, gbase, voff) do { _Pragma("unroll") for (int _i = 0; _i < 2; ++_i) \
        __builtin_amdgcn_global_load_lds((const unsigned*)((const char*)(gbase) + (voff)[_i]), (LAS unsigned*)(lds + (bufoff) + ldsw + _i * 8192), 16, 0, 0); } while (0)
#define PG8_LDA(dst, b, h) do { _Pragma("unroll") for (int m = 0; m < 4; ++m) _Pragma("unroll") for (int k = 0; k < 2; ++k) dst[m][k] = *(const LAS bf16x8*)(lds + PG8_SA(b, h) + aoff + m * 2048 + k * 1024); } while (0)
#define PG8_LDB(dst, b, h) do { _Pragma("unroll") for (int n = 0; n < 2; ++n) _Pragma("unroll") for (int k = 0; k < 2; ++k) dst[n][k] = *(const LAS bf16x8*)(lds + PG8_SB(b, h) + boff + n * 2048 + k * 1024); } while (0)
#define PG8_MMA(ai, bj, At, Bt) do { __builtin_amdgcn_s_setprio(1); _Pragma("unroll") for (int m = 0; m < 4; ++m) _Pragma("unroll") for (int n = 0; n < 2; ++n) _Pragma("unroll") for (int k = 0; k < 2; ++k) \
        acc[ai][bj][m][n] = __builtin_amdgcn_mfma_f32_16x16x32_bf16(Bt[n][k], At[m][k], acc[ai][bj][m][n], 0, 0, 0); __builtin_amdgcn_s_setprio(0); } while (0)
#define PG8_WAIT_V(n) asm volatile("s_waitcnt vmcnt(" #n ")" ::: "memory")
#define PG8_WAIT_L(n) asm volatile("s_waitcnt lgkmcnt(" #n ")" ::: "memory")
#define PG8_BAR __builtin_amdgcn_s_barrier()
#define PG8_SCHED __builtin_amdgcn_sched_barrier(0)
#define PG8_SET_OA(o, u) do { _Pragma("unroll") for (int _h = 0; _h < 2; ++_h) _Pragma("unroll") for (int _i = 0; _i < 2; ++_i) { \
        if constexpr (GATHER) o[_h][_i] = (unsigned)S.row_tok(u, _h * HALF + RA[_i]) * (unsigned)(K * 2) + CA2[_i]; \
        else o[_h][_i] = (unsigned)(_h * (int)hstep) + (unsigned)(RA[_i] * K * 2) + CA2[_i]; } } while (0)
    Unit cur, nxt; int ui = 0;
    if (!S.next(0, cur)) return;
    f32x4 acc[2][2][4][2];
#pragma unroll
    for (int a = 0; a < 2; ++a)
#pragma unroll
        for (int b = 0; b < 2; ++b)
#pragma unroll
            for (int m = 0; m < 4; ++m)
#pragma unroll
                for (int n = 0; n < 2; ++n) acc[a][b][m][n] = (f32x4){0.f, 0.f, 0.f, 0.f};
    bf16x8 At[4][2], B0[2][2], B1[2][2];
    unsigned oAc[2][2], oAn[2][2];
    PG8_SET_OA(oAc, cur);
    const char* cA = GATHER ? (const char*)g.A : (const char*)g.A + (size_t)cur.pm * tstep; const char* cB = (const char*)g.Bt + (size_t)cur.pn * tstep;
    PG8_STAGE(PG8_SB(0, 0), cB, voffB); PG8_STAGE(PG8_SB(0, 1), cB + hstep, voffB); PG8_STAGE(PG8_SA(0, 0), cA, oAc[0]); PG8_STAGE(PG8_SA(0, 1), cA, oAc[1]);
    if (wr == 1) PG8_BAR;
    PG8_WAIT_V(2); PG8_BAR;
    PG8_STAGE(PG8_SB(1, 0), cB + kstep, voffB); PG8_STAGE(PG8_SA(1, 0), cA + kstep, oAc[0]); PG8_STAGE(PG8_SB(1, 1), cB + hstep + kstep, voffB);
    PG8_WAIT_V(6); PG8_BAR;
    for (;;) {
        const bool has_next = S.next(ui + 1, nxt);
        const char* nA = has_next ? (GATHER ? (const char*)g.A : (const char*)g.A + (size_t)nxt.pm * tstep) : cA; const char* nB = has_next ? (const char*)g.Bt + (size_t)nxt.pn * tstep : cB;
        if (has_next) { PG8_SET_OA(oAn, nxt); }
        else {
#pragma unroll
            for (int _h = 0; _h < 2; ++_h)
#pragma unroll
                for (int _i = 0; _i < 2; ++_i) oAn[_h][_i] = oAc[_h][_i]; }
        PSUB(g.pid * 10, 0); PSUB(g.pid * 10 + 2, 0);
        for (int t = 0; t < nt; t += 2) {
            const bool last = (t == nt - 2);
            if (t == 0) { PSUB(g.pid * 10 + 3, 0); } if (t == 2) { PSUB(g.pid * 10 + 3, 1); PSUB(g.pid * 10 + 4, 0); } if (t == 4) { PSUB(g.pid * 10 + 4, 1); }
            const char* a1 = cA + (size_t)(t + 1) * kstep;
            const char* a2 = last ? nA : cA + (size_t)(t + 2) * kstep; const char* b2 = last ? nB : cB + (size_t)(t + 2) * kstep;
            const char* a3 = a2 + kstep; const char* b3 = b2 + kstep;
            unsigned o2[2][2];
#pragma unroll
            for (int _h = 0; _h < 2; ++_h)
#pragma unroll
                for (int _i = 0; _i < 2; ++_i) o2[_h][_i] = GATHER ? (last ? oAn[_h][_i] : oAc[_h][_i]) : oAc[_h][_i];
            PG8_LDB(B0, 0, 0); PG8_LDB(B1, 0, 1); PG8_SCHED; PG8_LDA(At, 0, 0); PG8_STAGE(PG8_SA(1, 1), a1, oAc[1]);
            PG8_WAIT_V(8); PG8_WAIT_L(0); PG8_BAR; PG8_MMA(0, 0, At, B0); PG8_MMA(0, 1, At, B1); PG8_BAR; PG8_SCHED;
            PG8_LDA(At, 0, 1); PG8_STAGE(PG8_SB(0, 0), b2, voffB); PG8_STAGE(PG8_SB(0, 1), b2 + hstep, voffB); PG8_STAGE(PG8_SA(0, 0), a2, o2[0]);
            PG8_WAIT_V(8); PG8_WAIT_L(0); PG8_BAR; PG8_MMA(1, 0, At, B0); PG8_MMA(1, 1, At, B1); PG8_BAR; PG8_SCHED;
            PG8_LDB(B0, 1, 0); PG8_LDB(B1, 1, 1); PG8_SCHED; PG8_LDA(At, 1, 0); PG8_STAGE(PG8_SA(0, 1), a2, o2[1]);
            PG8_WAIT_V(8); PG8_WAIT_L(0); PG8_BAR; PG8_MMA(0, 0, At, B0); PG8_MMA(0, 1, At, B1); PG8_BAR; PG8_SCHED;
            PG8_LDA(At, 1, 1); PG8_STAGE(PG8_SB(1, 0), b3, voffB); PG8_STAGE(PG8_SB(1, 1), b3 + hstep, voffB); PG8_STAGE(PG8_SA(1, 0), a3, o2[0]);
            PG8_WAIT_V(8); PG8_WAIT_L(0); PG8_BAR; PG8_MMA(1, 0, At, B0); PG8_MMA(1, 1, At, B1); PG8_BAR; PG8_SCHED;
        }
        PSUB(g.pid * 10, 1); PSUB(g.pid * 10 + 1, 0);
        if (wr == 0) PG8_BAR;
        { int fr_ = fr, fq_ = fq, wr_ = wr, wc_ = wc; asm volatile("" : "+v"(fr_), "+v"(fq_), "+s"(wr_), "+s"(wc_));
          E(acc, cur, wr_, wc_, fr_, fq_); }
        PSUB(g.pid * 10 + 1, 1); PSUB(g.pid * 10 + 2, 1);
        if (!has_next) break;
#pragma unroll
        for (int a = 0; a < 2; ++a)
#pragma unroll
            for (int b = 0; b < 2; ++b)
#pragma unroll
                for (int m = 0; m < 4; ++m)
#pragma unroll
                    for (int n = 0; n < 2; ++n) acc[a][b][m][n] = (f32x4){0.f, 0.f, 0.f, 0.f};
        cur = nxt; cA = nA; cB = nB; ++ui;
#pragma unroll
        for (int _h = 0; _h < 2; ++_h)
#pragma unroll
            for (int _i = 0; _i < 2; ++_i) oAc[_h][_i] = oAn[_h][_i];
        if (wr == 1) PG8_BAR;
    }
    PG8_WAIT_V(0);
    PG8_BAR;
#undef PG8_SA
#undef PG8_SB
#undef PG8_STAGE
#undef PG8_LDA
#undef PG8_LDB
#undef PG8_MMA
#undef PG8_WAIT_V
#undef PG8_WAIT_L
#undef PG8_BAR
#undef PG8_SCHED
#undef PG8_SET_OA
}
}
struct Args { const void* in[27]; float* out; unsigned char* ws; int ph_lo, ph_hi; };
struct Frame {
    const Args* ap;
    __device__ __forceinline__ LAS unsigned char* lds() const { extern __shared__ __attribute__((aligned(16))) unsigned char lds_raw[]; return (LAS unsigned char*)lds_raw; }
    __device__ __forceinline__ unsigned char* ws() const { return ap->ws; }
    __device__ __forceinline__ gu32* ctl() const { return (gu32*)(ap->ws + WS_CTL); }
    __device__ __forceinline__ float* out() const { return ap->out; }
    __device__ __forceinline__ int tid() const { return (int)threadIdx.x; }
    __device__ __forceinline__ int lane() const { return (int)threadIdx.x & 63; }
    __device__ __forceinline__ int wave() const { return __builtin_amdgcn_readfirstlane((int)threadIdx.x >> 6); }
    __device__ __forceinline__ int G() const { return (int)gridDim.x; }
    __device__ __forceinline__ int bid() const { return (int)blockIdx.x; }
    __device__ __forceinline__ const CAS float* f(int i) const { return (const CAS float*)ap->in[i]; }
    __device__ __forceinline__ const CAS int* i32(int i) const { return (const CAS int*)ap->in[i]; }
};
#define WSP(T, off) ((T*)(F.ws() + (off)))

__device__ __forceinline__ int inproj_src_col(int P) {
    const int tile = P >> 8, within = P & 255, bj = within >> 7, w = within & 127;
    if (tile < 4) return SEG_Z + tile * 256 + within;
    if (tile < 10) return SEG_XBC + (tile - 4) * 256 + within;
    if (tile < 14) return SEG_Q + (2 * (tile - 10) + (w >> 6)) * 128 + (w & 63) + 64 * bj;
    if (tile < 18) return SEG_K + (2 * (tile - 14) + (w >> 6)) * 128 + (w & 63) + 64 * bj;
    if (tile < 22) return SEG_V + (tile - 18) * 256 + within;
    if (tile < 26) return SEG_QI + (4 * (tile - 22) + (w >> 5)) * 64 + (w & 31) + 32 * bj;
    if (bj == 0) { if (w < 32) return SEG_KI + w; if (w < 48) return SEG_WI + (w - 32); if (w < 64) return SEG_DT + (w - 48); return -1; }
    if (w < 32) return SEG_KI + 32 + w;
    return -1;
}
__device__ __forceinline__ void tr64(const CAS float* qsrc, bool valid, int ld, bf16* dst0  , int K, LAS float* scr, int lane) {
    f32x4 v[16];
#pragma unroll
    for (int i = 0; i < 16; ++i) v[i] = valid ? *(const CAS f32x4*)(qsrc + (size_t)(4 * i) * ld) : (f32x4){0.f, 0.f, 0.f, 0.f};
#pragma unroll
    for (int i = 0; i < 16; ++i) { LAS float* s = scr + ((lane >> 4) + 4 * i) * 65 + 4 * (lane & 15); s[0] = v[i][0]; s[1] = v[i][1]; s[2] = v[i][2]; s[3] = v[i][3]; }
    LDS_WAIT(); asm volatile("" ::: "memory");
    const int c = lane & 7;
#pragma unroll
    for (int jj = 0; jj < 8; ++jj) { const int n = (lane >> 3) + 8 * jj; const LAS float* s = scr + (8 * c) * 65 + n;
        u32x4 o; o.x = cvt_pk_bf16(s[0], s[65]); o.y = cvt_pk_bf16(s[2 * 65], s[3 * 65]); o.z = cvt_pk_bf16(s[4 * 65], s[5 * 65]); o.w = cvt_pk_bf16(s[6 * 65], s[7 * 65]);
        *(u32x4*)(dst0 + (size_t)n * K + 8 * c) = o; }
    LDS_WAIT(); asm volatile("" ::: "memory");
}
constexpr int I_IN = 32 * 108, I_OUT = 32 * 32, I_GU = NEX * 32 * 16, I_DN = NEX * 8 * 32, I_TR = I_IN + I_OUT + I_GU + I_DN;
__device__ __forceinline__ void tr_item(Frame& F, int it, LAS float* scr) {
    const int lane = F.lane(), kr = lane >> 4, nq = 4 * (lane & 15);
    if (it < I_IN) { const int kb = it / 108, nb = it % 108, k0 = 64 * kb, n0 = 64 * nb; const int sc = inproj_src_col(n0 + nq);
        tr64(F.f(5) + (size_t)(k0 + kr) * NPROJ + (sc < 0 ? 0 : sc), sc >= 0, NPROJ, WSP(bf16, WS_WIN) + (size_t)n0 * DM + k0, DM, scr, lane); return; }
    it -= I_IN;
    if (it < I_OUT) { const int kb = it >> 5, nb = it & 31, k0 = 64 * kb, n0 = 64 * nb;
        tr64(F.f(14) + (size_t)(k0 + kr) * DM + n0 + nq, true, DM, WSP(bf16, WS_WOUT) + (size_t)n0 * DM + k0, DM, scr, lane); return; }
    it -= I_OUT;
    if (it < I_GU) { const int e = it >> 9, r = it & 511, kb = r >> 4, nb = r & 15, k0 = 64 * kb;
        const int p = nb >> 2, bj = (nb >> 1) & 1, w0 = (nb & 1) * 64;
        const CAS float* src = (e < NE) ? ((bj ? F.f(20) : F.f(19)) + (size_t)e * DM * DE) : (bj ? F.f(23) : F.f(22));
        tr64(src + (size_t)(k0 + kr) * DE + 128 * p + w0 + nq, true, DE, WSP(bf16, WS_WGU) + ((size_t)e * 1024 + 64 * nb) * DM + k0, DM, scr, lane); return; }
    it -= I_GU;
    { const int e = it >> 8, r = it & 255, kb = r >> 5, nb = r & 31, k0 = 64 * kb, n0 = 64 * nb;
        const CAS float* src = (e < NE) ? (F.f(21) + (size_t)e * DE * DM) : F.f(24);
        tr64(src + (size_t)(k0 + kr) * DM + n0 + nq, true, DM, WSP(bf16, WS_WDN) + ((size_t)e * DM + n0) * DE + k0, DE, scr, lane); }
}
__device__ __forceinline__ void p0_prologue(Frame& F) {
    const int gw = F.bid() * 8 + F.wave(), NGW = F.G() * 8, gt = F.bid() * 512 + F.tid(), NGT = F.G() * 512;
    {
        LAS float* red = (LAS float*)F.lds();
        float* modp = WSP(float, WS_MODP);
        for (int item = F.bid(); item < 48 * 16; item += F.G()) {
            const int cc = item % 48, ks = item / 48;
            f32x4 a0 = {0.f, 0.f, 0.f, 0.f}, a1 = {0.f, 0.f, 0.f, 0.f};
            const int kbase = ks * 128 + F.wave() * 16;
#pragma unroll 4
            for (int i = 0; i < 16; ++i) { const int k = kbase + i;
                const float c0 = silu_f(F.f(1)[k]), c1 = silu_f(F.f(1)[DM + k]);
                const f32x4 wv = *(const CAS f32x4*)(F.f(3) + (size_t)k * (6 * DM) + cc * 256 + F.lane() * 4);
                a0 += wv * c0; a1 += wv * c1; }
            *(LAS f32x4*)(red + (F.wave() * 2 + 0) * 256 + F.lane() * 4) = a0;
            *(LAS f32x4*)(red + (F.wave() * 2 + 1) * 256 + F.lane() * 4) = a1;
            __syncthreads();
            { const int b = F.tid() >> 8, col = F.tid() & 255; float s = 0.f;
#pragma unroll
              for (int w = 0; w < 8; ++w) s += red[(w * 2 + b) * 256 + col];
              modp[((size_t)ks * 2 + b) * (6 * DM) + cc * 256 + col] = s; }
            __syncthreads();
        }
    }
    {
        float* cosA = WSP(float, WS_COSA); float* sinA = WSP(float, WS_SINA); float* cosI = WSP(float, WS_COSI); float* sinI = WSP(float, WS_SINI);
        for (int i = gt; i < NTOK * 64; i += NGT) { const int tok = i >> 6, j = i & 63;
            const float inv = 1.0f / powf(10000.0f, (float)(2 * j) / 128.0f); const float ang = (float)F.i32(2)[tok] * inv;
            float s, c; sincosf(ang, &s, &c); cosA[i] = c; sinA[i] = s; }
        for (int i = gt; i < NTOK * 32; i += NGT) { const int tok = i >> 5, j = i & 31;
            const float inv = 1.0f / powf(10000.0f, (float)(2 * j) / 64.0f); const float ang = (float)F.i32(2)[tok] * inv;
            float s, c; sincosf(ang, &s, &c); cosI[i] = c; sinI[i] = s; }
    }
    {
        bf16* wr_hi = WSP(bf16, WS_WR); bf16* wr_lo = wr_hi + NE * DM;
        for (int i = gt; i < NE * (DM / 8); i += NGT) { const int e = i & 63, kc = i >> 6;
            float v[8], l[8];
#pragma unroll
            for (int j = 0; j < 8; ++j) { v[j] = F.f(17)[(size_t)(8 * kc + j) * NE + e]; l[j] = v[j] - bf2f(f2bf(v[j])); }
            u32x4 h = {cvt_pk_bf16(v[0], v[1]), cvt_pk_bf16(v[2], v[3]), cvt_pk_bf16(v[4], v[5]), cvt_pk_bf16(v[6], v[7])};
            u32x4 lo = {cvt_pk_bf16(l[0], l[1]), cvt_pk_bf16(l[2], l[3]), cvt_pk_bf16(l[4], l[5]), cvt_pk_bf16(l[6], l[7])};
            *(u32x4*)(wr_hi + (size_t)e * DM + 8 * kc) = h; *(u32x4*)(wr_lo + (size_t)e * DM + 8 * kc) = lo; }
    }
    {
        LAS float* scr = (LAS float*)(F.lds() + F.wave() * 16640);
        for (int it = gw; it < I_IN + I_OUT; it += NGW) tr_item(F, it, scr);
    }
}

constexpr int Q_GU = I_GU, Q_ALL = I_GU + I_DN, Q_GRAB = 16;
__device__ __forceinline__ void slack_fill(Frame& F, int budget, bool drain, int upto) {
    LAS float* scr = (LAS float*)(F.lds() + F.wave() * 16640);
    volatile LAS int* qw = (volatile LAS int*)(F.lds() + LDS_MISC + 16);
    __syncthreads();
    for (int gi = 0; drain || gi < budget; ++gi) {
        if (F.tid() == 0) { int stop = 0;
            const int idx = (int)__hip_atomic_fetch_add(F.ctl() + CW_QHEAD, (unsigned)Q_GRAB, RLX_AGENT); if (idx >= Q_ALL) stop = 1; else if (idx >= upto) stop = 2;
            qw[0] = stop; qw[1] = idx; }
        __syncthreads();
        const int stop = qw[0], idx = qw[1];
        __syncthreads();
        if (stop == 1) break;
#pragma unroll 1
        for (int i = 0; i < Q_GRAB / 8; ++i) { const int it = idx + i * 8 + F.wave(); if (it < Q_ALL) tr_item(F, I_IN + I_OUT + it, scr); }
        if (stop == 2) break;
    }
}

__device__ __forceinline__ void p1_modulate(Frame& F) {
    const float* modp = WSP(const float, WS_MODP); float* modf = WSP(float, WS_MODF); bf16* u1 = WSP(bf16, WS_U1);
    LAS float* sh = (LAS float*)F.lds(); LAS float* sc = sh + DM;
    for (int rg = F.bid(); rg < 256; rg += F.G()) {
        const int b = rg >> 7;
        if (F.tid() < 96) { const int v = rg * 96 + F.tid(); const int bb = v / (6 * DM), col = v % (6 * DM); float s = F.f(4)[col];
#pragma unroll
            for (int ks = 0; ks < 16; ++ks) s += modp[((size_t)ks * 2 + bb) * (6 * DM) + col];
            modf[v] = s; }
        { const int col = F.tid() * 4; f32x4 s0 = *(const CAS f32x4*)(F.f(4) + col), s1 = *(const CAS f32x4*)(F.f(4) + DM + col);
#pragma unroll
          for (int ks = 0; ks < 16; ++ks) { const float* p = modp + ((size_t)ks * 2 + b) * (6 * DM); s0 += *(const f32x4*)(p + col); s1 += *(const f32x4*)(p + DM + col); }
          *(LAS f32x4*)(sh + col) = s0; *(LAS f32x4*)(sc + col) = s1; }
        __syncthreads();
#pragma unroll
        for (int rr = 0; rr < 4; ++rr) { const int row = rg * 32 + F.wave() * 4 + rr;
#pragma unroll
            for (int j = 0; j < 8; ++j) { const int col = j * 256 + F.lane() * 4;
                const f32x4 xv = *(const CAS f32x4*)(F.f(0) + (size_t)row * DM + col); const f32x4 s0 = *(const LAS f32x4*)(sh + col), s1 = *(const LAS f32x4*)(sc + col);
                const f32x4 u = xv * (s1 + 1.0f) + s0;
                u32x2 o = {cvt_pk_bf16(u[0], u[1]), cvt_pk_bf16(u[2], u[3])};
                *(u32x2*)(u1 + (size_t)row * DM + col) = o; } }
        __syncthreads();
    }
}
struct EpiInProj {
    static constexpr bool PERM = true;
    unsigned char* ws; const CAS float *dt_bias, *lng, *lnb;
    __device__ __forceinline__ void operator()(const f32x4 (&acc)[2][2][4][2], const pg8::Unit& u, int wr, int wc, int fr, int fq) const {
        const int pn = u.pn; const int row0 = u.pm * 256 + wr * 64 + fr;
        if (pn < 10 || (pn >= 18 && pn < 22)) {
            size_t boff; int ld, col0;
            if (pn < 4) { boff = WS_Z; ld = 1024; col0 = pn * 256; } else if (pn < 10) { boff = WS_XBC; ld = CONV_CH; col0 = (pn - 4) * 256; } else { boff = WS_V; ld = 1024; col0 = (pn - 18) * 256; }
            bf16* base = (bf16*)(ws + boff);
            col0 += wc * 32 + 8 * fq;
#pragma unroll
            for (int ai = 0; ai < 2; ++ai)
#pragma unroll
                for (int m = 0; m < 4; ++m) { bf16* rowp = base + (size_t)(row0 + ai * 128 + m * 16) * ld + col0;
#pragma unroll
                    for (int bj = 0; bj < 2; ++bj) { const f32x4 v0 = acc[ai][bj][m][0], v1 = acc[ai][bj][m][1];
                        u32x4 w = {cvt_pk_bf16(v0[0], v0[1]), cvt_pk_bf16(v0[2], v0[3]), cvt_pk_bf16(v1[0], v1[1]), cvt_pk_bf16(v1[2], v1[3])};
                        *(u32x4*)(rowp + bj * 128) = w; } }
        } else if (pn < 26) {
            const bool att = pn < 18; const bool isq = pn < 14;
            bf16* base = (bf16*)(ws + (att ? (isq ? WS_Q : WS_K) : WS_QIDX)); const CAS float* ct = (const CAS float*)(ws + (att ? WS_COSA : WS_COSI)); const CAS float* sn = (const CAS float*)(ws + (att ? WS_SINA : WS_SINI));
            const int tw = att ? 64 : 32;
            const int head = att ? 2 * (pn - (isq ? 10 : 14)) + (wc >> 1) : 4 * (pn - 22) + wc, jj0 = att ? 32 * (wc & 1) + 8 * fq : 8 * fq;
#pragma unroll
            for (int ai = 0; ai < 2; ++ai)
#pragma unroll
                for (int m = 0; m < 4; ++m) { const int row = row0 + ai * 128 + m * 16;
                    bf16* rowp = base + (size_t)row * 1024 + head * (2 * tw) + jj0;
#pragma unroll
                    for (int n = 0; n < 2; ++n) { const f32x4 c = *(const CAS f32x4*)(ct + (size_t)row * tw + jj0 + 4 * n), sv = *(const CAS f32x4*)(sn + (size_t)row * tw + jj0 + 4 * n);
                        const f32x4 a = acc[ai][0][m][n], bb = acc[ai][1][m][n];
                        const f32x4 o1 = a * c - bb * sv, o2 = bb * c + a * sv;
                        *(u32x2*)(rowp + 4 * n) = (u32x2){cvt_pk_bf16(o1[0], o1[1]), cvt_pk_bf16(o1[2], o1[3])};
                        *(u32x2*)(rowp + tw + 4 * n) = (u32x2){cvt_pk_bf16(o2[0], o2[1]), cvt_pk_bf16(o2[2], o2[3])}; } }
        } else {
            const CAS float* cosI = (const CAS float*)(ws + WS_COSI); const CAS float* sinI = (const CAS float*)(ws + WS_SINI); bf16* kidx = (bf16*)(ws + WS_KIDX); float* widx = (float*)(ws + WS_WIDX); float* dt = (float*)(ws + WS_DT);
            if (wc == 0) {
                const int jj0 = 8 * fq;
#pragma unroll
                for (int am = 0; am < 8; ++am) { const int ai = am >> 2, m = am & 3; const int row = row0 + ai * 128 + m * 16;
                        f32x4 a0 = acc[ai][0][m][0], a1 = acc[ai][0][m][1], b0 = acc[ai][1][m][0], b1 = acc[ai][1][m][1];
                        float s = (a0[0] + a0[1] + a0[2] + a0[3]) + (a1[0] + a1[1] + a1[2] + a1[3]) + (b0[0] + b0[1] + b0[2] + b0[3]) + (b1[0] + b1[1] + b1[2] + b1[3]);
                        s += __shfl_xor(s, 16); s += __shfl_xor(s, 32);
                        const float mu = s * (1.0f / 64.0f);
                        a0 = a0 - mu; a1 = a1 - mu; b0 = b0 - mu; b1 = b1 - mu;
                        float qv = (a0[0] * a0[0] + a0[1] * a0[1] + a0[2] * a0[2] + a0[3] * a0[3]) + (a1[0] * a1[0] + a1[1] * a1[1] + a1[2] * a1[2] + a1[3] * a1[3])
                                 + (b0[0] * b0[0] + b0[1] * b0[1] + b0[2] * b0[2] + b0[3] * b0[3]) + (b1[0] * b1[0] + b1[1] * b1[1] + b1[2] * b1[2] + b1[3] * b1[3]);
                        qv += __shfl_xor(qv, 16); qv += __shfl_xor(qv, 32);
                        const float rstd = 1.0f / sqrtf(qv * (1.0f / 64.0f) + LN_EPS);
                        a0 = a0 * rstd * *(const CAS f32x4*)(lng + jj0) + *(const CAS f32x4*)(lnb + jj0); a1 = a1 * rstd * *(const CAS f32x4*)(lng + jj0 + 4) + *(const CAS f32x4*)(lnb + jj0 + 4);
                        b0 = b0 * rstd * *(const CAS f32x4*)(lng + 32 + jj0) + *(const CAS f32x4*)(lnb + 32 + jj0); b1 = b1 * rstd * *(const CAS f32x4*)(lng + 36 + jj0) + *(const CAS f32x4*)(lnb + 36 + jj0);
                        const f32x4 c0 = *(const CAS f32x4*)(cosI + (size_t)row * 32 + jj0), c1 = *(const CAS f32x4*)(cosI + (size_t)row * 32 + jj0 + 4);
                        const f32x4 s0 = *(const CAS f32x4*)(sinI + (size_t)row * 32 + jj0), s1 = *(const CAS f32x4*)(sinI + (size_t)row * 32 + jj0 + 4);
                        const f32x4 o10 = a0 * c0 - b0 * s0, o11 = a1 * c1 - b1 * s1, o20 = b0 * c0 + a0 * s0, o21 = b1 * c1 + a1 * s1;
                        bf16* rowp = kidx + (size_t)row * 64 + jj0;
                        u32x4 w1 = {cvt_pk_bf16(o10[0], o10[1]), cvt_pk_bf16(o10[2], o10[3]), cvt_pk_bf16(o11[0], o11[1]), cvt_pk_bf16(o11[2], o11[3])};
                        u32x4 w2 = {cvt_pk_bf16(o20[0], o20[1]), cvt_pk_bf16(o20[2], o20[3]), cvt_pk_bf16(o21[0], o21[1]), cvt_pk_bf16(o21[2], o21[3])};
                        *(u32x4*)rowp = w1; *(u32x4*)(rowp + 32) = w2; }
            } else if (wc == 1) {
                const int h0 = 8 * (fq & 1);
                const f32x4 db0 = *(const CAS f32x4*)(dt_bias + h0), db1 = *(const CAS f32x4*)(dt_bias + h0 + 4);
#pragma unroll
                for (int ai = 0; ai < 2; ++ai)
#pragma unroll
                    for (int m = 0; m < 4; ++m) { const int row = row0 + ai * 128 + m * 16;
                        const f32x4 a0 = acc[ai][0][m][0], a1 = acc[ai][0][m][1];
                        if (fq < 2) { *(f32x4*)(widx + (size_t)row * 16 + h0) = a0 * 0.03125f; *(f32x4*)(widx + (size_t)row * 16 + h0 + 4) = a1 * 0.03125f; }
                        else { f32x4 d0 = a0 + db0, d1 = a1 + db1;
#pragma unroll
                            for (int i = 0; i < 4; ++i) { d0[i] = d0[i] > 20.f ? d0[i] : log1pf(__expf(d0[i])); d1[i] = d1[i] > 20.f ? d1[i] : log1pf(__expf(d1[i])); }
                            *(f32x4*)(dt + (size_t)row * 16 + h0) = d0; *(f32x4*)(dt + (size_t)row * 16 + h0 + 4) = d1; } }
            }
        }
    }
};
constexpr int IX_QP = 2064;
constexpr int IX_ST = 32 * IX_QP;
constexpr int IX_WL = IX_ST + 8 * 8320;
__device__ __forceinline__ void idx_unit(Frame& F, int b, int s, int par) {
    const CAS bf16* kidx = (const CAS bf16*)(F.ws() + WS_KIDX); const CAS bf16* qidx = (const CAS bf16*)(F.ws() + WS_QIDX); const CAS float* widx = (const CAS float*)(F.ws() + WS_WIDX); float* scores = WSP(float, WS_SCORES);
    const int lane = F.lane(), r32 = lane & 31, hi = lane >> 5, w = F.wave(), tid = F.tid();
    LAS unsigned char* Ql = F.lds();
    { const CAS bf16* src = qidx + (size_t)(b * SEQ + s * 32) * 1024;
#pragma unroll
      for (int i = 0; i < 8; ++i) { const int c = tid + 512 * i, row = c >> 7, ch = c & 127;
          *(LAS bf16x8*)(Ql + row * IX_QP + ch * 16) = *(const CAS bf16x8*)(src + (size_t)row * 1024 + ch * 8); }
      if (tid < 128) { const f32x4 wv = *(const CAS f32x4*)(widx + (size_t)(b * SEQ + s * 32 + (tid >> 2)) * 16 + 4 * (tid & 3)); LAS float* wl = (LAS float*)(F.lds() + IX_WL) + (tid >> 2) * 17 + 4 * (tid & 3);
          wl[0] = wv[0]; wl[1] = wv[1]; wl[2] = wv[2]; wl[3] = wv[3]; } }
    __syncthreads();
    const int qpos = s * 32 + r32, nT = (s >> 2) + 1;
    const LAS float* wrow = (const LAS float*)(F.lds() + IX_WL) + r32 * 17;
    const LAS unsigned char* qrow = Ql + r32 * IX_QP + hi * 16;
    LAS float* st = (LAS float*)(F.lds() + IX_ST + w * 8320);
#pragma unroll 1
    for (int t = par + 2 * w; t < nT; t += 16) {
        const int kpos0 = t * 128;
        bf16x8 A[4][4];
#pragma unroll
        for (int kt = 0; kt < 4; ++kt)
#pragma unroll
            for (int ks = 0; ks < 4; ++ks) A[kt][ks] = *(const CAS bf16x8*)(kidx + (size_t)(b * SEQ + kpos0 + kt * 32 + r32) * 64 + ks * 16 + hi * 8);
        f32x16 o[4] = {};
#pragma unroll 1
        for (int h = 0; h < 16; ++h) { const float wh = wrow[h];
            bf16x8 Bq[4];
#pragma unroll
            for (int ks = 0; ks < 4; ++ks) Bq[ks] = *(const LAS bf16x8*)(qrow + h * 128 + ks * 32);
#pragma unroll
            for (int kt = 0; kt < 4; ++kt) { f32x16 a = {};
#pragma unroll
                for (int ks = 0; ks < 4; ++ks) a = __builtin_amdgcn_mfma_f32_32x32x16_bf16(A[kt][ks], Bq[ks], a, 0, 0, 0);
#pragma unroll
                for (int r = 0; r < 16; ++r) o[kt][r] = fmaf(wh, __int_as_float(max(__float_as_int(a[r]), 0)), o[kt][r]); } }
        const float NEG = -__builtin_inff();
#pragma unroll
        for (int half = 0; half < 2; ++half) {
#pragma unroll
            for (int r = 0; r < 16; ++r) { const int kk = crow(r, hi);
                st[r32 * 65 + kk] = (kpos0 + half * 64 + kk > qpos) ? NEG : o[2 * half][r];
                st[r32 * 65 + 32 + kk] = (kpos0 + half * 64 + 32 + kk > qpos) ? NEG : o[2 * half + 1][r]; }
            LDS_WAIT(); asm volatile("" ::: "memory");
            float* dst = scores + (size_t)(b * SEQ + s * 32) * SEQ + kpos0 + half * 64 + lane;
#pragma unroll 4
            for (int q = 0; q < 32; ++q) { *dst = st[q * 65 + lane]; dst += SEQ; }
            LDS_WAIT(); asm volatile("" ::: "memory"); }
    }
    __syncthreads();
}

constexpr int SA_P = 136;
constexpr int SA_BN = 0, SA_CN = 34816, SA_BT = 69632, SA_CB = 104448, SA_SM = 139264;
__device__ __forceinline__ void conv8(const CAS bf16* xraw_row  , int tpos, const CAS float* cw, const CAS float* cb, float (&o)[8]) {
    bf16x8 xv[4];
#pragma unroll
    for (int k = 0; k < 4; ++k) { const int dt_ = k - 3; xv[k] = *(const CAS bf16x8*)(xraw_row + ((tpos + dt_ >= 0) ? (long)dt_ * CONV_CH : 0l)); }
    const f32x4 b0 = *(const CAS f32x4*)cb, b1 = *(const CAS f32x4*)(cb + 4);
#pragma unroll
    for (int j = 0; j < 4; ++j) { o[j] = b0[j]; o[4 + j] = b1[j]; }
#pragma unroll
    for (int k = 0; k < 4; ++k) { const float vm = (tpos + k - 3 >= 0) ? 1.f : 0.f; float xf[8]; unpack8(xv[k], xf);
        const f32x4 w0 = *(const CAS f32x4*)(cw + k * CONV_CH) * vm, w1 = *(const CAS f32x4*)(cw + k * CONV_CH + 4) * vm;
#pragma unroll
        for (int j = 0; j < 4; ++j) { o[j] += w0[j] * xf[j]; o[4 + j] += w1[j] * xf[4 + j]; } }
#pragma unroll
    for (int j = 0; j < 8; ++j) o[j] = silu_f(o[j]);
}
__device__ __forceinline__ void ssd_a_unit(Frame& F, int b, int c, int g, int hf) {
    const CAS bf16* xbc = (const CAS bf16*)(F.ws() + WS_XBC); bf16* xact = WSP(bf16, WS_XBCACT); const CAS float* dtg = (const CAS float*)(F.ws() + WS_DT); float* csg = WSP(float, WS_CS);
    float* ydiag = WSP(float, WS_YDIAG); float* states = WSP(float, WS_STATES);
    LAS bf16* Bn = (LAS bf16*)(F.lds() + SA_BN); LAS bf16* Cn = (LAS bf16*)(F.lds() + SA_CN); LAS bf16* BT = (LAS bf16*)(F.lds() + SA_BT); LAS bf16* CB = (LAS bf16*)(F.lds() + SA_CB);
    const int lane = F.lane(), r32 = lane & 31, hi = lane >> 5, w = F.wave();
    const int tok0 = b * SEQ + c * CHUNK;
#pragma unroll 4
    for (int i = 0; i < 8; ++i) { const int id = F.tid() + 512 * i, mi = id >> 11, rem = id & 2047, s = rem >> 4, ch = rem & 15;
        const int chan = 1024 + mi * 256 + g * 128 + ch * 8; float o[8];
        conv8(xbc + (size_t)(tok0 + s) * CONV_CH + chan, c * CHUNK + s, F.f(6) + chan, F.f(7) + chan, o);
        u32x4 pk = {cvt_pk_bf16(o[0], o[1]), cvt_pk_bf16(o[2], o[3]), cvt_pk_bf16(o[4], o[5]), cvt_pk_bf16(o[6], o[7])};
        if (mi == 0) { *(LAS u32x4*)(Bn + s * SA_P + ch * 8) = pk;
#pragma unroll
            for (int j = 0; j < 8; ++j) BT[(ch * 8 + j) * SA_P + s] = (bf16)((pk[j >> 1] >> (16 * (j & 1))) & 0xffffu); }
        else { *(LAS u32x4*)(Cn + s * SA_P + ch * 8) = pk; if (hf == 0) *(u32x4*)(xact + (size_t)(tok0 + s) * CONV_CH + chan) = pk; } }
    __syncthreads();
    { const int lt = w >> 1;
#pragma unroll
      for (int sq = 0; sq < 2; ++sq) { const int st = 2 * (w & 1) + sq; f32x16 a = {};
#pragma unroll
          for (int ks = 0; ks < 8; ++ks) { const bf16x8 av = *(const LAS bf16x8*)(Cn + (32 * lt + r32) * SA_P + 16 * ks + 8 * hi), bv = *(const LAS bf16x8*)(Bn + (32 * st + r32) * SA_P + 16 * ks + 8 * hi);
              a = __builtin_amdgcn_mfma_f32_32x32x16_bf16(av, bv, a, 0, 0, 0); }
#pragma unroll
          for (int r = 0; r < 16; ++r) CB[(32 * lt + crow(r, hi)) * SA_P + 32 * st + r32] = f2bf(a[r]); } }
    __syncthreads();
    const int j = w >> 1, sub = w & 1, h = 8 * g + 4 * hf + j;
    LAS bf16* XT = (LAS bf16*)(F.lds() + j * 17408);
    LAS float* cs_l = (LAS float*)(F.lds() + SA_SM) + j * 384; LAS float* wdec = cs_l + 128;
    {
        const float ah = -__expf(F.f(9)[h]);
        const float d0 = dtg[(size_t)(tok0 + lane) * 16 + h], d1 = dtg[(size_t)(tok0 + 64 + lane) * 16 + h];
        float c0 = d0 * ah, c1 = d1 * ah;
#pragma unroll
        for (int o = 1; o < 64; o <<= 1) { const float t0 = __shfl_up(c0, o), t1 = __shfl_up(c1, o); if (lane >= o) { c0 += t0; c1 += t1; } }
        const float tot0 = __shfl(c0, 63); c1 += tot0; const float cend = __shfl(c1, 63);
        if (sub == 0) { cs_l[lane] = c0; cs_l[64 + lane] = c1; wdec[lane] = __expf(cend - c0); wdec[64 + lane] = __expf(cend - c1);
            csg[(size_t)(tok0 + lane) * 16 + h] = c0; csg[(size_t)(tok0 + 64 + lane) * 16 + h] = c1; }
#pragma unroll 4
        for (int i = 0; i < 8; ++i) { const int id = lane + 64 * i, s = 64 * sub + (id >> 3), ch = id & 7, chan = h * 64 + ch * 8; float o[8];
            conv8(xbc + (size_t)(tok0 + s) * CONV_CH + chan, c * CHUNK + s, F.f(6) + chan, F.f(7) + chan, o);
            u32x4 pk = {cvt_pk_bf16(o[0], o[1]), cvt_pk_bf16(o[2], o[3]), cvt_pk_bf16(o[4], o[5]), cvt_pk_bf16(o[6], o[7])};
            *(u32x4*)(xact + (size_t)(tok0 + s) * CONV_CH + chan) = pk;
            const float dts = dtg[(size_t)(tok0 + s) * 16 + h];
#pragma unroll
            for (int jj = 0; jj < 8; ++jj) XT[(ch * 8 + jj) * SA_P + s] = f2bf(o[jj] * dts); }
    }
    __syncthreads();
#pragma unroll
    for (int lq = 0; lq < 2; ++lq) { const int lt = 2 * sub + lq; const int l = 32 * lt + r32; const float csl = cs_l[l];
        f32x16 a0 = {}, a1 = {};
        for (int ks = 0; ks <= 2 * lt + 1; ++ks) { const int s0 = 16 * ks + 8 * hi;
            float cbf[8]; unpack8(*(const LAS bf16x8*)(CB + l * SA_P + s0), cbf);
            const f32x4 q0 = *(const LAS f32x4*)(cs_l + s0), q1 = *(const LAS f32x4*)(cs_l + s0 + 4);
            float mv[8];
#pragma unroll
            for (int jj = 0; jj < 8; ++jj) { const float cq = jj < 4 ? q0[jj & 3] : q1[jj & 3]; mv[jj] = (s0 + jj <= l) ? cbf[jj] * __expf(csl - cq) : 0.f; }
            const bf16x8 av = pack8((f32x4){mv[0], mv[1], mv[2], mv[3]}, (f32x4){mv[4], mv[5], mv[6], mv[7]});
            const bf16x8 b0 = *(const LAS bf16x8*)(XT + r32 * SA_P + s0), b1 = *(const LAS bf16x8*)(XT + (32 + r32) * SA_P + s0);
            a0 = __builtin_amdgcn_mfma_f32_32x32x16_bf16(av, b0, a0, 0, 0, 0); a1 = __builtin_amdgcn_mfma_f32_32x32x16_bf16(av, b1, a1, 0, 0, 0); }
#pragma unroll
        for (int r = 0; r < 16; ++r) { float* yp = ydiag + (size_t)(tok0 + 32 * lt + crow(r, hi)) * D_SSM + h * 64 + r32; yp[0] = a0[r]; yp[32] = a1[r]; } }
    { f32x16 a[2][2] = {};
      for (int ks = 0; ks < 8; ++ks) { const int s0 = 16 * ks + 8 * hi;
          const f32x4 q0 = *(const LAS f32x4*)(wdec + s0), q1 = *(const LAS f32x4*)(wdec + s0 + 4);
          bf16x8 av[2];
#pragma unroll
          for (int pt = 0; pt < 2; ++pt) { float xf[8]; unpack8(*(const LAS bf16x8*)(XT + (32 * pt + r32) * SA_P + s0), xf);
              av[pt] = pack8((f32x4){xf[0] * q0[0], xf[1] * q0[1], xf[2] * q0[2], xf[3] * q0[3]}, (f32x4){xf[4] * q1[0], xf[5] * q1[1], xf[6] * q1[2], xf[7] * q1[3]}); }
#pragma unroll
          for (int nq = 0; nq < 2; ++nq) { const bf16x8 bv = *(const LAS bf16x8*)(BT + (32 * (2 * sub + nq) + r32) * SA_P + s0);
#pragma unroll
              for (int pt = 0; pt < 2; ++pt) a[pt][nq] = __builtin_amdgcn_mfma_f32_32x32x16_bf16(av[pt], bv, a[pt][nq], 0, 0, 0); } }
      float* sp = states + ((size_t)((b * NCHUNK + c) * SSM_H + h) * SSM_P) * SSM_N;
#pragma unroll
      for (int pt = 0; pt < 2; ++pt)
#pragma unroll
          for (int nq = 0; nq < 2; ++nq)
#pragma unroll
              for (int r = 0; r < 16; ++r) sp[(size_t)(32 * pt + crow(r, hi)) * SSM_N + 32 * (2 * sub + nq) + r32] = a[pt][nq][r]; }
    __syncthreads();
}
constexpr int N_SSD_A = NBATCH * NCHUNK * 2 * 2, N_IDX_U = 256;
__device__ __forceinline__ void p3_ssd(Frame& F) {
#pragma unroll 1
    for (int L = F.bid(); L < N_SSD_A; L += F.G()) { const int hf = L & 1, g = (L >> 1) & 1, c = (L >> 2) & 31, b = L >> 7; ssd_a_unit(F, b, c, g, hf); }
}
__device__ __forceinline__ void p3_idx(Frame& F) {
    int L = F.bid(); while (L < N_SSD_A) L += F.G();
#pragma unroll 1
    for (; L < N_SSD_A + N_IDX_U; L += F.G()) { const int p0 = L - N_SSD_A, b = p0 >> 7, par = p0 & 1, s = (p0 >> 1) & 63;
        idx_unit(F, b, 127 - s, par); idx_unit(F, b, s, par); }
}
__device__ __forceinline__ unsigned fkey(float f) { const unsigned u = __float_as_uint(f); return (u & 0x80000000u) ? ~u : (u | 0x80000000u); }
__device__ __forceinline__ void select_row(Frame& F, int row, LAS unsigned* hist, LAS unsigned* keys) {
    const float* sc = WSP(const float, WS_SCORES) + (size_t)row * SEQ; unsigned long long* mrow = WSP(unsigned long long, WS_MASK) + (size_t)row * 64;
    const int lane = F.lane(), t = row & (SEQ - 1);
    if (t < TOPK_SEL) {
        const int lo = 64 * lane; unsigned long long m;
        if (lo + 63 <= t) m = ~0ull; else if (lo > t) m = 0ull; else m = (1ull << (t - lo + 1)) - 1ull;
        mrow[lane] = m; return;
    }
    const int nI = (t >> 6) + 1;
    float amax = 0.f;
    const int n4 = (t >> 8) + 1;
#pragma unroll 8
    for (int i = 0; i < n4; ++i) { const int e0 = 256 * i + 4 * lane; const f32x4 v = *(const f32x4*)(sc + e0);
        u32x4 kb;
#pragma unroll
        for (int j = 0; j < 4; ++j) { const bool ok = (e0 + j <= t); kb[j] = ok ? __float_as_uint(v[j]) : 0u; amax = fmaxf(amax, ok ? fabsf(v[j]) : 0.f); }
        *(LAS u32x4*)(keys + e0) = kb; }
#pragma unroll
    for (int o = 1; o < 64; o <<= 1) amax = fmaxf(amax, __shfl_xor(amax, o));
    const float ks = 0.49f / fmaxf(amax, 1e-30f);
    unsigned prefix = 0u, need = TOPK_SEL, pmask = 0u, cnt_eq = 0u;
#pragma unroll 1
    for (int pass = 0; pass < 3; ++pass) { const int shift = (pass == 0) ? 15 : (pass == 1 ? 7 : 0); const unsigned dmask = (pass == 2) ? 127u : 255u;
        hist[4 * lane] = 0u; hist[4 * lane + 1] = 0u; hist[4 * lane + 2] = 0u; hist[4 * lane + 3] = 0u;
        LDS_WAIT(); asm volatile("" ::: "memory");
        if (pass == 0) {
#pragma unroll 1
            for (int i0 = 0; i0 < nI; i0 += 8) { unsigned kk[8];
#pragma unroll
                for (int j = 0; j < 8; ++j) { const int e = 64 * (i0 + j) + lane; kk[j] = keys[e & 4095]; }
#pragma unroll
                for (int j = 0; j < 8; ++j) { const int e = 64 * (i0 + j) + lane; kk[j] = (e <= t) ? (__float_as_uint(fmaf(__uint_as_float(kk[j]), ks, 1.5f)) & 0x7fffffu) : 0u; }
#pragma unroll
                for (int j = 0; j < 8; ++j) { const int e = 64 * (i0 + j) + lane; if (i0 + j < nI) keys[e] = kk[j];
                    if (kk[j] != 0u) __hip_atomic_fetch_add(hist + (kk[j] >> 15), 1u, __ATOMIC_RELAXED, __HIP_MEMORY_SCOPE_WORKGROUP); } }
        } else {
#pragma unroll 1
            for (int i0 = 0; i0 < nI; i0 += 8) { unsigned kk[8];
#pragma unroll
                for (int j = 0; j < 8; ++j) { const int e = 64 * (i0 + j) + lane; kk[j] = (i0 + j < nI) ? keys[e & 4095] : 0u; }
#pragma unroll
                for (int j = 0; j < 8; ++j) if ((kk[j] & pmask) == prefix && kk[j] != 0u) __hip_atomic_fetch_add(hist + ((kk[j] >> shift) & dmask), 1u, __ATOMIC_RELAXED, __HIP_MEMORY_SCOPE_WORKGROUP); }
        }
        LDS_WAIT(); asm volatile("" ::: "memory");
        const unsigned c0 = hist[4 * lane], c1 = hist[4 * lane + 1], c2 = hist[4 * lane + 2], c3 = hist[4 * lane + 3];
        const unsigned tot = c0 + c1 + c2 + c3;
        unsigned suf = tot;
#pragma unroll
        for (int o = 1; o < 64; o <<= 1) { const unsigned tt = __shfl_down(suf, o); if (lane + o < 64) suf += tt; }
        unsigned above = suf - tot;
        int found = -1; unsigned nneed = 0u, fcnt = 0u;
        if (above < need && need <= above + c3) { found = 3; nneed = need - above; fcnt = c3; }
        above += c3;
        if (found < 0 && above < need && need <= above + c2) { found = 2; nneed = need - above; fcnt = c2; }
        above += c2;
        if (found < 0 && above < need && need <= above + c1) { found = 1; nneed = need - above; fcnt = c1; }
        above += c1;
        if (found < 0 && above < need && need <= above + c0) { found = 0; nneed = need - above; fcnt = c0; }
        const unsigned long long bal = __ballot(found >= 0);
        const int src = (int)__builtin_ctzll(bal | (1ull << 63));
        const unsigned digit = (unsigned)__shfl(4 * lane + found, src);
        need = (unsigned)__shfl((int)nneed, src); cnt_eq = (unsigned)__shfl((int)fcnt, src);
        prefix |= digit << shift; pmask |= dmask << shift;
        LDS_WAIT(); asm volatile("" ::: "memory");
    }
    const bool all_eq = (cnt_eq == need);
    unsigned run = 0u; unsigned long long myword = 0ull;
    const unsigned long long lt_mask = (lane == 0) ? 0ull : (~0ull >> (64 - lane));
#pragma unroll 4
    for (int i = 0; i < nI; ++i) {
        const unsigned k = keys[64 * i + lane]; bool sel = k > prefix;
        if (all_eq) { sel = sel || (k == prefix); }
        else { const unsigned long long em = __ballot(k == prefix); if (k == prefix) sel = (run + (unsigned)__popcll(em & lt_mask)) < need; run += (unsigned)__popcll(em); }
        const unsigned long long wb = __ballot(sel);
        if (lane == i) myword = wb;
    }
    mrow[lane] = myword;
    LDS_WAIT(); asm volatile("" ::: "memory");
}
__device__ __forceinline__ void p4_select(Frame& F) {
    LAS unsigned* keys = (LAS unsigned*)(F.lds() + F.wave() * 16384); LAS unsigned* hist = (LAS unsigned*)(F.lds() + 131072 + F.wave() * 1024);
    const int gw = F.bid() * 8 + F.wave(), NGW = F.G() * 8;
    for (int pr = gw; pr < SEQ / 2; pr += NGW) {
#pragma unroll 1
        for (int b = 0; b < NBATCH; ++b) { select_row(F, b * SEQ + pr, hist, keys); select_row(F, b * SEQ + (SEQ - 1 - pr), hist, keys); }
    }
}
__device__ __forceinline__ void p4_scan(Frame& F) {
    const CAS float* states = (const CAS float*)(F.ws() + WS_STATES); bf16* hin = WSP(bf16, WS_HIN); const CAS float* csg = (const CAS float*)(F.ws() + WS_CS);
    const int gt = F.bid() * 512 + F.tid(), NGT = F.G() * 512;
    for (int q = gt; q < NBATCH * SSM_H * SSM_P * (SSM_N / 2); q += NGT) {
        const int n = 2 * (q & 63), p = (q >> 6) & 63, h = (q >> 12) & 15, b = q >> 16;
        float h0 = 0.f, h1 = 0.f;
#pragma unroll 8
        for (int c = 0; c < NCHUNK; ++c) {
            const size_t off = ((size_t)((b * NCHUNK + c) * SSM_H + h) * SSM_P + p) * SSM_N + n;
            *(unsigned*)(hin + off) = cvt_pk_bf16(h0, h1);
            const float dec = __expf(csg[(size_t)(b * SEQ + c * CHUNK + CHUNK - 1) * 16 + h]);
            const f32x2 st = *(const CAS f32x2*)(states + off);
            h0 = dec * h0 + st[0]; h1 = dec * h1 + st[1];
        }
    }
}
namespace att {
constexpr int KVBLK = 64, SHM_K = KVBLK * 128 * 2, SHM_V = SHM_K;
constexpr float SCALE = 0.08838834764831845f, THR = 8.f, C2 = 1.4426950408889634f * SCALE;
#define KSWZ(row, colB) ((row) * 256 + ((colB) ^ (((row) & 7) << 4)))
__device__ __forceinline__ int v_st(int k, int c) { const int kk = (k & ~0xC) | ((k & 4) << 1) | ((k & 8) >> 1); return ((kk >> 3) * 4 + (c >> 5)) * 512 + ((kk & 7) * 32 + (c & 31)) * 2; }
__device__ __forceinline__ int v_rd_base(int lane) { return ((lane & 3) << 3) | (((lane >> 2) & 3) << 6) | (((lane >> 4) & 1) << 5) | (((lane >> 5) & 1) << 8); }
constexpr int v_rd_off(int d0, int ks, int half) { return d0 * 512 + ks * 4096 + half * 2048; }
template <int KB>
__device__ __forceinline__ void qkt(f32x16& p0, f32x16& p1, LAS const char* K_lds, int r32, int hi, const bf16x8* qr) {
    p0 = f32x16{}; p1 = f32x16{};
    LAS const char* kb[4];
#pragma unroll
    for (int dd = 0; dd < 4; ++dd) kb[dd] = K_lds + KB * SHM_K + KSWZ(r32, (dd * 16 + hi * 8) * 2);
#pragma unroll
    for (int d0 = 0; d0 < 8; ++d0) { LAS const char* a = kb[d0 & 3] + (d0 >> 2) * 128;
        const bf16x8 b0 = *(LAS const bf16x8*)a;
        const bf16x8 b1 = *(LAS const bf16x8*)(a + 32 * 256);
        p0 = __builtin_amdgcn_mfma_f32_32x32x16_bf16(b0, qr[d0], p0, 0, 0, 0);
        p1 = __builtin_amdgcn_mfma_f32_32x32x16_bf16(b1, qr[d0], p1, 0, 0, 0); }
}
template <int VB>
__device__ __forceinline__ void pv_tile(f32x16* o, int vb0, bf16x8 pa0, bf16x8 pa1, bf16x8 pa2, bf16x8 pa3) {
#define TRRD(dst, off) asm volatile("ds_read_b64_tr_b16 %0, %1 offset:%2" : "=&v"(dst) : "v"(vb0), "i"(off) : "memory")
#define PV_D0(d0) do { s16x4 l0, l1, l2, l3, h0, h1, h2, h3; constexpr int b_ = VB * SHM_V + v_rd_off(d0, 0, 0); \
        TRRD(l0, b_); TRRD(h0, b_ + 2048); TRRD(l1, b_ + 4096); TRRD(h1, b_ + 6144); TRRD(l2, b_ + 8192); TRRD(h2, b_ + 10240); TRRD(l3, b_ + 12288); TRRD(h3, b_ + 14336); \
        asm volatile("s_waitcnt lgkmcnt(0)" ::: "memory"); __builtin_amdgcn_sched_barrier(0); \
        o[d0] = __builtin_amdgcn_mfma_f32_32x32x16_bf16(pa0, (bf16x8){l0[0], l0[1], l0[2], l0[3], h0[0], h0[1], h0[2], h0[3]}, o[d0], 0, 0, 0);   \
        o[d0] = __builtin_amdgcn_mfma_f32_32x32x16_bf16(pa1, (bf16x8){l1[0], l1[1], l1[2], l1[3], h1[0], h1[1], h1[2], h1[3]}, o[d0], 0, 0, 0);   \
        o[d0] = __builtin_amdgcn_mfma_f32_32x32x16_bf16(pa2, (bf16x8){l2[0], l2[1], l2[2], l2[3], h2[0], h2[1], h2[2], h2[3]}, o[d0], 0, 0, 0);   \
        o[d0] = __builtin_amdgcn_mfma_f32_32x32x16_bf16(pa3, (bf16x8){l3[0], l3[1], l3[2], l3[3], h3[0], h3[1], h3[2], h3[3]}, o[d0], 0, 0, 0); } while (0)
    PV_D0(0); PV_D0(1); PV_D0(2); PV_D0(3);
#undef PV_D0
#undef TRRD
}
__device__ __forceinline__ void softmax_tile(f32x16& p0, f32x16& p1, unsigned long long mw, int hi, float& m_reg, float& l_reg, float& alpha, bf16x8& pa0, bf16x8& pa1, bf16x8& pa2, bf16x8& pa3) {
    float pmax = p0[0];
#pragma unroll
    for (int r = 1; r < 16; ++r) pmax = fmaxf(pmax, p0[r]);
#pragma unroll
    for (int r = 0; r < 16; ++r) pmax = fmaxf(pmax, p1[r]);
    { auto rr = __builtin_amdgcn_permlane32_swap(__float_as_uint(pmax), __float_as_uint(pmax), false, false); pmax = fmaxf(__uint_as_float(rr[0]), __uint_as_float(rr[1])); }
    float mn;
    if (__all((pmax - m_reg) * SCALE <= THR)) { mn = m_reg; alpha = 1.f; }
    else { mn = fmaxf(m_reg, pmax); alpha = __builtin_amdgcn_exp2f((m_reg - mn) * C2); m_reg = mn; }
    const float mnL = -mn * C2;
    const int lo = (int)((unsigned)mw >> (4 * hi)), hh = (int)((unsigned)(mw >> 32) >> (4 * hi));
#pragma unroll
    for (int r = 0; r < 16; ++r) { const int c = (r & 3) + 8 * (r >> 2);
        const float e0 = __builtin_amdgcn_exp2f(fmaf(p0[r], C2, mnL)), e1 = __builtin_amdgcn_exp2f(fmaf(p1[r], C2, mnL));
        p0[r] = __uint_as_float(__float_as_uint(e0) & (unsigned)__builtin_amdgcn_sbfe(lo, c, 1));
        p1[r] = __uint_as_float(__float_as_uint(e1) & (unsigned)__builtin_amdgcn_sbfe(hh, c, 1)); }
    float ps = 0.f;
#pragma unroll
    for (int r = 0; r < 16; ++r) ps += p0[r];
#pragma unroll
    for (int r = 0; r < 16; ++r) ps += p1[r];
    { auto rr = __builtin_amdgcn_permlane32_swap(__float_as_uint(ps), __float_as_uint(ps), false, false); ps = __uint_as_float(rr[0]) + __uint_as_float(rr[1]); }
    l_reg = l_reg * alpha + ps;
#define PK4(P, B_, OUT) do { unsigned a0 = cvt_pk_bf16(P[B_+0], P[B_+1]), a1 = cvt_pk_bf16(P[B_+2], P[B_+3]); \
        unsigned b0 = cvt_pk_bf16(P[B_+4], P[B_+5]), b1 = cvt_pk_bf16(P[B_+6], P[B_+7]); \
        auto r0 = __builtin_amdgcn_permlane32_swap(a0, b0, false, false); auto r1 = __builtin_amdgcn_permlane32_swap(a1, b1, false, false); \
        u32x4 w = {r0[0], r1[0], r0[1], r1[1]}; OUT = __builtin_bit_cast(bf16x8, w); } while (0)
    PK4(p0, 0, pa0); PK4(p0, 8, pa1); PK4(p1, 0, pa2); PK4(p1, 8, pa3);
#undef PK4
}
}

__device__ __forceinline__ void attn_item(Frame& F, int b, int h, int X) {
    using namespace att;
    const bf16* qg = WSP(const bf16, WS_Q); const bf16* kg = WSP(const bf16, WS_K) + (size_t)(b * SEQ) * 1024 + h * 128; const bf16* vg = WSP(const bf16, WS_V) + (size_t)(b * SEQ) * 1024 + h * 128;
    const unsigned long long* maskg = WSP(const unsigned long long, WS_MASK); bf16* ycat = WSP(bf16, WS_YCAT);
    const int tid = F.tid(), wid = F.wave(), lane = F.lane(), r32 = lane & 31, hi = lane >> 5;
    LAS char* V_lds = (LAS char*)F.lds(); LAS char* K_lds = V_lds + 2 * SHM_V;
    LAS float* wsl = (LAS float*)(F.lds() + 2 * SHM_V + 2 * SHM_K) + wid * 64; LAS float* li_l = wsl; LAS float* al_l = wsl + 32;
    const int tokq = b * SEQ + X * 256 + wid * 32 + r32, NT = 4 * X + 4;
    bf16x8 qr[8];
#pragma unroll
    for (int d0 = 0; d0 < 8; ++d0) qr[d0] = *(const bf16x8*)(qg + (size_t)tokq * 1024 + h * 128 + d0 * 16 + hi * 8);
    const unsigned long long* mrow = maskg + (size_t)tokq * 64;
    const int sr = tid >> 4, sc = (tid & 15) * 8, vst0 = v_st(sr, sc), vst1 = v_st(32 + sr, sc), kws = KSWZ(sr, sc * 2);
    const int vb0 = (int)(unsigned)(uintptr_t)V_lds + v_rd_base(lane);
    float m_reg = -1e30f, l_reg = 0.f; f32x16 o[4] = {};
    bf16x8 st_k0, st_k1, st_v0, st_v1;
#define ALOAD(t) do { const size_t r0_ = (size_t)((t) * KVBLK + sr) * 1024 + sc; st_k0 = *(const bf16x8*)(kg + r0_); st_k1 = *(const bf16x8*)(kg + r0_ + 32 * 1024); \
                      st_v0 = *(const bf16x8*)(vg + r0_); st_v1 = *(const bf16x8*)(vg + r0_ + 32 * 1024); } while (0)
#define AWRITE(bf) do { *(LAS bf16x8*)(K_lds + (bf) * SHM_K + kws) = st_k0; *(LAS bf16x8*)(K_lds + (bf) * SHM_K + kws + 32 * 256) = st_k1; \
                        *(LAS bf16x8*)(V_lds + (bf) * SHM_V + vst0) = st_v0; *(LAS bf16x8*)(V_lds + (bf) * SHM_V + vst1) = st_v1; } while (0)
#define ASTEP(t, KB) do { AWRITE(KB); __syncthreads(); \
        const unsigned long long mw_ = mrow[(t)]; if ((t) + 1 < NT) ALOAD((t) + 1); \
        f32x16 p0, p1; float alpha; bf16x8 pa0, pa1, pa2, pa3; \
        qkt<KB>(p0, p1, K_lds, r32, hi, qr); \
        softmax_tile(p0, p1, mw_, hi, m_reg, l_reg, alpha, pa0, pa1, pa2, pa3); \
        if (__any(alpha < 1.f)) { if (hi == 0) al_l[r32] = alpha; LDS_WAIT(); \
            _Pragma("unroll") for (int d_ = 0; d_ < 4; ++d_) _Pragma("unroll") for (int r = 0; r < 16; ++r) o[d_][r] *= al_l[crow(r, hi)]; } \
        pv_tile<KB>(o, vb0, pa0, pa1, pa2, pa3); } while (0)
    ALOAD(0);
    for (int t = 0; t < NT; t += 2) { ASTEP(t, 0); ASTEP(t + 1, 1); }
#undef ASTEP
#undef AWRITE
#undef ALOAD
    if (hi == 0) li_l[r32] = l_reg; LDS_WAIT();
    float rli[16];
#pragma unroll
    for (int r = 0; r < 16; ++r) rli[r] = __builtin_amdgcn_rcpf(li_l[crow(r, hi)]);
    bf16* Ow = ycat + (size_t)(b * SEQ + X * 256 + wid * 32) * DM + D_SSM + h * 128;
#pragma unroll
    for (int r = 0; r < 16; ++r) { const int orow = crow(r, hi);
#pragma unroll
        for (int d0 = 0; d0 < 4; ++d0) { const float v = o[d0][r] * rli[r]; const float vn = __shfl_xor(v, 1);
            if ((r32 & 1) == 0) *(unsigned*)(Ow + (size_t)orow * DM + d0 * 32 + r32) = cvt_pk_bf16(v, vn); } }
    __syncthreads();
}

__device__ __forceinline__ void ssd_c_unit(Frame& F, int b, int c, int lq) {
    const bf16* xact = WSP(const bf16, WS_XBCACT); const bf16* hin = WSP(const bf16, WS_HIN); const float* csg = WSP(const float, WS_CS); const float* ydiag = WSP(const float, WS_YDIAG);
    const bf16* zg = WSP(const bf16, WS_Z); bf16* ycat = WSP(bf16, WS_YCAT);
    LAS float* gb = (LAS float*)F.lds();
    const int lane = F.lane(), r32 = lane & 31, hi = lane >> 5, w = F.wave(), g = w >> 2;
    const int tok0 = b * SEQ + c * CHUNK + lq * 32;
    bf16x8 Af[8];
#pragma unroll
    for (int ks = 0; ks < 8; ++ks) Af[ks] = *(const bf16x8*)(xact + (size_t)(tok0 + r32) * CONV_CH + 1280 + g * 128 + 16 * ks + 8 * hi);
#pragma unroll
    for (int hh = 0; hh < 2; ++hh) { const int h = 2 * w + hh;
        const bf16* hp = hin + ((size_t)((b * NCHUNK + c) * SSM_H + h) * SSM_P) * SSM_N;
        f32x16 a0 = {}, a1 = {};
#pragma unroll
        for (int ks = 0; ks < 8; ++ks) { const bf16x8 b0 = *(const bf16x8*)(hp + (size_t)r32 * SSM_N + 16 * ks + 8 * hi), b1 = *(const bf16x8*)(hp + (size_t)(32 + r32) * SSM_N + 16 * ks + 8 * hi);
            a0 = __builtin_amdgcn_mfma_f32_32x32x16_bf16(Af[ks], b0, a0, 0, 0, 0); a1 = __builtin_amdgcn_mfma_f32_32x32x16_bf16(Af[ks], b1, a1, 0, 0, 0); }
        const float dsk = F.f(10)[h];
#pragma unroll
        for (int r = 0; r < 16; ++r) { const int l = crow(r, hi); const size_t tok = (size_t)(tok0 + l);
            const float e = __expf(csg[tok * 16 + h]);
#pragma unroll
            for (int pt = 0; pt < 2; ++pt) { const int col = h * 64 + 32 * pt + r32;
                const float y = ydiag[tok * D_SSM + col] + e * (pt ? a1[r] : a0[r]) + dsk * bf2f(xact[tok * CONV_CH + col]);
                gb[l * 1024 + col] = y * silu_f(bf2f(zg[tok * 1024 + col])); } } }
    __syncthreads();
#pragma unroll
    for (int rr = 0; rr < 4; ++rr) { const int l = 4 * w + rr; float ss = 0.f; f32x4 v[4];
#pragma unroll
        for (int j = 0; j < 4; ++j) { v[j] = *(const LAS f32x4*)(gb + l * 1024 + j * 256 + lane * 4); ss += v[j][0] * v[j][0] + v[j][1] * v[j][1] + v[j][2] * v[j][2] + v[j][3] * v[j][3]; }
        const float rs = 1.0f / sqrtf(wave_sum(ss) * (1.0f / 1024.0f) + LN_EPS);
#pragma unroll
        for (int j = 0; j < 4; ++j) { const f32x4 nw = *(const CAS f32x4*)(F.f(11) + j * 256 + lane * 4); const f32x4 y = v[j] * rs * nw;
            u32x2 o = {cvt_pk_bf16(y[0], y[1]), cvt_pk_bf16(y[2], y[3])};
            *(u32x2*)(ycat + (size_t)(tok0 + l) * DM + j * 256 + lane * 4) = o; } }
    __syncthreads();
}
__device__ __forceinline__ void p5_phase(Frame& F) {
    for (int L = F.bid(); L < 256; L += F.G()) { const int lq = L & 3, c = (L >> 2) & 31, b = L >> 7; ssd_c_unit(F, b, c, lq); }
    for (int L = F.bid(); L < 256; L += F.G()) { const int X = 15 - (L >> 4), h = L & 7, b = (L >> 3) & 1; attn_item(F, b, h, X); }
}
struct EpiOutProj {
    static constexpr bool PERM = false;
    const CAS float* x; const CAS float* modf; float* out;
    __device__ __forceinline__ void operator()(const f32x4 (&acc)[2][2][4][2], const pg8::Unit& u, int wr, int wc, int fr, int fq) const {
        const int row0 = u.pm * 256 + wr * 64 + fr, col0 = u.pn * 256 + wc * 32 + 4 * fq; const int b = (u.pm * 256) / SEQ;
        f32x4 gv[2][2];
#pragma unroll
        for (int bj = 0; bj < 2; ++bj)
#pragma unroll
            for (int n = 0; n < 2; ++n) gv[bj][n] = *(const CAS f32x4*)(modf + (size_t)b * (6 * DM) + 2 * DM + col0 + bj * 128 + n * 16);
#pragma unroll
        for (int ai = 0; ai < 2; ++ai)
#pragma unroll
            for (int m = 0; m < 4; ++m) { const size_t off = (size_t)(row0 + ai * 128 + m * 16) * DM + col0;
#pragma unroll
                for (int bj = 0; bj < 2; ++bj)
#pragma unroll
                    for (int n = 0; n < 2; ++n) { const f32x4 xv = *(const CAS f32x4*)(x + off + bj * 128 + n * 16);
                        *(f32x4*)(out + off + bj * 128 + n * 16) = xv * ALPHA_DN + gv[bj][n] * acc[ai][bj][m][n]; } }
    }
};

constexpr int RT_P = 2056;
__device__ __forceinline__ void p7_unit(Frame& F, int un) {
    const CAS float* modf = (const CAS float*)(F.ws() + WS_MODF); bf16* u2 = WSP(bf16, WS_U2); const CAS bf16* wr_hi = (const CAS bf16*)(F.ws() + WS_WR); const CAS bf16* wr_lo = wr_hi + NE * DM;
    int* inv = WSP(int, WS_INV); int* ltok = WSP(int, WS_LTOK); float* lw = WSP(float, WS_LW);
    LAS bf16* Ah = (LAS bf16*)F.lds(); LAS bf16* Al = Ah + 16 * RT_P; LAS float* red = (LAS float*)F.lds();
    LAS float* logit = (LAS float*)(F.lds() + 135168);
    const int lane = F.lane(), w = F.wave(), row0 = un * 16, b = row0 / SEQ;
    const CAS float* sh2 = modf + (size_t)b * (6 * DM) + 3 * DM; const CAS float* sc2 = modf + (size_t)b * (6 * DM) + 4 * DM;
    PSUB(70, 0); PSUB(71, 0);
#pragma unroll 1
    for (int rr = 0; rr < 2; ++rr) { const int rl = 2 * w + rr; const size_t row = (size_t)(row0 + rl);
        f32x4 v[8]; float s = 0.f;
#pragma unroll
        for (int j = 0; j < 8; ++j) { v[j] = *(const f32x4*)(F.out() + row * DM + j * 256 + lane * 4); s += (v[j][0] + v[j][1]) + (v[j][2] + v[j][3]); }
        const float mu = wave_sum(s) * (1.0f / DM); float q = 0.f;
#pragma unroll
        for (int j = 0; j < 8; ++j) { v[j] = v[j] - mu; q += (v[j][0] * v[j][0] + v[j][1] * v[j][1]) + (v[j][2] * v[j][2] + v[j][3] * v[j][3]); }
        const float rstd = 1.0f / sqrtf(wave_sum(q) * (1.0f / DM) + LN_EPS);
#pragma unroll
        for (int j = 0; j < 8; ++j) { const int col = j * 256 + lane * 4;
            const f32x4 x1 = v[j] * rstd * *(const CAS f32x4*)(F.f(15) + col) + *(const CAS f32x4*)(F.f(16) + col);
            *(f32x4*)(F.out() + row * DM + col) = x1;
            const f32x4 uu = x1 * (*(const CAS f32x4*)(sc2 + col) + 1.0f) + *(const CAS f32x4*)(sh2 + col);
            const unsigned h0 = cvt_pk_bf16(uu[0], uu[1]), h1 = cvt_pk_bf16(uu[2], uu[3]);
            *(u32x2*)(u2 + row * DM + col) = (u32x2){h0, h1};
            const unsigned l0 = cvt_pk_bf16(uu[0] - bflo(h0), uu[1] - bfhi(h0)), l1 = cvt_pk_bf16(uu[2] - bflo(h1), uu[3] - bfhi(h1));
            *(LAS u32x2*)(Ah + rl * RT_P + col) = (u32x2){h0, h1}; *(LAS u32x2*)(Al + rl * RT_P + col) = (u32x2){l0, l1}; } }
    __syncthreads();
    PSUB(70, 1); PSUB(72, 0);
    f32x4 acc[4] = {};
    { const int fr = lane & 15, fq = lane >> 4;
      bf16x8 bhA[4], blA[4], bhB[4], blB[4];
#define RT_LOADB(dh, dl, ks_) do { const int k0_ = w * 256 + (ks_) * 32 + fq * 8; _Pragma("unroll") for (int nt = 0; nt < 4; ++nt) { \
          dh[nt] = *(const CAS bf16x8*)(wr_hi + (size_t)(16 * nt + fr) * DM + k0_); dl[nt] = *(const CAS bf16x8*)(wr_lo + (size_t)(16 * nt + fr) * DM + k0_); } } while (0)
#define RT_STEP(sh_, sl_, ks_) do { const int k0_ = w * 256 + (ks_) * 32 + fq * 8; \
          const bf16x8 ah = *(const LAS bf16x8*)(Ah + fr * RT_P + k0_), al = *(const LAS bf16x8*)(Al + fr * RT_P + k0_); \
          _Pragma("unroll") for (int nt = 0; nt < 4; ++nt) { acc[nt] = __builtin_amdgcn_mfma_f32_16x16x32_bf16(ah, sh_[nt], acc[nt], 0, 0, 0); \
              acc[nt] = __builtin_amdgcn_mfma_f32_16x16x32_bf16(al, sh_[nt], acc[nt], 0, 0, 0); acc[nt] = __builtin_amdgcn_mfma_f32_16x16x32_bf16(ah, sl_[nt], acc[nt], 0, 0, 0); } } while (0)
      RT_LOADB(bhA, blA, 0);
#pragma unroll
      for (int ks = 0; ks < 8; ks += 2) { RT_LOADB(bhB, blB, ks + 1); RT_STEP(bhA, blA, ks); if (ks + 2 < 8) RT_LOADB(bhA, blA, ks + 2); RT_STEP(bhB, blB, ks + 1); }
#undef RT_LOADB
#undef RT_STEP
      __syncthreads();
#pragma unroll
      for (int nt = 0; nt < 4; ++nt)
#pragma unroll
          for (int r = 0; r < 4; ++r) red[(w * 16 + fq * 4 + r) * 64 + 16 * nt + fr] = acc[nt][r]; }
    __syncthreads();
#pragma unroll
    for (int i = 0; i < 2; ++i) { const int o = F.tid() + 512 * i; float s = 0.f;
#pragma unroll
        for (int ww = 0; ww < 8; ++ww) s += red[ww * 1024 + o];
        logit[o] = s; }
    __syncthreads();
    PSUB(72, 1); PSUB(73, 0);
    float score_[2]; int erank_[2]; bool sel_[2];
#pragma unroll
    for (int rr = 0; rr < 2; ++rr) { const int rl = 2 * w + rr;
        const float score = sigmoid_f(logit[rl * 64 + lane]); const float biased = score + F.f(18)[lane];
        float m1 = biased;
#pragma unroll
        for (int o = 1; o < 8; o <<= 1) m1 = fmaxf(m1, __shfl_xor(m1, o));
        int i1 = (biased == m1) ? lane : 64;
#pragma unroll
        for (int o = 1; o < 8; o <<= 1) i1 = min(i1, __shfl_xor(i1, o));
        float m2 = (lane == i1) ? -__builtin_inff() : biased;
#pragma unroll
        for (int o = 1; o < 8; o <<= 1) m2 = fmaxf(m2, __shfl_xor(m2, o));
        const float gs = m1 + m2; const int grp = lane >> 3;
        int grank = 0;
#pragma unroll
        for (int g2 = 0; g2 < 8; ++g2) { const float og = __int_as_float(__builtin_amdgcn_readlane(__float_as_int(gs), 8 * g2)); grank += (og > gs || (og == gs && g2 < grp)) ? 1 : 0; }
        const float mk = (grank < 4) ? biased : -__builtin_inff();
        int erank = 0;
#pragma unroll 8
        for (int e2 = 0; e2 < 64; ++e2) { const float oe = __int_as_float(__builtin_amdgcn_readlane(__float_as_int(mk), e2)); erank += (oe > mk || (oe == mk && e2 < lane)) ? 1 : 0; }
        score_[rr] = score; erank_[rr] = erank; sel_[rr] = erank < 8; }
#pragma unroll
    for (int rr = 0; rr < 2; ++rr) { const int tok = row0 + 2 * w + rr;
        const float wsum = wave_sum(sel_[rr] ? score_[rr] : 0.f);
        if (sel_[rr]) { const float gw = score_[rr] / wsum * 2.5f;
            const int rk = (int)__hip_atomic_fetch_add(F.ctl() + CW_ECNT + 64 * lane, 1u, RLX_AGENT);
            ltok[lane * NTOK + rk] = tok; lw[lane * NTOK + rk] = gw; inv[tok * 8 + erank_[rr]] = lane * NTOK + rk; } }
    __syncthreads();
    PSUB(73, 1); PSUB(71, 1);
}
__device__ __forceinline__ void p7_phase(Frame& F) { for (int un = F.bid(); un < NTOK / 16; un += F.G()) p7_unit(F, un); }
struct MoeOrder {
    const LAS int* tab; const int* ltok; int G, c, npn;
    __device__ __forceinline__ bool next(int i, pg8::Unit& u) const {
        const int L = i * G + c; const int total = tab[80 + NEX] * npn; if (L >= total) return false;
        int e = 0;
        for (int k = 1; k < NEX; ++k) e += (tab[80 + k] * npn <= L) ? 1 : 0;
        const int nte = tab[80 + e + 1] - tab[80 + e], rem = L - tab[80 + e] * npn;
        const int mt = (npn == 8) ? rem / npn : rem % nte, pn = (npn == 8) ? rem % npn : rem / nte;
        u.pm = tab[80 + e] + mt; u.pn = e * npn + pn; u.ax = (e << 8) | mt; return true;
    }
    __device__ __forceinline__ int row_tok(const pg8::Unit& u, int r) const {
        const int e = u.ax >> 8, idx = (u.ax & 255) * 256 + r;
        if (e == NE) return idx;
        return idx < tab[e] ? ltok[e * NTOK + idx] : 0;
    }
};
__device__ __forceinline__ void moe_tables(Frame& F) {
    LAS int* tab = (LAS int*)(F.lds() + LDS_MISC + 64);
    if (F.tid() == 0) { int cum = 0;
        for (int e = 0; e < NE; ++e) { const int cn = (int)__hip_atomic_load(F.ctl() + CW_ECNT + 64 * e, RLX_AGENT); tab[e] = cn; tab[80 + e] = cum; cum += (cn + 255) >> 8; }
        tab[NE] = NTOK; tab[80 + NE] = cum; cum += NTOK / 256; tab[80 + NEX] = cum; }
    __syncthreads();
}
struct EpiGateUp {
    static constexpr bool PERM = true;
    bf16* hid; const CAS float* lw; const LAS int* tab;
    __device__ __forceinline__ void operator()(const f32x4 (&acc)[2][2][4][2], const pg8::Unit& u, int wr, int wc, int fr, int fq) const {
        const int e = u.ax >> 8, mt = u.ax & 255, pn = u.pn & 3; const int cnt = tab[e];
#pragma unroll
        for (int ai = 0; ai < 2; ++ai)
#pragma unroll
            for (int m = 0; m < 4; ++m) { const int rl = ai * 128 + wr * 64 + m * 16 + fr, idx = mt * 256 + rl;
                const float gw = (e == NE) ? 1.0f : (idx < cnt ? lw[e * NTOK + idx] : 0.0f);
                f32x4 h0, h1;
#pragma unroll
                for (int i = 0; i < 4; ++i) { h0[i] = silu_f(acc[ai][0][m][0][i]) * acc[ai][1][m][0][i] * gw; h1[i] = silu_f(acc[ai][0][m][1][i]) * acc[ai][1][m][1][i] * gw; }
                u32x4 w = {cvt_pk_bf16(h0[0], h0[1]), cvt_pk_bf16(h0[2], h0[3]), cvt_pk_bf16(h1[0], h1[1]), cvt_pk_bf16(h1[2], h1[3])};
                *(u32x4*)(hid + (size_t)(u.pm * 256 + rl) * DE + pn * 128 + wc * 32 + 8 * fq) = w; }
    }
};
struct EpiDown {
    static constexpr bool PERM = true;
    bf16* outs;
    __device__ __forceinline__ void operator()(const f32x4 (&acc)[2][2][4][2], const pg8::Unit& u, int wr, int wc, int fr, int fq) const {
        const int pn = u.pn & 7;
#pragma unroll
        for (int ai = 0; ai < 2; ++ai)
#pragma unroll
            for (int m = 0; m < 4; ++m) { bf16* rowp = outs + (size_t)(u.pm * 256 + ai * 128 + wr * 64 + m * 16 + fr) * DM + pn * 256 + wc * 32 + 8 * fq;
#pragma unroll
                for (int bj = 0; bj < 2; ++bj) { const f32x4 v0 = acc[ai][bj][m][0], v1 = acc[ai][bj][m][1];
                    u32x4 w = {cvt_pk_bf16(v0[0], v0[1]), cvt_pk_bf16(v0[2], v0[3]), cvt_pk_bf16(v1[0], v1[1]), cvt_pk_bf16(v1[2], v1[3])};
                    *(u32x4*)(rowp + bj * 128) = w; } }
    }
};
__device__ __forceinline__ void p10_final(Frame& F) {
    const CAS float* modf = (const CAS float*)(F.ws() + WS_MODF); const CAS bf16* outs = (const CAS bf16*)(F.ws() + WS_OUTS); const CAS int* inv = (const CAS int*)(F.ws() + WS_INV);
    const LAS int* tab = (const LAS int*)(F.lds() + LDS_MISC + 64);
    const int gw = F.bid() * 8 + F.wave(), NGW = F.G() * 8;
    for (int tok = gw; tok < NTOK; tok += NGW) { int lane = F.lane(); asm volatile("" : "+v"(lane)); const int b = tok / SEQ; const CAS float* g2 = modf + (size_t)b * (6 * DM) + 5 * DM;
        size_t rows[9];
#pragma unroll
        for (int k = 0; k < 8; ++k) { const int iv = inv[tok * 8 + k]; const int e = iv / NTOK, rk = iv % NTOK; rows[k] = (size_t)(tab[80 + e] * 256 + rk); }
        rows[8] = (size_t)(tab[80 + NE] * 256 + tok);
        f32x4 v[8]; float s = 0.f;
#pragma unroll
        for (int jj = 0; jj < 4; ++jj) { const int col = jj * 512 + lane * 8; f32x4 f0 = {0.f, 0.f, 0.f, 0.f}, f1 = {0.f, 0.f, 0.f, 0.f};
#pragma unroll
            for (int k = 0; k < 9; ++k) { const u32x4 w = *(const CAS u32x4*)(outs + rows[k] * DM + col);
                f0[0] += bflo(w[0]); f0[1] += bfhi(w[0]); f0[2] += bflo(w[1]); f0[3] += bfhi(w[1]); f1[0] += bflo(w[2]); f1[1] += bfhi(w[2]); f1[2] += bflo(w[3]); f1[3] += bfhi(w[3]); }
            const f32x4 xa = *(const f32x4*)(F.out() + (size_t)tok * DM + col), xb = *(const f32x4*)(F.out() + (size_t)tok * DM + col + 4);
            v[2 * jj] = xa * ALPHA_DN + *(const CAS f32x4*)(g2 + col) * f0; v[2 * jj + 1] = xb * ALPHA_DN + *(const CAS f32x4*)(g2 + col + 4) * f1;
            s += (v[2 * jj][0] + v[2 * jj][1]) + (v[2 * jj][2] + v[2 * jj][3]) + (v[2 * jj + 1][0] + v[2 * jj + 1][1]) + (v[2 * jj + 1][2] + v[2 * jj + 1][3]); }
        const float mu = wave_sum(s) * (1.0f / DM); float q = 0.f;
#pragma unroll
        for (int j = 0; j < 8; ++j) { v[j] = v[j] - mu; q += (v[j][0] * v[j][0] + v[j][1] * v[j][1]) + (v[j][2] * v[j][2] + v[j][3] * v[j][3]); }
        const float rstd = 1.0f / sqrtf(wave_sum(q) * (1.0f / DM) + LN_EPS);
#pragma unroll
        for (int j = 0; j < 8; ++j) { const int col = (j >> 1) * 512 + lane * 8 + (j & 1) * 4;
            *(f32x4*)(F.out() + (size_t)tok * DM + col) = v[j] * rstd * *(const CAS f32x4*)(F.f(25) + col) + *(const CAS f32x4*)(F.f(26) + col); } }
}
#ifndef MK_N_LAUNCHES
#define MK_N_LAUNCHES 1
#endif
constexpr int N_PHASES = 11;
__global__ void __launch_bounds__(512, 2) fwd_kernel(Args args) {
    Frame F; F.ap = &args;
    if (F.tid() < 16) ((LAS unsigned*)(F.lds() + LDS_MISC))[F.tid()] = 0u;
    __syncthreads();
    if (args.ph_hi - args.ph_lo > 1) (void)xcd_barrier_post((unsigned*)(F.ctl() + CW_BAR), (volatile LAS unsigned*)(F.lds() + LDS_MISC));
#ifndef PH_MASK
#define PH_MASK 0x7ff
#endif
#define IN(k) (((PH_MASK >> (k)) & 1) && args.ph_lo <= (k) && (k) < args.ph_hi)
#ifdef PROBE_PHASE
    unsigned long long pt0_ = __builtin_amdgcn_s_memrealtime(), pt1_ = 0ull;
#ifdef PROBE_SUB
#define PMARK(k) do { } while (0)
#else
#define PMARK(k) do { if ((k) + 1 == PROBE_PHASE) pt0_ = __builtin_amdgcn_s_memrealtime(); if ((k) == PROBE_PHASE) pt1_ = __builtin_amdgcn_s_memrealtime(); } while (0)
#endif
#else
#define PMARK(k) do { } while (0)
#endif
#define SEAM(k) do { if (IN(k) && IN((k) + 1)) { XcdBarrier bar_; bar_.bar = (unsigned*)(F.ctl() + CW_BAR); bar_.x = xb_xcc_id(); bar_.st = (volatile LAS unsigned*)(F.lds() + LDS_MISC); xcd_barrier(bar_); } } while (0)
    if (IN(0)) { p0_prologue(F); } SEAM(0); PMARK(0);
    if (IN(1)) { p1_modulate(F); } SEAM(1); PMARK(1);
    if (IN(2)) {
        pg8::Gemm g{WSP(const bf16, WS_U1), WSP(const bf16, WS_WIN), DM, 20}; pg8::StaticOrder S; S.init(NTOK, NPROJ_PAD, F.G(), F.bid());
        EpiInProj E{F.ws(), F.f(8), F.f(12), F.f(13)};
        pg8::gemm_phase<EpiInProj, pg8::StaticOrder, false>(F.lds(), g, S, E);
        slack_fill(F, (F.bid() + 3 * F.G() < 32 * NPROJ_TILES) ? 0 : 8, false, Q_ALL);
    } SEAM(2); PMARK(2);
    if (IN(3)) {
        PSUB(3, 0); p3_ssd(F); PSUB(3, 1); PSUB(30, 0); p3_idx(F); PSUB(30, 1);
    } SEAM(3); PMARK(3);
    if (IN(4)) { PSUB(40, 0); p4_select(F); PSUB(40, 1); PSUB(41, 0); p4_scan(F); PSUB(41, 1); } SEAM(4); PMARK(4);
    if (IN(5)) { p5_phase(F); slack_fill(F, (F.G() == 256) ? ((F.bid() >> 4) * 3) / 2 : 0, false, Q_ALL); } SEAM(5); PMARK(5);
    if (IN(6)) {
        pg8::Gemm g{WSP(const bf16, WS_YCAT), WSP(const bf16, WS_WOUT), DM, 60}; pg8::StaticOrder S; S.init(NTOK, DM, F.G(), F.bid());
        EpiOutProj E{F.f(0), (const CAS float*)(F.ws() + WS_MODF), F.out()};
        pg8::gemm_phase<EpiOutProj, pg8::StaticOrder, false>(F.lds(), g, S, E);
    } SEAM(6); PMARK(6);
    if (IN(7)) { p7_phase(F); slack_fill(F, 0, true, Q_GU); } SEAM(7); PMARK(7);
    if (IN(8)) {
        const int vcu = (F.G() % 8 == 0) ? (F.bid() % 8) * (F.G() / 8) + F.bid() / 8 : F.bid();
        moe_tables(F);
        const LAS int* tab = (const LAS int*)(F.lds() + LDS_MISC + 64);
        pg8::Gemm g{WSP(const bf16, WS_U2), WSP(const bf16, WS_WGU), DM, 80}; MoeOrder S{tab, WSP(const int, WS_LTOK), F.G(), vcu, 4};
        EpiGateUp E{WSP(bf16, WS_HID), (const CAS float*)(F.ws() + WS_LW), tab};
        pg8::gemm_phase<EpiGateUp, MoeOrder, true>(F.lds(), g, S, E);
        slack_fill(F, 0, true, Q_ALL);
    } SEAM(8); PMARK(8);
    if (IN(9)) {
        const int vcu = (F.G() % 8 == 0) ? (F.bid() % 8) * (F.G() / 8) + F.bid() / 8 : F.bid();
        moe_tables(F);
        const LAS int* tab = (const LAS int*)(F.lds() + LDS_MISC + 64);
        pg8::Gemm g{WSP(const bf16, WS_HID), WSP(const bf16, WS_WDN), DE, 90}; MoeOrder S{tab, WSP(const int, WS_LTOK), F.G(), vcu, 8};
        EpiDown E{WSP(bf16, WS_OUTS)};
        pg8::gemm_phase<EpiDown, MoeOrder, false>(F.lds(), g, S, E);
    } SEAM(9); PMARK(9);
    if (IN(10)) { moe_tables(F); p10_final(F); }
#ifdef PROBE_PHASE
    if (pt1_ == 0ull) pt1_ = __builtin_amdgcn_s_memrealtime();
#ifdef PROBE_SUB
    __syncthreads(); pt0_ = *(volatile LAS unsigned long long*)(F.lds() + LDS_MISC + 32); pt1_ = *(volatile LAS unsigned long long*)(F.lds() + LDS_MISC + 40);
#endif
    if (F.bid() == 0) { const unsigned long long w = 8ull * (pt1_ - pt0_), te = __builtin_amdgcn_s_memrealtime(); while (__builtin_amdgcn_s_memrealtime() - te < w) __builtin_amdgcn_s_sleep(32); }
#endif
#ifdef DBG_OFF
    if (args.ph_hi == N_PHASES) {
        const size_t n = (size_t)NTOK * DM; float* o = F.out();
        for (size_t i = (size_t)F.bid() * 512 + F.tid(); i < n; i += (size_t)F.G() * 512) {
            float v;
            if (DBG_KIND == 0) v = bf2f(((const bf16*)(F.ws() + (size_t)(DBG_OFF)))[i % (size_t)(DBG_N)]);
            else v = ((const float*)(F.ws() + (size_t)(DBG_OFF)))[i % (size_t)(DBG_N)];
            if (!(fabsf(v) < 1e30f)) v = 1e30f;
            o[i] = v; }
    }
#endif
#undef IN
#undef SEAM
#undef PMARK
}

extern "C" void kernel_launch(void* const* d_in, const int* in_sizes, int n_in, void* d_out, int out_size, void* d_ws, size_t ws_size, hipStream_t stream) {
    static int grid = 0;
    if (grid == 0) {
        if (n_in != 27 || out_size != NTOK * DM || ws_size < WS_END) { fprintf(stderr, "kernel_launch: unexpected shapes (n_in %d, out %d, ws %zu; need ws >= %zu)\n", n_in, out_size, ws_size, (size_t)WS_END); }
        int dev = 0, cus = 0, per_cu = 0;
        if (hipGetDevice(&dev) != hipSuccess || hipDeviceGetAttribute(&cus, hipDeviceAttributeMultiprocessorCount, dev) != hipSuccess) { grid = -1; return; }
        if (hipFuncSetAttribute((const void*)fwd_kernel, hipFuncAttributeMaxDynamicSharedMemorySize, LDS_BYTES) != hipSuccess) { fprintf(stderr, "kernel_launch: hipFuncSetAttribute failed\n"); grid = -1; return; }
        if (hipOccupancyMaxActiveBlocksPerMultiprocessor(&per_cu, (const void*)fwd_kernel, 512, LDS_BYTES) != hipSuccess || per_cu < 1) fprintf(stderr, "kernel_launch: occupancy query reports %d\n", per_cu);
        (void)hipGetLastError();
        grid = cus;
    }
    if (grid < 0) return;
    (void)hipMemsetAsync((char*)d_ws + WS_CTL, 0, CTL_ZERO_BYTES, stream);
    Args a{};
    for (int i = 0; i < 27; ++i) a.in[i] = d_in[i];
    a.out = (float*)d_out; a.ws = (unsigned char*)d_ws;
#if MK_N_LAUNCHES == 1
    a.ph_lo = 0; a.ph_hi = N_PHASES;
    hipLaunchKernelGGL(fwd_kernel, dim3(grid), dim3(512), LDS_BYTES, stream, a);
#else
    for (int p = 0; p < N_PHASES; ++p) { a.ph_lo = p; a.ph_hi = p + 1; hipLaunchKernelGGL(fwd_kernel, dim3(grid), dim3(512), LDS_BYTES, stream, a);
#ifdef DUP_PHASE
        if (p == DUP_PHASE) hipLaunchKernelGGL(fwd_kernel, dim3(grid), dim3(512), LDS_BYTES, stream, a);
#endif
    }
#endif
}
```

```cpp
#define MK_N_LAUNCHES 1
#define PH_MASK 0x7ff
#include <hip/hip_runtime.h>
#include <cstdio>
#include <cstdint>

#define GAS __attribute__((address_space(1)))
#define LAS __attribute__((address_space(3)))
#define CAS __attribute__((address_space(4)))
typedef unsigned short bf16;
typedef short bf16x8 __attribute__((ext_vector_type(8)));
typedef short s16x4 __attribute__((ext_vector_type(4)));
typedef float f32x2 __attribute__((ext_vector_type(2)));
typedef float f32x4 __attribute__((ext_vector_type(4)));
typedef float f32x16 __attribute__((ext_vector_type(16)));
typedef unsigned u32x2 __attribute__((ext_vector_type(2)));
typedef unsigned u32x4 __attribute__((ext_vector_type(4)));
typedef GAS unsigned gu32;
#define RLX_AGENT __ATOMIC_RELAXED, __HIP_MEMORY_SCOPE_AGENT
#define LDS_WAIT() asm volatile("s_waitcnt lgkmcnt(0)" ::: "memory")
#define VM_WAIT() asm volatile("s_waitcnt vmcnt(0)" ::: "memory")

constexpr int DM = 2048, NBATCH = 2, SEQ = 4096, NTOK = NBATCH * SEQ;
constexpr int D_SSM = 1024, SSM_H = 16, SSM_P = 64, SSM_N = 128, CONV_CH = 1536, CHUNK = 128, NCHUNK = SEQ / CHUNK;
constexpr int ATT_H = 8, ATT_D = 128, IDX_H = 16, IDX_D = 64, TOPK_SEL = 256;
constexpr int NE = 64, DE = 512, NEX = NE + 1;
constexpr int NPROJ = 6752, NPROJ_PAD = 6912, NPROJ_TILES = 27;
constexpr float ALPHA_DN = 1.189207115002721f;
constexpr float LN_EPS = 1e-5f;
constexpr int SEG_Z = 0, SEG_XBC = 1024, SEG_DT = 2560, SEG_Q = 2576, SEG_K = 3600, SEG_V = 4624, SEG_QI = 5648, SEG_KI = 6672, SEG_WI = 6736;

constexpr size_t MiB = 1u << 20;
constexpr size_t WS_CTL = 0, CTL_ZERO_BYTES = 1 * MiB;
constexpr size_t WS_MODP = 1 * MiB;
constexpr size_t WS_MODF = 3 * MiB;
constexpr size_t WS_COSA = 4 * MiB, WS_SINA = 6 * MiB;
constexpr size_t WS_COSI = 8 * MiB, WS_SINI = 9 * MiB;
constexpr size_t WS_WR = 10 * MiB;
constexpr size_t WS_KIDX = 11 * MiB;
constexpr size_t WS_WIDX = 12 * MiB;
constexpr size_t WS_DT = 12 * MiB + 512 * 1024;
constexpr size_t WS_CS = 13 * MiB;
constexpr size_t WS_INV = 14 * MiB;
constexpr size_t WS_LTOK = 15 * MiB;
constexpr size_t WS_LW = 17 * MiB;
constexpr size_t WS_MASK = 19 * MiB;
constexpr size_t WS_U2 = 25 * MiB;
constexpr size_t WS_WGU = 57 * MiB;
constexpr size_t WS_WDN = 317 * MiB;
constexpr size_t WS_T = 447 * MiB;
constexpr size_t WS_HID = WS_T;
constexpr size_t WS_OUTS = WS_T + 88 * MiB;
constexpr size_t WS_WIN = WS_T;
constexpr size_t WS_WOUT = WS_T + 27 * MiB;
constexpr size_t WS_U1 = WS_T + 35 * MiB;
constexpr size_t WS_Z = WS_T + 67 * MiB;
constexpr size_t WS_XBC = WS_T + 83 * MiB;
constexpr size_t WS_Q = WS_T + 107 * MiB, WS_K = WS_T + 123 * MiB, WS_V = WS_T + 139 * MiB;
constexpr size_t WS_QIDX = WS_T + 155 * MiB;
constexpr size_t WS_SCORES = WS_T + 171 * MiB;
constexpr size_t WS_STATES = WS_T + 299 * MiB;
constexpr size_t WS_HIN = WS_T + 331 * MiB;
constexpr size_t WS_YDIAG = WS_T + 347 * MiB;
constexpr size_t WS_YCAT = WS_T + 379 * MiB;
constexpr size_t WS_XBCACT = WS_T + 411 * MiB;
constexpr size_t WS_END = WS_T + 440 * MiB;
static_assert(WS_XBCACT + 24 * MiB <= WS_END && WS_OUTS + 352 * MiB <= WS_END, "ws map");
constexpr int MAXPOS = 90112;
constexpr int CW_TMO = 0, CW_BAR = 4096, CW_ECNT = 8192;
constexpr int CW_QHEAD = 16384, CW_DONE = 16448;

constexpr int LDS_MISC = 155648;
constexpr int LDS_BYTES = 157696;

typedef __bf16 bf16x2_t __attribute__((ext_vector_type(2)));
__device__ __forceinline__ unsigned cvt_pk_bf16(float lo, float hi) { const bf16x2_t v = {(__bf16)lo, (__bf16)hi}; return __builtin_bit_cast(unsigned, v); }
__device__ __forceinline__ float bflo(unsigned w) { return __uint_as_float(w << 16); }
__device__ __forceinline__ float bfhi(unsigned w) { return __uint_as_float(w & 0xffff0000u); }
__device__ __forceinline__ float bf2f(bf16 b) { return __uint_as_float((unsigned)b << 16); }
__device__ __forceinline__ bf16 f2bf(float f) { return __builtin_bit_cast(unsigned short, (__bf16)f); }
__device__ __forceinline__ float silu_f(float x) { return x / (1.f + __expf(-x)); }
__device__ __forceinline__ float sigmoid_f(float x) { return 1.f / (1.f + __expf(-x)); }
__device__ __forceinline__ float wave_sum(float v) {
#pragma unroll
    for (int o = 1; o < 64; o <<= 1) v += __shfl_xor(v, o);
    return v;
}
__device__ __forceinline__ bf16x8 pack8(f32x4 a, f32x4 b) {
    u32x4 w = {cvt_pk_bf16(a[0], a[1]), cvt_pk_bf16(a[2], a[3]), cvt_pk_bf16(b[0], b[1]), cvt_pk_bf16(b[2], b[3])};
    return __builtin_bit_cast(bf16x8, w);
}
__device__ __forceinline__ void unpack8(bf16x8 v, float (&o)[8]) {
    u32x4 w = __builtin_bit_cast(u32x4, v);
#pragma unroll
    for (int i = 0; i < 4; ++i) { o[2 * i] = bflo(w[i]); o[2 * i + 1] = bfhi(w[i]); }
}
__device__ __forceinline__ int crow(int r, int hi) { return (r & 3) + 8 * (r >> 2) + 4 * hi; }

__device__ __forceinline__ LAS unsigned char* lds_base() { extern __shared__ __attribute__((aligned(16))) unsigned char lds_raw[]; return (LAS unsigned char*)lds_raw; }
#ifdef PROBE_SUB
#define PSUB(n, w) do { if ((n) == PROBE_SUB && blockIdx.x == 0 && threadIdx.x == 0) *(volatile LAS unsigned long long*)(lds_base() + LDS_MISC + 32 + 8 * (w)) = __builtin_amdgcn_s_memrealtime(); } while (0)
#else
#define PSUB(n, w) do { } while (0)
#endif
#define XB_TMO      128
#define XB_XCNT(j)  (256  + 64 * (j))
#define XB_XSUB(j)  (1280 + 64 * (j))
#define XB_XGEN(j)  (2304 + 64 * (j))
#define XB_TOP      3328
#define XB_TOPGEN   3392
#define XCD_BAR_WORDS 3456
#define XB_SPIN_CAP (1u << 18)

__device__ __forceinline__ unsigned xb_ld(unsigned* p)              { return __hip_atomic_load(p, __ATOMIC_RELAXED, __HIP_MEMORY_SCOPE_AGENT); }
__device__ __forceinline__ unsigned xb_add(unsigned* p, unsigned v) { return __hip_atomic_fetch_add(p, v, __ATOMIC_RELAXED, __HIP_MEMORY_SCOPE_AGENT); }
__device__ __forceinline__ unsigned xb_xcc_id() { return (unsigned)__builtin_amdgcn_s_getreg((3 << 11) | 20) & 0xFu; }
#define XB_SPIN(cond, bar) do { unsigned _sp = 0; while (cond) { __builtin_amdgcn_s_sleep(1); \
    if ((++_sp & 255u) == 0u) { if (xb_ld(&(bar)[XB_TMO])) break; if (_sp > XB_SPIN_CAP) { atomicAdd(&(bar)[XB_TMO], 1u); break; } } } } while (0)

struct XcdBarrier {
    unsigned* bar; unsigned x;
    volatile LAS unsigned* st;
};

__device__ __forceinline__ XcdBarrier xcd_barrier_post(unsigned* bar, volatile LAS unsigned* st) {
    XcdBarrier b; b.bar = bar; b.x = xb_xcc_id(); b.st = st;
    if (threadIdx.x == 0) (void)xb_add(&bar[XB_XCNT(b.x)], 1u);
    return b;
}
__device__ __forceinline__ void xcd_barrier_complete(unsigned* bar, unsigned x, unsigned& nloc, unsigned& nx) {
    const unsigned G = gridDim.x * gridDim.y * gridDim.z;
    unsigned sum, cnt, mine, sp = 0u;
    for (;;) {
        sum = 0u; cnt = 0u; mine = 0u;
#pragma unroll
        for (unsigned j = 0; j < 16; ++j) { const unsigned c = xb_ld(&bar[XB_XCNT(j)]); sum += c; cnt += (c > 0u) ? 1u : 0u; mine = (j == x) ? c : mine; }
        if (sum == G) break;
        __builtin_amdgcn_s_sleep(1);
        if ((++sp & 255u) == 0u) { if (xb_ld(&bar[XB_TMO])) break; if (sp > XB_SPIN_CAP) { atomicAdd(&bar[XB_TMO], 1u); break; } }
    }
    nloc = mine > 0u ? mine : 1u; nx = cnt > 0u ? cnt : 1u;
}

__device__ __forceinline__ void xcd_barrier(const XcdBarrier& b) {
    asm volatile("s_waitcnt vmcnt(0)" ::: "memory");
    __syncthreads();
    if (threadIdx.x == 0) {
        unsigned* bar = b.bar;
        __builtin_amdgcn_s_waitcnt(0);
        unsigned nloc = b.st[0], nx = b.st[1];
        if (nloc == 0u) { xcd_barrier_complete(bar, b.x, nloc, nx); b.st[0] = nloc; b.st[1] = nx; }
        const unsigned old = xb_add(&bar[XB_XSUB(b.x)], 1u);
        const unsigned gen = old / nloc;
        if (old + 1u == (gen + 1u) * nloc) {
            __builtin_amdgcn_fence(__ATOMIC_RELEASE, "agent");
            asm volatile("s_waitcnt vmcnt(0)" ::: "memory");
            const unsigned og = xb_add(&bar[XB_TOP], 1u);
            const unsigned tg = og / nx;
            if (og + 1u == (tg + 1u) * nx) xb_add(&bar[XB_TOPGEN], 1u);
            else XB_SPIN(xb_ld(&bar[XB_TOPGEN]) == tg, bar);
            __builtin_amdgcn_fence(__ATOMIC_ACQUIRE, "agent");
            xb_add(&bar[XB_XGEN(b.x)], 1u);
            asm volatile("s_waitcnt vmcnt(0)" ::: "memory");
        } else {
            XB_SPIN(xb_ld(&bar[XB_XGEN(b.x)]) == gen, bar);
            __builtin_amdgcn_fence(__ATOMIC_ACQUIRE, "agent");
            asm volatile("s_waitcnt vmcnt(0)" ::: "memory");
        }
    }
    __syncthreads();
}

namespace pg8 {
constexpr int BM = 256, BK = 64, HALF = 128, HTB = HALF * BK * 2  , STAGE_BYTES = 8 * HTB, NXCD = 8, WGM = 8;
__host__ __device__ __forceinline__ int lds_byte(int r, int c) { const int st = (r >> 4) * 2 + (c >> 5), rr = r & 15, cc = c & 31, ob = rr * 64 + cc * 2; return st * 1024 + (ob ^ (((ob >> 9) & 1) << 5)); }
__host__ __device__ __forceinline__ void stage_rc(int b, int& R, int& C) { const int st = b / 1024, sb = b % 1024, swz = sb ^ (((sb >> 9) & 1) << 5); R = (st >> 1) * 16 + swz / 64; C = (st & 1) * 32 + (swz % 64) / 2; }
__host__ __device__ __forceinline__ int perm32(int rho) { const int n = rho >> 4, i = rho & 15; return 8 * (i >> 2) + 4 * n + (i & 3); }

struct Unit { int pm, pn, ax; };
struct Gemm { const bf16* A; const bf16* Bt; int K; int pid; };

struct StaticOrder {
    int nM, nN, nwg, G, c;
    __device__ void init(int M, int N, int G_, int c_) { nM = M / BM; nN = N / BM; nwg = nM * nN; G = G_; c = c_; }
    __device__ __forceinline__ bool next(int i, Unit& u) const {
        const long L = (long)i * G + c; if (L >= nwg) return false;
        int wgid = (int)L; { const int q = nwg / NXCD, r = nwg % NXCD, xcd = wgid % NXCD, off = wgid / NXCD; wgid = (xcd < r ? xcd * (q + 1) : r * (q + 1) + (xcd - r) * q) + off; }
        const int nig = WGM * nN, gid = wgid / nig, fm = gid * WGM, gsz = (nM - fm) < WGM ? (nM - fm) : WGM;
        u.pm = fm + ((wgid % nig) % gsz); u.pn = (wgid % nig) / gsz; u.ax = 0; return true;
    }
    __device__ __forceinline__ int row_tok(const Unit&, int) const { return 0; }
};

template <class Epi, class Sched, bool GATHER>
__device__ __forceinline__ void gemm_phase(LAS unsigned char* lds, const Gemm g, const Sched& S, const Epi& E) {
    const int tid = threadIdx.x, wid = __builtin_amdgcn_readfirstlane(tid >> 6), lane = tid & 63, wr = wid >> 2, wc = wid & 3, fr = lane & 15, fq = lane >> 4;
    const int K = g.K, nt = K / BK;
    unsigned voffB[2]; int RA[2]; unsigned CA2[2];
#pragma unroll
    for (int i = 0; i < 2; ++i) { int R, C; stage_rc(tid * 16 + i * 8192, R, C); const int Rb = Epi::PERM ? ((R & ~31) + perm32(R & 31)) : R;
        voffB[i] = (unsigned)(Rb * K + C) * 2u; RA[i] = R; CA2[i] = (unsigned)C * 2u; }
    const size_t kstep = (size_t)(BK * 2);
    const size_t hstep = (size_t)HALF * K * 2;
    const size_t tstep = 2 * hstep;
    const unsigned ldsw = (unsigned)wid * 1024u;
    const int aoff = lds_byte(wr * 64 + fr, fq * 8), boff = lds_byte(wc * 32 + fr, fq * 8);
#define PG8_SA(b, h) (((b) * 2 + (h)) * HTB)
#define PG8_SB(b, h) ((4 + (b) * 2 + (h)) * HTB)
#define PG8_STAGE(bufoff, gbase, voff) do { _Pragma("unroll") for (int _i = 0; _i < 2; ++_i) \
        __builtin_amdgcn_global_load_lds((const unsigned*)((const char*)(gbase) + (voff)[_i]), (LAS unsigned*)(lds + (bufoff) + ldsw + _i * 8192), 16, 0, 0); } while (0)
#define PG8_LDA(dst, b, h) do { _Pragma("unroll") for (int m = 0; m < 4; ++m) _Pragma("unroll") for (int k = 0; k < 2; ++k) dst[m][k] = *(const LAS bf16x8*)(lds + PG8_SA(b, h) + aoff + m * 2048 + k * 1024); } while (0)
#define PG8_LDB(dst, b, h) do { _Pragma("unroll") for (int n = 0; n < 2; ++n) _Pragma("unroll") for (int k = 0; k < 2; ++k) dst[n][k] = *(const LAS bf16x8*)(lds + PG8_SB(b, h) + boff + n * 2048 + k * 1024); } while (0)
#define PG8_MMA(ai, bj, At, Bt) do { __builtin_amdgcn_s_setprio(1); _Pragma("unroll") for (int m = 0; m < 4; ++m) _Pragma("unroll") for (int n = 0; n < 2; ++n) _Pragma("unroll") for (int k = 0; k < 2; ++k) \
        acc[ai][bj][m][n] = __builtin_amdgcn_mfma_f32_16x16x32_bf16(Bt[n][k], At[m][k], acc[ai][bj][m][n], 0, 0, 0); __builtin_amdgcn_s_setprio(0); } while (0)
#define PG8_WAIT_V(n) asm volatile("s_waitcnt vmcnt(" #n ")" ::: "memory")
#define PG8_WAIT_L(n) asm volatile("s_waitcnt lgkmcnt(" #n ")" ::: "memory")
#define PG8_BAR __builtin_amdgcn_s_barrier()
#define PG8_SCHED __builtin_amdgcn_sched_barrier(0)
#define PG8_SET_OA(o, u) do { _Pragma("unroll") for (int _h = 0; _h < 2; ++_h) _Pragma("unroll") for (int _i = 0; _i < 2; ++_i) { \
        if constexpr (GATHER) o[_h][_i] = (unsigned)S.row_tok(u, _h * HALF + RA[_i]) * (unsigned)(K * 2) + CA2[_i]; \
        else o[_h][_i] = (unsigned)(_h * (int)hstep) + (unsigned)(RA[_i] * K * 2) + CA2[_i]; } } while (0)
    Unit cur, nxt; int ui = 0;
    if (!S.next(0, cur)) return;
    f32x4 acc[2][2][4][2];
#pragma unroll
    for (int a = 0; a < 2; ++a)
#pragma unroll
        for (int b = 0; b < 2; ++b)
#pragma unroll
            for (int m = 0; m < 4; ++m)
#pragma unroll
                for (int n = 0; n < 2; ++n) acc[a][b][m][n] = (f32x4){0.f, 0.f, 0.f, 0.f};
    bf16x8 At[4][2], B0[2][2], B1[2][2];
    unsigned oAc[2][2], oAn[2][2];
    PG8_SET_OA(oAc, cur);
    const char* cA = GATHER ? (const char*)g.A : (const char*)g.A + (size_t)cur.pm * tstep; const char* cB = (const char*)g.Bt + (size_t)cur.pn * tstep;
    PG8_STAGE(PG8_SB(0, 0), cB, voffB); PG8_STAGE(PG8_SB(0, 1), cB + hstep, voffB); PG8_STAGE(PG8_SA(0, 0), cA, oAc[0]); PG8_STAGE(PG8_SA(0, 1), cA, oAc[1]);
    if (wr == 1) PG8_BAR;
    PG8_WAIT_V(2); PG8_BAR;
    PG8_STAGE(PG8_SB(1, 0), cB + kstep, voffB); PG8_STAGE(PG8_SA(1, 0), cA + kstep, oAc[0]); PG8_STAGE(PG8_SB(1, 1), cB + hstep + kstep, voffB);
    PG8_WAIT_V(6); PG8_BAR;
    for (;;) {
        const bool has_next = S.next(ui + 1, nxt);
        const char* nA = has_next ? (GATHER ? (const char*)g.A : (const char*)g.A + (size_t)nxt.pm * tstep) : cA; const char* nB = has_next ? (const char*)g.Bt + (size_t)nxt.pn * tstep : cB;
        if (has_next) { PG8_SET_OA(oAn, nxt); }
        else {
#pragma unroll
            for (int _h = 0; _h < 2; ++_h)
#pragma unroll
                for (int _i = 0; _i < 2; ++_i) oAn[_h][_i] = oAc[_h][_i]; }
        PSUB(g.pid * 10, 0); PSUB(g.pid * 10 + 2, 0);
        for (int t = 0; t < nt; t += 2) {
            const bool last = (t == nt - 2);
            if (t == 0) { PSUB(g.pid * 10 + 3, 0); } if (t == 2) { PSUB(g.pid * 10 + 3, 1); PSUB(g.pid * 10 + 4, 0); } if (t == 4) { PSUB(g.pid * 10 + 4, 1); }
            const char* a1 = cA + (size_t)(t + 1) * kstep;
            const char* a2 = last ? nA : cA + (size_t)(t + 2) * kstep; const char* b2 = last ? nB : cB + (size_t)(t + 2) * kstep;
            const char* a3 = a2 + kstep; const char* b3 = b2 + kstep;
            unsigned o2[2][2];
#pragma unroll
            for (int _h = 0; _h < 2; ++_h)
#pragma unroll
                for (int _i = 0; _i < 2; ++_i) o2[_h][_i] = GATHER ? (last ? oAn[_h][_i] : oAc[_h][_i]) : oAc[_h][_i];
            PG8_LDB(B0, 0, 0); PG8_LDB(B1, 0, 1); PG8_SCHED; PG8_LDA(At, 0, 0); PG8_STAGE(PG8_SA(1, 1), a1, oAc[1]);
            PG8_WAIT_V(8); PG8_WAIT_L(0); PG8_BAR; PG8_MMA(0, 0, At, B0); PG8_MMA(0, 1, At, B1); PG8_BAR; PG8_SCHED;
            PG8_LDA(At, 0, 1); PG8_STAGE(PG8_SB(0, 0), b2, voffB); PG8_STAGE(PG8_SB(0, 1), b2 + hstep, voffB); PG8_STAGE(PG8_SA(0, 0), a2, o2[0]);
            PG8_WAIT_V(8); PG8_WAIT_L(0); PG8_BAR; PG8_MMA(1, 0, At, B0); PG8_MMA(1, 1, At, B1); PG8_BAR; PG8_SCHED;
            PG8_LDB(B0, 1, 0); PG8_LDB(B1, 1, 1); PG8_SCHED; PG8_LDA(At, 1, 0); PG8_STAGE(PG8_SA(0, 1), a2, o2[1]);
            PG8_WAIT_V(8); PG8_WAIT_L(0); PG8_BAR; PG8_MMA(0, 0, At, B0); PG8_MMA(0, 1, At, B1); PG8_BAR; PG8_SCHED;
            PG8_LDA(At, 1, 1); PG8_STAGE(PG8_SB(1, 0), b3, voffB); PG8_STAGE(PG8_SB(1, 1), b3 + hstep, voffB); PG8_STAGE(PG8_SA(1, 0), a3, o2[0]);
            PG8_WAIT_V(8); PG8_WAIT_L(0); PG8_BAR; PG8_MMA(1, 0, At, B0); PG8_MMA(1, 1, At, B1); PG8_BAR; PG8_SCHED;
        }
        PSUB(g.pid * 10, 1); PSUB(g.pid * 10 + 1, 0);
        if (wr == 0) PG8_BAR;
        { int fr_ = fr, fq_ = fq, wr_ = wr, wc_ = wc; asm volatile("" : "+v"(fr_), "+v"(fq_), "+s"(wr_), "+s"(wc_));
          E(acc, cur, wr_, wc_, fr_, fq_); }
        PSUB(g.pid * 10 + 1, 1); PSUB(g.pid * 10 + 2, 1);
        if (!has_next) break;
#pragma unroll
        for (int a = 0; a < 2; ++a)
#pragma unroll
            for (int b = 0; b < 2; ++b)
#pragma unroll
                for (int m = 0; m < 4; ++m)
#pragma unroll
                    for (int n = 0; n < 2; ++n) acc[a][b][m][n] = (f32x4){0.f, 0.f, 0.f, 0.f};
        cur = nxt; cA = nA; cB = nB; ++ui;
#pragma unroll
        for (int _h = 0; _h < 2; ++_h)
#pragma unroll
            for (int _i = 0; _i < 2; ++_i) oAc[_h][_i] = oAn[_h][_i];
        if (wr == 1) PG8_BAR;
    }
    PG8_WAIT_V(0);
    PG8_BAR;
#undef PG8_SA
#undef PG8_SB
#undef PG8_STAGE
#undef PG8_LDA
#undef PG8_LDB
#undef PG8_MMA
#undef PG8_WAIT_V
#undef PG8_WAIT_L
#undef PG8_BAR
#undef PG8_SCHED
#undef PG8_SET_OA
}
}
struct Args { const void* in[27]; float* out; unsigned char* ws; int ph_lo, ph_hi; };
struct Frame {
    const Args* ap;
    __device__ __forceinline__ LAS unsigned char* lds() const { extern __shared__ __attribute__((aligned(16))) unsigned char lds_raw[]; return (LAS unsigned char*)lds_raw; }
    __device__ __forceinline__ unsigned char* ws() const { return ap->ws; }
    __device__ __forceinline__ gu32* ctl() const { return (gu32*)(ap->ws + WS_CTL); }
    __device__ __forceinline__ float* out() const { return ap->out; }
    __device__ __forceinline__ int tid() const { return (int)threadIdx.x; }
    __device__ __forceinline__ int lane() const { return (int)threadIdx.x & 63; }
    __device__ __forceinline__ int wave() const { return __builtin_amdgcn_readfirstlane((int)threadIdx.x >> 6); }
    __device__ __forceinline__ int G() const { return (int)gridDim.x; }
    __device__ __forceinline__ int bid() const { return (int)blockIdx.x; }
    __device__ __forceinline__ const CAS float* f(int i) const { return (const CAS float*)ap->in[i]; }
    __device__ __forceinline__ const CAS int* i32(int i) const { return (const CAS int*)ap->in[i]; }
};
#define WSP(T, off) ((T*)(F.ws() + (off)))

__device__ __forceinline__ int inproj_src_col(int P) {
    const int tile = P >> 8, within = P & 255, bj = within >> 7, w = within & 127;
    if (tile < 4) return SEG_Z + tile * 256 + within;
    if (tile < 10) return SEG_XBC + (tile - 4) * 256 + within;
    if (tile < 14) return SEG_Q + (2 * (tile - 10) + (w >> 6)) * 128 + (w & 63) + 64 * bj;
    if (tile < 18) return SEG_K + (2 * (tile - 14) + (w >> 6)) * 128 + (w & 63) + 64 * bj;
    if (tile < 22) return SEG_V + (tile - 18) * 256 + within;
    if (tile < 26) return SEG_QI + (4 * (tile - 22) + (w >> 5)) * 64 + (w & 31) + 32 * bj;
    if (bj == 0) { if (w < 32) return SEG_KI + w; if (w < 48) return SEG_WI + (w - 32); if (w < 64) return SEG_DT + (w - 48); return -1; }
    if (w < 32) return SEG_KI + 32 + w;
    return -1;
}
__device__ __forceinline__ void tr64(const CAS float* qsrc, bool valid, int ld, bf16* dst0  , int K, LAS float* scr, int lane) {
    f32x4 v[16];
#pragma unroll
    for (int i = 0; i < 16; ++i) v[i] = valid ? *(const CAS f32x4*)(qsrc + (size_t)(4 * i) * ld) : (f32x4){0.f, 0.f, 0.f, 0.f};
#pragma unroll
    for (int i = 0; i < 16; ++i) { LAS float* s = scr + ((lane >> 4) + 4 * i) * 65 + 4 * (lane & 15); s[0] = v[i][0]; s[1] = v[i][1]; s[2] = v[i][2]; s[3] = v[i][3]; }
    LDS_WAIT(); asm volatile("" ::: "memory");
    const int c = lane & 7;
#pragma unroll
    for (int jj = 0; jj < 8; ++jj) { const int n = (lane >> 3) + 8 * jj; const LAS float* s = scr + (8 * c) * 65 + n;
        u32x4 o; o.x = cvt_pk_bf16(s[0], s[65]); o.y = cvt_pk_bf16(s[2 * 65], s[3 * 65]); o.z = cvt_pk_bf16(s[4 * 65], s[5 * 65]); o.w = cvt_pk_bf16(s[6 * 65], s[7 * 65]);
        *(u32x4*)(dst0 + (size_t)n * K + 8 * c) = o; }
    LDS_WAIT(); asm volatile("" ::: "memory");
}
constexpr int I_IN = 32 * 108, I_OUT = 32 * 32, I_GU = NEX * 32 * 16, I_DN = NEX * 8 * 32, I_TR = I_IN + I_OUT + I_GU + I_DN;
__device__ __forceinline__ void tr_item(Frame& F, int it, LAS float* scr) {
    const int lane = F.lane(), kr = lane >> 4, nq = 4 * (lane & 15);
    if (it < I_IN) { const int kb = it / 108, nb = it % 108, k0 = 64 * kb, n0 = 64 * nb; const int sc = inproj_src_col(n0 + nq);
        tr64(F.f(5) + (size_t)(k0 + kr) * NPROJ + (sc < 0 ? 0 : sc), sc >= 0, NPROJ, WSP(bf16, WS_WIN) + (size_t)n0 * DM + k0, DM, scr, lane); return; }
    it -= I_IN;
    if (it < I_OUT) { const int kb = it >> 5, nb = it & 31, k0 = 64 * kb, n0 = 64 * nb;
        tr64(F.f(14) + (size_t)(k0 + kr) * DM + n0 + nq, true, DM, WSP(bf16, WS_WOUT) + (size_t)n0 * DM + k0, DM, scr, lane); return; }
    it -= I_OUT;
    if (it < I_GU) { const int e = it >> 9, r = it & 511, kb = r >> 4, nb = r & 15, k0 = 64 * kb;
        const int p = nb >> 2, bj = (nb >> 1) & 1, w0 = (nb & 1) * 64;
        const CAS float* src = (e < NE) ? ((bj ? F.f(20) : F.f(19)) + (size_t)e * DM * DE) : (bj ? F.f(23) : F.f(22));
        tr64(src + (size_t)(k0 + kr) * DE + 128 * p + w0 + nq, true, DE, WSP(bf16, WS_WGU) + ((size_t)e * 1024 + 64 * nb) * DM + k0, DM, scr, lane); return; }
    it -= I_GU;
    { const int e = it >> 8, r = it & 255, kb = r >> 5, nb = r & 31, k0 = 64 * kb, n0 = 64 * nb;
        const CAS float* src = (e < NE) ? (F.f(21) + (size_t)e * DE * DM) : F.f(24);
        tr64(src + (size_t)(k0 + kr) * DM + n0 + nq, true, DM, WSP(bf16, WS_WDN) + ((size_t)e * DM + n0) * DE + k0, DE, scr, lane); }
}
__device__ __forceinline__ void p0_prologue(Frame& F) {
    const int gw = F.bid() * 8 + F.wave(), NGW = F.G() * 8, gt = F.bid() * 512 + F.tid(), NGT = F.G() * 512;
    {
        LAS float* red = (LAS float*)F.lds();
        float* modp = WSP(float, WS_MODP);
        for (int item = F.bid(); item < 48 * 16; item += F.G()) {
            const int cc = item % 48, ks = item / 48;
            f32x4 a0 = {0.f, 0.f, 0.f, 0.f}, a1 = {0.f, 0.f, 0.f, 0.f};
            const int kbase = ks * 128 + F.wave() * 16;
#pragma unroll 4
            for (int i = 0; i < 16; ++i) { const int k = kbase + i;
                const float c0 = silu_f(F.f(1)[k]), c1 = silu_f(F.f(1)[DM + k]);
                const f32x4 wv = *(const CAS f32x4*)(F.f(3) + (size_t)k * (6 * DM) + cc * 256 + F.lane() * 4);
                a0 += wv * c0; a1 += wv * c1; }
            *(LAS f32x4*)(red + (F.wave() * 2 + 0) * 256 + F.lane() * 4) = a0;
            *(LAS f32x4*)(red + (F.wave() * 2 + 1) * 256 + F.lane() * 4) = a1;
            __syncthreads();
            { const int b = F.tid() >> 8, col = F.tid() & 255; float s = 0.f;
#pragma unroll
              for (int w = 0; w < 8; ++w) s += red[(w * 2 + b) * 256 + col];
              modp[((size_t)ks * 2 + b) * (6 * DM) + cc * 256 + col] = s; }
            __syncthreads();
        }
    }
    {
        float* cosA = WSP(float, WS_COSA); float* sinA = WSP(float, WS_SINA); float* cosI = WSP(float, WS_COSI); float* sinI = WSP(float, WS_SINI);
        for (int i = gt; i < NTOK * 64; i += NGT) { const int tok = i >> 6, j = i & 63;
            const float inv = 1.0f / powf(10000.0f, (float)(2 * j) / 128.0f); const float ang = (float)F.i32(2)[tok] * inv;
            float s, c; sincosf(ang, &s, &c); cosA[i] = c; sinA[i] = s; }
        for (int i = gt; i < NTOK * 32; i += NGT) { const int tok = i >> 5, j = i & 31;
            const float inv = 1.0f / powf(10000.0f, (float)(2 * j) / 64.0f); const float ang = (float)F.i32(2)[tok] * inv;
            float s, c; sincosf(ang, &s, &c); cosI[i] = c; sinI[i] = s; }
    }
    {
        bf16* wr_hi = WSP(bf16, WS_WR); bf16* wr_lo = wr_hi + NE * DM;
        for (int i = gt; i < NE * (DM / 8); i += NGT) { const int e = i & 63, kc = i >> 6;
            float v[8], l[8];
#pragma unroll
            for (int j = 0; j < 8; ++j) { v[j] = F.f(17)[(size_t)(8 * kc + j) * NE + e]; l[j] = v[j] - bf2f(f2bf(v[j])); }
            u32x4 h = {cvt_pk_bf16(v[0], v[1]), cvt_pk_bf16(v[2], v[3]), cvt_pk_bf16(v[4], v[5]), cvt_pk_bf16(v[6], v[7])};
            u32x4 lo = {cvt_pk_bf16(l[0], l[1]), cvt_pk_bf16(l[2], l[3]), cvt_pk_bf16(l[4], l[5]), cvt_pk_bf16(l[6], l[7])};
            *(u32x4*)(wr_hi + (size_t)e * DM + 8 * kc) = h; *(u32x4*)(wr_lo + (size_t)e * DM + 8 * kc) = lo; }
    }
    {
        LAS float* scr = (LAS float*)(F.lds() + F.wave() * 16640);
        for (int it = gw; it < I_IN + I_OUT; it += NGW) tr_item(F, it, scr);
    }
}

constexpr int Q_GU = I_GU, Q_ALL = I_GU + I_DN, Q_GRAB = 16;
__device__ __forceinline__ void slack_fill(Frame& F, int budget, bool drain, int upto) {
    LAS float* scr = (LAS float*)(F.lds() + F.wave() * 16640);
    volatile LAS int* qw = (volatile LAS int*)(F.lds() + LDS_MISC + 16);
    __syncthreads();
    for (int gi = 0; drain || gi < budget; ++gi) {
        if (F.tid() == 0) { int stop = 0;
            const int idx = (int)__hip_atomic_fetch_add(F.ctl() + CW_QHEAD, (unsigned)Q_GRAB, RLX_AGENT); if (idx >= Q_ALL) stop = 1; else if (idx >= upto) stop = 2;
            qw[0] = stop; qw[1] = idx; }
        __syncthreads();
        const int stop = qw[0], idx = qw[1];
        __syncthreads();
        if (stop == 1) break;
#pragma unroll 1
        for (int i = 0; i < Q_GRAB / 8; ++i) { const int it = idx + i * 8 + F.wave(); if (it < Q_ALL) tr_item(F, I_IN + I_OUT + it, scr); }
        if (stop == 2) break;
    }
}

__device__ __forceinline__ void p1_modulate(Frame& F) {
    const float* modp = WSP(const float, WS_MODP); float* modf = WSP(float, WS_MODF); bf16* u1 = WSP(bf16, WS_U1);
    LAS float* sh = (LAS float*)F.lds(); LAS float* sc = sh + DM;
    for (int rg = F.bid(); rg < 256; rg += F.G()) {
        const int b = rg >> 7;
        if (F.tid() < 96) { const int v = rg * 96 + F.tid(); const int bb = v / (6 * DM), col = v % (6 * DM); float s = F.f(4)[col];
#pragma unroll
            for (int ks = 0; ks < 16; ++ks) s += modp[((size_t)ks * 2 + bb) * (6 * DM) + col];
            modf[v] = s; }
        { const int col = F.tid() * 4; f32x4 s0 = *(const CAS f32x4*)(F.f(4) + col), s1 = *(const CAS f32x4*)(F.f(4) + DM + col);
#pragma unroll
          for (int ks = 0; ks < 16; ++ks) { const float* p = modp + ((size_t)ks * 2 + b) * (6 * DM); s0 += *(const f32x4*)(p + col); s1 += *(const f32x4*)(p + DM + col); }
          *(LAS f32x4*)(sh + col) = s0; *(LAS f32x4*)(sc + col) = s1; }
        __syncthreads();
#pragma unroll
        for (int rr = 0; rr < 4; ++rr) { const int row = rg * 32 + F.wave() * 4 + rr;
#pragma unroll
            for (int j = 0; j < 8; ++j) { const int col = j * 256 + F.lane() * 4;
                const f32x4 xv = *(const CAS f32x4*)(F.f(0) + (size_t)row * DM + col); const f32x4 s0 = *(const LAS f32x4*)(sh + col), s1 = *(const LAS f32x4*)(sc + col);
                const f32x4 u = xv * (s1 + 1.0f) + s0;
                u32x2 o = {cvt_pk_bf16(u[0], u[1]), cvt_pk_bf16(u[2], u[3])};
                *(u32x2*)(u1 + (size_t)row * DM + col) = o; } }
        __syncthreads();
    }
}
struct EpiInProj {
    static constexpr bool PERM = true;
    unsigned char* ws; const CAS float *dt_bias, *lng, *lnb;
    __device__ __forceinline__ void operator()(const f32x4 (&acc)[2][2][4][2], const pg8::Unit& u, int wr, int wc, int fr, int fq) const {
        const int pn = u.pn; const int row0 = u.pm * 256 + wr * 64 + fr;
        if (pn < 10 || (pn >= 18 && pn < 22)) {
            size_t boff; int ld, col0;
            if (pn < 4) { boff = WS_Z; ld = 1024; col0 = pn * 256; } else if (pn < 10) { boff = WS_XBC; ld = CONV_CH; col0 = (pn - 4) * 256; } else { boff = WS_V; ld = 1024; col0 = (pn - 18) * 256; }
            bf16* base = (bf16*)(ws + boff);
            col0 += wc * 32 + 8 * fq;
#pragma unroll
            for (int ai = 0; ai < 2; ++ai)
#pragma unroll
                for (int m = 0; m < 4; ++m) { bf16* rowp = base + (size_t)(row0 + ai * 128 + m * 16) * ld + col0;
#pragma unroll
                    for (int bj = 0; bj < 2; ++bj) { const f32x4 v0 = acc[ai][bj][m][0], v1 = acc[ai][bj][m][1];
                        u32x4 w = {cvt_pk_bf16(v0[0], v0[1]), cvt_pk_bf16(v0[2], v0[3]), cvt_pk_bf16(v1[0], v1[1]), cvt_pk_bf16(v1[2], v1[3])};
                        *(u32x4*)(rowp + bj * 128) = w; } }
        } else if (pn < 26) {
            const bool att = pn < 18; const bool isq = pn < 14;
            bf16* base = (bf16*)(ws + (att ? (isq ? WS_Q : WS_K) : WS_QIDX)); const CAS float* ct = (const CAS float*)(ws + (att ? WS_COSA : WS_COSI)); const CAS float* sn = (const CAS float*)(ws + (att ? WS_SINA : WS_SINI));
            const int tw = att ? 64 : 32;
            const int head = att ? 2 * (pn - (isq ? 10 : 14)) + (wc >> 1) : 4 * (pn - 22) + wc, jj0 = att ? 32 * (wc & 1) + 8 * fq : 8 * fq;
#pragma unroll
            for (int ai = 0; ai < 2; ++ai)
#pragma unroll
                for (int m = 0; m < 4; ++m) { const int row = row0 + ai * 128 + m * 16;
                    bf16* rowp = base + (size_t)row * 1024 + head * (2 * tw) + jj0;
#pragma unroll
                    for (int n = 0; n < 2; ++n) { const f32x4 c = *(const CAS f32x4*)(ct + (size_t)row * tw + jj0 + 4 * n), sv = *(const CAS f32x4*)(sn + (size_t)row * tw + jj0 + 4 * n);
                        const f32x4 a = acc[ai][0][m][n], bb = acc[ai][1][m][n];
                        const f32x4 o1 = a * c - bb * sv, o2 = bb * c + a * sv;
                        *(u32x2*)(rowp + 4 * n) = (u32x2){cvt_pk_bf16(o1[0], o1[1]), cvt_pk_bf16(o1[2], o1[3])};
                        *(u32x2*)(rowp + tw + 4 * n) = (u32x2){cvt_pk_bf16(o2[0], o2[1]), cvt_pk_bf16(o2[2], o2[3])}; } }
        } else {
            const CAS float* cosI = (const CAS float*)(ws + WS_COSI); const CAS float* sinI = (const CAS float*)(ws + WS_SINI); bf16* kidx = (bf16*)(ws + WS_KIDX); float* widx = (float*)(ws + WS_WIDX); float* dt = (float*)(ws + WS_DT);
            if (wc == 0) {
                const int jj0 = 8 * fq;
#pragma unroll
                for (int am = 0; am < 8; ++am) { const int ai = am >> 2, m = am & 3; const int row = row0 + ai * 128 + m * 16;
                        f32x4 a0 = acc[ai][0][m][0], a1 = acc[ai][0][m][1], b0 = acc[ai][1][m][0], b1 = acc[ai][1][m][1];
                        float s = (a0[0] + a0[1] + a0[2] + a0[3]) + (a1[0] + a1[1] + a1[2] + a1[3]) + (b0[0] + b0[1] + b0[2] + b0[3]) + (b1[0] + b1[1] + b1[2] + b1[3]);
                        s += __shfl_xor(s, 16); s += __shfl_xor(s, 32);
                        const float mu = s * (1.0f / 64.0f);
                        a0 = a0 - mu; a1 = a1 - mu; b0 = b0 - mu; b1 = b1 - mu;
                        float qv = (a0[0] * a0[0] + a0[1] * a0[1] + a0[2] * a0[2] + a0[3] * a0[3]) + (a1[0] * a1[0] + a1[1] * a1[1] + a1[2] * a1[2] + a1[3] * a1[3])
                                 + (b0[0] * b0[0] + b0[1] * b0[1] + b0[2] * b0[2] + b0[3] * b0[3]) + (b1[0] * b1[0] + b1[1] * b1[1] + b1[2] * b1[2] + b1[3] * b1[3]);
                        qv += __shfl_xor(qv, 16); qv += __shfl_xor(qv, 32);
                        const float rstd = 1.0f / sqrtf(qv * (1.0f / 64.0f) + LN_EPS);
                        a0 = a0 * rstd * *(const CAS f32x4*)(lng + jj0) + *(const CAS f32x4*)(lnb + jj0); a1 = a1 * rstd * *(const CAS f32x4*)(lng + jj0 + 4) + *(const CAS f32x4*)(lnb + jj0 + 4);
                        b0 = b0 * rstd * *(const CAS f32x4*)(lng + 32 + jj0) + *(const CAS f32x4*)(lnb + 32 + jj0); b1 = b1 * rstd * *(const CAS f32x4*)(lng + 36 + jj0) + *(const CAS f32x4*)(lnb + 36 + jj0);
                        const f32x4 c0 = *(const CAS f32x4*)(cosI + (size_t)row * 32 + jj0), c1 = *(const CAS f32x4*)(cosI + (size_t)row * 32 + jj0 + 4);
                        const f32x4 s0 = *(const CAS f32x4*)(sinI + (size_t)row * 32 + jj0), s1 = *(const CAS f32x4*)(sinI + (size_t)row * 32 + jj0 + 4);
                        const f32x4 o10 = a0 * c0 - b0 * s0, o11 = a1 * c1 - b1 * s1, o20 = b0 * c0 + a0 * s0, o21 = b1 * c1 + a1 * s1;
                        bf16* rowp = kidx + (size_t)row * 64 + jj0;
                        u32x4 w1 = {cvt_pk_bf16(o10[0], o10[1]), cvt_pk_bf16(o10[2], o10[3]), cvt_pk_bf16(o11[0], o11[1]), cvt_pk_bf16(o11[2], o11[3])};
                        u32x4 w2 = {cvt_pk_bf16(o20[0], o20[1]), cvt_pk_bf16(o20[2], o20[3]), cvt_pk_bf16(o21[0], o21[1]), cvt_pk_bf16(o21[2], o21[3])};
                        *(u32x4*)rowp = w1; *(u32x4*)(rowp + 32) = w2; }
            } else if (wc == 1) {
                const int h0 = 8 * (fq & 1);
                const f32x4 db0 = *(const CAS f32x4*)(dt_bias + h0), db1 = *(const CAS f32x4*)(dt_bias + h0 + 4);
#pragma unroll
                for (int ai = 0; ai < 2; ++ai)
#pragma unroll
                    for (int m = 0; m < 4; ++m) { const int row = row0 + ai * 128 + m * 16;
                        const f32x4 a0 = acc[ai][0][m][0], a1 = acc[ai][0][m][1];
                        if (fq < 2) { *(f32x4*)(widx + (size_t)row * 16 + h0) = a0 * 0.03125f; *(f32x4*)(widx + (size_t)row * 16 + h0 + 4) = a1 * 0.03125f; }
                        else { f32x4 d0 = a0 + db0, d1 = a1 + db1;
#pragma unroll
                            for (int i = 0; i < 4; ++i) { d0[i] = d0[i] > 20.f ? d0[i] : log1pf(__expf(d0[i])); d1[i] = d1[i] > 20.f ? d1[i] : log1pf(__expf(d1[i])); }
                            *(f32x4*)(dt + (size_t)row * 16 + h0) = d0; *(f32x4*)(dt + (size_t)row * 16 + h0 + 4) = d1; } }
            }
        }
    }
};
constexpr int IX_QP = 2064;
constexpr int IX_ST = 32 * IX_QP;
constexpr int IX_WL = IX_ST + 8 * 8320;
__device__ __forceinline__ void idx_unit(Frame& F, int b, int s, int par) {
    const CAS bf16* kidx = (const CAS bf16*)(F.ws() + WS_KIDX); const CAS bf16* qidx = (const CAS bf16*)(F.ws() + WS_QIDX); const CAS float* widx = (const CAS float*)(F.ws() + WS_WIDX); float* scores = WSP(float, WS_SCORES);
    const int lane = F.lane(), r32 = lane & 31, hi = lane >> 5, w = F.wave(), tid = F.tid();
    LAS unsigned char* Ql = F.lds();
    { const CAS bf16* src = qidx + (size_t)(b * SEQ + s * 32) * 1024;
#pragma unroll
      for (int i = 0; i < 8; ++i) { const int c = tid + 512 * i, row = c >> 7, ch = c & 127;
          *(LAS bf16x8*)(Ql + row * IX_QP + ch * 16) = *(const CAS bf16x8*)(src + (size_t)row * 1024 + ch * 8); }
      if (tid < 128) { const f32x4 wv = *(const CAS f32x4*)(widx + (size_t)(b * SEQ + s * 32 + (tid >> 2)) * 16 + 4 * (tid & 3)); LAS float* wl = (LAS float*)(F.lds() + IX_WL) + (tid >> 2) * 17 + 4 * (tid & 3);
          wl[0] = wv[0]; wl[1] = wv[1]; wl[2] = wv[2]; wl[3] = wv[3]; } }
    __syncthreads();
    const int qpos = s * 32 + r32, nT = (s >> 2) + 1;
    const LAS float* wrow = (const LAS float*)(F.lds() + IX_WL) + r32 * 17;
    const LAS unsigned char* qrow = Ql + r32 * IX_QP + hi * 16;
    LAS float* st = (LAS float*)(F.lds() + IX_ST + w * 8320);
#pragma unroll 1
    for (int t = par + 2 * w; t < nT; t += 16) {
        const int kpos0 = t * 128;
        bf16x8 A[4][4];
#pragma unroll
        for (int kt = 0; kt < 4; ++kt)
#pragma unroll
            for (int ks = 0; ks < 4; ++ks) A[kt][ks] = *(const CAS bf16x8*)(kidx + (size_t)(b * SEQ + kpos0 + kt * 32 + r32) * 64 + ks * 16 + hi * 8);
        f32x16 o[4] = {};
#pragma unroll 1
        for (int h = 0; h < 16; ++h) { const float wh = wrow[h];
            bf16x8 Bq[4];
#pragma unroll
            for (int ks = 0; ks < 4; ++ks) Bq[ks] = *(const LAS bf16x8*)(qrow + h * 128 + ks * 32);
#pragma unroll
            for (int kt = 0; kt < 4; ++kt) { f32x16 a = {};
#pragma unroll
                for (int ks = 0; ks < 4; ++ks) a = __builtin_amdgcn_mfma_f32_32x32x16_bf16(A[kt][ks], Bq[ks], a, 0, 0, 0);
#pragma unroll
                for (int r = 0; r < 16; ++r) o[kt][r] = fmaf(wh, __int_as_float(max(__float_as_int(a[r]), 0)), o[kt][r]); } }
        const float NEG = -__builtin_inff();
#pragma unroll
        for (int half = 0; half < 2; ++half) {
#pragma unroll
            for (int r = 0; r < 16; ++r) { const int kk = crow(r, hi);
                st[r32 * 65 + kk] = (kpos0 + half * 64 + kk > qpos) ? NEG : o[2 * half][r];
                st[r32 * 65 + 32 + kk] = (kpos0 + half * 64 + 32 + kk > qpos) ? NEG : o[2 * half + 1][r]; }
            LDS_WAIT(); asm volatile("" ::: "memory");
            float* dst = scores + (size_t)(b * SEQ + s * 32) * SEQ + kpos0 + half * 64 + lane;
#pragma unroll 4
            for (int q = 0; q < 32; ++q) { *dst = st[q * 65 + lane]; dst += SEQ; }
            LDS_WAIT(); asm volatile("" ::: "memory"); }
    }
    __syncthreads();
}

constexpr int SA_P = 136;
constexpr int SA_BN = 0, SA_CN = 34816, SA_BT = 69632, SA_CB = 104448, SA_SM = 139264;
__device__ __forceinline__ void conv8(const CAS bf16* xraw_row  , int tpos, const CAS float* cw, const CAS float* cb, float (&o)[8]) {
    bf16x8 xv[4];
#pragma unroll
    for (int k = 0; k < 4; ++k) { const int dt_ = k - 3; xv[k] = *(const CAS bf16x8*)(xraw_row + ((tpos + dt_ >= 0) ? (long)dt_ * CONV_CH : 0l)); }
    const f32x4 b0 = *(const CAS f32x4*)cb, b1 = *(const CAS f32x4*)(cb + 4);
#pragma unroll
    for (int j = 0; j < 4; ++j) { o[j] = b0[j]; o[4 + j] = b1[j]; }
#pragma unroll
    for (int k = 0; k < 4; ++k) { const float vm = (tpos + k - 3 >= 0) ? 1.f : 0.f; float xf[8]; unpack8(xv[k], xf);
        const f32x4 w0 = *(const CAS f32x4*)(cw + k * CONV_CH) * vm, w1 = *(const CAS f32x4*)(cw + k * CONV_CH + 4) * vm;
#pragma unroll
        for (int j = 0; j < 4; ++j) { o[j] += w0[j] * xf[j]; o[4 + j] += w1[j] * xf[4 + j]; } }
#pragma unroll
    for (int j = 0; j < 8; ++j) o[j] = silu_f(o[j]);
}
__device__ __forceinline__ void ssd_a_unit(Frame& F, int b, int c, int g, int hf) {
    const CAS bf16* xbc = (const CAS bf16*)(F.ws() + WS_XBC); bf16* xact = WSP(bf16, WS_XBCACT); const CAS float* dtg = (const CAS float*)(F.ws() + WS_DT); float* csg = WSP(float, WS_CS);
    float* ydiag = WSP(float, WS_YDIAG); float* states = WSP(float, WS_STATES);
    LAS bf16* Bn = (LAS bf16*)(F.lds() + SA_BN); LAS bf16* Cn = (LAS bf16*)(F.lds() + SA_CN); LAS bf16* BT = (LAS bf16*)(F.lds() + SA_BT); LAS bf16* CB = (LAS bf16*)(F.lds() + SA_CB);
    const int lane = F.lane(), r32 = lane & 31, hi = lane >> 5, w = F.wave();
    const int tok0 = b * SEQ + c * CHUNK;
#pragma unroll 4
    for (int i = 0; i < 8; ++i) { const int id = F.tid() + 512 * i, mi = id >> 11, rem = id & 2047, s = rem >> 4, ch = rem & 15;
        const int chan = 1024 + mi * 256 + g * 128 + ch * 8; float o[8];
        conv8(xbc + (size_t)(tok0 + s) * CONV_CH + chan, c * CHUNK + s, F.f(6) + chan, F.f(7) + chan, o);
        u32x4 pk = {cvt_pk_bf16(o[0], o[1]), cvt_pk_bf16(o[2], o[3]), cvt_pk_bf16(o[4], o[5]), cvt_pk_bf16(o[6], o[7])};
        if (mi == 0) { *(LAS u32x4*)(Bn + s * SA_P + ch * 8) = pk;
#pragma unroll
            for (int j = 0; j < 8; ++j) BT[(ch * 8 + j) * SA_P + s] = (bf16)((pk[j >> 1] >> (16 * (j & 1))) & 0xffffu); }
        else { *(LAS u32x4*)(Cn + s * SA_P + ch * 8) = pk; if (hf == 0) *(u32x4*)(xact + (size_t)(tok0 + s) * CONV_CH + chan) = pk; } }
    __syncthreads();
    { const int lt = w >> 1;
#pragma unroll
      for (int sq = 0; sq < 2; ++sq) { const int st = 2 * (w & 1) + sq; f32x16 a = {};
#pragma unroll
          for (int ks = 0; ks < 8; ++ks) { const bf16x8 av = *(const LAS bf16x8*)(Cn + (32 * lt + r32) * SA_P + 16 * ks + 8 * hi), bv = *(const LAS bf16x8*)(Bn + (32 * st + r32) * SA_P + 16 * ks + 8 * hi);
              a = __builtin_amdgcn_mfma_f32_32x32x16_bf16(av, bv, a, 0, 0, 0); }
#pragma unroll
          for (int r = 0; r < 16; ++r) CB[(32 * lt + crow(r, hi)) * SA_P + 32 * st + r32] = f2bf(a[r]); } }
    __syncthreads();
    const int j = w >> 1, sub = w & 1, h = 8 * g + 4 * hf + j;
    LAS bf16* XT = (LAS bf16*)(F.lds() + j * 17408);
    LAS float* cs_l = (LAS float*)(F.lds() + SA_SM) + j * 384; LAS float* wdec = cs_l + 128;
    {
        const float ah = -__expf(F.f(9)[h]);
        const float d0 = dtg[(size_t)(tok0 + lane) * 16 + h], d1 = dtg[(size_t)(tok0 + 64 + lane) * 16 + h];
        float c0 = d0 * ah, c1 = d1 * ah;
#pragma unroll
        for (int o = 1; o < 64; o <<= 1) { const float t0 = __shfl_up(c0, o), t1 = __shfl_up(c1, o); if (lane >= o) { c0 += t0; c1 += t1; } }
        const float tot0 = __shfl(c0, 63); c1 += tot0; const float cend = __shfl(c1, 63);
        if (sub == 0) { cs_l[lane] = c0; cs_l[64 + lane] = c1; wdec[lane] = __expf(cend - c0); wdec[64 + lane] = __expf(cend - c1);
            csg[(size_t)(tok0 + lane) * 16 + h] = c0; csg[(size_t)(tok0 + 64 + lane) * 16 + h] = c1; }
#pragma unroll 4
        for (int i = 0; i < 8; ++i) { const int id = lane + 64 * i, s = 64 * sub + (id >> 3), ch = id & 7, chan = h * 64 + ch * 8; float o[8];
            conv8(xbc + (size_t)(tok0 + s) * CONV_CH + chan, c * CHUNK + s, F.f(6) + chan, F.f(7) + chan, o);
            u32x4 pk = {cvt_pk_bf16(o[0], o[1]), cvt_pk_bf16(o[2], o[3]), cvt_pk_bf16(o[4], o[5]), cvt_pk_bf16(o[6], o[7])};
            *(u32x4*)(xact + (size_t)(tok0 + s) * CONV_CH + chan) = pk;
            const float dts = dtg[(size_t)(tok0 + s) * 16 + h];
#pragma unroll
            for (int jj = 0; jj < 8; ++jj) XT[(ch * 8 + jj) * SA_P + s] = f2bf(o[jj] * dts); }
    }
    __syncthreads();
#pragma unroll
    for (int lq = 0; lq < 2; ++lq) { const int lt = 2 * sub + lq; const int l = 32 * lt + r32; const float csl = cs_l[l];
        f32x16 a0 = {}, a1 = {};
        for (int ks = 0; ks <= 2 * lt + 1; ++ks) { const int s0 = 16 * ks + 8 * hi;
            float cbf[8]; unpack8(*(const LAS bf16x8*)(CB + l * SA_P + s0), cbf);
            const f32x4 q0 = *(const LAS f32x4*)(cs_l + s0), q1 = *(const LAS f32x4*)(cs_l + s0 + 4);
            float mv[8];
#pragma unroll
            for (int jj = 0; jj < 8; ++jj) { const float cq = jj < 4 ? q0[jj & 3] : q1[jj & 3]; mv[jj] = (s0 + jj <= l) ? cbf[jj] * __expf(csl - cq) : 0.f; }
            const bf16x8 av = pack8((f32x4){mv[0], mv[1], mv[2], mv[3]}, (f32x4){mv[4], mv[5], mv[6], mv[7]});
            const bf16x8 b0 = *(const LAS bf16x8*)(XT + r32 * SA_P + s0), b1 = *(const LAS bf16x8*)(XT + (32 + r32) * SA_P + s0);
            a0 = __builtin_amdgcn_mfma_f32_32x32x16_bf16(av, b0, a0, 0, 0, 0); a1 = __builtin_amdgcn_mfma_f32_32x32x16_bf16(av, b1, a1, 0, 0, 0); }
#pragma unroll
        for (int r = 0; r < 16; ++r) { float* yp = ydiag + (size_t)(tok0 + 32 * lt + crow(r, hi)) * D_SSM + h * 64 + r32; yp[0] = a0[r]; yp[32] = a1[r]; } }
    { f32x16 a[2][2] = {};
      for (int ks = 0; ks < 8; ++ks) { const int s0 = 16 * ks + 8 * hi;
          const f32x4 q0 = *(const LAS f32x4*)(wdec + s0), q1 = *(const LAS f32x4*)(wdec + s0 + 4);
          bf16x8 av[2];
#pragma unroll
          for (int pt = 0; pt < 2; ++pt) { float xf[8]; unpack8(*(const LAS bf16x8*)(XT + (32 * pt + r32) * SA_P + s0), xf);
              av[pt] = pack8((f32x4){xf[0] * q0[0], xf[1] * q0[1], xf[2] * q0[2], xf[3] * q0[3]}, (f32x4){xf[4] * q1[0], xf[5] * q1[1], xf[6] * q1[2], xf[7] * q1[3]}); }
#pragma unroll
          for (int nq = 0; nq < 2; ++nq) { const bf16x8 bv = *(const LAS bf16x8*)(BT + (32 * (2 * sub + nq) + r32) * SA_P + s0);
#pragma unroll
              for (int pt = 0; pt < 2; ++pt) a[pt][nq] = __builtin_amdgcn_mfma_f32_32x32x16_bf16(av[pt], bv, a[pt][nq], 0, 0, 0); } }
      float* sp = states + ((size_t)((b * NCHUNK + c) * SSM_H + h) * SSM_P) * SSM_N;
#pragma unroll
      for (int pt = 0; pt < 2; ++pt)
#pragma unroll
          for (int nq = 0; nq < 2; ++nq)
#pragma unroll
              for (int r = 0; r < 16; ++r) sp[(size_t)(32 * pt + crow(r, hi)) * SSM_N + 32 * (2 * sub + nq) + r32] = a[pt][nq][r]; }
    __syncthreads();
}
constexpr int N_SSD_A = NBATCH * NCHUNK * 2 * 2, N_IDX_U = 256;
__device__ __forceinline__ void p3_ssd(Frame& F) {
#pragma unroll 1
    for (int L = F.bid(); L < N_SSD_A; L += F.G()) { const int hf = L & 1, g = (L >> 1) & 1, c = (L >> 2) & 31, b = L >> 7; ssd_a_unit(F, b, c, g, hf); }
}
__device__ __forceinline__ void p3_idx(Frame& F) {
    int L = F.bid(); while (L < N_SSD_A) L += F.G();
#pragma unroll 1
    for (; L < N_SSD_A + N_IDX_U; L += F.G()) { const int p0 = L - N_SSD_A, b = p0 >> 7, par = p0 & 1, s = (p0 >> 1) & 63;
        idx_unit(F, b, 127 - s, par); idx_unit(F, b, s, par); }
}
__device__ __forceinline__ unsigned fkey(float f) { const unsigned u = __float_as_uint(f); return (u & 0x80000000u) ? ~u : (u | 0x80000000u); }
__device__ __forceinline__ void select_row(Frame& F, int row, LAS unsigned* hist, LAS unsigned* keys) {
    const float* sc = WSP(const float, WS_SCORES) + (size_t)row * SEQ; unsigned long long* mrow = WSP(unsigned long long, WS_MASK) + (size_t)row * 64;
    const int lane = F.lane(), t = row & (SEQ - 1);
    if (t < TOPK_SEL) {
        const int lo = 64 * lane; unsigned long long m;
        if (lo + 63 <= t) m = ~0ull; else if (lo > t) m = 0ull; else m = (1ull << (t - lo + 1)) - 1ull;
        mrow[lane] = m; return;
    }
    const int nI = (t >> 6) + 1;
    float amax = 0.f;
    const int n4 = (t >> 8) + 1;
#pragma unroll 8
    for (int i = 0; i < n4; ++i) { const int e0 = 256 * i + 4 * lane; const f32x4 v = *(const f32x4*)(sc + e0);
        u32x4 kb;
#pragma unroll
        for (int j = 0; j < 4; ++j) { const bool ok = (e0 + j <= t); kb[j] = ok ? __float_as_uint(v[j]) : 0u; amax = fmaxf(amax, ok ? fabsf(v[j]) : 0.f); }
        *(LAS u32x4*)(keys + e0) = kb; }
#pragma unroll
    for (int o = 1; o < 64; o <<= 1) amax = fmaxf(amax, __shfl_xor(amax, o));
    const float ks = 0.49f / fmaxf(amax, 1e-30f);
    unsigned prefix = 0u, need = TOPK_SEL, pmask = 0u, cnt_eq = 0u;
#pragma unroll 1
    for (int pass = 0; pass < 3; ++pass) { const int shift = (pass == 0) ? 15 : (pass == 1 ? 7 : 0); const unsigned dmask = (pass == 2) ? 127u : 255u;
        hist[4 * lane] = 0u; hist[4 * lane + 1] = 0u; hist[4 * lane + 2] = 0u; hist[4 * lane + 3] = 0u;
        LDS_WAIT(); asm volatile("" ::: "memory");
        if (pass == 0) {
#pragma unroll 1
            for (int i0 = 0; i0 < nI; i0 += 8) { unsigned kk[8];
#pragma unroll
                for (int j = 0; j < 8; ++j) { const int e = 64 * (i0 + j) + lane; kk[j] = keys[e & 4095]; }
#pragma unroll
                for (int j = 0; j < 8; ++j) { const int e = 64 * (i0 + j) + lane; kk[j] = (e <= t) ? (__float_as_uint(fmaf(__uint_as_float(kk[j]), ks, 1.5f)) & 0x7fffffu) : 0u; }
#pragma unroll
                for (int j = 0; j < 8; ++j) { const int e = 64 * (i0 + j) + lane; if (i0 + j < nI) keys[e] = kk[j];
                    if (kk[j] != 0u) __hip_atomic_fetch_add(hist + (kk[j] >> 15), 1u, __ATOMIC_RELAXED, __HIP_MEMORY_SCOPE_WORKGROUP); } }
        } else {
#pragma unroll 1
            for (int i0 = 0; i0 < nI; i0 += 8) { unsigned kk[8];
#pragma unroll
                for (int j = 0; j < 8; ++j) { const int e = 64 * (i0 + j) + lane; kk[j] = (i0 + j < nI) ? keys[e & 4095] : 0u; }
#pragma unroll
                for (int j = 0; j < 8; ++j) if ((kk[j] & pmask) == prefix && kk[j] != 0u) __hip_atomic_fetch_add(hist + ((kk[j] >> shift) & dmask), 1u, __ATOMIC_RELAXED, __HIP_MEMORY_SCOPE_WORKGROUP); }
        }
        LDS_WAIT(); asm volatile("" ::: "memory");
        const unsigned c0 = hist[4 * lane], c1 = hist[4 * lane + 1], c2 = hist[4 * lane + 2], c3 = hist[4 * lane + 3];
        const unsigned tot = c0 + c1 + c2 + c3;
        unsigned suf = tot;
#pragma unroll
        for (int o = 1; o < 64; o <<= 1) { const unsigned tt = __shfl_down(suf, o); if (lane + o < 64) suf += tt; }
        unsigned above = suf - tot;
        int found = -1; unsigned nneed = 0u, fcnt = 0u;
        if (above < need && need <= above + c3) { found = 3; nneed = need - above; fcnt = c3; }
        above += c3;
        if (found < 0 && above < need && need <= above + c2) { found = 2; nneed = need - above; fcnt = c2; }
        above += c2;
        if (found < 0 && above < need && need <= above + c1) { found = 1; nneed = need - above; fcnt = c1; }
        above += c1;
        if (found < 0 && above < need && need <= above + c0) { found = 0; nneed = need - above; fcnt = c0; }
        const unsigned long long bal = __ballot(found >= 0);
        const int src = (int)__builtin_ctzll(bal | (1ull << 63));
        const unsigned digit = (unsigned)__shfl(4 * lane + found, src);
        need = (unsigned)__shfl((int)nneed, src); cnt_eq = (unsigned)__shfl((int)fcnt, src);
        prefix |= digit << shift; pmask |= dmask << shift;
        LDS_WAIT(); asm volatile("" ::: "memory");
    }
    const bool all_eq = (cnt_eq == need);
    unsigned run = 0u; unsigned long long myword = 0ull;
    const unsigned long long lt_mask = (lane == 0) ? 0ull : (~0ull >> (64 - lane));
#pragma unroll 4
    for (int i = 0; i < nI; ++i) {
        const unsigned k = keys[64 * i + lane]; bool sel = k > prefix;
        if (all_eq) { sel = sel || (k == prefix); }
        else { const unsigned long long em = __ballot(k == prefix); if (k == prefix) sel = (run + (unsigned)__popcll(em & lt_mask)) < need; run += (unsigned)__popcll(em); }
        const unsigned long long wb = __ballot(sel);
        if (lane == i) myword = wb;
    }
    mrow[lane] = myword;
    LDS_WAIT(); asm volatile("" ::: "memory");
}
__device__ __forceinline__ void p4_select(Frame& F) {
    LAS unsigned* keys = (LAS unsigned*)(F.lds() + F.wave() * 16384); LAS unsigned* hist = (LAS unsigned*)(F.lds() + 131072 + F.wave() * 1024);
    const int gw = F.bid() * 8 + F.wave(), NGW = F.G() * 8;
    for (int pr = gw; pr < SEQ / 2; pr += NGW) {
#pragma unroll 1
        for (int b = 0; b < NBATCH; ++b) { select_row(F, b * SEQ + pr, hist, keys); select_row(F, b * SEQ + (SEQ - 1 - pr), hist, keys); }
    }
}
__device__ __forceinline__ void p4_scan(Frame& F) {
    const CAS float* states = (const CAS float*)(F.ws() + WS_STATES); bf16* hin = WSP(bf16, WS_HIN); const CAS float* csg = (const CAS float*)(F.ws() + WS_CS);
    const int gt = F.bid() * 512 + F.tid(), NGT = F.G() * 512;
    for (int q = gt; q < NBATCH * SSM_H * SSM_P * (SSM_N / 2); q += NGT) {
        const int n = 2 * (q & 63), p = (q >> 6) & 63, h = (q >> 12) & 15, b = q >> 16;
        float h0 = 0.f, h1 = 0.f;
#pragma unroll 8
        for (int c = 0; c < NCHUNK; ++c) {
            const size_t off = ((size_t)((b * NCHUNK + c) * SSM_H + h) * SSM_P + p) * SSM_N + n;
            *(unsigned*)(hin + off) = cvt_pk_bf16(h0, h1);
            const float dec = __expf(csg[(size_t)(b * SEQ + c * CHUNK + CHUNK - 1) * 16 + h]);
            const f32x2 st = *(const CAS f32x2*)(states + off);
            h0 = dec * h0 + st[0]; h1 = dec * h1 + st[1];
        }
    }
}
namespace att {
constexpr int KVBLK = 64, SHM_K = KVBLK * 128 * 2, SHM_V = SHM_K;
constexpr float SCALE = 0.08838834764831845f, THR = 8.f, C2 = 1.4426950408889634f * SCALE;
#define KSWZ(row, colB) ((row) * 256 + ((colB) ^ (((row) & 7) << 4)))
__device__ __forceinline__ int v_st(int k, int c) { const int kk = (k & ~0xC) | ((k & 4) << 1) | ((k & 8) >> 1); return ((kk >> 3) * 4 + (c >> 5)) * 512 + ((kk & 7) * 32 + (c & 31)) * 2; }
__device__ __forceinline__ int v_rd_base(int lane) { return ((lane & 3) << 3) | (((lane >> 2) & 3) << 6) | (((lane >> 4) & 1) << 5) | (((lane >> 5) & 1) << 8); }
constexpr int v_rd_off(int d0, int ks, int half) { return d0 * 512 + ks * 4096 + half * 2048; }
template <int KB>
__device__ __forceinline__ void qkt(f32x16& p0, f32x16& p1, LAS const char* K_lds, int r32, int hi, const bf16x8* qr) {
    p0 = f32x16{}; p1 = f32x16{};
    LAS const char* kb[4];
#pragma unroll
    for (int dd = 0; dd < 4; ++dd) kb[dd] = K_lds + KB * SHM_K + KSWZ(r32, (dd * 16 + hi * 8) * 2);
#pragma unroll
    for (int d0 = 0; d0 < 8; ++d0) { LAS const char* a = kb[d0 & 3] + (d0 >> 2) * 128;
        const bf16x8 b0 = *(LAS const bf16x8*)a;
        const bf16x8 b1 = *(LAS const bf16x8*)(a + 32 * 256);
        p0 = __builtin_amdgcn_mfma_f32_32x32x16_bf16(b0, qr[d0], p0, 0, 0, 0);
        p1 = __builtin_amdgcn_mfma_f32_32x32x16_bf16(b1, qr[d0], p1, 0, 0, 0); }
}
template <int VB>
__device__ __forceinline__ void pv_tile(f32x16* o, int vb0, bf16x8 pa0, bf16x8 pa1, bf16x8 pa2, bf16x8 pa3) {
#define TRRD(dst, off) asm volatile("ds_read_b64_tr_b16 %0, %1 offset:%2" : "=&v"(dst) : "v"(vb0), "i"(off) : "memory")
#define PV_D0(d0) do { s16x4 l0, l1, l2, l3, h0, h1, h2, h3; constexpr int b_ = VB * SHM_V + v_rd_off(d0, 0, 0); \
        TRRD(l0, b_); TRRD(h0, b_ + 2048); TRRD(l1, b_ + 4096); TRRD(h1, b_ + 6144); TRRD(l2, b_ + 8192); TRRD(h2, b_ + 10240); TRRD(l3, b_ + 12288); TRRD(h3, b_ + 14336); \
        asm volatile("s_waitcnt lgkmcnt(0)" ::: "memory"); __builtin_amdgcn_sched_barrier(0); \
        o[d0] = __builtin_amdgcn_mfma_f32_32x32x16_bf16(pa0, (bf16x8){l0[0], l0[1], l0[2], l0[3], h0[0], h0[1], h0[2], h0[3]}, o[d0], 0, 0, 0);   \
        o[d0] = __builtin_amdgcn_mfma_f32_32x32x16_bf16(pa1, (bf16x8){l1[0], l1[1], l1[2], l1[3], h1[0], h1[1], h1[2], h1[3]}, o[d0], 0, 0, 0);   \
        o[d0] = __builtin_amdgcn_mfma_f32_32x32x16_bf16(pa2, (bf16x8){l2[0], l2[1], l2[2], l2[3], h2[0], h2[1], h2[2], h2[3]}, o[d0], 0, 0, 0);   \
        o[d0] = __builtin_amdgcn_mfma_f32_32x32x16_bf16(pa3, (bf16x8){l3[0], l3[1], l3[2], l3[3], h3[0], h3[1], h3[2], h3[3]}, o[d0], 0, 0, 0); } while (0)
    PV_D0(0); PV_D0(1); PV_D0(2); PV_D0(3);
#undef PV_D0
#undef TRRD
}
__device__ __forceinline__ void softmax_tile(f32x16& p0, f32x16& p1, unsigned long long mw, int hi, float& m_reg, float& l_reg, float& alpha, bf16x8& pa0, bf16x8& pa1, bf16x8& pa2, bf16x8& pa3) {
    float pmax = p0[0];
#pragma unroll
    for (int r = 1; r < 16; ++r) pmax = fmaxf(pmax, p0[r]);
#pragma unroll
    for (int r = 0; r < 16; ++r) pmax = fmaxf(pmax, p1[r]);
    { auto rr = __builtin_amdgcn_permlane32_swap(__float_as_uint(pmax), __float_as_uint(pmax), false, false); pmax = fmaxf(__uint_as_float(rr[0]), __uint_as_float(rr[1])); }
    float mn;
    if (__all((pmax - m_reg) * SCALE <= THR)) { mn = m_reg; alpha = 1.f; }
    else { mn = fmaxf(m_reg, pmax); alpha = __builtin_amdgcn_exp2f((m_reg - mn) * C2); m_reg = mn; }
    const float mnL = -mn * C2;
    const int lo = (int)((unsigned)mw >> (4 * hi)), hh = (int)((unsigned)(mw >> 32) >> (4 * hi));
#pragma unroll
    for (int r = 0; r < 16; ++r) { const int c = (r & 3) + 8 * (r >> 2);
        const float e0 = __builtin_amdgcn_exp2f(fmaf(p0[r], C2, mnL)), e1 = __builtin_amdgcn_exp2f(fmaf(p1[r], C2, mnL));
        p0[r] = __uint_as_float(__float_as_uint(e0) & (unsigned)__builtin_amdgcn_sbfe(lo, c, 1));
        p1[r] = __uint_as_float(__float_as_uint(e1) & (unsigned)__builtin_amdgcn_sbfe(hh, c, 1)); }
    float ps = 0.f;
#pragma unroll
    for (int r = 0; r < 16; ++r) ps += p0[r];
#pragma unroll
    for (int r = 0; r < 16; ++r) ps += p1[r];
    { auto rr = __builtin_amdgcn_permlane32_swap(__float_as_uint(ps), __float_as_uint(ps), false, false); ps = __uint_as_float(rr[0]) + __uint_as_float(rr[1]); }
    l_reg = l_reg * alpha + ps;
#define PK4(P, B_, OUT) do { unsigned a0 = cvt_pk_bf16(P[B_+0], P[B_+1]), a1 = cvt_pk_bf16(P[B_+2], P[B_+3]); \
        unsigned b0 = cvt_pk_bf16(P[B_+4], P[B_+5]), b1 = cvt_pk_bf16(P[B_+6], P[B_+7]); \
        auto r0 = __builtin_amdgcn_permlane32_swap(a0, b0, false, false); auto r1 = __builtin_amdgcn_permlane32_swap(a1, b1, false, false); \
        u32x4 w = {r0[0], r1[0], r0[1], r1[1]}; OUT = __builtin_bit_cast(bf16x8, w); } while (0)
    PK4(p0, 0, pa0); PK4(p0, 8, pa1); PK4(p1, 0, pa2); PK4(p1, 8, pa3);
#undef PK4
}
}

__device__ __forceinline__ void attn_item(Frame& F, int b, int h, int X) {
    using namespace att;
    const bf16* qg = WSP(const bf16, WS_Q); const bf16* kg = WSP(const bf16, WS_K) + (size_t)(b * SEQ) * 1024 + h * 128; const bf16* vg = WSP(const bf16, WS_V) + (size_t)(b * SEQ) * 1024 + h * 128;
    const unsigned long long* maskg = WSP(const unsigned long long, WS_MASK); bf16* ycat = WSP(bf16, WS_YCAT);
    const int tid = F.tid(), wid = F.wave(), lane = F.lane(), r32 = lane & 31, hi = lane >> 5;
    LAS char* V_lds = (LAS char*)F.lds(); LAS char* K_lds = V_lds + 2 * SHM_V;
    LAS float* wsl = (LAS float*)(F.lds() + 2 * SHM_V + 2 * SHM_K) + wid * 64; LAS float* li_l = wsl; LAS float* al_l = wsl + 32;
    const int tokq = b * SEQ + X * 256 + wid * 32 + r32, NT = 4 * X + 4;
    bf16x8 qr[8];
#pragma unroll
    for (int d0 = 0; d0 < 8; ++d0) qr[d0] = *(const bf16x8*)(qg + (size_t)tokq * 1024 + h * 128 + d0 * 16 + hi * 8);
    const unsigned long long* mrow = maskg + (size_t)tokq * 64;
    const int sr = tid >> 4, sc = (tid & 15) * 8, vst0 = v_st(sr, sc), vst1 = v_st(32 + sr, sc), kws = KSWZ(sr, sc * 2);
    const int vb0 = (int)(unsigned)(uintptr_t)V_lds + v_rd_base(lane);
    float m_reg = -1e30f, l_reg = 0.f; f32x16 o[4] = {};
    bf16x8 sA[4], sB[4];
    unsigned long long mwE, mwO;
#define ALOAD(S, t) do { const size_t r0_ = (size_t)((t) * KVBLK + sr) * 1024 + sc; S[0] = *(const bf16x8*)(kg + r0_); S[1] = *(const bf16x8*)(kg + r0_ + 32 * 1024); \
                         S[2] = *(const bf16x8*)(vg + r0_); S[3] = *(const bf16x8*)(vg + r0_ + 32 * 1024); } while (0)
#define AWRITE(S, bf) do { *(LAS bf16x8*)(K_lds + (bf) * SHM_K + kws) = S[0]; *(LAS bf16x8*)(K_lds + (bf) * SHM_K + kws + 32 * 256) = S[1]; \
                           *(LAS bf16x8*)(V_lds + (bf) * SHM_V + vst0) = S[2]; *(LAS bf16x8*)(V_lds + (bf) * SHM_V + vst1) = S[3]; } while (0)
#define ASTEP(t, KB, SW, MW) do { __syncthreads(); \
        if ((t) + 1 < NT) AWRITE(SW, (KB) ^ 1); \
        if ((t) + 3 < NT) ALOAD(SW, (t) + 3); \
        const unsigned long long mw_ = MW; if ((t) + 2 < NT) MW = mrow[(t) + 2]; \
        f32x16 p0, p1; float alpha; bf16x8 pa0, pa1, pa2, pa3; \
        qkt<KB>(p0, p1, K_lds, r32, hi, qr); \
        softmax_tile(p0, p1, mw_, hi, m_reg, l_reg, alpha, pa0, pa1, pa2, pa3); \
        if (__any(alpha < 1.f)) { if (hi == 0) al_l[r32] = alpha; LDS_WAIT(); \
            _Pragma("unroll") for (int d_ = 0; d_ < 4; ++d_) _Pragma("unroll") for (int r = 0; r < 16; ++r) o[d_][r] *= al_l[crow(r, hi)]; } \
        pv_tile<KB>(o, vb0, pa0, pa1, pa2, pa3); } while (0)
    ALOAD(sA, 0); mwE = mrow[0]; mwO = mrow[1];
    AWRITE(sA, 0);
    ALOAD(sB, 1); ALOAD(sA, 2);
    for (int t = 0; t < NT; t += 2) { ASTEP(t, 0, sB, mwE); ASTEP(t + 1, 1, sA, mwO); }
#undef ASTEP
#undef AWRITE
#undef ALOAD
    if (hi == 0) li_l[r32] = l_reg; LDS_WAIT();
    float rli[16];
#pragma unroll
    for (int r = 0; r < 16; ++r) rli[r] = __builtin_amdgcn_rcpf(li_l[crow(r, hi)]);
    bf16* Ow = ycat + (size_t)(b * SEQ + X * 256 + wid * 32) * DM + D_SSM + h * 128;
#pragma unroll
    for (int r = 0; r < 16; ++r) { const int orow = crow(r, hi);
#pragma unroll
        for (int d0 = 0; d0 < 4; ++d0) { const float v = o[d0][r] * rli[r]; const float vn = __shfl_xor(v, 1);
            if ((r32 & 1) == 0) *(unsigned*)(Ow + (size_t)orow * DM + d0 * 32 + r32) = cvt_pk_bf16(v, vn); } }
    __syncthreads();
}

__device__ __forceinline__ void ssd_c_unit(Frame& F, int b, int c, int lq) {
    const CAS bf16* xact = (const CAS bf16*)(F.ws() + WS_XBCACT); const CAS bf16* hin = (const CAS bf16*)(F.ws() + WS_HIN); const CAS float* csg = (const CAS float*)(F.ws() + WS_CS);
    const CAS float* ydiag = (const CAS float*)(F.ws() + WS_YDIAG); const CAS bf16* zg = (const CAS bf16*)(F.ws() + WS_Z); bf16* ycat = WSP(bf16, WS_YCAT);
    LAS float* gb = (LAS float*)F.lds();
    const int lane = F.lane(), r32 = lane & 31, hi = lane >> 5, w = F.wave(), g = w >> 2;
    const int tok0 = b * SEQ + c * CHUNK + lq * 32;
    bf16x8 Af[8];
#pragma unroll
    for (int ks = 0; ks < 8; ++ks) Af[ks] = *(const CAS bf16x8*)(xact + (size_t)(tok0 + r32) * CONV_CH + 1280 + g * 128 + 16 * ks + 8 * hi);
#pragma unroll
    for (int hh = 0; hh < 2; ++hh) { const int h = 2 * w + hh;
        const CAS bf16* hp = hin + ((size_t)((b * NCHUNK + c) * SSM_H + h) * SSM_P) * SSM_N;
        float e[16];
#pragma unroll
        for (int r = 0; r < 16; ++r) e[r] = csg[(size_t)(tok0 + crow(r, hi)) * 16 + h];
        f32x16 a0 = {}, a1 = {};
#pragma unroll
        for (int ks = 0; ks < 8; ++ks) { const bf16x8 b0 = *(const CAS bf16x8*)(hp + (size_t)r32 * SSM_N + 16 * ks + 8 * hi), b1 = *(const CAS bf16x8*)(hp + (size_t)(32 + r32) * SSM_N + 16 * ks + 8 * hi);
            a0 = __builtin_amdgcn_mfma_f32_32x32x16_bf16(Af[ks], b0, a0, 0, 0, 0); a1 = __builtin_amdgcn_mfma_f32_32x32x16_bf16(Af[ks], b1, a1, 0, 0, 0); }
#pragma unroll
        for (int r = 0; r < 16; ++r) { const float ee = __expf(e[r]); LAS float* p = gb + crow(r, hi) * 1024 + h * 64 + r32; p[0] = ee * a0[r]; p[32] = ee * a1[r]; } }
    __syncthreads();
    f32x4 dsk[4], nw[4];
#pragma unroll
    for (int j = 0; j < 4; ++j) { const float d = F.f(10)[4 * j + (lane >> 4)]; dsk[j] = (f32x4){d, d, d, d}; nw[j] = *(const CAS f32x4*)(F.f(11) + j * 256 + lane * 4); }
    f32x4 yd[4][4]; u32x2 xs[4][4], zz[4][4];
#pragma unroll
    for (int rr = 0; rr < 4; ++rr) { const size_t tok = (size_t)(tok0 + 4 * w + rr);
#pragma unroll
        for (int j = 0; j < 4; ++j) { const int col = j * 256 + lane * 4; yd[rr][j] = *(const CAS f32x4*)(ydiag + tok * D_SSM + col);
            xs[rr][j] = *(const CAS u32x2*)(xact + tok * CONV_CH + col); zz[rr][j] = *(const CAS u32x2*)(zg + tok * 1024 + col); } }
#pragma unroll
    for (int rr = 0; rr < 4; ++rr) { const int l = 4 * w + rr; float ss = 0.f; f32x4 v[4];
#pragma unroll
        for (int j = 0; j < 4; ++j) { const f32x4 yo = *(const LAS f32x4*)(gb + l * 1024 + j * 256 + lane * 4);
            const f32x4 xf = {bflo(xs[rr][j][0]), bfhi(xs[rr][j][0]), bflo(xs[rr][j][1]), bfhi(xs[rr][j][1])}, zf = {bflo(zz[rr][j][0]), bfhi(zz[rr][j][0]), bflo(zz[rr][j][1]), bfhi(zz[rr][j][1])};
            f32x4 y = yd[rr][j] + yo + dsk[j] * xf;
#pragma unroll
            for (int i = 0; i < 4; ++i) y[i] *= silu_f(zf[i]);
            v[j] = y; ss += (y[0] * y[0] + y[1] * y[1]) + (y[2] * y[2] + y[3] * y[3]); }
        const float rs = 1.0f / sqrtf(wave_sum(ss) * (1.0f / 1024.0f) + LN_EPS);
#pragma unroll
        for (int j = 0; j < 4; ++j) { const f32x4 y = v[j] * rs * nw[j];
            *(u32x2*)(ycat + (size_t)(tok0 + l) * DM + j * 256 + lane * 4) = (u32x2){cvt_pk_bf16(y[0], y[1]), cvt_pk_bf16(y[2], y[3])}; } }
    __syncthreads();
}
__device__ __forceinline__ void p5_phase(Frame& F) {
    for (int L = F.bid(); L < 256; L += F.G()) { const int lq = L & 3, c = (L >> 2) & 31, b = L >> 7; ssd_c_unit(F, b, c, lq); }
    PSUB(50, 0);
    for (int L = F.bid(); L < 256; L += F.G()) { const int X = 15 - (L >> 4), h = L & 7, b = (L >> 3) & 1; attn_item(F, b, h, X); }
    PSUB(50, 1);
}
struct EpiOutProj {
    static constexpr bool PERM = false;
    const CAS float* x; const CAS float* modf; float* out;
    __device__ __forceinline__ void operator()(const f32x4 (&acc)[2][2][4][2], const pg8::Unit& u, int wr, int wc, int fr, int fq) const {
        const int row0 = u.pm * 256 + wr * 64 + fr, col0 = u.pn * 256 + wc * 32 + 4 * fq; const int b = (u.pm * 256) / SEQ;
        f32x4 gv[2][2];
#pragma unroll
        for (int bj = 0; bj < 2; ++bj)
#pragma unroll
            for (int n = 0; n < 2; ++n) gv[bj][n] = *(const CAS f32x4*)(modf + (size_t)b * (6 * DM) + 2 * DM + col0 + bj * 128 + n * 16);
#pragma unroll
        for (int ai = 0; ai < 2; ++ai)
#pragma unroll
            for (int m = 0; m < 4; ++m) { const size_t off = (size_t)(row0 + ai * 128 + m * 16) * DM + col0;
#pragma unroll
                for (int bj = 0; bj < 2; ++bj)
#pragma unroll
                    for (int n = 0; n < 2; ++n) { const f32x4 xv = *(const CAS f32x4*)(x + off + bj * 128 + n * 16);
                        *(f32x4*)(out + off + bj * 128 + n * 16) = xv * ALPHA_DN + gv[bj][n] * acc[ai][bj][m][n]; } }
    }
};

constexpr int RT_P = 2056;
__device__ __forceinline__ void p7_unit(Frame& F, int un) {
    const CAS float* modf = (const CAS float*)(F.ws() + WS_MODF); bf16* u2 = WSP(bf16, WS_U2); const CAS bf16* wr_hi = (const CAS bf16*)(F.ws() + WS_WR); const CAS bf16* wr_lo = wr_hi + NE * DM;
    int* inv = WSP(int, WS_INV); int* ltok = WSP(int, WS_LTOK); float* lw = WSP(float, WS_LW);
    LAS bf16* Ah = (LAS bf16*)F.lds(); LAS bf16* Al = Ah + 16 * RT_P; LAS float* red = (LAS float*)F.lds();
    LAS float* logit = (LAS float*)(F.lds() + 135168);
    LAS int* ecnt = (LAS int*)(F.lds() + 139264); LAS int* ebase = ecnt + 64;
    const int lane = F.lane(), w = F.wave(), row0 = un * 16, b = row0 / SEQ;
    const CAS float* sh2 = modf + (size_t)b * (6 * DM) + 3 * DM; const CAS float* sc2 = modf + (size_t)b * (6 * DM) + 4 * DM;
    PSUB(70, 0); PSUB(71, 0);
#pragma unroll 1
    for (int rr = 0; rr < 2; ++rr) { const int rl = 2 * w + rr; const size_t row = (size_t)(row0 + rl);
        f32x4 v[8]; float s = 0.f;
#pragma unroll
        for (int j = 0; j < 8; ++j) { v[j] = *(const f32x4*)(F.out() + row * DM + j * 256 + lane * 4); s += (v[j][0] + v[j][1]) + (v[j][2] + v[j][3]); }
        const float mu = wave_sum(s) * (1.0f / DM); float q = 0.f;
#pragma unroll
        for (int j = 0; j < 8; ++j) { v[j] = v[j] - mu; q += (v[j][0] * v[j][0] + v[j][1] * v[j][1]) + (v[j][2] * v[j][2] + v[j][3] * v[j][3]); }
        const float rstd = 1.0f / sqrtf(wave_sum(q) * (1.0f / DM) + LN_EPS);
#pragma unroll
        for (int j = 0; j < 8; ++j) { const int col = j * 256 + lane * 4;
            const f32x4 x1 = v[j] * rstd * *(const CAS f32x4*)(F.f(15) + col) + *(const CAS f32x4*)(F.f(16) + col);
            *(f32x4*)(F.out() + row * DM + col) = x1;
            const f32x4 uu = x1 * (*(const CAS f32x4*)(sc2 + col) + 1.0f) + *(const CAS f32x4*)(sh2 + col);
            const unsigned h0 = cvt_pk_bf16(uu[0], uu[1]), h1 = cvt_pk_bf16(uu[2], uu[3]);
            *(u32x2*)(u2 + row * DM + col) = (u32x2){h0, h1};
            const unsigned l0 = cvt_pk_bf16(uu[0] - bflo(h0), uu[1] - bfhi(h0)), l1 = cvt_pk_bf16(uu[2] - bflo(h1), uu[3] - bfhi(h1));
            *(LAS u32x2*)(Ah + rl * RT_P + col) = (u32x2){h0, h1}; *(LAS u32x2*)(Al + rl * RT_P + col) = (u32x2){l0, l1}; } }
    if (F.tid() < 64) ecnt[F.tid()] = 0;
    __syncthreads();
    PSUB(70, 1); PSUB(72, 0);
    f32x4 acc[4] = {};
    { const int fr = lane & 15, fq = lane >> 4;
      bf16x8 bh[4][4], bl[4][4];
#pragma unroll
      for (int kb = 0; kb < 2; ++kb) {
#pragma unroll
          for (int kq = 0; kq < 4; ++kq) { const int k0_ = w * 256 + (4 * kb + kq) * 32 + fq * 8;
#pragma unroll
              for (int nt = 0; nt < 4; ++nt) { bh[kq][nt] = *(const CAS bf16x8*)(wr_hi + (size_t)(16 * nt + fr) * DM + k0_); bl[kq][nt] = *(const CAS bf16x8*)(wr_lo + (size_t)(16 * nt + fr) * DM + k0_); } }
#pragma unroll
          for (int kq = 0; kq < 4; ++kq) { const int k0_ = w * 256 + (4 * kb + kq) * 32 + fq * 8;
              const bf16x8 ah = *(const LAS bf16x8*)(Ah + fr * RT_P + k0_), al = *(const LAS bf16x8*)(Al + fr * RT_P + k0_);
#pragma unroll
              for (int nt = 0; nt < 4; ++nt) { acc[nt] = __builtin_amdgcn_mfma_f32_16x16x32_bf16(ah, bh[kq][nt], acc[nt], 0, 0, 0);
                  acc[nt] = __builtin_amdgcn_mfma_f32_16x16x32_bf16(al, bh[kq][nt], acc[nt], 0, 0, 0); acc[nt] = __builtin_amdgcn_mfma_f32_16x16x32_bf16(ah, bl[kq][nt], acc[nt], 0, 0, 0); } } }
      __syncthreads();
#pragma unroll
      for (int nt = 0; nt < 4; ++nt)
#pragma unroll
          for (int r = 0; r < 4; ++r) red[(w * 16 + fq * 4 + r) * 64 + 16 * nt + fr] = acc[nt][r]; }
    __syncthreads();
#pragma unroll
    for (int i = 0; i < 2; ++i) { const int o = F.tid() + 512 * i; float s = 0.f;
#pragma unroll
        for (int ww = 0; ww < 8; ++ww) s += red[ww * 1024 + o];
        logit[o] = s; }
    __syncthreads();
    PSUB(72, 1); PSUB(73, 0);
    float score_[2]; int erank_[2]; bool sel_[2];
#pragma unroll
    for (int rr = 0; rr < 2; ++rr) { const int rl = 2 * w + rr;
        const float score = sigmoid_f(logit[rl * 64 + lane]); const float biased = score + F.f(18)[lane];
        float m1 = biased;
#pragma unroll
        for (int o = 1; o < 8; o <<= 1) m1 = fmaxf(m1, __shfl_xor(m1, o));
        int i1 = (biased == m1) ? lane : 64;
#pragma unroll
        for (int o = 1; o < 8; o <<= 1) i1 = min(i1, __shfl_xor(i1, o));
        float m2 = (lane == i1) ? -__builtin_inff() : biased;
#pragma unroll
        for (int o = 1; o < 8; o <<= 1) m2 = fmaxf(m2, __shfl_xor(m2, o));
        const float gs = m1 + m2; const int grp = lane >> 3;
        int grank = 0;
#pragma unroll
        for (int g2 = 0; g2 < 8; ++g2) { const float og = __int_as_float(__builtin_amdgcn_readlane(__float_as_int(gs), 8 * g2)); grank += (og > gs || (og == gs && g2 < grp)) ? 1 : 0; }
        const float mk = (grank < 4) ? biased : -__builtin_inff();
        int erank = 0;
#pragma unroll 8
        for (int e2 = 0; e2 < 64; ++e2) { const float oe = __int_as_float(__builtin_amdgcn_readlane(__float_as_int(mk), e2)); erank += (oe > mk || (oe == mk && e2 < lane)) ? 1 : 0; }
        score_[rr] = score; erank_[rr] = erank; sel_[rr] = erank < 8; }
    int lr_[2]; float gw_[2];
#pragma unroll
    for (int rr = 0; rr < 2; ++rr) { const float wsum = wave_sum(sel_[rr] ? score_[rr] : 0.f); gw_[rr] = score_[rr] / wsum * 2.5f;
        lr_[rr] = sel_[rr] ? __hip_atomic_fetch_add(ecnt + lane, 1, __ATOMIC_RELAXED, __HIP_MEMORY_SCOPE_WORKGROUP) : 0; }
    __syncthreads();
    if (w == 0) { const int c = ecnt[lane]; ebase[lane] = c ? (int)__hip_atomic_fetch_add(F.ctl() + CW_ECNT + 64 * lane, (unsigned)c, RLX_AGENT) : 0; }
    __syncthreads();
#pragma unroll
    for (int rr = 0; rr < 2; ++rr) { const int tok = row0 + 2 * w + rr;
        if (sel_[rr]) { const int rk = ebase[lane] + lr_[rr];
            ltok[lane * NTOK + rk] = tok; lw[lane * NTOK + rk] = gw_[rr]; inv[tok * 8 + erank_[rr]] = lane * NTOK + rk; } }
    __syncthreads();
    PSUB(73, 1); PSUB(71, 1);
}
__device__ __forceinline__ void p7_phase(Frame& F) { for (int un = F.bid(); un < NTOK / 16; un += F.G()) p7_unit(F, un); }
struct MoeOrder {
    const LAS int* tab; const int* ltok; int G, c, npn;
    __device__ __forceinline__ bool next(int i, pg8::Unit& u) const {
        const int L = i * G + c; const int total = tab[80 + NEX] * npn; if (L >= total) return false;
        int e = 0;
#pragma unroll
        for (int st = 64; st >= 1; st >>= 1) { const int k = e + st; if (k < NEX && tab[80 + k] * npn <= L) e = k; }
        const int nte = tab[80 + e + 1] - tab[80 + e], rem = L - tab[80 + e] * npn;
        const int mt = (npn == 8) ? rem / npn : rem % nte, pn = (npn == 8) ? rem % npn : rem / nte;
        u.pm = tab[80 + e] + mt; u.pn = e * npn + pn; u.ax = (e << 8) | mt; return true;
    }
    __device__ __forceinline__ int row_tok(const pg8::Unit& u, int r) const {
        const int e = u.ax >> 8, idx = (u.ax & 255) * 256 + r;
        if (e == NE) return idx;
        return idx < tab[e] ? ltok[e * NTOK + idx] : 0;
    }
};
__device__ __forceinline__ void moe_tables(Frame& F) {
    LAS int* tab = (LAS int*)(F.lds() + LDS_MISC + 64);
    if (F.tid() == 0) { int cum = 0;
        for (int e = 0; e < NE; ++e) { const int cn = (int)__hip_atomic_load(F.ctl() + CW_ECNT + 64 * e, RLX_AGENT); tab[e] = cn; tab[80 + e] = cum; cum += (cn + 255) >> 8; }
        tab[NE] = NTOK; tab[80 + NE] = cum; cum += NTOK / 256; tab[80 + NEX] = cum; }
    __syncthreads();
}
struct EpiGateUp {
    static constexpr bool PERM = true;
    bf16* hid; const CAS float* lw; const LAS int* tab;
    __device__ __forceinline__ void operator()(const f32x4 (&acc)[2][2][4][2], const pg8::Unit& u, int wr, int wc, int fr, int fq) const {
        const int e = u.ax >> 8, mt = u.ax & 255, pn = u.pn & 3; const int cnt = tab[e];
#pragma unroll
        for (int ai = 0; ai < 2; ++ai)
#pragma unroll
            for (int m = 0; m < 4; ++m) { const int rl = ai * 128 + wr * 64 + m * 16 + fr, idx = mt * 256 + rl;
                const float gw = (e == NE) ? 1.0f : (idx < cnt ? lw[e * NTOK + idx] : 0.0f);
                f32x4 h0, h1;
#pragma unroll
                for (int i = 0; i < 4; ++i) { h0[i] = silu_f(acc[ai][0][m][0][i]) * acc[ai][1][m][0][i] * gw; h1[i] = silu_f(acc[ai][0][m][1][i]) * acc[ai][1][m][1][i] * gw; }
                u32x4 w = {cvt_pk_bf16(h0[0], h0[1]), cvt_pk_bf16(h0[2], h0[3]), cvt_pk_bf16(h1[0], h1[1]), cvt_pk_bf16(h1[2], h1[3])};
                *(u32x4*)(hid + (size_t)(u.pm * 256 + rl) * DE + pn * 128 + wc * 32 + 8 * fq) = w; }
    }
};
struct EpiDown {
    static constexpr bool PERM = true;
    bf16* outs;
    __device__ __forceinline__ void operator()(const f32x4 (&acc)[2][2][4][2], const pg8::Unit& u, int wr, int wc, int fr, int fq) const {
        const int pn = u.pn & 7;
#pragma unroll
        for (int ai = 0; ai < 2; ++ai)
#pragma unroll
            for (int m = 0; m < 4; ++m) { bf16* rowp = outs + (size_t)(u.pm * 256 + ai * 128 + wr * 64 + m * 16 + fr) * DM + pn * 256 + wc * 32 + 8 * fq;
#pragma unroll
                for (int bj = 0; bj < 2; ++bj) { const f32x4 v0 = acc[ai][bj][m][0], v1 = acc[ai][bj][m][1];
                    u32x4 w = {cvt_pk_bf16(v0[0], v0[1]), cvt_pk_bf16(v0[2], v0[3]), cvt_pk_bf16(v1[0], v1[1]), cvt_pk_bf16(v1[2], v1[3])};
                    *(u32x4*)(rowp + bj * 128) = w; } }
    }
};
__device__ __forceinline__ void p10_final(Frame& F) {
    const CAS float* modf = (const CAS float*)(F.ws() + WS_MODF); const CAS bf16* outs = (const CAS bf16*)(F.ws() + WS_OUTS); const CAS int* inv = (const CAS int*)(F.ws() + WS_INV);
    const LAS int* tab = (const LAS int*)(F.lds() + LDS_MISC + 64);
    const int gw = F.bid() * 8 + F.wave(), NGW = F.G() * 8;
    for (int tok = gw; tok < NTOK; tok += NGW) { int lane = F.lane(); asm volatile("" : "+v"(lane)); const int b = tok / SEQ; const CAS float* g2 = modf + (size_t)b * (6 * DM) + 5 * DM;
        size_t rows[9];
#pragma unroll
        for (int k = 0; k < 8; ++k) { const int iv = inv[tok * 8 + k]; const int e = iv / NTOK, rk = iv % NTOK; rows[k] = (size_t)(tab[80 + e] * 256 + rk); }
        rows[8] = (size_t)(tab[80 + NE] * 256 + tok);
        f32x4 v[8]; float s = 0.f;
#pragma unroll
        for (int jj = 0; jj < 4; ++jj) { const int col = jj * 512 + lane * 8; f32x4 f0 = {0.f, 0.f, 0.f, 0.f}, f1 = {0.f, 0.f, 0.f, 0.f};
#pragma unroll
            for (int k = 0; k < 9; ++k) { const u32x4 w = *(const CAS u32x4*)(outs + rows[k] * DM + col);
                f0[0] += bflo(w[0]); f0[1] += bfhi(w[0]); f0[2] += bflo(w[1]); f0[3] += bfhi(w[1]); f1[0] += bflo(w[2]); f1[1] += bfhi(w[2]); f1[2] += bflo(w[3]); f1[3] += bfhi(w[3]); }
            const f32x4 xa = *(const f32x4*)(F.out() + (size_t)tok * DM + col), xb = *(const f32x4*)(F.out() + (size_t)tok * DM + col + 4);
            v[2 * jj] = xa * ALPHA_DN + *(const CAS f32x4*)(g2 + col) * f0; v[2 * jj + 1] = xb * ALPHA_DN + *(const CAS f32x4*)(g2 + col + 4) * f1;
            s += (v[2 * jj][0] + v[2 * jj][1]) + (v[2 * jj][2] + v[2 * jj][3]) + (v[2 * jj + 1][0] + v[2 * jj + 1][1]) + (v[2 * jj + 1][2] + v[2 * jj + 1][3]); }
        const float mu = wave_sum(s) * (1.0f / DM); float q = 0.f;
#pragma unroll
        for (int j = 0; j < 8; ++j) { v[j] = v[j] - mu; q += (v[j][0] * v[j][0] + v[j][1] * v[j][1]) + (v[j][2] * v[j][2] + v[j][3] * v[j][3]); }
        const float rstd = 1.0f / sqrtf(wave_sum(q) * (1.0f / DM) + LN_EPS);
#pragma unroll
        for (int j = 0; j < 8; ++j) { const int col = (j >> 1) * 512 + lane * 8 + (j & 1) * 4;
            *(f32x4*)(F.out() + (size_t)tok * DM + col) = v[j] * rstd * *(const CAS f32x4*)(F.f(25) + col) + *(const CAS f32x4*)(F.f(26) + col); } }
}
#ifndef MK_N_LAUNCHES
#define MK_N_LAUNCHES 1
#endif
constexpr int N_PHASES = 11;
__global__ void __launch_bounds__(512, 2) fwd_kernel(Args args) {
    Frame F; F.ap = &args;
    if (F.tid() < 16) ((LAS unsigned*)(F.lds() + LDS_MISC))[F.tid()] = 0u;
    __syncthreads();
    if (args.ph_hi - args.ph_lo > 1) (void)xcd_barrier_post((unsigned*)(F.ctl() + CW_BAR), (volatile LAS unsigned*)(F.lds() + LDS_MISC));
#ifndef PH_MASK
#define PH_MASK 0x7ff
#endif
#define IN(k) (((PH_MASK >> (k)) & 1) && args.ph_lo <= (k) && (k) < args.ph_hi)
#ifdef PROBE_PHASE
    unsigned long long pt0_ = __builtin_amdgcn_s_memrealtime(), pt1_ = 0ull;
#ifdef PROBE_SUB
#define PMARK(k) do { } while (0)
#else
#define PMARK(k) do { if ((k) + 1 == PROBE_PHASE) pt0_ = __builtin_amdgcn_s_memrealtime(); if ((k) == PROBE_PHASE) pt1_ = __builtin_amdgcn_s_memrealtime(); } while (0)
#endif
#else
#define PMARK(k) do { } while (0)
#endif
#define SEAM(k) do { if (IN(k) && IN((k) + 1)) { XcdBarrier bar_; bar_.bar = (unsigned*)(F.ctl() + CW_BAR); bar_.x = xb_xcc_id(); bar_.st = (volatile LAS unsigned*)(F.lds() + LDS_MISC); xcd_barrier(bar_); } } while (0)
    if (IN(0)) { p0_prologue(F); } SEAM(0); PMARK(0);
    if (IN(1)) { p1_modulate(F); } SEAM(1); PMARK(1);
    if (IN(2)) {
        pg8::Gemm g{WSP(const bf16, WS_U1), WSP(const bf16, WS_WIN), DM, 20}; pg8::StaticOrder S; S.init(NTOK, NPROJ_PAD, F.G(), F.bid());
        EpiInProj E{F.ws(), F.f(8), F.f(12), F.f(13)};
        pg8::gemm_phase<EpiInProj, pg8::StaticOrder, false>(F.lds(), g, S, E);
        slack_fill(F, (F.bid() + 3 * F.G() < 32 * NPROJ_TILES) ? 0 : 8, false, Q_ALL);
    } SEAM(2); PMARK(2);
    if (IN(3)) {
        PSUB(3, 0); p3_ssd(F); PSUB(3, 1); PSUB(30, 0); p3_idx(F); PSUB(30, 1);
    } SEAM(3); PMARK(3);
    if (IN(4)) { PSUB(40, 0); p4_select(F); PSUB(40, 1); PSUB(41, 0); p4_scan(F); PSUB(41, 1); } SEAM(4); PMARK(4);
    if (IN(5)) { p5_phase(F); slack_fill(F, (F.G() == 256) ? ((F.bid() >> 4) * 5) / 4 : 0, false, Q_ALL); } SEAM(5); PMARK(5);
    if (IN(6)) {
        pg8::Gemm g{WSP(const bf16, WS_YCAT), WSP(const bf16, WS_WOUT), DM, 60}; pg8::StaticOrder S; S.init(NTOK, DM, F.G(), F.bid());
        EpiOutProj E{F.f(0), (const CAS float*)(F.ws() + WS_MODF), F.out()};
        pg8::gemm_phase<EpiOutProj, pg8::StaticOrder, false>(F.lds(), g, S, E);
    } SEAM(6); PMARK(6);
    if (IN(7)) { p7_phase(F); slack_fill(F, 0, true, Q_GU); } SEAM(7); PMARK(7);
    if (IN(8)) {
        const int vcu = (F.G() % 8 == 0) ? (F.bid() % 8) * (F.G() / 8) + F.bid() / 8 : F.bid();
        moe_tables(F);
        const LAS int* tab = (const LAS int*)(F.lds() + LDS_MISC + 64);
        pg8::Gemm g{WSP(const bf16, WS_U2), WSP(const bf16, WS_WGU), DM, 80}; MoeOrder S{tab, WSP(const int, WS_LTOK), F.G(), vcu, 4};
        EpiGateUp E{WSP(bf16, WS_HID), (const CAS float*)(F.ws() + WS_LW), tab};
        pg8::gemm_phase<EpiGateUp, MoeOrder, true>(F.lds(), g, S, E);
        slack_fill(F, 0, true, Q_ALL);
    } SEAM(8); PMARK(8);
    if (IN(9)) {
        const int vcu = (F.G() % 8 == 0) ? (F.bid() % 8) * (F.G() / 8) + F.bid() / 8 : F.bid();
        moe_tables(F);
        const LAS int* tab = (const LAS int*)(F.lds() + LDS_MISC + 64);
        pg8::Gemm g{WSP(const bf16, WS_HID), WSP(const bf16, WS_WDN), DE, 90}; MoeOrder S{tab, WSP(const int, WS_LTOK), F.G(), vcu, 8};
        EpiDown E{WSP(bf16, WS_OUTS)};
        pg8::gemm_phase<EpiDown, MoeOrder, false>(F.lds(), g, S, E);
    } SEAM(9); PMARK(9);
    if (IN(10)) { moe_tables(F); p10_final(F); }
#ifdef PROBE_PHASE
    if (pt1_ == 0ull) pt1_ = __builtin_amdgcn_s_memrealtime();
#ifdef PROBE_SUB
    __syncthreads(); pt0_ = *(volatile LAS unsigned long long*)(F.lds() + LDS_MISC + 32); pt1_ = *(volatile LAS unsigned long long*)(F.lds() + LDS_MISC + 40);
#endif
    if (F.bid() == 0) { const unsigned long long w = 8ull * (pt1_ - pt0_), te = __builtin_amdgcn_s_memrealtime(); while (__builtin_amdgcn_s_memrealtime() - te < w) __builtin_amdgcn_s_sleep(32); }
#endif
#ifdef DBG_OFF
    if (args.ph_hi == N_PHASES) {
        const size_t n = (size_t)NTOK * DM; float* o = F.out();
        for (size_t i = (size_t)F.bid() * 512 + F.tid(); i < n; i += (size_t)F.G() * 512) {
            float v;
            if (DBG_KIND == 0) v = bf2f(((const bf16*)(F.ws() + (size_t)(DBG_OFF)))[i % (size_t)(DBG_N)]);
            else v = ((const float*)(F.ws() + (size_t)(DBG_OFF)))[i % (size_t)(DBG_N)];
            if (!(fabsf(v) < 1e30f)) v = 1e30f;
            o[i] = v; }
    }
#endif
#undef IN
#undef SEAM
#undef PMARK
}

extern "C" void kernel_launch(void* const* d_in, const int* in_sizes, int n_in, void* d_out, int out_size, void* d_ws, size_t ws_size, hipStream_t stream) {
    static int grid = 0;
    if (grid == 0) {
        if (n_in != 27 || out_size != NTOK * DM || ws_size < WS_END) { fprintf(stderr, "kernel_launch: unexpected shapes (n_in %d, out %d, ws %zu; need ws >= %zu)\n", n_in, out_size, ws_size, (size_t)WS_END); }
        int dev = 0, cus = 0, per_cu = 0;
        if (hipGetDevice(&dev) != hipSuccess || hipDeviceGetAttribute(&cus, hipDeviceAttributeMultiprocessorCount, dev) != hipSuccess) { grid = -1; return; }
        if (hipFuncSetAttribute((const void*)fwd_kernel, hipFuncAttributeMaxDynamicSharedMemorySize, LDS_BYTES) != hipSuccess) { fprintf(stderr, "kernel_launch: hipFuncSetAttribute failed\n"); grid = -1; return; }
        if (hipOccupancyMaxActiveBlocksPerMultiprocessor(&per_cu, (const void*)fwd_kernel, 512, LDS_BYTES) != hipSuccess || per_cu < 1) fprintf(stderr, "kernel_launch: occupancy query reports %d\n", per_cu);
        (void)hipGetLastError();
        grid = cus;
    }
    if (grid < 0) return;
    (void)hipMemsetAsync((char*)d_ws + WS_CTL, 0, CTL_ZERO_BYTES, stream);
    Args a{};
    for (int i = 0; i < 27; ++i) a.in[i] = d_in[i];
    a.out = (float*)d_out; a.ws = (unsigned char*)d_ws;
#if MK_N_LAUNCHES == 1
    a.ph_lo = 0; a.ph_hi = N_PHASES;
    hipLaunchKernelGGL(fwd_kernel, dim3(grid), dim3(512), LDS_BYTES, stream, a);
#else
    for (int p = 0; p < N_PHASES; ++p) { a.ph_lo = p; a.ph_hi = p + 1; hipLaunchKernelGGL(fwd_kernel, dim3(grid), dim3(512), LDS_BYTES, stream, a);
#ifdef DUP_PHASE
        if (p == DUP_PHASE) hipLaunchKernelGGL(fwd_kernel, dim3(grid), dim3(512), LDS_BYTES, stream, a);
#endif
    }
#endif
}
```

```cpp
#define MK_N_LAUNCHES 1
#define PH_MASK 0x7ff
#include <hip/hip_runtime.h>
#include <cstdio>
#include <cstdint>

#define GAS __attribute__((address_space(1)))
#define LAS __attribute__((address_space(3)))
#define CAS __attribute__((address_space(4)))
typedef unsigned short bf16;
typedef short bf16x8 __attribute__((ext_vector_type(8)));
typedef short s16x4 __attribute__((ext_vector_type(4)));
typedef float f32x2 __attribute__((ext_vector_type(2)));
typedef float f32x4 __attribute__((ext_vector_type(4)));
typedef float f32x16 __attribute__((ext_vector_type(16)));
typedef unsigned u32x2 __attribute__((ext_vector_type(2)));
typedef unsigned u32x4 __attribute__((ext_vector_type(4)));
typedef GAS unsigned gu32;
#define RLX_AGENT __ATOMIC_RELAXED, __HIP_MEMORY_SCOPE_AGENT
#define LDS_WAIT() asm volatile("s_waitcnt lgkmcnt(0)" ::: "memory")
#define VM_WAIT() asm volatile("s_waitcnt vmcnt(0)" ::: "memory")

constexpr int DM = 2048, NBATCH = 2, SEQ = 4096, NTOK = NBATCH * SEQ;
constexpr int D_SSM = 1024, SSM_H = 16, SSM_P = 64, SSM_N = 128, CONV_CH = 1536, CHUNK = 128, NCHUNK = SEQ / CHUNK;
constexpr int ATT_H = 8, ATT_D = 128, IDX_H = 16, IDX_D = 64, TOPK_SEL = 256;
constexpr int NE = 64, DE = 512, NEX = NE + 1;
constexpr int NPROJ = 6752, NPROJ_PAD = 6912, NPROJ_TILES = 27;
constexpr float ALPHA_DN = 1.189207115002721f;
constexpr float LN_EPS = 1e-5f;
constexpr int SEG_Z = 0, SEG_XBC = 1024, SEG_DT = 2560, SEG_Q = 2576, SEG_K = 3600, SEG_V = 4624, SEG_QI = 5648, SEG_KI = 6672, SEG_WI = 6736;

constexpr size_t MiB = 1u << 20;
constexpr size_t WS_CTL = 0, CTL_ZERO_BYTES = 1 * MiB;
constexpr size_t WS_MODP = 1 * MiB;
constexpr size_t WS_MODF = 3 * MiB;
constexpr size_t WS_COSA = 4 * MiB, WS_SINA = 6 * MiB;
constexpr size_t WS_COSI = 8 * MiB, WS_SINI = 9 * MiB;
constexpr size_t WS_WR = 10 * MiB;
constexpr size_t WS_KIDX = 11 * MiB;
constexpr size_t WS_WIDX = 12 * MiB;
constexpr size_t WS_DT = 12 * MiB + 512 * 1024;
constexpr size_t WS_CS = 13 * MiB;
constexpr size_t WS_INV = 14 * MiB;
constexpr size_t WS_LTOK = 15 * MiB;
constexpr size_t WS_LW = 17 * MiB;
constexpr size_t WS_MASK = 19 * MiB;
constexpr size_t WS_U2 = 25 * MiB;
constexpr size_t WS_WGU = 57 * MiB;
constexpr size_t WS_WDN = 317 * MiB;
constexpr size_t WS_T = 447 * MiB;
constexpr size_t WS_HID = WS_T;
constexpr size_t WS_OUTS = WS_T + 88 * MiB;
constexpr size_t WS_WIN = WS_T;
constexpr size_t WS_WOUT = WS_T + 27 * MiB;
constexpr size_t WS_U1 = WS_T + 35 * MiB;
constexpr size_t WS_Z = WS_T + 67 * MiB;
constexpr size_t WS_XBC = WS_T + 83 * MiB;
constexpr size_t WS_Q = WS_T + 107 * MiB, WS_K = WS_T + 123 * MiB, WS_V = WS_T + 139 * MiB;
constexpr size_t WS_QIDX = WS_T + 155 * MiB;
constexpr size_t WS_SCORES = WS_T + 171 * MiB;
constexpr size_t WS_STATES = WS_T + 299 * MiB;
constexpr size_t WS_HIN = WS_T + 331 * MiB;
constexpr size_t WS_YDIAG = WS_T + 347 * MiB;
constexpr size_t WS_YCAT = WS_T + 379 * MiB;
constexpr size_t WS_XBCACT = WS_T + 411 * MiB;
constexpr size_t WS_END = WS_T + 440 * MiB;
static_assert(WS_XBCACT + 24 * MiB <= WS_END && WS_OUTS + 352 * MiB <= WS_END, "ws map");
constexpr int MAXPOS = 90112;
constexpr int CW_TMO = 0, CW_BAR = 4096, CW_ECNT = 8192;
constexpr int CW_QHEAD = 16384, CW_DONE = 16448;

constexpr int LDS_MISC = 155648;
constexpr int LDS_BYTES = 157696;

typedef __bf16 bf16x2_t __attribute__((ext_vector_type(2)));
__device__ __forceinline__ unsigned cvt_pk_bf16(float lo, float hi) { const bf16x2_t v = {(__bf16)lo, (__bf16)hi}; return __builtin_bit_cast(unsigned, v); }
__device__ __forceinline__ float bflo(unsigned w) { return __uint_as_float(w << 16); }
__device__ __forceinline__ float bfhi(unsigned w) { return __uint_as_float(w & 0xffff0000u); }
__device__ __forceinline__ float bf2f(bf16 b) { return __uint_as_float((unsigned)b << 16); }
__device__ __forceinline__ bf16 f2bf(float f) { return __builtin_bit_cast(unsigned short, (__bf16)f); }
__device__ __forceinline__ float silu_f(float x) { return x / (1.f + __expf(-x)); }
__device__ __forceinline__ float sigmoid_f(float x) { return 1.f / (1.f + __expf(-x)); }
__device__ __forceinline__ float wave_sum(float v) {
#pragma unroll
    for (int o = 1; o < 64; o <<= 1) v += __shfl_xor(v, o);
    return v;
}
__device__ __forceinline__ bf16x8 pack8(f32x4 a, f32x4 b) {
    u32x4 w = {cvt_pk_bf16(a[0], a[1]), cvt_pk_bf16(a[2], a[3]), cvt_pk_bf16(b[0], b[1]), cvt_pk_bf16(b[2], b[3])};
    return __builtin_bit_cast(bf16x8, w);
}
__device__ __forceinline__ void unpack8(bf16x8 v, float (&o)[8]) {
    u32x4 w = __builtin_bit_cast(u32x4, v);
#pragma unroll
    for (int i = 0; i < 4; ++i) { o[2 * i] = bflo(w[i]); o[2 * i + 1] = bfhi(w[i]); }
}
__device__ __forceinline__ int crow(int r, int hi) { return (r & 3) + 8 * (r >> 2) + 4 * hi; }

__device__ __forceinline__ LAS unsigned char* lds_base() { extern __shared__ __attribute__((aligned(16))) unsigned char lds_raw[]; return (LAS unsigned char*)lds_raw; }
#ifdef PROBE_SUB
#define PSUB(n, w) do { if ((n) == PROBE_SUB && blockIdx.x == 0 && threadIdx.x == 0) *(volatile LAS unsigned long long*)(lds_base() + LDS_MISC + 32 + 8 * (w)) = __builtin_amdgcn_s_memrealtime(); } while (0)
#else
#define PSUB(n, w) do { } while (0)
#endif
#define XB_TMO      128
#define XB_XCNT(j)  (256  + 64 * (j))
#define XB_XSUB(j)  (1280 + 64 * (j))
#define XB_XGEN(j)  (2304 + 64 * (j))
#define XB_TOP      3328
#define XB_TOPGEN   3392
#define XCD_BAR_WORDS 3456
#define XB_SPIN_CAP (1u << 18)

__device__ __forceinline__ unsigned xb_ld(unsigned* p)              { return __hip_atomic_load(p, __ATOMIC_RELAXED, __HIP_MEMORY_SCOPE_AGENT); }
__device__ __forceinline__ unsigned xb_add(unsigned* p, unsigned v) { return __hip_atomic_fetch_add(p, v, __ATOMIC_RELAXED, __HIP_MEMORY_SCOPE_AGENT); }
__device__ __forceinline__ unsigned xb_xcc_id() { return (unsigned)__builtin_amdgcn_s_getreg((3 << 11) | 20) & 0xFu; }
#define XB_SPIN(cond, bar) do { unsigned _sp = 0; while (cond) { __builtin_amdgcn_s_sleep(1); \
    if ((++_sp & 255u) == 0u) { if (xb_ld(&(bar)[XB_TMO])) break; if (_sp > XB_SPIN_CAP) { atomicAdd(&(bar)[XB_TMO], 1u); break; } } } } while (0)

struct XcdBarrier {
    unsigned* bar; unsigned x;
    volatile LAS unsigned* st;
};

__device__ __forceinline__ XcdBarrier xcd_barrier_post(unsigned* bar, volatile LAS unsigned* st) {
    XcdBarrier b; b.bar = bar; b.x = xb_xcc_id(); b.st = st;
    if (threadIdx.x == 0) (void)xb_add(&bar[XB_XCNT(b.x)], 1u);
    return b;
}
__device__ __forceinline__ void xcd_barrier_complete(unsigned* bar, unsigned x, unsigned& nloc, unsigned& nx) {
    const unsigned G = gridDim.x * gridDim.y * gridDim.z;
    unsigned sum, cnt, mine, sp = 0u;
    for (;;) {
        sum = 0u; cnt = 0u; mine = 0u;
#pragma unroll
        for (unsigned j = 0; j < 16; ++j) { const unsigned c = xb_ld(&bar[XB_XCNT(j)]); sum += c; cnt += (c > 0u) ? 1u : 0u; mine = (j == x) ? c : mine; }
        if (sum == G) break;
        __builtin_amdgcn_s_sleep(1);
        if ((++sp & 255u) == 0u) { if (xb_ld(&bar[XB_TMO])) break; if (sp > XB_SPIN_CAP) { atomicAdd(&bar[XB_TMO], 1u); break; } }
    }
    nloc = mine > 0u ? mine : 1u; nx = cnt > 0u ? cnt : 1u;
}

__device__ __forceinline__ void xcd_barrier(const XcdBarrier& b) {
    asm volatile("s_waitcnt vmcnt(0)" ::: "memory");
    __syncthreads();
    if (threadIdx.x == 0) {
        unsigned* bar = b.bar;
        __builtin_amdgcn_s_waitcnt(0);
        unsigned nloc = b.st[0], nx = b.st[1];
        if (nloc == 0u) { xcd_barrier_complete(bar, b.x, nloc, nx); b.st[0] = nloc; b.st[1] = nx; }
        const unsigned old = xb_add(&bar[XB_XSUB(b.x)], 1u);
        const unsigned gen = old / nloc;
        if (old + 1u == (gen + 1u) * nloc) {
            __builtin_amdgcn_fence(__ATOMIC_RELEASE, "agent");
            asm volatile("s_waitcnt vmcnt(0)" ::: "memory");
            const unsigned og = xb_add(&bar[XB_TOP], 1u);
            const unsigned tg = og / nx;
            if (og + 1u == (tg + 1u) * nx) xb_add(&bar[XB_TOPGEN], 1u);
            else XB_SPIN(xb_ld(&bar[XB_TOPGEN]) == tg, bar);
            __builtin_amdgcn_fence(__ATOMIC_ACQUIRE, "agent");
            xb_add(&bar[XB_XGEN(b.x)], 1u);
            asm volatile("s_waitcnt vmcnt(0)" ::: "memory");
        } else {
            XB_SPIN(xb_ld(&bar[XB_XGEN(b.x)]) == gen, bar);
            __builtin_amdgcn_fence(__ATOMIC_ACQUIRE, "agent");
            asm volatile("s_waitcnt vmcnt(0)" ::: "memory");
        }
    }
    __syncthreads();
}

namespace pg8 {
constexpr int BM = 256, BK = 64, HALF = 128, HTB = HALF * BK * 2  , STAGE_BYTES = 8 * HTB, NXCD = 8, WGM = 8;
__host__ __device__ __forceinline__ int lds_byte(int r, int c) { const int st = (r >> 4) * 2 + (c >> 5), rr = r & 15, cc = c & 31, ob = rr * 64 + cc * 2; return st * 1024 + (ob ^ (((ob >> 9) & 1) << 5)); }
__host__ __device__ __forceinline__ void stage_rc(int b, int& R, int& C) { const int st = b / 1024, sb = b % 1024, swz = sb ^ (((sb >> 9) & 1) << 5); R = (st >> 1) * 16 + swz / 64; C = (st & 1) * 32 + (swz % 64) / 2; }
__host__ __device__ __forceinline__ int perm32(int rho) { const int n = rho >> 4, i = rho & 15; return 8 * (i >> 2) + 4 * n + (i & 3); }

struct Unit { int pm, pn, ax; };
struct Gemm { const bf16* A; const bf16* Bt; int K; int pid; };

struct StaticOrder {
    int nM, nN, nwg, G, c;
    __device__ void init(int M, int N, int G_, int c_) { nM = M / BM; nN = N / BM; nwg = nM * nN; G = G_; c = c_; }
    __device__ __forceinline__ bool next(int i, Unit& u) const {
        const long L = (long)i * G + c; if (L >= nwg) return false;
        int wgid = (int)L; { const int q = nwg / NXCD, r = nwg % NXCD, xcd = wgid % NXCD, off = wgid / NXCD; wgid = (xcd < r ? xcd * (q + 1) : r * (q + 1) + (xcd - r) * q) + off; }
        const int nig = WGM * nN, gid = wgid / nig, fm = gid * WGM, gsz = (nM - fm) < WGM ? (nM - fm) : WGM;
        u.pm = fm + ((wgid % nig) % gsz); u.pn = (wgid % nig) / gsz; u.ax = 0; return true;
    }
    __device__ __forceinline__ int row_tok(const Unit&, int) const { return 0; }
};

template <class Epi, class Sched, bool GATHER>
__device__ __forceinline__ void gemm_phase(LAS unsigned char* lds, const Gemm g, const Sched& S, const Epi& E) {
    const int tid = threadIdx.x, wid = __builtin_amdgcn_readfirstlane(tid >> 6), lane = tid & 63, wr = wid >> 2, wc = wid & 3, fr = lane & 15, fq = lane >> 4;
    const int K = g.K, nt = K / BK;
    unsigned voffB[2]; int RA[2]; unsigned CA2[2];
#pragma unroll
    for (int i = 0; i < 2; ++i) { int R, C; stage_rc(tid * 16 + i * 8192, R, C); const int Rb = Epi::PERM ? ((R & ~31) + perm32(R & 31)) : R;
        voffB[i] = (unsigned)(Rb * K + C) * 2u; RA[i] = R; CA2[i] = (unsigned)C * 2u; }
    const size_t kstep = (size_t)(BK * 2);
    const size_t hstep = (size_t)HALF * K * 2;
    const size_t tstep = 2 * hstep;
    const unsigned ldsw = (unsigned)wid * 1024u;
    const int aoff = lds_byte(wr * 64 + fr, fq * 8), boff = lds_byte(wc * 32 + fr, fq * 8);
#define PG8_SA(b, h) (((b) * 2 + (h)) * HTB)
#define PG8_SB(b, h) ((4 + (b) * 2 + (h)) * HTB)
#define PG8_STAGE(bufoff, gbase, voff) do { _Pragma("unroll") for (int _i = 0; _i < 2; ++_i) \
        __builtin_amdgcn_global_load_lds((const unsigned*)((const char*)(gbase) + (voff)[_i]), (LAS unsigned*)(lds + (bufoff) + ldsw + _i * 8192), 16, 0, 0); } while (0)
#define PG8_LDA(dst, b, h) do { _Pragma("unroll") for (int m = 0; m < 4; ++m) _Pragma("unroll") for (int k = 0; k < 2; ++k) dst[m][k] = *(const LAS bf16x8*)(lds + PG8_SA(b, h) + aoff + m * 2048 + k * 1024); } while (0)
#define PG8_LDB(dst, b, h) do { _Pragma("unroll") for (int n = 0; n < 2; ++n) _Pragma("unroll") for (int k = 0; k < 2; ++k) dst[n][k] = *(const LAS bf16x8*)(lds + PG8_SB(b, h) + boff + n * 2048 + k * 1024); } while (0)
#define PG8_MMA(ai, bj, At, Bt) do { __builtin_amdgcn_s_setprio(1); _Pragma("unroll") for (int m = 0; m < 4; ++m) _Pragma("unroll") for (int n = 0; n < 2; ++n) _Pragma("unroll") for (int k = 0; k < 2; ++k) \
        acc[ai][bj][m][n] = __builtin_amdgcn_mfma_f32_16x16x32_bf16(Bt[n][k], At[m][k], acc[ai][bj][m][n], 0, 0, 0); __builtin_amdgcn_s_setprio(0); } while (0)
#define PG8_WAIT_V(n) asm volatile("s_waitcnt vmcnt(" #n ")" ::: "memory")
#define PG8_WAIT_L(n) asm volatile("s_waitcnt lgkmcnt(" #n ")" ::: "memory")
#define PG8_BAR __builtin_amdgcn_s_barrier()
#define PG8_SCHED __builtin_amdgcn_sched_barrier(0)
#define PG8_SET_OA(o, u) do { _Pragma("unroll") for (int _h = 0; _h < 2; ++_h) _Pragma("unroll") for (int _i = 0; _i < 2; ++_i) { \
        if constexpr (GATHER) o[_h][_i] = (unsigned)S.row_tok(u, _h * HALF + RA[_i]) * (unsigned)(K * 2) + CA2[_i]; \
        else o[_h][_i] = (unsigned)(_h * (int)hstep) + (unsigned)(RA[_i] * K * 2) + CA2[_i]; } } while (0)
    Unit cur, nxt; int ui = 0;
    if (!S.next(0, cur)) return;
    f32x4 acc[2][2][4][2];
#pragma unroll
    for (int a = 0; a < 2; ++a)
#pragma unroll
        for (int b = 0; b < 2; ++b)
#pragma unroll
            for (int m = 0; m < 4; ++m)
#pragma unroll
                for (int n = 0; n < 2; ++n) acc[a][b][m][n] = (f32x4){0.f, 0.f, 0.f, 0.f};
    bf16x8 At[4][2], B0[2][2], B1[2][2];
    unsigned oAc[2][2], oAn[2][2];
    PG8_SET_OA(oAc, cur);
    const char* cA = GATHER ? (const char*)g.A : (const char*)g.A + (size_t)cur.pm * tstep; const char* cB = (const char*)g.Bt + (size_t)cur.pn * tstep;
    PG8_STAGE(PG8_SB(0, 0), cB, voffB); PG8_STAGE(PG8_SB(0, 1), cB + hstep, voffB); PG8_STAGE(PG8_SA(0, 0), cA, oAc[0]); PG8_STAGE(PG8_SA(0, 1), cA, oAc[1]);
    if (wr == 1) PG8_BAR;
    PG8_WAIT_V(2); PG8_BAR;
    PG8_STAGE(PG8_SB(1, 0), cB + kstep, voffB); PG8_STAGE(PG8_SA(1, 0), cA + kstep, oAc[0]); PG8_STAGE(PG8_SB(1, 1), cB + hstep + kstep, voffB);
    PG8_WAIT_V(6); PG8_BAR;
    for (;;) {
        const bool has_next = S.next(ui + 1, nxt);
        const char* nA = has_next ? (GATHER ? (const char*)g.A : (const char*)g.A + (size_t)nxt.pm * tstep) : cA; const char* nB = has_next ? (const char*)g.Bt + (size_t)nxt.pn * tstep : cB;
        if (has_next) { PG8_SET_OA(oAn, nxt); }
        else {
#pragma unroll
            for (int _h = 0; _h < 2; ++_h)
#pragma unroll
                for (int _i = 0; _i < 2; ++_i) oAn[_h][_i] = oAc[_h][_i]; }
        PSUB(g.pid * 10, 0); PSUB(g.pid * 10 + 2, 0);
        for (int t = 0; t < nt; t += 2) {
            const bool last = (t == nt - 2);
            if (t == 0) { PSUB(g.pid * 10 + 3, 0); } if (t == 2) { PSUB(g.pid * 10 + 3, 1); PSUB(g.pid * 10 + 4, 0); } if (t == 4) { PSUB(g.pid * 10 + 4, 1); }
            const char* a1 = cA + (size_t)(t + 1) * kstep;
            const char* a2 = last ? nA : cA + (size_t)(t + 2) * kstep; const char* b2 = last ? nB : cB + (size_t)(t + 2) * kstep;
            const char* a3 = a2 + kstep; const char* b3 = b2 + kstep;
            unsigned o2[2][2];
#pragma unroll
            for (int _h = 0; _h < 2; ++_h)
#pragma unroll
                for (int _i = 0; _i < 2; ++_i) o2[_h][_i] = GATHER ? (last ? oAn[_h][_i] : oAc[_h][_i]) : oAc[_h][_i];
            PG8_LDB(B0, 0, 0); PG8_LDB(B1, 0, 1); PG8_SCHED; PG8_LDA(At, 0, 0); PG8_STAGE(PG8_SA(1, 1), a1, oAc[1]);
            PG8_WAIT_V(8); PG8_WAIT_L(0); PG8_BAR; PG8_MMA(0, 0, At, B0); PG8_MMA(0, 1, At, B1); PG8_BAR; PG8_SCHED;
            PG8_LDA(At, 0, 1); PG8_STAGE(PG8_SB(0, 0), b2, voffB); PG8_STAGE(PG8_SB(0, 1), b2 + hstep, voffB); PG8_STAGE(PG8_SA(0, 0), a2, o2[0]);
            PG8_WAIT_V(8); PG8_WAIT_L(0); PG8_BAR; PG8_MMA(1, 0, At, B0); PG8_MMA(1, 1, At, B1); PG8_BAR; PG8_SCHED;
            PG8_LDB(B0, 1, 0); PG8_LDB(B1, 1, 1); PG8_SCHED; PG8_LDA(At, 1, 0); PG8_STAGE(PG8_SA(0, 1), a2, o2[1]);
            PG8_WAIT_V(8); PG8_WAIT_L(0); PG8_BAR; PG8_MMA(0, 0, At, B0); PG8_MMA(0, 1, At, B1); PG8_BAR; PG8_SCHED;
            PG8_LDA(At, 1, 1); PG8_STAGE(PG8_SB(1, 0), b3, voffB); PG8_STAGE(PG8_SB(1, 1), b3 + hstep, voffB); PG8_STAGE(PG8_SA(1, 0), a3, o2[0]);
            PG8_WAIT_V(8); PG8_WAIT_L(0); PG8_BAR; PG8_MMA(1, 0, At, B0); PG8_MMA(1, 1, At, B1); PG8_BAR; PG8_SCHED;
        }
        PSUB(g.pid * 10, 1); PSUB(g.pid * 10 + 1, 0);
        if (wr == 0) PG8_BAR;
        { int fr_ = fr, fq_ = fq, wr_ = wr, wc_ = wc; asm volatile("" : "+v"(fr_), "+v"(fq_), "+s"(wr_), "+s"(wc_));
          E(acc, cur, wr_, wc_, fr_, fq_); }
        PSUB(g.pid * 10 + 1, 1); PSUB(g.pid * 10 + 2, 1);
        if (!has_next) break;
#pragma unroll
        for (int a = 0; a < 2; ++a)
#pragma unroll
            for (int b = 0; b < 2; ++b)
#pragma unroll
                for (int m = 0; m < 4; ++m)
#pragma unroll
                    for (int n = 0; n < 2; ++n) acc[a][b][m][n] = (f32x4){0.f, 0.f, 0.f, 0.f};
        cur = nxt; cA = nA; cB = nB; ++ui;
#pragma unroll
        for (int _h = 0; _h < 2; ++_h)
#pragma unroll
            for (int _i = 0; _i < 2; ++_i) oAc[_h][_i] = oAn[_h][_i];
        if (wr == 1) PG8_BAR;
    }
    PG8_WAIT_V(0);
    PG8_BAR;
#undef PG8_SA
#undef PG8_SB
#undef PG8_STAGE
#undef PG8_LDA
#undef PG8_LDB
#undef PG8_MMA
#undef PG8_WAIT_V
#undef PG8_WAIT_L
#undef PG8_BAR
#undef PG8_SCHED
#undef PG8_SET_OA
}
}
struct Args { const void* in[27]; float* out; unsigned char* ws; int ph_lo, ph_hi; };
struct Frame {
    const Args* ap;
    __device__ __forceinline__ LAS unsigned char* lds() const { extern __shared__ __attribute__((aligned(16))) unsigned char lds_raw[]; return (LAS unsigned char*)lds_raw; }
    __device__ __forceinline__ unsigned char* ws() const { return ap->ws; }
    __device__ __forceinline__ gu32* ctl() const { return (gu32*)(ap->ws + WS_CTL); }
    __device__ __forceinline__ float* out() const { return ap->out; }
    __device__ __forceinline__ int tid() const { return (int)threadIdx.x; }
    __device__ __forceinline__ int lane() const { return (int)threadIdx.x & 63; }
    __device__ __forceinline__ int wave() const { return __builtin_amdgcn_readfirstlane((int)threadIdx.x >> 6); }
    __device__ __forceinline__ int G() const { return (int)gridDim.x; }
    __device__ __forceinline__ int bid() const { return (int)blockIdx.x; }
    __device__ __forceinline__ const CAS float* f(int i) const { return (const CAS float*)ap->in[i]; }
    __device__ __forceinline__ const CAS int* i32(int i) const { return (const CAS int*)ap->in[i]; }
};
#define WSP(T, off) ((T*)(F.ws() + (off)))

__device__ __forceinline__ int inproj_src_col(int P) {
    const int tile = P >> 8, within = P & 255, bj = within >> 7, w = within & 127;
    if (tile < 4) return SEG_Z + tile * 256 + within;
    if (tile < 10) return SEG_XBC + (tile - 4) * 256 + within;
    if (tile < 14) return SEG_Q + (2 * (tile - 10) + (w >> 6)) * 128 + (w & 63) + 64 * bj;
    if (tile < 18) return SEG_K + (2 * (tile - 14) + (w >> 6)) * 128 + (w & 63) + 64 * bj;
    if (tile < 22) return SEG_V + (tile - 18) * 256 + within;
    if (tile < 26) return SEG_QI + (4 * (tile - 22) + (w >> 5)) * 64 + (w & 31) + 32 * bj;
    if (bj == 0) { if (w < 32) return SEG_KI + w; if (w < 48) return SEG_WI + (w - 32); if (w < 64) return SEG_DT + (w - 48); return -1; }
    if (w < 32) return SEG_KI + 32 + w;
    return -1;
}
__device__ __forceinline__ void tr64(const CAS float* qsrc, bool valid, int ld, bf16* dst0  , int K, LAS float* scr, int lane) {
    f32x4 v[16];
#pragma unroll
    for (int i = 0; i < 16; ++i) v[i] = valid ? *(const CAS f32x4*)(qsrc + (size_t)(4 * i) * ld) : (f32x4){0.f, 0.f, 0.f, 0.f};
#pragma unroll
    for (int i = 0; i < 16; ++i) { LAS float* s = scr + ((lane >> 4) + 4 * i) * 65 + 4 * (lane & 15); s[0] = v[i][0]; s[1] = v[i][1]; s[2] = v[i][2]; s[3] = v[i][3]; }
    LDS_WAIT(); asm volatile("" ::: "memory");
    const int c = lane & 7;
#pragma unroll
    for (int jj = 0; jj < 8; ++jj) { const int n = (lane >> 3) + 8 * jj; const LAS float* s = scr + (8 * c) * 65 + n;
        u32x4 o; o.x = cvt_pk_bf16(s[0], s[65]); o.y = cvt_pk_bf16(s[2 * 65], s[3 * 65]); o.z = cvt_pk_bf16(s[4 * 65], s[5 * 65]); o.w = cvt_pk_bf16(s[6 * 65], s[7 * 65]);
        *(u32x4*)(dst0 + (size_t)n * K + 8 * c) = o; }
    LDS_WAIT(); asm volatile("" ::: "memory");
}
constexpr int I_IN = 32 * 108, I_OUT = 32 * 32, I_GU = NEX * 32 * 16, I_DN = NEX * 8 * 32, I_TR = I_IN + I_OUT + I_GU + I_DN;
__device__ __forceinline__ void tr_item(Frame& F, int it, LAS float* scr) {
    const int lane = F.lane(), kr = lane >> 4, nq = 4 * (lane & 15);
    if (it < I_IN) { const int kb = it / 108, nb = it % 108, k0 = 64 * kb, n0 = 64 * nb; const int sc = inproj_src_col(n0 + nq);
        tr64(F.f(5) + (size_t)(k0 + kr) * NPROJ + (sc < 0 ? 0 : sc), sc >= 0, NPROJ, WSP(bf16, WS_WIN) + (size_t)n0 * DM + k0, DM, scr, lane); return; }
    it -= I_IN;
    if (it < I_OUT) { const int kb = it >> 5, nb = it & 31, k0 = 64 * kb, n0 = 64 * nb;
        tr64(F.f(14) + (size_t)(k0 + kr) * DM + n0 + nq, true, DM, WSP(bf16, WS_WOUT) + (size_t)n0 * DM + k0, DM, scr, lane); return; }
    it -= I_OUT;
    if (it < I_GU) { const int e = it >> 9, r = it & 511, kb = r >> 4, nb = r & 15, k0 = 64 * kb;
        const int p = nb >> 2, bj = (nb >> 1) & 1, w0 = (nb & 1) * 64;
        const CAS float* src = (e < NE) ? ((bj ? F.f(20) : F.f(19)) + (size_t)e * DM * DE) : (bj ? F.f(23) : F.f(22));
        tr64(src + (size_t)(k0 + kr) * DE + 128 * p + w0 + nq, true, DE, WSP(bf16, WS_WGU) + ((size_t)e * 1024 + 64 * nb) * DM + k0, DM, scr, lane); return; }
    it -= I_GU;
    { const int e = it >> 8, r = it & 255, kb = r >> 5, nb = r & 31, k0 = 64 * kb, n0 = 64 * nb;
        const CAS float* src = (e < NE) ? (F.f(21) + (size_t)e * DE * DM) : F.f(24);
        tr64(src + (size_t)(k0 + kr) * DM + n0 + nq, true, DM, WSP(bf16, WS_WDN) + ((size_t)e * DM + n0) * DE + k0, DE, scr, lane); }
}
__device__ __forceinline__ void p0_prologue(Frame& F) {
    const int gw = F.bid() * 8 + F.wave(), NGW = F.G() * 8, gt = F.bid() * 512 + F.tid(), NGT = F.G() * 512;
    PSUB(1, 0);
    {
        LAS float* red = (LAS float*)F.lds();
        float* modp = WSP(float, WS_MODP);
        for (int item = F.bid(); item < 48 * 16; item += F.G()) {
            const int cc = item % 48, ks = item / 48;
            f32x4 a0 = {0.f, 0.f, 0.f, 0.f}, a1 = {0.f, 0.f, 0.f, 0.f};
            const int kbase = ks * 128 + F.wave() * 16;
#pragma unroll 4
            for (int i = 0; i < 16; ++i) { const int k = kbase + i;
                const float c0 = silu_f(F.f(1)[k]), c1 = silu_f(F.f(1)[DM + k]);
                const f32x4 wv = *(const CAS f32x4*)(F.f(3) + (size_t)k * (6 * DM) + cc * 256 + F.lane() * 4);
                a0 += wv * c0; a1 += wv * c1; }
            *(LAS f32x4*)(red + (F.wave() * 2 + 0) * 256 + F.lane() * 4) = a0;
            *(LAS f32x4*)(red + (F.wave() * 2 + 1) * 256 + F.lane() * 4) = a1;
            __syncthreads();
            { const int b = F.tid() >> 8, col = F.tid() & 255; float s = 0.f;
#pragma unroll
              for (int w = 0; w < 8; ++w) s += red[(w * 2 + b) * 256 + col];
              modp[((size_t)ks * 2 + b) * (6 * DM) + cc * 256 + col] = s; }
            __syncthreads();
        }
    }
    PSUB(1, 1); PSUB(2, 0);
    {
        float* cosA = WSP(float, WS_COSA); float* sinA = WSP(float, WS_SINA); float* cosI = WSP(float, WS_COSI); float* sinI = WSP(float, WS_SINI);
        for (int i = gt; i < NTOK * 64; i += NGT) { const int tok = i >> 6, j = i & 63;
            const float inv = 1.0f / powf(10000.0f, (float)(2 * j) / 128.0f); const float ang = (float)F.i32(2)[tok] * inv;
            float s, c; sincosf(ang, &s, &c); cosA[i] = c; sinA[i] = s; }
        for (int i = gt; i < NTOK * 32; i += NGT) { const int tok = i >> 5, j = i & 31;
            const float inv = 1.0f / powf(10000.0f, (float)(2 * j) / 64.0f); const float ang = (float)F.i32(2)[tok] * inv;
            float s, c; sincosf(ang, &s, &c); cosI[i] = c; sinI[i] = s; }
    }
    PSUB(2, 1); PSUB(4, 0);
    {
        bf16* wr_hi = WSP(bf16, WS_WR); bf16* wr_lo = wr_hi + NE * DM;
        for (int i = gt; i < NE * (DM / 8); i += NGT) { const int e = i & 63, kc = i >> 6;
            float v[8], l[8];
#pragma unroll
            for (int j = 0; j < 8; ++j) { v[j] = F.f(17)[(size_t)(8 * kc + j) * NE + e]; l[j] = v[j] - bf2f(f2bf(v[j])); }
            u32x4 h = {cvt_pk_bf16(v[0], v[1]), cvt_pk_bf16(v[2], v[3]), cvt_pk_bf16(v[4], v[5]), cvt_pk_bf16(v[6], v[7])};
            u32x4 lo = {cvt_pk_bf16(l[0], l[1]), cvt_pk_bf16(l[2], l[3]), cvt_pk_bf16(l[4], l[5]), cvt_pk_bf16(l[6], l[7])};
            *(u32x4*)(wr_hi + (size_t)e * DM + 8 * kc) = h; *(u32x4*)(wr_lo + (size_t)e * DM + 8 * kc) = lo; }
    }
    PSUB(4, 1); PSUB(5, 0);
    {
        LAS float* scr = (LAS float*)(F.lds() + F.wave() * 16640);
        for (int it = gw; it < I_IN + I_OUT; it += NGW) tr_item(F, it, scr);
    }
    PSUB(5, 1);
}

constexpr int Q_GU = I_GU, Q_ALL = I_GU + I_DN, Q_GRAB = 16;
__device__ __forceinline__ void slack_fill(Frame& F, int budget, bool drain, int upto) {
    LAS float* scr = (LAS float*)(F.lds() + F.wave() * 16640);
    volatile LAS int* qw = (volatile LAS int*)(F.lds() + LDS_MISC + 16);
    __syncthreads();
    for (int gi = 0; drain || gi < budget; ++gi) {
        if (F.tid() == 0) { int stop = 0;
            const int idx = (int)__hip_atomic_fetch_add(F.ctl() + CW_QHEAD, (unsigned)Q_GRAB, RLX_AGENT); if (idx >= Q_ALL) stop = 1; else if (idx >= upto) stop = 2;
            qw[0] = stop; qw[1] = idx; }
        __syncthreads();
        const int stop = qw[0], idx = qw[1];
        __syncthreads();
        if (stop == 1) break;
#pragma unroll 1
        for (int i = 0; i < Q_GRAB / 8; ++i) { const int it = idx + i * 8 + F.wave(); if (it < Q_ALL) tr_item(F, I_IN + I_OUT + it, scr); }
        if (stop == 2) break;
    }
}

__device__ __forceinline__ void p1_modulate(Frame& F) {
    const float* modp = WSP(const float, WS_MODP); float* modf = WSP(float, WS_MODF); bf16* u1 = WSP(bf16, WS_U1);
    LAS float* sh = (LAS float*)F.lds(); LAS float* sc = sh + DM;
    for (int rg = F.bid(); rg < 256; rg += F.G()) {
        const int b = rg >> 7;
        if (F.tid() < 96) { const int v = rg * 96 + F.tid(); const int bb = v / (6 * DM), col = v % (6 * DM); float s = F.f(4)[col];
#pragma unroll
            for (int ks = 0; ks < 16; ++ks) s += modp[((size_t)ks * 2 + bb) * (6 * DM) + col];
            modf[v] = s; }
        { const int col = F.tid() * 4; f32x4 s0 = *(const CAS f32x4*)(F.f(4) + col), s1 = *(const CAS f32x4*)(F.f(4) + DM + col);
#pragma unroll
          for (int ks = 0; ks < 16; ++ks) { const float* p = modp + ((size_t)ks * 2 + b) * (6 * DM); s0 += *(const f32x4*)(p + col); s1 += *(const f32x4*)(p + DM + col); }
          *(LAS f32x4*)(sh + col) = s0; *(LAS f32x4*)(sc + col) = s1; }
        __syncthreads();
#pragma unroll
        for (int rr = 0; rr < 4; ++rr) { const int row = rg * 32 + F.wave() * 4 + rr;
#pragma unroll
            for (int j = 0; j < 8; ++j) { const int col = j * 256 + F.lane() * 4;
                const f32x4 xv = *(const CAS f32x4*)(F.f(0) + (size_t)row * DM + col); const f32x4 s0 = *(const LAS f32x4*)(sh + col), s1 = *(const LAS f32x4*)(sc + col);
                const f32x4 u = xv * (s1 + 1.0f) + s0;
                u32x2 o = {cvt_pk_bf16(u[0], u[1]), cvt_pk_bf16(u[2], u[3])};
                *(u32x2*)(u1 + (size_t)row * DM + col) = o; } }
        __syncthreads();
    }
}
struct EpiInProj {
    static constexpr bool PERM = true;
    unsigned char* ws; const CAS float *dt_bias, *lng, *lnb;
    __device__ __forceinline__ void operator()(const f32x4 (&acc)[2][2][4][2], const pg8::Unit& u, int wr, int wc, int fr, int fq) const {
        const int pn = u.pn; const int row0 = u.pm * 256 + wr * 64 + fr;
        if (pn < 10 || (pn >= 18 && pn < 22)) {
            size_t boff; int ld, col0;
            if (pn < 4) { boff = WS_Z; ld = 1024; col0 = pn * 256; } else if (pn < 10) { boff = WS_XBC; ld = CONV_CH; col0 = (pn - 4) * 256; } else { boff = WS_V; ld = 1024; col0 = (pn - 18) * 256; }
            bf16* base = (bf16*)(ws + boff);
            col0 += wc * 32 + 8 * fq;
#pragma unroll
            for (int ai = 0; ai < 2; ++ai)
#pragma unroll
                for (int m = 0; m < 4; ++m) { bf16* rowp = base + (size_t)(row0 + ai * 128 + m * 16) * ld + col0;
#pragma unroll
                    for (int bj = 0; bj < 2; ++bj) { const f32x4 v0 = acc[ai][bj][m][0], v1 = acc[ai][bj][m][1];
                        u32x4 w = {cvt_pk_bf16(v0[0], v0[1]), cvt_pk_bf16(v0[2], v0[3]), cvt_pk_bf16(v1[0], v1[1]), cvt_pk_bf16(v1[2], v1[3])};
                        *(u32x4*)(rowp + bj * 128) = w; } }
        } else if (pn < 26) {
            const bool att = pn < 18; const bool isq = pn < 14;
            bf16* base = (bf16*)(ws + (att ? (isq ? WS_Q : WS_K) : WS_QIDX)); const CAS float* ct = (const CAS float*)(ws + (att ? WS_COSA : WS_COSI)); const CAS float* sn = (const CAS float*)(ws + (att ? WS_SINA : WS_SINI));
            const int tw = att ? 64 : 32;
            const int head = att ? 2 * (pn - (isq ? 10 : 14)) + (wc >> 1) : 4 * (pn - 22) + wc, jj0 = att ? 32 * (wc & 1) + 8 * fq : 8 * fq;
#pragma unroll
            for (int ai = 0; ai < 2; ++ai)
#pragma unroll
                for (int m = 0; m < 4; ++m) { const int row = row0 + ai * 128 + m * 16;
                    bf16* rowp = base + (size_t)row * 1024 + head * (2 * tw) + jj0;
#pragma unroll
                    for (int n = 0; n < 2; ++n) { const f32x4 c = *(const CAS f32x4*)(ct + (size_t)row * tw + jj0 + 4 * n), sv = *(const CAS f32x4*)(sn + (size_t)row * tw + jj0 + 4 * n);
                        const f32x4 a = acc[ai][0][m][n], bb = acc[ai][1][m][n];
                        const f32x4 o1 = a * c - bb * sv, o2 = bb * c + a * sv;
                        *(u32x2*)(rowp + 4 * n) = (u32x2){cvt_pk_bf16(o1[0], o1[1]), cvt_pk_bf16(o1[2], o1[3])};
                        *(u32x2*)(rowp + tw + 4 * n) = (u32x2){cvt_pk_bf16(o2[0], o2[1]), cvt_pk_bf16(o2[2], o2[3])}; } }
        } else {
            const CAS float* cosI = (const CAS float*)(ws + WS_COSI); const CAS float* sinI = (const CAS float*)(ws + WS_SINI); bf16* kidx = (bf16*)(ws + WS_KIDX); float* widx = (float*)(ws + WS_WIDX); float* dt = (float*)(ws + WS_DT);
            if (wc == 0) {
                const int jj0 = 8 * fq;
#pragma unroll
                for (int am = 0; am < 8; ++am) { const int ai = am >> 2, m = am & 3; const int row = row0 + ai * 128 + m * 16;
                        f32x4 a0 = acc[ai][0][m][0], a1 = acc[ai][0][m][1], b0 = acc[ai][1][m][0], b1 = acc[ai][1][m][1];
                        float s = (a0[0] + a0[1] + a0[2] + a0[3]) + (a1[0] + a1[1] + a1[2] + a1[3]) + (b0[0] + b0[1] + b0[2] + b0[3]) + (b1[0] + b1[1] + b1[2] + b1[3]);
                        s += __shfl_xor(s, 16); s += __shfl_xor(s, 32);
                        const float mu = s * (1.0f / 64.0f);
                        a0 = a0 - mu; a1 = a1 - mu; b0 = b0 - mu; b1 = b1 - mu;
                        float qv = (a0[0] * a0[0] + a0[1] * a0[1] + a0[2] * a0[2] + a0[3] * a0[3]) + (a1[0] * a1[0] + a1[1] * a1[1] + a1[2] * a1[2] + a1[3] * a1[3])
                                 + (b0[0] * b0[0] + b0[1] * b0[1] + b0[2] * b0[2] + b0[3] * b0[3]) + (b1[0] * b1[0] + b1[1] * b1[1] + b1[2] * b1[2] + b1[3] * b1[3]);
                        qv += __shfl_xor(qv, 16); qv += __shfl_xor(qv, 32);
                        const float rstd = 1.0f / sqrtf(qv * (1.0f / 64.0f) + LN_EPS);
                        a0 = a0 * rstd * *(const CAS f32x4*)(lng + jj0) + *(const CAS f32x4*)(lnb + jj0); a1 = a1 * rstd * *(const CAS f32x4*)(lng + jj0 + 4) + *(const CAS f32x4*)(lnb + jj0 + 4);
                        b0 = b0 * rstd * *(const CAS f32x4*)(lng + 32 + jj0) + *(const CAS f32x4*)(lnb + 32 + jj0); b1 = b1 * rstd * *(const CAS f32x4*)(lng + 36 + jj0) + *(const CAS f32x4*)(lnb + 36 + jj0);
                        const f32x4 c0 = *(const CAS f32x4*)(cosI + (size_t)row * 32 + jj0), c1 = *(const CAS f32x4*)(cosI + (size_t)row * 32 + jj0 + 4);
                        const f32x4 s0 = *(const CAS f32x4*)(sinI + (size_t)row * 32 + jj0), s1 = *(const CAS f32x4*)(sinI + (size_t)row * 32 + jj0 + 4);
                        const f32x4 o10 = a0 * c0 - b0 * s0, o11 = a1 * c1 - b1 * s1, o20 = b0 * c0 + a0 * s0, o21 = b1 * c1 + a1 * s1;
                        bf16* rowp = kidx + (size_t)row * 64 + jj0;
                        u32x4 w1 = {cvt_pk_bf16(o10[0], o10[1]), cvt_pk_bf16(o10[2], o10[3]), cvt_pk_bf16(o11[0], o11[1]), cvt_pk_bf16(o11[2], o11[3])};
                        u32x4 w2 = {cvt_pk_bf16(o20[0], o20[1]), cvt_pk_bf16(o20[2], o20[3]), cvt_pk_bf16(o21[0], o21[1]), cvt_pk_bf16(o21[2], o21[3])};
                        *(u32x4*)rowp = w1; *(u32x4*)(rowp + 32) = w2; }
            } else if (wc == 1) {
                const int h0 = 8 * (fq & 1);
                const f32x4 db0 = *(const CAS f32x4*)(dt_bias + h0), db1 = *(const CAS f32x4*)(dt_bias + h0 + 4);
#pragma unroll
                for (int ai = 0; ai < 2; ++ai)
#pragma unroll
                    for (int m = 0; m < 4; ++m) { const int row = row0 + ai * 128 + m * 16;
                        const f32x4 a0 = acc[ai][0][m][0], a1 = acc[ai][0][m][1];
                        if (fq < 2) { *(f32x4*)(widx + (size_t)row * 16 + h0) = a0 * 0.03125f; *(f32x4*)(widx + (size_t)row * 16 + h0 + 4) = a1 * 0.03125f; }
                        else { f32x4 d0 = a0 + db0, d1 = a1 + db1;
#pragma unroll
                            for (int i = 0; i < 4; ++i) { d0[i] = d0[i] > 20.f ? d0[i] : log1pf(__expf(d0[i])); d1[i] = d1[i] > 20.f ? d1[i] : log1pf(__expf(d1[i])); }
                            *(f32x4*)(dt + (size_t)row * 16 + h0) = d0; *(f32x4*)(dt + (size_t)row * 16 + h0 + 4) = d1; } }
            }
        }
    }
};
constexpr int IX_QP = 2064;
constexpr int IX_ST = 32 * IX_QP;
constexpr int IX_WL = IX_ST + 8 * 8320;
__device__ __forceinline__ void idx_unit(Frame& F, int b, int s, int par) {
    const CAS bf16* kidx = (const CAS bf16*)(F.ws() + WS_KIDX); const CAS bf16* qidx = (const CAS bf16*)(F.ws() + WS_QIDX); const CAS float* widx = (const CAS float*)(F.ws() + WS_WIDX); float* scores = WSP(float, WS_SCORES);
    const int lane = F.lane(), r32 = lane & 31, hi = lane >> 5, w = F.wave(), tid = F.tid();
    LAS unsigned char* Ql = F.lds();
    { const CAS bf16* src = qidx + (size_t)(b * SEQ + s * 32) * 1024;
#pragma unroll
      for (int i = 0; i < 8; ++i) { const int c = tid + 512 * i, row = c >> 7, ch = c & 127;
          *(LAS bf16x8*)(Ql + row * IX_QP + ch * 16) = *(const CAS bf16x8*)(src + (size_t)row * 1024 + ch * 8); }
      if (tid < 128) { const f32x4 wv = *(const CAS f32x4*)(widx + (size_t)(b * SEQ + s * 32 + (tid >> 2)) * 16 + 4 * (tid & 3)); LAS float* wl = (LAS float*)(F.lds() + IX_WL) + (tid >> 2) * 17 + 4 * (tid & 3);
          wl[0] = wv[0]; wl[1] = wv[1]; wl[2] = wv[2]; wl[3] = wv[3]; } }
    __syncthreads();
    const int qpos = s * 32 + r32, nT = (s >> 2) + 1;
    const LAS float* wrow = (const LAS float*)(F.lds() + IX_WL) + r32 * 17;
    const LAS unsigned char* qrow = Ql + r32 * IX_QP + hi * 16;
    LAS float* st = (LAS float*)(F.lds() + IX_ST + w * 8320);
#pragma unroll 1
    for (int t = par + 2 * w; t < nT; t += 16) {
        const int kpos0 = t * 128;
        bf16x8 A[4][4];
#pragma unroll
        for (int kt = 0; kt < 4; ++kt)
#pragma unroll
            for (int ks = 0; ks < 4; ++ks) A[kt][ks] = *(const CAS bf16x8*)(kidx + (size_t)(b * SEQ + kpos0 + kt * 32 + r32) * 64 + ks * 16 + hi * 8);
        f32x16 o[4] = {};
#pragma unroll 1
        for (int h = 0; h < 16; ++h) { const float wh = wrow[h];
            bf16x8 Bq[4];
#pragma unroll
            for (int ks = 0; ks < 4; ++ks) Bq[ks] = *(const LAS bf16x8*)(qrow + h * 128 + ks * 32);
#pragma unroll
            for (int kt = 0; kt < 4; ++kt) { f32x16 a = {};
#pragma unroll
                for (int ks = 0; ks < 4; ++ks) a = __builtin_amdgcn_mfma_f32_32x32x16_bf16(A[kt][ks], Bq[ks], a, 0, 0, 0);
#pragma unroll
                for (int r = 0; r < 16; ++r) o[kt][r] = fmaf(wh, __int_as_float(max(__float_as_int(a[r]), 0)), o[kt][r]); } }
        const float NEG = -__builtin_inff();
#pragma unroll
        for (int half = 0; half < 2; ++half) {
#pragma unroll
            for (int r = 0; r < 16; ++r) { const int kk = crow(r, hi);
                st[r32 * 65 + kk] = (kpos0 + half * 64 + kk > qpos) ? NEG : o[2 * half][r];
                st[r32 * 65 + 32 + kk] = (kpos0 + half * 64 + 32 + kk > qpos) ? NEG : o[2 * half + 1][r]; }
            LDS_WAIT(); asm volatile("" ::: "memory");
            float* dst = scores + (size_t)(b * SEQ + s * 32) * SEQ + kpos0 + half * 64 + lane;
#pragma unroll 4
            for (int q = 0; q < 32; ++q) { *dst = st[q * 65 + lane]; dst += SEQ; }
            LDS_WAIT(); asm volatile("" ::: "memory"); }
    }
    __syncthreads();
}

constexpr int SA_P = 136;
constexpr int SA_BN = 0, SA_CN = 34816, SA_BT = 69632, SA_CB = 104448, SA_SM = 139264;
__device__ __forceinline__ void conv8(const CAS bf16* xraw_row  , int tpos, const CAS float* cw, const CAS float* cb, float (&o)[8]) {
    bf16x8 xv[4];
#pragma unroll
    for (int k = 0; k < 4; ++k) { const int dt_ = k - 3; xv[k] = *(const CAS bf16x8*)(xraw_row + ((tpos + dt_ >= 0) ? (long)dt_ * CONV_CH : 0l)); }
    const f32x4 b0 = *(const CAS f32x4*)cb, b1 = *(const CAS f32x4*)(cb + 4);
#pragma unroll
    for (int j = 0; j < 4; ++j) { o[j] = b0[j]; o[4 + j] = b1[j]; }
#pragma unroll
    for (int k = 0; k < 4; ++k) { const float vm = (tpos + k - 3 >= 0) ? 1.f : 0.f; float xf[8]; unpack8(xv[k], xf);
        const f32x4 w0 = *(const CAS f32x4*)(cw + k * CONV_CH) * vm, w1 = *(const CAS f32x4*)(cw + k * CONV_CH + 4) * vm;
#pragma unroll
        for (int j = 0; j < 4; ++j) { o[j] += w0[j] * xf[j]; o[4 + j] += w1[j] * xf[4 + j]; } }
#pragma unroll
    for (int j = 0; j < 8; ++j) o[j] = silu_f(o[j]);
}
__device__ __forceinline__ void ssd_a_unit(Frame& F, int b, int c, int g, int hf) {
    const CAS bf16* xbc = (const CAS bf16*)(F.ws() + WS_XBC); bf16* xact = WSP(bf16, WS_XBCACT); const CAS float* dtg = (const CAS float*)(F.ws() + WS_DT); float* csg = WSP(float, WS_CS);
    float* ydiag = WSP(float, WS_YDIAG); float* states = WSP(float, WS_STATES);
    LAS bf16* Bn = (LAS bf16*)(F.lds() + SA_BN); LAS bf16* Cn = (LAS bf16*)(F.lds() + SA_CN); LAS bf16* BT = (LAS bf16*)(F.lds() + SA_BT); LAS bf16* CB = (LAS bf16*)(F.lds() + SA_CB);
    const int lane = F.lane(), r32 = lane & 31, hi = lane >> 5, w = F.wave();
    const int tok0 = b * SEQ + c * CHUNK;
#pragma unroll 4
    for (int i = 0; i < 8; ++i) { const int id = F.tid() + 512 * i, mi = id >> 11, rem = id & 2047, s = rem >> 4, ch = rem & 15;
        const int chan = 1024 + mi * 256 + g * 128 + ch * 8; float o[8];
        conv8(xbc + (size_t)(tok0 + s) * CONV_CH + chan, c * CHUNK + s, F.f(6) + chan, F.f(7) + chan, o);
        u32x4 pk = {cvt_pk_bf16(o[0], o[1]), cvt_pk_bf16(o[2], o[3]), cvt_pk_bf16(o[4], o[5]), cvt_pk_bf16(o[6], o[7])};
        if (mi == 0) { *(LAS u32x4*)(Bn + s * SA_P + ch * 8) = pk;
#pragma unroll
            for (int j = 0; j < 8; ++j) BT[(ch * 8 + j) * SA_P + s] = (bf16)((pk[j >> 1] >> (16 * (j & 1))) & 0xffffu); }
        else { *(LAS u32x4*)(Cn + s * SA_P + ch * 8) = pk; if (hf == 0) *(u32x4*)(xact + (size_t)(tok0 + s) * CONV_CH + chan) = pk; } }
    __syncthreads();
    { const int lt = w >> 1;
#pragma unroll
      for (int sq = 0; sq < 2; ++sq) { const int st = 2 * (w & 1) + sq; f32x16 a = {};
#pragma unroll
          for (int ks = 0; ks < 8; ++ks) { const bf16x8 av = *(const LAS bf16x8*)(Cn + (32 * lt + r32) * SA_P + 16 * ks + 8 * hi), bv = *(const LAS bf16x8*)(Bn + (32 * st + r32) * SA_P + 16 * ks + 8 * hi);
              a = __builtin_amdgcn_mfma_f32_32x32x16_bf16(av, bv, a, 0, 0, 0); }
#pragma unroll
          for (int r = 0; r < 16; ++r) CB[(32 * lt + crow(r, hi)) * SA_P + 32 * st + r32] = f2bf(a[r]); } }
    __syncthreads();
    const int j = w >> 1, sub = w & 1, h = 8 * g + 4 * hf + j;
    LAS bf16* XT = (LAS bf16*)(F.lds() + j * 17408);
    LAS float* cs_l = (LAS float*)(F.lds() + SA_SM) + j * 384; LAS float* wdec = cs_l + 128;
    {
        const float ah = -__expf(F.f(9)[h]);
        const float d0 = dtg[(size_t)(tok0 + lane) * 16 + h], d1 = dtg[(size_t)(tok0 + 64 + lane) * 16 + h];
        float c0 = d0 * ah, c1 = d1 * ah;
#pragma unroll
        for (int o = 1; o < 64; o <<= 1) { const float t0 = __shfl_up(c0, o), t1 = __shfl_up(c1, o); if (lane >= o) { c0 += t0; c1 += t1; } }
        const float tot0 = __shfl(c0, 63); c1 += tot0; const float cend = __shfl(c1, 63);
        if (sub == 0) { cs_l[lane] = c0; cs_l[64 + lane] = c1; wdec[lane] = __expf(cend - c0); wdec[64 + lane] = __expf(cend - c1);
            csg[(size_t)(tok0 + lane) * 16 + h] = c0; csg[(size_t)(tok0 + 64 + lane) * 16 + h] = c1; }
#pragma unroll 4
        for (int i = 0; i < 8; ++i) { const int id = lane + 64 * i, s = 64 * sub + (id >> 3), ch = id & 7, chan = h * 64 + ch * 8; float o[8];
            conv8(xbc + (size_t)(tok0 + s) * CONV_CH + chan, c * CHUNK + s, F.f(6) + chan, F.f(7) + chan, o);
            u32x4 pk = {cvt_pk_bf16(o[0], o[1]), cvt_pk_bf16(o[2], o[3]), cvt_pk_bf16(o[4], o[5]), cvt_pk_bf16(o[6], o[7])};
            *(u32x4*)(xact + (size_t)(tok0 + s) * CONV_CH + chan) = pk;
            const float dts = dtg[(size_t)(tok0 + s) * 16 + h];
#pragma unroll
            for (int jj = 0; jj < 8; ++jj) XT[(ch * 8 + jj) * SA_P + s] = f2bf(o[jj] * dts); }
    }
    __syncthreads();
#pragma unroll
    for (int lq = 0; lq < 2; ++lq) { const int lt = 2 * sub + lq; const int l = 32 * lt + r32; const float csl = cs_l[l];
        f32x16 a0 = {}, a1 = {};
        for (int ks = 0; ks <= 2 * lt + 1; ++ks) { const int s0 = 16 * ks + 8 * hi;
            float cbf[8]; unpack8(*(const LAS bf16x8*)(CB + l * SA_P + s0), cbf);
            const f32x4 q0 = *(const LAS f32x4*)(cs_l + s0), q1 = *(const LAS f32x4*)(cs_l + s0 + 4);
            float mv[8];
#pragma unroll
            for (int jj = 0; jj < 8; ++jj) { const float cq = jj < 4 ? q0[jj & 3] : q1[jj & 3]; mv[jj] = (s0 + jj <= l) ? cbf[jj] * __expf(csl - cq) : 0.f; }
            const bf16x8 av = pack8((f32x4){mv[0], mv[1], mv[2], mv[3]}, (f32x4){mv[4], mv[5], mv[6], mv[7]});
            const bf16x8 b0 = *(const LAS bf16x8*)(XT + r32 * SA_P + s0), b1 = *(const LAS bf16x8*)(XT + (32 + r32) * SA_P + s0);
            a0 = __builtin_amdgcn_mfma_f32_32x32x16_bf16(av, b0, a0, 0, 0, 0); a1 = __builtin_amdgcn_mfma_f32_32x32x16_bf16(av, b1, a1, 0, 0, 0); }
#pragma unroll
        for (int r = 0; r < 16; ++r) { float* yp = ydiag + (size_t)(tok0 + 32 * lt + crow(r, hi)) * D_SSM + h * 64 + r32; yp[0] = a0[r]; yp[32] = a1[r]; } }
    { f32x16 a[2][2] = {};
      for (int ks = 0; ks < 8; ++ks) { const int s0 = 16 * ks + 8 * hi;
          const f32x4 q0 = *(const LAS f32x4*)(wdec + s0), q1 = *(const LAS f32x4*)(wdec + s0 + 4);
          bf16x8 av[2];
#pragma unroll
          for (int pt = 0; pt < 2; ++pt) { float xf[8]; unpack8(*(const LAS bf16x8*)(XT + (32 * pt + r32) * SA_P + s0), xf);
              av[pt] = pack8((f32x4){xf[0] * q0[0], xf[1] * q0[1], xf[2] * q0[2], xf[3] * q0[3]}, (f32x4){xf[4] * q1[0], xf[5] * q1[1], xf[6] * q1[2], xf[7] * q1[3]}); }
#pragma unroll
          for (int nq = 0; nq < 2; ++nq) { const bf16x8 bv = *(const LAS bf16x8*)(BT + (32 * (2 * sub + nq) + r32) * SA_P + s0);
#pragma unroll
              for (int pt = 0; pt < 2; ++pt) a[pt][nq] = __builtin_amdgcn_mfma_f32_32x32x16_bf16(av[pt], bv, a[pt][nq], 0, 0, 0); } }
      float* sp = states + ((size_t)((b * NCHUNK + c) * SSM_H + h) * SSM_P) * SSM_N;
#pragma unroll
      for (int pt = 0; pt < 2; ++pt)
#pragma unroll
          for (int nq = 0; nq < 2; ++nq)
#pragma unroll
              for (int r = 0; r < 16; ++r) sp[(size_t)(32 * pt + crow(r, hi)) * SSM_N + 32 * (2 * sub + nq) + r32] = a[pt][nq][r]; }
    __syncthreads();
}
constexpr int N_SSD_A = NBATCH * NCHUNK * 2 * 2, N_IDX_U = 256;
__device__ __forceinline__ void p3_ssd(Frame& F) {
#pragma unroll 1
    for (int L = F.bid(); L < N_SSD_A; L += F.G()) { const int hf = L & 1, g = (L >> 1) & 1, c = (L >> 2) & 31, b = L >> 7; ssd_a_unit(F, b, c, g, hf); }
}
__device__ __forceinline__ void p3_idx(Frame& F) {
    int L = F.bid(); while (L < N_SSD_A) L += F.G();
#pragma unroll 1
    for (; L < N_SSD_A + N_IDX_U; L += F.G()) { const int p0 = L - N_SSD_A, b = p0 >> 7, par = p0 & 1, s = (p0 >> 1) & 63;
        idx_unit(F, b, 127 - s, par); idx_unit(F, b, s, par); }
}
__device__ __forceinline__ unsigned fkey(float f) { const unsigned u = __float_as_uint(f); return (u & 0x80000000u) ? ~u : (u | 0x80000000u); }
__device__ __forceinline__ void select_row(Frame& F, int row, LAS unsigned* hist, LAS unsigned* keys) {
    const float* sc = WSP(const float, WS_SCORES) + (size_t)row * SEQ; unsigned long long* mrow = WSP(unsigned long long, WS_MASK) + (size_t)row * 64;
    const int lane = F.lane(), t = row & (SEQ - 1);
    if (t < TOPK_SEL) {
        const int lo = 64 * lane; unsigned long long m;
        if (lo + 63 <= t) m = ~0ull; else if (lo > t) m = 0ull; else m = (1ull << (t - lo + 1)) - 1ull;
        mrow[lane] = m; return;
    }
    const int nI = (t >> 6) + 1;
    float amax = 0.f;
    const int n4 = (t >> 8) + 1;
#pragma unroll 8
    for (int i = 0; i < n4; ++i) { const int e0 = 256 * i + 4 * lane; const f32x4 v = *(const f32x4*)(sc + e0);
        u32x4 kb;
#pragma unroll
        for (int j = 0; j < 4; ++j) { const bool ok = (e0 + j <= t); kb[j] = ok ? __float_as_uint(v[j]) : 0u; amax = fmaxf(amax, ok ? fabsf(v[j]) : 0.f); }
        *(LAS u32x4*)(keys + e0) = kb; }
#pragma unroll
    for (int o = 1; o < 64; o <<= 1) amax = fmaxf(amax, __shfl_xor(amax, o));
    const float ks = 0.49f / fmaxf(amax, 1e-30f);
    unsigned prefix = 0u, need = TOPK_SEL, pmask = 0u, cnt_eq = 0u;
#pragma unroll 1
    for (int pass = 0; pass < 3; ++pass) { const int shift = (pass == 0) ? 15 : (pass == 1 ? 7 : 0); const unsigned dmask = (pass == 2) ? 127u : 255u;
        hist[4 * lane] = 0u; hist[4 * lane + 1] = 0u; hist[4 * lane + 2] = 0u; hist[4 * lane + 3] = 0u;
        LDS_WAIT(); asm volatile("" ::: "memory");
        if (pass == 0) {
#pragma unroll 1
            for (int i0 = 0; i0 < nI; i0 += 8) { unsigned kk[8];
#pragma unroll
                for (int j = 0; j < 8; ++j) { const int e = 64 * (i0 + j) + lane; kk[j] = keys[e & 4095]; }
#pragma unroll
                for (int j = 0; j < 8; ++j) { const int e = 64 * (i0 + j) + lane; kk[j] = (e <= t) ? (__float_as_uint(fmaf(__uint_as_float(kk[j]), ks, 1.5f)) & 0x7fffffu) : 0u; }
#pragma unroll
                for (int j = 0; j < 8; ++j) { const int e = 64 * (i0 + j) + lane; if (i0 + j < nI) keys[e] = kk[j];
                    if (kk[j] != 0u) __hip_atomic_fetch_add(hist + (kk[j] >> 15), 1u, __ATOMIC_RELAXED, __HIP_MEMORY_SCOPE_WORKGROUP); } }
        } else {
#pragma unroll 1
            for (int i0 = 0; i0 < nI; i0 += 8) { unsigned kk[8];
#pragma unroll
                for (int j = 0; j < 8; ++j) { const int e = 64 * (i0 + j) + lane; kk[j] = (i0 + j < nI) ? keys[e & 4095] : 0u; }
#pragma unroll
                for (int j = 0; j < 8; ++j) if ((kk[j] & pmask) == prefix && kk[j] != 0u) __hip_atomic_fetch_add(hist + ((kk[j] >> shift) & dmask), 1u, __ATOMIC_RELAXED, __HIP_MEMORY_SCOPE_WORKGROUP); }
        }
        LDS_WAIT(); asm volatile("" ::: "memory");
        const unsigned c0 = hist[4 * lane], c1 = hist[4 * lane + 1], c2 = hist[4 * lane + 2], c3 = hist[4 * lane + 3];
        const unsigned tot = c0 + c1 + c2 + c3;
        unsigned suf = tot;
#pragma unroll
        for (int o = 1; o < 64; o <<= 1) { const unsigned tt = __shfl_down(suf, o); if (lane + o < 64) suf += tt; }
        unsigned above = suf - tot;
        int found = -1; unsigned nneed = 0u, fcnt = 0u;
        if (above < need && need <= above + c3) { found = 3; nneed = need - above; fcnt = c3; }
        above += c3;
        if (found < 0 && above < need && need <= above + c2) { found = 2; nneed = need - above; fcnt = c2; }
        above += c2;
        if (found < 0 && above < need && need <= above + c1) { found = 1; nneed = need - above; fcnt = c1; }
        above += c1;
        if (found < 0 && above < need && need <= above + c0) { found = 0; nneed = need - above; fcnt = c0; }
        const unsigned long long bal = __ballot(found >= 0);
        const int src = (int)__builtin_ctzll(bal | (1ull << 63));
        const unsigned digit = (unsigned)__shfl(4 * lane + found, src);
        need = (unsigned)__shfl((int)nneed, src); cnt_eq = (unsigned)__shfl((int)fcnt, src);
        prefix |= digit << shift; pmask |= dmask << shift;
        LDS_WAIT(); asm volatile("" ::: "memory");
    }
    const bool all_eq = (cnt_eq == need);
    unsigned run = 0u; unsigned long long myword = 0ull;
    const unsigned long long lt_mask = (lane == 0) ? 0ull : (~0ull >> (64 - lane));
#pragma unroll 4
    for (int i = 0; i < nI; ++i) {
        const unsigned k = keys[64 * i + lane]; bool sel = k > prefix;
        if (all_eq) { sel = sel || (k == prefix); }
        else { const unsigned long long em = __ballot(k == prefix); if (k == prefix) sel = (run + (unsigned)__popcll(em & lt_mask)) < need; run += (unsigned)__popcll(em); }
        const unsigned long long wb = __ballot(sel);
        if (lane == i) myword = wb;
    }
    mrow[lane] = myword;
    LDS_WAIT(); asm volatile("" ::: "memory");
}
__device__ __forceinline__ void p4_select(Frame& F) {
    LAS unsigned* keys = (LAS unsigned*)(F.lds() + F.wave() * 16384); LAS unsigned* hist = (LAS unsigned*)(F.lds() + 131072 + F.wave() * 1024);
    const int gw = F.bid() * 8 + F.wave(), NGW = F.G() * 8;
    for (int pr = gw; pr < SEQ / 2; pr += NGW) {
#pragma unroll 1
        for (int b = 0; b < NBATCH; ++b) { select_row(F, b * SEQ + pr, hist, keys); select_row(F, b * SEQ + (SEQ - 1 - pr), hist, keys); }
    }
}
__device__ __forceinline__ void p4_scan(Frame& F) {
    const CAS float* states = (const CAS float*)(F.ws() + WS_STATES); bf16* hin = WSP(bf16, WS_HIN); const CAS float* csg = (const CAS float*)(F.ws() + WS_CS);
    const int gt = F.bid() * 512 + F.tid(), NGT = F.G() * 512;
    for (int q = gt; q < NBATCH * SSM_H * SSM_P * (SSM_N / 2); q += NGT) {
        const int n = 2 * (q & 63), p = (q >> 6) & 63, h = (q >> 12) & 15, b = q >> 16;
        float h0 = 0.f, h1 = 0.f;
#pragma unroll 8
        for (int c = 0; c < NCHUNK; ++c) {
            const size_t off = ((size_t)((b * NCHUNK + c) * SSM_H + h) * SSM_P + p) * SSM_N + n;
            *(unsigned*)(hin + off) = cvt_pk_bf16(h0, h1);
            const float dec = __expf(csg[(size_t)(b * SEQ + c * CHUNK + CHUNK - 1) * 16 + h]);
            const f32x2 st = *(const CAS f32x2*)(states + off);
            h0 = dec * h0 + st[0]; h1 = dec * h1 + st[1];
        }
    }
}
namespace att {
constexpr int KVBLK = 64, SHM_K = KVBLK * 128 * 2, SHM_V = SHM_K;
constexpr float SCALE = 0.08838834764831845f, THR = 8.f, C2 = 1.4426950408889634f * SCALE;
#define KSWZ(row, colB) ((row) * 256 + ((colB) ^ (((row) & 7) << 4)))
__device__ __forceinline__ int v_st(int k, int c) { const int kk = (k & ~0xC) | ((k & 4) << 1) | ((k & 8) >> 1); return ((kk >> 3) * 4 + (c >> 5)) * 512 + ((kk & 7) * 32 + (c & 31)) * 2; }
__device__ __forceinline__ int v_rd_base(int lane) { return ((lane & 3) << 3) | (((lane >> 2) & 3) << 6) | (((lane >> 4) & 1) << 5) | (((lane >> 5) & 1) << 8); }
constexpr int v_rd_off(int d0, int ks, int half) { return d0 * 512 + ks * 4096 + half * 2048; }
template <int KB>
__device__ __forceinline__ void qkt(f32x16& p0, f32x16& p1, LAS const char* K_lds, int r32, int hi, const bf16x8* qr) {
    p0 = f32x16{}; p1 = f32x16{};
    LAS const char* kb[4];
#pragma unroll
    for (int dd = 0; dd < 4; ++dd) kb[dd] = K_lds + KB * SHM_K + KSWZ(r32, (dd * 16 + hi * 8) * 2);
#pragma unroll
    for (int d0 = 0; d0 < 8; ++d0) { LAS const char* a = kb[d0 & 3] + (d0 >> 2) * 128;
        const bf16x8 b0 = *(LAS const bf16x8*)a;
        const bf16x8 b1 = *(LAS const bf16x8*)(a + 32 * 256);
        p0 = __builtin_amdgcn_mfma_f32_32x32x16_bf16(b0, qr[d0], p0, 0, 0, 0);
        p1 = __builtin_amdgcn_mfma_f32_32x32x16_bf16(b1, qr[d0], p1, 0, 0, 0); }
}
template <int VB>
__device__ __forceinline__ void pv_tile(f32x16* o, int vb0, bf16x8 pa0, bf16x8 pa1, bf16x8 pa2, bf16x8 pa3) {
#define TRRD(dst, off) asm volatile("ds_read_b64_tr_b16 %0, %1 offset:%2" : "=&v"(dst) : "v"(vb0), "i"(off) : "memory")
#define PV_D0(d0) do { s16x4 l0, l1, l2, l3, h0, h1, h2, h3; constexpr int b_ = VB * SHM_V + v_rd_off(d0, 0, 0); \
        TRRD(l0, b_); TRRD(h0, b_ + 2048); TRRD(l1, b_ + 4096); TRRD(h1, b_ + 6144); TRRD(l2, b_ + 8192); TRRD(h2, b_ + 10240); TRRD(l3, b_ + 12288); TRRD(h3, b_ + 14336); \
        asm volatile("s_waitcnt lgkmcnt(0)" ::: "memory"); __builtin_amdgcn_sched_barrier(0); \
        o[d0] = __builtin_amdgcn_mfma_f32_32x32x16_bf16(pa0, (bf16x8){l0[0], l0[1], l0[2], l0[3], h0[0], h0[1], h0[2], h0[3]}, o[d0], 0, 0, 0);   \
        o[d0] = __builtin_amdgcn_mfma_f32_32x32x16_bf16(pa1, (bf16x8){l1[0], l1[1], l1[2], l1[3], h1[0], h1[1], h1[2], h1[3]}, o[d0], 0, 0, 0);   \
        o[d0] = __builtin_amdgcn_mfma_f32_32x32x16_bf16(pa2, (bf16x8){l2[0], l2[1], l2[2], l2[3], h2[0], h2[1], h2[2], h2[3]}, o[d0], 0, 0, 0);   \
        o[d0] = __builtin_amdgcn_mfma_f32_32x32x16_bf16(pa3, (bf16x8){l3[0], l3[1], l3[2], l3[3], h3[0], h3[1], h3[2], h3[3]}, o[d0], 0, 0, 0); } while (0)
    PV_D0(0); PV_D0(1); PV_D0(2); PV_D0(3);
#undef PV_D0
#undef TRRD
}
__device__ __forceinline__ void softmax_tile(f32x16& p0, f32x16& p1, unsigned long long mw, int hi, float& m_reg, float& l_reg, float& alpha, bf16x8& pa0, bf16x8& pa1, bf16x8& pa2, bf16x8& pa3) {
    float pmax = p0[0];
#pragma unroll
    for (int r = 1; r < 16; ++r) pmax = fmaxf(pmax, p0[r]);
#pragma unroll
    for (int r = 0; r < 16; ++r) pmax = fmaxf(pmax, p1[r]);
    { auto rr = __builtin_amdgcn_permlane32_swap(__float_as_uint(pmax), __float_as_uint(pmax), false, false); pmax = fmaxf(__uint_as_float(rr[0]), __uint_as_float(rr[1])); }
    float mn;
    if (__all((pmax - m_reg) * SCALE <= THR)) { mn = m_reg; alpha = 1.f; }
    else { mn = fmaxf(m_reg, pmax); alpha = __builtin_amdgcn_exp2f((m_reg - mn) * C2); m_reg = mn; }
    const float mnL = -mn * C2;
    const int lo = (int)((unsigned)mw >> (4 * hi)), hh = (int)((unsigned)(mw >> 32) >> (4 * hi));
#pragma unroll
    for (int r = 0; r < 16; ++r) { const int c = (r & 3) + 8 * (r >> 2);
        const float e0 = __builtin_amdgcn_exp2f(fmaf(p0[r], C2, mnL)), e1 = __builtin_amdgcn_exp2f(fmaf(p1[r], C2, mnL));
        p0[r] = __uint_as_float(__float_as_uint(e0) & (unsigned)__builtin_amdgcn_sbfe(lo, c, 1));
        p1[r] = __uint_as_float(__float_as_uint(e1) & (unsigned)__builtin_amdgcn_sbfe(hh, c, 1)); }
    float ps = 0.f;
#pragma unroll
    for (int r = 0; r < 16; ++r) ps += p0[r];
#pragma unroll
    for (int r = 0; r < 16; ++r) ps += p1[r];
    { auto rr = __builtin_amdgcn_permlane32_swap(__float_as_uint(ps), __float_as_uint(ps), false, false); ps = __uint_as_float(rr[0]) + __uint_as_float(rr[1]); }
    l_reg = l_reg * alpha + ps;
#define PK4(P, B_, OUT) do { unsigned a0 = cvt_pk_bf16(P[B_+0], P[B_+1]), a1 = cvt_pk_bf16(P[B_+2], P[B_+3]); \
        unsigned b0 = cvt_pk_bf16(P[B_+4], P[B_+5]), b1 = cvt_pk_bf16(P[B_+6], P[B_+7]); \
        auto r0 = __builtin_amdgcn_permlane32_swap(a0, b0, false, false); auto r1 = __builtin_amdgcn_permlane32_swap(a1, b1, false, false); \
        u32x4 w = {r0[0], r1[0], r0[1], r1[1]}; OUT = __builtin_bit_cast(bf16x8, w); } while (0)
    PK4(p0, 0, pa0); PK4(p0, 8, pa1); PK4(p1, 0, pa2); PK4(p1, 8, pa3);
#undef PK4
}
}

__device__ __forceinline__ void attn_item(Frame& F, int b, int h, int X) {
    using namespace att;
    const bf16* qg = WSP(const bf16, WS_Q); const bf16* kg = WSP(const bf16, WS_K) + (size_t)(b * SEQ) * 1024 + h * 128; const bf16* vg = WSP(const bf16, WS_V) + (size_t)(b * SEQ) * 1024 + h * 128;
    const unsigned long long* maskg = WSP(const unsigned long long, WS_MASK); bf16* ycat = WSP(bf16, WS_YCAT);
    const int tid = F.tid(), wid = F.wave(), lane = F.lane(), r32 = lane & 31, hi = lane >> 5;
    LAS char* V_lds = (LAS char*)F.lds(); LAS char* K_lds = V_lds + 2 * SHM_V;
    LAS float* wsl = (LAS float*)(F.lds() + 2 * SHM_V + 2 * SHM_K) + wid * 64; LAS float* li_l = wsl; LAS float* al_l = wsl + 32;
    const int tokq = b * SEQ + X * 256 + wid * 32 + r32, NT = 4 * X + 4;
    bf16x8 qr[8];
#pragma unroll
    for (int d0 = 0; d0 < 8; ++d0) qr[d0] = *(const bf16x8*)(qg + (size_t)tokq * 1024 + h * 128 + d0 * 16 + hi * 8);
    const unsigned long long* mrow = maskg + (size_t)tokq * 64;
    const int sr = tid >> 4, sc = (tid & 15) * 8, vst0 = v_st(sr, sc), vst1 = v_st(32 + sr, sc), kws = KSWZ(sr, sc * 2);
    const int vb0 = (int)(unsigned)(uintptr_t)V_lds + v_rd_base(lane);
    float m_reg = -1e30f, l_reg = 0.f; f32x16 o[4] = {};
    bf16x8 sA[4], sB[4];
    unsigned long long mwE, mwO;
#define ALOAD(S, t) do { const size_t r0_ = (size_t)((t) * KVBLK + sr) * 1024 + sc; S[0] = *(const bf16x8*)(kg + r0_); S[1] = *(const bf16x8*)(kg + r0_ + 32 * 1024); \
                         S[2] = *(const bf16x8*)(vg + r0_); S[3] = *(const bf16x8*)(vg + r0_ + 32 * 1024); } while (0)
#define AWRITE(S, bf) do { *(LAS bf16x8*)(K_lds + (bf) * SHM_K + kws) = S[0]; *(LAS bf16x8*)(K_lds + (bf) * SHM_K + kws + 32 * 256) = S[1]; \
                           *(LAS bf16x8*)(V_lds + (bf) * SHM_V + vst0) = S[2]; *(LAS bf16x8*)(V_lds + (bf) * SHM_V + vst1) = S[3]; } while (0)
#define ASTEP(t, KB, SW, MW) do { __syncthreads(); \
        if ((t) + 1 < NT) AWRITE(SW, (KB) ^ 1); \
        if ((t) + 3 < NT) ALOAD(SW, (t) + 3); \
        const unsigned long long mw_ = MW; if ((t) + 2 < NT) MW = mrow[(t) + 2]; \
        f32x16 p0, p1; float alpha; bf16x8 pa0, pa1, pa2, pa3; \
        qkt<KB>(p0, p1, K_lds, r32, hi, qr); \
        softmax_tile(p0, p1, mw_, hi, m_reg, l_reg, alpha, pa0, pa1, pa2, pa3); \
        if (__any(alpha < 1.f)) { if (hi == 0) al_l[r32] = alpha; LDS_WAIT(); \
            _Pragma("unroll") for (int d_ = 0; d_ < 4; ++d_) _Pragma("unroll") for (int r = 0; r < 16; ++r) o[d_][r] *= al_l[crow(r, hi)]; } \
        pv_tile<KB>(o, vb0, pa0, pa1, pa2, pa3); } while (0)
    ALOAD(sA, 0); mwE = mrow[0]; mwO = mrow[1];
    AWRITE(sA, 0);
    ALOAD(sB, 1); ALOAD(sA, 2);
    for (int t = 0; t < NT; t += 2) { ASTEP(t, 0, sB, mwE); ASTEP(t + 1, 1, sA, mwO); }
#undef ASTEP
#undef AWRITE
#undef ALOAD
    if (hi == 0) li_l[r32] = l_reg; LDS_WAIT();
    float rli[16];
#pragma unroll
    for (int r = 0; r < 16; ++r) rli[r] = __builtin_amdgcn_rcpf(li_l[crow(r, hi)]);
    bf16* Ow = ycat + (size_t)(b * SEQ + X * 256 + wid * 32) * DM + D_SSM + h * 128;
#pragma unroll
    for (int r = 0; r < 16; ++r) { const int orow = crow(r, hi);
#pragma unroll
        for (int d0 = 0; d0 < 4; ++d0) { const float v = o[d0][r] * rli[r]; const float vn = __shfl_xor(v, 1);
            if ((r32 & 1) == 0) *(unsigned*)(Ow + (size_t)orow * DM + d0 * 32 + r32) = cvt_pk_bf16(v, vn); } }
    __syncthreads();
}

__device__ __forceinline__ void ssd_c_unit(Frame& F, int b, int c, int lq) {
    const CAS bf16* xact = (const CAS bf16*)(F.ws() + WS_XBCACT); const CAS bf16* hin = (const CAS bf16*)(F.ws() + WS_HIN); const CAS float* csg = (const CAS float*)(F.ws() + WS_CS);
    const CAS float* ydiag = (const CAS float*)(F.ws() + WS_YDIAG); const CAS bf16* zg = (const CAS bf16*)(F.ws() + WS_Z); bf16* ycat = WSP(bf16, WS_YCAT);
    LAS float* gb = (LAS float*)F.lds();
    const int lane = F.lane(), r32 = lane & 31, hi = lane >> 5, w = F.wave(), g = w >> 2;
    const int tok0 = b * SEQ + c * CHUNK + lq * 32;
    bf16x8 Af[8];
#pragma unroll
    for (int ks = 0; ks < 8; ++ks) Af[ks] = *(const CAS bf16x8*)(xact + (size_t)(tok0 + r32) * CONV_CH + 1280 + g * 128 + 16 * ks + 8 * hi);
#pragma unroll
    for (int hh = 0; hh < 2; ++hh) { const int h = 2 * w + hh;
        const CAS bf16* hp = hin + ((size_t)((b * NCHUNK + c) * SSM_H + h) * SSM_P) * SSM_N;
        float e[16];
#pragma unroll
        for (int r = 0; r < 16; ++r) e[r] = csg[(size_t)(tok0 + crow(r, hi)) * 16 + h];
        f32x16 a0 = {}, a1 = {};
#pragma unroll
        for (int ks = 0; ks < 8; ++ks) { const bf16x8 b0 = *(const CAS bf16x8*)(hp + (size_t)r32 * SSM_N + 16 * ks + 8 * hi), b1 = *(const CAS bf16x8*)(hp + (size_t)(32 + r32) * SSM_N + 16 * ks + 8 * hi);
            a0 = __builtin_amdgcn_mfma_f32_32x32x16_bf16(Af[ks], b0, a0, 0, 0, 0); a1 = __builtin_amdgcn_mfma_f32_32x32x16_bf16(Af[ks], b1, a1, 0, 0, 0); }
#pragma unroll
        for (int r = 0; r < 16; ++r) { const float ee = __expf(e[r]); LAS float* p = gb + crow(r, hi) * 1024 + h * 64 + r32; p[0] = ee * a0[r]; p[32] = ee * a1[r]; } }
    __syncthreads();
    f32x4 dsk[4], nw[4];
#pragma unroll
    for (int j = 0; j < 4; ++j) { const float d = F.f(10)[4 * j + (lane >> 4)]; dsk[j] = (f32x4){d, d, d, d}; nw[j] = *(const CAS f32x4*)(F.f(11) + j * 256 + lane * 4); }
    f32x4 yd[4][4]; u32x2 xs[4][4], zz[4][4];
#pragma unroll
    for (int rr = 0; rr < 4; ++rr) { const size_t tok = (size_t)(tok0 + 4 * w + rr);
#pragma unroll
        for (int j = 0; j < 4; ++j) { const int col = j * 256 + lane * 4; yd[rr][j] = *(const CAS f32x4*)(ydiag + tok * D_SSM + col);
            xs[rr][j] = *(const CAS u32x2*)(xact + tok * CONV_CH + col); zz[rr][j] = *(const CAS u32x2*)(zg + tok * 1024 + col); } }
#pragma unroll
    for (int rr = 0; rr < 4; ++rr) { const int l = 4 * w + rr; float ss = 0.f; f32x4 v[4];
#pragma unroll
        for (int j = 0; j < 4; ++j) { const f32x4 yo = *(const LAS f32x4*)(gb + l * 1024 + j * 256 + lane * 4);
            const f32x4 xf = {bflo(xs[rr][j][0]), bfhi(xs[rr][j][0]), bflo(xs[rr][j][1]), bfhi(xs[rr][j][1])}, zf = {bflo(zz[rr][j][0]), bfhi(zz[rr][j][0]), bflo(zz[rr][j][1]), bfhi(zz[rr][j][1])};
            f32x4 y = yd[rr][j] + yo + dsk[j] * xf;
#pragma unroll
            for (int i = 0; i < 4; ++i) y[i] *= silu_f(zf[i]);
            v[j] = y; ss += (y[0] * y[0] + y[1] * y[1]) + (y[2] * y[2] + y[3] * y[3]); }
        const float rs = 1.0f / sqrtf(wave_sum(ss) * (1.0f / 1024.0f) + LN_EPS);
#pragma unroll
        for (int j = 0; j < 4; ++j) { const f32x4 y = v[j] * rs * nw[j];
            *(u32x2*)(ycat + (size_t)(tok0 + l) * DM + j * 256 + lane * 4) = (u32x2){cvt_pk_bf16(y[0], y[1]), cvt_pk_bf16(y[2], y[3])}; } }
    __syncthreads();
}
__device__ __forceinline__ void p5_phase(Frame& F) {
    for (int L = F.bid(); L < 256; L += F.G()) { const int lq = L & 3, c = (L >> 2) & 31, b = L >> 7; ssd_c_unit(F, b, c, lq); }
    PSUB(50, 0);
    for (int L = F.bid(); L < 256; L += F.G()) { const int X = 15 - (L >> 4), h = L & 7, b = (L >> 3) & 1; attn_item(F, b, h, X); }
    PSUB(50, 1);
}
struct EpiOutProj {
    static constexpr bool PERM = false;
    const CAS float* x; const CAS float* modf; float* out;
    __device__ __forceinline__ void operator()(const f32x4 (&acc)[2][2][4][2], const pg8::Unit& u, int wr, int wc, int fr, int fq) const {
        const int row0 = u.pm * 256 + wr * 64 + fr, col0 = u.pn * 256 + wc * 32 + 4 * fq; const int b = (u.pm * 256) / SEQ;
        f32x4 gv[2][2];
#pragma unroll
        for (int bj = 0; bj < 2; ++bj)
#pragma unroll
            for (int n = 0; n < 2; ++n) gv[bj][n] = *(const CAS f32x4*)(modf + (size_t)b * (6 * DM) + 2 * DM + col0 + bj * 128 + n * 16);
#pragma unroll
        for (int ai = 0; ai < 2; ++ai)
#pragma unroll
            for (int m = 0; m < 4; ++m) { const size_t off = (size_t)(row0 + ai * 128 + m * 16) * DM + col0;
#pragma unroll
                for (int bj = 0; bj < 2; ++bj)
#pragma unroll
                    for (int n = 0; n < 2; ++n) { const f32x4 xv = *(const CAS f32x4*)(x + off + bj * 128 + n * 16);
                        *(f32x4*)(out + off + bj * 128 + n * 16) = xv * ALPHA_DN + gv[bj][n] * acc[ai][bj][m][n]; } }
    }
};

constexpr int RT_P = 2056;
__device__ __forceinline__ void p7_unit(Frame& F, int un) {
    const CAS float* modf = (const CAS float*)(F.ws() + WS_MODF); bf16* u2 = WSP(bf16, WS_U2); const CAS bf16* wr_hi = (const CAS bf16*)(F.ws() + WS_WR); const CAS bf16* wr_lo = wr_hi + NE * DM;
    int* inv = WSP(int, WS_INV); int* ltok = WSP(int, WS_LTOK); float* lw = WSP(float, WS_LW);
    LAS bf16* Ah = (LAS bf16*)F.lds(); LAS bf16* Al = Ah + 16 * RT_P; LAS float* red = (LAS float*)F.lds();
    LAS float* logit = (LAS float*)(F.lds() + 135168);
    LAS int* ecnt = (LAS int*)(F.lds() + 139264); LAS int* ebase = ecnt + 64;
    const int lane = F.lane(), w = F.wave(), row0 = un * 16, b = row0 / SEQ;
    const CAS float* sh2 = modf + (size_t)b * (6 * DM) + 3 * DM; const CAS float* sc2 = modf + (size_t)b * (6 * DM) + 4 * DM;
    PSUB(70, 0); PSUB(71, 0);
#pragma unroll 1
    for (int rr = 0; rr < 2; ++rr) { const int rl = 2 * w + rr; const size_t row = (size_t)(row0 + rl);
        f32x4 v[8]; float s = 0.f;
#pragma unroll
        for (int j = 0; j < 8; ++j) { v[j] = *(const f32x4*)(F.out() + row * DM + j * 256 + lane * 4); s += (v[j][0] + v[j][1]) + (v[j][2] + v[j][3]); }
        const float mu = wave_sum(s) * (1.0f / DM); float q = 0.f;
#pragma unroll
        for (int j = 0; j < 8; ++j) { v[j] = v[j] - mu; q += (v[j][0] * v[j][0] + v[j][1] * v[j][1]) + (v[j][2] * v[j][2] + v[j][3] * v[j][3]); }
        const float rstd = 1.0f / sqrtf(wave_sum(q) * (1.0f / DM) + LN_EPS);
#pragma unroll
        for (int j = 0; j < 8; ++j) { const int col = j * 256 + lane * 4;
            const f32x4 x1 = v[j] * rstd * *(const CAS f32x4*)(F.f(15) + col) + *(const CAS f32x4*)(F.f(16) + col);
            *(f32x4*)(F.out() + row * DM + col) = x1;
            const f32x4 uu = x1 * (*(const CAS f32x4*)(sc2 + col) + 1.0f) + *(const CAS f32x4*)(sh2 + col);
            const unsigned h0 = cvt_pk_bf16(uu[0], uu[1]), h1 = cvt_pk_bf16(uu[2], uu[3]);
            *(u32x2*)(u2 + row * DM + col) = (u32x2){h0, h1};
            const unsigned l0 = cvt_pk_bf16(uu[0] - bflo(h0), uu[1] - bfhi(h0)), l1 = cvt_pk_bf16(uu[2] - bflo(h1), uu[3] - bfhi(h1));
            *(LAS u32x2*)(Ah + rl * RT_P + col) = (u32x2){h0, h1}; *(LAS u32x2*)(Al + rl * RT_P + col) = (u32x2){l0, l1}; } }
    if (F.tid() < 64) ecnt[F.tid()] = 0;
    __syncthreads();
    PSUB(70, 1); PSUB(72, 0);
    f32x4 acc[4] = {};
    { const int fr = lane & 15, fq = lane >> 4;
      bf16x8 bh[4][4], bl[4][4];
#pragma unroll
      for (int kb = 0; kb < 2; ++kb) {
#pragma unroll
          for (int kq = 0; kq < 4; ++kq) { const int k0_ = w * 256 + (4 * kb + kq) * 32 + fq * 8;
#pragma unroll
              for (int nt = 0; nt < 4; ++nt) { bh[kq][nt] = *(const CAS bf16x8*)(wr_hi + (size_t)(16 * nt + fr) * DM + k0_); bl[kq][nt] = *(const CAS bf16x8*)(wr_lo + (size_t)(16 * nt + fr) * DM + k0_); } }
#pragma unroll
          for (int kq = 0; kq < 4; ++kq) { const int k0_ = w * 256 + (4 * kb + kq) * 32 + fq * 8;
              const bf16x8 ah = *(const LAS bf16x8*)(Ah + fr * RT_P + k0_), al = *(const LAS bf16x8*)(Al + fr * RT_P + k0_);
#pragma unroll
              for (int nt = 0; nt < 4; ++nt) { acc[nt] = __builtin_amdgcn_mfma_f32_16x16x32_bf16(ah, bh[kq][nt], acc[nt], 0, 0, 0);
                  acc[nt] = __builtin_amdgcn_mfma_f32_16x16x32_bf16(al, bh[kq][nt], acc[nt], 0, 0, 0); acc[nt] = __builtin_amdgcn_mfma_f32_16x16x32_bf16(ah, bl[kq][nt], acc[nt], 0, 0, 0); } } }
      __syncthreads();
#pragma unroll
      for (int nt = 0; nt < 4; ++nt)
#pragma unroll
          for (int r = 0; r < 4; ++r) red[(w * 16 + fq * 4 + r) * 64 + 16 * nt + fr] = acc[nt][r]; }
    __syncthreads();
#pragma unroll
    for (int i = 0; i < 2; ++i) { const int o = F.tid() + 512 * i; float s = 0.f;
#pragma unroll
        for (int ww = 0; ww < 8; ++ww) s += red[ww * 1024 + o];
        logit[o] = s; }
    __syncthreads();
    PSUB(72, 1); PSUB(73, 0);
    float score_[2]; int erank_[2]; bool sel_[2];
#pragma unroll
    for (int rr = 0; rr < 2; ++rr) { const int rl = 2 * w + rr;
        const float score = sigmoid_f(logit[rl * 64 + lane]); const float biased = score + F.f(18)[lane];
        float m1 = biased;
#pragma unroll
        for (int o = 1; o < 8; o <<= 1) m1 = fmaxf(m1, __shfl_xor(m1, o));
        int i1 = (biased == m1) ? lane : 64;
#pragma unroll
        for (int o = 1; o < 8; o <<= 1) i1 = min(i1, __shfl_xor(i1, o));
        float m2 = (lane == i1) ? -__builtin_inff() : biased;
#pragma unroll
        for (int o = 1; o < 8; o <<= 1) m2 = fmaxf(m2, __shfl_xor(m2, o));
        const float gs = m1 + m2; const int grp = lane >> 3;
        int grank = 0;
#pragma unroll
        for (int g2 = 0; g2 < 8; ++g2) { const float og = __int_as_float(__builtin_amdgcn_readlane(__float_as_int(gs), 8 * g2)); grank += (og > gs || (og == gs && g2 < grp)) ? 1 : 0; }
        const float mk = (grank < 4) ? biased : -__builtin_inff();
        int erank = 0;
#pragma unroll 8
        for (int e2 = 0; e2 < 64; ++e2) { const float oe = __int_as_float(__builtin_amdgcn_readlane(__float_as_int(mk), e2)); erank += (oe > mk || (oe == mk && e2 < lane)) ? 1 : 0; }
        score_[rr] = score; erank_[rr] = erank; sel_[rr] = erank < 8; }
    int lr_[2]; float gw_[2];
#pragma unroll
    for (int rr = 0; rr < 2; ++rr) { const float wsum = wave_sum(sel_[rr] ? score_[rr] : 0.f); gw_[rr] = score_[rr] / wsum * 2.5f;
        lr_[rr] = sel_[rr] ? __hip_atomic_fetch_add(ecnt + lane, 1, __ATOMIC_RELAXED, __HIP_MEMORY_SCOPE_WORKGROUP) : 0; }
    __syncthreads();
    if (w == 0) { const int c = ecnt[lane]; ebase[lane] = c ? (int)__hip_atomic_fetch_add(F.ctl() + CW_ECNT + 64 * lane, (unsigned)c, RLX_AGENT) : 0; }
    __syncthreads();
#pragma unroll
    for (int rr = 0; rr < 2; ++rr) { const int tok = row0 + 2 * w + rr;
        if (sel_[rr]) { const int rk = ebase[lane] + lr_[rr];
            ltok[lane * NTOK + rk] = tok; lw[lane * NTOK + rk] = gw_[rr]; inv[tok * 8 + erank_[rr]] = lane * NTOK + rk; } }
    __syncthreads();
    PSUB(73, 1); PSUB(71, 1);
}
__device__ __forceinline__ void p7_phase(Frame& F) { for (int un = F.bid(); un < NTOK / 16; un += F.G()) p7_unit(F, un); }
struct MoeOrder {
    const LAS int* tab; const int* ltok; int G, c, npn;
    __device__ __forceinline__ bool next(int i, pg8::Unit& u) const {
        const int L = i * G + c; const int total = tab[80 + NEX] * npn; if (L >= total) return false;
        int e = 0;
#pragma unroll
        for (int st = 64; st >= 1; st >>= 1) { const int k = e + st; if (k < NEX && tab[80 + k] * npn <= L) e = k; }
        const int nte = tab[80 + e + 1] - tab[80 + e], rem = L - tab[80 + e] * npn;
        const int mt = (npn == 8) ? rem / npn : rem % nte, pn = (npn == 8) ? rem % npn : rem / nte;
        u.pm = tab[80 + e] + mt; u.pn = e * npn + pn; u.ax = (e << 8) | mt; return true;
    }
    __device__ __forceinline__ int row_tok(const pg8::Unit& u, int r) const {
        const int e = u.ax >> 8, idx = (u.ax & 255) * 256 + r;
        if (e == NE) return idx;
        return idx < tab[e] ? ltok[e * NTOK + idx] : 0;
    }
};
__device__ __forceinline__ void moe_tables(Frame& F) {
    LAS int* tab = (LAS int*)(F.lds() + LDS_MISC + 64);
    if (F.wave() == 0) { const int lane = F.lane();
        const int cn = (int)__hip_atomic_load(F.ctl() + CW_ECNT + 64 * lane, RLX_AGENT); const int nt = (cn + 255) >> 8;
        int inc = nt;
#pragma unroll
        for (int o = 1; o < 64; o <<= 1) { const int t = __shfl_up(inc, o); if (lane >= o) inc += t; }
        tab[lane] = cn; tab[80 + lane] = inc - nt;
        if (lane == 63) { tab[NE] = NTOK; tab[80 + NE] = inc; tab[80 + NEX] = inc + NTOK / 256; } }
    __syncthreads();
}
struct EpiGateUp {
    static constexpr bool PERM = true;
    bf16* hid; const CAS float* lw; const LAS int* tab;
    __device__ __forceinline__ void operator()(const f32x4 (&acc)[2][2][4][2], const pg8::Unit& u, int wr, int wc, int fr, int fq) const {
        const int e = u.ax >> 8, mt = u.ax & 255, pn = u.pn & 3; const int cnt = tab[e];
#pragma unroll
        for (int ai = 0; ai < 2; ++ai)
#pragma unroll
            for (int m = 0; m < 4; ++m) { const int rl = ai * 128 + wr * 64 + m * 16 + fr, idx = mt * 256 + rl;
                const float gw = (e == NE) ? 1.0f : (idx < cnt ? lw[e * NTOK + idx] : 0.0f);
                f32x4 h0, h1;
#pragma unroll
                for (int i = 0; i < 4; ++i) { h0[i] = silu_f(acc[ai][0][m][0][i]) * acc[ai][1][m][0][i] * gw; h1[i] = silu_f(acc[ai][0][m][1][i]) * acc[ai][1][m][1][i] * gw; }
                u32x4 w = {cvt_pk_bf16(h0[0], h0[1]), cvt_pk_bf16(h0[2], h0[3]), cvt_pk_bf16(h1[0], h1[1]), cvt_pk_bf16(h1[2], h1[3])};
                *(u32x4*)(hid + (size_t)(u.pm * 256 + rl) * DE + pn * 128 + wc * 32 + 8 * fq) = w; }
    }
};
struct EpiDown {
    static constexpr bool PERM = true;
    bf16* outs;
    __device__ __forceinline__ void operator()(const f32x4 (&acc)[2][2][4][2], const pg8::Unit& u, int wr, int wc, int fr, int fq) const {
        const int pn = u.pn & 7;
#pragma unroll
        for (int ai = 0; ai < 2; ++ai)
#pragma unroll
            for (int m = 0; m < 4; ++m) { bf16* rowp = outs + (size_t)(u.pm * 256 + ai * 128 + wr * 64 + m * 16 + fr) * DM + pn * 256 + wc * 32 + 8 * fq;
#pragma unroll
                for (int bj = 0; bj < 2; ++bj) { const f32x4 v0 = acc[ai][bj][m][0], v1 = acc[ai][bj][m][1];
                    u32x4 w = {cvt_pk_bf16(v0[0], v0[1]), cvt_pk_bf16(v0[2], v0[3]), cvt_pk_bf16(v1[0], v1[1]), cvt_pk_bf16(v1[2], v1[3])};
                    *(u32x4*)(rowp + bj * 128) = w; } }
    }
};
__device__ __forceinline__ void p10_final(Frame& F) {
    const CAS float* modf = (const CAS float*)(F.ws() + WS_MODF); const CAS bf16* outs = (const CAS bf16*)(F.ws() + WS_OUTS); const CAS int* inv = (const CAS int*)(F.ws() + WS_INV);
    const LAS int* tab = (const LAS int*)(F.lds() + LDS_MISC + 64);
    const int gw = F.bid() * 8 + F.wave(), NGW = F.G() * 8;
    for (int tok = gw; tok < NTOK; tok += NGW) { int lane = F.lane(); asm volatile("" : "+v"(lane)); const int b = tok / SEQ; const CAS float* g2 = modf + (size_t)b * (6 * DM) + 5 * DM;
        size_t rows[9];
#pragma unroll
        for (int k = 0; k < 8; ++k) { const int iv = inv[tok * 8 + k]; const int e = iv / NTOK, rk = iv % NTOK; rows[k] = (size_t)(tab[80 + e] * 256 + rk); }
        rows[8] = (size_t)(tab[80 + NE] * 256 + tok);
        f32x4 v[8]; float s = 0.f;
#pragma unroll
        for (int jj = 0; jj < 4; ++jj) { const int col = jj * 512 + lane * 8; f32x4 f0 = {0.f, 0.f, 0.f, 0.f}, f1 = {0.f, 0.f, 0.f, 0.f};
#pragma unroll
            for (int k = 0; k < 9; ++k) { const u32x4 w = *(const CAS u32x4*)(outs + rows[k] * DM + col);
                f0[0] += bflo(w[0]); f0[1] += bfhi(w[0]); f0[2] += bflo(w[1]); f0[3] += bfhi(w[1]); f1[0] += bflo(w[2]); f1[1] += bfhi(w[2]); f1[2] += bflo(w[3]); f1[3] += bfhi(w[3]); }
            const f32x4 xa = *(const f32x4*)(F.out() + (size_t)tok * DM + col), xb = *(const f32x4*)(F.out() + (size_t)tok * DM + col + 4);
            v[2 * jj] = xa * ALPHA_DN + *(const CAS f32x4*)(g2 + col) * f0; v[2 * jj + 1] = xb * ALPHA_DN + *(const CAS f32x4*)(g2 + col + 4) * f1;
            s += (v[2 * jj][0] + v[2 * jj][1]) + (v[2 * jj][2] + v[2 * jj][3]) + (v[2 * jj + 1][0] + v[2 * jj + 1][1]) + (v[2 * jj + 1][2] + v[2 * jj + 1][3]); }
        const float mu = wave_sum(s) * (1.0f / DM); float q = 0.f;
#pragma unroll
        for (int j = 0; j < 8; ++j) { v[j] = v[j] - mu; q += (v[j][0] * v[j][0] + v[j][1] * v[j][1]) + (v[j][2] * v[j][2] + v[j][3] * v[j][3]); }
        const float rstd = 1.0f / sqrtf(wave_sum(q) * (1.0f / DM) + LN_EPS);
#pragma unroll
        for (int j = 0; j < 8; ++j) { const int col = (j >> 1) * 512 + lane * 8 + (j & 1) * 4;
            *(f32x4*)(F.out() + (size_t)tok * DM + col) = v[j] * rstd * *(const CAS f32x4*)(F.f(25) + col) + *(const CAS f32x4*)(F.f(26) + col); } }
}
#ifndef MK_N_LAUNCHES
#define MK_N_LAUNCHES 1
#endif
constexpr int N_PHASES = 11;
__global__ void __launch_bounds__(512, 2) fwd_kernel(Args args) {
    Frame F; F.ap = &args;
    if (F.tid() < 16) ((LAS unsigned*)(F.lds() + LDS_MISC))[F.tid()] = 0u;
    __syncthreads();
    if (args.ph_hi - args.ph_lo > 1) (void)xcd_barrier_post((unsigned*)(F.ctl() + CW_BAR), (volatile LAS unsigned*)(F.lds() + LDS_MISC));
#ifndef PH_MASK
#define PH_MASK 0x7ff
#endif
#define IN(k) (((PH_MASK >> (k)) & 1) && args.ph_lo <= (k) && (k) < args.ph_hi)
#ifdef PROBE_PHASE
    unsigned long long pt0_ = __builtin_amdgcn_s_memrealtime(), pt1_ = 0ull;
#ifdef PROBE_SUB
#define PMARK(k) do { } while (0)
#else
#define PMARK(k) do { if ((k) + 1 == PROBE_PHASE) pt0_ = __builtin_amdgcn_s_memrealtime(); if ((k) == PROBE_PHASE) pt1_ = __builtin_amdgcn_s_memrealtime(); } while (0)
#endif
#else
#define PMARK(k) do { } while (0)
#endif
#define SEAM(k) do { if (IN(k) && IN((k) + 1)) { XcdBarrier bar_; bar_.bar = (unsigned*)(F.ctl() + CW_BAR); bar_.x = xb_xcc_id(); bar_.st = (volatile LAS unsigned*)(F.lds() + LDS_MISC); xcd_barrier(bar_); } } while (0)
    if (IN(0)) { p0_prologue(F); } SEAM(0); PMARK(0);
    if (IN(1)) { p1_modulate(F); } SEAM(1); PMARK(1);
    if (IN(2)) {
        pg8::Gemm g{WSP(const bf16, WS_U1), WSP(const bf16, WS_WIN), DM, 20}; pg8::StaticOrder S; S.init(NTOK, NPROJ_PAD, F.G(), F.bid());
        EpiInProj E{F.ws(), F.f(8), F.f(12), F.f(13)};
        pg8::gemm_phase<EpiInProj, pg8::StaticOrder, false>(F.lds(), g, S, E);
        slack_fill(F, (F.bid() + 3 * F.G() < 32 * NPROJ_TILES) ? 0 : 8, false, Q_ALL);
    } SEAM(2); PMARK(2);
    if (IN(3)) {
        PSUB(3, 0); p3_ssd(F); PSUB(3, 1); PSUB(30, 0); p3_idx(F); PSUB(30, 1);
    } SEAM(3); PMARK(3);
    if (IN(4)) { PSUB(40, 0); p4_select(F); PSUB(40, 1); PSUB(41, 0); p4_scan(F); PSUB(41, 1); } SEAM(4); PMARK(4);
    if (IN(5)) { p5_phase(F); slack_fill(F, (F.G() == 256) ? ((F.bid() >> 4) * 5) / 4 : 0, false, Q_ALL); } SEAM(5); PMARK(5);
    if (IN(6)) {
        pg8::Gemm g{WSP(const bf16, WS_YCAT), WSP(const bf16, WS_WOUT), DM, 60}; pg8::StaticOrder S; S.init(NTOK, DM, F.G(), F.bid());
        EpiOutProj E{F.f(0), (const CAS float*)(F.ws() + WS_MODF), F.out()};
        pg8::gemm_phase<EpiOutProj, pg8::StaticOrder, false>(F.lds(), g, S, E);
    } SEAM(6); PMARK(6);
    if (IN(7)) { p7_phase(F); slack_fill(F, 0, true, Q_GU); } SEAM(7); PMARK(7);
    if (IN(8)) {
        const int vcu = (F.G() % 8 == 0) ? (F.bid() % 8) * (F.G() / 8) + F.bid() / 8 : F.bid();
        moe_tables(F);
        const LAS int* tab = (const LAS int*)(F.lds() + LDS_MISC + 64);
        pg8::Gemm g{WSP(const bf16, WS_U2), WSP(const bf16, WS_WGU), DM, 80}; MoeOrder S{tab, WSP(const int, WS_LTOK), F.G(), vcu, 4};
        EpiGateUp E{WSP(bf16, WS_HID), (const CAS float*)(F.ws() + WS_LW), tab};
        pg8::gemm_phase<EpiGateUp, MoeOrder, true>(F.lds(), g, S, E);
        slack_fill(F, 0, true, Q_ALL);
    } SEAM(8); PMARK(8);
    if (IN(9)) {
        const int vcu = (F.G() % 8 == 0) ? (F.bid() % 8) * (F.G() / 8) + F.bid() / 8 : F.bid();
        moe_tables(F);
        const LAS int* tab = (const LAS int*)(F.lds() + LDS_MISC + 64);
        pg8::Gemm g{WSP(const bf16, WS_HID), WSP(const bf16, WS_WDN), DE, 90}; MoeOrder S{tab, WSP(const int, WS_LTOK), F.G(), vcu, 8};
        EpiDown E{WSP(bf16, WS_OUTS)};
        pg8::gemm_phase<EpiDown, MoeOrder, false>(F.lds(), g, S, E);
    } SEAM(9); PMARK(9);
    if (IN(10)) { moe_tables(F); p10_final(F); }
#ifdef PROBE_PHASE
    if (pt1_ == 0ull) pt1_ = __builtin_amdgcn_s_memrealtime();
#ifdef PROBE_SUB
    __syncthreads(); pt0_ = *(volatile LAS unsigned long long*)(F.lds() + LDS_MISC + 32); pt1_ = *(volatile LAS unsigned long long*)(F.lds() + LDS_MISC + 40);
#endif
    if (F.bid() == 0) { const unsigned long long w = 8ull * (pt1_ - pt0_), te = __builtin_amdgcn_s_memrealtime(); while (__builtin_amdgcn_s_memrealtime() - te < w) __builtin_amdgcn_s_sleep(32); }
#endif
#ifdef DBG_OFF
    if (args.ph_hi == N_PHASES) {
        const size_t n = (size_t)NTOK * DM; float* o = F.out();
        for (size_t i = (size_t)F.bid() * 512 + F.tid(); i < n; i += (size_t)F.G() * 512) {
            float v;
            if (DBG_KIND == 0) v = bf2f(((const bf16*)(F.ws() + (size_t)(DBG_OFF)))[i % (size_t)(DBG_N)]);
            else v = ((const float*)(F.ws() + (size_t)(DBG_OFF)))[i % (size_t)(DBG_N)];
            if (!(fabsf(v) < 1e30f)) v = 1e30f;
            o[i] = v; }
    }
#endif
#undef IN
#undef SEAM
#undef PMARK
}

extern "C" void kernel_launch(void* const* d_in, const int* in_sizes, int n_in, void* d_out, int out_size, void* d_ws, size_t ws_size, hipStream_t stream) {
    static int grid = 0;
    if (grid == 0) {
        if (n_in != 27 || out_size != NTOK * DM || ws_size < WS_END) { fprintf(stderr, "kernel_launch: unexpected shapes (n_in %d, out %d, ws %zu; need ws >= %zu)\n", n_in, out_size, ws_size, (size_t)WS_END); }
        int dev = 0, cus = 0, per_cu = 0;
        if (hipGetDevice(&dev) != hipSuccess || hipDeviceGetAttribute(&cus, hipDeviceAttributeMultiprocessorCount, dev) != hipSuccess) { grid = -1; return; }
        if (hipFuncSetAttribute((const void*)fwd_kernel, hipFuncAttributeMaxDynamicSharedMemorySize, LDS_BYTES) != hipSuccess) { fprintf(stderr, "kernel_launch: hipFuncSetAttribute failed\n"); grid = -1; return; }
        if (hipOccupancyMaxActiveBlocksPerMultiprocessor(&per_cu, (const void*)fwd_kernel, 512, LDS_BYTES) != hipSuccess || per_cu < 1) fprintf(stderr, "kernel_launch: occupancy query reports %d\n", per_cu);
        (void)hipGetLastError();
        grid = cus;
    }
    if (grid < 0) return;
    (void)hipMemsetAsync((char*)d_ws + WS_CTL, 0, CTL_ZERO_BYTES, stream);
    Args a{};
    for (int i = 0; i < 27; ++i) a.in[i] = d_in[i];
    a.out = (float*)d_out; a.ws = (unsigned char*)d_ws;
#if MK_N_LAUNCHES == 1
    a.ph_lo = 0; a.ph_hi = N_PHASES;
    hipLaunchKernelGGL(fwd_kernel, dim3(grid), dim3(512), LDS_BYTES, stream, a);
#else
    for (int p = 0; p < N_PHASES; ++p) { a.ph_lo = p; a.ph_hi = p + 1; hipLaunchKernelGGL(fwd_kernel, dim3(grid), dim3(512), LDS_BYTES, stream, a);
#ifdef DUP_PHASE
        if (p == DUP_PHASE) hipLaunchKernelGGL(fwd_kernel, dim3(grid), dim3(512), LDS_BYTES, stream, a);
#endif
    }
#endif
}
```

```cpp
#define MK_N_LAUNCHES 1
#define PH_MASK 0x7ff
#include <hip/hip_runtime.h>
#include <cstdio>
#include <cstdint>

#define GAS __attribute__((address_space(1)))
#define LAS __attribute__((address_space(3)))
#define CAS __attribute__((address_space(4)))
typedef unsigned short bf16;
typedef short bf16x8 __attribute__((ext_vector_type(8)));
typedef short s16x4 __attribute__((ext_vector_type(4)));
typedef float f32x2 __attribute__((ext_vector_type(2)));
typedef float f32x4 __attribute__((ext_vector_type(4)));
typedef float f32x16 __attribute__((ext_vector_type(16)));
typedef unsigned u32x2 __attribute__((ext_vector_type(2)));
typedef unsigned u32x4 __attribute__((ext_vector_type(4)));
typedef GAS unsigned gu32;
#define RLX_AGENT __ATOMIC_RELAXED, __HIP_MEMORY_SCOPE_AGENT
#define LDS_WAIT() asm volatile("s_waitcnt lgkmcnt(0)" ::: "memory")
#define VM_WAIT() asm volatile("s_waitcnt vmcnt(0)" ::: "memory")

constexpr int DM = 2048, NBATCH = 2, SEQ = 4096, NTOK = NBATCH * SEQ;
constexpr int D_SSM = 1024, SSM_H = 16, SSM_P = 64, SSM_N = 128, CONV_CH = 1536, CHUNK = 128, NCHUNK = SEQ / CHUNK;
constexpr int ATT_H = 8, ATT_D = 128, IDX_H = 16, IDX_D = 64, TOPK_SEL = 256;
constexpr int NE = 64, DE = 512, NEX = NE + 1;
constexpr int NPROJ = 6752, NPROJ_PAD = 6912, NPROJ_TILES = 27;
constexpr float ALPHA_DN = 1.189207115002721f;
constexpr float LN_EPS = 1e-5f;
constexpr int SEG_Z = 0, SEG_XBC = 1024, SEG_DT = 2560, SEG_Q = 2576, SEG_K = 3600, SEG_V = 4624, SEG_QI = 5648, SEG_KI = 6672, SEG_WI = 6736;

constexpr size_t MiB = 1u << 20;
constexpr size_t WS_CTL = 0, CTL_ZERO_BYTES = 1 * MiB;
constexpr size_t WS_MODP = 1 * MiB;
constexpr size_t WS_MODF = 3 * MiB;
constexpr size_t WS_COSA = 4 * MiB, WS_SINA = 6 * MiB;
constexpr size_t WS_COSI = 8 * MiB, WS_SINI = 9 * MiB;
constexpr size_t WS_WR = 10 * MiB;
constexpr size_t WS_KIDX = 11 * MiB;
constexpr size_t WS_WIDX = 12 * MiB;
constexpr size_t WS_DT = 12 * MiB + 512 * 1024;
constexpr size_t WS_CS = 13 * MiB;
constexpr size_t WS_INV = 14 * MiB;
constexpr size_t WS_LTOK = 15 * MiB;
constexpr size_t WS_LW = 17 * MiB;
constexpr size_t WS_MASK = 19 * MiB;
constexpr size_t WS_U2 = 25 * MiB;
constexpr size_t WS_WGU = 57 * MiB;
constexpr size_t WS_WDN = 317 * MiB;
constexpr size_t WS_T = 447 * MiB;
constexpr size_t WS_HID = WS_T;
constexpr size_t WS_OUTS = WS_T + 88 * MiB;
constexpr size_t WS_WIN = WS_T;
constexpr size_t WS_WOUT = WS_T + 27 * MiB;
constexpr size_t WS_U1 = WS_T + 35 * MiB;
constexpr size_t WS_Z = WS_T + 67 * MiB;
constexpr size_t WS_XBC = WS_T + 83 * MiB;
constexpr size_t WS_Q = WS_T + 107 * MiB, WS_K = WS_T + 123 * MiB, WS_V = WS_T + 139 * MiB;
constexpr size_t WS_QIDX = WS_T + 155 * MiB;
constexpr size_t WS_SCORES = WS_T + 171 * MiB;
constexpr size_t WS_STATES = WS_T + 299 * MiB;
constexpr size_t WS_HIN = WS_T + 331 * MiB;
constexpr size_t WS_YDIAG = WS_T + 347 * MiB;
constexpr size_t WS_YCAT = WS_T + 379 * MiB;
constexpr size_t WS_XBCACT = WS_T + 411 * MiB;
constexpr size_t WS_END = WS_T + 440 * MiB;
static_assert(WS_XBCACT + 24 * MiB <= WS_END && WS_OUTS + 352 * MiB <= WS_END, "ws map");
constexpr int MAXPOS = 90112;
constexpr int CW_TMO = 0, CW_BAR = 4096, CW_ECNT = 8192;
constexpr int CW_QHEAD = 16384, CW_DONE = 16448;

constexpr int LDS_MISC = 155648;
constexpr int LDS_BYTES = 157696;

typedef __bf16 bf16x2_t __attribute__((ext_vector_type(2)));
__device__ __forceinline__ unsigned cvt_pk_bf16(float lo, float hi) { const bf16x2_t v = {(__bf16)lo, (__bf16)hi}; return __builtin_bit_cast(unsigned, v); }
__device__ __forceinline__ float bflo(unsigned w) { return __uint_as_float(w << 16); }
__device__ __forceinline__ float bfhi(unsigned w) { return __uint_as_float(w & 0xffff0000u); }
__device__ __forceinline__ float bf2f(bf16 b) { return __uint_as_float((unsigned)b << 16); }
__device__ __forceinline__ bf16 f2bf(float f) { return __builtin_bit_cast(unsigned short, (__bf16)f); }
__device__ __forceinline__ float silu_f(float x) { return x / (1.f + __expf(-x)); }
__device__ __forceinline__ float sigmoid_f(float x) { return 1.f / (1.f + __expf(-x)); }
__device__ __forceinline__ float wave_sum(float v) {
#pragma unroll
    for (int o = 1; o < 64; o <<= 1) v += __shfl_xor(v, o);
    return v;
}
__device__ __forceinline__ bf16x8 pack8(f32x4 a, f32x4 b) {
    u32x4 w = {cvt_pk_bf16(a[0], a[1]), cvt_pk_bf16(a[2], a[3]), cvt_pk_bf16(b[0], b[1]), cvt_pk_bf16(b[2], b[3])};
    return __builtin_bit_cast(bf16x8, w);
}
__device__ __forceinline__ void unpack8(bf16x8 v, float (&o)[8]) {
    u32x4 w = __builtin_bit_cast(u32x4, v);
#pragma unroll
    for (int i = 0; i < 4; ++i) { o[2 * i] = bflo(w[i]); o[2 * i + 1] = bfhi(w[i]); }
}
__device__ __forceinline__ int crow(int r, int hi) { return (r & 3) + 8 * (r >> 2) + 4 * hi; }

__device__ __forceinline__ LAS unsigned char* lds_base() { extern __shared__ __attribute__((aligned(16))) unsigned char lds_raw[]; return (LAS unsigned char*)lds_raw; }
#ifdef PROBE_SUB
#define PSUB(n, w) do { if ((n) == PROBE_SUB && blockIdx.x == 0 && threadIdx.x == 0) *(volatile LAS unsigned long long*)(lds_base() + LDS_MISC + 32 + 8 * (w)) = __builtin_amdgcn_s_memrealtime(); } while (0)
#else
#define PSUB(n, w) do { } while (0)
#endif
#define XB_TMO      128
#define XB_XCNT(j)  (256  + 64 * (j))
#define XB_XSUB(j)  (1280 + 64 * (j))
#define XB_XGEN(j)  (2304 + 64 * (j))
#define XB_TOP      3328
#define XB_TOPGEN   3392
#define XCD_BAR_WORDS 3456
#define XB_SPIN_CAP (1u << 18)

__device__ __forceinline__ unsigned xb_ld(unsigned* p)              { return __hip_atomic_load(p, __ATOMIC_RELAXED, __HIP_MEMORY_SCOPE_AGENT); }
__device__ __forceinline__ unsigned xb_add(unsigned* p, unsigned v) { return __hip_atomic_fetch_add(p, v, __ATOMIC_RELAXED, __HIP_MEMORY_SCOPE_AGENT); }
__device__ __forceinline__ unsigned xb_xcc_id() { return (unsigned)__builtin_amdgcn_s_getreg((3 << 11) | 20) & 0xFu; }
#define XB_SPIN(cond, bar) do { unsigned _sp = 0; while (cond) { __builtin_amdgcn_s_sleep(1); \
    if ((++_sp & 255u) == 0u) { if (xb_ld(&(bar)[XB_TMO])) break; if (_sp > XB_SPIN_CAP) { atomicAdd(&(bar)[XB_TMO], 1u); break; } } } } while (0)

struct XcdBarrier {
    unsigned* bar; unsigned x;
    volatile LAS unsigned* st;
};

__device__ __forceinline__ XcdBarrier xcd_barrier_post(unsigned* bar, volatile LAS unsigned* st) {
    XcdBarrier b; b.bar = bar; b.x = xb_xcc_id(); b.st = st;
    if (threadIdx.x == 0) (void)xb_add(&bar[XB_XCNT(b.x)], 1u);
    return b;
}
__device__ __forceinline__ void xcd_barrier_complete(unsigned* bar, unsigned x, unsigned& nloc, unsigned& nx) {
    const unsigned G = gridDim.x * gridDim.y * gridDim.z;
    unsigned sum, cnt, mine, sp = 0u;
    for (;;) {
        sum = 0u; cnt = 0u; mine = 0u;
#pragma unroll
        for (unsigned j = 0; j < 16; ++j) { const unsigned c = xb_ld(&bar[XB_XCNT(j)]); sum += c; cnt += (c > 0u) ? 1u : 0u; mine = (j == x) ? c : mine; }
        if (sum == G) break;
        __builtin_amdgcn_s_sleep(1);
        if ((++sp & 255u) == 0u) { if (xb_ld(&bar[XB_TMO])) break; if (sp > XB_SPIN_CAP) { atomicAdd(&bar[XB_TMO], 1u); break; } }
    }
    nloc = mine > 0u ? mine : 1u; nx = cnt > 0u ? cnt : 1u;
}

__device__ __forceinline__ void xcd_barrier(const XcdBarrier& b) {
    asm volatile("s_waitcnt vmcnt(0)" ::: "memory");
    __syncthreads();
    if (threadIdx.x == 0) {
        unsigned* bar = b.bar;
        __builtin_amdgcn_s_waitcnt(0);
        unsigned nloc = b.st[0], nx = b.st[1];
        if (nloc == 0u) { xcd_barrier_complete(bar, b.x, nloc, nx); b.st[0] = nloc; b.st[1] = nx; }
        const unsigned old = xb_add(&bar[XB_XSUB(b.x)], 1u);
        const unsigned gen = old / nloc;
        if (old + 1u == (gen + 1u) * nloc) {
            __builtin_amdgcn_fence(__ATOMIC_RELEASE, "agent");
            asm volatile("s_waitcnt vmcnt(0)" ::: "memory");
            const unsigned og = xb_add(&bar[XB_TOP], 1u);
            const unsigned tg = og / nx;
            if (og + 1u == (tg + 1u) * nx) xb_add(&bar[XB_TOPGEN], 1u);
            else XB_SPIN(xb_ld(&bar[XB_TOPGEN]) == tg, bar);
            __builtin_amdgcn_fence(__ATOMIC_ACQUIRE, "agent");
            xb_add(&bar[XB_XGEN(b.x)], 1u);
            asm volatile("s_waitcnt vmcnt(0)" ::: "memory");
        } else {
            XB_SPIN(xb_ld(&bar[XB_XGEN(b.x)]) == gen, bar);
            __builtin_amdgcn_fence(__ATOMIC_ACQUIRE, "agent");
            asm volatile("s_waitcnt vmcnt(0)" ::: "memory");
        }
    }
    __syncthreads();
}

namespace pg8 {
constexpr int BM = 256, BK = 64, HALF = 128, HTB = HALF * BK * 2  , STAGE_BYTES = 8 * HTB, NXCD = 8, WGM = 8;
__host__ __device__ __forceinline__ int lds_byte(int r, int c) { const int st = (r >> 4) * 2 + (c >> 5), rr = r & 15, cc = c & 31, ob = rr * 64 + cc * 2; return st * 1024 + (ob ^ (((ob >> 9) & 1) << 5)); }
__host__ __device__ __forceinline__ void stage_rc(int b, int& R, int& C) { const int st = b / 1024, sb = b % 1024, swz = sb ^ (((sb >> 9) & 1) << 5); R = (st >> 1) * 16 + swz / 64; C = (st & 1) * 32 + (swz % 64) / 2; }
__host__ __device__ __forceinline__ int perm32(int rho) { const int n = rho >> 4, i = rho & 15; return 8 * (i >> 2) + 4 * n + (i & 3); }

struct Unit { int pm, pn, ax; };
struct Gemm { const bf16* A; const bf16* Bt; int K; int pid; };

struct StaticOrder {
    int nM, nN, nwg, G, c;
    __device__ void init(int M, int N, int G_, int c_) { nM = M / BM; nN = N / BM; nwg = nM * nN; G = G_; c = c_; }
    __device__ __forceinline__ bool next(int i, Unit& u) const {
        const long L = (long)i * G + c; if (L >= nwg) return false;
        int wgid = (int)L; { const int q = nwg / NXCD, r = nwg % NXCD, xcd = wgid % NXCD, off = wgid / NXCD; wgid = (xcd < r ? xcd * (q + 1) : r * (q + 1) + (xcd - r) * q) + off; }
        const int nig = WGM * nN, gid = wgid / nig, fm = gid * WGM, gsz = (nM - fm) < WGM ? (nM - fm) : WGM;
        u.pm = fm + ((wgid % nig) % gsz); u.pn = (wgid % nig) / gsz; u.ax = 0; return true;
    }
    __device__ __forceinline__ int row_tok(const Unit&, int) const { return 0; }
};

template <class Epi, class Sched, bool GATHER>
__device__ __forceinline__ void gemm_phase(LAS unsigned char* lds, const Gemm g, const Sched& S, const Epi& E) {
    const int tid = threadIdx.x, wid = __builtin_amdgcn_readfirstlane(tid >> 6), lane = tid & 63, wr = wid >> 2, wc = wid & 3, fr = lane & 15, fq = lane >> 4;
    const int K = g.K, nt = K / BK;
    unsigned voffB[2]; int RA[2]; unsigned CA2[2];
#pragma unroll
    for (int i = 0; i < 2; ++i) { int R, C; stage_rc(tid * 16 + i * 8192, R, C); const int Rb = Epi::PERM ? ((R & ~31) + perm32(R & 31)) : R;
        voffB[i] = (unsigned)(Rb * K + C) * 2u; RA[i] = R; CA2[i] = (unsigned)C * 2u; }
    const size_t kstep = (size_t)(BK * 2);
    const size_t hstep = (size_t)HALF * K * 2;
    const size_t tstep = 2 * hstep;
    const unsigned ldsw = (unsigned)wid * 1024u;
    const int aoff = lds_byte(wr * 64 + fr, fq * 8), boff = lds_byte(wc * 32 + fr, fq * 8);
#define PG8_SA(b, h) (((b) * 2 + (h)) * HTB)
#define PG8_SB(b, h) ((4 + (b) * 2 + (h)) * HTB)
#define PG8_STAGE(bufoff, gbase, voff) do { _Pragma("unroll") for (int _i = 0; _i < 2; ++_i) \
        __builtin_amdgcn_global_load_lds((const unsigned*)((const char*)(gbase) + (voff)[_i]), (LAS unsigned*)(lds + (bufoff) + ldsw + _i * 8192), 16, 0, 0); } while (0)
#define PG8_LDA(dst, b, h) do { _Pragma("unroll") for (int m = 0; m < 4; ++m) _Pragma("unroll") for (int k = 0; k < 2; ++k) dst[m][k] = *(const LAS bf16x8*)(lds + PG8_SA(b, h) + aoff + m * 2048 + k * 1024); } while (0)
#define PG8_LDB(dst, b, h) do { _Pragma("unroll") for (int n = 0; n < 2; ++n) _Pragma("unroll") for (int k = 0; k < 2; ++k) dst[n][k] = *(const LAS bf16x8*)(lds + PG8_SB(b, h) + boff + n * 2048 + k * 1024); } while (0)
#define PG8_MMA(ai, bj, At, Bt) do { __builtin_amdgcn_s_setprio(1); _Pragma("unroll") for (int m = 0; m < 4; ++m) _Pragma("unroll") for (int n = 0; n < 2; ++n) _Pragma("unroll") for (int k = 0; k < 2; ++k) \
        acc[ai][bj][m][n] = __builtin_amdgcn_mfma_f32_16x16x32_bf16(Bt[n][k], At[m][k], acc[ai][bj][m][n], 0, 0, 0); __builtin_amdgcn_s_setprio(0); } while (0)
#define PG8_WAIT_V(n) asm volatile("s_waitcnt vmcnt(" #n ")" ::: "memory")
#define PG8_WAIT_L(n) asm volatile("s_waitcnt lgkmcnt(" #n ")" ::: "memory")
#define PG8_BAR __builtin_amdgcn_s_barrier()
#define PG8_SCHED __builtin_amdgcn_sched_barrier(0)
#define PG8_SET_OA(o, u) do { _Pragma("unroll") for (int _h = 0; _h < 2; ++_h) _Pragma("unroll") for (int _i = 0; _i < 2; ++_i) { \
        if constexpr (GATHER) o[_h][_i] = (unsigned)S.row_tok(u, _h * HALF + RA[_i]) * (unsigned)(K * 2) + CA2[_i]; \
        else o[_h][_i] = (unsigned)(_h * (int)hstep) + (unsigned)(RA[_i] * K * 2) + CA2[_i]; } } while (0)
    Unit cur, nxt; int ui = 0;
    if (!S.next(0, cur)) return;
    f32x4 acc[2][2][4][2];
#pragma unroll
    for (int a = 0; a < 2; ++a)
#pragma unroll
        for (int b = 0; b < 2; ++b)
#pragma unroll
            for (int m = 0; m < 4; ++m)
#pragma unroll
                for (int n = 0; n < 2; ++n) acc[a][b][m][n] = (f32x4){0.f, 0.f, 0.f, 0.f};
    bf16x8 At[4][2], B0[2][2], B1[2][2];
    unsigned oAc[2][2], oAn[2][2];
    PG8_SET_OA(oAc, cur);
    const char* cA = GATHER ? (const char*)g.A : (const char*)g.A + (size_t)cur.pm * tstep; const char* cB = (const char*)g.Bt + (size_t)cur.pn * tstep;
    PG8_STAGE(PG8_SB(0, 0), cB, voffB); PG8_STAGE(PG8_SB(0, 1), cB + hstep, voffB); PG8_STAGE(PG8_SA(0, 0), cA, oAc[0]); PG8_STAGE(PG8_SA(0, 1), cA, oAc[1]);
    if (wr == 1) PG8_BAR;
    PG8_WAIT_V(2); PG8_BAR;
    PG8_STAGE(PG8_SB(1, 0), cB + kstep, voffB); PG8_STAGE(PG8_SA(1, 0), cA + kstep, oAc[0]); PG8_STAGE(PG8_SB(1, 1), cB + hstep + kstep, voffB);
    PG8_WAIT_V(6); PG8_BAR;
    for (;;) {
        const bool has_next = S.next(ui + 1, nxt);
        const char* nA = has_next ? (GATHER ? (const char*)g.A : (const char*)g.A + (size_t)nxt.pm * tstep) : cA; const char* nB = has_next ? (const char*)g.Bt + (size_t)nxt.pn * tstep : cB;
        if (has_next) { PG8_SET_OA(oAn, nxt); }
        else {
#pragma unroll
            for (int _h = 0; _h < 2; ++_h)
#pragma unroll
                for (int _i = 0; _i < 2; ++_i) oAn[_h][_i] = oAc[_h][_i]; }
        PSUB(g.pid * 10, 0); PSUB(g.pid * 10 + 2, 0);
        for (int t = 0; t < nt; t += 2) {
            const bool last = (t == nt - 2);
            if (t == 0) { PSUB(g.pid * 10 + 3, 0); } if (t == 2) { PSUB(g.pid * 10 + 3, 1); PSUB(g.pid * 10 + 4, 0); } if (t == 4) { PSUB(g.pid * 10 + 4, 1); }
            const char* a1 = cA + (size_t)(t + 1) * kstep;
            const char* a2 = last ? nA : cA + (size_t)(t + 2) * kstep; const char* b2 = last ? nB : cB + (size_t)(t + 2) * kstep;
            const char* a3 = a2 + kstep; const char* b3 = b2 + kstep;
            unsigned o2[2][2];
#pragma unroll
            for (int _h = 0; _h < 2; ++_h)
#pragma unroll
                for (int _i = 0; _i < 2; ++_i) o2[_h][_i] = GATHER ? (last ? oAn[_h][_i] : oAc[_h][_i]) : oAc[_h][_i];
            PG8_LDB(B0, 0, 0); PG8_LDB(B1, 0, 1); PG8_SCHED; PG8_LDA(At, 0, 0); PG8_STAGE(PG8_SA(1, 1), a1, oAc[1]);
            PG8_WAIT_V(8); PG8_WAIT_L(0); PG8_BAR; PG8_MMA(0, 0, At, B0); PG8_MMA(0, 1, At, B1); PG8_BAR; PG8_SCHED;
            PG8_LDA(At, 0, 1); PG8_STAGE(PG8_SB(0, 0), b2, voffB); PG8_STAGE(PG8_SB(0, 1), b2 + hstep, voffB); PG8_STAGE(PG8_SA(0, 0), a2, o2[0]);
            PG8_WAIT_V(8); PG8_WAIT_L(0); PG8_BAR; PG8_MMA(1, 0, At, B0); PG8_MMA(1, 1, At, B1); PG8_BAR; PG8_SCHED;
            PG8_LDB(B0, 1, 0); PG8_LDB(B1, 1, 1); PG8_SCHED; PG8_LDA(At, 1, 0); PG8_STAGE(PG8_SA(0, 1), a2, o2[1]);
            PG8_WAIT_V(8); PG8_WAIT_L(0); PG8_BAR; PG8_MMA(0, 0, At, B0); PG8_MMA(0, 1, At, B1); PG8_BAR; PG8_SCHED;
            PG8_LDA(At, 1, 1); PG8_STAGE(PG8_SB(1, 0), b3, voffB); PG8_STAGE(PG8_SB(1, 1), b3 + hstep, voffB); PG8_STAGE(PG8_SA(1, 0), a3, o2[0]);
            PG8_WAIT_V(8); PG8_WAIT_L(0); PG8_BAR; PG8_MMA(1, 0, At, B0); PG8_MMA(1, 1, At, B1); PG8_BAR; PG8_SCHED;
        }
        PSUB(g.pid * 10, 1); PSUB(g.pid * 10 + 1, 0);
        if (wr == 0) PG8_BAR;
        { int fr_ = fr, fq_ = fq, wr_ = wr, wc_ = wc; asm volatile("" : "+v"(fr_), "+v"(fq_), "+s"(wr_), "+s"(wc_));
          E(acc, cur, wr_, wc_, fr_, fq_); }
        PSUB(g.pid * 10 + 1, 1); PSUB(g.pid * 10 + 2, 1);
        if (!has_next) break;
#pragma unroll
        for (int a = 0; a < 2; ++a)
#pragma unroll
            for (int b = 0; b < 2; ++b)
#pragma unroll
                for (int m = 0; m < 4; ++m)
#pragma unroll
                    for (int n = 0; n < 2; ++n) acc[a][b][m][n] = (f32x4){0.f, 0.f, 0.f, 0.f};
        cur = nxt; cA = nA; cB = nB; ++ui;
#pragma unroll
        for (int _h = 0; _h < 2; ++_h)
#pragma unroll
            for (int _i = 0; _i < 2; ++_i) oAc[_h][_i] = oAn[_h][_i];
        if (wr == 1) PG8_BAR;
    }
    PG8_WAIT_V(0);
    PG8_BAR;
#undef PG8_SA
#undef PG8_SB
#undef PG8_STAGE
#undef PG8_LDA
#undef PG8_LDB
#undef PG8_MMA
#undef PG8_WAIT_V
#undef PG8_WAIT_L
#undef PG8_BAR
#undef PG8_SCHED
#undef PG8_SET_OA
}
}
struct Args { const void* in[27]; float* out; unsigned char* ws; int ph_lo, ph_hi; };
struct Frame {
    const Args* ap;
    __device__ __forceinline__ LAS unsigned char* lds() const { extern __shared__ __attribute__((aligned(16))) unsigned char lds_raw[]; return (LAS unsigned char*)lds_raw; }
    __device__ __forceinline__ unsigned char* ws() const { return ap->ws; }
    __device__ __forceinline__ gu32* ctl() const { return (gu32*)(ap->ws + WS_CTL); }
    __device__ __forceinline__ float* out() const { return ap->out; }
    __device__ __forceinline__ int tid() const { return (int)threadIdx.x; }
    __device__ __forceinline__ int lane() const { return (int)threadIdx.x & 63; }
    __device__ __forceinline__ int wave() const { return __builtin_amdgcn_readfirstlane((int)threadIdx.x >> 6); }
    __device__ __forceinline__ int G() const { return (int)gridDim.x; }
    __device__ __forceinline__ int bid() const { return (int)blockIdx.x; }
    __device__ __forceinline__ const CAS float* f(int i) const { return (const CAS float*)ap->in[i]; }
    __device__ __forceinline__ const CAS int* i32(int i) const { return (const CAS int*)ap->in[i]; }
};
#define WSP(T, off) ((T*)(F.ws() + (off)))

__device__ __forceinline__ int inproj_src_col(int P) {
    const int tile = P >> 8, within = P & 255, bj = within >> 7, w = within & 127;
    if (tile < 4) return SEG_Z + tile * 256 + within;
    if (tile < 10) return SEG_XBC + (tile - 4) * 256 + within;
    if (tile < 14) return SEG_Q + (2 * (tile - 10) + (w >> 6)) * 128 + (w & 63) + 64 * bj;
    if (tile < 18) return SEG_K + (2 * (tile - 14) + (w >> 6)) * 128 + (w & 63) + 64 * bj;
    if (tile < 22) return SEG_V + (tile - 18) * 256 + within;
    if (tile < 26) return SEG_QI + (4 * (tile - 22) + (w >> 5)) * 64 + (w & 31) + 32 * bj;
    if (bj == 0) { if (w < 32) return SEG_KI + w; if (w < 48) return SEG_WI + (w - 32); if (w < 64) return SEG_DT + (w - 48); return -1; }
    if (w < 32) return SEG_KI + 32 + w;
    return -1;
}
struct TrD { const CAS float* q; bf16* dst; int ld, K; bool valid, live; };
__device__ __forceinline__ void tr_load(const TrD& t, f32x4 (&v)[16]) {
#pragma unroll
    for (int i = 0; i < 16; ++i) v[i] = (t.valid && t.live) ? *(const CAS f32x4*)(t.q + (size_t)(4 * i) * t.ld) : (f32x4){0.f, 0.f, 0.f, 0.f};
}
__device__ __forceinline__ void tr_fin(const TrD& t, const f32x4 (&v)[16], LAS float* scr, int lane) {
#pragma unroll
    for (int i = 0; i < 16; ++i) { LAS float* s = scr + ((lane >> 4) + 4 * i) * 65 + 4 * (lane & 15); s[0] = v[i][0]; s[1] = v[i][1]; s[2] = v[i][2]; s[3] = v[i][3]; }
    LDS_WAIT(); asm volatile("" ::: "memory");
    const int c = lane & 7;
    if (t.live) {
#pragma unroll
        for (int jj = 0; jj < 8; ++jj) { const int n = (lane >> 3) + 8 * jj; const LAS float* s = scr + (8 * c) * 65 + n;
            u32x4 o; o.x = cvt_pk_bf16(s[0], s[65]); o.y = cvt_pk_bf16(s[2 * 65], s[3 * 65]); o.z = cvt_pk_bf16(s[4 * 65], s[5 * 65]); o.w = cvt_pk_bf16(s[6 * 65], s[7 * 65]);
            *(u32x4*)(t.dst + (size_t)n * t.K + 8 * c) = o; } }
    LDS_WAIT(); asm volatile("" ::: "memory");
}
constexpr int I_IN = 32 * 108, I_OUT = 32 * 32, I_GU = NEX * 32 * 16, I_DN = NEX * 8 * 32, I_TR = I_IN + I_OUT + I_GU + I_DN;
__device__ __forceinline__ TrD tr_desc(Frame& F, int it, bool live) {
    const int lane = F.lane(), kr = lane >> 4, nq = 4 * (lane & 15); TrD t; t.live = live; t.valid = true;
    if (!live) it = 0;
    if (it < I_IN) { const int kb = it / 108, nb = it % 108, k0 = 64 * kb, n0 = 64 * nb; const int sc = inproj_src_col(n0 + nq);
        t.q = F.f(5) + (size_t)(k0 + kr) * NPROJ + (sc < 0 ? 0 : sc); t.valid = sc >= 0; t.ld = NPROJ; t.dst = WSP(bf16, WS_WIN) + (size_t)n0 * DM + k0; t.K = DM; return t; }
    it -= I_IN;
    if (it < I_OUT) { const int kb = it >> 5, nb = it & 31, k0 = 64 * kb, n0 = 64 * nb;
        t.q = F.f(14) + (size_t)(k0 + kr) * DM + n0 + nq; t.ld = DM; t.dst = WSP(bf16, WS_WOUT) + (size_t)n0 * DM + k0; t.K = DM; return t; }
    it -= I_OUT;
    if (it < I_GU) { const int e = it >> 9, r = it & 511, kb = r >> 4, nb = r & 15, k0 = 64 * kb;
        const int p = nb >> 2, bj = (nb >> 1) & 1, w0 = (nb & 1) * 64;
        const CAS float* src = (e < NE) ? ((bj ? F.f(20) : F.f(19)) + (size_t)e * DM * DE) : (bj ? F.f(23) : F.f(22));
        t.q = src + (size_t)(k0 + kr) * DE + 128 * p + w0 + nq; t.ld = DE; t.dst = WSP(bf16, WS_WGU) + ((size_t)e * 1024 + 64 * nb) * DM + k0; t.K = DM; return t; }
    it -= I_GU;
    { const int e = it >> 8, r = it & 255, kb = r >> 5, nb = r & 31, k0 = 64 * kb, n0 = 64 * nb;
        const CAS float* src = (e < NE) ? (F.f(21) + (size_t)e * DE * DM) : F.f(24);
        const int P = n0 + nq, p = P & 255, cl = 64 * ((p >> 5) & 3) + 16 * ((p >> 3) & 3) + 8 * (p >> 7) + 4 * ((p >> 2) & 1);
        t.q = src + (size_t)(k0 + kr) * DM + (P & ~255) + cl; t.ld = DM; t.dst = WSP(bf16, WS_WDN) + ((size_t)e * DM + n0) * DE + k0; t.K = DE; return t; }
}
__device__ __forceinline__ void tr_item(Frame& F, int it, LAS float* scr) { f32x4 v[16]; const TrD t = tr_desc(F, it, true); tr_load(t, v); tr_fin(t, v, scr, F.lane()); }
__device__ __forceinline__ void tr_items4(Frame& F, int it0, int stride, int lim, LAS float* scr) {
    f32x4 va[16], vb[16]; const int lane = F.lane();
    TrD t0 = tr_desc(F, it0, it0 < lim); tr_load(t0, va);
    TrD t1 = tr_desc(F, it0 + stride, it0 + stride < lim); tr_load(t1, vb);
    tr_fin(t0, va, scr, lane);
    t0 = tr_desc(F, it0 + 2 * stride, it0 + 2 * stride < lim); tr_load(t0, va);
    tr_fin(t1, vb, scr, lane);
    t1 = tr_desc(F, it0 + 3 * stride, it0 + 3 * stride < lim); tr_load(t1, vb);
    tr_fin(t0, va, scr, lane);
    tr_fin(t1, vb, scr, lane);
}
__device__ __forceinline__ void p0_prologue(Frame& F) {
    const int gw = F.bid() * 8 + F.wave(), NGW = F.G() * 8, gt = F.bid() * 512 + F.tid(), NGT = F.G() * 512;
    PSUB(1, 0);
    {
        LAS float* red = (LAS float*)F.lds();
        float* modp = WSP(float, WS_MODP);
        for (int item = F.bid(); item < 48 * 16; item += F.G()) {
            const int cc = item % 48, ks = item / 48;
            f32x4 a0 = {0.f, 0.f, 0.f, 0.f}, a1 = {0.f, 0.f, 0.f, 0.f};
            const int kbase = ks * 128 + F.wave() * 16;
#pragma unroll 4
            for (int i = 0; i < 16; ++i) { const int k = kbase + i;
                const float c0 = silu_f(F.f(1)[k]), c1 = silu_f(F.f(1)[DM + k]);
                const f32x4 wv = *(const CAS f32x4*)(F.f(3) + (size_t)k * (6 * DM) + cc * 256 + F.lane() * 4);
                a0 += wv * c0; a1 += wv * c1; }
            *(LAS f32x4*)(red + (F.wave() * 2 + 0) * 256 + F.lane() * 4) = a0;
            *(LAS f32x4*)(red + (F.wave() * 2 + 1) * 256 + F.lane() * 4) = a1;
            __syncthreads();
            { const int b = F.tid() >> 8, col = F.tid() & 255; float s = 0.f;
#pragma unroll
              for (int w = 0; w < 8; ++w) s += red[(w * 2 + b) * 256 + col];
              modp[((size_t)ks * 2 + b) * (6 * DM) + cc * 256 + col] = s; }
            __syncthreads();
        }
    }
    PSUB(1, 1); PSUB(2, 0);
    {
        float* cosA = WSP(float, WS_COSA); float* sinA = WSP(float, WS_SINA); float* cosI = WSP(float, WS_COSI); float* sinI = WSP(float, WS_SINI);
        for (int i = gt; i < NTOK * 64; i += NGT) { const int tok = i >> 6, j = i & 63;
            const float inv = 1.0f / powf(10000.0f, (float)(2 * j) / 128.0f); const float ang = (float)F.i32(2)[tok] * inv;
            float s, c; sincosf(ang, &s, &c); cosA[i] = c; sinA[i] = s; }
        for (int i = gt; i < NTOK * 32; i += NGT) { const int tok = i >> 5, j = i & 31;
            const float inv = 1.0f / powf(10000.0f, (float)(2 * j) / 64.0f); const float ang = (float)F.i32(2)[tok] * inv;
            float s, c; sincosf(ang, &s, &c); cosI[i] = c; sinI[i] = s; }
    }
    PSUB(2, 1); PSUB(4, 0);
    {
        bf16* wr_hi = WSP(bf16, WS_WR); bf16* wr_lo = wr_hi + NE * DM;
        for (int i = gt; i < NE * (DM / 8); i += NGT) { const int e = i & 63, kc = i >> 6;
            float v[8], l[8];
#pragma unroll
            for (int j = 0; j < 8; ++j) { v[j] = F.f(17)[(size_t)(8 * kc + j) * NE + e]; l[j] = v[j] - bf2f(f2bf(v[j])); }
            u32x4 h = {cvt_pk_bf16(v[0], v[1]), cvt_pk_bf16(v[2], v[3]), cvt_pk_bf16(v[4], v[5]), cvt_pk_bf16(v[6], v[7])};
            u32x4 lo = {cvt_pk_bf16(l[0], l[1]), cvt_pk_bf16(l[2], l[3]), cvt_pk_bf16(l[4], l[5]), cvt_pk_bf16(l[6], l[7])};
            *(u32x4*)(wr_hi + (size_t)e * DM + 8 * kc) = h; *(u32x4*)(wr_lo + (size_t)e * DM + 8 * kc) = lo; }
    }
    PSUB(4, 1); PSUB(5, 0);
    {
        LAS float* scr = (LAS float*)(F.lds() + F.wave() * 16640);
        for (int it = gw; it < I_IN + I_OUT; it += NGW) tr_item(F, it, scr);
    }
    PSUB(5, 1);
}

constexpr int Q_GU = I_GU, Q_ALL = I_GU + I_DN, Q_GRAB = 32;
__device__ __forceinline__ void slack_fill(Frame& F, int budget, bool drain, int upto) {
    LAS float* scr = (LAS float*)(F.lds() + F.wave() * 16640);
    volatile LAS int* qw = (volatile LAS int*)(F.lds() + LDS_MISC + 16);
    __syncthreads();
    for (int gi = 0; drain || gi < budget; ++gi) {
        if (F.tid() == 0) { int stop = 0;
            const int idx = (int)__hip_atomic_fetch_add(F.ctl() + CW_QHEAD, (unsigned)Q_GRAB, RLX_AGENT); if (idx >= Q_ALL) stop = 1; else if (idx >= upto) stop = 2;
            qw[0] = stop; qw[1] = idx; }
        __syncthreads();
        const int stop = qw[0], idx = qw[1];
        __syncthreads();
        if (stop == 1) break;
        tr_items4(F, I_IN + I_OUT + idx + F.wave(), 8, I_IN + I_OUT + Q_ALL, scr);
        if (stop == 2) break;
    }
}

__device__ __forceinline__ void p1_modulate(Frame& F) {
    const float* modp = WSP(const float, WS_MODP); float* modf = WSP(float, WS_MODF); bf16* u1 = WSP(bf16, WS_U1);
    LAS float* sh = (LAS float*)F.lds(); LAS float* sc = sh + DM;
    for (int rg = F.bid(); rg < 256; rg += F.G()) {
        const int b = rg >> 7;
        if (F.tid() < 96) { const int v = rg * 96 + F.tid(); const int bb = v / (6 * DM), col = v % (6 * DM); float s = F.f(4)[col];
#pragma unroll
            for (int ks = 0; ks < 16; ++ks) s += modp[((size_t)ks * 2 + bb) * (6 * DM) + col];
            modf[v] = s; }
        { const int col = F.tid() * 4; f32x4 s0 = *(const CAS f32x4*)(F.f(4) + col), s1 = *(const CAS f32x4*)(F.f(4) + DM + col);
#pragma unroll
          for (int ks = 0; ks < 16; ++ks) { const float* p = modp + ((size_t)ks * 2 + b) * (6 * DM); s0 += *(const f32x4*)(p + col); s1 += *(const f32x4*)(p + DM + col); }
          *(LAS f32x4*)(sh + col) = s0; *(LAS f32x4*)(sc + col) = s1; }
        __syncthreads();
#pragma unroll
        for (int rr = 0; rr < 4; ++rr) { const int row = rg * 32 + F.wave() * 4 + rr;
#pragma unroll
            for (int j = 0; j < 8; ++j) { const int col = j * 256 + F.lane() * 4;
                const f32x4 xv = *(const CAS f32x4*)(F.f(0) + (size_t)row * DM + col); const f32x4 s0 = *(const LAS f32x4*)(sh + col), s1 = *(const LAS f32x4*)(sc + col);
                const f32x4 u = xv * (s1 + 1.0f) + s0;
                u32x2 o = {cvt_pk_bf16(u[0], u[1]), cvt_pk_bf16(u[2], u[3])};
                *(u32x2*)(u1 + (size_t)row * DM + col) = o; } }
        __syncthreads();
    }
}
struct EpiInProj {
    static constexpr bool PERM = true;
    unsigned char* ws; const CAS float *dt_bias, *lng, *lnb;
    __device__ __forceinline__ void operator()(const f32x4 (&acc)[2][2][4][2], const pg8::Unit& u, int wr, int wc, int fr, int fq) const {
        const int pn = u.pn; const int row0 = u.pm * 256 + wr * 64 + fr;
        if (pn < 10 || (pn >= 18 && pn < 22)) {
            size_t boff; int ld, col0;
            if (pn < 4) { boff = WS_Z; ld = 1024; col0 = pn * 256; } else if (pn < 10) { boff = WS_XBC; ld = CONV_CH; col0 = (pn - 4) * 256; } else { boff = WS_V; ld = 1024; col0 = (pn - 18) * 256; }
            bf16* base = (bf16*)(ws + boff);
            col0 += wc * 32 + 8 * fq;
#pragma unroll
            for (int ai = 0; ai < 2; ++ai)
#pragma unroll
                for (int m = 0; m < 4; ++m) { bf16* rowp = base + (size_t)(row0 + ai * 128 + m * 16) * ld + col0;
#pragma unroll
                    for (int bj = 0; bj < 2; ++bj) { const f32x4 v0 = acc[ai][bj][m][0], v1 = acc[ai][bj][m][1];
                        u32x4 w = {cvt_pk_bf16(v0[0], v0[1]), cvt_pk_bf16(v0[2], v0[3]), cvt_pk_bf16(v1[0], v1[1]), cvt_pk_bf16(v1[2], v1[3])};
                        *(u32x4*)(rowp + bj * 128) = w; } }
        } else if (pn < 26) {
            const bool att = pn < 18; const bool isq = pn < 14;
            bf16* base = (bf16*)(ws + (att ? (isq ? WS_Q : WS_K) : WS_QIDX)); const CAS float* ct = (const CAS float*)(ws + (att ? WS_COSA : WS_COSI)); const CAS float* sn = (const CAS float*)(ws + (att ? WS_SINA : WS_SINI));
            const int tw = att ? 64 : 32;
            const int head = att ? 2 * (pn - (isq ? 10 : 14)) + (wc >> 1) : 4 * (pn - 22) + wc, jj0 = att ? 32 * (wc & 1) + 8 * fq : 8 * fq;
#pragma unroll
            for (int ai = 0; ai < 2; ++ai)
#pragma unroll
                for (int m = 0; m < 4; ++m) { const int row = row0 + ai * 128 + m * 16;
                    bf16* rowp = base + (size_t)row * 1024 + head * (2 * tw) + jj0;
#pragma unroll
                    for (int n = 0; n < 2; ++n) { const f32x4 c = *(const CAS f32x4*)(ct + (size_t)row * tw + jj0 + 4 * n), sv = *(const CAS f32x4*)(sn + (size_t)row * tw + jj0 + 4 * n);
                        const f32x4 a = acc[ai][0][m][n], bb = acc[ai][1][m][n];
                        const f32x4 o1 = a * c - bb * sv, o2 = bb * c + a * sv;
                        *(u32x2*)(rowp + 4 * n) = (u32x2){cvt_pk_bf16(o1[0], o1[1]), cvt_pk_bf16(o1[2], o1[3])};
                        *(u32x2*)(rowp + tw + 4 * n) = (u32x2){cvt_pk_bf16(o2[0], o2[1]), cvt_pk_bf16(o2[2], o2[3])}; } }
        } else {
            const CAS float* cosI = (const CAS float*)(ws + WS_COSI); const CAS float* sinI = (const CAS float*)(ws + WS_SINI); bf16* kidx = (bf16*)(ws + WS_KIDX); float* widx = (float*)(ws + WS_WIDX); float* dt = (float*)(ws + WS_DT);
            if (wc == 0) {
                const int jj0 = 8 * fq;
#pragma unroll
                for (int am = 0; am < 8; ++am) { const int ai = am >> 2, m = am & 3; const int row = row0 + ai * 128 + m * 16;
                        f32x4 a0 = acc[ai][0][m][0], a1 = acc[ai][0][m][1], b0 = acc[ai][1][m][0], b1 = acc[ai][1][m][1];
                        float s = (a0[0] + a0[1] + a0[2] + a0[3]) + (a1[0] + a1[1] + a1[2] + a1[3]) + (b0[0] + b0[1] + b0[2] + b0[3]) + (b1[0] + b1[1] + b1[2] + b1[3]);
                        s += __shfl_xor(s, 16); s += __shfl_xor(s, 32);
                        const float mu = s * (1.0f / 64.0f);
                        a0 = a0 - mu; a1 = a1 - mu; b0 = b0 - mu; b1 = b1 - mu;
                        float qv = (a0[0] * a0[0] + a0[1] * a0[1] + a0[2] * a0[2] + a0[3] * a0[3]) + (a1[0] * a1[0] + a1[1] * a1[1] + a1[2] * a1[2] + a1[3] * a1[3])
                                 + (b0[0] * b0[0] + b0[1] * b0[1] + b0[2] * b0[2] + b0[3] * b0[3]) + (b1[0] * b1[0] + b1[1] * b1[1] + b1[2] * b1[2] + b1[3] * b1[3]);
                        qv += __shfl_xor(qv, 16); qv += __shfl_xor(qv, 32);
                        const float rstd = 1.0f / sqrtf(qv * (1.0f / 64.0f) + LN_EPS);
                        a0 = a0 * rstd * *(const CAS f32x4*)(lng + jj0) + *(const CAS f32x4*)(lnb + jj0); a1 = a1 * rstd * *(const CAS f32x4*)(lng + jj0 + 4) + *(const CAS f32x4*)(lnb + jj0 + 4);
                        b0 = b0 * rstd * *(const CAS f32x4*)(lng + 32 + jj0) + *(const CAS f32x4*)(lnb + 32 + jj0); b1 = b1 * rstd * *(const CAS f32x4*)(lng + 36 + jj0) + *(const CAS f32x4*)(lnb + 36 + jj0);
                        const f32x4 c0 = *(const CAS f32x4*)(cosI + (size_t)row * 32 + jj0), c1 = *(const CAS f32x4*)(cosI + (size_t)row * 32 + jj0 + 4);
                        const f32x4 s0 = *(const CAS f32x4*)(sinI + (size_t)row * 32 + jj0), s1 = *(const CAS f32x4*)(sinI + (size_t)row * 32 + jj0 + 4);
                        const f32x4 o10 = a0 * c0 - b0 * s0, o11 = a1 * c1 - b1 * s1, o20 = b0 * c0 + a0 * s0, o21 = b1 * c1 + a1 * s1;
                        bf16* rowp = kidx + (size_t)row * 64 + jj0;
                        u32x4 w1 = {cvt_pk_bf16(o10[0], o10[1]), cvt_pk_bf16(o10[2], o10[3]), cvt_pk_bf16(o11[0], o11[1]), cvt_pk_bf16(o11[2], o11[3])};
                        u32x4 w2 = {cvt_pk_bf16(o20[0], o20[1]), cvt_pk_bf16(o20[2], o20[3]), cvt_pk_bf16(o21[0], o21[1]), cvt_pk_bf16(o21[2], o21[3])};
                        *(u32x4*)rowp = w1; *(u32x4*)(rowp + 32) = w2; }
            } else if (wc == 1) {
                const int h0 = 8 * (fq & 1);
                const f32x4 db0 = *(const CAS f32x4*)(dt_bias + h0), db1 = *(const CAS f32x4*)(dt_bias + h0 + 4);
#pragma unroll
                for (int ai = 0; ai < 2; ++ai)
#pragma unroll
                    for (int m = 0; m < 4; ++m) { const int row = row0 + ai * 128 + m * 16;
                        const f32x4 a0 = acc[ai][0][m][0], a1 = acc[ai][0][m][1];
                        if (fq < 2) { *(f32x4*)(widx + (size_t)row * 16 + h0) = a0 * 0.03125f; *(f32x4*)(widx + (size_t)row * 16 + h0 + 4) = a1 * 0.03125f; }
                        else { f32x4 d0 = a0 + db0, d1 = a1 + db1;
#pragma unroll
                            for (int i = 0; i < 4; ++i) { d0[i] = d0[i] > 20.f ? d0[i] : log1pf(__expf(d0[i])); d1[i] = d1[i] > 20.f ? d1[i] : log1pf(__expf(d1[i])); }
                            *(f32x4*)(dt + (size_t)row * 16 + h0) = d0; *(f32x4*)(dt + (size_t)row * 16 + h0 + 4) = d1; } }
            }
        }
    }
};
constexpr int IX_QP = 2064;
constexpr int IX_ST = 32 * IX_QP;
constexpr int IX_WL = IX_ST + 8 * 8320;
__device__ __forceinline__ void idx_unit(Frame& F, int b, int s, int par) {
    const CAS bf16* kidx = (const CAS bf16*)(F.ws() + WS_KIDX); const CAS bf16* qidx = (const CAS bf16*)(F.ws() + WS_QIDX); const CAS float* widx = (const CAS float*)(F.ws() + WS_WIDX); float* scores = WSP(float, WS_SCORES);
    const int lane = F.lane(), r32 = lane & 31, hi = lane >> 5, w = F.wave(), tid = F.tid();
    LAS unsigned char* Ql = F.lds();
    { const CAS bf16* src = qidx + (size_t)(b * SEQ + s * 32) * 1024;
#pragma unroll
      for (int i = 0; i < 8; ++i) { const int c = tid + 512 * i, row = c >> 7, ch = c & 127;
          *(LAS bf16x8*)(Ql + row * IX_QP + ch * 16) = *(const CAS bf16x8*)(src + (size_t)row * 1024 + ch * 8); }
      if (tid < 128) { const f32x4 wv = *(const CAS f32x4*)(widx + (size_t)(b * SEQ + s * 32 + (tid >> 2)) * 16 + 4 * (tid & 3)); LAS float* wl = (LAS float*)(F.lds() + IX_WL) + (tid >> 2) * 17 + 4 * (tid & 3);
          wl[0] = wv[0]; wl[1] = wv[1]; wl[2] = wv[2]; wl[3] = wv[3]; } }
    __syncthreads();
    const int qpos = s * 32 + r32, nT = (s >> 2) + 1;
    const LAS float* wrow = (const LAS float*)(F.lds() + IX_WL) + r32 * 17;
    const LAS unsigned char* qrow = Ql + r32 * IX_QP + hi * 16;
    LAS float* st = (LAS float*)(F.lds() + IX_ST + w * 8320);
#pragma unroll 1
    for (int t = par + 2 * w; t < nT; t += 16) {
        const int kpos0 = t * 128;
        bf16x8 A[4][4];
#pragma unroll
        for (int kt = 0; kt < 4; ++kt)
#pragma unroll
            for (int ks = 0; ks < 4; ++ks) A[kt][ks] = *(const CAS bf16x8*)(kidx + (size_t)(b * SEQ + kpos0 + kt * 32 + r32) * 64 + ks * 16 + hi * 8);
        f32x16 o[4] = {};
#pragma unroll 1
        for (int h = 0; h < 16; ++h) { const float wh = wrow[h];
            bf16x8 Bq[4];
#pragma unroll
            for (int ks = 0; ks < 4; ++ks) Bq[ks] = *(const LAS bf16x8*)(qrow + h * 128 + ks * 32);
#pragma unroll
            for (int kt = 0; kt < 4; ++kt) { f32x16 a = {};
#pragma unroll
                for (int ks = 0; ks < 4; ++ks) a = __builtin_amdgcn_mfma_f32_32x32x16_bf16(A[kt][ks], Bq[ks], a, 0, 0, 0);
#pragma unroll
                for (int r = 0; r < 16; ++r) o[kt][r] = fmaf(wh, __int_as_float(max(__float_as_int(a[r]), 0)), o[kt][r]); } }
        const float NEG = -__builtin_inff();
#pragma unroll
        for (int half = 0; half < 2; ++half) {
#pragma unroll
            for (int r = 0; r < 16; ++r) { const int kk = crow(r, hi);
                st[r32 * 65 + kk] = (kpos0 + half * 64 + kk > qpos) ? NEG : o[2 * half][r];
                st[r32 * 65 + 32 + kk] = (kpos0 + half * 64 + 32 + kk > qpos) ? NEG : o[2 * half + 1][r]; }
            LDS_WAIT(); asm volatile("" ::: "memory");
            float* dst = scores + (size_t)(b * SEQ + s * 32) * SEQ + kpos0 + half * 64 + lane;
#pragma unroll 4
            for (int q = 0; q < 32; ++q) { *dst = st[q * 65 + lane]; dst += SEQ; }
            LDS_WAIT(); asm volatile("" ::: "memory"); }
    }
    __syncthreads();
}

constexpr int SA_P = 136;
constexpr int SA_BN = 0, SA_CN = 34816, SA_BT = 69632, SA_CB = 104448, SA_SM = 139264;
__device__ __forceinline__ void conv8(const CAS bf16* xraw_row  , int tpos, const CAS float* cw, const CAS float* cb, float (&o)[8]) {
    bf16x8 xv[4];
#pragma unroll
    for (int k = 0; k < 4; ++k) { const int dt_ = k - 3; xv[k] = *(const CAS bf16x8*)(xraw_row + ((tpos + dt_ >= 0) ? (long)dt_ * CONV_CH : 0l)); }
    const f32x4 b0 = *(const CAS f32x4*)cb, b1 = *(const CAS f32x4*)(cb + 4);
#pragma unroll
    for (int j = 0; j < 4; ++j) { o[j] = b0[j]; o[4 + j] = b1[j]; }
#pragma unroll
    for (int k = 0; k < 4; ++k) { const float vm = (tpos + k - 3 >= 0) ? 1.f : 0.f; float xf[8]; unpack8(xv[k], xf);
        const f32x4 w0 = *(const CAS f32x4*)(cw + k * CONV_CH) * vm, w1 = *(const CAS f32x4*)(cw + k * CONV_CH + 4) * vm;
#pragma unroll
        for (int j = 0; j < 4; ++j) { o[j] += w0[j] * xf[j]; o[4 + j] += w1[j] * xf[4 + j]; } }
#pragma unroll
    for (int j = 0; j < 8; ++j) o[j] = silu_f(o[j]);
}
__device__ __forceinline__ void ssd_a_unit(Frame& F, int b, int c, int g, int hf) {
    const CAS bf16* xbc = (const CAS bf16*)(F.ws() + WS_XBC); bf16* xact = WSP(bf16, WS_XBCACT); const CAS float* dtg = (const CAS float*)(F.ws() + WS_DT); float* csg = WSP(float, WS_CS);
    float* ydiag = WSP(float, WS_YDIAG); float* states = WSP(float, WS_STATES);
    LAS bf16* Bn = (LAS bf16*)(F.lds() + SA_BN); LAS bf16* Cn = (LAS bf16*)(F.lds() + SA_CN); LAS bf16* BT = (LAS bf16*)(F.lds() + SA_BT); LAS bf16* CB = (LAS bf16*)(F.lds() + SA_CB);
    const int lane = F.lane(), r32 = lane & 31, hi = lane >> 5, w = F.wave();
    const int tok0 = b * SEQ + c * CHUNK;
#pragma unroll 4
    for (int i = 0; i < 8; ++i) { const int id = F.tid() + 512 * i, mi = id >> 11, rem = id & 2047, s = rem >> 4, ch = rem & 15;
        const int chan = 1024 + mi * 256 + g * 128 + ch * 8; float o[8];
        conv8(xbc + (size_t)(tok0 + s) * CONV_CH + chan, c * CHUNK + s, F.f(6) + chan, F.f(7) + chan, o);
        u32x4 pk = {cvt_pk_bf16(o[0], o[1]), cvt_pk_bf16(o[2], o[3]), cvt_pk_bf16(o[4], o[5]), cvt_pk_bf16(o[6], o[7])};
        if (mi == 0) { *(LAS u32x4*)(Bn + s * SA_P + ch * 8) = pk;
#pragma unroll
            for (int j = 0; j < 8; ++j) BT[(ch * 8 + j) * SA_P + s] = (bf16)((pk[j >> 1] >> (16 * (j & 1))) & 0xffffu); }
        else { *(LAS u32x4*)(Cn + s * SA_P + ch * 8) = pk; if (hf == 0) *(u32x4*)(xact + (size_t)(tok0 + s) * CONV_CH + chan) = pk; } }
    __syncthreads();
    { const int lt = w >> 1;
#pragma unroll
      for (int sq = 0; sq < 2; ++sq) { const int st = 2 * (w & 1) + sq; f32x16 a = {};
#pragma unroll
          for (int ks = 0; ks < 8; ++ks) { const bf16x8 av = *(const LAS bf16x8*)(Cn + (32 * lt + r32) * SA_P + 16 * ks + 8 * hi), bv = *(const LAS bf16x8*)(Bn + (32 * st + r32) * SA_P + 16 * ks + 8 * hi);
              a = __builtin_amdgcn_mfma_f32_32x32x16_bf16(av, bv, a, 0, 0, 0); }
#pragma unroll
          for (int r = 0; r < 16; ++r) CB[(32 * lt + crow(r, hi)) * SA_P + 32 * st + r32] = f2bf(a[r]); } }
    __syncthreads();
    const int j = w >> 1, sub = w & 1, h = 8 * g + 4 * hf + j;
    LAS bf16* XT = (LAS bf16*)(F.lds() + j * 17408);
    LAS float* cs_l = (LAS float*)(F.lds() + SA_SM) + j * 384; LAS float* wdec = cs_l + 128;
    {
        const float ah = -__expf(F.f(9)[h]);
        const float d0 = dtg[(size_t)(tok0 + lane) * 16 + h], d1 = dtg[(size_t)(tok0 + 64 + lane) * 16 + h];
        float c0 = d0 * ah, c1 = d1 * ah;
#pragma unroll
        for (int o = 1; o < 64; o <<= 1) { const float t0 = __shfl_up(c0, o), t1 = __shfl_up(c1, o); if (lane >= o) { c0 += t0; c1 += t1; } }
        const float tot0 = __shfl(c0, 63); c1 += tot0; const float cend = __shfl(c1, 63);
        if (sub == 0) { cs_l[lane] = c0; cs_l[64 + lane] = c1; wdec[lane] = __expf(cend - c0); wdec[64 + lane] = __expf(cend - c1);
            csg[(size_t)(tok0 + lane) * 16 + h] = c0; csg[(size_t)(tok0 + 64 + lane) * 16 + h] = c1; }
#pragma unroll 4
        for (int i = 0; i < 8; ++i) { const int id = lane + 64 * i, s = 64 * sub + (id >> 3), ch = id & 7, chan = h * 64 + ch * 8; float o[8];
            conv8(xbc + (size_t)(tok0 + s) * CONV_CH + chan, c * CHUNK + s, F.f(6) + chan, F.f(7) + chan, o);
            u32x4 pk = {cvt_pk_bf16(o[0], o[1]), cvt_pk_bf16(o[2], o[3]), cvt_pk_bf16(o[4], o[5]), cvt_pk_bf16(o[6], o[7])};
            *(u32x4*)(xact + (size_t)(tok0 + s) * CONV_CH + chan) = pk;
            const float dts = dtg[(size_t)(tok0 + s) * 16 + h];
#pragma unroll
            for (int jj = 0; jj < 8; ++jj) XT[(ch * 8 + jj) * SA_P + s] = f2bf(o[jj] * dts); }
    }
    __syncthreads();
#pragma unroll
    for (int lq = 0; lq < 2; ++lq) { const int lt = 2 * sub + lq; const int l = 32 * lt + r32; const float csl = cs_l[l];
        f32x16 a0 = {}, a1 = {};
        for (int ks = 0; ks <= 2 * lt + 1; ++ks) { const int s0 = 16 * ks + 8 * hi;
            float cbf[8]; unpack8(*(const LAS bf16x8*)(CB + l * SA_P + s0), cbf);
            const f32x4 q0 = *(const LAS f32x4*)(cs_l + s0), q1 = *(const LAS f32x4*)(cs_l + s0 + 4);
            float mv[8];
#pragma unroll
            for (int jj = 0; jj < 8; ++jj) { const float cq = jj < 4 ? q0[jj & 3] : q1[jj & 3]; mv[jj] = (s0 + jj <= l) ? cbf[jj] * __expf(csl - cq) : 0.f; }
            const bf16x8 av = pack8((f32x4){mv[0], mv[1], mv[2], mv[3]}, (f32x4){mv[4], mv[5], mv[6], mv[7]});
            const bf16x8 b0 = *(const LAS bf16x8*)(XT + r32 * SA_P + s0), b1 = *(const LAS bf16x8*)(XT + (32 + r32) * SA_P + s0);
            a0 = __builtin_amdgcn_mfma_f32_32x32x16_bf16(av, b0, a0, 0, 0, 0); a1 = __builtin_amdgcn_mfma_f32_32x32x16_bf16(av, b1, a1, 0, 0, 0); }
#pragma unroll
        for (int r = 0; r < 16; ++r) { float* yp = ydiag + (size_t)(tok0 + 32 * lt + crow(r, hi)) * D_SSM + h * 64 + r32; yp[0] = a0[r]; yp[32] = a1[r]; } }
    { f32x16 a[2][2] = {};
      for (int ks = 0; ks < 8; ++ks) { const int s0 = 16 * ks + 8 * hi;
          const f32x4 q0 = *(const LAS f32x4*)(wdec + s0), q1 = *(const LAS f32x4*)(wdec + s0 + 4);
          bf16x8 av[2];
#pragma unroll
          for (int pt = 0; pt < 2; ++pt) { float xf[8]; unpack8(*(const LAS bf16x8*)(XT + (32 * pt + r32) * SA_P + s0), xf);
              av[pt] = pack8((f32x4){xf[0] * q0[0], xf[1] * q0[1], xf[2] * q0[2], xf[3] * q0[3]}, (f32x4){xf[4] * q1[0], xf[5] * q1[1], xf[6] * q1[2], xf[7] * q1[3]}); }
#pragma unroll
          for (int nq = 0; nq < 2; ++nq) { const bf16x8 bv = *(const LAS bf16x8*)(BT + (32 * (2 * sub + nq) + r32) * SA_P + s0);
#pragma unroll
              for (int pt = 0; pt < 2; ++pt) a[pt][nq] = __builtin_amdgcn_mfma_f32_32x32x16_bf16(av[pt], bv, a[pt][nq], 0, 0, 0); } }
      float* sp = states + ((size_t)((b * NCHUNK + c) * SSM_H + h) * SSM_P) * SSM_N;
#pragma unroll
      for (int pt = 0; pt < 2; ++pt)
#pragma unroll
          for (int nq = 0; nq < 2; ++nq)
#pragma unroll
              for (int r = 0; r < 16; ++r) sp[(size_t)(32 * pt + crow(r, hi)) * SSM_N + 32 * (2 * sub + nq) + r32] = a[pt][nq][r]; }
    __syncthreads();
}
constexpr int N_SSD_A = NBATCH * NCHUNK * 2 * 2, N_IDX_U = 256;
__device__ __forceinline__ void p3_ssd(Frame& F) {
#pragma unroll 1
    for (int L = F.bid(); L < N_SSD_A; L += F.G()) { const int hf = L & 1, g = (L >> 1) & 1, c = (L >> 2) & 31, b = L >> 7; ssd_a_unit(F, b, c, g, hf); }
}
__device__ __forceinline__ void p3_idx(Frame& F) {
    int L = F.bid(); while (L < N_SSD_A) L += F.G();
#pragma unroll 1
    for (; L < N_SSD_A + N_IDX_U; L += F.G()) { const int p0 = L - N_SSD_A, b = p0 >> 7, par = p0 & 1, s = (p0 >> 1) & 63;
        idx_unit(F, b, 127 - s, par); idx_unit(F, b, s, par); }
}
__device__ __forceinline__ unsigned fkey(float f) { const unsigned u = __float_as_uint(f); return (u & 0x80000000u) ? ~u : (u | 0x80000000u); }
__device__ __forceinline__ void select_row(Frame& F, int row, LAS unsigned* hist, LAS unsigned* keys) {
    const float* sc = WSP(const float, WS_SCORES) + (size_t)row * SEQ; unsigned long long* mrow = WSP(unsigned long long, WS_MASK) + (size_t)row * 64;
    const int lane = F.lane(), t = row & (SEQ - 1);
    if (t < TOPK_SEL) {
        const int lo = 64 * lane; unsigned long long m;
        if (lo + 63 <= t) m = ~0ull; else if (lo > t) m = 0ull; else m = (1ull << (t - lo + 1)) - 1ull;
        mrow[lane] = m; return;
    }
    const int nI = (t >> 6) + 1;
    float amax = 0.f;
    const int n4 = (t >> 8) + 1;
#pragma unroll 8
    for (int i = 0; i < n4; ++i) { const int e0 = 256 * i + 4 * lane; const f32x4 v = *(const f32x4*)(sc + e0);
        u32x4 kb;
#pragma unroll
        for (int j = 0; j < 4; ++j) { const bool ok = (e0 + j <= t); kb[j] = ok ? __float_as_uint(v[j]) : 0u; amax = fmaxf(amax, ok ? fabsf(v[j]) : 0.f); }
        *(LAS u32x4*)(keys + e0) = kb; }
#pragma unroll
    for (int o = 1; o < 64; o <<= 1) amax = fmaxf(amax, __shfl_xor(amax, o));
    const float ks = 0.49f / fmaxf(amax, 1e-30f);
    unsigned prefix = 0u, need = TOPK_SEL, pmask = 0u, cnt_eq = 0u;
#pragma unroll 1
    for (int pass = 0; pass < 3; ++pass) { const int shift = (pass == 0) ? 15 : (pass == 1 ? 7 : 0); const unsigned dmask = (pass == 2) ? 127u : 255u;
        hist[4 * lane] = 0u; hist[4 * lane + 1] = 0u; hist[4 * lane + 2] = 0u; hist[4 * lane + 3] = 0u;
        LDS_WAIT(); asm volatile("" ::: "memory");
        if (pass == 0) {
#pragma unroll 1
            for (int i0 = 0; i0 < nI; i0 += 8) { unsigned kk[8];
#pragma unroll
                for (int j = 0; j < 8; ++j) { const int e = 64 * (i0 + j) + lane; kk[j] = keys[e & 4095]; }
#pragma unroll
                for (int j = 0; j < 8; ++j) { const int e = 64 * (i0 + j) + lane; kk[j] = (e <= t) ? (__float_as_uint(fmaf(__uint_as_float(kk[j]), ks, 1.5f)) & 0x7fffffu) : 0u; }
#pragma unroll
                for (int j = 0; j < 8; ++j) { const int e = 64 * (i0 + j) + lane; if (i0 + j < nI) keys[e] = kk[j];
                    if (kk[j] != 0u) __hip_atomic_fetch_add(hist + (kk[j] >> 15), 1u, __ATOMIC_RELAXED, __HIP_MEMORY_SCOPE_WORKGROUP); } }
        } else {
#pragma unroll 1
            for (int i0 = 0; i0 < nI; i0 += 8) { unsigned kk[8];
#pragma unroll
                for (int j = 0; j < 8; ++j) { const int e = 64 * (i0 + j) + lane; kk[j] = (i0 + j < nI) ? keys[e & 4095] : 0u; }
#pragma unroll
                for (int j = 0; j < 8; ++j) if ((kk[j] & pmask) == prefix && kk[j] != 0u) __hip_atomic_fetch_add(hist + ((kk[j] >> shift) & dmask), 1u, __ATOMIC_RELAXED, __HIP_MEMORY_SCOPE_WORKGROUP); }
        }
        LDS_WAIT(); asm volatile("" ::: "memory");
        const unsigned c0 = hist[4 * lane], c1 = hist[4 * lane + 1], c2 = hist[4 * lane + 2], c3 = hist[4 * lane + 3];
        const unsigned tot = c0 + c1 + c2 + c3;
        unsigned suf = tot;
#pragma unroll
        for (int o = 1; o < 64; o <<= 1) { const unsigned tt = __shfl_down(suf, o); if (lane + o < 64) suf += tt; }
        unsigned above = suf - tot;
        int found = -1; unsigned nneed = 0u, fcnt = 0u;
        if (above < need && need <= above + c3) { found = 3; nneed = need - above; fcnt = c3; }
        above += c3;
        if (found < 0 && above < need && need <= above + c2) { found = 2; nneed = need - above; fcnt = c2; }
        above += c2;
        if (found < 0 && above < need && need <= above + c1) { found = 1; nneed = need - above; fcnt = c1; }
        above += c1;
        if (found < 0 && above < need && need <= above + c0) { found = 0; nneed = need - above; fcnt = c0; }
        const unsigned long long bal = __ballot(found >= 0);
        const int src = (int)__builtin_ctzll(bal | (1ull << 63));
        const unsigned digit = (unsigned)__shfl(4 * lane + found, src);
        need = (unsigned)__shfl((int)nneed, src); cnt_eq = (unsigned)__shfl((int)fcnt, src);
        prefix |= digit << shift; pmask |= dmask << shift;
        LDS_WAIT(); asm volatile("" ::: "memory");
    }
    const bool all_eq = (cnt_eq == need);
    unsigned run = 0u; unsigned long long myword = 0ull;
    const unsigned long long lt_mask = (lane == 0) ? 0ull : (~0ull >> (64 - lane));
#pragma unroll 4
    for (int i = 0; i < nI; ++i) {
        const unsigned k = keys[64 * i + lane]; bool sel = k > prefix;
        if (all_eq) { sel = sel || (k == prefix); }
        else { const unsigned long long em = __ballot(k == prefix); if (k == prefix) sel = (run + (unsigned)__popcll(em & lt_mask)) < need; run += (unsigned)__popcll(em); }
        const unsigned long long wb = __ballot(sel);
        if (lane == i) myword = wb;
    }
    mrow[lane] = myword;
    LDS_WAIT(); asm volatile("" ::: "memory");
}
__device__ __forceinline__ void p4_select(Frame& F) {
    LAS unsigned* keys = (LAS unsigned*)(F.lds() + F.wave() * 16384); LAS unsigned* hist = (LAS unsigned*)(F.lds() + 131072 + F.wave() * 1024);
    const int gw = F.bid() * 8 + F.wave(), NGW = F.G() * 8;
    for (int pr = gw; pr < SEQ / 2; pr += NGW) {
#pragma unroll 1
        for (int b = 0; b < NBATCH; ++b) { select_row(F, b * SEQ + pr, hist, keys); select_row(F, b * SEQ + (SEQ - 1 - pr), hist, keys); }
    }
}
__device__ __forceinline__ void p4_scan(Frame& F) {
    const CAS float* states = (const CAS float*)(F.ws() + WS_STATES); bf16* hin = WSP(bf16, WS_HIN); const CAS float* csg = (const CAS float*)(F.ws() + WS_CS);
    const int gt = F.bid() * 512 + F.tid(), NGT = F.G() * 512;
    for (int q = gt; q < NBATCH * SSM_H * SSM_P * (SSM_N / 2); q += NGT) {
        const int n = 2 * (q & 63), p = (q >> 6) & 63, h = (q >> 12) & 15, b = q >> 16;
        float h0 = 0.f, h1 = 0.f;
#pragma unroll 8
        for (int c = 0; c < NCHUNK; ++c) {
            const size_t off = ((size_t)((b * NCHUNK + c) * SSM_H + h) * SSM_P + p) * SSM_N + n;
            *(unsigned*)(hin + off) = cvt_pk_bf16(h0, h1);
            const float dec = __expf(csg[(size_t)(b * SEQ + c * CHUNK + CHUNK - 1) * 16 + h]);
            const f32x2 st = *(const CAS f32x2*)(states + off);
            h0 = dec * h0 + st[0]; h1 = dec * h1 + st[1];
        }
    }
}
namespace att {
constexpr int KVBLK = 64, SHM_K = KVBLK * 128 * 2, SHM_V = SHM_K;
constexpr float SCALE = 0.08838834764831845f, THR = 8.f, C2 = 1.4426950408889634f * SCALE;
#define KSWZ(row, colB) ((row) * 256 + ((colB) ^ (((row) & 7) << 4)))
__device__ __forceinline__ int v_st(int k, int c) { const int kk = (k & ~0xC) | ((k & 4) << 1) | ((k & 8) >> 1); return ((kk >> 3) * 4 + (c >> 5)) * 512 + ((kk & 7) * 32 + (c & 31)) * 2; }
__device__ __forceinline__ int v_rd_base(int lane) { return ((lane & 3) << 3) | (((lane >> 2) & 3) << 6) | (((lane >> 4) & 1) << 5) | (((lane >> 5) & 1) << 8); }
constexpr int v_rd_off(int d0, int ks, int half) { return d0 * 512 + ks * 4096 + half * 2048; }
template <int KB>
__device__ __forceinline__ void qkt(f32x16& p0, f32x16& p1, LAS const char* K_lds, int r32, int hi, const bf16x8* qr) {
    p0 = f32x16{}; p1 = f32x16{};
    LAS const char* kb[4];
#pragma unroll
    for (int dd = 0; dd < 4; ++dd) kb[dd] = K_lds + KB * SHM_K + KSWZ(r32, (dd * 16 + hi * 8) * 2);
#pragma unroll
    for (int d0 = 0; d0 < 8; ++d0) { LAS const char* a = kb[d0 & 3] + (d0 >> 2) * 128;
        const bf16x8 b0 = *(LAS const bf16x8*)a;
        const bf16x8 b1 = *(LAS const bf16x8*)(a + 32 * 256);
        p0 = __builtin_amdgcn_mfma_f32_32x32x16_bf16(b0, qr[d0], p0, 0, 0, 0);
        p1 = __builtin_amdgcn_mfma_f32_32x32x16_bf16(b1, qr[d0], p1, 0, 0, 0); }
}
template <int VB>
__device__ __forceinline__ void pv_tile(f32x16* o, int vb0, bf16x8 pa0, bf16x8 pa1, bf16x8 pa2, bf16x8 pa3) {
#define TRRD(dst, off) asm volatile("ds_read_b64_tr_b16 %0, %1 offset:%2" : "=&v"(dst) : "v"(vb0), "i"(off) : "memory")
#define PV_D0(d0) do { s16x4 l0, l1, l2, l3, h0, h1, h2, h3; constexpr int b_ = VB * SHM_V + v_rd_off(d0, 0, 0); \
        TRRD(l0, b_); TRRD(h0, b_ + 2048); TRRD(l1, b_ + 4096); TRRD(h1, b_ + 6144); TRRD(l2, b_ + 8192); TRRD(h2, b_ + 10240); TRRD(l3, b_ + 12288); TRRD(h3, b_ + 14336); \
        asm volatile("s_waitcnt lgkmcnt(0)" ::: "memory"); __builtin_amdgcn_sched_barrier(0); \
        o[d0] = __builtin_amdgcn_mfma_f32_32x32x16_bf16(pa0, (bf16x8){l0[0], l0[1], l0[2], l0[3], h0[0], h0[1], h0[2], h0[3]}, o[d0], 0, 0, 0);   \
        o[d0] = __builtin_amdgcn_mfma_f32_32x32x16_bf16(pa1, (bf16x8){l1[0], l1[1], l1[2], l1[3], h1[0], h1[1], h1[2], h1[3]}, o[d0], 0, 0, 0);   \
        o[d0] = __builtin_amdgcn_mfma_f32_32x32x16_bf16(pa2, (bf16x8){l2[0], l2[1], l2[2], l2[3], h2[0], h2[1], h2[2], h2[3]}, o[d0], 0, 0, 0);   \
        o[d0] = __builtin_amdgcn_mfma_f32_32x32x16_bf16(pa3, (bf16x8){l3[0], l3[1], l3[2], l3[3], h3[0], h3[1], h3[2], h3[3]}, o[d0], 0, 0, 0); } while (0)
    PV_D0(0); PV_D0(1); PV_D0(2); PV_D0(3);
#undef PV_D0
#undef TRRD
}
__device__ __forceinline__ void softmax_tile(f32x16& p0, f32x16& p1, unsigned long long mw, int hi, float& m_reg, float& l_reg, float& alpha, bf16x8& pa0, bf16x8& pa1, bf16x8& pa2, bf16x8& pa3) {
    float pmax = p0[0];
#pragma unroll
    for (int r = 1; r < 16; ++r) pmax = fmaxf(pmax, p0[r]);
#pragma unroll
    for (int r = 0; r < 16; ++r) pmax = fmaxf(pmax, p1[r]);
    { auto rr = __builtin_amdgcn_permlane32_swap(__float_as_uint(pmax), __float_as_uint(pmax), false, false); pmax = fmaxf(__uint_as_float(rr[0]), __uint_as_float(rr[1])); }
    float mn;
    if (__all((pmax - m_reg) * SCALE <= THR)) { mn = m_reg; alpha = 1.f; }
    else { mn = fmaxf(m_reg, pmax); alpha = __builtin_amdgcn_exp2f((m_reg - mn) * C2); m_reg = mn; }
    const float mnL = -mn * C2;
    const int lo = (int)((unsigned)mw >> (4 * hi)), hh = (int)((unsigned)(mw >> 32) >> (4 * hi));
#pragma unroll
    for (int r = 0; r < 16; ++r) { const int c = (r & 3) + 8 * (r >> 2);
        const float e0 = __builtin_amdgcn_exp2f(fmaf(p0[r], C2, mnL)), e1 = __builtin_amdgcn_exp2f(fmaf(p1[r], C2, mnL));
        p0[r] = __uint_as_float(__float_as_uint(e0) & (unsigned)__builtin_amdgcn_sbfe(lo, c, 1));
        p1[r] = __uint_as_float(__float_as_uint(e1) & (unsigned)__builtin_amdgcn_sbfe(hh, c, 1)); }
    float ps = 0.f;
#pragma unroll
    for (int r = 0; r < 16; ++r) ps += p0[r];
#pragma unroll
    for (int r = 0; r < 16; ++r) ps += p1[r];
    { auto rr = __builtin_amdgcn_permlane32_swap(__float_as_uint(ps), __float_as_uint(ps), false, false); ps = __uint_as_float(rr[0]) + __uint_as_float(rr[1]); }
    l_reg = l_reg * alpha + ps;
#define PK4(P, B_, OUT) do { unsigned a0 = cvt_pk_bf16(P[B_+0], P[B_+1]), a1 = cvt_pk_bf16(P[B_+2], P[B_+3]); \
        unsigned b0 = cvt_pk_bf16(P[B_+4], P[B_+5]), b1 = cvt_pk_bf16(P[B_+6], P[B_+7]); \
        auto r0 = __builtin_amdgcn_permlane32_swap(a0, b0, false, false); auto r1 = __builtin_amdgcn_permlane32_swap(a1, b1, false, false); \
        u32x4 w = {r0[0], r1[0], r0[1], r1[1]}; OUT = __builtin_bit_cast(bf16x8, w); } while (0)
    PK4(p0, 0, pa0); PK4(p0, 8, pa1); PK4(p1, 0, pa2); PK4(p1, 8, pa3);
#undef PK4
}
}

__device__ __forceinline__ void attn_item(Frame& F, int b, int h, int X) {
    using namespace att;
    const bf16* qg = WSP(const bf16, WS_Q); const bf16* kg = WSP(const bf16, WS_K) + (size_t)(b * SEQ) * 1024 + h * 128; const bf16* vg = WSP(const bf16, WS_V) + (size_t)(b * SEQ) * 1024 + h * 128;
    const unsigned long long* maskg = WSP(const unsigned long long, WS_MASK); bf16* ycat = WSP(bf16, WS_YCAT);
    const int tid = F.tid(), wid = F.wave(), lane = F.lane(), r32 = lane & 31, hi = lane >> 5;
    LAS char* V_lds = (LAS char*)F.lds(); LAS char* K_lds = V_lds + 2 * SHM_V;
    LAS float* wsl = (LAS float*)(F.lds() + 2 * SHM_V + 2 * SHM_K) + wid * 64; LAS float* li_l = wsl; LAS float* al_l = wsl + 32;
    const int tokq = b * SEQ + X * 256 + wid * 32 + r32, NT = 4 * X + 4;
    bf16x8 qr[8];
#pragma unroll
    for (int d0 = 0; d0 < 8; ++d0) qr[d0] = *(const bf16x8*)(qg + (size_t)tokq * 1024 + h * 128 + d0 * 16 + hi * 8);
    const unsigned long long* mrow = maskg + (size_t)tokq * 64;
    const int sr = tid >> 4, sc = (tid & 15) * 8, vst0 = v_st(sr, sc), vst1 = v_st(32 + sr, sc), kws = KSWZ(sr, sc * 2);
    const int vb0 = (int)(unsigned)(uintptr_t)V_lds + v_rd_base(lane);
    float m_reg = -1e30f, l_reg = 0.f; f32x16 o[4] = {};
    bf16x8 sA[4], sB[4];
    unsigned long long mwE, mwO;
#define ALOAD(S, t) do { const size_t r0_ = (size_t)((t) * KVBLK + sr) * 1024 + sc; S[0] = *(const bf16x8*)(kg + r0_); S[1] = *(const bf16x8*)(kg + r0_ + 32 * 1024); \
                         S[2] = *(const bf16x8*)(vg + r0_); S[3] = *(const bf16x8*)(vg + r0_ + 32 * 1024); } while (0)
#define AWRITE(S, bf) do { *(LAS bf16x8*)(K_lds + (bf) * SHM_K + kws) = S[0]; *(LAS bf16x8*)(K_lds + (bf) * SHM_K + kws + 32 * 256) = S[1]; \
                           *(LAS bf16x8*)(V_lds + (bf) * SHM_V + vst0) = S[2]; *(LAS bf16x8*)(V_lds + (bf) * SHM_V + vst1) = S[3]; } while (0)
#define ASTEP(t, KB, SW, MW) do { __syncthreads(); \
        if ((t) + 1 < NT) AWRITE(SW, (KB) ^ 1); \
        if ((t) + 3 < NT) ALOAD(SW, (t) + 3); \
        const unsigned long long mw_ = MW; if ((t) + 2 < NT) MW = mrow[(t) + 2]; \
        f32x16 p0, p1; float alpha; bf16x8 pa0, pa1, pa2, pa3; \
        qkt<KB>(p0, p1, K_lds, r32, hi, qr); \
        softmax_tile(p0, p1, mw_, hi, m_reg, l_reg, alpha, pa0, pa1, pa2, pa3); \
        if (__any(alpha < 1.f)) { if (hi == 0) al_l[r32] = alpha; LDS_WAIT(); \
            _Pragma("unroll") for (int d_ = 0; d_ < 4; ++d_) _Pragma("unroll") for (int r = 0; r < 16; ++r) o[d_][r] *= al_l[crow(r, hi)]; } \
        pv_tile<KB>(o, vb0, pa0, pa1, pa2, pa3); } while (0)
    ALOAD(sA, 0); mwE = mrow[0]; mwO = mrow[1];
    AWRITE(sA, 0);
    ALOAD(sB, 1); ALOAD(sA, 2);
    for (int t = 0; t < NT; t += 2) { ASTEP(t, 0, sB, mwE); ASTEP(t + 1, 1, sA, mwO); }
#undef ASTEP
#undef AWRITE
#undef ALOAD
    if (hi == 0) li_l[r32] = l_reg; LDS_WAIT();
    float rli[16];
#pragma unroll
    for (int r = 0; r < 16; ++r) rli[r] = __builtin_amdgcn_rcpf(li_l[crow(r, hi)]);
    bf16* Ow = ycat + (size_t)(b * SEQ + X * 256 + wid * 32) * DM + D_SSM + h * 128;
#pragma unroll
    for (int r = 0; r < 16; ++r) { const int orow = crow(r, hi);
#pragma unroll
        for (int d0 = 0; d0 < 4; ++d0) { const float v = o[d0][r] * rli[r]; const float vn = __shfl_xor(v, 1);
            if ((r32 & 1) == 0) *(unsigned*)(Ow + (size_t)orow * DM + d0 * 32 + r32) = cvt_pk_bf16(v, vn); } }
    __syncthreads();
}

__device__ __forceinline__ void ssd_c_unit(Frame& F, int b, int c, int lq) {
    const CAS bf16* xact = (const CAS bf16*)(F.ws() + WS_XBCACT); const CAS bf16* hin = (const CAS bf16*)(F.ws() + WS_HIN); const CAS float* csg = (const CAS float*)(F.ws() + WS_CS);
    const CAS float* ydiag = (const CAS float*)(F.ws() + WS_YDIAG); const CAS bf16* zg = (const CAS bf16*)(F.ws() + WS_Z); bf16* ycat = WSP(bf16, WS_YCAT);
    LAS float* gb = (LAS float*)F.lds();
    const int lane = F.lane(), r32 = lane & 31, hi = lane >> 5, w = F.wave(), g = w >> 2;
    const int tok0 = b * SEQ + c * CHUNK + lq * 32;
    bf16x8 Af[8];
#pragma unroll
    for (int ks = 0; ks < 8; ++ks) Af[ks] = *(const CAS bf16x8*)(xact + (size_t)(tok0 + r32) * CONV_CH + 1280 + g * 128 + 16 * ks + 8 * hi);
#pragma unroll
    for (int hh = 0; hh < 2; ++hh) { const int h = 2 * w + hh;
        const CAS bf16* hp = hin + ((size_t)((b * NCHUNK + c) * SSM_H + h) * SSM_P) * SSM_N;
        float e[16];
#pragma unroll
        for (int r = 0; r < 16; ++r) e[r] = csg[(size_t)(tok0 + crow(r, hi)) * 16 + h];
        f32x16 a0 = {}, a1 = {};
#pragma unroll
        for (int ks = 0; ks < 8; ++ks) { const bf16x8 b0 = *(const CAS bf16x8*)(hp + (size_t)r32 * SSM_N + 16 * ks + 8 * hi), b1 = *(const CAS bf16x8*)(hp + (size_t)(32 + r32) * SSM_N + 16 * ks + 8 * hi);
            a0 = __builtin_amdgcn_mfma_f32_32x32x16_bf16(Af[ks], b0, a0, 0, 0, 0); a1 = __builtin_amdgcn_mfma_f32_32x32x16_bf16(Af[ks], b1, a1, 0, 0, 0); }
#pragma unroll
        for (int r = 0; r < 16; ++r) { const float ee = __expf(e[r]); LAS float* p = gb + crow(r, hi) * 1024 + h * 64 + r32; p[0] = ee * a0[r]; p[32] = ee * a1[r]; } }
    __syncthreads();
    f32x4 dsk[4], nw[4];
#pragma unroll
    for (int j = 0; j < 4; ++j) { const float d = F.f(10)[4 * j + (lane >> 4)]; dsk[j] = (f32x4){d, d, d, d}; nw[j] = *(const CAS f32x4*)(F.f(11) + j * 256 + lane * 4); }
    f32x4 yd[4][4]; u32x2 xs[4][4], zz[4][4];
#pragma unroll
    for (int rr = 0; rr < 4; ++rr) { const size_t tok = (size_t)(tok0 + 4 * w + rr);
#pragma unroll
        for (int j = 0; j < 4; ++j) { const int col = j * 256 + lane * 4; yd[rr][j] = *(const CAS f32x4*)(ydiag + tok * D_SSM + col);
            xs[rr][j] = *(const CAS u32x2*)(xact + tok * CONV_CH + col); zz[rr][j] = *(const CAS u32x2*)(zg + tok * 1024 + col); } }
#pragma unroll
    for (int rr = 0; rr < 4; ++rr) { const int l = 4 * w + rr; float ss = 0.f; f32x4 v[4];
#pragma unroll
        for (int j = 0; j < 4; ++j) { const f32x4 yo = *(const LAS f32x4*)(gb + l * 1024 + j * 256 + lane * 4);
            const f32x4 xf = {bflo(xs[rr][j][0]), bfhi(xs[rr][j][0]), bflo(xs[rr][j][1]), bfhi(xs[rr][j][1])}, zf = {bflo(zz[rr][j][0]), bfhi(zz[rr][j][0]), bflo(zz[rr][j][1]), bfhi(zz[rr][j][1])};
            f32x4 y = yd[rr][j] + yo + dsk[j] * xf;
#pragma unroll
            for (int i = 0; i < 4; ++i) y[i] *= silu_f(zf[i]);
            v[j] = y; ss += (y[0] * y[0] + y[1] * y[1]) + (y[2] * y[2] + y[3] * y[3]); }
        const float rs = 1.0f / sqrtf(wave_sum(ss) * (1.0f / 1024.0f) + LN_EPS);
#pragma unroll
        for (int j = 0; j < 4; ++j) { const f32x4 y = v[j] * rs * nw[j];
            *(u32x2*)(ycat + (size_t)(tok0 + l) * DM + j * 256 + lane * 4) = (u32x2){cvt_pk_bf16(y[0], y[1]), cvt_pk_bf16(y[2], y[3])}; } }
    __syncthreads();
}
__device__ __forceinline__ void p5_phase(Frame& F) {
    for (int L = F.bid(); L < 256; L += F.G()) { const int lq = L & 3, c = (L >> 2) & 31, b = L >> 7; ssd_c_unit(F, b, c, lq); }
    PSUB(50, 0);
    for (int L = F.bid(); L < 256; L += F.G()) { const int X = 15 - (L >> 4), h = L & 7, b = (L >> 3) & 1; attn_item(F, b, h, X); }
    PSUB(50, 1);
}
struct EpiOutProj {
    static constexpr bool PERM = false;
    const CAS float* x; const CAS float* modf; float* out;
    __device__ __forceinline__ void operator()(const f32x4 (&acc)[2][2][4][2], const pg8::Unit& u, int wr, int wc, int fr, int fq) const {
        const int row0 = u.pm * 256 + wr * 64 + fr, col0 = u.pn * 256 + wc * 32 + 4 * fq; const int b = (u.pm * 256) / SEQ;
        f32x4 gv[2][2];
#pragma unroll
        for (int bj = 0; bj < 2; ++bj)
#pragma unroll
            for (int n = 0; n < 2; ++n) gv[bj][n] = *(const CAS f32x4*)(modf + (size_t)b * (6 * DM) + 2 * DM + col0 + bj * 128 + n * 16);
#pragma unroll
        for (int ai = 0; ai < 2; ++ai)
#pragma unroll
            for (int m = 0; m < 4; ++m) { const size_t off = (size_t)(row0 + ai * 128 + m * 16) * DM + col0;
#pragma unroll
                for (int bj = 0; bj < 2; ++bj)
#pragma unroll
                    for (int n = 0; n < 2; ++n) { const f32x4 xv = *(const CAS f32x4*)(x + off + bj * 128 + n * 16);
                        *(f32x4*)(out + off + bj * 128 + n * 16) = xv * ALPHA_DN + gv[bj][n] * acc[ai][bj][m][n]; } }
    }
};

constexpr int RT_P = 2056;
__device__ __forceinline__ void p7_unit(Frame& F, int un) {
    const CAS float* modf = (const CAS float*)(F.ws() + WS_MODF); bf16* u2 = WSP(bf16, WS_U2); const CAS bf16* wr_hi = (const CAS bf16*)(F.ws() + WS_WR); const CAS bf16* wr_lo = wr_hi + NE * DM;
    int* inv = WSP(int, WS_INV); int* ltok = WSP(int, WS_LTOK); float* lw = WSP(float, WS_LW);
    LAS bf16* Ah = (LAS bf16*)F.lds(); LAS bf16* Al = Ah + 16 * RT_P; LAS float* red = (LAS float*)F.lds();
    LAS float* logit = (LAS float*)(F.lds() + 135168);
    LAS int* ecnt = (LAS int*)(F.lds() + 139264); LAS int* ebase = ecnt + 64;
    const int lane = F.lane(), w = F.wave(), row0 = un * 16, b = row0 / SEQ;
    const CAS float* sh2 = modf + (size_t)b * (6 * DM) + 3 * DM; const CAS float* sc2 = modf + (size_t)b * (6 * DM) + 4 * DM;
    PSUB(70, 0); PSUB(71, 0);
#pragma unroll 1
    for (int rr = 0; rr < 2; ++rr) { const int rl = 2 * w + rr; const size_t row = (size_t)(row0 + rl);
        f32x4 v[8]; float s = 0.f;
#pragma unroll
        for (int j = 0; j < 8; ++j) { v[j] = *(const f32x4*)(F.out() + row * DM + j * 256 + lane * 4); s += (v[j][0] + v[j][1]) + (v[j][2] + v[j][3]); }
        const float mu = wave_sum(s) * (1.0f / DM); float q = 0.f;
#pragma unroll
        for (int j = 0; j < 8; ++j) { v[j] = v[j] - mu; q += (v[j][0] * v[j][0] + v[j][1] * v[j][1]) + (v[j][2] * v[j][2] + v[j][3] * v[j][3]); }
        const float rstd = 1.0f / sqrtf(wave_sum(q) * (1.0f / DM) + LN_EPS);
#pragma unroll
        for (int j = 0; j < 8; ++j) { const int col = j * 256 + lane * 4;
            const f32x4 x1 = v[j] * rstd * *(const CAS f32x4*)(F.f(15) + col) + *(const CAS f32x4*)(F.f(16) + col);
            *(f32x4*)(F.out() + row * DM + col) = x1;
            const f32x4 uu = x1 * (*(const CAS f32x4*)(sc2 + col) + 1.0f) + *(const CAS f32x4*)(sh2 + col);
            const unsigned h0 = cvt_pk_bf16(uu[0], uu[1]), h1 = cvt_pk_bf16(uu[2], uu[3]);
            *(u32x2*)(u2 + row * DM + col) = (u32x2){h0, h1};
            const unsigned l0 = cvt_pk_bf16(uu[0] - bflo(h0), uu[1] - bfhi(h0)), l1 = cvt_pk_bf16(uu[2] - bflo(h1), uu[3] - bfhi(h1));
            *(LAS u32x2*)(Ah + rl * RT_P + col) = (u32x2){h0, h1}; *(LAS u32x2*)(Al + rl * RT_P + col) = (u32x2){l0, l1}; } }
    if (F.tid() < 64) ecnt[F.tid()] = 0;
    __syncthreads();
    PSUB(70, 1); PSUB(72, 0);
    f32x4 acc[4] = {};
    { const int fr = lane & 15, fq = lane >> 4;
      bf16x8 bh[4][4], bl[4][4];
#pragma unroll
      for (int kb = 0; kb < 2; ++kb) {
#pragma unroll
          for (int kq = 0; kq < 4; ++kq) { const int k0_ = w * 256 + (4 * kb + kq) * 32 + fq * 8;
#pragma unroll
              for (int nt = 0; nt < 4; ++nt) { bh[kq][nt] = *(const CAS bf16x8*)(wr_hi + (size_t)(16 * nt + fr) * DM + k0_); bl[kq][nt] = *(const CAS bf16x8*)(wr_lo + (size_t)(16 * nt + fr) * DM + k0_); } }
#pragma unroll
          for (int kq = 0; kq < 4; ++kq) { const int k0_ = w * 256 + (4 * kb + kq) * 32 + fq * 8;
              const bf16x8 ah = *(const LAS bf16x8*)(Ah + fr * RT_P + k0_), al = *(const LAS bf16x8*)(Al + fr * RT_P + k0_);
#pragma unroll
              for (int nt = 0; nt < 4; ++nt) { acc[nt] = __builtin_amdgcn_mfma_f32_16x16x32_bf16(ah, bh[kq][nt], acc[nt], 0, 0, 0);
                  acc[nt] = __builtin_amdgcn_mfma_f32_16x16x32_bf16(al, bh[kq][nt], acc[nt], 0, 0, 0); acc[nt] = __builtin_amdgcn_mfma_f32_16x16x32_bf16(ah, bl[kq][nt], acc[nt], 0, 0, 0); } } }
      __syncthreads();
#pragma unroll
      for (int nt = 0; nt < 4; ++nt)
#pragma unroll
          for (int r = 0; r < 4; ++r) red[(w * 16 + fq * 4 + r) * 64 + 16 * nt + fr] = acc[nt][r]; }
    __syncthreads();
#pragma unroll
    for (int i = 0; i < 2; ++i) { const int o = F.tid() + 512 * i; float s = 0.f;
#pragma unroll
        for (int ww = 0; ww < 8; ++ww) s += red[ww * 1024 + o];
        logit[o] = s; }
    __syncthreads();
    PSUB(72, 1); PSUB(73, 0);
    float score_[2]; int erank_[2]; bool sel_[2];
#pragma unroll
    for (int rr = 0; rr < 2; ++rr) { const int rl = 2 * w + rr;
        const float score = sigmoid_f(logit[rl * 64 + lane]); const float biased = score + F.f(18)[lane];
        float m1 = biased;
#pragma unroll
        for (int o = 1; o < 8; o <<= 1) m1 = fmaxf(m1, __shfl_xor(m1, o));
        int i1 = (biased == m1) ? lane : 64;
#pragma unroll
        for (int o = 1; o < 8; o <<= 1) i1 = min(i1, __shfl_xor(i1, o));
        float m2 = (lane == i1) ? -__builtin_inff() : biased;
#pragma unroll
        for (int o = 1; o < 8; o <<= 1) m2 = fmaxf(m2, __shfl_xor(m2, o));
        const float gs = m1 + m2; const int grp = lane >> 3;
        int grank = 0;
#pragma unroll
        for (int g2 = 0; g2 < 8; ++g2) { const float og = __int_as_float(__builtin_amdgcn_readlane(__float_as_int(gs), 8 * g2)); grank += (og > gs || (og == gs && g2 < grp)) ? 1 : 0; }
        const float mk = (grank < 4) ? biased : -__builtin_inff();
        int erank = 0;
#pragma unroll 8
        for (int e2 = 0; e2 < 64; ++e2) { const float oe = __int_as_float(__builtin_amdgcn_readlane(__float_as_int(mk), e2)); erank += (oe > mk || (oe == mk && e2 < lane)) ? 1 : 0; }
        score_[rr] = score; erank_[rr] = erank; sel_[rr] = erank < 8; }
    int lr_[2]; float gw_[2];
#pragma unroll
    for (int rr = 0; rr < 2; ++rr) { const float wsum = wave_sum(sel_[rr] ? score_[rr] : 0.f); gw_[rr] = score_[rr] / wsum * 2.5f;
        lr_[rr] = sel_[rr] ? __hip_atomic_fetch_add(ecnt + lane, 1, __ATOMIC_RELAXED, __HIP_MEMORY_SCOPE_WORKGROUP) : 0; }
    __syncthreads();
    if (w == 0) { const int c = ecnt[lane]; ebase[lane] = c ? (int)__hip_atomic_fetch_add(F.ctl() + CW_ECNT + 64 * lane, (unsigned)c, RLX_AGENT) : 0; }
    __syncthreads();
#pragma unroll
    for (int rr = 0; rr < 2; ++rr) { const int tok = row0 + 2 * w + rr;
        if (sel_[rr]) { const int rk = ebase[lane] + lr_[rr];
            ltok[lane * NTOK + rk] = tok; lw[lane * NTOK + rk] = gw_[rr]; inv[tok * 8 + erank_[rr]] = lane * NTOK + rk; } }
    __syncthreads();
    PSUB(73, 1); PSUB(71, 1);
}
__device__ __forceinline__ void p7_phase(Frame& F) { for (int un = F.bid(); un < NTOK / 16; un += F.G()) p7_unit(F, un); }
struct MoeOrder {
    const LAS int* tab; const int* ltok; int G, c, npn;
    __device__ __forceinline__ bool next(int i, pg8::Unit& u) const {
        const int L = i * G + c; const int total = tab[80 + NEX] * npn; if (L >= total) return false;
        int e = 0;
#pragma unroll
        for (int st = 64; st >= 1; st >>= 1) { const int k = e + st; if (k < NEX && tab[80 + k] * npn <= L) e = k; }
        const int nte = tab[80 + e + 1] - tab[80 + e], rem = L - tab[80 + e] * npn;
        const int mt = (npn == 8) ? rem / npn : rem % nte, pn = (npn == 8) ? rem % npn : rem / nte;
        u.pm = tab[80 + e] + mt; u.pn = e * npn + pn; u.ax = (e << 8) | mt; return true;
    }
    __device__ __forceinline__ int row_tok(const pg8::Unit& u, int r) const {
        const int e = u.ax >> 8, idx = (u.ax & 255) * 256 + r;
        if (e == NE) return idx;
        return idx < tab[e] ? ltok[e * NTOK + idx] : 0;
    }
};
__device__ __forceinline__ void moe_tables(Frame& F) {
    LAS int* tab = (LAS int*)(F.lds() + LDS_MISC + 64);
    if (F.wave() == 0) { const int lane = F.lane();
        const int cn = (int)__hip_atomic_load(F.ctl() + CW_ECNT + 64 * lane, RLX_AGENT); const int nt = (cn + 255) >> 8;
        int inc = nt;
#pragma unroll
        for (int o = 1; o < 64; o <<= 1) { const int t = __shfl_up(inc, o); if (lane >= o) inc += t; }
        tab[lane] = cn; tab[80 + lane] = inc - nt;
        if (lane == 63) { tab[NE] = NTOK; tab[80 + NE] = inc; tab[80 + NEX] = inc + NTOK / 256; } }
    __syncthreads();
}
struct EpiGateUp {
    static constexpr bool PERM = true;
    bf16* hid; const CAS float* lw; const LAS int* tab;
    __device__ __forceinline__ void operator()(const f32x4 (&acc)[2][2][4][2], const pg8::Unit& u, int wr, int wc, int fr, int fq) const {
        const int e = u.ax >> 8, mt = u.ax & 255, pn = u.pn & 3; const int cnt = tab[e];
#pragma unroll
        for (int ai = 0; ai < 2; ++ai)
#pragma unroll
            for (int m = 0; m < 4; ++m) { const int rl = ai * 128 + wr * 64 + m * 16 + fr, idx = mt * 256 + rl;
                const float gw = (e == NE) ? 1.0f : (idx < cnt ? lw[e * NTOK + idx] : 0.0f);
                f32x4 h0, h1;
#pragma unroll
                for (int i = 0; i < 4; ++i) { h0[i] = silu_f(acc[ai][0][m][0][i]) * acc[ai][1][m][0][i] * gw; h1[i] = silu_f(acc[ai][0][m][1][i]) * acc[ai][1][m][1][i] * gw; }
                u32x4 w = {cvt_pk_bf16(h0[0], h0[1]), cvt_pk_bf16(h0[2], h0[3]), cvt_pk_bf16(h1[0], h1[1]), cvt_pk_bf16(h1[2], h1[3])};
                *(u32x4*)(hid + (size_t)(u.pm * 256 + rl) * DE + pn * 128 + wc * 32 + 8 * fq) = w; }
    }
};
constexpr float OUT_SCALE = 32.0f, OUT_INV = 1.0f / 32.0f;
__device__ __forceinline__ unsigned pk4_fp8(f32x4 v) { unsigned w = (unsigned)__builtin_amdgcn_cvt_pk_fp8_f32(v[0] * OUT_SCALE, v[1] * OUT_SCALE, 0, false); return (unsigned)__builtin_amdgcn_cvt_pk_fp8_f32(v[2] * OUT_SCALE, v[3] * OUT_SCALE, (int)w, true); }
struct EpiDown {
    static constexpr bool PERM = true;
    unsigned char* outs;
    __device__ __forceinline__ void operator()(const f32x4 (&acc)[2][2][4][2], const pg8::Unit& u, int wr, int wc, int fr, int fq) const {
        const int pn = u.pn & 7;
#pragma unroll
        for (int ai = 0; ai < 2; ++ai)
#pragma unroll
            for (int m = 0; m < 4; ++m) { unsigned char* rowp = outs + (size_t)(u.pm * 256 + ai * 128 + wr * 64 + m * 16 + fr) * DM + pn * 256 + 64 * wc + 16 * fq;
                const u32x4 w = {pk4_fp8(acc[ai][0][m][0]), pk4_fp8(acc[ai][0][m][1]), pk4_fp8(acc[ai][1][m][0]), pk4_fp8(acc[ai][1][m][1])};
                *(u32x4*)rowp = w; }
    }
};
__device__ __forceinline__ void p10_final(Frame& F) {
    const CAS float* modf = (const CAS float*)(F.ws() + WS_MODF); const CAS unsigned char* outs = (const CAS unsigned char*)(F.ws() + WS_OUTS); const CAS int* inv = (const CAS int*)(F.ws() + WS_INV);
    const LAS int* tab = (const LAS int*)(F.lds() + LDS_MISC + 64);
    const int gw = F.bid() * 8 + F.wave(), NGW = F.G() * 8;
    for (int tok = gw; tok < NTOK; tok += NGW) { int lane = F.lane(); asm volatile("" : "+v"(lane)); const int b = tok / SEQ; const CAS float* g2 = modf + (size_t)b * (6 * DM) + 5 * DM;
        size_t rows[9];
#pragma unroll
        for (int k = 0; k < 8; ++k) { const int iv = inv[tok * 8 + k]; const int e = iv / NTOK, rk = iv % NTOK; rows[k] = (size_t)(tab[80 + e] * 256 + rk); }
        rows[8] = (size_t)(tab[80 + NE] * 256 + tok);
        f32x4 v[8]; float s = 0.f;
#pragma unroll
        for (int jj = 0; jj < 2; ++jj) { const int col = jj * 1024 + lane * 16; f32x4 f[4] = {};
#pragma unroll
            for (int k = 0; k < 9; ++k) { const u32x4 w = *(const CAS u32x4*)(outs + rows[k] * DM + col);
#pragma unroll
                for (int d = 0; d < 4; ++d) { const f32x2 lo = __builtin_amdgcn_cvt_pk_f32_fp8((int)w[d], false), hi = __builtin_amdgcn_cvt_pk_f32_fp8((int)w[d], true);
                    f[d][0] += lo[0]; f[d][1] += lo[1]; f[d][2] += hi[0]; f[d][3] += hi[1]; } }
#pragma unroll
            for (int d = 0; d < 4; ++d) { const f32x4 x1 = *(const f32x4*)(F.out() + (size_t)tok * DM + col + 4 * d);
                v[4 * jj + d] = x1 * ALPHA_DN + *(const CAS f32x4*)(g2 + col + 4 * d) * (f[d] * OUT_INV);
                s += (v[4 * jj + d][0] + v[4 * jj + d][1]) + (v[4 * jj + d][2] + v[4 * jj + d][3]); } }
        const float mu = wave_sum(s) * (1.0f / DM); float q = 0.f;
#pragma unroll
        for (int j = 0; j < 8; ++j) { v[j] = v[j] - mu; q += (v[j][0] * v[j][0] + v[j][1] * v[j][1]) + (v[j][2] * v[j][2] + v[j][3] * v[j][3]); }
        const float rstd = 1.0f / sqrtf(wave_sum(q) * (1.0f / DM) + LN_EPS);
#pragma unroll
        for (int j = 0; j < 8; ++j) { const int col = (j >> 2) * 1024 + lane * 16 + (j & 3) * 4;
            *(f32x4*)(F.out() + (size_t)tok * DM + col) = v[j] * rstd * *(const CAS f32x4*)(F.f(25) + col) + *(const CAS f32x4*)(F.f(26) + col); } }
}
#ifndef MK_N_LAUNCHES
#define MK_N_LAUNCHES 1
#endif
constexpr int N_PHASES = 11;
__global__ void __launch_bounds__(512, 2) fwd_kernel(Args args) {
    Frame F; F.ap = &args;
    if (F.tid() < 16) ((LAS unsigned*)(F.lds() + LDS_MISC))[F.tid()] = 0u;
    __syncthreads();
    if (args.ph_hi - args.ph_lo > 1) (void)xcd_barrier_post((unsigned*)(F.ctl() + CW_BAR), (volatile LAS unsigned*)(F.lds() + LDS_MISC));
#ifndef PH_MASK
#define PH_MASK 0x7ff
#endif
#define IN(k) (((PH_MASK >> (k)) & 1) && args.ph_lo <= (k) && (k) < args.ph_hi)
#ifdef PROBE_PHASE
    unsigned long long pt0_ = __builtin_amdgcn_s_memrealtime(), pt1_ = 0ull;
#ifdef PROBE_SUB
#define PMARK(k) do { } while (0)
#else
#define PMARK(k) do { if ((k) + 1 == PROBE_PHASE) pt0_ = __builtin_amdgcn_s_memrealtime(); if ((k) == PROBE_PHASE) pt1_ = __builtin_amdgcn_s_memrealtime(); } while (0)
#endif
#else
#define PMARK(k) do { } while (0)
#endif
#define SEAM(k) do { if (IN(k) && IN((k) + 1)) { XcdBarrier bar_; bar_.bar = (unsigned*)(F.ctl() + CW_BAR); bar_.x = xb_xcc_id(); bar_.st = (volatile LAS unsigned*)(F.lds() + LDS_MISC); xcd_barrier(bar_); } } while (0)
    if (IN(0)) { p0_prologue(F); } SEAM(0); PMARK(0);
    if (IN(1)) { p1_modulate(F); } SEAM(1); PMARK(1);
    if (IN(2)) {
        pg8::Gemm g{WSP(const bf16, WS_U1), WSP(const bf16, WS_WIN), DM, 20}; pg8::StaticOrder S; S.init(NTOK, NPROJ_PAD, F.G(), F.bid());
        EpiInProj E{F.ws(), F.f(8), F.f(12), F.f(13)};
        pg8::gemm_phase<EpiInProj, pg8::StaticOrder, false>(F.lds(), g, S, E);
        slack_fill(F, (F.bid() + 3 * F.G() < 32 * NPROJ_TILES) ? 0 : 4, false, Q_ALL);
    } SEAM(2); PMARK(2);
    if (IN(3)) {
        PSUB(3, 0); p3_ssd(F); PSUB(3, 1); PSUB(30, 0); p3_idx(F); PSUB(30, 1);
    } SEAM(3); PMARK(3);
    if (IN(4)) { PSUB(40, 0); p4_select(F); PSUB(40, 1); PSUB(41, 0); p4_scan(F); PSUB(41, 1); } SEAM(4); PMARK(4);
    if (IN(5)) { p5_phase(F); slack_fill(F, (F.G() == 256) ? ((F.bid() >> 4) * 5) / 8 : 0, false, Q_ALL); } SEAM(5); PMARK(5);
    if (IN(6)) {
        pg8::Gemm g{WSP(const bf16, WS_YCAT), WSP(const bf16, WS_WOUT), DM, 60}; pg8::StaticOrder S; S.init(NTOK, DM, F.G(), F.bid());
        EpiOutProj E{F.f(0), (const CAS float*)(F.ws() + WS_MODF), F.out()};
        pg8::gemm_phase<EpiOutProj, pg8::StaticOrder, false>(F.lds(), g, S, E);
    } SEAM(6); PMARK(6);
    if (IN(7)) { p7_phase(F); slack_fill(F, 0, true, Q_GU); } SEAM(7); PMARK(7);
    if (IN(8)) {
        const int vcu = (F.G() % 8 == 0) ? (F.bid() % 8) * (F.G() / 8) + F.bid() / 8 : F.bid();
        moe_tables(F);
        const LAS int* tab = (const LAS int*)(F.lds() + LDS_MISC + 64);
        pg8::Gemm g{WSP(const bf16, WS_U2), WSP(const bf16, WS_WGU), DM, 80}; MoeOrder S{tab, WSP(const int, WS_LTOK), F.G(), vcu, 4};
        EpiGateUp E{WSP(bf16, WS_HID), (const CAS float*)(F.ws() + WS_LW), tab};
        pg8::gemm_phase<EpiGateUp, MoeOrder, true>(F.lds(), g, S, E);
        slack_fill(F, 0, true, Q_ALL);
    } SEAM(8); PMARK(8);
    if (IN(9)) {
        const int vcu = (F.G() % 8 == 0) ? (F.bid() % 8) * (F.G() / 8) + F.bid() / 8 : F.bid();
        moe_tables(F);
        const LAS int* tab = (const LAS int*)(F.lds() + LDS_MISC + 64);
        pg8::Gemm g{WSP(const bf16, WS_HID), WSP(const bf16, WS_WDN), DE, 90}; MoeOrder S{tab, WSP(const int, WS_LTOK), F.G(), vcu, 8};
        EpiDown E{F.ws() + WS_OUTS};
        pg8::gemm_phase<EpiDown, MoeOrder, false>(F.lds(), g, S, E);
    } SEAM(9); PMARK(9);
    if (IN(10)) { moe_tables(F); p10_final(F); }
#ifdef PROBE_PHASE
    if (pt1_ == 0ull) pt1_ = __builtin_amdgcn_s_memrealtime();
#ifdef PROBE_SUB
    __syncthreads(); pt0_ = *(volatile LAS unsigned long long*)(F.lds() + LDS_MISC + 32); pt1_ = *(volatile LAS unsigned long long*)(F.lds() + LDS_MISC + 40);
#endif
    if (F.bid() == 0) { const unsigned long long w = 8ull * (pt1_ - pt0_), te = __builtin_amdgcn_s_memrealtime(); while (__builtin_amdgcn_s_memrealtime() - te < w) __builtin_amdgcn_s_sleep(32); }
#endif
#ifdef DBG_OFF
    if (args.ph_hi == N_PHASES) {
        const size_t n = (size_t)NTOK * DM; float* o = F.out();
        for (size_t i = (size_t)F.bid() * 512 + F.tid(); i < n; i += (size_t)F.G() * 512) {
            float v;
            if (DBG_KIND == 0) v = bf2f(((const bf16*)(F.ws() + (size_t)(DBG_OFF)))[i % (size_t)(DBG_N)]);
            else v = ((const float*)(F.ws() + (size_t)(DBG_OFF)))[i % (size_t)(DBG_N)];
            if (!(fabsf(v) < 1e30f)) v = 1e30f;
            o[i] = v; }
    }
#endif
#undef IN
#undef SEAM
#undef PMARK
}

extern "C" void kernel_launch(void* const* d_in, const int* in_sizes, int n_in, void* d_out, int out_size, void* d_ws, size_t ws_size, hipStream_t stream) {
    static int grid = 0;
    if (grid == 0) {
        if (n_in != 27 || out_size != NTOK * DM || ws_size < WS_END) { fprintf(stderr, "kernel_launch: unexpected shapes (n_in %d, out %d, ws %zu; need ws >= %zu)\n", n_in, out_size, ws_size, (size_t)WS_END); }
        int dev = 0, cus = 0, per_cu = 0;
        if (hipGetDevice(&dev) != hipSuccess || hipDeviceGetAttribute(&cus, hipDeviceAttributeMultiprocessorCount, dev) != hipSuccess) { grid = -1; return; }
        if (hipFuncSetAttribute((const void*)fwd_kernel, hipFuncAttributeMaxDynamicSharedMemorySize, LDS_BYTES) != hipSuccess) { fprintf(stderr, "kernel_launch: hipFuncSetAttribute failed\n"); grid = -1; return; }
        if (hipOccupancyMaxActiveBlocksPerMultiprocessor(&per_cu, (const void*)fwd_kernel, 512, LDS_BYTES) != hipSuccess || per_cu < 1) fprintf(stderr, "kernel_launch: occupancy query reports %d\n", per_cu);
        (void)hipGetLastError();
        grid = cus;
    }
    if (grid < 0) return;
    (void)hipMemsetAsync((char*)d_ws + WS_CTL, 0, CTL_ZERO_BYTES, stream);
    Args a{};
    for (int i = 0; i < 27; ++i) a.in[i] = d_in[i];
    a.out = (float*)d_out; a.ws = (unsigned char*)d_ws;
#if MK_N_LAUNCHES == 1
    a.ph_lo = 0; a.ph_hi = N_PHASES;
    hipLaunchKernelGGL(fwd_kernel, dim3(grid), dim3(512), LDS_BYTES, stream, a);
#else
    for (int p = 0; p < N_PHASES; ++p) { a.ph_lo = p; a.ph_hi = p + 1; hipLaunchKernelGGL(fwd_kernel, dim3(grid), dim3(512), LDS_BYTES, stream, a);
#ifdef DUP_PHASE
        if (p == DUP_PHASE) hipLaunchKernelGGL(fwd_kernel, dim3(grid), dim3(512), LDS_BYTES, stream, a);
#endif
    }
#endif
}
```

```cpp
#define MK_N_LAUNCHES 1
#define PH_MASK 0x7ff
#include <hip/hip_runtime.h>
#include <cstdio>
#include <cstdint>

#define GAS __attribute__((address_space(1)))
#define LAS __attribute__((address_space(3)))
#define CAS __attribute__((address_space(4)))
typedef unsigned short bf16;
typedef short bf16x8 __attribute__((ext_vector_type(8)));
typedef short s16x4 __attribute__((ext_vector_type(4)));
typedef float f32x2 __attribute__((ext_vector_type(2)));
typedef float f32x4 __attribute__((ext_vector_type(4)));
typedef float f32x16 __attribute__((ext_vector_type(16)));
typedef unsigned u32x2 __attribute__((ext_vector_type(2)));
typedef unsigned u32x4 __attribute__((ext_vector_type(4)));
typedef GAS unsigned gu32;
#define RLX_AGENT __ATOMIC_RELAXED, __HIP_MEMORY_SCOPE_AGENT
#define LDS_WAIT() asm volatile("s_waitcnt lgkmcnt(0)" ::: "memory")
#define VM_WAIT() asm volatile("s_waitcnt vmcnt(0)" ::: "memory")

constexpr int DM = 2048, NBATCH = 2, SEQ = 4096, NTOK = NBATCH * SEQ;
constexpr int D_SSM = 1024, SSM_H = 16, SSM_P = 64, SSM_N = 128, CONV_CH = 1536, CHUNK = 128, NCHUNK = SEQ / CHUNK;
constexpr int ATT_H = 8, ATT_D = 128, IDX_H = 16, IDX_D = 64, TOPK_SEL = 256;
constexpr int NE = 64, DE = 512, NEX = NE + 1;
constexpr int NPROJ = 6752, NPROJ_PAD = 6912, NPROJ_TILES = 27;
constexpr float ALPHA_DN = 1.189207115002721f;
constexpr float LN_EPS = 1e-5f;
#ifndef MOE_FP8_DN
#define MOE_FP8_DN 1
#endif
#ifndef MOE_FP8
#define MOE_FP8 0
#endif
constexpr float W8_SCALE = 16.0f, U8_SCALE = 16.0f, H8_SCALE = 4.0f;
constexpr int E8_W = 0x7b7b7b7b, E8_U = 0x7b7b7b7b, E8_H = 0x7d7d7d7d;
constexpr int SEG_Z = 0, SEG_XBC = 1024, SEG_DT = 2560, SEG_Q = 2576, SEG_K = 3600, SEG_V = 4624, SEG_QI = 5648, SEG_KI = 6672, SEG_WI = 6736;

constexpr size_t MiB = 1u << 20;
constexpr size_t WS_CTL = 0, CTL_ZERO_BYTES = 1 * MiB;
constexpr size_t WS_MODP = 1 * MiB;
constexpr size_t WS_MODF = 3 * MiB;
constexpr size_t WS_COSA = 4 * MiB, WS_SINA = 6 * MiB;
constexpr size_t WS_COSI = 8 * MiB, WS_SINI = 9 * MiB;
constexpr size_t WS_WR = 10 * MiB;
constexpr size_t WS_KIDX = 11 * MiB;
constexpr size_t WS_WIDX = 12 * MiB;
constexpr size_t WS_DT = 12 * MiB + 512 * 1024;
constexpr size_t WS_CS = 13 * MiB;
constexpr size_t WS_INV = 14 * MiB;
constexpr size_t WS_LTOK = 15 * MiB;
constexpr size_t WS_LW = 17 * MiB;
constexpr size_t WS_MASK = 19 * MiB;
constexpr size_t WS_U2 = 25 * MiB;
constexpr size_t WS_WGU = 57 * MiB;
constexpr size_t WS_WDN = 317 * MiB;
constexpr size_t WS_T = 447 * MiB;
constexpr size_t WS_HID = WS_T;
constexpr size_t WS_OUTS = WS_T + 88 * MiB;
constexpr size_t WS_WIN = WS_T;
constexpr size_t WS_WOUT = WS_T + 27 * MiB;
constexpr size_t WS_U1 = WS_T + 35 * MiB;
constexpr size_t WS_Z = WS_T + 67 * MiB;
constexpr size_t WS_XBC = WS_T + 83 * MiB;
constexpr size_t WS_Q = WS_T + 107 * MiB, WS_K = WS_T + 123 * MiB, WS_V = WS_T + 139 * MiB;
constexpr size_t WS_QIDX = WS_T + 155 * MiB;
constexpr size_t WS_SCORES = WS_T + 171 * MiB;
constexpr size_t WS_STATES = WS_T + 299 * MiB;
constexpr size_t WS_HIN = WS_T + 331 * MiB;
constexpr size_t WS_YDIAG = WS_T + 347 * MiB;
constexpr size_t WS_YCAT = WS_T + 379 * MiB;
constexpr size_t WS_XBCACT = WS_T + 411 * MiB;
constexpr size_t WS_END = WS_T + 440 * MiB;
static_assert(WS_XBCACT + 24 * MiB <= WS_END && WS_OUTS + 352 * MiB <= WS_END, "ws map");
constexpr int MAXPOS = 90112;
constexpr int CW_TMO = 0, CW_BAR = 4096, CW_ECNT = 8192;
constexpr int CW_QHEAD = 16384, CW_DONE = 16448;

constexpr int LDS_MISC = 155648;
constexpr int LDS_BYTES = 157696;

typedef __bf16 bf16x2_t __attribute__((ext_vector_type(2)));
__device__ __forceinline__ unsigned cvt_pk_bf16(float lo, float hi) { const bf16x2_t v = {(__bf16)lo, (__bf16)hi}; return __builtin_bit_cast(unsigned, v); }
__device__ __forceinline__ float bflo(unsigned w) { return __uint_as_float(w << 16); }
__device__ __forceinline__ float bfhi(unsigned w) { return __uint_as_float(w & 0xffff0000u); }
__device__ __forceinline__ float bf2f(bf16 b) { return __uint_as_float((unsigned)b << 16); }
__device__ __forceinline__ bf16 f2bf(float f) { return __builtin_bit_cast(unsigned short, (__bf16)f); }
__device__ __forceinline__ float silu_f(float x) { return x / (1.f + __expf(-x)); }
__device__ __forceinline__ float sigmoid_f(float x) { return 1.f / (1.f + __expf(-x)); }
__device__ __forceinline__ float wave_sum(float v) {
#pragma unroll
    for (int o = 1; o < 64; o <<= 1) v += __shfl_xor(v, o);
    return v;
}
__device__ __forceinline__ bf16x8 pack8(f32x4 a, f32x4 b) {
    u32x4 w = {cvt_pk_bf16(a[0], a[1]), cvt_pk_bf16(a[2], a[3]), cvt_pk_bf16(b[0], b[1]), cvt_pk_bf16(b[2], b[3])};
    return __builtin_bit_cast(bf16x8, w);
}
__device__ __forceinline__ void unpack8(bf16x8 v, float (&o)[8]) {
    u32x4 w = __builtin_bit_cast(u32x4, v);
#pragma unroll
    for (int i = 0; i < 4; ++i) { o[2 * i] = bflo(w[i]); o[2 * i + 1] = bfhi(w[i]); }
}
__device__ __forceinline__ int crow(int r, int hi) { return (r & 3) + 8 * (r >> 2) + 4 * hi; }

__device__ __forceinline__ LAS unsigned char* lds_base() { extern __shared__ __attribute__((aligned(16))) unsigned char lds_raw[]; return (LAS unsigned char*)lds_raw; }
#ifdef PROBE_SUB
#define PSUB(n, w) do { if ((n) == PROBE_SUB && blockIdx.x == 0 && threadIdx.x == 0) *(volatile LAS unsigned long long*)(lds_base() + LDS_MISC + 32 + 8 * (w)) = __builtin_amdgcn_s_memrealtime(); } while (0)
#else
#define PSUB(n, w) do { } while (0)
#endif
#define XB_TMO      128
#define XB_XCNT(j)  (256  + 64 * (j))
#define XB_XSUB(j)  (1280 + 64 * (j))
#define XB_XGEN(j)  (2304 + 64 * (j))
#define XB_TOP      3328
#define XB_TOPGEN   3392
#define XCD_BAR_WORDS 3456
#define XB_SPIN_CAP (1u << 18)

__device__ __forceinline__ unsigned xb_ld(unsigned* p)              { return __hip_atomic_load(p, __ATOMIC_RELAXED, __HIP_MEMORY_SCOPE_AGENT); }
__device__ __forceinline__ unsigned xb_add(unsigned* p, unsigned v) { return __hip_atomic_fetch_add(p, v, __ATOMIC_RELAXED, __HIP_MEMORY_SCOPE_AGENT); }
__device__ __forceinline__ unsigned xb_xcc_id() { return (unsigned)__builtin_amdgcn_s_getreg((3 << 11) | 20) & 0xFu; }
#define XB_SPIN(cond, bar) do { unsigned _sp = 0; while (cond) { __builtin_amdgcn_s_sleep(1); \
    if ((++_sp & 255u) == 0u) { if (xb_ld(&(bar)[XB_TMO])) break; if (_sp > XB_SPIN_CAP) { atomicAdd(&(bar)[XB_TMO], 1u); break; } } } } while (0)

struct XcdBarrier {
    unsigned* bar; unsigned x;
    volatile LAS unsigned* st;
};

__device__ __forceinline__ XcdBarrier xcd_barrier_post(unsigned* bar, volatile LAS unsigned* st) {
    XcdBarrier b; b.bar = bar; b.x = xb_xcc_id(); b.st = st;
    if (threadIdx.x == 0) (void)xb_add(&bar[XB_XCNT(b.x)], 1u);
    return b;
}
__device__ __forceinline__ void xcd_barrier_complete(unsigned* bar, unsigned x, unsigned& nloc, unsigned& nx) {
    const unsigned G = gridDim.x * gridDim.y * gridDim.z;
    unsigned sum, cnt, mine, sp = 0u;
    for (;;) {
        sum = 0u; cnt = 0u; mine = 0u;
#pragma unroll
        for (unsigned j = 0; j < 16; ++j) { const unsigned c = xb_ld(&bar[XB_XCNT(j)]); sum += c; cnt += (c > 0u) ? 1u : 0u; mine = (j == x) ? c : mine; }
        if (sum == G) break;
        __builtin_amdgcn_s_sleep(1);
        if ((++sp & 255u) == 0u) { if (xb_ld(&bar[XB_TMO])) break; if (sp > XB_SPIN_CAP) { atomicAdd(&bar[XB_TMO], 1u); break; } }
    }
    nloc = mine > 0u ? mine : 1u; nx = cnt > 0u ? cnt : 1u;
}

__device__ __forceinline__ void xcd_barrier(const XcdBarrier& b) {
    asm volatile("s_waitcnt vmcnt(0)" ::: "memory");
    __syncthreads();
    if (threadIdx.x == 0) {
        unsigned* bar = b.bar;
        __builtin_amdgcn_s_waitcnt(0);
        unsigned nloc = b.st[0], nx = b.st[1];
        if (nloc == 0u) { xcd_barrier_complete(bar, b.x, nloc, nx); b.st[0] = nloc; b.st[1] = nx; }
        const unsigned old = xb_add(&bar[XB_XSUB(b.x)], 1u);
        const unsigned gen = old / nloc;
        if (old + 1u == (gen + 1u) * nloc) {
            __builtin_amdgcn_fence(__ATOMIC_RELEASE, "agent");
            asm volatile("s_waitcnt vmcnt(0)" ::: "memory");
            const unsigned og = xb_add(&bar[XB_TOP], 1u);
            const unsigned tg = og / nx;
            if (og + 1u == (tg + 1u) * nx) xb_add(&bar[XB_TOPGEN], 1u);
            else XB_SPIN(xb_ld(&bar[XB_TOPGEN]) == tg, bar);
            __builtin_amdgcn_fence(__ATOMIC_ACQUIRE, "agent");
            xb_add(&bar[XB_XGEN(b.x)], 1u);
            asm volatile("s_waitcnt vmcnt(0)" ::: "memory");
        } else {
            XB_SPIN(xb_ld(&bar[XB_XGEN(b.x)]) == gen, bar);
            __builtin_amdgcn_fence(__ATOMIC_ACQUIRE, "agent");
            asm volatile("s_waitcnt vmcnt(0)" ::: "memory");
        }
    }
    __syncthreads();
}

namespace pg8 {
constexpr int BM = 256, BK = 64, HALF = 128, HTB = HALF * BK * 2  , STAGE_BYTES = 8 * HTB, NXCD = 8, WGM = 8;
__host__ __device__ __forceinline__ int lds_byte(int r, int c) { const int st = (r >> 4) * 2 + (c >> 5), rr = r & 15, cc = c & 31, ob = rr * 64 + cc * 2; return st * 1024 + (ob ^ (((ob >> 9) & 1) << 5)); }
__host__ __device__ __forceinline__ void stage_rc(int b, int& R, int& C) { const int st = b / 1024, sb = b % 1024, swz = sb ^ (((sb >> 9) & 1) << 5); R = (st >> 1) * 16 + swz / 64; C = (st & 1) * 32 + (swz % 64) / 2; }
__host__ __device__ __forceinline__ int perm32(int rho) { const int n = rho >> 4, i = rho & 15; return 8 * (i >> 2) + 4 * n + (i & 3); }

struct Unit { int pm, pn, ax; };
struct Gemm { const bf16* A; const bf16* Bt; int K; int pid; int sw, sa; };

struct StaticOrder {
    int nM, nN, nwg, G, c;
    __device__ void init(int M, int N, int G_, int c_) { nM = M / BM; nN = N / BM; nwg = nM * nN; G = G_; c = c_; }
    __device__ __forceinline__ bool next(int i, Unit& u) const {
        const long L = (long)i * G + c; if (L >= nwg) return false;
        int wgid = (int)L; { const int q = nwg / NXCD, r = nwg % NXCD, xcd = wgid % NXCD, off = wgid / NXCD; wgid = (xcd < r ? xcd * (q + 1) : r * (q + 1) + (xcd - r) * q) + off; }
        const int nig = WGM * nN, gid = wgid / nig, fm = gid * WGM, gsz = (nM - fm) < WGM ? (nM - fm) : WGM;
        u.pm = fm + ((wgid % nig) % gsz); u.pn = (wgid % nig) / gsz; u.ax = 0; return true;
    }
    __device__ __forceinline__ int row_tok(const Unit&, int) const { return 0; }
};

typedef int i32x8 __attribute__((ext_vector_type(8)));
typedef int i32x4 __attribute__((ext_vector_type(4)));
template <class Epi, class Sched, bool GATHER, bool F8 = false>
__device__ __forceinline__ void gemm_phase(LAS unsigned char* lds, const Gemm g, const Sched& S, const Epi& E) {
    int tid = threadIdx.x; asm volatile("" : "+v"(tid));
    const int wid = __builtin_amdgcn_readfirstlane(tid >> 6), lane = tid & 63, wr = wid >> 2, wc = wid & 3, fr = lane & 15, fq = lane >> 4;
    const int K = g.K, nt = K / BK;
    unsigned voffB0[2];
#pragma unroll
    for (int i = 0; i < 2; ++i) { int R, C; stage_rc(tid * 16 + i * 8192, R, C); const int Rb = Epi::PERM ? ((R & ~31) + perm32(R & 31)) : R;
        voffB0[i] = (unsigned)(Rb * K + C) * 2u; }
    *(LAS u32x2*)(lds + STAGE_BYTES + 16384 + tid * 8) = (u32x2){voffB0[0], voffB0[1]};
    const unsigned kstep = (unsigned)(BK * 2);
    const unsigned hstep = (unsigned)(HALF * K * 2);
    const unsigned tstep = 2 * hstep;
    const char* const pA = (const char*)g.A; const char* const pB = (const char*)g.Bt;
    const unsigned ldsw = (unsigned)wid * 1024u;
    const int aoff = lds_byte(wr * 64 + fr, fq * 8), boff = lds_byte(wc * 32 + fr, fq * 8);
#define PG8_SA(b, h) (((b) * 2 + (h)) * HTB)
#define PG8_SB(b, h) ((4 + (b) * 2 + (h)) * HTB)
#define PG8_STAGE(bufoff, gbase, soff, voff) do { _Pragma("unroll") for (int _i = 0; _i < 2; ++_i) \
        __builtin_amdgcn_global_load_lds((const unsigned*)((const char*)(gbase) + (unsigned)((soff) + (voff)[_i])), (LAS unsigned*)(lds + (bufoff) + ldsw + _i * 8192), 16, 0, 0); } while (0)
#define PG8_LD8(base) __builtin_shufflevector(*(const LAS i32x4*)(base), *(const LAS i32x4*)((base) + 1024), 0, 1, 2, 3, 4, 5, 6, 7)
#define PG8_LDA(dst, b, h) do { _Pragma("unroll") for (int m = 0; m < 4; ++m) dst[m] = PG8_LD8(lds + PG8_SA(b, h) + aoff + m * 2048); } while (0)
#define PG8_LDB(dst, b, h) do { _Pragma("unroll") for (int n = 0; n < 2; ++n) dst[n] = PG8_LD8(lds + PG8_SB(b, h) + boff + n * 2048); } while (0)
#define PG8_H0(x) __builtin_bit_cast(bf16x8, __builtin_shufflevector(x, x, 0, 1, 2, 3))
#define PG8_H1(x) __builtin_bit_cast(bf16x8, __builtin_shufflevector(x, x, 4, 5, 6, 7))
#define PG8_MMA(ai, bj, At, Bt) do { __builtin_amdgcn_s_setprio(1); _Pragma("unroll") for (int m = 0; m < 4; ++m) _Pragma("unroll") for (int n = 0; n < 2; ++n) { \
        if constexpr (F8) acc[ai][bj][m][n] = __builtin_amdgcn_mfma_scale_f32_16x16x128_f8f6f4(Bt[n], At[m], acc[ai][bj][m][n], 0, 0, 0, g.sw, 0, g.sa); \
        else { acc[ai][bj][m][n] = __builtin_amdgcn_mfma_f32_16x16x32_bf16(PG8_H0(Bt[n]), PG8_H0(At[m]), acc[ai][bj][m][n], 0, 0, 0); \
               acc[ai][bj][m][n] = __builtin_amdgcn_mfma_f32_16x16x32_bf16(PG8_H1(Bt[n]), PG8_H1(At[m]), acc[ai][bj][m][n], 0, 0, 0); } } \
        __builtin_amdgcn_s_setprio(0); } while (0)
#define PG8_WAIT_V(n) asm volatile("s_waitcnt vmcnt(" #n ")" ::: "memory")
#define PG8_WAIT_L(n) asm volatile("s_waitcnt lgkmcnt(" #n ")" ::: "memory")
#define PG8_BAR __builtin_amdgcn_s_barrier()
#define PG8_SCHED __builtin_amdgcn_sched_barrier(0)
#define PG8_SET_OA(o, u) do { int _tz = threadIdx.x; asm volatile("" : "+v"(_tz)); _Pragma("unroll") for (int _i = 0; _i < 2; ++_i) { int _R, _C; stage_rc(_tz * 16 + _i * 8192, _R, _C); \
        _Pragma("unroll") for (int _h = 0; _h < 2; ++_h) { \
        if constexpr (GATHER) o[_h][_i] = (unsigned)S.row_tok(u, _h * HALF + _R) * (unsigned)(K * 2) + (unsigned)_C * 2u; \
        else o[_h][_i] = (unsigned)_h * hstep + (unsigned)(_R * K * 2) + (unsigned)_C * 2u; } } } while (0)
    Unit cur, nxt; int ui = 0;
    if (!S.next(0, cur)) return;
    f32x4 acc[2][2][4][2];
#pragma unroll
    for (int a = 0; a < 2; ++a)
#pragma unroll
        for (int b = 0; b < 2; ++b)
#pragma unroll
            for (int m = 0; m < 4; ++m)
#pragma unroll
                for (int n = 0; n < 2; ++n) acc[a][b][m][n] = (f32x4){0.f, 0.f, 0.f, 0.f};
    i32x8 At[4], B0[2], B1[2];
    LAS u32x4* const oslot = (LAS u32x4*)(lds + STAGE_BYTES) + tid;
    unsigned oAc[2][2];
    PG8_SET_OA(oAc, cur);
    oslot[0] = (u32x4){oAc[0][0], oAc[0][1], oAc[1][0], oAc[1][1]};
    unsigned cA = GATHER ? 0u : (unsigned)cur.pm * tstep; unsigned cB = (unsigned)cur.pn * tstep;
    PG8_STAGE(PG8_SB(0, 0), pB, cB, voffB0); PG8_STAGE(PG8_SB(0, 1), pB, cB + hstep, voffB0); PG8_STAGE(PG8_SA(0, 0), pA, cA, oAc[0]); PG8_STAGE(PG8_SA(0, 1), pA, cA, oAc[1]);
    if (wr == 1) PG8_BAR;
    PG8_WAIT_V(2); PG8_BAR;
    PG8_STAGE(PG8_SB(1, 0), pB, cB + kstep, voffB0); PG8_STAGE(PG8_SA(1, 0), pA, cA + kstep, oAc[0]); PG8_STAGE(PG8_SB(1, 1), pB, cB + hstep + kstep, voffB0);
    PG8_WAIT_V(6); PG8_BAR;
    for (;;) {
        const bool has_next = S.next(ui + 1, nxt);
        const unsigned nA = has_next ? (GATHER ? 0u : (unsigned)nxt.pm * tstep) : cA; const unsigned nB = has_next ? (unsigned)nxt.pn * tstep : cB;
        if constexpr (GATHER) {
            unsigned on[2][2];
            if (has_next) { PG8_SET_OA(on, nxt); oslot[512] = (u32x4){on[0][0], on[0][1], on[1][0], on[1][1]}; }
            else oslot[512] = oslot[0];
        }
        PSUB(g.pid * 10, 0); PSUB(g.pid * 10 + 2, 0);
#pragma unroll 1
        for (int t = 0; t < nt; t += 2) {
            const bool last = (t == nt - 2);
            const unsigned a1 = cA + (unsigned)(t + 1) * kstep;
            const unsigned a2 = last ? nA : cA + (unsigned)(t + 2) * kstep; const unsigned b2 = last ? nB : cB + (unsigned)(t + 2) * kstep;
            const unsigned a3 = a2 + kstep; const unsigned b3 = b2 + kstep;
            const u32x4 oc = oslot[0]; const u32x4 on = (GATHER && last) ? oslot[512] : oc;
            const u32x2 vb_ = *(const LAS u32x2*)(lds + STAGE_BYTES + 16384 + tid * 8); const unsigned voffB[2] = {vb_[0], vb_[1]};
            const unsigned o1[2] = {oc[2], oc[3]}; const unsigned o20[2] = {on[0], on[1]}, o21[2] = {on[2], on[3]};
            PG8_LDB(B0, 0, 0); PG8_LDB(B1, 0, 1); PG8_SCHED; PG8_LDA(At, 0, 0); PG8_STAGE(PG8_SA(1, 1), pA, a1, o1);
            PG8_WAIT_V(8); PG8_WAIT_L(0); PG8_BAR; PG8_MMA(0, 0, At, B0); PG8_MMA(0, 1, At, B1); PG8_BAR; PG8_SCHED;
            PG8_LDA(At, 0, 1); PG8_STAGE(PG8_SB(0, 0), pB, b2, voffB); PG8_STAGE(PG8_SB(0, 1), pB, b2 + hstep, voffB); PG8_STAGE(PG8_SA(0, 0), pA, a2, o20);
            PG8_WAIT_V(8); PG8_WAIT_L(0); PG8_BAR; PG8_MMA(1, 0, At, B0); PG8_MMA(1, 1, At, B1); PG8_BAR; PG8_SCHED;
            PG8_LDB(B0, 1, 0); PG8_LDB(B1, 1, 1); PG8_SCHED; PG8_LDA(At, 1, 0); PG8_STAGE(PG8_SA(0, 1), pA, a2, o21);
            PG8_WAIT_V(8); PG8_WAIT_L(0); PG8_BAR; PG8_MMA(0, 0, At, B0); PG8_MMA(0, 1, At, B1); PG8_BAR; PG8_SCHED;
            PG8_LDA(At, 1, 1); PG8_STAGE(PG8_SB(1, 0), pB, b3, voffB); PG8_STAGE(PG8_SB(1, 1), pB, b3 + hstep, voffB); PG8_STAGE(PG8_SA(1, 0), pA, a3, o20);
            PG8_WAIT_V(8); PG8_WAIT_L(0); PG8_BAR; PG8_MMA(1, 0, At, B0); PG8_MMA(1, 1, At, B1); PG8_BAR; PG8_SCHED;
        }
        PSUB(g.pid * 10, 1); PSUB(g.pid * 10 + 1, 0);
        if (wr == 0) PG8_BAR;
        { int tz = threadIdx.x; asm volatile("" : "+v"(tz));
          const int wid_ = __builtin_amdgcn_readfirstlane(tz >> 6), fr_ = tz & 15, fq_ = (tz & 63) >> 4, wr_ = wid_ >> 2, wc_ = wid_ & 3;
          E(acc, cur, wr_, wc_, fr_, fq_); }
        PSUB(g.pid * 10 + 1, 1); PSUB(g.pid * 10 + 2, 1);
        if (!has_next) break;
#pragma unroll
        for (int a = 0; a < 2; ++a)
#pragma unroll
            for (int b = 0; b < 2; ++b)
#pragma unroll
                for (int m = 0; m < 4; ++m)
#pragma unroll
                    for (int n = 0; n < 2; ++n) acc[a][b][m][n] = (f32x4){0.f, 0.f, 0.f, 0.f};
        cur = nxt; cA = nA; cB = nB; ++ui;
        if constexpr (GATHER) oslot[0] = oslot[512];
        if (wr == 1) PG8_BAR;
    }
    PG8_WAIT_V(0);
    PG8_BAR;
#undef PG8_SA
#undef PG8_SB
#undef PG8_STAGE
#undef PG8_LDA
#undef PG8_LDB
#undef PG8_MMA
#undef PG8_LD8
#undef PG8_H0
#undef PG8_H1
#undef PG8_WAIT_V
#undef PG8_WAIT_L
#undef PG8_BAR
#undef PG8_SCHED
#undef PG8_SET_OA
}
}
struct Args { const void* in[27]; float* out; unsigned char* ws; int ph_lo, ph_hi; };
struct Frame {
    const Args* ap;
    __device__ __forceinline__ LAS unsigned char* lds() const { extern __shared__ __attribute__((aligned(16))) unsigned char lds_raw[]; return (LAS unsigned char*)lds_raw; }
    __device__ __forceinline__ unsigned char* ws() const { return ap->ws; }
    __device__ __forceinline__ gu32* ctl() const { return (gu32*)(ap->ws + WS_CTL); }
    __device__ __forceinline__ float* out() const { return ap->out; }
    __device__ __forceinline__ int tid() const { return (int)threadIdx.x; }
    __device__ __forceinline__ int lane() const { return (int)threadIdx.x & 63; }
    __device__ __forceinline__ int wave() const { return __builtin_amdgcn_readfirstlane((int)threadIdx.x >> 6); }
    __device__ __forceinline__ int G() const { return (int)gridDim.x; }
    __device__ __forceinline__ int bid() const { return (int)blockIdx.x; }
    __device__ __forceinline__ const CAS float* f(int i) const { return (const CAS float*)ap->in[i]; }
    __device__ __forceinline__ const CAS int* i32(int i) const { return (const CAS int*)ap->in[i]; }
};
#define WSP(T, off) ((T*)(F.ws() + (off)))

__device__ __forceinline__ int inproj_src_col(int P) {
    const int tile = P >> 8, within = P & 255, bj = within >> 7, w = within & 127;
    if (tile < 4) return SEG_Z + tile * 256 + within;
    if (tile < 10) return SEG_XBC + (tile - 4) * 256 + within;
    if (tile < 14) return SEG_Q + (2 * (tile - 10) + (w >> 6)) * 128 + (w & 63) + 64 * bj;
    if (tile < 18) return SEG_K + (2 * (tile - 14) + (w >> 6)) * 128 + (w & 63) + 64 * bj;
    if (tile < 22) return SEG_V + (tile - 18) * 256 + within;
    if (tile < 26) return SEG_QI + (4 * (tile - 22) + (w >> 5)) * 64 + (w & 31) + 32 * bj;
    if (bj == 0) { if (w < 32) return SEG_KI + w; if (w < 48) return SEG_WI + (w - 32); if (w < 64) return SEG_DT + (w - 48); return -1; }
    if (w < 32) return SEG_KI + 32 + w;
    return -1;
}
struct TrD { const CAS float* q; bf16* dst; int ld, K; bool valid, live, f8; };
__device__ __forceinline__ void tr_load(const TrD& t, f32x4 (&v)[16]) {
#pragma unroll
    for (int i = 0; i < 16; ++i) v[i] = (t.valid && t.live) ? *(const CAS f32x4*)(t.q + (size_t)(4 * i) * t.ld) : (f32x4){0.f, 0.f, 0.f, 0.f};
}
__device__ __forceinline__ void tr_fin(const TrD& t, const f32x4 (&v)[16], LAS float* scr, int lane) {
#pragma unroll
    for (int i = 0; i < 16; ++i) { LAS float* s = scr + ((lane >> 4) + 4 * i) * 65 + 4 * (lane & 15); s[0] = v[i][0]; s[1] = v[i][1]; s[2] = v[i][2]; s[3] = v[i][3]; }
    LDS_WAIT(); asm volatile("" ::: "memory");
    const int c = lane & 7;
    if (t.live) {
        if (t.f8) {
#pragma unroll
            for (int jj = 0; jj < 8; ++jj) { const int n = (lane >> 3) + 8 * jj; const LAS float* s = scr + (8 * c) * 65 + n;
                unsigned lo = (unsigned)__builtin_amdgcn_cvt_pk_fp8_f32(s[0] * W8_SCALE, s[65] * W8_SCALE, 0, false); lo = (unsigned)__builtin_amdgcn_cvt_pk_fp8_f32(s[2 * 65] * W8_SCALE, s[3 * 65] * W8_SCALE, (int)lo, true);
                unsigned hi = (unsigned)__builtin_amdgcn_cvt_pk_fp8_f32(s[4 * 65] * W8_SCALE, s[5 * 65] * W8_SCALE, 0, false); hi = (unsigned)__builtin_amdgcn_cvt_pk_fp8_f32(s[6 * 65] * W8_SCALE, s[7 * 65] * W8_SCALE, (int)hi, true);
                *(u32x2*)((unsigned char*)t.dst + (size_t)n * t.K + 8 * c) = (u32x2){lo, hi}; }
        } else {
#pragma unroll
            for (int jj = 0; jj < 8; ++jj) { const int n = (lane >> 3) + 8 * jj; const LAS float* s = scr + (8 * c) * 65 + n;
                u32x4 o; o.x = cvt_pk_bf16(s[0], s[65]); o.y = cvt_pk_bf16(s[2 * 65], s[3 * 65]); o.z = cvt_pk_bf16(s[4 * 65], s[5 * 65]); o.w = cvt_pk_bf16(s[6 * 65], s[7 * 65]);
                *(u32x4*)(t.dst + (size_t)n * t.K + 8 * c) = o; } } }
    LDS_WAIT(); asm volatile("" ::: "memory");
}
constexpr int I_IN = 32 * 108, I_OUT = 32 * 32, I_GU = NEX * 32 * 16, I_DN = NEX * 8 * 32, I_TR = I_IN + I_OUT + I_GU + I_DN;
__device__ __forceinline__ TrD tr_desc(Frame& F, int it, bool live) {
    const int lane = F.lane(), kr = lane >> 4, nq = 4 * (lane & 15); TrD t; t.live = live; t.valid = true; t.f8 = false;
    if (!live) it = 0;
    if (it < I_IN) { const int kb = it / 108, nb = it % 108, k0 = 64 * kb, n0 = 64 * nb; const int sc = inproj_src_col(n0 + nq);
        t.q = F.f(5) + (size_t)(k0 + kr) * NPROJ + (sc < 0 ? 0 : sc); t.valid = sc >= 0; t.ld = NPROJ; t.dst = WSP(bf16, WS_WIN) + (size_t)n0 * DM + k0; t.K = DM; return t; }
    it -= I_IN;
    if (it < I_OUT) { const int kb = it >> 5, nb = it & 31, k0 = 64 * kb, n0 = 64 * nb;
        t.q = F.f(14) + (size_t)(k0 + kr) * DM + n0 + nq; t.ld = DM; t.dst = WSP(bf16, WS_WOUT) + (size_t)n0 * DM + k0; t.K = DM; return t; }
    it -= I_OUT;
    if (it < I_GU) { const int e = it >> 9, r = it & 511, kb = r >> 4, nb = r & 15, k0 = 64 * kb;
        const int p = nb >> 2, bj = (nb >> 1) & 1, w0 = (nb & 1) * 64;
        const CAS float* src = (e < NE) ? ((bj ? F.f(20) : F.f(19)) + (size_t)e * DM * DE) : (bj ? F.f(23) : F.f(22));
        t.q = src + (size_t)(k0 + kr) * DE + 128 * p + w0 + nq; t.ld = DE; t.dst = (bf16*)(F.ws() + WS_WGU + ((size_t)e * 1024 + 64 * nb) * DM + k0); t.K = DM; t.f8 = MOE_FP8; if (!MOE_FP8) t.dst = WSP(bf16, WS_WGU) + ((size_t)e * 1024 + 64 * nb) * DM + k0; return t; }
    it -= I_GU;
    { const int e = it >> 8, r = it & 255, kb = r >> 5, nb = r & 31, k0 = 64 * kb, n0 = 64 * nb;
        const CAS float* src = (e < NE) ? (F.f(21) + (size_t)e * DE * DM) : F.f(24);
        const int P = n0 + nq, p = P & 255, cl = 64 * ((p >> 5) & 3) + 16 * ((p >> 3) & 3) + 8 * (p >> 7) + 4 * ((p >> 2) & 1);
        t.q = src + (size_t)(k0 + kr) * DM + (P & ~255) + cl; t.ld = DM; t.dst = (bf16*)(F.ws() + WS_WDN + ((size_t)e * DM + n0) * DE + k0); t.K = DE; t.f8 = MOE_FP8_DN; if (!MOE_FP8_DN) t.dst = WSP(bf16, WS_WDN) + ((size_t)e * DM + n0) * DE + k0; return t; }
}
__device__ __forceinline__ void tr_item(Frame& F, int it, LAS float* scr) { f32x4 v[16]; const TrD t = tr_desc(F, it, true); tr_load(t, v); tr_fin(t, v, scr, F.lane()); }
__device__ __forceinline__ void tr_items4(Frame& F, int it0, int stride, int lim, LAS float* scr) {
    f32x4 va[16], vb[16]; const int lane = F.lane();
    TrD t0 = tr_desc(F, it0, it0 < lim); tr_load(t0, va);
    TrD t1 = tr_desc(F, it0 + stride, it0 + stride < lim); tr_load(t1, vb);
    tr_fin(t0, va, scr, lane);
    t0 = tr_desc(F, it0 + 2 * stride, it0 + 2 * stride < lim); tr_load(t0, va);
    tr_fin(t1, vb, scr, lane);
    t1 = tr_desc(F, it0 + 3 * stride, it0 + 3 * stride < lim); tr_load(t1, vb);
    tr_fin(t0, va, scr, lane);
    tr_fin(t1, vb, scr, lane);
}
__device__ __forceinline__ void p0_prologue(Frame& F) {
    const int gw = F.bid() * 8 + F.wave(), NGW = F.G() * 8, gt = F.bid() * 512 + F.tid(), NGT = F.G() * 512;
    PSUB(1, 0);
    {
        LAS float* red = (LAS float*)F.lds();
        float* modp = WSP(float, WS_MODP);
        for (int item = F.bid(); item < 48 * 16; item += F.G()) {
            const int cc = item % 48, ks = item / 48;
            f32x4 a0 = {0.f, 0.f, 0.f, 0.f}, a1 = {0.f, 0.f, 0.f, 0.f};
            const int kbase = ks * 128 + F.wave() * 16;
#pragma unroll 4
            for (int i = 0; i < 16; ++i) { const int k = kbase + i;
                const float c0 = silu_f(F.f(1)[k]), c1 = silu_f(F.f(1)[DM + k]);
                const f32x4 wv = *(const CAS f32x4*)(F.f(3) + (size_t)k * (6 * DM) + cc * 256 + F.lane() * 4);
                a0 += wv * c0; a1 += wv * c1; }
            *(LAS f32x4*)(red + (F.wave() * 2 + 0) * 256 + F.lane() * 4) = a0;
            *(LAS f32x4*)(red + (F.wave() * 2 + 1) * 256 + F.lane() * 4) = a1;
            __syncthreads();
            { const int b = F.tid() >> 8, col = F.tid() & 255; float s = 0.f;
#pragma unroll
              for (int w = 0; w < 8; ++w) s += red[(w * 2 + b) * 256 + col];
              modp[((size_t)ks * 2 + b) * (6 * DM) + cc * 256 + col] = s; }
            __syncthreads();
        }
    }
    PSUB(1, 1); PSUB(2, 0);
    {
        float* cosA = WSP(float, WS_COSA); float* sinA = WSP(float, WS_SINA); float* cosI = WSP(float, WS_COSI); float* sinI = WSP(float, WS_SINI);
        for (int i = gt; i < NTOK * 64; i += NGT) { const int tok = i >> 6, j = i & 63;
            const float inv = 1.0f / powf(10000.0f, (float)(2 * j) / 128.0f); const float ang = (float)F.i32(2)[tok] * inv;
            float s, c; sincosf(ang, &s, &c); cosA[i] = c; sinA[i] = s; }
        for (int i = gt; i < NTOK * 32; i += NGT) { const int tok = i >> 5, j = i & 31;
            const float inv = 1.0f / powf(10000.0f, (float)(2 * j) / 64.0f); const float ang = (float)F.i32(2)[tok] * inv;
            float s, c; sincosf(ang, &s, &c); cosI[i] = c; sinI[i] = s; }
    }
    PSUB(2, 1); PSUB(4, 0);
    {
        bf16* wr_hi = WSP(bf16, WS_WR); bf16* wr_lo = wr_hi + NE * DM;
        for (int i = gt; i < NE * (DM / 8); i += NGT) { const int e = i & 63, kc = i >> 6;
            float v[8], l[8];
#pragma unroll
            for (int j = 0; j < 8; ++j) { v[j] = F.f(17)[(size_t)(8 * kc + j) * NE + e]; l[j] = v[j] - bf2f(f2bf(v[j])); }
            u32x4 h = {cvt_pk_bf16(v[0], v[1]), cvt_pk_bf16(v[2], v[3]), cvt_pk_bf16(v[4], v[5]), cvt_pk_bf16(v[6], v[7])};
            u32x4 lo = {cvt_pk_bf16(l[0], l[1]), cvt_pk_bf16(l[2], l[3]), cvt_pk_bf16(l[4], l[5]), cvt_pk_bf16(l[6], l[7])};
            *(u32x4*)(wr_hi + (size_t)e * DM + 8 * kc) = h; *(u32x4*)(wr_lo + (size_t)e * DM + 8 * kc) = lo; }
    }
    PSUB(4, 1); PSUB(5, 0);
    {
        LAS float* scr = (LAS float*)(F.lds() + F.wave() * 16640);
        for (int it = gw; it < I_IN + I_OUT; it += NGW) tr_item(F, it, scr);
    }
    PSUB(5, 1);
}

constexpr int Q_GU = I_GU, Q_ALL = I_GU + I_DN, Q_GRAB = 32;
__device__ __forceinline__ void slack_fill(Frame& F, int budget, bool drain, int upto) {
    LAS float* scr = (LAS float*)(F.lds() + F.wave() * 16640);
    volatile LAS int* qw = (volatile LAS int*)(F.lds() + LDS_MISC + 16);
    __syncthreads();
    for (int gi = 0; drain || gi < budget; ++gi) {
        if (F.tid() == 0) { int stop = 0;
            const int idx = (int)__hip_atomic_fetch_add(F.ctl() + CW_QHEAD, (unsigned)Q_GRAB, RLX_AGENT); if (idx >= Q_ALL) stop = 1; else if (idx >= upto) stop = 2;
            qw[0] = stop; qw[1] = idx; }
        __syncthreads();
        const int stop = qw[0], idx = qw[1];
        __syncthreads();
        if (stop == 1) break;
        tr_items4(F, I_IN + I_OUT + idx + F.wave(), 8, I_IN + I_OUT + Q_ALL, scr);
        if (stop == 2) break;
    }
}

__device__ __forceinline__ void p1_modulate(Frame& F) {
    const float* modp = WSP(const float, WS_MODP); float* modf = WSP(float, WS_MODF); bf16* u1 = WSP(bf16, WS_U1);
    LAS float* sh = (LAS float*)F.lds(); LAS float* sc = sh + DM;
    for (int rg = F.bid(); rg < 256; rg += F.G()) {
        const int b = rg >> 7;
        if (F.tid() < 96) { const int v = rg * 96 + F.tid(); const int bb = v / (6 * DM), col = v % (6 * DM); float s = F.f(4)[col];
#pragma unroll
            for (int ks = 0; ks < 16; ++ks) s += modp[((size_t)ks * 2 + bb) * (6 * DM) + col];
            modf[v] = s; }
        { const int col = F.tid() * 4; f32x4 s0 = *(const CAS f32x4*)(F.f(4) + col), s1 = *(const CAS f32x4*)(F.f(4) + DM + col);
#pragma unroll
          for (int ks = 0; ks < 16; ++ks) { const float* p = modp + ((size_t)ks * 2 + b) * (6 * DM); s0 += *(const f32x4*)(p + col); s1 += *(const f32x4*)(p + DM + col); }
          *(LAS f32x4*)(sh + col) = s0; *(LAS f32x4*)(sc + col) = s1; }
        __syncthreads();
#pragma unroll
        for (int rr = 0; rr < 4; ++rr) { const int row = rg * 32 + F.wave() * 4 + rr;
#pragma unroll
            for (int j = 0; j < 8; ++j) { const int col = j * 256 + F.lane() * 4;
                const f32x4 xv = *(const CAS f32x4*)(F.f(0) + (size_t)row * DM + col); const f32x4 s0 = *(const LAS f32x4*)(sh + col), s1 = *(const LAS f32x4*)(sc + col);
                const f32x4 u = xv * (s1 + 1.0f) + s0;
                u32x2 o = {cvt_pk_bf16(u[0], u[1]), cvt_pk_bf16(u[2], u[3])};
                *(u32x2*)(u1 + (size_t)row * DM + col) = o; } }
        __syncthreads();
    }
}
struct EpiInProj {
    static constexpr bool PERM = true;
    unsigned char* ws; const CAS float *dt_bias, *lng, *lnb;
    __device__ __forceinline__ void operator()(const f32x4 (&acc)[2][2][4][2], const pg8::Unit& u, int wr, int wc, int fr, int fq) const {
        const int pn = u.pn; const int row0 = u.pm * 256 + wr * 64 + fr;
        if (pn < 10 || (pn >= 18 && pn < 22)) {
            size_t boff; int ld, col0;
            if (pn < 4) { boff = WS_Z; ld = 1024; col0 = pn * 256; } else if (pn < 10) { boff = WS_XBC; ld = CONV_CH; col0 = (pn - 4) * 256; } else { boff = WS_V; ld = 1024; col0 = (pn - 18) * 256; }
            bf16* base = (bf16*)(ws + boff);
            col0 += wc * 32 + 8 * fq;
#pragma unroll
            for (int ai = 0; ai < 2; ++ai)
#pragma unroll
                for (int m = 0; m < 4; ++m) { bf16* rowp = base + (size_t)(row0 + ai * 128 + m * 16) * ld + col0;
#pragma unroll
                    for (int bj = 0; bj < 2; ++bj) { const f32x4 v0 = acc[ai][bj][m][0], v1 = acc[ai][bj][m][1];
                        u32x4 w = {cvt_pk_bf16(v0[0], v0[1]), cvt_pk_bf16(v0[2], v0[3]), cvt_pk_bf16(v1[0], v1[1]), cvt_pk_bf16(v1[2], v1[3])};
                        *(u32x4*)(rowp + bj * 128) = w; } }
        } else if (pn < 26) {
            const bool att = pn < 18; const bool isq = pn < 14;
            bf16* base = (bf16*)(ws + (att ? (isq ? WS_Q : WS_K) : WS_QIDX)); const CAS float* ct = (const CAS float*)(ws + (att ? WS_COSA : WS_COSI)); const CAS float* sn = (const CAS float*)(ws + (att ? WS_SINA : WS_SINI));
            const int tw = att ? 64 : 32;
            const int head = att ? 2 * (pn - (isq ? 10 : 14)) + (wc >> 1) : 4 * (pn - 22) + wc, jj0 = att ? 32 * (wc & 1) + 8 * fq : 8 * fq;
#pragma unroll
            for (int ai = 0; ai < 2; ++ai)
#pragma unroll
                for (int m = 0; m < 4; ++m) { const int row = row0 + ai * 128 + m * 16;
                    bf16* rowp = base + (size_t)row * 1024 + head * (2 * tw) + jj0;
#pragma unroll
                    for (int n = 0; n < 2; ++n) { const f32x4 c = *(const CAS f32x4*)(ct + (size_t)row * tw + jj0 + 4 * n), sv = *(const CAS f32x4*)(sn + (size_t)row * tw + jj0 + 4 * n);
                        const f32x4 a = acc[ai][0][m][n], bb = acc[ai][1][m][n];
                        const f32x4 o1 = a * c - bb * sv, o2 = bb * c + a * sv;
                        *(u32x2*)(rowp + 4 * n) = (u32x2){cvt_pk_bf16(o1[0], o1[1]), cvt_pk_bf16(o1[2], o1[3])};
                        *(u32x2*)(rowp + tw + 4 * n) = (u32x2){cvt_pk_bf16(o2[0], o2[1]), cvt_pk_bf16(o2[2], o2[3])}; } }
        } else {
            const CAS float* cosI = (const CAS float*)(ws + WS_COSI); const CAS float* sinI = (const CAS float*)(ws + WS_SINI); bf16* kidx = (bf16*)(ws + WS_KIDX); float* widx = (float*)(ws + WS_WIDX); float* dt = (float*)(ws + WS_DT);
            if (wc == 0) {
                const int jj0 = 8 * fq;
#pragma unroll
                for (int am = 0; am < 8; ++am) { const int ai = am >> 2, m = am & 3; const int row = row0 + ai * 128 + m * 16;
                        f32x4 a0 = acc[ai][0][m][0], a1 = acc[ai][0][m][1], b0 = acc[ai][1][m][0], b1 = acc[ai][1][m][1];
                        float s = (a0[0] + a0[1] + a0[2] + a0[3]) + (a1[0] + a1[1] + a1[2] + a1[3]) + (b0[0] + b0[1] + b0[2] + b0[3]) + (b1[0] + b1[1] + b1[2] + b1[3]);
                        s += __shfl_xor(s, 16); s += __shfl_xor(s, 32);
                        const float mu = s * (1.0f / 64.0f);
                        a0 = a0 - mu; a1 = a1 - mu; b0 = b0 - mu; b1 = b1 - mu;
                        float qv = (a0[0] * a0[0] + a0[1] * a0[1] + a0[2] * a0[2] + a0[3] * a0[3]) + (a1[0] * a1[0] + a1[1] * a1[1] + a1[2] * a1[2] + a1[3] * a1[3])
                                 + (b0[0] * b0[0] + b0[1] * b0[1] + b0[2] * b0[2] + b0[3] * b0[3]) + (b1[0] * b1[0] + b1[1] * b1[1] + b1[2] * b1[2] + b1[3] * b1[3]);
                        qv += __shfl_xor(qv, 16); qv += __shfl_xor(qv, 32);
                        const float rstd = 1.0f / sqrtf(qv * (1.0f / 64.0f) + LN_EPS);
                        a0 = a0 * rstd * *(const CAS f32x4*)(lng + jj0) + *(const CAS f32x4*)(lnb + jj0); a1 = a1 * rstd * *(const CAS f32x4*)(lng + jj0 + 4) + *(const CAS f32x4*)(lnb + jj0 + 4);
                        b0 = b0 * rstd * *(const CAS f32x4*)(lng + 32 + jj0) + *(const CAS f32x4*)(lnb + 32 + jj0); b1 = b1 * rstd * *(const CAS f32x4*)(lng + 36 + jj0) + *(const CAS f32x4*)(lnb + 36 + jj0);
                        const f32x4 c0 = *(const CAS f32x4*)(cosI + (size_t)row * 32 + jj0), c1 = *(const CAS f32x4*)(cosI + (size_t)row * 32 + jj0 + 4);
                        const f32x4 s0 = *(const CAS f32x4*)(sinI + (size_t)row * 32 + jj0), s1 = *(const CAS f32x4*)(sinI + (size_t)row * 32 + jj0 + 4);
                        const f32x4 o10 = a0 * c0 - b0 * s0, o11 = a1 * c1 - b1 * s1, o20 = b0 * c0 + a0 * s0, o21 = b1 * c1 + a1 * s1;
                        bf16* rowp = kidx + (size_t)row * 64 + jj0;
                        u32x4 w1 = {cvt_pk_bf16(o10[0], o10[1]), cvt_pk_bf16(o10[2], o10[3]), cvt_pk_bf16(o11[0], o11[1]), cvt_pk_bf16(o11[2], o11[3])};
                        u32x4 w2 = {cvt_pk_bf16(o20[0], o20[1]), cvt_pk_bf16(o20[2], o20[3]), cvt_pk_bf16(o21[0], o21[1]), cvt_pk_bf16(o21[2], o21[3])};
                        *(u32x4*)rowp = w1; *(u32x4*)(rowp + 32) = w2; }
            } else if (wc == 1) {
                const int h0 = 8 * (fq & 1);
                const f32x4 db0 = *(const CAS f32x4*)(dt_bias + h0), db1 = *(const CAS f32x4*)(dt_bias + h0 + 4);
#pragma unroll
                for (int ai = 0; ai < 2; ++ai)
#pragma unroll
                    for (int m = 0; m < 4; ++m) { const int row = row0 + ai * 128 + m * 16;
                        const f32x4 a0 = acc[ai][0][m][0], a1 = acc[ai][0][m][1];
                        if (fq < 2) { *(f32x4*)(widx + (size_t)row * 16 + h0) = a0 * 0.03125f; *(f32x4*)(widx + (size_t)row * 16 + h0 + 4) = a1 * 0.03125f; }
                        else { f32x4 d0 = a0 + db0, d1 = a1 + db1;
#pragma unroll
                            for (int i = 0; i < 4; ++i) { d0[i] = d0[i] > 20.f ? d0[i] : log1pf(__expf(d0[i])); d1[i] = d1[i] > 20.f ? d1[i] : log1pf(__expf(d1[i])); }
                            *(f32x4*)(dt + (size_t)row * 16 + h0) = d0; *(f32x4*)(dt + (size_t)row * 16 + h0 + 4) = d1; } }
            }
        }
    }
};
constexpr int IX_QP = 2064;
constexpr int IX_ST = 32 * IX_QP;
constexpr int IX_WL = IX_ST + 8 * 8320;
__device__ __forceinline__ void idx_unit(Frame& F, int b, int s, int par) {
    const CAS bf16* kidx = (const CAS bf16*)(F.ws() + WS_KIDX); const CAS bf16* qidx = (const CAS bf16*)(F.ws() + WS_QIDX); const CAS float* widx = (const CAS float*)(F.ws() + WS_WIDX); float* scores = WSP(float, WS_SCORES);
    const int lane = F.lane(), r32 = lane & 31, hi = lane >> 5, w = F.wave(), tid = F.tid();
    LAS unsigned char* Ql = F.lds();
    { const CAS bf16* src = qidx + (size_t)(b * SEQ + s * 32) * 1024;
#pragma unroll
      for (int i = 0; i < 8; ++i) { const int c = tid + 512 * i, row = c >> 7, ch = c & 127;
          *(LAS bf16x8*)(Ql + row * IX_QP + ch * 16) = *(const CAS bf16x8*)(src + (size_t)row * 1024 + ch * 8); }
      if (tid < 128) { const f32x4 wv = *(const CAS f32x4*)(widx + (size_t)(b * SEQ + s * 32 + (tid >> 2)) * 16 + 4 * (tid & 3)); LAS float* wl = (LAS float*)(F.lds() + IX_WL) + (tid >> 2) * 17 + 4 * (tid & 3);
          wl[0] = wv[0]; wl[1] = wv[1]; wl[2] = wv[2]; wl[3] = wv[3]; } }
    __syncthreads();
    const int qpos = s * 32 + r32, nT = (s >> 2) + 1;
    const LAS float* wrow = (const LAS float*)(F.lds() + IX_WL) + r32 * 17;
    const LAS unsigned char* qrow = Ql + r32 * IX_QP + hi * 16;
    LAS float* st = (LAS float*)(F.lds() + IX_ST + w * 8320);
#pragma unroll 1
    for (int t = par + 2 * w; t < nT; t += 16) {
        const int kpos0 = t * 128;
        bf16x8 A[4][4];
#pragma unroll
        for (int kt = 0; kt < 4; ++kt)
#pragma unroll
            for (int ks = 0; ks < 4; ++ks) A[kt][ks] = *(const CAS bf16x8*)(kidx + (size_t)(b * SEQ + kpos0 + kt * 32 + r32) * 64 + ks * 16 + hi * 8);
        f32x16 o[4] = {};
#pragma unroll 1
        for (int h = 0; h < 16; ++h) { const float wh = wrow[h];
            bf16x8 Bq[4];
#pragma unroll
            for (int ks = 0; ks < 4; ++ks) Bq[ks] = *(const LAS bf16x8*)(qrow + h * 128 + ks * 32);
#pragma unroll
            for (int kt = 0; kt < 4; ++kt) { f32x16 a = {};
#pragma unroll
                for (int ks = 0; ks < 4; ++ks) a = __builtin_amdgcn_mfma_f32_32x32x16_bf16(A[kt][ks], Bq[ks], a, 0, 0, 0);
#pragma unroll
                for (int r = 0; r < 16; ++r) o[kt][r] = fmaf(wh, __int_as_float(max(__float_as_int(a[r]), 0)), o[kt][r]); } }
        const float NEG = -__builtin_inff();
#pragma unroll
        for (int half = 0; half < 2; ++half) {
#pragma unroll
            for (int r = 0; r < 16; ++r) { const int kk = crow(r, hi);
                st[r32 * 65 + kk] = (kpos0 + half * 64 + kk > qpos) ? NEG : o[2 * half][r];
                st[r32 * 65 + 32 + kk] = (kpos0 + half * 64 + 32 + kk > qpos) ? NEG : o[2 * half + 1][r]; }
            LDS_WAIT(); asm volatile("" ::: "memory");
            float* dst = scores + (size_t)(b * SEQ + s * 32) * SEQ + kpos0 + half * 64 + lane;
#pragma unroll 4
            for (int q = 0; q < 32; ++q) { *dst = st[q * 65 + lane]; dst += SEQ; }
            LDS_WAIT(); asm volatile("" ::: "memory"); }
    }
    __syncthreads();
}

constexpr int SA_P = 136;
constexpr int SA_BN = 0, SA_CN = 34816, SA_BT = 69632, SA_CB = 104448, SA_SM = 139264;
__device__ __forceinline__ void conv8(const CAS bf16* xraw_row  , int tpos, const CAS float* cw, const CAS float* cb, float (&o)[8]) {
    bf16x8 xv[4];
#pragma unroll
    for (int k = 0; k < 4; ++k) { const int dt_ = k - 3; xv[k] = *(const CAS bf16x8*)(xraw_row + ((tpos + dt_ >= 0) ? (long)dt_ * CONV_CH : 0l)); }
    const f32x4 b0 = *(const CAS f32x4*)cb, b1 = *(const CAS f32x4*)(cb + 4);
#pragma unroll
    for (int j = 0; j < 4; ++j) { o[j] = b0[j]; o[4 + j] = b1[j]; }
#pragma unroll
    for (int k = 0; k < 4; ++k) { const float vm = (tpos + k - 3 >= 0) ? 1.f : 0.f; float xf[8]; unpack8(xv[k], xf);
        const f32x4 w0 = *(const CAS f32x4*)(cw + k * CONV_CH) * vm, w1 = *(const CAS f32x4*)(cw + k * CONV_CH + 4) * vm;
#pragma unroll
        for (int j = 0; j < 4; ++j) { o[j] += w0[j] * xf[j]; o[4 + j] += w1[j] * xf[4 + j]; } }
#pragma unroll
    for (int j = 0; j < 8; ++j) o[j] = silu_f(o[j]);
}
__device__ __forceinline__ void ssd_a_unit(Frame& F, int b, int c, int g, int hf) {
    const CAS bf16* xbc = (const CAS bf16*)(F.ws() + WS_XBC); bf16* xact = WSP(bf16, WS_XBCACT); const CAS float* dtg = (const CAS float*)(F.ws() + WS_DT); float* csg = WSP(float, WS_CS);
    float* ydiag = WSP(float, WS_YDIAG); float* states = WSP(float, WS_STATES);
    LAS bf16* Bn = (LAS bf16*)(F.lds() + SA_BN); LAS bf16* Cn = (LAS bf16*)(F.lds() + SA_CN); LAS bf16* BT = (LAS bf16*)(F.lds() + SA_BT); LAS bf16* CB = (LAS bf16*)(F.lds() + SA_CB);
    const int lane = F.lane(), r32 = lane & 31, hi = lane >> 5, w = F.wave();
    const int tok0 = b * SEQ + c * CHUNK;
#pragma unroll 4
    for (int i = 0; i < 8; ++i) { const int id = F.tid() + 512 * i, mi = id >> 11, rem = id & 2047, s = rem >> 4, ch = rem & 15;
        const int chan = 1024 + mi * 256 + g * 128 + ch * 8; float o[8];
        conv8(xbc + (size_t)(tok0 + s) * CONV_CH + chan, c * CHUNK + s, F.f(6) + chan, F.f(7) + chan, o);
        u32x4 pk = {cvt_pk_bf16(o[0], o[1]), cvt_pk_bf16(o[2], o[3]), cvt_pk_bf16(o[4], o[5]), cvt_pk_bf16(o[6], o[7])};
        if (mi == 0) { *(LAS u32x4*)(Bn + s * SA_P + ch * 8) = pk;
#pragma unroll
            for (int j = 0; j < 8; ++j) BT[(ch * 8 + j) * SA_P + s] = (bf16)((pk[j >> 1] >> (16 * (j & 1))) & 0xffffu); }
        else { *(LAS u32x4*)(Cn + s * SA_P + ch * 8) = pk; if (hf == 0) *(u32x4*)(xact + (size_t)(tok0 + s) * CONV_CH + chan) = pk; } }
    __syncthreads();
    { const int lt = w >> 1;
#pragma unroll
      for (int sq = 0; sq < 2; ++sq) { const int st = 2 * (w & 1) + sq; f32x16 a = {};
#pragma unroll
          for (int ks = 0; ks < 8; ++ks) { const bf16x8 av = *(const LAS bf16x8*)(Cn + (32 * lt + r32) * SA_P + 16 * ks + 8 * hi), bv = *(const LAS bf16x8*)(Bn + (32 * st + r32) * SA_P + 16 * ks + 8 * hi);
              a = __builtin_amdgcn_mfma_f32_32x32x16_bf16(av, bv, a, 0, 0, 0); }
#pragma unroll
          for (int r = 0; r < 16; ++r) CB[(32 * lt + crow(r, hi)) * SA_P + 32 * st + r32] = f2bf(a[r]); } }
    __syncthreads();
    const int j = w >> 1, sub = w & 1, h = 8 * g + 4 * hf + j;
    LAS bf16* XT = (LAS bf16*)(F.lds() + j * 17408);
    LAS float* cs_l = (LAS float*)(F.lds() + SA_SM) + j * 384; LAS float* wdec = cs_l + 128;
    {
        const float ah = -__expf(F.f(9)[h]);
        const float d0 = dtg[(size_t)(tok0 + lane) * 16 + h], d1 = dtg[(size_t)(tok0 + 64 + lane) * 16 + h];
        float c0 = d0 * ah, c1 = d1 * ah;
#pragma unroll
        for (int o = 1; o < 64; o <<= 1) { const float t0 = __shfl_up(c0, o), t1 = __shfl_up(c1, o); if (lane >= o) { c0 += t0; c1 += t1; } }
        const float tot0 = __shfl(c0, 63); c1 += tot0; const float cend = __shfl(c1, 63);
        if (sub == 0) { cs_l[lane] = c0; cs_l[64 + lane] = c1; wdec[lane] = __expf(cend - c0); wdec[64 + lane] = __expf(cend - c1);
            csg[(size_t)(tok0 + lane) * 16 + h] = c0; csg[(size_t)(tok0 + 64 + lane) * 16 + h] = c1; }
#pragma unroll 4
        for (int i = 0; i < 8; ++i) { const int id = lane + 64 * i, s = 64 * sub + (id >> 3), ch = id & 7, chan = h * 64 + ch * 8; float o[8];
            conv8(xbc + (size_t)(tok0 + s) * CONV_CH + chan, c * CHUNK + s, F.f(6) + chan, F.f(7) + chan, o);
            u32x4 pk = {cvt_pk_bf16(o[0], o[1]), cvt_pk_bf16(o[2], o[3]), cvt_pk_bf16(o[4], o[5]), cvt_pk_bf16(o[6], o[7])};
            *(u32x4*)(xact + (size_t)(tok0 + s) * CONV_CH + chan) = pk;
            const float dts = dtg[(size_t)(tok0 + s) * 16 + h];
#pragma unroll
            for (int jj = 0; jj < 8; ++jj) XT[(ch * 8 + jj) * SA_P + s] = f2bf(o[jj] * dts); }
    }
    __syncthreads();
#pragma unroll
    for (int lq = 0; lq < 2; ++lq) { const int lt = 2 * sub + lq; const int l = 32 * lt + r32; const float csl = cs_l[l];
        f32x16 a0 = {}, a1 = {};
        for (int ks = 0; ks <= 2 * lt + 1; ++ks) { const int s0 = 16 * ks + 8 * hi;
            float cbf[8]; unpack8(*(const LAS bf16x8*)(CB + l * SA_P + s0), cbf);
            const f32x4 q0 = *(const LAS f32x4*)(cs_l + s0), q1 = *(const LAS f32x4*)(cs_l + s0 + 4);
            float mv[8];
#pragma unroll
            for (int jj = 0; jj < 8; ++jj) { const float cq = jj < 4 ? q0[jj & 3] : q1[jj & 3]; mv[jj] = (s0 + jj <= l) ? cbf[jj] * __expf(csl - cq) : 0.f; }
            const bf16x8 av = pack8((f32x4){mv[0], mv[1], mv[2], mv[3]}, (f32x4){mv[4], mv[5], mv[6], mv[7]});
            const bf16x8 b0 = *(const LAS bf16x8*)(XT + r32 * SA_P + s0), b1 = *(const LAS bf16x8*)(XT + (32 + r32) * SA_P + s0);
            a0 = __builtin_amdgcn_mfma_f32_32x32x16_bf16(av, b0, a0, 0, 0, 0); a1 = __builtin_amdgcn_mfma_f32_32x32x16_bf16(av, b1, a1, 0, 0, 0); }
#pragma unroll
        for (int r = 0; r < 16; ++r) { float* yp = ydiag + (size_t)(tok0 + 32 * lt + crow(r, hi)) * D_SSM + h * 64 + r32; yp[0] = a0[r]; yp[32] = a1[r]; } }
    { f32x16 a[2][2] = {};
      for (int ks = 0; ks < 8; ++ks) { const int s0 = 16 * ks + 8 * hi;
          const f32x4 q0 = *(const LAS f32x4*)(wdec + s0), q1 = *(const LAS f32x4*)(wdec + s0 + 4);
          bf16x8 av[2];
#pragma unroll
          for (int pt = 0; pt < 2; ++pt) { float xf[8]; unpack8(*(const LAS bf16x8*)(XT + (32 * pt + r32) * SA_P + s0), xf);
              av[pt] = pack8((f32x4){xf[0] * q0[0], xf[1] * q0[1], xf[2] * q0[2], xf[3] * q0[3]}, (f32x4){xf[4] * q1[0], xf[5] * q1[1], xf[6] * q1[2], xf[7] * q1[3]}); }
#pragma unroll
          for (int nq = 0; nq < 2; ++nq) { const bf16x8 bv = *(const LAS bf16x8*)(BT + (32 * (2 * sub + nq) + r32) * SA_P + s0);
#pragma unroll
              for (int pt = 0; pt < 2; ++pt) a[pt][nq] = __builtin_amdgcn_mfma_f32_32x32x16_bf16(av[pt], bv, a[pt][nq], 0, 0, 0); } }
      float* sp = states + ((size_t)((b * NCHUNK + c) * SSM_H + h) * SSM_P) * SSM_N;
#pragma unroll
      for (int pt = 0; pt < 2; ++pt)
#pragma unroll
          for (int nq = 0; nq < 2; ++nq)
#pragma unroll
              for (int r = 0; r < 16; ++r) sp[(size_t)(32 * pt + crow(r, hi)) * SSM_N + 32 * (2 * sub + nq) + r32] = a[pt][nq][r]; }
    __syncthreads();
}
constexpr int N_SSD_A = NBATCH * NCHUNK * 2 * 2, N_IDX_U = 256;
__device__ __forceinline__ void p3_ssd(Frame& F) {
#pragma unroll 1
    for (int L = F.bid(); L < N_SSD_A; L += F.G()) { const int hf = L & 1, g = (L >> 1) & 1, c = (L >> 2) & 31, b = L >> 7; ssd_a_unit(F, b, c, g, hf); }
}
__device__ __forceinline__ void p3_idx(Frame& F) {
    int L = F.bid(); while (L < N_SSD_A) L += F.G();
#pragma unroll 1
    for (; L < N_SSD_A + N_IDX_U; L += F.G()) { const int p0 = L - N_SSD_A, b = p0 >> 7, par = p0 & 1, s = (p0 >> 1) & 63;
        idx_unit(F, b, 127 - s, par); idx_unit(F, b, s, par); }
}
__device__ __forceinline__ unsigned fkey(float f) { const unsigned u = __float_as_uint(f); return (u & 0x80000000u) ? ~u : (u | 0x80000000u); }
__device__ __forceinline__ void select_row(Frame& F, int row, LAS unsigned* hist, LAS unsigned* keys) {
    const float* sc = WSP(const float, WS_SCORES) + (size_t)row * SEQ; unsigned long long* mrow = WSP(unsigned long long, WS_MASK) + (size_t)row * 64;
    const int lane = F.lane(), t = row & (SEQ - 1);
    if (t < TOPK_SEL) {
        const int lo = 64 * lane; unsigned long long m;
        if (lo + 63 <= t) m = ~0ull; else if (lo > t) m = 0ull; else m = (1ull << (t - lo + 1)) - 1ull;
        mrow[lane] = m; return;
    }
    const int nI = (t >> 6) + 1;
    float amax = 0.f;
    const int n4 = (t >> 8) + 1;
#pragma unroll 8
    for (int i = 0; i < n4; ++i) { const int e0 = 256 * i + 4 * lane; const f32x4 v = *(const f32x4*)(sc + e0);
        u32x4 kb;
#pragma unroll
        for (int j = 0; j < 4; ++j) { const bool ok = (e0 + j <= t); kb[j] = ok ? __float_as_uint(v[j]) : 0u; amax = fmaxf(amax, ok ? fabsf(v[j]) : 0.f); }
        *(LAS u32x4*)(keys + e0) = kb; }
#pragma unroll
    for (int o = 1; o < 64; o <<= 1) amax = fmaxf(amax, __shfl_xor(amax, o));
    const float ks = 0.49f / fmaxf(amax, 1e-30f);
    unsigned prefix = 0u, need = TOPK_SEL, pmask = 0u, cnt_eq = 0u;
#pragma unroll 1
    for (int pass = 0; pass < 3; ++pass) { const int shift = (pass == 0) ? 15 : (pass == 1 ? 7 : 0); const unsigned dmask = (pass == 2) ? 127u : 255u;
        hist[4 * lane] = 0u; hist[4 * lane + 1] = 0u; hist[4 * lane + 2] = 0u; hist[4 * lane + 3] = 0u;
        LDS_WAIT(); asm volatile("" ::: "memory");
        if (pass == 0) {
#pragma unroll 1
            for (int i0 = 0; i0 < nI; i0 += 8) { unsigned kk[8];
#pragma unroll
                for (int j = 0; j < 8; ++j) { const int e = 64 * (i0 + j) + lane; kk[j] = keys[e & 4095]; }
#pragma unroll
                for (int j = 0; j < 8; ++j) { const int e = 64 * (i0 + j) + lane; kk[j] = (e <= t) ? (__float_as_uint(fmaf(__uint_as_float(kk[j]), ks, 1.5f)) & 0x7fffffu) : 0u; }
#pragma unroll
                for (int j = 0; j < 8; ++j) { const int e = 64 * (i0 + j) + lane; if (i0 + j < nI) keys[e] = kk[j];
                    if (kk[j] != 0u) __hip_atomic_fetch_add(hist + (kk[j] >> 15), 1u, __ATOMIC_RELAXED, __HIP_MEMORY_SCOPE_WORKGROUP); } }
        } else {
#pragma unroll 1
            for (int i0 = 0; i0 < nI; i0 += 8) { unsigned kk[8];
#pragma unroll
                for (int j = 0; j < 8; ++j) { const int e = 64 * (i0 + j) + lane; kk[j] = (i0 + j < nI) ? keys[e & 4095] : 0u; }
#pragma unroll
                for (int j = 0; j < 8; ++j) if ((kk[j] & pmask) == prefix && kk[j] != 0u) __hip_atomic_fetch_add(hist + ((kk[j] >> shift) & dmask), 1u, __ATOMIC_RELAXED, __HIP_MEMORY_SCOPE_WORKGROUP); }
        }
        LDS_WAIT(); asm volatile("" ::: "memory");
        const unsigned c0 = hist[4 * lane], c1 = hist[4 * lane + 1], c2 = hist[4 * lane + 2], c3 = hist[4 * lane + 3];
        const unsigned tot = c0 + c1 + c2 + c3;
        unsigned suf = tot;
#pragma unroll
        for (int o = 1; o < 64; o <<= 1) { const unsigned tt = __shfl_down(suf, o); if (lane + o < 64) suf += tt; }
        unsigned above = suf - tot;
        int found = -1; unsigned nneed = 0u, fcnt = 0u;
        if (above < need && need <= above + c3) { found = 3; nneed = need - above; fcnt = c3; }
        above += c3;
        if (found < 0 && above < need && need <= above + c2) { found = 2; nneed = need - above; fcnt = c2; }
        above += c2;
        if (found < 0 && above < need && need <= above + c1) { found = 1; nneed = need - above; fcnt = c1; }
        above += c1;
        if (found < 0 && above < need && need <= above + c0) { found = 0; nneed = need - above; fcnt = c0; }
        const unsigned long long bal = __ballot(found >= 0);
        const int src = (int)__builtin_ctzll(bal | (1ull << 63));
        const unsigned digit = (unsigned)__shfl(4 * lane + found, src);
        need = (unsigned)__shfl((int)nneed, src); cnt_eq = (unsigned)__shfl((int)fcnt, src);
        prefix |= digit << shift; pmask |= dmask << shift;
        LDS_WAIT(); asm volatile("" ::: "memory");
    }
    const bool all_eq = (cnt_eq == need);
    unsigned run = 0u; unsigned long long myword = 0ull;
    const unsigned long long lt_mask = (lane == 0) ? 0ull : (~0ull >> (64 - lane));
#pragma unroll 4
    for (int i = 0; i < nI; ++i) {
        const unsigned k = keys[64 * i + lane]; bool sel = k > prefix;
        if (all_eq) { sel = sel || (k == prefix); }
        else { const unsigned long long em = __ballot(k == prefix); if (k == prefix) sel = (run + (unsigned)__popcll(em & lt_mask)) < need; run += (unsigned)__popcll(em); }
        const unsigned long long wb = __ballot(sel);
        if (lane == i) myword = wb;
    }
    mrow[lane] = myword;
    LDS_WAIT(); asm volatile("" ::: "memory");
}
__device__ __forceinline__ void p4_select(Frame& F) {
    LAS unsigned* keys = (LAS unsigned*)(F.lds() + F.wave() * 16384); LAS unsigned* hist = (LAS unsigned*)(F.lds() + 131072 + F.wave() * 1024);
    const int gw = F.bid() * 8 + F.wave(), NGW = F.G() * 8;
    for (int pr = gw; pr < SEQ / 2; pr += NGW) {
#pragma unroll 1
        for (int b = 0; b < NBATCH; ++b) { select_row(F, b * SEQ + pr, hist, keys); select_row(F, b * SEQ + (SEQ - 1 - pr), hist, keys); }
    }
}
__device__ __forceinline__ void p4_scan(Frame& F) {
    const CAS float* states = (const CAS float*)(F.ws() + WS_STATES); bf16* hin = WSP(bf16, WS_HIN); const CAS float* csg = (const CAS float*)(F.ws() + WS_CS);
    const int gt = F.bid() * 512 + F.tid(), NGT = F.G() * 512;
    for (int q = gt; q < NBATCH * SSM_H * SSM_P * (SSM_N / 2); q += NGT) {
        const int n = 2 * (q & 63), p = (q >> 6) & 63, h = (q >> 12) & 15, b = q >> 16;
        float h0 = 0.f, h1 = 0.f;
#pragma unroll 8
        for (int c = 0; c < NCHUNK; ++c) {
            const size_t off = ((size_t)((b * NCHUNK + c) * SSM_H + h) * SSM_P + p) * SSM_N + n;
            *(unsigned*)(hin + off) = cvt_pk_bf16(h0, h1);
            const float dec = __expf(csg[(size_t)(b * SEQ + c * CHUNK + CHUNK - 1) * 16 + h]);
            const f32x2 st = *(const CAS f32x2*)(states + off);
            h0 = dec * h0 + st[0]; h1 = dec * h1 + st[1];
        }
    }
}
namespace att {
constexpr int KVBLK = 64, SHM_K = KVBLK * 128 * 2, SHM_V = SHM_K;
constexpr float SCALE = 0.08838834764831845f, THR = 8.f, C2 = 1.4426950408889634f * SCALE;
#define KSWZ(row, colB) ((row) * 256 + ((colB) ^ (((row) & 7) << 4)))
__device__ __forceinline__ int v_st(int k, int c) { const int kk = (k & ~0xC) | ((k & 4) << 1) | ((k & 8) >> 1); return ((kk >> 3) * 4 + (c >> 5)) * 512 + ((kk & 7) * 32 + (c & 31)) * 2; }
__device__ __forceinline__ int v_rd_base(int lane) { return ((lane & 3) << 3) | (((lane >> 2) & 3) << 6) | (((lane >> 4) & 1) << 5) | (((lane >> 5) & 1) << 8); }
constexpr int v_rd_off(int d0, int ks, int half) { return d0 * 512 + ks * 4096 + half * 2048; }
template <int KB>
__device__ __forceinline__ void qkt(f32x16& p0, f32x16& p1, LAS const char* K_lds, int r32, int hi, const bf16x8* qr) {
    p0 = f32x16{}; p1 = f32x16{};
    LAS const char* kb[4];
#pragma unroll
    for (int dd = 0; dd < 4; ++dd) kb[dd] = K_lds + KB * SHM_K + KSWZ(r32, (dd * 16 + hi * 8) * 2);
#pragma unroll
    for (int d0 = 0; d0 < 8; ++d0) { LAS const char* a = kb[d0 & 3] + (d0 >> 2) * 128;
        const bf16x8 b0 = *(LAS const bf16x8*)a;
        const bf16x8 b1 = *(LAS const bf16x8*)(a + 32 * 256);
        p0 = __builtin_amdgcn_mfma_f32_32x32x16_bf16(b0, qr[d0], p0, 0, 0, 0);
        p1 = __builtin_amdgcn_mfma_f32_32x32x16_bf16(b1, qr[d0], p1, 0, 0, 0); }
}
template <int VB>
__device__ __forceinline__ void pv_tile(f32x16* o, int vb0, bf16x8 pa0, bf16x8 pa1, bf16x8 pa2, bf16x8 pa3) {
#define TRRD(dst, off) asm volatile("ds_read_b64_tr_b16 %0, %1 offset:%2" : "=&v"(dst) : "v"(vb0), "i"(off) : "memory")
#define PV_D0(d0) do { s16x4 l0, l1, l2, l3, h0, h1, h2, h3; constexpr int b_ = VB * SHM_V + v_rd_off(d0, 0, 0); \
        TRRD(l0, b_); TRRD(h0, b_ + 2048); TRRD(l1, b_ + 4096); TRRD(h1, b_ + 6144); TRRD(l2, b_ + 8192); TRRD(h2, b_ + 10240); TRRD(l3, b_ + 12288); TRRD(h3, b_ + 14336); \
        asm volatile("s_waitcnt lgkmcnt(0)" ::: "memory"); __builtin_amdgcn_sched_barrier(0); \
        o[d0] = __builtin_amdgcn_mfma_f32_32x32x16_bf16(pa0, (bf16x8){l0[0], l0[1], l0[2], l0[3], h0[0], h0[1], h0[2], h0[3]}, o[d0], 0, 0, 0);   \
        o[d0] = __builtin_amdgcn_mfma_f32_32x32x16_bf16(pa1, (bf16x8){l1[0], l1[1], l1[2], l1[3], h1[0], h1[1], h1[2], h1[3]}, o[d0], 0, 0, 0);   \
        o[d0] = __builtin_amdgcn_mfma_f32_32x32x16_bf16(pa2, (bf16x8){l2[0], l2[1], l2[2], l2[3], h2[0], h2[1], h2[2], h2[3]}, o[d0], 0, 0, 0);   \
        o[d0] = __builtin_amdgcn_mfma_f32_32x32x16_bf16(pa3, (bf16x8){l3[0], l3[1], l3[2], l3[3], h3[0], h3[1], h3[2], h3[3]}, o[d0], 0, 0, 0); } while (0)
    PV_D0(0); PV_D0(1); PV_D0(2); PV_D0(3);
#undef PV_D0
#undef TRRD
}
__device__ __forceinline__ void softmax_tile(f32x16& p0, f32x16& p1, unsigned long long mw, int hi, float& m_reg, float& l_reg, float& alpha, bf16x8& pa0, bf16x8& pa1, bf16x8& pa2, bf16x8& pa3) {
    float pmax = p0[0];
#pragma unroll
    for (int r = 1; r < 16; ++r) pmax = fmaxf(pmax, p0[r]);
#pragma unroll
    for (int r = 0; r < 16; ++r) pmax = fmaxf(pmax, p1[r]);
    { auto rr = __builtin_amdgcn_permlane32_swap(__float_as_uint(pmax), __float_as_uint(pmax), false, false); pmax = fmaxf(__uint_as_float(rr[0]), __uint_as_float(rr[1])); }
    float mn;
    if (__all((pmax - m_reg) * SCALE <= THR)) { mn = m_reg; alpha = 1.f; }
    else { mn = fmaxf(m_reg, pmax); alpha = __builtin_amdgcn_exp2f((m_reg - mn) * C2); m_reg = mn; }
    const float mnL = -mn * C2;
    const int lo = (int)((unsigned)mw >> (4 * hi)), hh = (int)((unsigned)(mw >> 32) >> (4 * hi));
#pragma unroll
    for (int r = 0; r < 16; ++r) { const int c = (r & 3) + 8 * (r >> 2);
        const float e0 = __builtin_amdgcn_exp2f(fmaf(p0[r], C2, mnL)), e1 = __builtin_amdgcn_exp2f(fmaf(p1[r], C2, mnL));
        p0[r] = __uint_as_float(__float_as_uint(e0) & (unsigned)__builtin_amdgcn_sbfe(lo, c, 1));
        p1[r] = __uint_as_float(__float_as_uint(e1) & (unsigned)__builtin_amdgcn_sbfe(hh, c, 1)); }
    float ps = 0.f;
#pragma unroll
    for (int r = 0; r < 16; ++r) ps += p0[r];
#pragma unroll
    for (int r = 0; r < 16; ++r) ps += p1[r];
    { auto rr = __builtin_amdgcn_permlane32_swap(__float_as_uint(ps), __float_as_uint(ps), false, false); ps = __uint_as_float(rr[0]) + __uint_as_float(rr[1]); }
    l_reg = l_reg * alpha + ps;
#define PK4(P, B_, OUT) do { unsigned a0 = cvt_pk_bf16(P[B_+0], P[B_+1]), a1 = cvt_pk_bf16(P[B_+2], P[B_+3]); \
        unsigned b0 = cvt_pk_bf16(P[B_+4], P[B_+5]), b1 = cvt_pk_bf16(P[B_+6], P[B_+7]); \
        auto r0 = __builtin_amdgcn_permlane32_swap(a0, b0, false, false); auto r1 = __builtin_amdgcn_permlane32_swap(a1, b1, false, false); \
        u32x4 w = {r0[0], r1[0], r0[1], r1[1]}; OUT = __builtin_bit_cast(bf16x8, w); } while (0)
    PK4(p0, 0, pa0); PK4(p0, 8, pa1); PK4(p1, 0, pa2); PK4(p1, 8, pa3);
#undef PK4
}
}

__device__ __forceinline__ void attn_item(Frame& F, int b, int h, int X) {
    using namespace att;
    const bf16* qg = WSP(const bf16, WS_Q); const bf16* kg = WSP(const bf16, WS_K) + (size_t)(b * SEQ) * 1024 + h * 128; const bf16* vg = WSP(const bf16, WS_V) + (size_t)(b * SEQ) * 1024 + h * 128;
    const unsigned long long* maskg = WSP(const unsigned long long, WS_MASK); bf16* ycat = WSP(bf16, WS_YCAT);
    const int tid = F.tid(), wid = F.wave(), lane = F.lane(), r32 = lane & 31, hi = lane >> 5;
    LAS char* V_lds = (LAS char*)F.lds(); LAS char* K_lds = V_lds + 2 * SHM_V;
    LAS float* wsl = (LAS float*)(F.lds() + 2 * SHM_V + 2 * SHM_K) + wid * 64; LAS float* li_l = wsl; LAS float* al_l = wsl + 32;
    const int tokq = b * SEQ + X * 256 + wid * 32 + r32, NT = 4 * X + 4;
    bf16x8 qr[8];
#pragma unroll
    for (int d0 = 0; d0 < 8; ++d0) qr[d0] = *(const bf16x8*)(qg + (size_t)tokq * 1024 + h * 128 + d0 * 16 + hi * 8);
    const unsigned long long* mrow = maskg + (size_t)tokq * 64;
    const int sr = tid >> 4, sc = (tid & 15) * 8, vst0 = v_st(sr, sc), vst1 = v_st(32 + sr, sc), kws = KSWZ(sr, sc * 2);
    const int vb0 = (int)(unsigned)(uintptr_t)V_lds + v_rd_base(lane);
    float m_reg = -1e30f, l_reg = 0.f; f32x16 o[4] = {};
    bf16x8 sA[4], sB[4];
    unsigned long long mwE, mwO;
#define ALOAD(S, t) do { const size_t r0_ = (size_t)((t) * KVBLK + sr) * 1024 + sc; S[0] = *(const bf16x8*)(kg + r0_); S[1] = *(const bf16x8*)(kg + r0_ + 32 * 1024); \
                         S[2] = *(const bf16x8*)(vg + r0_); S[3] = *(const bf16x8*)(vg + r0_ + 32 * 1024); } while (0)
#define AWRITE(S, bf) do { *(LAS bf16x8*)(K_lds + (bf) * SHM_K + kws) = S[0]; *(LAS bf16x8*)(K_lds + (bf) * SHM_K + kws + 32 * 256) = S[1]; \
                           *(LAS bf16x8*)(V_lds + (bf) * SHM_V + vst0) = S[2]; *(LAS bf16x8*)(V_lds + (bf) * SHM_V + vst1) = S[3]; } while (0)
#define ASTEP(t, KB, SW, MW) do { __syncthreads(); \
        if ((t) + 1 < NT) AWRITE(SW, (KB) ^ 1); \
        if ((t) + 3 < NT) ALOAD(SW, (t) + 3); \
        const unsigned long long mw_ = MW; if ((t) + 2 < NT) MW = mrow[(t) + 2]; \
        f32x16 p0, p1; float alpha; bf16x8 pa0, pa1, pa2, pa3; \
        qkt<KB>(p0, p1, K_lds, r32, hi, qr); \
        softmax_tile(p0, p1, mw_, hi, m_reg, l_reg, alpha, pa0, pa1, pa2, pa3); \
        if (__any(alpha < 1.f)) { if (hi == 0) al_l[r32] = alpha; LDS_WAIT(); \
            _Pragma("unroll") for (int d_ = 0; d_ < 4; ++d_) _Pragma("unroll") for (int r = 0; r < 16; ++r) o[d_][r] *= al_l[crow(r, hi)]; } \
        pv_tile<KB>(o, vb0, pa0, pa1, pa2, pa3); } while (0)
    ALOAD(sA, 0); mwE = mrow[0]; mwO = mrow[1];
    AWRITE(sA, 0);
    ALOAD(sB, 1); ALOAD(sA, 2);
    for (int t = 0; t < NT; t += 2) { ASTEP(t, 0, sB, mwE); ASTEP(t + 1, 1, sA, mwO); }
#undef ASTEP
#undef AWRITE
#undef ALOAD
    if (hi == 0) li_l[r32] = l_reg; LDS_WAIT();
    float rli[16];
#pragma unroll
    for (int r = 0; r < 16; ++r) rli[r] = __builtin_amdgcn_rcpf(li_l[crow(r, hi)]);
    bf16* Ow = ycat + (size_t)(b * SEQ + X * 256 + wid * 32) * DM + D_SSM + h * 128;
#pragma unroll
    for (int r = 0; r < 16; ++r) { const int orow = crow(r, hi);
#pragma unroll
        for (int d0 = 0; d0 < 4; ++d0) { const float v = o[d0][r] * rli[r]; const float vn = __shfl_xor(v, 1);
            if ((r32 & 1) == 0) *(unsigned*)(Ow + (size_t)orow * DM + d0 * 32 + r32) = cvt_pk_bf16(v, vn); } }
    __syncthreads();
}

__device__ __forceinline__ void ssd_c_unit(Frame& F, int b, int c, int lq) {
    const CAS bf16* xact = (const CAS bf16*)(F.ws() + WS_XBCACT); const CAS bf16* hin = (const CAS bf16*)(F.ws() + WS_HIN); const CAS float* csg = (const CAS float*)(F.ws() + WS_CS);
    const CAS float* ydiag = (const CAS float*)(F.ws() + WS_YDIAG); const CAS bf16* zg = (const CAS bf16*)(F.ws() + WS_Z); bf16* ycat = WSP(bf16, WS_YCAT);
    LAS float* gb = (LAS float*)F.lds();
    const int lane = F.lane(), r32 = lane & 31, hi = lane >> 5, w = F.wave(), g = w >> 2;
    const int tok0 = b * SEQ + c * CHUNK + lq * 32;
    bf16x8 Af[8];
#pragma unroll
    for (int ks = 0; ks < 8; ++ks) Af[ks] = *(const CAS bf16x8*)(xact + (size_t)(tok0 + r32) * CONV_CH + 1280 + g * 128 + 16 * ks + 8 * hi);
#pragma unroll
    for (int hh = 0; hh < 2; ++hh) { const int h = 2 * w + hh;
        const CAS bf16* hp = hin + ((size_t)((b * NCHUNK + c) * SSM_H + h) * SSM_P) * SSM_N;
        float e[16];
#pragma unroll
        for (int r = 0; r < 16; ++r) e[r] = csg[(size_t)(tok0 + crow(r, hi)) * 16 + h];
        f32x16 a0 = {}, a1 = {};
#pragma unroll
        for (int ks = 0; ks < 8; ++ks) { const bf16x8 b0 = *(const CAS bf16x8*)(hp + (size_t)r32 * SSM_N + 16 * ks + 8 * hi), b1 = *(const CAS bf16x8*)(hp + (size_t)(32 + r32) * SSM_N + 16 * ks + 8 * hi);
            a0 = __builtin_amdgcn_mfma_f32_32x32x16_bf16(Af[ks], b0, a0, 0, 0, 0); a1 = __builtin_amdgcn_mfma_f32_32x32x16_bf16(Af[ks], b1, a1, 0, 0, 0); }
#pragma unroll
        for (int r = 0; r < 16; ++r) { const float ee = __expf(e[r]); LAS float* p = gb + crow(r, hi) * 1024 + h * 64 + r32; p[0] = ee * a0[r]; p[32] = ee * a1[r]; } }
    __syncthreads();
    f32x4 dsk[4], nw[4];
#pragma unroll
    for (int j = 0; j < 4; ++j) { const float d = F.f(10)[4 * j + (lane >> 4)]; dsk[j] = (f32x4){d, d, d, d}; nw[j] = *(const CAS f32x4*)(F.f(11) + j * 256 + lane * 4); }
    f32x4 yd[4][4]; u32x2 xs[4][4], zz[4][4];
#pragma unroll
    for (int rr = 0; rr < 4; ++rr) { const size_t tok = (size_t)(tok0 + 4 * w + rr);
#pragma unroll
        for (int j = 0; j < 4; ++j) { const int col = j * 256 + lane * 4; yd[rr][j] = *(const CAS f32x4*)(ydiag + tok * D_SSM + col);
            xs[rr][j] = *(const CAS u32x2*)(xact + tok * CONV_CH + col); zz[rr][j] = *(const CAS u32x2*)(zg + tok * 1024 + col); } }
#pragma unroll
    for (int rr = 0; rr < 4; ++rr) { const int l = 4 * w + rr; float ss = 0.f; f32x4 v[4];
#pragma unroll
        for (int j = 0; j < 4; ++j) { const f32x4 yo = *(const LAS f32x4*)(gb + l * 1024 + j * 256 + lane * 4);
            const f32x4 xf = {bflo(xs[rr][j][0]), bfhi(xs[rr][j][0]), bflo(xs[rr][j][1]), bfhi(xs[rr][j][1])}, zf = {bflo(zz[rr][j][0]), bfhi(zz[rr][j][0]), bflo(zz[rr][j][1]), bfhi(zz[rr][j][1])};
            f32x4 y = yd[rr][j] + yo + dsk[j] * xf;
#pragma unroll
            for (int i = 0; i < 4; ++i) y[i] *= silu_f(zf[i]);
            v[j] = y; ss += (y[0] * y[0] + y[1] * y[1]) + (y[2] * y[2] + y[3] * y[3]); }
        const float rs = 1.0f / sqrtf(wave_sum(ss) * (1.0f / 1024.0f) + LN_EPS);
#pragma unroll
        for (int j = 0; j < 4; ++j) { const f32x4 y = v[j] * rs * nw[j];
            *(u32x2*)(ycat + (size_t)(tok0 + l) * DM + j * 256 + lane * 4) = (u32x2){cvt_pk_bf16(y[0], y[1]), cvt_pk_bf16(y[2], y[3])}; } }
    __syncthreads();
}
__device__ __forceinline__ void p5_phase(Frame& F) {
    for (int L = F.bid(); L < 256; L += F.G()) { const int lq = L & 3, c = (L >> 2) & 31, b = L >> 7; ssd_c_unit(F, b, c, lq); }
    PSUB(50, 0);
    for (int L = F.bid(); L < 256; L += F.G()) { const int X = 15 - (L >> 4), h = L & 7, b = (L >> 3) & 1; attn_item(F, b, h, X); }
    PSUB(50, 1);
}
struct EpiOutProj {
    static constexpr bool PERM = false;
    const CAS float* x; const CAS float* modf; float* out;
    __device__ __forceinline__ void operator()(const f32x4 (&acc)[2][2][4][2], const pg8::Unit& u, int wr, int wc, int fr, int fq) const {
        const int row0 = u.pm * 256 + wr * 64 + fr, col0 = u.pn * 256 + wc * 32 + 4 * fq; const int b = (u.pm * 256) / SEQ;
        f32x4 gv[2][2];
#pragma unroll
        for (int bj = 0; bj < 2; ++bj)
#pragma unroll
            for (int n = 0; n < 2; ++n) gv[bj][n] = *(const CAS f32x4*)(modf + (size_t)b * (6 * DM) + 2 * DM + col0 + bj * 128 + n * 16);
#pragma unroll
        for (int ai = 0; ai < 2; ++ai)
#pragma unroll
            for (int m = 0; m < 4; ++m) { const size_t off = (size_t)(row0 + ai * 128 + m * 16) * DM + col0;
#pragma unroll
                for (int bj = 0; bj < 2; ++bj)
#pragma unroll
                    for (int n = 0; n < 2; ++n) { const f32x4 xv = *(const CAS f32x4*)(x + off + bj * 128 + n * 16);
                        *(f32x4*)(out + off + bj * 128 + n * 16) = xv * ALPHA_DN + gv[bj][n] * acc[ai][bj][m][n]; } }
    }
};

constexpr int RT_P = 2056;
__device__ __forceinline__ void p7_unit(Frame& F, int un) {
    const CAS float* modf = (const CAS float*)(F.ws() + WS_MODF); bf16* u2 = WSP(bf16, WS_U2); const CAS bf16* wr_hi = (const CAS bf16*)(F.ws() + WS_WR); const CAS bf16* wr_lo = wr_hi + NE * DM;
    int* inv = WSP(int, WS_INV); int* ltok = WSP(int, WS_LTOK); float* lw = WSP(float, WS_LW);
    LAS bf16* Ah = (LAS bf16*)F.lds(); LAS bf16* Al = Ah + 16 * RT_P; LAS float* red = (LAS float*)F.lds();
    LAS float* logit = (LAS float*)(F.lds() + 135168);
    LAS int* ecnt = (LAS int*)(F.lds() + 139264); LAS int* ebase = ecnt + 64;
    const int lane = F.lane(), w = F.wave(), row0 = un * 16, b = row0 / SEQ;
    const CAS float* sh2 = modf + (size_t)b * (6 * DM) + 3 * DM; const CAS float* sc2 = modf + (size_t)b * (6 * DM) + 4 * DM;
    PSUB(70, 0); PSUB(71, 0);
#pragma unroll 1
    for (int rr = 0; rr < 2; ++rr) { const int rl = 2 * w + rr; const size_t row = (size_t)(row0 + rl);
        f32x4 v[8]; float s = 0.f;
#pragma unroll
        for (int j = 0; j < 8; ++j) { v[j] = *(const f32x4*)(F.out() + row * DM + j * 256 + lane * 4); s += (v[j][0] + v[j][1]) + (v[j][2] + v[j][3]); }
        const float mu = wave_sum(s) * (1.0f / DM); float q = 0.f;
#pragma unroll
        for (int j = 0; j < 8; ++j) { v[j] = v[j] - mu; q += (v[j][0] * v[j][0] + v[j][1] * v[j][1]) + (v[j][2] * v[j][2] + v[j][3] * v[j][3]); }
        const float rstd = 1.0f / sqrtf(wave_sum(q) * (1.0f / DM) + LN_EPS);
#pragma unroll
        for (int j = 0; j < 8; ++j) { const int col = j * 256 + lane * 4;
            const f32x4 x1 = v[j] * rstd * *(const CAS f32x4*)(F.f(15) + col) + *(const CAS f32x4*)(F.f(16) + col);
            *(f32x4*)(F.out() + row * DM + col) = x1;
            const f32x4 uu = x1 * (*(const CAS f32x4*)(sc2 + col) + 1.0f) + *(const CAS f32x4*)(sh2 + col);
            const unsigned h0 = cvt_pk_bf16(uu[0], uu[1]), h1 = cvt_pk_bf16(uu[2], uu[3]);
#if MOE_FP8
            { unsigned q8 = (unsigned)__builtin_amdgcn_cvt_pk_fp8_f32(uu[0] * U8_SCALE, uu[1] * U8_SCALE, 0, false); q8 = (unsigned)__builtin_amdgcn_cvt_pk_fp8_f32(uu[2] * U8_SCALE, uu[3] * U8_SCALE, (int)q8, true); *(unsigned*)((unsigned char*)u2 + row * DM + col) = q8; }
#else
            *(u32x2*)(u2 + row * DM + col) = (u32x2){h0, h1};
#endif
            const unsigned l0 = cvt_pk_bf16(uu[0] - bflo(h0), uu[1] - bfhi(h0)), l1 = cvt_pk_bf16(uu[2] - bflo(h1), uu[3] - bfhi(h1));
            *(LAS u32x2*)(Ah + rl * RT_P + col) = (u32x2){h0, h1}; *(LAS u32x2*)(Al + rl * RT_P + col) = (u32x2){l0, l1}; } }
    if (F.tid() < 64) ecnt[F.tid()] = 0;
    __syncthreads();
    PSUB(70, 1); PSUB(72, 0);
    f32x4 acc[4] = {};
    { const int fr = lane & 15, fq = lane >> 4;
      bf16x8 bh[4][4], bl[4][4];
#pragma unroll
      for (int kb = 0; kb < 2; ++kb) {
#pragma unroll
          for (int kq = 0; kq < 4; ++kq) { const int k0_ = w * 256 + (4 * kb + kq) * 32 + fq * 8;
#pragma unroll
              for (int nt = 0; nt < 4; ++nt) { bh[kq][nt] = *(const CAS bf16x8*)(wr_hi + (size_t)(16 * nt + fr) * DM + k0_); bl[kq][nt] = *(const CAS bf16x8*)(wr_lo + (size_t)(16 * nt + fr) * DM + k0_); } }
#pragma unroll
          for (int kq = 0; kq < 4; ++kq) { const int k0_ = w * 256 + (4 * kb + kq) * 32 + fq * 8;
              const bf16x8 ah = *(const LAS bf16x8*)(Ah + fr * RT_P + k0_), al = *(const LAS bf16x8*)(Al + fr * RT_P + k0_);
#pragma unroll
              for (int nt = 0; nt < 4; ++nt) { acc[nt] = __builtin_amdgcn_mfma_f32_16x16x32_bf16(ah, bh[kq][nt], acc[nt], 0, 0, 0);
                  acc[nt] = __builtin_amdgcn_mfma_f32_16x16x32_bf16(al, bh[kq][nt], acc[nt], 0, 0, 0); acc[nt] = __builtin_amdgcn_mfma_f32_16x16x32_bf16(ah, bl[kq][nt], acc[nt], 0, 0, 0); } } }
      __syncthreads();
#pragma unroll
      for (int nt = 0; nt < 4; ++nt)
#pragma unroll
          for (int r = 0; r < 4; ++r) red[(w * 16 + fq * 4 + r) * 64 + 16 * nt + fr] = acc[nt][r]; }
    __syncthreads();
#pragma unroll
    for (int i = 0; i < 2; ++i) { const int o = F.tid() + 512 * i; float s = 0.f;
#pragma unroll
        for (int ww = 0; ww < 8; ++ww) s += red[ww * 1024 + o];
        logit[o] = s; }
    __syncthreads();
    PSUB(72, 1); PSUB(73, 0);
    float score_[2]; int erank_[2]; bool sel_[2];
#pragma unroll
    for (int rr = 0; rr < 2; ++rr) { const int rl = 2 * w + rr;
        const float score = sigmoid_f(logit[rl * 64 + lane]); const float biased = score + F.f(18)[lane];
        float m1 = biased;
#pragma unroll
        for (int o = 1; o < 8; o <<= 1) m1 = fmaxf(m1, __shfl_xor(m1, o));
        int i1 = (biased == m1) ? lane : 64;
#pragma unroll
        for (int o = 1; o < 8; o <<= 1) i1 = min(i1, __shfl_xor(i1, o));
        float m2 = (lane == i1) ? -__builtin_inff() : biased;
#pragma unroll
        for (int o = 1; o < 8; o <<= 1) m2 = fmaxf(m2, __shfl_xor(m2, o));
        const float gs = m1 + m2; const int grp = lane >> 3;
        int grank = 0;
#pragma unroll
        for (int g2 = 0; g2 < 8; ++g2) { const float og = __int_as_float(__builtin_amdgcn_readlane(__float_as_int(gs), 8 * g2)); grank += (og > gs || (og == gs && g2 < grp)) ? 1 : 0; }
        const float mk = (grank < 4) ? biased : -__builtin_inff();
        int erank = 0;
#pragma unroll 8
        for (int e2 = 0; e2 < 64; ++e2) { const float oe = __int_as_float(__builtin_amdgcn_readlane(__float_as_int(mk), e2)); erank += (oe > mk || (oe == mk && e2 < lane)) ? 1 : 0; }
        score_[rr] = score; erank_[rr] = erank; sel_[rr] = erank < 8; }
    int lr_[2]; float gw_[2];
#pragma unroll
    for (int rr = 0; rr < 2; ++rr) { const float wsum = wave_sum(sel_[rr] ? score_[rr] : 0.f); gw_[rr] = score_[rr] / wsum * 2.5f;
        lr_[rr] = sel_[rr] ? __hip_atomic_fetch_add(ecnt + lane, 1, __ATOMIC_RELAXED, __HIP_MEMORY_SCOPE_WORKGROUP) : 0; }
    __syncthreads();
    if (w == 0) { const int c = ecnt[lane]; ebase[lane] = c ? (int)__hip_atomic_fetch_add(F.ctl() + CW_ECNT + 64 * lane, (unsigned)c, RLX_AGENT) : 0; }
    __syncthreads();
#pragma unroll
    for (int rr = 0; rr < 2; ++rr) { const int tok = row0 + 2 * w + rr;
        if (sel_[rr]) { const int rk = ebase[lane] + lr_[rr];
            ltok[lane * NTOK + rk] = tok; lw[lane * NTOK + rk] = gw_[rr]; inv[tok * 8 + erank_[rr]] = lane * NTOK + rk; } }
    __syncthreads();
    PSUB(73, 1); PSUB(71, 1);
}
__device__ __forceinline__ void p7_phase(Frame& F) { for (int un = F.bid(); un < NTOK / 16; un += F.G()) p7_unit(F, un); }
struct MoeOrder {
    unsigned char* ws; int G, c, npn;
    __device__ __forceinline__ bool next(int i, pg8::Unit& u) const {
        const LAS int* tab = (const LAS int*)(lds_base() + LDS_MISC + 64);
        const int L = i * G + c; const int total = __builtin_amdgcn_readfirstlane(tab[80 + NEX]) * npn; if (L >= total) return false;
        int e = 0;
#pragma unroll
        for (int st = 64; st >= 1; st >>= 1) { const int k = e + st; if (k < NEX && tab[80 + k] * npn <= L) e = k; }
        e = __builtin_amdgcn_readfirstlane(e);
        const int t0 = __builtin_amdgcn_readfirstlane(tab[80 + e]), t1 = __builtin_amdgcn_readfirstlane(tab[80 + e + 1]);
        const int nte = t1 - t0, rem = L - t0 * npn;
        const int mt = (npn == 8) ? rem / npn : rem % nte, pn = (npn == 8) ? rem % npn : rem / nte;
        u.pm = t0 + mt; u.pn = e * npn + pn; u.ax = (e << 8) | mt; return true;
    }
    __device__ __forceinline__ int row_tok(const pg8::Unit& u, int r) const {
        const LAS int* tab = (const LAS int*)(lds_base() + LDS_MISC + 64); const int* ltok = (const int*)(ws + WS_LTOK);
        const int e = u.ax >> 8, idx = (u.ax & 255) * 256 + r;
        if (e == NE) return idx;
        return idx < tab[e] ? ltok[e * NTOK + idx] : 0;
    }
};
__device__ __forceinline__ void moe_tables(Frame& F) {
    LAS int* tab = (LAS int*)(F.lds() + LDS_MISC + 64);
    if (F.wave() == 0) { const int lane = F.lane();
        const int cn = (int)__hip_atomic_load(F.ctl() + CW_ECNT + 64 * lane, RLX_AGENT); const int nt = (cn + 255) >> 8;
        int inc = nt;
#pragma unroll
        for (int o = 1; o < 64; o <<= 1) { const int t = __shfl_up(inc, o); if (lane >= o) inc += t; }
        tab[lane] = cn; tab[80 + lane] = inc - nt;
        if (lane == 63) { tab[NE] = NTOK; tab[80 + NE] = inc; tab[80 + NEX] = inc + NTOK / 256; } }
    __syncthreads();
}
struct EpiGateUp {
    static constexpr bool PERM = true;
    unsigned char* ws;
    __device__ __forceinline__ void operator()(const f32x4 (&acc)[2][2][4][2], const pg8::Unit& u, int wr, int wc, int fr, int fq) const {
        const LAS int* tab = (const LAS int*)(lds_base() + LDS_MISC + 64); const CAS float* lw = (const CAS float*)(ws + WS_LW); unsigned char* hid = ws + WS_HID;
        const int e = u.ax >> 8, mt = u.ax & 255, pn = u.pn & 3; const int cnt = __builtin_amdgcn_readfirstlane(tab[e]);
#pragma unroll
        for (int ai = 0; ai < 2; ++ai)
#pragma unroll
            for (int m = 0; m < 4; ++m) { const int rl = ai * 128 + wr * 64 + m * 16 + fr, idx = mt * 256 + rl;
                const float gw = (e == NE) ? 1.0f : (idx < cnt ? lw[e * NTOK + idx] : 0.0f);
                f32x4 h0, h1;
#pragma unroll
                for (int i = 0; i < 4; ++i) { h0[i] = silu_f(acc[ai][0][m][0][i]) * acc[ai][1][m][0][i] * gw; h1[i] = silu_f(acc[ai][0][m][1][i]) * acc[ai][1][m][1][i] * gw; }
#if MOE_FP8_DN
                unsigned lo = (unsigned)__builtin_amdgcn_cvt_pk_fp8_f32(h0[0] * H8_SCALE, h0[1] * H8_SCALE, 0, false); lo = (unsigned)__builtin_amdgcn_cvt_pk_fp8_f32(h0[2] * H8_SCALE, h0[3] * H8_SCALE, (int)lo, true);
                unsigned hi = (unsigned)__builtin_amdgcn_cvt_pk_fp8_f32(h1[0] * H8_SCALE, h1[1] * H8_SCALE, 0, false); hi = (unsigned)__builtin_amdgcn_cvt_pk_fp8_f32(h1[2] * H8_SCALE, h1[3] * H8_SCALE, (int)hi, true);
                *(u32x2*)(hid + (size_t)(u.pm * 256 + rl) * DE + pn * 128 + wc * 32 + 8 * fq) = (u32x2){lo, hi}; }
#else
                u32x4 w = {cvt_pk_bf16(h0[0], h0[1]), cvt_pk_bf16(h0[2], h0[3]), cvt_pk_bf16(h1[0], h1[1]), cvt_pk_bf16(h1[2], h1[3])};
                *(u32x4*)((bf16*)hid + (size_t)(u.pm * 256 + rl) * DE + pn * 128 + wc * 32 + 8 * fq) = w; }
#endif
    }
};
constexpr float OUT_SCALE = 32.0f, OUT_INV = 1.0f / 32.0f;
__device__ __forceinline__ unsigned pk4_fp8(f32x4 v) { unsigned w = (unsigned)__builtin_amdgcn_cvt_pk_fp8_f32(v[0] * OUT_SCALE, v[1] * OUT_SCALE, 0, false); return (unsigned)__builtin_amdgcn_cvt_pk_fp8_f32(v[2] * OUT_SCALE, v[3] * OUT_SCALE, (int)w, true); }
struct EpiDown {
    static constexpr bool PERM = true;
    unsigned char* outs;
    __device__ __forceinline__ void operator()(const f32x4 (&acc)[2][2][4][2], const pg8::Unit& u, int wr, int wc, int fr, int fq) const {
        const int pn = u.pn & 7;
#pragma unroll
        for (int ai = 0; ai < 2; ++ai)
#pragma unroll
            for (int m = 0; m < 4; ++m) { unsigned char* rowp = outs + (size_t)(u.pm * 256 + ai * 128 + wr * 64 + m * 16 + fr) * DM + pn * 256 + 64 * wc + 16 * fq;
                const u32x4 w = {pk4_fp8(acc[ai][0][m][0]), pk4_fp8(acc[ai][0][m][1]), pk4_fp8(acc[ai][1][m][0]), pk4_fp8(acc[ai][1][m][1])};
                *(u32x4*)rowp = w; }
    }
};
__device__ __forceinline__ void p10_final(Frame& F) {
    const CAS float* modf = (const CAS float*)(F.ws() + WS_MODF); const CAS unsigned char* outs = (const CAS unsigned char*)(F.ws() + WS_OUTS); const CAS int* inv = (const CAS int*)(F.ws() + WS_INV);
    const LAS int* tab = (const LAS int*)(F.lds() + LDS_MISC + 64);
    const int gw = F.bid() * 8 + F.wave(), NGW = F.G() * 8;
    for (int tok = gw; tok < NTOK; tok += NGW) { int lane = F.lane(); asm volatile("" : "+v"(lane)); const int b = tok / SEQ; const CAS float* g2 = modf + (size_t)b * (6 * DM) + 5 * DM;
        size_t rows[9];
#pragma unroll
        for (int k = 0; k < 8; ++k) { const int iv = inv[tok * 8 + k]; const int e = iv / NTOK, rk = iv % NTOK; rows[k] = (size_t)(tab[80 + e] * 256 + rk); }
        rows[8] = (size_t)(tab[80 + NE] * 256 + tok);
        f32x4 v[8]; float s = 0.f;
#pragma unroll
        for (int jj = 0; jj < 2; ++jj) { const int col = jj * 1024 + lane * 16; f32x4 f[4] = {};
#pragma unroll
            for (int k = 0; k < 9; ++k) { const u32x4 w = *(const CAS u32x4*)(outs + rows[k] * DM + col);
#pragma unroll
                for (int d = 0; d < 4; ++d) { const f32x2 lo = __builtin_amdgcn_cvt_pk_f32_fp8((int)w[d], false), hi = __builtin_amdgcn_cvt_pk_f32_fp8((int)w[d], true);
                    f[d][0] += lo[0]; f[d][1] += lo[1]; f[d][2] += hi[0]; f[d][3] += hi[1]; } }
#pragma unroll
            for (int d = 0; d < 4; ++d) { const f32x4 x1 = *(const f32x4*)(F.out() + (size_t)tok * DM + col + 4 * d);
                v[4 * jj + d] = x1 * ALPHA_DN + *(const CAS f32x4*)(g2 + col + 4 * d) * (f[d] * OUT_INV);
                s += (v[4 * jj + d][0] + v[4 * jj + d][1]) + (v[4 * jj + d][2] + v[4 * jj + d][3]); } }
        const float mu = wave_sum(s) * (1.0f / DM); float q = 0.f;
#pragma unroll
        for (int j = 0; j < 8; ++j) { v[j] = v[j] - mu; q += (v[j][0] * v[j][0] + v[j][1] * v[j][1]) + (v[j][2] * v[j][2] + v[j][3] * v[j][3]); }
        const float rstd = 1.0f / sqrtf(wave_sum(q) * (1.0f / DM) + LN_EPS);
#pragma unroll
        for (int j = 0; j < 8; ++j) { const int col = (j >> 2) * 1024 + lane * 16 + (j & 3) * 4;
            *(f32x4*)(F.out() + (size_t)tok * DM + col) = v[j] * rstd * *(const CAS f32x4*)(F.f(25) + col) + *(const CAS f32x4*)(F.f(26) + col); } }
}
#ifndef MK_N_LAUNCHES
#define MK_N_LAUNCHES 1
#endif
constexpr int N_PHASES = 11;
__global__ void __launch_bounds__(512, 2) fwd_kernel(Args args) {
    Frame F; F.ap = &args;
    if (F.tid() < 16) ((LAS unsigned*)(F.lds() + LDS_MISC))[F.tid()] = 0u;
    __syncthreads();
    if (args.ph_hi - args.ph_lo > 1) (void)xcd_barrier_post((unsigned*)(F.ctl() + CW_BAR), (volatile LAS unsigned*)(F.lds() + LDS_MISC));
#ifndef PH_MASK
#define PH_MASK 0x7ff
#endif
#define IN(k) (((PH_MASK >> (k)) & 1) && args.ph_lo <= (k) && (k) < args.ph_hi)
#ifdef PROBE_PHASE
    unsigned long long pt0_ = __builtin_amdgcn_s_memrealtime(), pt1_ = 0ull;
#ifdef PROBE_SUB
#define PMARK(k) do { } while (0)
#else
#define PMARK(k) do { if ((k) + 1 == PROBE_PHASE) pt0_ = __builtin_amdgcn_s_memrealtime(); if ((k) == PROBE_PHASE) pt1_ = __builtin_amdgcn_s_memrealtime(); } while (0)
#endif
#else
#define PMARK(k) do { } while (0)
#endif
#define SEAM(k) do { if (IN(k) && IN((k) + 1)) { XcdBarrier bar_; bar_.bar = (unsigned*)(F.ctl() + CW_BAR); bar_.x = xb_xcc_id(); bar_.st = (volatile LAS unsigned*)(F.lds() + LDS_MISC); xcd_barrier(bar_); } } while (0)
    if (IN(0)) { p0_prologue(F); } SEAM(0); PMARK(0);
    if (IN(1)) { p1_modulate(F); } SEAM(1); PMARK(1);
    if (IN(2)) {
        pg8::Gemm g{WSP(const bf16, WS_U1), WSP(const bf16, WS_WIN), DM, 20, 0, 0}; pg8::StaticOrder S; S.init(NTOK, NPROJ_PAD, F.G(), F.bid());
        EpiInProj E{F.ws(), F.f(8), F.f(12), F.f(13)};
        pg8::gemm_phase<EpiInProj, pg8::StaticOrder, false>(F.lds(), g, S, E);
        slack_fill(F, (F.bid() + 3 * F.G() < 32 * NPROJ_TILES) ? 0 : 4, false, Q_ALL);
    } SEAM(2); PMARK(2);
    if (IN(3)) {
        PSUB(3, 0); p3_ssd(F); PSUB(3, 1); PSUB(30, 0); p3_idx(F); PSUB(30, 1);
    } SEAM(3); PMARK(3);
    if (IN(4)) { PSUB(40, 0); p4_select(F); PSUB(40, 1); PSUB(41, 0); p4_scan(F); PSUB(41, 1); } SEAM(4); PMARK(4);
    if (IN(5)) { p5_phase(F); slack_fill(F, (F.G() == 256) ? ((F.bid() >> 4) * 5) / 8 : 0, false, Q_ALL); } SEAM(5); PMARK(5);
    if (IN(6)) {
        pg8::Gemm g{WSP(const bf16, WS_YCAT), WSP(const bf16, WS_WOUT), DM, 60, 0, 0}; pg8::StaticOrder S; S.init(NTOK, DM, F.G(), F.bid());
        EpiOutProj E{F.f(0), (const CAS float*)(F.ws() + WS_MODF), F.out()};
        pg8::gemm_phase<EpiOutProj, pg8::StaticOrder, false>(F.lds(), g, S, E);
    } SEAM(6); PMARK(6);
    if (IN(7)) { p7_phase(F); slack_fill(F, 0, true, Q_GU); } SEAM(7); PMARK(7);
    if (IN(8)) {
        const int vcu = (F.G() % 8 == 0) ? (F.bid() % 8) * (F.G() / 8) + F.bid() / 8 : F.bid();
        moe_tables(F);
        pg8::Gemm g{WSP(const bf16, WS_U2), WSP(const bf16, WS_WGU), MOE_FP8 ? DM / 2 : DM, 80, E8_W, E8_U};     MoeOrder S{F.ws(), F.G(), vcu, 4};
        EpiGateUp E{F.ws()};
        pg8::gemm_phase<EpiGateUp, MoeOrder, true, MOE_FP8 != 0>(F.lds(), g, S, E);
        slack_fill(F, 0, true, Q_ALL);
    } SEAM(8); PMARK(8);
    if (IN(9)) {
        const int vcu = (F.G() % 8 == 0) ? (F.bid() % 8) * (F.G() / 8) + F.bid() / 8 : F.bid();
        moe_tables(F);
        pg8::Gemm g{WSP(const bf16, WS_HID), WSP(const bf16, WS_WDN), MOE_FP8_DN ? DE / 2 : DE, 90, E8_W, E8_H}; MoeOrder S{F.ws(), F.G(), vcu, 8};
        EpiDown E{F.ws() + WS_OUTS};
        pg8::gemm_phase<EpiDown, MoeOrder, false, MOE_FP8_DN != 0>(F.lds(), g, S, E);
    } SEAM(9); PMARK(9);
    if (IN(10)) { moe_tables(F); p10_final(F); }
#ifdef PROBE_PHASE
    if (pt1_ == 0ull) pt1_ = __builtin_amdgcn_s_memrealtime();
#ifdef PROBE_SUB
    __syncthreads(); pt0_ = *(volatile LAS unsigned long long*)(F.lds() + LDS_MISC + 32); pt1_ = *(volatile LAS unsigned long long*)(F.lds() + LDS_MISC + 40);
#endif
    if (F.bid() == 0) { const unsigned long long w = 8ull * (pt1_ - pt0_), te = __builtin_amdgcn_s_memrealtime(); while (__builtin_amdgcn_s_memrealtime() - te < w) __builtin_amdgcn_s_sleep(32); }
#endif
#ifdef DBG_OFF
    if (args.ph_hi == N_PHASES) {
        const size_t n = (size_t)NTOK * DM; float* o = F.out();
        for (size_t i = (size_t)F.bid() * 512 + F.tid(); i < n; i += (size_t)F.G() * 512) {
            float v;
            if (DBG_KIND == 0) v = bf2f(((const bf16*)(F.ws() + (size_t)(DBG_OFF)))[i % (size_t)(DBG_N)]);
            else v = ((const float*)(F.ws() + (size_t)(DBG_OFF)))[i % (size_t)(DBG_N)];
            if (!(fabsf(v) < 1e30f)) v = 1e30f;
            o[i] = v; }
    }
#endif
#undef IN
#undef SEAM
#undef PMARK
}

extern "C" void kernel_launch(void* const* d_in, const int* in_sizes, int n_in, void* d_out, int out_size, void* d_ws, size_t ws_size, hipStream_t stream) {
    static int grid = 0;
    if (grid == 0) {
        if (n_in != 27 || out_size != NTOK * DM || ws_size < WS_END) { fprintf(stderr, "kernel_launch: unexpected shapes (n_in %d, out %d, ws %zu; need ws >= %zu)\n", n_in, out_size, ws_size, (size_t)WS_END); }
        int dev = 0, cus = 0, per_cu = 0;
        if (hipGetDevice(&dev) != hipSuccess || hipDeviceGetAttribute(&cus, hipDeviceAttributeMultiprocessorCount, dev) != hipSuccess) { grid = -1; return; }
        if (hipFuncSetAttribute((const void*)fwd_kernel, hipFuncAttributeMaxDynamicSharedMemorySize, LDS_BYTES) != hipSuccess) { fprintf(stderr, "kernel_launch: hipFuncSetAttribute failed\n"); grid = -1; return; }
        if (hipOccupancyMaxActiveBlocksPerMultiprocessor(&per_cu, (const void*)fwd_kernel, 512, LDS_BYTES) != hipSuccess || per_cu < 1) fprintf(stderr, "kernel_launch: occupancy query reports %d\n", per_cu);
        (void)hipGetLastError();
        grid = cus;
    }
    if (grid < 0) return;
    (void)hipMemsetAsync((char*)d_ws + WS_CTL, 0, CTL_ZERO_BYTES, stream);
    Args a{};
    for (int i = 0; i < 27; ++i) a.in[i] = d_in[i];
    a.out = (float*)d_out; a.ws = (unsigned char*)d_ws;
#if MK_N_LAUNCHES == 1
    a.ph_lo = 0; a.ph_hi = N_PHASES;
    hipLaunchKernelGGL(fwd_kernel, dim3(grid), dim3(512), LDS_BYTES, stream, a);
#else
    for (int p = 0; p < N_PHASES; ++p) { a.ph_lo = p; a.ph_hi = p + 1; hipLaunchKernelGGL(fwd_kernel, dim3(grid), dim3(512), LDS_BYTES, stream, a);
#ifdef DUP_PHASE
        if (p == DUP_PHASE) hipLaunchKernelGGL(fwd_kernel, dim3(grid), dim3(512), LDS_BYTES, stream, a);
#endif
    }
#endif
}
```

```cpp
#define MK_N_LAUNCHES 1
#define PH_MASK 0x7ff
#include <hip/hip_runtime.h>
#include <cstdio>
#include <cstdint>

#define GAS __attribute__((address_space(1)))
#define LAS __attribute__((address_space(3)))
#define CAS __attribute__((address_space(4)))
typedef unsigned short bf16;
typedef short bf16x8 __attribute__((ext_vector_type(8)));
typedef short s16x4 __attribute__((ext_vector_type(4)));
typedef float f32x2 __attribute__((ext_vector_type(2)));
typedef float f32x4 __attribute__((ext_vector_type(4)));
typedef float f32x16 __attribute__((ext_vector_type(16)));
typedef unsigned u32x2 __attribute__((ext_vector_type(2)));
typedef unsigned u32x4 __attribute__((ext_vector_type(4)));
typedef GAS unsigned gu32;
#define RLX_AGENT __ATOMIC_RELAXED, __HIP_MEMORY_SCOPE_AGENT
#define LDS_WAIT() asm volatile("s_waitcnt lgkmcnt(0)" ::: "memory")
#define VM_WAIT() asm volatile("s_waitcnt vmcnt(0)" ::: "memory")

constexpr int DM = 2048, NBATCH = 2, SEQ = 4096, NTOK = NBATCH * SEQ;
constexpr int D_SSM = 1024, SSM_H = 16, SSM_P = 64, SSM_N = 128, CONV_CH = 1536, CHUNK = 128, NCHUNK = SEQ / CHUNK;
constexpr int ATT_H = 8, ATT_D = 128, IDX_H = 16, IDX_D = 64, TOPK_SEL = 256;
constexpr int NE = 64, DE = 512, NEX = NE + 1;
constexpr int NPROJ = 6752, NPROJ_PAD = 6912, NPROJ_TILES = 27;
constexpr float ALPHA_DN = 1.189207115002721f;
constexpr float LN_EPS = 1e-5f;
#ifndef MOE_FP8_DN
#define MOE_FP8_DN 1
#endif
#ifndef MOE_FP8
#define MOE_FP8 1
#endif
constexpr float W8_SCALE = 16.0f, U8_SCALE = 16.0f, H8_SCALE = 4.0f;
constexpr int E8_W = 0x7b7b7b7b, E8_U = 0x7b7b7b7b, E8_H = 0x7d7d7d7d;
constexpr int SEG_Z = 0, SEG_XBC = 1024, SEG_DT = 2560, SEG_Q = 2576, SEG_K = 3600, SEG_V = 4624, SEG_QI = 5648, SEG_KI = 6672, SEG_WI = 6736;

constexpr size_t MiB = 1u << 20;
constexpr size_t WS_CTL = 0, CTL_ZERO_BYTES = 1 * MiB;
constexpr size_t WS_MODP = 1 * MiB;
constexpr size_t WS_MODF = 3 * MiB;
constexpr size_t WS_COSA = 4 * MiB, WS_SINA = 6 * MiB;
constexpr size_t WS_COSI = 8 * MiB, WS_SINI = 9 * MiB;
constexpr size_t WS_WR = 10 * MiB;
constexpr size_t WS_KIDX = 11 * MiB;
constexpr size_t WS_WIDX = 12 * MiB;
constexpr size_t WS_DT = 12 * MiB + 512 * 1024;
constexpr size_t WS_CS = 13 * MiB;
constexpr size_t WS_INV = 14 * MiB;
constexpr size_t WS_LTOK = 15 * MiB;
constexpr size_t WS_LW = 17 * MiB;
constexpr size_t WS_MASK = 19 * MiB;
constexpr size_t WS_U2 = 25 * MiB;
constexpr size_t WS_WGU = 57 * MiB;
constexpr size_t WS_WDN = 317 * MiB;
constexpr size_t WS_T = 447 * MiB;
constexpr size_t WS_HID = WS_T;
constexpr size_t WS_OUTS = WS_T + 88 * MiB;
constexpr size_t WS_WIN = WS_T;
constexpr size_t WS_WOUT = WS_T + 27 * MiB;
constexpr size_t WS_U1 = WS_T + 35 * MiB;
constexpr size_t WS_Z = WS_T + 67 * MiB;
constexpr size_t WS_XBC = WS_T + 83 * MiB;
constexpr size_t WS_Q = WS_T + 107 * MiB, WS_K = WS_T + 123 * MiB, WS_V = WS_T + 139 * MiB;
constexpr size_t WS_QIDX = WS_T + 155 * MiB;
constexpr size_t WS_SCORES = WS_T + 171 * MiB;
constexpr size_t WS_STATES = WS_T + 299 * MiB;
constexpr size_t WS_HIN = WS_T + 331 * MiB;
constexpr size_t WS_YDIAG = WS_T + 347 * MiB;
constexpr size_t WS_YCAT = WS_T + 379 * MiB;
constexpr size_t WS_XBCACT = WS_T + 411 * MiB;
constexpr size_t WS_END = WS_T + 440 * MiB;
static_assert(WS_XBCACT + 24 * MiB <= WS_END && WS_OUTS + 352 * MiB <= WS_END, "ws map");
constexpr int MAXPOS = 90112;
constexpr int CW_TMO = 0, CW_BAR = 4096, CW_ECNT = 8192;
constexpr int CW_QHEAD = 16384, CW_DONE = 16448;

constexpr int LDS_MISC = 155648;
constexpr int LDS_BYTES = 157696;

typedef __bf16 bf16x2_t __attribute__((ext_vector_type(2)));
__device__ __forceinline__ unsigned cvt_pk_bf16(float lo, float hi) { const bf16x2_t v = {(__bf16)lo, (__bf16)hi}; return __builtin_bit_cast(unsigned, v); }
__device__ __forceinline__ float bflo(unsigned w) { return __uint_as_float(w << 16); }
__device__ __forceinline__ float bfhi(unsigned w) { return __uint_as_float(w & 0xffff0000u); }
__device__ __forceinline__ float bf2f(bf16 b) { return __uint_as_float((unsigned)b << 16); }
__device__ __forceinline__ bf16 f2bf(float f) { return __builtin_bit_cast(unsigned short, (__bf16)f); }
__device__ __forceinline__ float silu_f(float x) { return x / (1.f + __expf(-x)); }
__device__ __forceinline__ float sigmoid_f(float x) { return 1.f / (1.f + __expf(-x)); }
__device__ __forceinline__ float wave_sum(float v) {
#pragma unroll
    for (int o = 1; o < 64; o <<= 1) v += __shfl_xor(v, o);
    return v;
}
__device__ __forceinline__ bf16x8 pack8(f32x4 a, f32x4 b) {
    u32x4 w = {cvt_pk_bf16(a[0], a[1]), cvt_pk_bf16(a[2], a[3]), cvt_pk_bf16(b[0], b[1]), cvt_pk_bf16(b[2], b[3])};
    return __builtin_bit_cast(bf16x8, w);
}
__device__ __forceinline__ void unpack8(bf16x8 v, float (&o)[8]) {
    u32x4 w = __builtin_bit_cast(u32x4, v);
#pragma unroll
    for (int i = 0; i < 4; ++i) { o[2 * i] = bflo(w[i]); o[2 * i + 1] = bfhi(w[i]); }
}
__device__ __forceinline__ int crow(int r, int hi) { return (r & 3) + 8 * (r >> 2) + 4 * hi; }

__device__ __forceinline__ LAS unsigned char* lds_base() { extern __shared__ __attribute__((aligned(16))) unsigned char lds_raw[]; return (LAS unsigned char*)lds_raw; }
#ifdef PROBE_SUB
#define PSUB(n, w) do { if ((n) == PROBE_SUB && blockIdx.x == 0 && threadIdx.x == 0) *(volatile LAS unsigned long long*)(lds_base() + LDS_MISC + 32 + 8 * (w)) = __builtin_amdgcn_s_memrealtime(); } while (0)
#else
#define PSUB(n, w) do { } while (0)
#endif
#define XB_TMO      128
#define XB_XCNT(j)  (256  + 64 * (j))
#define XB_XSUB(j)  (1280 + 64 * (j))
#define XB_XGEN(j)  (2304 + 64 * (j))
#define XB_TOP      3328
#define XB_TOPGEN   3392
#define XCD_BAR_WORDS 3456
#define XB_SPIN_CAP (1u << 18)

__device__ __forceinline__ unsigned xb_ld(unsigned* p)              { return __hip_atomic_load(p, __ATOMIC_RELAXED, __HIP_MEMORY_SCOPE_AGENT); }
__device__ __forceinline__ unsigned xb_add(unsigned* p, unsigned v) { return __hip_atomic_fetch_add(p, v, __ATOMIC_RELAXED, __HIP_MEMORY_SCOPE_AGENT); }
__device__ __forceinline__ unsigned xb_xcc_id() { return (unsigned)__builtin_amdgcn_s_getreg((3 << 11) | 20) & 0xFu; }
#define XB_SPIN(cond, bar) do { unsigned _sp = 0; while (cond) { __builtin_amdgcn_s_sleep(1); \
    if ((++_sp & 255u) == 0u) { if (xb_ld(&(bar)[XB_TMO])) break; if (_sp > XB_SPIN_CAP) { atomicAdd(&(bar)[XB_TMO], 1u); break; } } } } while (0)

struct XcdBarrier {
    unsigned* bar; unsigned x;
    volatile LAS unsigned* st;
};

__device__ __forceinline__ XcdBarrier xcd_barrier_post(unsigned* bar, volatile LAS unsigned* st) {
    XcdBarrier b; b.bar = bar; b.x = xb_xcc_id(); b.st = st;
    if (threadIdx.x == 0) (void)xb_add(&bar[XB_XCNT(b.x)], 1u);
    return b;
}
__device__ __forceinline__ void xcd_barrier_complete(unsigned* bar, unsigned x, unsigned& nloc, unsigned& nx) {
    const unsigned G = gridDim.x * gridDim.y * gridDim.z;
    unsigned sum, cnt, mine, sp = 0u;
    for (;;) {
        sum = 0u; cnt = 0u; mine = 0u;
#pragma unroll
        for (unsigned j = 0; j < 16; ++j) { const unsigned c = xb_ld(&bar[XB_XCNT(j)]); sum += c; cnt += (c > 0u) ? 1u : 0u; mine = (j == x) ? c : mine; }
        if (sum == G) break;
        __builtin_amdgcn_s_sleep(1);
        if ((++sp & 255u) == 0u) { if (xb_ld(&bar[XB_TMO])) break; if (sp > XB_SPIN_CAP) { atomicAdd(&bar[XB_TMO], 1u); break; } }
    }
    nloc = mine > 0u ? mine : 1u; nx = cnt > 0u ? cnt : 1u;
}

__device__ __forceinline__ void xcd_barrier(const XcdBarrier& b) {
    asm volatile("s_waitcnt vmcnt(0)" ::: "memory");
    __syncthreads();
    if (threadIdx.x == 0) {
        unsigned* bar = b.bar;
        __builtin_amdgcn_s_waitcnt(0);
        unsigned nloc = b.st[0], nx = b.st[1];
        if (nloc == 0u) { xcd_barrier_complete(bar, b.x, nloc, nx); b.st[0] = nloc; b.st[1] = nx; }
        const unsigned old = xb_add(&bar[XB_XSUB(b.x)], 1u);
        const unsigned gen = old / nloc;
        if (old + 1u == (gen + 1u) * nloc) {
            __builtin_amdgcn_fence(__ATOMIC_RELEASE, "agent");
            asm volatile("s_waitcnt vmcnt(0)" ::: "memory");
            const unsigned og = xb_add(&bar[XB_TOP], 1u);
            const unsigned tg = og / nx;
            if (og + 1u == (tg + 1u) * nx) xb_add(&bar[XB_TOPGEN], 1u);
            else XB_SPIN(xb_ld(&bar[XB_TOPGEN]) == tg, bar);
            __builtin_amdgcn_fence(__ATOMIC_ACQUIRE, "agent");
            xb_add(&bar[XB_XGEN(b.x)], 1u);
            asm volatile("s_waitcnt vmcnt(0)" ::: "memory");
        } else {
            XB_SPIN(xb_ld(&bar[XB_XGEN(b.x)]) == gen, bar);
            __builtin_amdgcn_fence(__ATOMIC_ACQUIRE, "agent");
            asm volatile("s_waitcnt vmcnt(0)" ::: "memory");
        }
    }
    __syncthreads();
}

namespace pg8 {
constexpr int BM = 256, BK = 64, HALF = 128, HTB = HALF * BK * 2  , STAGE_BYTES = 8 * HTB, NXCD = 8, WGM = 8;
__host__ __device__ __forceinline__ int lds_byte(int r, int c) { const int st = (r >> 4) * 2 + (c >> 5), rr = r & 15, cc = c & 31, ob = rr * 64 + cc * 2; return st * 1024 + (ob ^ (((ob >> 9) & 1) << 5)); }
__host__ __device__ __forceinline__ void stage_rc(int b, int& R, int& C) { const int st = b / 1024, sb = b % 1024, swz = sb ^ (((sb >> 9) & 1) << 5); R = (st >> 1) * 16 + swz / 64; C = (st & 1) * 32 + (swz % 64) / 2; }
__host__ __device__ __forceinline__ int perm32(int rho) { const int n = rho >> 4, i = rho & 15; return 8 * (i >> 2) + 4 * n + (i & 3); }

struct Unit { int pm, pn, ax, cnt; };
struct Gemm { const bf16* A; const bf16* Bt; int K; int pid; int sw, sa; };

struct StaticOrder {
    int nM, nN, nwg, G, c;
    __device__ void init(int M, int N, int G_, int c_) { nM = M / BM; nN = N / BM; nwg = nM * nN; G = G_; c = c_; }
    __device__ __forceinline__ bool next(int i, Unit& u) const {
        const long L = (long)i * G + c; if (L >= nwg) return false;
        int wgid = (int)L; { const int q = nwg / NXCD, r = nwg % NXCD, xcd = wgid % NXCD, off = wgid / NXCD; wgid = (xcd < r ? xcd * (q + 1) : r * (q + 1) + (xcd - r) * q) + off; }
        const int nig = WGM * nN, gid = wgid / nig, fm = gid * WGM, gsz = (nM - fm) < WGM ? (nM - fm) : WGM;
        u.pm = fm + ((wgid % nig) % gsz); u.pn = (wgid % nig) / gsz; u.ax = 0; u.cnt = 0; return true;
    }
    __device__ __forceinline__ int row_tok(const Unit&, int) const { return 0; }
};

typedef int i32x8 __attribute__((ext_vector_type(8)));
typedef int i32x4 __attribute__((ext_vector_type(4)));
template <class Epi, class Sched, bool GATHER, bool F8 = false>
__device__ __forceinline__ void gemm_phase(LAS unsigned char* lds, const Gemm g, const Sched& S, const Epi& E) {
    int tid = threadIdx.x; asm volatile("" : "+v"(tid));
    const int wid = __builtin_amdgcn_readfirstlane(tid >> 6), lane = tid & 63, wr = wid >> 2, wc = wid & 3, fr = lane & 15, fq = lane >> 4;
    const int K = g.K, nt = K / BK;
    unsigned voffB0[2];
#pragma unroll
    for (int i = 0; i < 2; ++i) { int R, C; stage_rc(tid * 16 + i * 8192, R, C); const int Rb = Epi::PERM ? ((R & ~31) + perm32(R & 31)) : R;
        voffB0[i] = (unsigned)(Rb * K + C) * 2u; }
    *(LAS u32x2*)(lds + STAGE_BYTES + 16384 + tid * 8) = (u32x2){voffB0[0], voffB0[1]};
    const unsigned kstep = (unsigned)(BK * 2);
    const unsigned hstep = (unsigned)(HALF * K * 2);
    const unsigned tstep = 2 * hstep;
    const char* const pA = (const char*)g.A; const char* const pB = (const char*)g.Bt;
    const unsigned ldsw = (unsigned)wid * 1024u;
    const int aoff = lds_byte(wr * 64 + fr, fq * 8), boff = lds_byte(wc * 32 + fr, fq * 8);
#define PG8_SA(b, h) (((b) * 2 + (h)) * HTB)
#define PG8_SB(b, h) ((4 + (b) * 2 + (h)) * HTB)
#define PG8_STAGE(bufoff, gbase, soff, voff) do { _Pragma("unroll") for (int _i = 0; _i < 2; ++_i) \
        __builtin_amdgcn_global_load_lds((const unsigned*)((const char*)(gbase) + (unsigned)((soff) + (voff)[_i])), (LAS unsigned*)(lds + (bufoff) + ldsw + _i * 8192), 16, 0, 0); } while (0)
#define PG8_LD8(base) __builtin_shufflevector(*(const LAS i32x4*)(base), *(const LAS i32x4*)((base) + 1024), 0, 1, 2, 3, 4, 5, 6, 7)
#define PG8_LDA(dst, b, h) do { _Pragma("unroll") for (int m = 0; m < 4; ++m) dst[m] = PG8_LD8(lds + PG8_SA(b, h) + aoff + m * 2048); } while (0)
#define PG8_LDB(dst, b, h) do { _Pragma("unroll") for (int n = 0; n < 2; ++n) dst[n] = PG8_LD8(lds + PG8_SB(b, h) + boff + n * 2048); } while (0)
#define PG8_H0(x) __builtin_bit_cast(bf16x8, __builtin_shufflevector(x, x, 0, 1, 2, 3))
#define PG8_H1(x) __builtin_bit_cast(bf16x8, __builtin_shufflevector(x, x, 4, 5, 6, 7))
#define PG8_MMA(ai, bj, At, Bt) do { __builtin_amdgcn_s_setprio(1); _Pragma("unroll") for (int m = 0; m < 4; ++m) _Pragma("unroll") for (int n = 0; n < 2; ++n) { \
        if constexpr (F8) acc[ai][bj][m][n] = __builtin_amdgcn_mfma_scale_f32_16x16x128_f8f6f4(Bt[n], At[m], acc[ai][bj][m][n], 0, 0, 0, g.sw, 0, g.sa); \
        else { acc[ai][bj][m][n] = __builtin_amdgcn_mfma_f32_16x16x32_bf16(PG8_H0(Bt[n]), PG8_H0(At[m]), acc[ai][bj][m][n], 0, 0, 0); \
               acc[ai][bj][m][n] = __builtin_amdgcn_mfma_f32_16x16x32_bf16(PG8_H1(Bt[n]), PG8_H1(At[m]), acc[ai][bj][m][n], 0, 0, 0); } } \
        __builtin_amdgcn_s_setprio(0); } while (0)
#define PG8_WAIT_V(n) asm volatile("s_waitcnt vmcnt(" #n ")" ::: "memory")
#define PG8_WAIT_L(n) asm volatile("s_waitcnt lgkmcnt(" #n ")" ::: "memory")
#define PG8_BAR __builtin_amdgcn_s_barrier()
#define PG8_SCHED __builtin_amdgcn_sched_barrier(0)
#define PG8_SET_OA(o, u) do { int _tz = threadIdx.x; asm volatile("" : "+v"(_tz)); _Pragma("unroll") for (int _i = 0; _i < 2; ++_i) { int _R, _C; stage_rc(_tz * 16 + _i * 8192, _R, _C); \
        _Pragma("unroll") for (int _h = 0; _h < 2; ++_h) { \
        if constexpr (GATHER) o[_h][_i] = (unsigned)S.row_tok(u, _h * HALF + _R) * (unsigned)(K * 2) + (unsigned)_C * 2u; \
        else o[_h][_i] = (unsigned)_h * hstep + (unsigned)(_R * K * 2) + (unsigned)_C * 2u; } } } while (0)
    Unit cur, nxt; int ui = 0;
    if (!S.next(0, cur)) return;
    f32x4 acc[2][2][4][2];
#pragma unroll
    for (int a = 0; a < 2; ++a)
#pragma unroll
        for (int b = 0; b < 2; ++b)
#pragma unroll
            for (int m = 0; m < 4; ++m)
#pragma unroll
                for (int n = 0; n < 2; ++n) acc[a][b][m][n] = (f32x4){0.f, 0.f, 0.f, 0.f};
    i32x8 At[4], B0[2], B1[2];
    LAS u32x4* const oslot = (LAS u32x4*)(lds + STAGE_BYTES) + tid;
    unsigned oAc[2][2];
    PG8_SET_OA(oAc, cur);
    oslot[0] = (u32x4){oAc[0][0], oAc[0][1], oAc[1][0], oAc[1][1]};
    unsigned cA = GATHER ? 0u : (unsigned)cur.pm * tstep; unsigned cB = (unsigned)cur.pn * tstep;
    PG8_STAGE(PG8_SB(0, 0), pB, cB, voffB0); PG8_STAGE(PG8_SB(0, 1), pB, cB + hstep, voffB0); PG8_STAGE(PG8_SA(0, 0), pA, cA, oAc[0]); PG8_STAGE(PG8_SA(0, 1), pA, cA, oAc[1]);
    if (wr == 1) PG8_BAR;
    PG8_WAIT_V(2); PG8_BAR;
    PG8_STAGE(PG8_SB(1, 0), pB, cB + kstep, voffB0); PG8_STAGE(PG8_SA(1, 0), pA, cA + kstep, oAc[0]); PG8_STAGE(PG8_SB(1, 1), pB, cB + hstep + kstep, voffB0);
    PG8_WAIT_V(6); PG8_BAR;
    for (;;) {
        const bool has_next = S.next(ui + 1, nxt);
        const unsigned nA = has_next ? (GATHER ? 0u : (unsigned)nxt.pm * tstep) : cA; const unsigned nB = has_next ? (unsigned)nxt.pn * tstep : cB;
        if constexpr (GATHER) {
            unsigned on[2][2];
            if (has_next) { PG8_SET_OA(on, nxt); oslot[512] = (u32x4){on[0][0], on[0][1], on[1][0], on[1][1]}; }
            else oslot[512] = oslot[0];
        }
        PSUB(g.pid * 10, 0); PSUB(g.pid * 10 + 2, 0);
#pragma unroll 1
        for (int t = 0; t < nt; t += 2) {
            const bool last = (t == nt - 2);
            const unsigned a1 = cA + (unsigned)(t + 1) * kstep;
            const unsigned a2 = last ? nA : cA + (unsigned)(t + 2) * kstep; const unsigned b2 = last ? nB : cB + (unsigned)(t + 2) * kstep;
            const unsigned a3 = a2 + kstep; const unsigned b3 = b2 + kstep;
            const u32x2 oc1 = *((const LAS u32x2*)(oslot) + 1); const u32x4 on = oslot[(GATHER && last) ? 512 : 0];
            const u32x2 vb_ = *(const LAS u32x2*)(lds + STAGE_BYTES + 16384 + tid * 8); const unsigned voffB[2] = {vb_[0], vb_[1]};
            const unsigned o1[2] = {oc1[0], oc1[1]}; const unsigned o20[2] = {on[0], on[1]}, o21[2] = {on[2], on[3]};
            PG8_LDB(B0, 0, 0); PG8_LDB(B1, 0, 1); PG8_SCHED; PG8_LDA(At, 0, 0); PG8_STAGE(PG8_SA(1, 1), pA, a1, o1);
            PG8_WAIT_V(8); PG8_WAIT_L(0); PG8_BAR; PG8_MMA(0, 0, At, B0); PG8_MMA(0, 1, At, B1); PG8_BAR; PG8_SCHED;
            PG8_LDA(At, 0, 1); PG8_STAGE(PG8_SB(0, 0), pB, b2, voffB); PG8_STAGE(PG8_SB(0, 1), pB, b2 + hstep, voffB); PG8_STAGE(PG8_SA(0, 0), pA, a2, o20);
            PG8_WAIT_V(8); PG8_WAIT_L(0); PG8_BAR; PG8_MMA(1, 0, At, B0); PG8_MMA(1, 1, At, B1); PG8_BAR; PG8_SCHED;
            PG8_LDB(B0, 1, 0); PG8_LDB(B1, 1, 1); PG8_SCHED; PG8_LDA(At, 1, 0); PG8_STAGE(PG8_SA(0, 1), pA, a2, o21);
            PG8_WAIT_V(8); PG8_WAIT_L(0); PG8_BAR; PG8_MMA(0, 0, At, B0); PG8_MMA(0, 1, At, B1); PG8_BAR; PG8_SCHED;
            PG8_LDA(At, 1, 1); PG8_STAGE(PG8_SB(1, 0), pB, b3, voffB); PG8_STAGE(PG8_SB(1, 1), pB, b3 + hstep, voffB); PG8_STAGE(PG8_SA(1, 0), pA, a3, o20);
            PG8_WAIT_V(8); PG8_WAIT_L(0); PG8_BAR; PG8_MMA(1, 0, At, B0); PG8_MMA(1, 1, At, B1); PG8_BAR; PG8_SCHED;
        }
        PSUB(g.pid * 10, 1); PSUB(g.pid * 10 + 1, 0);
        if (wr == 0) PG8_BAR;
        { int tz = threadIdx.x; asm volatile("" : "+v"(tz));
          const int wid_ = __builtin_amdgcn_readfirstlane(tz >> 6), fr_ = tz & 15, fq_ = (tz & 63) >> 4, wr_ = wid_ >> 2, wc_ = wid_ & 3;
          E(acc, cur, wr_, wc_, fr_, fq_); }
        PSUB(g.pid * 10 + 1, 1); PSUB(g.pid * 10 + 2, 1);
        if (!has_next) break;
#pragma unroll
        for (int a = 0; a < 2; ++a)
#pragma unroll
            for (int b = 0; b < 2; ++b)
#pragma unroll
                for (int m = 0; m < 4; ++m)
#pragma unroll
                    for (int n = 0; n < 2; ++n) acc[a][b][m][n] = (f32x4){0.f, 0.f, 0.f, 0.f};
        cur = nxt; cA = nA; cB = nB; ++ui;
        if constexpr (GATHER) oslot[0] = oslot[512];
        if (wr == 1) PG8_BAR;
    }
    PG8_WAIT_V(0);
    PG8_BAR;
#undef PG8_SA
#undef PG8_SB
#undef PG8_STAGE
#undef PG8_LDA
#undef PG8_LDB
#undef PG8_MMA
#undef PG8_LD8
#undef PG8_H0
#undef PG8_H1
#undef PG8_WAIT_V
#undef PG8_WAIT_L
#undef PG8_BAR
#undef PG8_SCHED
#undef PG8_SET_OA
}
}
struct Args { const void* in[27]; float* out; unsigned char* ws; int ph_lo, ph_hi; };
struct Frame {
    const Args* ap;
    __device__ __forceinline__ LAS unsigned char* lds() const { extern __shared__ __attribute__((aligned(16))) unsigned char lds_raw[]; return (LAS unsigned char*)lds_raw; }
    __device__ __forceinline__ unsigned char* ws() const { return ap->ws; }
    __device__ __forceinline__ gu32* ctl() const { return (gu32*)(ap->ws + WS_CTL); }
    __device__ __forceinline__ float* out() const { return ap->out; }
    __device__ __forceinline__ int tid() const { return (int)threadIdx.x; }
    __device__ __forceinline__ int lane() const { return (int)threadIdx.x & 63; }
    __device__ __forceinline__ int wave() const { return __builtin_amdgcn_readfirstlane((int)threadIdx.x >> 6); }
    __device__ __forceinline__ int G() const { return (int)gridDim.x; }
    __device__ __forceinline__ int bid() const { return (int)blockIdx.x; }
    __device__ __forceinline__ const CAS float* f(int i) const { return (const CAS float*)ap->in[i]; }
    __device__ __forceinline__ const CAS int* i32(int i) const { return (const CAS int*)ap->in[i]; }
};
#define WSP(T, off) ((T*)(F.ws() + (off)))

__device__ __forceinline__ int inproj_src_col(int P) {
    const int tile = P >> 8, within = P & 255, bj = within >> 7, w = within & 127;
    if (tile < 4) return SEG_Z + tile * 256 + within;
    if (tile < 10) return SEG_XBC + (tile - 4) * 256 + within;
    if (tile < 14) return SEG_Q + (2 * (tile - 10) + (w >> 6)) * 128 + (w & 63) + 64 * bj;
    if (tile < 18) return SEG_K + (2 * (tile - 14) + (w >> 6)) * 128 + (w & 63) + 64 * bj;
    if (tile < 22) return SEG_V + (tile - 18) * 256 + within;
    if (tile < 26) return SEG_QI + (4 * (tile - 22) + (w >> 5)) * 64 + (w & 31) + 32 * bj;
    if (bj == 0) { if (w < 32) return SEG_KI + w; if (w < 48) return SEG_WI + (w - 32); if (w < 64) return SEG_DT + (w - 48); return -1; }
    if (w < 32) return SEG_KI + 32 + w;
    return -1;
}
struct TrD { const CAS float* q; bf16* dst; int ld, K; bool valid, live, f8; };
__device__ __forceinline__ void tr_load(const TrD& t, f32x4 (&v)[16]) {
#pragma unroll
    for (int i = 0; i < 16; ++i) v[i] = (t.valid && t.live) ? *(const CAS f32x4*)(t.q + (size_t)(4 * i) * t.ld) : (f32x4){0.f, 0.f, 0.f, 0.f};
}
__device__ __forceinline__ void tr_fin(const TrD& t, const f32x4 (&v)[16], LAS float* scr, int lane) {
#pragma unroll
    for (int i = 0; i < 16; ++i) { LAS float* s = scr + ((lane >> 4) + 4 * i) * 65 + 4 * (lane & 15); s[0] = v[i][0]; s[1] = v[i][1]; s[2] = v[i][2]; s[3] = v[i][3]; }
    LDS_WAIT(); asm volatile("" ::: "memory");
    const int c = lane & 7;
    if (t.live) {
        if (t.f8) {
#pragma unroll
            for (int jj = 0; jj < 8; ++jj) { const int n = (lane >> 3) + 8 * jj; const LAS float* s = scr + (8 * c) * 65 + n;
                unsigned lo = (unsigned)__builtin_amdgcn_cvt_pk_fp8_f32(s[0] * W8_SCALE, s[65] * W8_SCALE, 0, false); lo = (unsigned)__builtin_amdgcn_cvt_pk_fp8_f32(s[2 * 65] * W8_SCALE, s[3 * 65] * W8_SCALE, (int)lo, true);
                unsigned hi = (unsigned)__builtin_amdgcn_cvt_pk_fp8_f32(s[4 * 65] * W8_SCALE, s[5 * 65] * W8_SCALE, 0, false); hi = (unsigned)__builtin_amdgcn_cvt_pk_fp8_f32(s[6 * 65] * W8_SCALE, s[7 * 65] * W8_SCALE, (int)hi, true);
                *(u32x2*)((unsigned char*)t.dst + (size_t)n * t.K + 8 * c) = (u32x2){lo, hi}; }
        } else {
#pragma unroll
            for (int jj = 0; jj < 8; ++jj) { const int n = (lane >> 3) + 8 * jj; const LAS float* s = scr + (8 * c) * 65 + n;
                u32x4 o; o.x = cvt_pk_bf16(s[0], s[65]); o.y = cvt_pk_bf16(s[2 * 65], s[3 * 65]); o.z = cvt_pk_bf16(s[4 * 65], s[5 * 65]); o.w = cvt_pk_bf16(s[6 * 65], s[7 * 65]);
                *(u32x4*)(t.dst + (size_t)n * t.K + 8 * c) = o; } } }
    LDS_WAIT(); asm volatile("" ::: "memory");
}
constexpr int I_IN = 32 * 108, I_OUT = 32 * 32, I_GU = NEX * 32 * 16, I_DN = NEX * 8 * 32, I_TR = I_IN + I_OUT + I_GU + I_DN;
__device__ __forceinline__ TrD tr_desc(Frame& F, int it, bool live) {
    const int lane = F.lane(), kr = lane >> 4, nq = 4 * (lane & 15); TrD t; t.live = live; t.valid = true; t.f8 = false;
    if (!live) it = 0;
    if (it < I_IN) { const int kb = it / 108, nb = it % 108, k0 = 64 * kb, n0 = 64 * nb; const int sc = inproj_src_col(n0 + nq);
        t.q = F.f(5) + (size_t)(k0 + kr) * NPROJ + (sc < 0 ? 0 : sc); t.valid = sc >= 0; t.ld = NPROJ; t.dst = WSP(bf16, WS_WIN) + (size_t)n0 * DM + k0; t.K = DM; return t; }
    it -= I_IN;
    if (it < I_OUT) { const int kb = it >> 5, nb = it & 31, k0 = 64 * kb, n0 = 64 * nb;
        t.q = F.f(14) + (size_t)(k0 + kr) * DM + n0 + nq; t.ld = DM; t.dst = WSP(bf16, WS_WOUT) + (size_t)n0 * DM + k0; t.K = DM; return t; }
    it -= I_OUT;
    if (it < I_GU) { const int e = it >> 9, r = it & 511, kb = r >> 4, nb = r & 15, k0 = 64 * kb;
        const int p = nb >> 2, bj = (nb >> 1) & 1, w0 = (nb & 1) * 64;
        const CAS float* src = (e < NE) ? ((bj ? F.f(20) : F.f(19)) + (size_t)e * DM * DE) : (bj ? F.f(23) : F.f(22));
        t.q = src + (size_t)(k0 + kr) * DE + 128 * p + w0 + nq; t.ld = DE; t.dst = (bf16*)(F.ws() + WS_WGU + ((size_t)e * 1024 + 64 * nb) * DM + k0); t.K = DM; t.f8 = MOE_FP8; if (!MOE_FP8) t.dst = WSP(bf16, WS_WGU) + ((size_t)e * 1024 + 64 * nb) * DM + k0; return t; }
    it -= I_GU;
    { const int e = it >> 8, r = it & 255, kb = r >> 5, nb = r & 31, k0 = 64 * kb, n0 = 64 * nb;
        const CAS float* src = (e < NE) ? (F.f(21) + (size_t)e * DE * DM) : F.f(24);
        const int P = n0 + nq, p = P & 255, cl = 64 * ((p >> 5) & 3) + 16 * ((p >> 3) & 3) + 8 * (p >> 7) + 4 * ((p >> 2) & 1);
        t.q = src + (size_t)(k0 + kr) * DM + (P & ~255) + cl; t.ld = DM; t.dst = (bf16*)(F.ws() + WS_WDN + ((size_t)e * DM + n0) * DE + k0); t.K = DE; t.f8 = MOE_FP8_DN; if (!MOE_FP8_DN) t.dst = WSP(bf16, WS_WDN) + ((size_t)e * DM + n0) * DE + k0; return t; }
}
__device__ __forceinline__ void tr_item(Frame& F, int it, LAS float* scr) { f32x4 v[16]; const TrD t = tr_desc(F, it, true); tr_load(t, v); tr_fin(t, v, scr, F.lane()); }
__device__ __forceinline__ void tr_items4(Frame& F, int it0, int stride, int lim, LAS float* scr) {
    f32x4 va[16], vb[16]; const int lane = F.lane();
    TrD t0 = tr_desc(F, it0, it0 < lim); tr_load(t0, va);
    TrD t1 = tr_desc(F, it0 + stride, it0 + stride < lim); tr_load(t1, vb);
    tr_fin(t0, va, scr, lane);
    t0 = tr_desc(F, it0 + 2 * stride, it0 + 2 * stride < lim); tr_load(t0, va);
    tr_fin(t1, vb, scr, lane);
    t1 = tr_desc(F, it0 + 3 * stride, it0 + 3 * stride < lim); tr_load(t1, vb);
    tr_fin(t0, va, scr, lane);
    tr_fin(t1, vb, scr, lane);
}
__device__ __forceinline__ void p0_prologue(Frame& F) {
    const int gw = F.bid() * 8 + F.wave(), NGW = F.G() * 8, gt = F.bid() * 512 + F.tid(), NGT = F.G() * 512;
    PSUB(1, 0);
    {
        LAS float* red = (LAS float*)F.lds();
        float* modp = WSP(float, WS_MODP);
        for (int item = F.bid(); item < 48 * 16; item += F.G()) {
            const int cc = item % 48, ks = item / 48;
            f32x4 a0 = {0.f, 0.f, 0.f, 0.f}, a1 = {0.f, 0.f, 0.f, 0.f};
            const int kbase = ks * 128 + F.wave() * 16;
#pragma unroll 4
            for (int i = 0; i < 16; ++i) { const int k = kbase + i;
                const float c0 = silu_f(F.f(1)[k]), c1 = silu_f(F.f(1)[DM + k]);
                const f32x4 wv = *(const CAS f32x4*)(F.f(3) + (size_t)k * (6 * DM) + cc * 256 + F.lane() * 4);
                a0 += wv * c0; a1 += wv * c1; }
            *(LAS f32x4*)(red + (F.wave() * 2 + 0) * 256 + F.lane() * 4) = a0;
            *(LAS f32x4*)(red + (F.wave() * 2 + 1) * 256 + F.lane() * 4) = a1;
            __syncthreads();
            { const int b = F.tid() >> 8, col = F.tid() & 255; float s = 0.f;
#pragma unroll
              for (int w = 0; w < 8; ++w) s += red[(w * 2 + b) * 256 + col];
              modp[((size_t)ks * 2 + b) * (6 * DM) + cc * 256 + col] = s; }
            __syncthreads();
        }
    }
    PSUB(1, 1); PSUB(2, 0);
    {
        float* cosA = WSP(float, WS_COSA); float* sinA = WSP(float, WS_SINA); float* cosI = WSP(float, WS_COSI); float* sinI = WSP(float, WS_SINI);
        for (int i = gt; i < NTOK * 64; i += NGT) { const int tok = i >> 6, j = i & 63;
            const float inv = 1.0f / powf(10000.0f, (float)(2 * j) / 128.0f); const float ang = (float)F.i32(2)[tok] * inv;
            float s, c; sincosf(ang, &s, &c); cosA[i] = c; sinA[i] = s; }
        for (int i = gt; i < NTOK * 32; i += NGT) { const int tok = i >> 5, j = i & 31;
            const float inv = 1.0f / powf(10000.0f, (float)(2 * j) / 64.0f); const float ang = (float)F.i32(2)[tok] * inv;
            float s, c; sincosf(ang, &s, &c); cosI[i] = c; sinI[i] = s; }
    }
    PSUB(2, 1); PSUB(4, 0);
    {
        bf16* wr_hi = WSP(bf16, WS_WR); bf16* wr_lo = wr_hi + NE * DM;
        for (int i = gt; i < NE * (DM / 8); i += NGT) { const int e = i & 63, kc = i >> 6;
            float v[8], l[8];
#pragma unroll
            for (int j = 0; j < 8; ++j) { v[j] = F.f(17)[(size_t)(8 * kc + j) * NE + e]; l[j] = v[j] - bf2f(f2bf(v[j])); }
            u32x4 h = {cvt_pk_bf16(v[0], v[1]), cvt_pk_bf16(v[2], v[3]), cvt_pk_bf16(v[4], v[5]), cvt_pk_bf16(v[6], v[7])};
            u32x4 lo = {cvt_pk_bf16(l[0], l[1]), cvt_pk_bf16(l[2], l[3]), cvt_pk_bf16(l[4], l[5]), cvt_pk_bf16(l[6], l[7])};
            *(u32x4*)(wr_hi + (size_t)e * DM + 8 * kc) = h; *(u32x4*)(wr_lo + (size_t)e * DM + 8 * kc) = lo; }
    }
    PSUB(4, 1); PSUB(5, 0);
    {
        LAS float* scr = (LAS float*)(F.lds() + F.wave() * 16640);
        for (int it = gw; it < I_IN + I_OUT; it += NGW) tr_item(F, it, scr);
    }
    PSUB(5, 1);
}

constexpr int Q_GU = I_GU, Q_ALL = I_GU + I_DN, Q_GRAB = 32;
__device__ __forceinline__ void slack_fill(Frame& F, int budget, bool drain, int upto) {
    LAS float* scr = (LAS float*)(F.lds() + F.wave() * 16640);
    volatile LAS int* qw = (volatile LAS int*)(F.lds() + LDS_MISC + 16);
    __syncthreads();
    for (int gi = 0; drain || gi < budget; ++gi) {
        if (F.tid() == 0) { int stop = 0;
            const int idx = (int)__hip_atomic_fetch_add(F.ctl() + CW_QHEAD, (unsigned)Q_GRAB, RLX_AGENT); if (idx >= Q_ALL) stop = 1; else if (idx >= upto) stop = 2;
            qw[0] = stop; qw[1] = idx; }
        __syncthreads();
        const int stop = qw[0], idx = qw[1];
        __syncthreads();
        if (stop == 1) break;
        tr_items4(F, I_IN + I_OUT + idx + F.wave(), 8, I_IN + I_OUT + Q_ALL, scr);
        if (stop == 2) break;
    }
}

__device__ __forceinline__ void p1_modulate(Frame& F) {
    const float* modp = WSP(const float, WS_MODP); float* modf = WSP(float, WS_MODF); bf16* u1 = WSP(bf16, WS_U1);
    LAS float* sh = (LAS float*)F.lds(); LAS float* sc = sh + DM;
    for (int rg = F.bid(); rg < 256; rg += F.G()) {
        const int b = rg >> 7;
        if (F.tid() < 96) { const int v = rg * 96 + F.tid(); const int bb = v / (6 * DM), col = v % (6 * DM); float s = F.f(4)[col];
#pragma unroll
            for (int ks = 0; ks < 16; ++ks) s += modp[((size_t)ks * 2 + bb) * (6 * DM) + col];
            modf[v] = s; }
        { const int col = F.tid() * 4; f32x4 s0 = *(const CAS f32x4*)(F.f(4) + col), s1 = *(const CAS f32x4*)(F.f(4) + DM + col);
#pragma unroll
          for (int ks = 0; ks < 16; ++ks) { const float* p = modp + ((size_t)ks * 2 + b) * (6 * DM); s0 += *(const f32x4*)(p + col); s1 += *(const f32x4*)(p + DM + col); }
          *(LAS f32x4*)(sh + col) = s0; *(LAS f32x4*)(sc + col) = s1; }
        __syncthreads();
#pragma unroll
        for (int rr = 0; rr < 4; ++rr) { const int row = rg * 32 + F.wave() * 4 + rr;
#pragma unroll
            for (int j = 0; j < 8; ++j) { const int col = j * 256 + F.lane() * 4;
                const f32x4 xv = *(const CAS f32x4*)(F.f(0) + (size_t)row * DM + col); const f32x4 s0 = *(const LAS f32x4*)(sh + col), s1 = *(const LAS f32x4*)(sc + col);
                const f32x4 u = xv * (s1 + 1.0f) + s0;
                u32x2 o = {cvt_pk_bf16(u[0], u[1]), cvt_pk_bf16(u[2], u[3])};
                *(u32x2*)(u1 + (size_t)row * DM + col) = o; } }
        __syncthreads();
    }
}
struct EpiInProj {
    static constexpr bool PERM = true;
    unsigned char* ws; const CAS float *dt_bias, *lng, *lnb;
    __device__ __forceinline__ void operator()(const f32x4 (&acc)[2][2][4][2], const pg8::Unit& u, int wr, int wc, int fr, int fq) const {
        const int pn = u.pn; const int row0 = u.pm * 256 + wr * 64 + fr;
        if (pn < 10 || (pn >= 18 && pn < 22)) {
            size_t boff; int ld, col0;
            if (pn < 4) { boff = WS_Z; ld = 1024; col0 = pn * 256; } else if (pn < 10) { boff = WS_XBC; ld = CONV_CH; col0 = (pn - 4) * 256; } else { boff = WS_V; ld = 1024; col0 = (pn - 18) * 256; }
            bf16* base = (bf16*)(ws + boff);
            col0 += wc * 32 + 8 * fq;
#pragma unroll
            for (int ai = 0; ai < 2; ++ai)
#pragma unroll
                for (int m = 0; m < 4; ++m) { bf16* rowp = base + (size_t)(row0 + ai * 128 + m * 16) * ld + col0;
#pragma unroll
                    for (int bj = 0; bj < 2; ++bj) { const f32x4 v0 = acc[ai][bj][m][0], v1 = acc[ai][bj][m][1];
                        u32x4 w = {cvt_pk_bf16(v0[0], v0[1]), cvt_pk_bf16(v0[2], v0[3]), cvt_pk_bf16(v1[0], v1[1]), cvt_pk_bf16(v1[2], v1[3])};
                        *(u32x4*)(rowp + bj * 128) = w; } }
        } else if (pn < 26) {
            const bool att = pn < 18; const bool isq = pn < 14;
            bf16* base = (bf16*)(ws + (att ? (isq ? WS_Q : WS_K) : WS_QIDX)); const CAS float* ct = (const CAS float*)(ws + (att ? WS_COSA : WS_COSI)); const CAS float* sn = (const CAS float*)(ws + (att ? WS_SINA : WS_SINI));
            const int tw = att ? 64 : 32;
            const int head = att ? 2 * (pn - (isq ? 10 : 14)) + (wc >> 1) : 4 * (pn - 22) + wc, jj0 = att ? 32 * (wc & 1) + 8 * fq : 8 * fq;
#pragma unroll
            for (int ai = 0; ai < 2; ++ai)
#pragma unroll
                for (int m = 0; m < 4; ++m) { const int row = row0 + ai * 128 + m * 16;
                    bf16* rowp = base + (size_t)row * 1024 + head * (2 * tw) + jj0;
#pragma unroll
                    for (int n = 0; n < 2; ++n) { const f32x4 c = *(const CAS f32x4*)(ct + (size_t)row * tw + jj0 + 4 * n), sv = *(const CAS f32x4*)(sn + (size_t)row * tw + jj0 + 4 * n);
                        const f32x4 a = acc[ai][0][m][n], bb = acc[ai][1][m][n];
                        const f32x4 o1 = a * c - bb * sv, o2 = bb * c + a * sv;
                        *(u32x2*)(rowp + 4 * n) = (u32x2){cvt_pk_bf16(o1[0], o1[1]), cvt_pk_bf16(o1[2], o1[3])};
                        *(u32x2*)(rowp + tw + 4 * n) = (u32x2){cvt_pk_bf16(o2[0], o2[1]), cvt_pk_bf16(o2[2], o2[3])}; } }
        } else {
            const CAS float* cosI = (const CAS float*)(ws + WS_COSI); const CAS float* sinI = (const CAS float*)(ws + WS_SINI); bf16* kidx = (bf16*)(ws + WS_KIDX); float* widx = (float*)(ws + WS_WIDX); float* dt = (float*)(ws + WS_DT);
            if (wc == 0) {
                const int jj0 = 8 * fq;
#pragma unroll
                for (int am = 0; am < 8; ++am) { const int ai = am >> 2, m = am & 3; const int row = row0 + ai * 128 + m * 16;
                        f32x4 a0 = acc[ai][0][m][0], a1 = acc[ai][0][m][1], b0 = acc[ai][1][m][0], b1 = acc[ai][1][m][1];
                        float s = (a0[0] + a0[1] + a0[2] + a0[3]) + (a1[0] + a1[1] + a1[2] + a1[3]) + (b0[0] + b0[1] + b0[2] + b0[3]) + (b1[0] + b1[1] + b1[2] + b1[3]);
                        s += __shfl_xor(s, 16); s += __shfl_xor(s, 32);
                        const float mu = s * (1.0f / 64.0f);
                        a0 = a0 - mu; a1 = a1 - mu; b0 = b0 - mu; b1 = b1 - mu;
                        float qv = (a0[0] * a0[0] + a0[1] * a0[1] + a0[2] * a0[2] + a0[3] * a0[3]) + (a1[0] * a1[0] + a1[1] * a1[1] + a1[2] * a1[2] + a1[3] * a1[3])
                                 + (b0[0] * b0[0] + b0[1] * b0[1] + b0[2] * b0[2] + b0[3] * b0[3]) + (b1[0] * b1[0] + b1[1] * b1[1] + b1[2] * b1[2] + b1[3] * b1[3]);
                        qv += __shfl_xor(qv, 16); qv += __shfl_xor(qv, 32);
                        const float rstd = 1.0f / sqrtf(qv * (1.0f / 64.0f) + LN_EPS);
                        a0 = a0 * rstd * *(const CAS f32x4*)(lng + jj0) + *(const CAS f32x4*)(lnb + jj0); a1 = a1 * rstd * *(const CAS f32x4*)(lng + jj0 + 4) + *(const CAS f32x4*)(lnb + jj0 + 4);
                        b0 = b0 * rstd * *(const CAS f32x4*)(lng + 32 + jj0) + *(const CAS f32x4*)(lnb + 32 + jj0); b1 = b1 * rstd * *(const CAS f32x4*)(lng + 36 + jj0) + *(const CAS f32x4*)(lnb + 36 + jj0);
                        const f32x4 c0 = *(const CAS f32x4*)(cosI + (size_t)row * 32 + jj0), c1 = *(const CAS f32x4*)(cosI + (size_t)row * 32 + jj0 + 4);
                        const f32x4 s0 = *(const CAS f32x4*)(sinI + (size_t)row * 32 + jj0), s1 = *(const CAS f32x4*)(sinI + (size_t)row * 32 + jj0 + 4);
                        const f32x4 o10 = a0 * c0 - b0 * s0, o11 = a1 * c1 - b1 * s1, o20 = b0 * c0 + a0 * s0, o21 = b1 * c1 + a1 * s1;
                        bf16* rowp = kidx + (size_t)row * 64 + jj0;
                        u32x4 w1 = {cvt_pk_bf16(o10[0], o10[1]), cvt_pk_bf16(o10[2], o10[3]), cvt_pk_bf16(o11[0], o11[1]), cvt_pk_bf16(o11[2], o11[3])};
                        u32x4 w2 = {cvt_pk_bf16(o20[0], o20[1]), cvt_pk_bf16(o20[2], o20[3]), cvt_pk_bf16(o21[0], o21[1]), cvt_pk_bf16(o21[2], o21[3])};
                        *(u32x4*)rowp = w1; *(u32x4*)(rowp + 32) = w2; }
            } else if (wc == 1) {
                const int h0 = 8 * (fq & 1);
                const f32x4 db0 = *(const CAS f32x4*)(dt_bias + h0), db1 = *(const CAS f32x4*)(dt_bias + h0 + 4);
#pragma unroll
                for (int ai = 0; ai < 2; ++ai)
#pragma unroll
                    for (int m = 0; m < 4; ++m) { const int row = row0 + ai * 128 + m * 16;
                        const f32x4 a0 = acc[ai][0][m][0], a1 = acc[ai][0][m][1];
                        if (fq < 2) { *(f32x4*)(widx + (size_t)row * 16 + h0) = a0 * 0.03125f; *(f32x4*)(widx + (size_t)row * 16 + h0 + 4) = a1 * 0.03125f; }
                        else { f32x4 d0 = a0 + db0, d1 = a1 + db1;
#pragma unroll
                            for (int i = 0; i < 4; ++i) { d0[i] = d0[i] > 20.f ? d0[i] : log1pf(__expf(d0[i])); d1[i] = d1[i] > 20.f ? d1[i] : log1pf(__expf(d1[i])); }
                            *(f32x4*)(dt + (size_t)row * 16 + h0) = d0; *(f32x4*)(dt + (size_t)row * 16 + h0 + 4) = d1; } }
            }
        }
    }
};
constexpr int IX_QP = 2064;
constexpr int IX_ST = 32 * IX_QP;
constexpr int IX_WL = IX_ST + 8 * 8320;
__device__ __forceinline__ void idx_unit(Frame& F, int b, int s, int par) {
    const CAS bf16* kidx = (const CAS bf16*)(F.ws() + WS_KIDX); const CAS bf16* qidx = (const CAS bf16*)(F.ws() + WS_QIDX); const CAS float* widx = (const CAS float*)(F.ws() + WS_WIDX); float* scores = WSP(float, WS_SCORES);
    const int lane = F.lane(), r32 = lane & 31, hi = lane >> 5, w = F.wave(), tid = F.tid();
    LAS unsigned char* Ql = F.lds();
    { const CAS bf16* src = qidx + (size_t)(b * SEQ + s * 32) * 1024;
#pragma unroll
      for (int i = 0; i < 8; ++i) { const int c = tid + 512 * i, row = c >> 7, ch = c & 127;
          *(LAS bf16x8*)(Ql + row * IX_QP + ch * 16) = *(const CAS bf16x8*)(src + (size_t)row * 1024 + ch * 8); }
      if (tid < 128) { const f32x4 wv = *(const CAS f32x4*)(widx + (size_t)(b * SEQ + s * 32 + (tid >> 2)) * 16 + 4 * (tid & 3)); LAS float* wl = (LAS float*)(F.lds() + IX_WL) + (tid >> 2) * 17 + 4 * (tid & 3);
          wl[0] = wv[0]; wl[1] = wv[1]; wl[2] = wv[2]; wl[3] = wv[3]; } }
    __syncthreads();
    const int qpos = s * 32 + r32, nT = (s >> 2) + 1;
    const LAS float* wrow = (const LAS float*)(F.lds() + IX_WL) + r32 * 17;
    const LAS unsigned char* qrow = Ql + r32 * IX_QP + hi * 16;
    LAS float* st = (LAS float*)(F.lds() + IX_ST + w * 8320);
#pragma unroll 1
    for (int t = par + 2 * w; t < nT; t += 16) {
        const int kpos0 = t * 128;
        bf16x8 A[4][4];
#pragma unroll
        for (int kt = 0; kt < 4; ++kt)
#pragma unroll
            for (int ks = 0; ks < 4; ++ks) A[kt][ks] = *(const CAS bf16x8*)(kidx + (size_t)(b * SEQ + kpos0 + kt * 32 + r32) * 64 + ks * 16 + hi * 8);
        f32x16 o[4] = {};
#pragma unroll 1
        for (int h = 0; h < 16; ++h) { const float wh = wrow[h];
            bf16x8 Bq[4];
#pragma unroll
            for (int ks = 0; ks < 4; ++ks) Bq[ks] = *(const LAS bf16x8*)(qrow + h * 128 + ks * 32);
#pragma unroll
            for (int kt = 0; kt < 4; ++kt) { f32x16 a = {};
#pragma unroll
                for (int ks = 0; ks < 4; ++ks) a = __builtin_amdgcn_mfma_f32_32x32x16_bf16(A[kt][ks], Bq[ks], a, 0, 0, 0);
#pragma unroll
                for (int r = 0; r < 16; ++r) o[kt][r] = fmaf(wh, __int_as_float(max(__float_as_int(a[r]), 0)), o[kt][r]); } }
        const float NEG = -__builtin_inff();
#pragma unroll
        for (int half = 0; half < 2; ++half) {
#pragma unroll
            for (int r = 0; r < 16; ++r) { const int kk = crow(r, hi);
                st[r32 * 65 + kk] = (kpos0 + half * 64 + kk > qpos) ? NEG : o[2 * half][r];
                st[r32 * 65 + 32 + kk] = (kpos0 + half * 64 + 32 + kk > qpos) ? NEG : o[2 * half + 1][r]; }
            LDS_WAIT(); asm volatile("" ::: "memory");
            float* dst = scores + (size_t)(b * SEQ + s * 32) * SEQ + kpos0 + half * 64 + lane;
#pragma unroll 4
            for (int q = 0; q < 32; ++q) { *dst = st[q * 65 + lane]; dst += SEQ; }
            LDS_WAIT(); asm volatile("" ::: "memory"); }
    }
    __syncthreads();
}

constexpr int SA_P = 136;
constexpr int SA_BN = 0, SA_CN = 34816, SA_BT = 69632, SA_CB = 104448, SA_SM = 139264;
__device__ __forceinline__ void conv8(const CAS bf16* xraw_row  , int tpos, const CAS float* cw, const CAS float* cb, float (&o)[8]) {
    bf16x8 xv[4];
#pragma unroll
    for (int k = 0; k < 4; ++k) { const int dt_ = k - 3; xv[k] = *(const CAS bf16x8*)(xraw_row + ((tpos + dt_ >= 0) ? (long)dt_ * CONV_CH : 0l)); }
    const f32x4 b0 = *(const CAS f32x4*)cb, b1 = *(const CAS f32x4*)(cb + 4);
#pragma unroll
    for (int j = 0; j < 4; ++j) { o[j] = b0[j]; o[4 + j] = b1[j]; }
#pragma unroll
    for (int k = 0; k < 4; ++k) { const float vm = (tpos + k - 3 >= 0) ? 1.f : 0.f; float xf[8]; unpack8(xv[k], xf);
        const f32x4 w0 = *(const CAS f32x4*)(cw + k * CONV_CH) * vm, w1 = *(const CAS f32x4*)(cw + k * CONV_CH + 4) * vm;
#pragma unroll
        for (int j = 0; j < 4; ++j) { o[j] += w0[j] * xf[j]; o[4 + j] += w1[j] * xf[4 + j]; } }
#pragma unroll
    for (int j = 0; j < 8; ++j) o[j] = silu_f(o[j]);
}
__device__ __forceinline__ void ssd_a_unit(Frame& F, int b, int c, int g, int hf) {
    const CAS bf16* xbc = (const CAS bf16*)(F.ws() + WS_XBC); bf16* xact = WSP(bf16, WS_XBCACT); const CAS float* dtg = (const CAS float*)(F.ws() + WS_DT); float* csg = WSP(float, WS_CS);
    float* ydiag = WSP(float, WS_YDIAG); float* states = WSP(float, WS_STATES);
    LAS bf16* Bn = (LAS bf16*)(F.lds() + SA_BN); LAS bf16* Cn = (LAS bf16*)(F.lds() + SA_CN); LAS bf16* BT = (LAS bf16*)(F.lds() + SA_BT); LAS bf16* CB = (LAS bf16*)(F.lds() + SA_CB);
    const int lane = F.lane(), r32 = lane & 31, hi = lane >> 5, w = F.wave();
    const int tok0 = b * SEQ + c * CHUNK;
#pragma unroll 4
    for (int i = 0; i < 8; ++i) { const int id = F.tid() + 512 * i, mi = id >> 11, rem = id & 2047, s = rem >> 4, ch = rem & 15;
        const int chan = 1024 + mi * 256 + g * 128 + ch * 8; float o[8];
        conv8(xbc + (size_t)(tok0 + s) * CONV_CH + chan, c * CHUNK + s, F.f(6) + chan, F.f(7) + chan, o);
        u32x4 pk = {cvt_pk_bf16(o[0], o[1]), cvt_pk_bf16(o[2], o[3]), cvt_pk_bf16(o[4], o[5]), cvt_pk_bf16(o[6], o[7])};
        if (mi == 0) { *(LAS u32x4*)(Bn + s * SA_P + ch * 8) = pk;
#pragma unroll
            for (int j = 0; j < 8; ++j) BT[(ch * 8 + j) * SA_P + s] = (bf16)((pk[j >> 1] >> (16 * (j & 1))) & 0xffffu); }
        else { *(LAS u32x4*)(Cn + s * SA_P + ch * 8) = pk; if (hf == 0) *(u32x4*)(xact + (size_t)(tok0 + s) * CONV_CH + chan) = pk; } }
    __syncthreads();
    { const int lt = w >> 1;
#pragma unroll
      for (int sq = 0; sq < 2; ++sq) { const int st = 2 * (w & 1) + sq; f32x16 a = {};
#pragma unroll
          for (int ks = 0; ks < 8; ++ks) { const bf16x8 av = *(const LAS bf16x8*)(Cn + (32 * lt + r32) * SA_P + 16 * ks + 8 * hi), bv = *(const LAS bf16x8*)(Bn + (32 * st + r32) * SA_P + 16 * ks + 8 * hi);
              a = __builtin_amdgcn_mfma_f32_32x32x16_bf16(av, bv, a, 0, 0, 0); }
#pragma unroll
          for (int r = 0; r < 16; ++r) CB[(32 * lt + crow(r, hi)) * SA_P + 32 * st + r32] = f2bf(a[r]); } }
    __syncthreads();
    const int j = w >> 1, sub = w & 1, h = 8 * g + 4 * hf + j;
    LAS bf16* XT = (LAS bf16*)(F.lds() + j * 17408);
    LAS float* cs_l = (LAS float*)(F.lds() + SA_SM) + j * 384; LAS float* wdec = cs_l + 128;
    {
        const float ah = -__expf(F.f(9)[h]);
        const float d0 = dtg[(size_t)(tok0 + lane) * 16 + h], d1 = dtg[(size_t)(tok0 + 64 + lane) * 16 + h];
        float c0 = d0 * ah, c1 = d1 * ah;
#pragma unroll
        for (int o = 1; o < 64; o <<= 1) { const float t0 = __shfl_up(c0, o), t1 = __shfl_up(c1, o); if (lane >= o) { c0 += t0; c1 += t1; } }
        const float tot0 = __shfl(c0, 63); c1 += tot0; const float cend = __shfl(c1, 63);
        if (sub == 0) { cs_l[lane] = c0; cs_l[64 + lane] = c1; wdec[lane] = __expf(cend - c0); wdec[64 + lane] = __expf(cend - c1);
            csg[(size_t)(tok0 + lane) * 16 + h] = c0; csg[(size_t)(tok0 + 64 + lane) * 16 + h] = c1; }
#pragma unroll 4
        for (int i = 0; i < 8; ++i) { const int id = lane + 64 * i, s = 64 * sub + (id >> 3), ch = id & 7, chan = h * 64 + ch * 8; float o[8];
            conv8(xbc + (size_t)(tok0 + s) * CONV_CH + chan, c * CHUNK + s, F.f(6) + chan, F.f(7) + chan, o);
            u32x4 pk = {cvt_pk_bf16(o[0], o[1]), cvt_pk_bf16(o[2], o[3]), cvt_pk_bf16(o[4], o[5]), cvt_pk_bf16(o[6], o[7])};
            *(u32x4*)(xact + (size_t)(tok0 + s) * CONV_CH + chan) = pk;
            const float dts = dtg[(size_t)(tok0 + s) * 16 + h];
#pragma unroll
            for (int jj = 0; jj < 8; ++jj) XT[(ch * 8 + jj) * SA_P + s] = f2bf(o[jj] * dts); }
    }
    __syncthreads();
#pragma unroll
    for (int lq = 0; lq < 2; ++lq) { const int lt = 2 * sub + lq; const int l = 32 * lt + r32; const float csl = cs_l[l];
        f32x16 a0 = {}, a1 = {};
        for (int ks = 0; ks <= 2 * lt + 1; ++ks) { const int s0 = 16 * ks + 8 * hi;
            float cbf[8]; unpack8(*(const LAS bf16x8*)(CB + l * SA_P + s0), cbf);
            const f32x4 q0 = *(const LAS f32x4*)(cs_l + s0), q1 = *(const LAS f32x4*)(cs_l + s0 + 4);
            float mv[8];
#pragma unroll
            for (int jj = 0; jj < 8; ++jj) { const float cq = jj < 4 ? q0[jj & 3] : q1[jj & 3]; mv[jj] = (s0 + jj <= l) ? cbf[jj] * __expf(csl - cq) : 0.f; }
            const bf16x8 av = pack8((f32x4){mv[0], mv[1], mv[2], mv[3]}, (f32x4){mv[4], mv[5], mv[6], mv[7]});
            const bf16x8 b0 = *(const LAS bf16x8*)(XT + r32 * SA_P + s0), b1 = *(const LAS bf16x8*)(XT + (32 + r32) * SA_P + s0);
            a0 = __builtin_amdgcn_mfma_f32_32x32x16_bf16(av, b0, a0, 0, 0, 0); a1 = __builtin_amdgcn_mfma_f32_32x32x16_bf16(av, b1, a1, 0, 0, 0); }
#pragma unroll
        for (int r = 0; r < 16; ++r) { float* yp = ydiag + (size_t)(tok0 + 32 * lt + crow(r, hi)) * D_SSM + h * 64 + r32; yp[0] = a0[r]; yp[32] = a1[r]; } }
    { f32x16 a[2][2] = {};
      for (int ks = 0; ks < 8; ++ks) { const int s0 = 16 * ks + 8 * hi;
          const f32x4 q0 = *(const LAS f32x4*)(wdec + s0), q1 = *(const LAS f32x4*)(wdec + s0 + 4);
          bf16x8 av[2];
#pragma unroll
          for (int pt = 0; pt < 2; ++pt) { float xf[8]; unpack8(*(const LAS bf16x8*)(XT + (32 * pt + r32) * SA_P + s0), xf);
              av[pt] = pack8((f32x4){xf[0] * q0[0], xf[1] * q0[1], xf[2] * q0[2], xf[3] * q0[3]}, (f32x4){xf[4] * q1[0], xf[5] * q1[1], xf[6] * q1[2], xf[7] * q1[3]}); }
#pragma unroll
          for (int nq = 0; nq < 2; ++nq) { const bf16x8 bv = *(const LAS bf16x8*)(BT + (32 * (2 * sub + nq) + r32) * SA_P + s0);
#pragma unroll
              for (int pt = 0; pt < 2; ++pt) a[pt][nq] = __builtin_amdgcn_mfma_f32_32x32x16_bf16(av[pt], bv, a[pt][nq], 0, 0, 0); } }
      float* sp = states + ((size_t)((b * NCHUNK + c) * SSM_H + h) * SSM_P) * SSM_N;
#pragma unroll
      for (int pt = 0; pt < 2; ++pt)
#pragma unroll
          for (int nq = 0; nq < 2; ++nq)
#pragma unroll
              for (int r = 0; r < 16; ++r) sp[(size_t)(32 * pt + crow(r, hi)) * SSM_N + 32 * (2 * sub + nq) + r32] = a[pt][nq][r]; }
    __syncthreads();
}
constexpr int N_SSD_A = NBATCH * NCHUNK * 2 * 2, N_IDX_U = 256;
__device__ __forceinline__ void p3_ssd(Frame& F) {
#pragma unroll 1
    for (int L = F.bid(); L < N_SSD_A; L += F.G()) { const int hf = L & 1, g = (L >> 1) & 1, c = (L >> 2) & 31, b = L >> 7; ssd_a_unit(F, b, c, g, hf); }
}
__device__ __forceinline__ void p3_idx(Frame& F) {
    int L = F.bid(); while (L < N_SSD_A) L += F.G();
#pragma unroll 1
    for (; L < N_SSD_A + N_IDX_U; L += F.G()) { const int p0 = L - N_SSD_A, b = p0 >> 7, par = p0 & 1, s = (p0 >> 1) & 63;
        idx_unit(F, b, 127 - s, par); idx_unit(F, b, s, par); }
}
__device__ __forceinline__ unsigned fkey(float f) { const unsigned u = __float_as_uint(f); return (u & 0x80000000u) ? ~u : (u | 0x80000000u); }
__device__ __forceinline__ void select_row(Frame& F, int row, LAS unsigned* hist, LAS unsigned* keys) {
    const float* sc = WSP(const float, WS_SCORES) + (size_t)row * SEQ; unsigned long long* mrow = WSP(unsigned long long, WS_MASK) + (size_t)row * 64;
    const int lane = F.lane(), t = row & (SEQ - 1);
    if (t < TOPK_SEL) {
        const int lo = 64 * lane; unsigned long long m;
        if (lo + 63 <= t) m = ~0ull; else if (lo > t) m = 0ull; else m = (1ull << (t - lo + 1)) - 1ull;
        mrow[lane] = m; return;
    }
    const int nI = (t >> 6) + 1;
    float amax = 0.f;
    const int n4 = (t >> 8) + 1;
#pragma unroll 8
    for (int i = 0; i < n4; ++i) { const int e0 = 256 * i + 4 * lane; const f32x4 v = *(const f32x4*)(sc + e0);
        u32x4 kb;
#pragma unroll
        for (int j = 0; j < 4; ++j) { const bool ok = (e0 + j <= t); kb[j] = ok ? __float_as_uint(v[j]) : 0u; amax = fmaxf(amax, ok ? fabsf(v[j]) : 0.f); }
        *(LAS u32x4*)(keys + e0) = kb; }
#pragma unroll
    for (int o = 1; o < 64; o <<= 1) amax = fmaxf(amax, __shfl_xor(amax, o));
    const float ks = 0.49f / fmaxf(amax, 1e-30f);
    unsigned prefix = 0u, need = TOPK_SEL, pmask = 0u, cnt_eq = 0u;
#pragma unroll 1
    for (int pass = 0; pass < 3; ++pass) { const int shift = (pass == 0) ? 15 : (pass == 1 ? 7 : 0); const unsigned dmask = (pass == 2) ? 127u : 255u;
        hist[4 * lane] = 0u; hist[4 * lane + 1] = 0u; hist[4 * lane + 2] = 0u; hist[4 * lane + 3] = 0u;
        LDS_WAIT(); asm volatile("" ::: "memory");
        if (pass == 0) {
#pragma unroll 1
            for (int i0 = 0; i0 < nI; i0 += 8) { unsigned kk[8];
#pragma unroll
                for (int j = 0; j < 8; ++j) { const int e = 64 * (i0 + j) + lane; kk[j] = keys[e & 4095]; }
#pragma unroll
                for (int j = 0; j < 8; ++j) { const int e = 64 * (i0 + j) + lane; kk[j] = (e <= t) ? (__float_as_uint(fmaf(__uint_as_float(kk[j]), ks, 1.5f)) & 0x7fffffu) : 0u; }
#pragma unroll
                for (int j = 0; j < 8; ++j) { const int e = 64 * (i0 + j) + lane; if (i0 + j < nI) keys[e] = kk[j];
                    if (kk[j] != 0u) __hip_atomic_fetch_add(hist + (kk[j] >> 15), 1u, __ATOMIC_RELAXED, __HIP_MEMORY_SCOPE_WORKGROUP); } }
        } else {
#pragma unroll 1
            for (int i0 = 0; i0 < nI; i0 += 8) { unsigned kk[8];
#pragma unroll
                for (int j = 0; j < 8; ++j) { const int e = 64 * (i0 + j) + lane; kk[j] = (i0 + j < nI) ? keys[e & 4095] : 0u; }
#pragma unroll
                for (int j = 0; j < 8; ++j) if ((kk[j] & pmask) == prefix && kk[j] != 0u) __hip_atomic_fetch_add(hist + ((kk[j] >> shift) & dmask), 1u, __ATOMIC_RELAXED, __HIP_MEMORY_SCOPE_WORKGROUP); }
        }
        LDS_WAIT(); asm volatile("" ::: "memory");
        const unsigned c0 = hist[4 * lane], c1 = hist[4 * lane + 1], c2 = hist[4 * lane + 2], c3 = hist[4 * lane + 3];
        const unsigned tot = c0 + c1 + c2 + c3;
        unsigned suf = tot;
#pragma unroll
        for (int o = 1; o < 64; o <<= 1) { const unsigned tt = __shfl_down(suf, o); if (lane + o < 64) suf += tt; }
        unsigned above = suf - tot;
        int found = -1; unsigned nneed = 0u, fcnt = 0u;
        if (above < need && need <= above + c3) { found = 3; nneed = need - above; fcnt = c3; }
        above += c3;
        if (found < 0 && above < need && need <= above + c2) { found = 2; nneed = need - above; fcnt = c2; }
        above += c2;
        if (found < 0 && above < need && need <= above + c1) { found = 1; nneed = need - above; fcnt = c1; }
        above += c1;
        if (found < 0 && above < need && need <= above + c0) { found = 0; nneed = need - above; fcnt = c0; }
        const unsigned long long bal = __ballot(found >= 0);
        const int src = (int)__builtin_ctzll(bal | (1ull << 63));
        const unsigned digit = (unsigned)__shfl(4 * lane + found, src);
        need = (unsigned)__shfl((int)nneed, src); cnt_eq = (unsigned)__shfl((int)fcnt, src);
        prefix |= digit << shift; pmask |= dmask << shift;
        LDS_WAIT(); asm volatile("" ::: "memory");
    }
    const bool all_eq = (cnt_eq == need);
    unsigned run = 0u; unsigned long long myword = 0ull;
    const unsigned long long lt_mask = (lane == 0) ? 0ull : (~0ull >> (64 - lane));
#pragma unroll 4
    for (int i = 0; i < nI; ++i) {
        const unsigned k = keys[64 * i + lane]; bool sel = k > prefix;
        if (all_eq) { sel = sel || (k == prefix); }
        else { const unsigned long long em = __ballot(k == prefix); if (k == prefix) sel = (run + (unsigned)__popcll(em & lt_mask)) < need; run += (unsigned)__popcll(em); }
        const unsigned long long wb = __ballot(sel);
        if (lane == i) myword = wb;
    }
    mrow[lane] = myword;
    LDS_WAIT(); asm volatile("" ::: "memory");
}
__device__ __forceinline__ void p4_select(Frame& F) {
    LAS unsigned* keys = (LAS unsigned*)(F.lds() + F.wave() * 16384); LAS unsigned* hist = (LAS unsigned*)(F.lds() + 131072 + F.wave() * 1024);
    const int gw = F.bid() * 8 + F.wave(), NGW = F.G() * 8;
    for (int pr = gw; pr < SEQ / 2; pr += NGW) {
#pragma unroll 1
        for (int b = 0; b < NBATCH; ++b) { select_row(F, b * SEQ + pr, hist, keys); select_row(F, b * SEQ + (SEQ - 1 - pr), hist, keys); }
    }
}
__device__ __forceinline__ void p4_scan(Frame& F) {
    const CAS float* states = (const CAS float*)(F.ws() + WS_STATES); bf16* hin = WSP(bf16, WS_HIN); const CAS float* csg = (const CAS float*)(F.ws() + WS_CS);
    const int gt = F.bid() * 512 + F.tid(), NGT = F.G() * 512;
    for (int q = gt; q < NBATCH * SSM_H * SSM_P * (SSM_N / 2); q += NGT) {
        const int n = 2 * (q & 63), p = (q >> 6) & 63, h = (q >> 12) & 15, b = q >> 16;
        float h0 = 0.f, h1 = 0.f;
#pragma unroll 8
        for (int c = 0; c < NCHUNK; ++c) {
            const size_t off = ((size_t)((b * NCHUNK + c) * SSM_H + h) * SSM_P + p) * SSM_N + n;
            *(unsigned*)(hin + off) = cvt_pk_bf16(h0, h1);
            const float dec = __expf(csg[(size_t)(b * SEQ + c * CHUNK + CHUNK - 1) * 16 + h]);
            const f32x2 st = *(const CAS f32x2*)(states + off);
            h0 = dec * h0 + st[0]; h1 = dec * h1 + st[1];
        }
    }
}
namespace att {
constexpr int KVBLK = 64, SHM_K = KVBLK * 128 * 2, SHM_V = SHM_K;
constexpr float SCALE = 0.08838834764831845f, THR = 8.f, C2 = 1.4426950408889634f * SCALE;
#define KSWZ(row, colB) ((row) * 256 + ((colB) ^ (((row) & 7) << 4)))
__device__ __forceinline__ int v_st(int k, int c) { const int kk = (k & ~0xC) | ((k & 4) << 1) | ((k & 8) >> 1); return ((kk >> 3) * 4 + (c >> 5)) * 512 + ((kk & 7) * 32 + (c & 31)) * 2; }
__device__ __forceinline__ int v_rd_base(int lane) { return ((lane & 3) << 3) | (((lane >> 2) & 3) << 6) | (((lane >> 4) & 1) << 5) | (((lane >> 5) & 1) << 8); }
constexpr int v_rd_off(int d0, int ks, int half) { return d0 * 512 + ks * 4096 + half * 2048; }
template <int KB>
__device__ __forceinline__ void qkt(f32x16& p0, f32x16& p1, LAS const char* K_lds, int r32, int hi, const bf16x8* qr) {
    p0 = f32x16{}; p1 = f32x16{};
    LAS const char* kb[4];
#pragma unroll
    for (int dd = 0; dd < 4; ++dd) kb[dd] = K_lds + KB * SHM_K + KSWZ(r32, (dd * 16 + hi * 8) * 2);
#pragma unroll
    for (int d0 = 0; d0 < 8; ++d0) { LAS const char* a = kb[d0 & 3] + (d0 >> 2) * 128;
        const bf16x8 b0 = *(LAS const bf16x8*)a;
        const bf16x8 b1 = *(LAS const bf16x8*)(a + 32 * 256);
        p0 = __builtin_amdgcn_mfma_f32_32x32x16_bf16(b0, qr[d0], p0, 0, 0, 0);
        p1 = __builtin_amdgcn_mfma_f32_32x32x16_bf16(b1, qr[d0], p1, 0, 0, 0); }
}
template <int VB>
__device__ __forceinline__ void pv_tile(f32x16* o, int vb0, bf16x8 pa0, bf16x8 pa1, bf16x8 pa2, bf16x8 pa3) {
#define TRRD(dst, off) asm volatile("ds_read_b64_tr_b16 %0, %1 offset:%2" : "=&v"(dst) : "v"(vb0), "i"(off) : "memory")
#define PV_D0(d0) do { s16x4 l0, l1, l2, l3, h0, h1, h2, h3; constexpr int b_ = VB * SHM_V + v_rd_off(d0, 0, 0); \
        TRRD(l0, b_); TRRD(h0, b_ + 2048); TRRD(l1, b_ + 4096); TRRD(h1, b_ + 6144); TRRD(l2, b_ + 8192); TRRD(h2, b_ + 10240); TRRD(l3, b_ + 12288); TRRD(h3, b_ + 14336); \
        asm volatile("s_waitcnt lgkmcnt(0)" ::: "memory"); __builtin_amdgcn_sched_barrier(0); \
        o[d0] = __builtin_amdgcn_mfma_f32_32x32x16_bf16(pa0, (bf16x8){l0[0], l0[1], l0[2], l0[3], h0[0], h0[1], h0[2], h0[3]}, o[d0], 0, 0, 0);   \
        o[d0] = __builtin_amdgcn_mfma_f32_32x32x16_bf16(pa1, (bf16x8){l1[0], l1[1], l1[2], l1[3], h1[0], h1[1], h1[2], h1[3]}, o[d0], 0, 0, 0);   \
        o[d0] = __builtin_amdgcn_mfma_f32_32x32x16_bf16(pa2, (bf16x8){l2[0], l2[1], l2[2], l2[3], h2[0], h2[1], h2[2], h2[3]}, o[d0], 0, 0, 0);   \
        o[d0] = __builtin_amdgcn_mfma_f32_32x32x16_bf16(pa3, (bf16x8){l3[0], l3[1], l3[2], l3[3], h3[0], h3[1], h3[2], h3[3]}, o[d0], 0, 0, 0); } while (0)
    PV_D0(0); PV_D0(1); PV_D0(2); PV_D0(3);
#undef PV_D0
#undef TRRD
}
__device__ __forceinline__ void softmax_tile(f32x16& p0, f32x16& p1, unsigned long long mw, int hi, float& m_reg, float& l_reg, float& alpha, bf16x8& pa0, bf16x8& pa1, bf16x8& pa2, bf16x8& pa3) {
    float pmax = p0[0];
#pragma unroll
    for (int r = 1; r < 16; ++r) pmax = fmaxf(pmax, p0[r]);
#pragma unroll
    for (int r = 0; r < 16; ++r) pmax = fmaxf(pmax, p1[r]);
    { auto rr = __builtin_amdgcn_permlane32_swap(__float_as_uint(pmax), __float_as_uint(pmax), false, false); pmax = fmaxf(__uint_as_float(rr[0]), __uint_as_float(rr[1])); }
    float mn;
    if (__all((pmax - m_reg) * SCALE <= THR)) { mn = m_reg; alpha = 1.f; }
    else { mn = fmaxf(m_reg, pmax); alpha = __builtin_amdgcn_exp2f((m_reg - mn) * C2); m_reg = mn; }
    const float mnL = -mn * C2;
    const int lo = (int)((unsigned)mw >> (4 * hi)), hh = (int)((unsigned)(mw >> 32) >> (4 * hi));
#pragma unroll
    for (int r = 0; r < 16; ++r) { const int c = (r & 3) + 8 * (r >> 2);
        const float e0 = __builtin_amdgcn_exp2f(fmaf(p0[r], C2, mnL)), e1 = __builtin_amdgcn_exp2f(fmaf(p1[r], C2, mnL));
        p0[r] = __uint_as_float(__float_as_uint(e0) & (unsigned)__builtin_amdgcn_sbfe(lo, c, 1));
        p1[r] = __uint_as_float(__float_as_uint(e1) & (unsigned)__builtin_amdgcn_sbfe(hh, c, 1)); }
    float ps = 0.f;
#pragma unroll
    for (int r = 0; r < 16; ++r) ps += p0[r];
#pragma unroll
    for (int r = 0; r < 16; ++r) ps += p1[r];
    { auto rr = __builtin_amdgcn_permlane32_swap(__float_as_uint(ps), __float_as_uint(ps), false, false); ps = __uint_as_float(rr[0]) + __uint_as_float(rr[1]); }
    l_reg = l_reg * alpha + ps;
#define PK4(P, B_, OUT) do { unsigned a0 = cvt_pk_bf16(P[B_+0], P[B_+1]), a1 = cvt_pk_bf16(P[B_+2], P[B_+3]); \
        unsigned b0 = cvt_pk_bf16(P[B_+4], P[B_+5]), b1 = cvt_pk_bf16(P[B_+6], P[B_+7]); \
        auto r0 = __builtin_amdgcn_permlane32_swap(a0, b0, false, false); auto r1 = __builtin_amdgcn_permlane32_swap(a1, b1, false, false); \
        u32x4 w = {r0[0], r1[0], r0[1], r1[1]}; OUT = __builtin_bit_cast(bf16x8, w); } while (0)
    PK4(p0, 0, pa0); PK4(p0, 8, pa1); PK4(p1, 0, pa2); PK4(p1, 8, pa3);
#undef PK4
}
}

__device__ __forceinline__ void attn_item(Frame& F, int b, int h, int X) {
    using namespace att;
    const bf16* qg = WSP(const bf16, WS_Q); const bf16* kg = WSP(const bf16, WS_K) + (size_t)(b * SEQ) * 1024 + h * 128; const bf16* vg = WSP(const bf16, WS_V) + (size_t)(b * SEQ) * 1024 + h * 128;
    const unsigned long long* maskg = WSP(const unsigned long long, WS_MASK); bf16* ycat = WSP(bf16, WS_YCAT);
    const int tid = F.tid(), wid = F.wave(), lane = F.lane(), r32 = lane & 31, hi = lane >> 5;
    LAS char* V_lds = (LAS char*)F.lds(); LAS char* K_lds = V_lds + 2 * SHM_V;
    LAS float* wsl = (LAS float*)(F.lds() + 2 * SHM_V + 2 * SHM_K) + wid * 64; LAS float* li_l = wsl; LAS float* al_l = wsl + 32;
    const int tokq = b * SEQ + X * 256 + wid * 32 + r32, NT = 4 * X + 4;
    bf16x8 qr[8];
#pragma unroll
    for (int d0 = 0; d0 < 8; ++d0) qr[d0] = *(const bf16x8*)(qg + (size_t)tokq * 1024 + h * 128 + d0 * 16 + hi * 8);
    const unsigned long long* mrow = maskg + (size_t)tokq * 64;
    const int sr = tid >> 4, sc = (tid & 15) * 8, vst0 = v_st(sr, sc), vst1 = v_st(32 + sr, sc), kws = KSWZ(sr, sc * 2);
    const int vb0 = (int)(unsigned)(uintptr_t)V_lds + v_rd_base(lane);
    float m_reg = -1e30f, l_reg = 0.f; f32x16 o[4] = {};
    bf16x8 sA[4], sB[4];
    unsigned long long mwE, mwO;
#define ALOAD(S, t) do { const size_t r0_ = (size_t)((t) * KVBLK + sr) * 1024 + sc; S[0] = *(const bf16x8*)(kg + r0_); S[1] = *(const bf16x8*)(kg + r0_ + 32 * 1024); \
                         S[2] = *(const bf16x8*)(vg + r0_); S[3] = *(const bf16x8*)(vg + r0_ + 32 * 1024); } while (0)
#define AWRITE(S, bf) do { *(LAS bf16x8*)(K_lds + (bf) * SHM_K + kws) = S[0]; *(LAS bf16x8*)(K_lds + (bf) * SHM_K + kws + 32 * 256) = S[1]; \
                           *(LAS bf16x8*)(V_lds + (bf) * SHM_V + vst0) = S[2]; *(LAS bf16x8*)(V_lds + (bf) * SHM_V + vst1) = S[3]; } while (0)
#define ASTEP(t, KB, SW, MW) do { __syncthreads(); \
        if ((t) + 1 < NT) AWRITE(SW, (KB) ^ 1); \
        if ((t) + 3 < NT) ALOAD(SW, (t) + 3); \
        const unsigned long long mw_ = MW; if ((t) + 2 < NT) MW = mrow[(t) + 2]; \
        f32x16 p0, p1; float alpha; bf16x8 pa0, pa1, pa2, pa3; \
        qkt<KB>(p0, p1, K_lds, r32, hi, qr); \
        softmax_tile(p0, p1, mw_, hi, m_reg, l_reg, alpha, pa0, pa1, pa2, pa3); \
        if (__any(alpha < 1.f)) { if (hi == 0) al_l[r32] = alpha; LDS_WAIT(); \
            _Pragma("unroll") for (int d_ = 0; d_ < 4; ++d_) _Pragma("unroll") for (int r = 0; r < 16; ++r) o[d_][r] *= al_l[crow(r, hi)]; } \
        pv_tile<KB>(o, vb0, pa0, pa1, pa2, pa3); } while (0)
    ALOAD(sA, 0); mwE = mrow[0]; mwO = mrow[1];
    AWRITE(sA, 0);
    ALOAD(sB, 1); ALOAD(sA, 2);
    for (int t = 0; t < NT; t += 2) { ASTEP(t, 0, sB, mwE); ASTEP(t + 1, 1, sA, mwO); }
#undef ASTEP
#undef AWRITE
#undef ALOAD
    if (hi == 0) li_l[r32] = l_reg; LDS_WAIT();
    float rli[16];
#pragma unroll
    for (int r = 0; r < 16; ++r) rli[r] = __builtin_amdgcn_rcpf(li_l[crow(r, hi)]);
    bf16* Ow = ycat + (size_t)(b * SEQ + X * 256 + wid * 32) * DM + D_SSM + h * 128;
#pragma unroll
    for (int r = 0; r < 16; ++r) { const int orow = crow(r, hi);
#pragma unroll
        for (int d0 = 0; d0 < 4; ++d0) { const float v = o[d0][r] * rli[r]; const float vn = __shfl_xor(v, 1);
            if ((r32 & 1) == 0) *(unsigned*)(Ow + (size_t)orow * DM + d0 * 32 + r32) = cvt_pk_bf16(v, vn); } }
    __syncthreads();
}

__device__ __forceinline__ void ssd_c_unit(Frame& F, int b, int c, int lq) {
    const CAS bf16* xact = (const CAS bf16*)(F.ws() + WS_XBCACT); const CAS bf16* hin = (const CAS bf16*)(F.ws() + WS_HIN); const CAS float* csg = (const CAS float*)(F.ws() + WS_CS);
    const CAS float* ydiag = (const CAS float*)(F.ws() + WS_YDIAG); const CAS bf16* zg = (const CAS bf16*)(F.ws() + WS_Z); bf16* ycat = WSP(bf16, WS_YCAT);
    LAS float* gb = (LAS float*)F.lds();
    const int lane = F.lane(), r32 = lane & 31, hi = lane >> 5, w = F.wave(), g = w >> 2;
    const int tok0 = b * SEQ + c * CHUNK + lq * 32;
    bf16x8 Af[8];
#pragma unroll
    for (int ks = 0; ks < 8; ++ks) Af[ks] = *(const CAS bf16x8*)(xact + (size_t)(tok0 + r32) * CONV_CH + 1280 + g * 128 + 16 * ks + 8 * hi);
#pragma unroll
    for (int hh = 0; hh < 2; ++hh) { const int h = 2 * w + hh;
        const CAS bf16* hp = hin + ((size_t)((b * NCHUNK + c) * SSM_H + h) * SSM_P) * SSM_N;
        float e[16];
#pragma unroll
        for (int r = 0; r < 16; ++r) e[r] = csg[(size_t)(tok0 + crow(r, hi)) * 16 + h];
        f32x16 a0 = {}, a1 = {};
#pragma unroll
        for (int ks = 0; ks < 8; ++ks) { const bf16x8 b0 = *(const CAS bf16x8*)(hp + (size_t)r32 * SSM_N + 16 * ks + 8 * hi), b1 = *(const CAS bf16x8*)(hp + (size_t)(32 + r32) * SSM_N + 16 * ks + 8 * hi);
            a0 = __builtin_amdgcn_mfma_f32_32x32x16_bf16(Af[ks], b0, a0, 0, 0, 0); a1 = __builtin_amdgcn_mfma_f32_32x32x16_bf16(Af[ks], b1, a1, 0, 0, 0); }
#pragma unroll
        for (int r = 0; r < 16; ++r) { const float ee = __expf(e[r]); LAS float* p = gb + crow(r, hi) * 1024 + h * 64 + r32; p[0] = ee * a0[r]; p[32] = ee * a1[r]; } }
    __syncthreads();
    f32x4 dsk[4], nw[4];
#pragma unroll
    for (int j = 0; j < 4; ++j) { const float d = F.f(10)[4 * j + (lane >> 4)]; dsk[j] = (f32x4){d, d, d, d}; nw[j] = *(const CAS f32x4*)(F.f(11) + j * 256 + lane * 4); }
    f32x4 yd[4][4]; u32x2 xs[4][4], zz[4][4];
#pragma unroll
    for (int rr = 0; rr < 4; ++rr) { const size_t tok = (size_t)(tok0 + 4 * w + rr);
#pragma unroll
        for (int j = 0; j < 4; ++j) { const int col = j * 256 + lane * 4; yd[rr][j] = *(const CAS f32x4*)(ydiag + tok * D_SSM + col);
            xs[rr][j] = *(const CAS u32x2*)(xact + tok * CONV_CH + col); zz[rr][j] = *(const CAS u32x2*)(zg + tok * 1024 + col); } }
#pragma unroll
    for (int rr = 0; rr < 4; ++rr) { const int l = 4 * w + rr; float ss = 0.f; f32x4 v[4];
#pragma unroll
        for (int j = 0; j < 4; ++j) { const f32x4 yo = *(const LAS f32x4*)(gb + l * 1024 + j * 256 + lane * 4);
            const f32x4 xf = {bflo(xs[rr][j][0]), bfhi(xs[rr][j][0]), bflo(xs[rr][j][1]), bfhi(xs[rr][j][1])}, zf = {bflo(zz[rr][j][0]), bfhi(zz[rr][j][0]), bflo(zz[rr][j][1]), bfhi(zz[rr][j][1])};
            f32x4 y = yd[rr][j] + yo + dsk[j] * xf;
#pragma unroll
            for (int i = 0; i < 4; ++i) y[i] *= silu_f(zf[i]);
            v[j] = y; ss += (y[0] * y[0] + y[1] * y[1]) + (y[2] * y[2] + y[3] * y[3]); }
        const float rs = 1.0f / sqrtf(wave_sum(ss) * (1.0f / 1024.0f) + LN_EPS);
#pragma unroll
        for (int j = 0; j < 4; ++j) { const f32x4 y = v[j] * rs * nw[j];
            *(u32x2*)(ycat + (size_t)(tok0 + l) * DM + j * 256 + lane * 4) = (u32x2){cvt_pk_bf16(y[0], y[1]), cvt_pk_bf16(y[2], y[3])}; } }
    __syncthreads();
}
__device__ __forceinline__ void p5_phase(Frame& F) {
    for (int L = F.bid(); L < 256; L += F.G()) { const int lq = L & 3, c = (L >> 2) & 31, b = L >> 7; ssd_c_unit(F, b, c, lq); }
    PSUB(50, 0);
    for (int L = F.bid(); L < 256; L += F.G()) { const int X = 15 - (L >> 4), h = L & 7, b = (L >> 3) & 1; attn_item(F, b, h, X); }
    PSUB(50, 1);
}
struct EpiOutProj {
    static constexpr bool PERM = false;
    const CAS float* x; const CAS float* modf; float* out;
    __device__ __forceinline__ void operator()(const f32x4 (&acc)[2][2][4][2], const pg8::Unit& u, int wr, int wc, int fr, int fq) const {
        const int row0 = u.pm * 256 + wr * 64 + fr, col0 = u.pn * 256 + wc * 32 + 4 * fq; const int b = (u.pm * 256) / SEQ;
        f32x4 gv[2][2];
#pragma unroll
        for (int bj = 0; bj < 2; ++bj)
#pragma unroll
            for (int n = 0; n < 2; ++n) gv[bj][n] = *(const CAS f32x4*)(modf + (size_t)b * (6 * DM) + 2 * DM + col0 + bj * 128 + n * 16);
#pragma unroll
        for (int ai = 0; ai < 2; ++ai)
#pragma unroll
            for (int m = 0; m < 4; ++m) { const size_t off = (size_t)(row0 + ai * 128 + m * 16) * DM + col0;
#pragma unroll
                for (int bj = 0; bj < 2; ++bj)
#pragma unroll
                    for (int n = 0; n < 2; ++n) { const f32x4 xv = *(const CAS f32x4*)(x + off + bj * 128 + n * 16);
                        *(f32x4*)(out + off + bj * 128 + n * 16) = xv * ALPHA_DN + gv[bj][n] * acc[ai][bj][m][n]; } }
    }
};

constexpr int RT_P = 2056;
__device__ __forceinline__ void p7_unit(Frame& F, int un) {
    const CAS float* modf = (const CAS float*)(F.ws() + WS_MODF); bf16* u2 = WSP(bf16, WS_U2); const CAS bf16* wr_hi = (const CAS bf16*)(F.ws() + WS_WR); const CAS bf16* wr_lo = wr_hi + NE * DM;
    int* inv = WSP(int, WS_INV); int* ltok = WSP(int, WS_LTOK); float* lw = WSP(float, WS_LW);
    LAS bf16* Ah = (LAS bf16*)F.lds(); LAS bf16* Al = Ah + 16 * RT_P; LAS float* red = (LAS float*)F.lds();
    LAS float* logit = (LAS float*)(F.lds() + 135168);
    LAS int* ecnt = (LAS int*)(F.lds() + 139264); LAS int* ebase = ecnt + 64;
    const int lane = F.lane(), w = F.wave(), row0 = un * 16, b = row0 / SEQ;
    const CAS float* sh2 = modf + (size_t)b * (6 * DM) + 3 * DM; const CAS float* sc2 = modf + (size_t)b * (6 * DM) + 4 * DM;
    PSUB(70, 0); PSUB(71, 0);
#pragma unroll 1
    for (int rr = 0; rr < 2; ++rr) { const int rl = 2 * w + rr; const size_t row = (size_t)(row0 + rl);
        f32x4 v[8]; float s = 0.f;
#pragma unroll
        for (int j = 0; j < 8; ++j) { v[j] = *(const f32x4*)(F.out() + row * DM + j * 256 + lane * 4); s += (v[j][0] + v[j][1]) + (v[j][2] + v[j][3]); }
        const float mu = wave_sum(s) * (1.0f / DM); float q = 0.f;
#pragma unroll
        for (int j = 0; j < 8; ++j) { v[j] = v[j] - mu; q += (v[j][0] * v[j][0] + v[j][1] * v[j][1]) + (v[j][2] * v[j][2] + v[j][3] * v[j][3]); }
        const float rstd = 1.0f / sqrtf(wave_sum(q) * (1.0f / DM) + LN_EPS);
#pragma unroll
        for (int j = 0; j < 8; ++j) { const int col = j * 256 + lane * 4;
            const f32x4 x1 = v[j] * rstd * *(const CAS f32x4*)(F.f(15) + col) + *(const CAS f32x4*)(F.f(16) + col);
            *(f32x4*)(F.out() + row * DM + col) = x1;
            const f32x4 uu = x1 * (*(const CAS f32x4*)(sc2 + col) + 1.0f) + *(const CAS f32x4*)(sh2 + col);
            const unsigned h0 = cvt_pk_bf16(uu[0], uu[1]), h1 = cvt_pk_bf16(uu[2], uu[3]);
#if MOE_FP8
            { unsigned q8 = (unsigned)__builtin_amdgcn_cvt_pk_fp8_f32(uu[0] * U8_SCALE, uu[1] * U8_SCALE, 0, false); q8 = (unsigned)__builtin_amdgcn_cvt_pk_fp8_f32(uu[2] * U8_SCALE, uu[3] * U8_SCALE, (int)q8, true); *(unsigned*)((unsigned char*)u2 + row * DM + col) = q8; }
#else
            *(u32x2*)(u2 + row * DM + col) = (u32x2){h0, h1};
#endif
            const unsigned l0 = cvt_pk_bf16(uu[0] - bflo(h0), uu[1] - bfhi(h0)), l1 = cvt_pk_bf16(uu[2] - bflo(h1), uu[3] - bfhi(h1));
            *(LAS u32x2*)(Ah + rl * RT_P + col) = (u32x2){h0, h1}; *(LAS u32x2*)(Al + rl * RT_P + col) = (u32x2){l0, l1}; } }
    if (F.tid() < 64) ecnt[F.tid()] = 0;
    __syncthreads();
    PSUB(70, 1); PSUB(72, 0);
    f32x4 acc[4] = {};
    { const int fr = lane & 15, fq = lane >> 4;
      bf16x8 bh[4][4], bl[4][4];
#pragma unroll
      for (int kb = 0; kb < 2; ++kb) {
#pragma unroll
          for (int kq = 0; kq < 4; ++kq) { const int k0_ = w * 256 + (4 * kb + kq) * 32 + fq * 8;
#pragma unroll
              for (int nt = 0; nt < 4; ++nt) { bh[kq][nt] = *(const CAS bf16x8*)(wr_hi + (size_t)(16 * nt + fr) * DM + k0_); bl[kq][nt] = *(const CAS bf16x8*)(wr_lo + (size_t)(16 * nt + fr) * DM + k0_); } }
#pragma unroll
          for (int kq = 0; kq < 4; ++kq) { const int k0_ = w * 256 + (4 * kb + kq) * 32 + fq * 8;
              const bf16x8 ah = *(const LAS bf16x8*)(Ah + fr * RT_P + k0_), al = *(const LAS bf16x8*)(Al + fr * RT_P + k0_);
#pragma unroll
              for (int nt = 0; nt < 4; ++nt) { acc[nt] = __builtin_amdgcn_mfma_f32_16x16x32_bf16(ah, bh[kq][nt], acc[nt], 0, 0, 0);
                  acc[nt] = __builtin_amdgcn_mfma_f32_16x16x32_bf16(al, bh[kq][nt], acc[nt], 0, 0, 0); acc[nt] = __builtin_amdgcn_mfma_f32_16x16x32_bf16(ah, bl[kq][nt], acc[nt], 0, 0, 0); } } }
      __syncthreads();
#pragma unroll
      for (int nt = 0; nt < 4; ++nt)
#pragma unroll
          for (int r = 0; r < 4; ++r) red[(w * 16 + fq * 4 + r) * 64 + 16 * nt + fr] = acc[nt][r]; }
    __syncthreads();
#pragma unroll
    for (int i = 0; i < 2; ++i) { const int o = F.tid() + 512 * i; float s = 0.f;
#pragma unroll
        for (int ww = 0; ww < 8; ++ww) s += red[ww * 1024 + o];
        logit[o] = s; }
    __syncthreads();
    PSUB(72, 1); PSUB(73, 0);
    float score_[2]; int erank_[2]; bool sel_[2];
#pragma unroll
    for (int rr = 0; rr < 2; ++rr) { const int rl = 2 * w + rr;
        const float score = sigmoid_f(logit[rl * 64 + lane]); const float biased = score + F.f(18)[lane];
        float m1 = biased;
#pragma unroll
        for (int o = 1; o < 8; o <<= 1) m1 = fmaxf(m1, __shfl_xor(m1, o));
        int i1 = (biased == m1) ? lane : 64;
#pragma unroll
        for (int o = 1; o < 8; o <<= 1) i1 = min(i1, __shfl_xor(i1, o));
        float m2 = (lane == i1) ? -__builtin_inff() : biased;
#pragma unroll
        for (int o = 1; o < 8; o <<= 1) m2 = fmaxf(m2, __shfl_xor(m2, o));
        const float gs = m1 + m2; const int grp = lane >> 3;
        int grank = 0;
#pragma unroll
        for (int g2 = 0; g2 < 8; ++g2) { const float og = __int_as_float(__builtin_amdgcn_readlane(__float_as_int(gs), 8 * g2)); grank += (og > gs || (og == gs && g2 < grp)) ? 1 : 0; }
        const float mk = (grank < 4) ? biased : -__builtin_inff();
        int erank = 0;
#pragma unroll 8
        for (int e2 = 0; e2 < 64; ++e2) { const float oe = __int_as_float(__builtin_amdgcn_readlane(__float_as_int(mk), e2)); erank += (oe > mk || (oe == mk && e2 < lane)) ? 1 : 0; }
        score_[rr] = score; erank_[rr] = erank; sel_[rr] = erank < 8; }
    int lr_[2]; float gw_[2];
#pragma unroll
    for (int rr = 0; rr < 2; ++rr) { const float wsum = wave_sum(sel_[rr] ? score_[rr] : 0.f); gw_[rr] = score_[rr] / wsum * 2.5f;
        lr_[rr] = sel_[rr] ? __hip_atomic_fetch_add(ecnt + lane, 1, __ATOMIC_RELAXED, __HIP_MEMORY_SCOPE_WORKGROUP) : 0; }
    __syncthreads();
    if (w == 0) { const int c = ecnt[lane]; ebase[lane] = c ? (int)__hip_atomic_fetch_add(F.ctl() + CW_ECNT + 64 * lane, (unsigned)c, RLX_AGENT) : 0; }
    __syncthreads();
#pragma unroll
    for (int rr = 0; rr < 2; ++rr) { const int tok = row0 + 2 * w + rr;
        if (sel_[rr]) { const int rk = ebase[lane] + lr_[rr];
            ltok[lane * NTOK + rk] = tok; lw[lane * NTOK + rk] = gw_[rr]; inv[tok * 8 + erank_[rr]] = lane * NTOK + rk; } }
    __syncthreads();
    PSUB(73, 1); PSUB(71, 1);
}
__device__ __forceinline__ void p7_phase(Frame& F) { for (int un = F.bid(); un < NTOK / 16; un += F.G()) p7_unit(F, un); }
struct MoeOrder {
    unsigned char* ws; int G, c, npn, total;
    __device__ __forceinline__ bool next(int i, pg8::Unit& u) const {
        const LAS int* tab = (const LAS int*)(lds_base() + LDS_MISC + 64);
        const int L = i * G + c; if (L >= total) return false;
        int e = 0;
#pragma unroll
        for (int st = 64; st >= 1; st >>= 1) { const int k = e + st; if (k < NEX && tab[80 + k] * npn <= L) e = k; }
        e = __builtin_amdgcn_readfirstlane(e);
        const int t0 = __builtin_amdgcn_readfirstlane(tab[80 + e]), t1 = __builtin_amdgcn_readfirstlane(tab[80 + e + 1]);
        const int nte = t1 - t0, rem = L - t0 * npn;
        const int mt = (npn == 8) ? rem / npn : rem % nte, pn = (npn == 8) ? rem % npn : rem / nte;
        u.pm = t0 + mt; u.pn = e * npn + pn; u.ax = (e << 8) | mt; u.cnt = (e == NE) ? NTOK : __builtin_amdgcn_readfirstlane(tab[e]); return true;
    }
    __device__ __forceinline__ int row_tok(const pg8::Unit& u, int r) const {
        const int* ltok = (const int*)(ws + WS_LTOK);
        const int e = u.ax >> 8, idx = (u.ax & 255) * 256 + r;
        if (e == NE) return idx;
        return idx < u.cnt ? ltok[e * NTOK + idx] : 0;
    }
};
__device__ __forceinline__ void moe_tables(Frame& F) {
    LAS int* tab = (LAS int*)(F.lds() + LDS_MISC + 64);
    if (F.wave() == 0) { const int lane = F.lane();
        const int cn = (int)__hip_atomic_load(F.ctl() + CW_ECNT + 64 * lane, RLX_AGENT); const int nt = (cn + 255) >> 8;
        int inc = nt;
#pragma unroll
        for (int o = 1; o < 64; o <<= 1) { const int t = __shfl_up(inc, o); if (lane >= o) inc += t; }
        tab[lane] = cn; tab[80 + lane] = inc - nt;
        if (lane == 63) { tab[NE] = NTOK; tab[80 + NE] = inc; tab[80 + NEX] = inc + NTOK / 256; } }
    __syncthreads();
}
struct EpiGateUp {
    static constexpr bool PERM = true;
    unsigned char* ws;
    __device__ __forceinline__ void operator()(const f32x4 (&acc)[2][2][4][2], const pg8::Unit& u, int wr, int wc, int fr, int fq) const {
        const CAS float* lw = (const CAS float*)(ws + WS_LW); unsigned char* hid = ws + WS_HID;
        const int e = u.ax >> 8, mt = u.ax & 255, pn = u.pn & 3; const int cnt = u.cnt;
#pragma unroll
        for (int ai = 0; ai < 2; ++ai)
#pragma unroll
            for (int m = 0; m < 4; ++m) { const int rl = ai * 128 + wr * 64 + m * 16 + fr, idx = mt * 256 + rl;
                const float gw = (e == NE) ? 1.0f : (idx < cnt ? lw[e * NTOK + idx] : 0.0f);
                f32x4 h0, h1;
#pragma unroll
                for (int i = 0; i < 4; ++i) { h0[i] = silu_f(acc[ai][0][m][0][i]) * acc[ai][1][m][0][i] * gw; h1[i] = silu_f(acc[ai][0][m][1][i]) * acc[ai][1][m][1][i] * gw; }
#if MOE_FP8_DN
                unsigned lo = (unsigned)__builtin_amdgcn_cvt_pk_fp8_f32(h0[0] * H8_SCALE, h0[1] * H8_SCALE, 0, false); lo = (unsigned)__builtin_amdgcn_cvt_pk_fp8_f32(h0[2] * H8_SCALE, h0[3] * H8_SCALE, (int)lo, true);
                unsigned hi = (unsigned)__builtin_amdgcn_cvt_pk_fp8_f32(h1[0] * H8_SCALE, h1[1] * H8_SCALE, 0, false); hi = (unsigned)__builtin_amdgcn_cvt_pk_fp8_f32(h1[2] * H8_SCALE, h1[3] * H8_SCALE, (int)hi, true);
                *(u32x2*)(hid + (size_t)(u.pm * 256 + rl) * DE + pn * 128 + wc * 32 + 8 * fq) = (u32x2){lo, hi}; }
#else
                u32x4 w = {cvt_pk_bf16(h0[0], h0[1]), cvt_pk_bf16(h0[2], h0[3]), cvt_pk_bf16(h1[0], h1[1]), cvt_pk_bf16(h1[2], h1[3])};
                *(u32x4*)((bf16*)hid + (size_t)(u.pm * 256 + rl) * DE + pn * 128 + wc * 32 + 8 * fq) = w; }
#endif
    }
};
constexpr float OUT_SCALE = 32.0f, OUT_INV = 1.0f / 32.0f;
__device__ __forceinline__ unsigned pk4_fp8(f32x4 v) { unsigned w = (unsigned)__builtin_amdgcn_cvt_pk_fp8_f32(v[0] * OUT_SCALE, v[1] * OUT_SCALE, 0, false); return (unsigned)__builtin_amdgcn_cvt_pk_fp8_f32(v[2] * OUT_SCALE, v[3] * OUT_SCALE, (int)w, true); }
struct EpiDown {
    static constexpr bool PERM = true;
    unsigned char* outs;
    __device__ __forceinline__ void operator()(const f32x4 (&acc)[2][2][4][2], const pg8::Unit& u, int wr, int wc, int fr, int fq) const {
        const int pn = u.pn & 7;
#pragma unroll
        for (int ai = 0; ai < 2; ++ai)
#pragma unroll
            for (int m = 0; m < 4; ++m) { unsigned char* rowp = outs + (size_t)(u.pm * 256 + ai * 128 + wr * 64 + m * 16 + fr) * DM + pn * 256 + 64 * wc + 16 * fq;
                const u32x4 w = {pk4_fp8(acc[ai][0][m][0]), pk4_fp8(acc[ai][0][m][1]), pk4_fp8(acc[ai][1][m][0]), pk4_fp8(acc[ai][1][m][1])};
                *(u32x4*)rowp = w; }
    }
};
__device__ __forceinline__ void p10_final(Frame& F) {
    const CAS float* modf = (const CAS float*)(F.ws() + WS_MODF); const CAS unsigned char* outs = (const CAS unsigned char*)(F.ws() + WS_OUTS); const CAS int* inv = (const CAS int*)(F.ws() + WS_INV);
    const LAS int* tab = (const LAS int*)(F.lds() + LDS_MISC + 64);
    const int gw = F.bid() * 8 + F.wave(), NGW = F.G() * 8;
    for (int tok = gw; tok < NTOK; tok += NGW) { int lane = F.lane(); asm volatile("" : "+v"(lane)); const int b = tok / SEQ; const CAS float* g2 = modf + (size_t)b * (6 * DM) + 5 * DM;
        size_t rows[9];
#pragma unroll
        for (int k = 0; k < 8; ++k) { const int iv = inv[tok * 8 + k]; const int e = iv / NTOK, rk = iv % NTOK; rows[k] = (size_t)(tab[80 + e] * 256 + rk); }
        rows[8] = (size_t)(tab[80 + NE] * 256 + tok);
        f32x4 v[8]; float s = 0.f;
#pragma unroll
        for (int jj = 0; jj < 2; ++jj) { const int col = jj * 1024 + lane * 16; f32x4 f[4] = {};
#pragma unroll
            for (int k = 0; k < 9; ++k) { const u32x4 w = *(const CAS u32x4*)(outs + rows[k] * DM + col);
#pragma unroll
                for (int d = 0; d < 4; ++d) { const f32x2 lo = __builtin_amdgcn_cvt_pk_f32_fp8((int)w[d], false), hi = __builtin_amdgcn_cvt_pk_f32_fp8((int)w[d], true);
                    f[d][0] += lo[0]; f[d][1] += lo[1]; f[d][2] += hi[0]; f[d][3] += hi[1]; } }
#pragma unroll
            for (int d = 0; d < 4; ++d) { const f32x4 x1 = *(const f32x4*)(F.out() + (size_t)tok * DM + col + 4 * d);
                v[4 * jj + d] = x1 * ALPHA_DN + *(const CAS f32x4*)(g2 + col + 4 * d) * (f[d] * OUT_INV);
                s += (v[4 * jj + d][0] + v[4 * jj + d][1]) + (v[4 * jj + d][2] + v[4 * jj + d][3]); } }
        const float mu = wave_sum(s) * (1.0f / DM); float q = 0.f;
#pragma unroll
        for (int j = 0; j < 8; ++j) { v[j] = v[j] - mu; q += (v[j][0] * v[j][0] + v[j][1] * v[j][1]) + (v[j][2] * v[j][2] + v[j][3] * v[j][3]); }
        const float rstd = 1.0f / sqrtf(wave_sum(q) * (1.0f / DM) + LN_EPS);
#pragma unroll
        for (int j = 0; j < 8; ++j) { const int col = (j >> 2) * 1024 + lane * 16 + (j & 3) * 4;
            *(f32x4*)(F.out() + (size_t)tok * DM + col) = v[j] * rstd * *(const CAS f32x4*)(F.f(25) + col) + *(const CAS f32x4*)(F.f(26) + col); } }
}
#ifndef MK_N_LAUNCHES
#define MK_N_LAUNCHES 1
#endif
constexpr int N_PHASES = 11;
__global__ void __launch_bounds__(512, 2) fwd_kernel(Args args) {
    Frame F; F.ap = &args;
    if (F.tid() < 16) ((LAS unsigned*)(F.lds() + LDS_MISC))[F.tid()] = 0u;
    __syncthreads();
    if (args.ph_hi - args.ph_lo > 1) (void)xcd_barrier_post((unsigned*)(F.ctl() + CW_BAR), (volatile LAS unsigned*)(F.lds() + LDS_MISC));
#ifndef PH_MASK
#define PH_MASK 0x7ff
#endif
#define IN(k) (((PH_MASK >> (k)) & 1) && args.ph_lo <= (k) && (k) < args.ph_hi)
#ifdef PROBE_PHASE
    unsigned long long pt0_ = __builtin_amdgcn_s_memrealtime(), pt1_ = 0ull;
#ifdef PROBE_SUB
#define PMARK(k) do { } while (0)
#else
#define PMARK(k) do { if ((k) + 1 == PROBE_PHASE) pt0_ = __builtin_amdgcn_s_memrealtime(); if ((k) == PROBE_PHASE) pt1_ = __builtin_amdgcn_s_memrealtime(); } while (0)
#endif
#else
#define PMARK(k) do { } while (0)
#endif
#define SEAM(k) do { if (IN(k) && IN((k) + 1)) { XcdBarrier bar_; bar_.bar = (unsigned*)(F.ctl() + CW_BAR); bar_.x = xb_xcc_id(); bar_.st = (volatile LAS unsigned*)(F.lds() + LDS_MISC); xcd_barrier(bar_); } } while (0)
    if (IN(0)) { p0_prologue(F); } SEAM(0); PMARK(0);
    if (IN(1)) { p1_modulate(F); } SEAM(1); PMARK(1);
    if (IN(2)) {
        pg8::Gemm g{WSP(const bf16, WS_U1), WSP(const bf16, WS_WIN), DM, 20, 0, 0}; pg8::StaticOrder S; S.init(NTOK, NPROJ_PAD, F.G(), F.bid());
        EpiInProj E{F.ws(), F.f(8), F.f(12), F.f(13)};
        pg8::gemm_phase<EpiInProj, pg8::StaticOrder, false>(F.lds(), g, S, E);
        slack_fill(F, (F.bid() + 3 * F.G() < 32 * NPROJ_TILES) ? 0 : 4, false, Q_ALL);
    } SEAM(2); PMARK(2);
    if (IN(3)) {
        PSUB(3, 0); p3_ssd(F); PSUB(3, 1); PSUB(30, 0); p3_idx(F); PSUB(30, 1);
    } SEAM(3); PMARK(3);
    if (IN(4)) { PSUB(40, 0); p4_select(F); PSUB(40, 1); PSUB(41, 0); p4_scan(F); PSUB(41, 1); } SEAM(4); PMARK(4);
    if (IN(5)) { p5_phase(F); slack_fill(F, (F.G() == 256) ? ((F.bid() >> 4) * 5) / 8 : 0, false, Q_ALL); } SEAM(5); PMARK(5);
    if (IN(6)) {
        pg8::Gemm g{WSP(const bf16, WS_YCAT), WSP(const bf16, WS_WOUT), DM, 60, 0, 0}; pg8::StaticOrder S; S.init(NTOK, DM, F.G(), F.bid());
        EpiOutProj E{F.f(0), (const CAS float*)(F.ws() + WS_MODF), F.out()};
        pg8::gemm_phase<EpiOutProj, pg8::StaticOrder, false>(F.lds(), g, S, E);
    } SEAM(6); PMARK(6);
    if (IN(7)) { p7_phase(F); slack_fill(F, 0, true, Q_GU); } SEAM(7); PMARK(7);
    if (IN(8)) {
        const int vcu = (F.G() % 8 == 0) ? (F.bid() % 8) * (F.G() / 8) + F.bid() / 8 : F.bid();
        moe_tables(F);
        pg8::Gemm g{WSP(const bf16, WS_U2), WSP(const bf16, WS_WGU), MOE_FP8 ? DM / 2 : DM, 80, E8_W, E8_U};     MoeOrder S{F.ws(), F.G(), vcu, 4, __builtin_amdgcn_readfirstlane(((const LAS int*)(F.lds() + LDS_MISC + 64))[80 + NEX]) * 4};
        EpiGateUp E{F.ws()};
        pg8::gemm_phase<EpiGateUp, MoeOrder, true, MOE_FP8 != 0>(F.lds(), g, S, E);
        slack_fill(F, 0, true, Q_ALL);
    } SEAM(8); PMARK(8);
    if (IN(9)) {
        const int vcu = (F.G() % 8 == 0) ? (F.bid() % 8) * (F.G() / 8) + F.bid() / 8 : F.bid();
        moe_tables(F);
        pg8::Gemm g{WSP(const bf16, WS_HID), WSP(const bf16, WS_WDN), MOE_FP8_DN ? DE / 2 : DE, 90, E8_W, E8_H}; MoeOrder S{F.ws(), F.G(), vcu, 8, __builtin_amdgcn_readfirstlane(((const LAS int*)(F.lds() + LDS_MISC + 64))[80 + NEX]) * 8};
        EpiDown E{F.ws() + WS_OUTS};
        pg8::gemm_phase<EpiDown, MoeOrder, false, MOE_FP8_DN != 0>(F.lds(), g, S, E);
    } SEAM(9); PMARK(9);
    if (IN(10)) { moe_tables(F); p10_final(F); }
#ifdef PROBE_PHASE
    if (pt1_ == 0ull) pt1_ = __builtin_amdgcn_s_memrealtime();
#ifdef PROBE_SUB
    __syncthreads(); pt0_ = *(volatile LAS unsigned long long*)(F.lds() + LDS_MISC + 32); pt1_ = *(volatile LAS unsigned long long*)(F.lds() + LDS_MISC + 40);
#endif
    if (F.bid() == 0) { const unsigned long long w = 8ull * (pt1_ - pt0_), te = __builtin_amdgcn_s_memrealtime(); while (__builtin_amdgcn_s_memrealtime() - te < w) __builtin_amdgcn_s_sleep(32); }
#endif
#ifdef DBG_OFF
    if (args.ph_hi == N_PHASES) {
        const size_t n = (size_t)NTOK * DM; float* o = F.out();
        for (size_t i = (size_t)F.bid() * 512 + F.tid(); i < n; i += (size_t)F.G() * 512) {
            float v;
            if (DBG_KIND == 0) v = bf2f(((const bf16*)(F.ws() + (size_t)(DBG_OFF)))[i % (size_t)(DBG_N)]);
            else v = ((const float*)(F.ws() + (size_t)(DBG_OFF)))[i % (size_t)(DBG_N)];
            if (!(fabsf(v) < 1e30f)) v = 1e30f;
            o[i] = v; }
    }
#endif
#undef IN
#undef SEAM
#undef PMARK
}

extern "C" void kernel_launch(void* const* d_in, const int* in_sizes, int n_in, void* d_out, int out_size, void* d_ws, size_t ws_size, hipStream_t stream) {
    static int grid = 0;
    if (grid == 0) {
        if (n_in != 27 || out_size != NTOK * DM || ws_size < WS_END) { fprintf(stderr, "kernel_launch: unexpected shapes (n_in %d, out %d, ws %zu; need ws >= %zu)\n", n_in, out_size, ws_size, (size_t)WS_END); }
        int dev = 0, cus = 0, per_cu = 0;
        if (hipGetDevice(&dev) != hipSuccess || hipDeviceGetAttribute(&cus, hipDeviceAttributeMultiprocessorCount, dev) != hipSuccess) { grid = -1; return; }
        if (hipFuncSetAttribute((const void*)fwd_kernel, hipFuncAttributeMaxDynamicSharedMemorySize, LDS_BYTES) != hipSuccess) { fprintf(stderr, "kernel_launch: hipFuncSetAttribute failed\n"); grid = -1; return; }
        if (hipOccupancyMaxActiveBlocksPerMultiprocessor(&per_cu, (const void*)fwd_kernel, 512, LDS_BYTES) != hipSuccess || per_cu < 1) fprintf(stderr, "kernel_launch: occupancy query reports %d\n", per_cu);
        (void)hipGetLastError();
        grid = cus;
    }
    if (grid < 0) return;
    (void)hipMemsetAsync((char*)d_ws + WS_CTL, 0, CTL_ZERO_BYTES, stream);
    Args a{};
    for (int i = 0; i < 27; ++i) a.in[i] = d_in[i];
    a.out = (float*)d_out; a.ws = (unsigned char*)d_ws;
#if MK_N_LAUNCHES == 1
    a.ph_lo = 0; a.ph_hi = N_PHASES;
    hipLaunchKernelGGL(fwd_kernel, dim3(grid), dim3(512), LDS_BYTES, stream, a);
#else
    for (int p = 0; p < N_PHASES; ++p) { a.ph_lo = p; a.ph_hi = p + 1; hipLaunchKernelGGL(fwd_kernel, dim3(grid), dim3(512), LDS_BYTES, stream, a);
#ifdef DUP_PHASE
        if (p == DUP_PHASE) hipLaunchKernelGGL(fwd_kernel, dim3(grid), dim3(512), LDS_BYTES, stream, a);
#endif
    }
#endif
}
```
